# Optimizing an MI355X kernel written in HIP

```python
import math
import jax, jax.numpy as jnp
from jax import lax
import numpy as np

D_MODEL = 1024
BATCH = 8
SEQ = 8192
DEPTH = 2

GRID_W = 64
CTX_LEN = 256
N_BRANCH = 3
BRANCH_W = 1024
Q_BLOCK = 128
EPS = 1e-6
ROPE_BASE = 10000.0
NEG_INF = -1e30

MLA_HEADS = 8
MLA_NOPE = 64
MLA_ROPE = 32
MLA_V = 128
MLA_Q_RANK = 384
MLA_KV_RANK = 256

DIFF_HEADS = 8
DIFF_HD = 64
DIFF_V = 2 * DIFF_HD

SWA_HEADS = 16
SWA_KV_HEADS = 4
SWA_GROUP = SWA_HEADS // SWA_KV_HEADS
SWA_HD = 64
WINDOW = 128

IN_SPLITS = (MLA_Q_RANK, MLA_KV_RANK, MLA_ROPE,
             DIFF_HEADS * 2 * DIFF_HD, DIFF_HEADS * 2 * DIFF_HD, DIFF_HEADS * DIFF_V,
             SWA_HEADS * SWA_HD, SWA_KV_HEADS * SWA_HD, SWA_KV_HEADS * SWA_HD,
             N_BRANCH * BRANCH_W, N_BRANCH * D_MODEL)
D_IN = sum(IN_SPLITS)

kernel_name = 'hybrid_mla_diff_swa_dit'


def rms_norm(x, g):
    xf = x.astype(jnp.float32)
    y = xf * lax.rsqrt(jnp.mean(xf * xf, axis=-1, keepdims=True) + EPS)
    return (y * g.astype(jnp.float32)).astype(x.dtype)


def split_cols(p):
    idx = np.cumsum(np.array(IN_SPLITS))[:-1].tolist()
    return jnp.split(p, idx, axis=-1)


def axial_rope_tables(row, col, rot_dim):
    n_freq = rot_dim // 4
    inv_freq = ROPE_BASE ** (-jnp.arange(n_freq, dtype=jnp.float32) / n_freq)
    ang = jnp.concatenate([row.astype(jnp.float32)[:, None] * inv_freq,
                           col.astype(jnp.float32)[:, None] * inv_freq], axis=-1)
    return jnp.cos(ang), jnp.sin(ang)


def apply_rope(x, cos, sin):
    half = x.shape[-1] // 2
    x1, x2 = x[..., :half], x[..., half:]
    cs = cos[:, None, :].astype(x.dtype)
    sn = sin[:, None, :].astype(x.dtype)
    return jnp.concatenate([x1 * cs - x2 * sn, x2 * cs + x1 * sn], axis=-1)


def sweep_query_blocks(fn, *qs):
    b, n = qs[0].shape[:2]
    nb = n // Q_BLOCK
    blocked = tuple(jnp.moveaxis(q.reshape(b, nb, Q_BLOCK, *q.shape[2:]), 1, 0) for q in qs)
    out = lax.map(lambda args: fn(*args), (jnp.arange(nb),) + blocked)
    out = jnp.moveaxis(out, 0, 1)
    return out.reshape(b, n, *out.shape[3:])


def dense_attend(q, k, v):
    s = jnp.einsum('bqhd,bkhd->bhqk', q * (q.shape[-1] ** -0.5), k)
    p = jax.nn.softmax(s.astype(jnp.float32), axis=-1).astype(v.dtype)
    return jnp.einsum('bhqk,bkhd->bqhd', p, v)


def diff_attend(q, k, v, lam):
    s = jnp.einsum('bqhmd,bkhmd->bhmqk', q * (DIFF_HD ** -0.5), k)
    p = jax.nn.softmax(s.astype(jnp.float32), axis=-1)
    a = (p[:, :, 0] - lam * p[:, :, 1]).astype(v.dtype)
    return jnp.einsum('bhqk,bkhd->bqhd', a, v)


def diff_post(o, subln, lam_init):
    b, n = o.shape[:2]
    return (rms_norm(o, subln) * (1.0 - lam_init)).reshape(b, n, DIFF_HEADS * DIFF_V)


def sink_softmax(sink, parts):
    b, h, g, q = parts[0].shape[:4]
    sk = jnp.broadcast_to(sink.astype(jnp.float32).reshape(1, h, g, 1, 1), (b, h, g, q, 1))
    p = jax.nn.softmax(jnp.concatenate([sk] + [s.astype(jnp.float32) for s in parts], axis=-1), axis=-1)
    out, off = [], 1
    for s in parts:
        out.append(p[..., off:off + s.shape[-1]])
        off += s.shape[-1]
    return out


def mla_heads(qc, kvc, kr, q_norm, w_uq, kv_norm, w_ukv, rope):
    b, n = qc.shape[:2]
    q = (rms_norm(qc, q_norm) @ w_uq).reshape(b, n, MLA_HEADS, MLA_NOPE + MLA_ROPE)
    kv = (rms_norm(kvc, kv_norm) @ w_ukv).reshape(b, n, MLA_HEADS, MLA_NOPE + MLA_V)
    q_nope, q_rot = q[..., :MLA_NOPE], q[..., MLA_NOPE:]
    k_nope, v = kv[..., :MLA_NOPE], kv[..., MLA_NOPE:]
    k_rot = kr[:, :, None, :]
    if rope is not None:
        q_rot = apply_rope(q_rot, *rope)
        k_rot = apply_rope(k_rot, *rope)
    k_rot = jnp.broadcast_to(k_rot, (b, n, MLA_HEADS, MLA_ROPE))
    return (jnp.concatenate([q_nope, q_rot], axis=-1), jnp.concatenate([k_nope, k_rot], axis=-1), v)


def diff_heads(q, k, v, rope):
    b, n = q.shape[:2]
    q = q.reshape(b, n, 2 * DIFF_HEADS, DIFF_HD)
    k = k.reshape(b, n, 2 * DIFF_HEADS, DIFF_HD)
    if rope is not None:
        q = apply_rope(q, *rope)
        k = apply_rope(k, *rope)
    return (q.reshape(b, n, DIFF_HEADS, 2, DIFF_HD), k.reshape(b, n, DIFF_HEADS, 2, DIFF_HD),
            v.reshape(b, n, DIFF_HEADS, DIFF_V))


def swa_heads(q, k, v, rope):
    b, n = q.shape[:2]
    q = q.reshape(b, n, SWA_HEADS, SWA_HD)
    k = k.reshape(b, n, SWA_KV_HEADS, SWA_HD)
    v = v.reshape(b, n, SWA_KV_HEADS, SWA_HD)
    if rope is not None:
        q = apply_rope(q, *rope)
        k = apply_rope(k, *rope)
    return q, k, v


def swa_latent(q, k, v, k_ctx, v_ctx, sink):
    b, n_seq = q.shape[:2]
    span = Q_BLOCK + 2 * WINDOW
    pad = ((0, 0), (WINDOW, WINDOW), (0, 0), (0, 0))
    kp, vp = jnp.pad(k, pad), jnp.pad(v, pad)

    def block(i, qb):
        start = i * Q_BLOCK
        kb = lax.dynamic_slice_in_dim(kp, start, span, axis=1)
        vb = lax.dynamic_slice_in_dim(vp, start, span, axis=1)
        qpos = start + jnp.arange(Q_BLOCK)
        kpos = start - WINDOW + jnp.arange(span)
        mask = (jnp.abs(qpos[:, None] - kpos[None, :]) <= WINDOW) & (kpos >= 0)[None, :] & (kpos < n_seq)[None, :]
        qg = qb.reshape(b, Q_BLOCK, SWA_KV_HEADS, SWA_GROUP, SWA_HD) * (SWA_HD ** -0.5)
        s_loc = jnp.where(mask, jnp.einsum('bqhgd,bkhd->bhgqk', qg, kb).astype(jnp.float32), NEG_INF)
        s_ctx = jnp.einsum('bqhgd,bkhd->bhgqk', qg, k_ctx)
        p_ctx, p_loc = sink_softmax(sink, (s_ctx, s_loc))
        o = (jnp.einsum('bhgqk,bkhd->bqhgd', p_ctx.astype(v.dtype), v_ctx)
             + jnp.einsum('bhgqk,bkhd->bqhgd', p_loc.astype(v.dtype), vb))
        return o.reshape(b, Q_BLOCK, SWA_HEADS * SWA_HD)

    return sweep_query_blocks(block, q)


def swa_context(q, k, v, sink):
    b, n = q.shape[:2]
    qg = q.reshape(b, n, SWA_KV_HEADS, SWA_GROUP, SWA_HD) * (SWA_HD ** -0.5)
    (p,) = sink_softmax(sink, (jnp.einsum('bqhgd,bkhd->bhgqk', qg, k),))
    o = jnp.einsum('bhgqk,bkhd->bqhgd', p.astype(v.dtype), v)
    return o.reshape(b, n, SWA_HEADS * SWA_HD)


def merge_branches(ys, z, gm, w_branch, w_out):
    terms = []
    for r, y in enumerate(ys):
        zr = z[..., r * BRANCH_W:(r + 1) * BRANCH_W]
        gr = gm[..., r * D_MODEL:(r + 1) * D_MODEL]
        terms.append(jax.nn.sigmoid(gr) * ((y * jax.nn.silu(zr)) @ w_branch[r]))
    return (terms[0] + terms[1] + terms[2]) @ w_out


def hybrid_layer(x, ctx, mod_lat, mod_ctx, rope_mla, rope_hd, norm_g, w_in,
                 mla_q_norm, mla_w_uq, mla_kv_norm, mla_w_ukv,
                 lam, lam_init, diff_subln, swa_sink, w_branch, w_out, need_ctx):
    shift, scale, gate = jnp.split(mod_lat[:, None, :], 3, axis=-1)
    shift_c, scale_c, gate_c = jnp.split(mod_ctx, 3, axis=-1)
    h_lat = rms_norm(x, norm_g) * (1.0 + scale) + shift
    h_ctx = rms_norm(ctx, norm_g) * (1.0 + scale_c) + shift_c
    qc_l, kvc_l, kr_l, dq_l, dk_l, dv_l, sq_l, sk_l, sv_l, z_l, gm_l = split_cols(h_lat @ w_in)
    qc_c, kvc_c, kr_c, dq_c, dk_c, dv_c, sq_c, sk_c, sv_c, z_c, gm_c = split_cols(h_ctx @ w_in)

    mq_l, mk_l, mv_l = mla_heads(qc_l, kvc_l, kr_l, mla_q_norm, mla_w_uq, mla_kv_norm, mla_w_ukv, rope_mla)
    mq_c, mk_c, mv_c = mla_heads(qc_c, kvc_c, kr_c, mla_q_norm, mla_w_uq, mla_kv_norm, mla_w_ukv, None)
    mk_all = jnp.concatenate([mk_c, mk_l], axis=1)
    mv_all = jnp.concatenate([mv_c, mv_l], axis=1)
    b, n = x.shape[:2]
    ya_l = sweep_query_blocks(lambda i, qb: dense_attend(qb, mk_all, mv_all), mq_l).reshape(b, n, BRANCH_W)

    dq_l, dk_l, dv_l = diff_heads(dq_l, dk_l, dv_l, rope_hd)
    dq_c, dk_c, dv_c = diff_heads(dq_c, dk_c, dv_c, None)
    dk_all = jnp.concatenate([dk_c, dk_l], axis=1)
    dv_all = jnp.concatenate([dv_c, dv_l], axis=1)
    yb_l = diff_post(sweep_query_blocks(lambda i, qb: diff_attend(qb, dk_all, dv_all, lam), dq_l),
                     diff_subln, lam_init)

    sq_l, sk_l, sv_l = swa_heads(sq_l, sk_l, sv_l, rope_hd)
    sq_c, sk_c, sv_c = swa_heads(sq_c, sk_c, sv_c, None)
    yc_l = swa_latent(sq_l, sk_l, sv_l, sk_c, sv_c, swa_sink)

    x = x + gate * merge_branches((ya_l, yb_l, yc_l), z_l, gm_l, w_branch, w_out)

    if need_ctx:
        bc, nc = ctx.shape[:2]
        ya_c = dense_attend(mq_c, mk_c, mv_c).reshape(bc, nc, BRANCH_W)
        yb_c = diff_post(diff_attend(dq_c, dk_c, dv_c, lam), diff_subln, lam_init)
        yc_c = swa_context(sq_c, sk_c, sv_c, swa_sink)
        ctx = ctx + gate_c * merge_branches((ya_c, yb_c, yc_c), z_c, gm_c, w_branch, w_out)
    return x, ctx


def setup_inputs(seed: int = 0) -> dict:
    key = jax.random.key(seed)
    ks = jax.random.split(key, 22)
    f32 = jnp.float32

    def nrm(k, shape, s):
        return jax.random.normal(k, shape, f32) * s

    L = DEPTH
    return {
        'x': nrm(ks[0], (BATCH, SEQ, D_MODEL), 1.0),
        'c': nrm(ks[1], (BATCH, D_MODEL), 1.0),
        'ctx': nrm(ks[2], (BATCH, CTX_LEN, D_MODEL), 1.0),
        'c_ctx': nrm(ks[3], (D_MODEL,), 1.0),
        'w_mod': nrm(ks[4], (L, D_MODEL, 3 * D_MODEL), D_MODEL ** -0.5),
        'b_mod': nrm(ks[5], (L, 3 * D_MODEL), 0.01),
        'norm_g': 1.0 + nrm(ks[6], (L, D_MODEL), 0.02),
        'w_in': nrm(ks[7], (L, D_MODEL, D_IN), D_MODEL ** -0.5),
        'mla_q_norm': 1.0 + nrm(ks[8], (L, MLA_Q_RANK), 0.02),
        'mla_w_uq': nrm(ks[9], (L, MLA_Q_RANK, MLA_HEADS * (MLA_NOPE + MLA_ROPE)), MLA_Q_RANK ** -0.5),
        'mla_kv_norm': 1.0 + nrm(ks[10], (L, MLA_KV_RANK), 0.02),
        'mla_w_ukv': nrm(ks[11], (L, MLA_KV_RANK, MLA_HEADS * (MLA_NOPE + MLA_V)), MLA_KV_RANK ** -0.5),
        'diff_lq1': nrm(ks[12], (L, DIFF_HD), 0.1),
        'diff_lk1': nrm(ks[13], (L, DIFF_HD), 0.1),
        'diff_lq2': nrm(ks[14], (L, DIFF_HD), 0.1),
        'diff_lk2': nrm(ks[15], (L, DIFF_HD), 0.1),
        'diff_subln': 1.0 + nrm(ks[16], (L, DIFF_V), 0.02),
        'swa_sink': nrm(ks[17], (L, SWA_HEADS), 0.5),
        'w_branch': nrm(ks[18], (L, N_BRANCH, BRANCH_W, D_MODEL), BRANCH_W ** -0.5),
        'w_out': nrm(ks[19], (L, D_MODEL, D_MODEL), D_MODEL ** -0.5),
        'final_norm': 1.0 + nrm(ks[20], (D_MODEL,), 0.02),
    }


def reference(x, c, ctx, c_ctx, w_mod, b_mod, norm_g, w_in, mla_q_norm, mla_w_uq, mla_kv_norm, mla_w_ukv,
              diff_lq1, diff_lk1, diff_lq2, diff_lk2, diff_subln, swa_sink, w_branch, w_out, final_norm):
    n_lat = x.shape[1]
    ROWS = n_lat // GRID_W
    row = jnp.repeat(jnp.arange(ROWS), GRID_W)
    col = jnp.tile(jnp.arange(GRID_W), ROWS)
    rope_mla = axial_rope_tables(row, col, MLA_ROPE)
    rope_hd = axial_rope_tables(row, col, SWA_HD)
    silu_c = jax.nn.silu(c)
    silu_cc = jax.nn.silu(c_ctx)
    f32 = jnp.float32
    for l in range(DEPTH):
        mod_lat = silu_c @ w_mod[l] + b_mod[l]
        mod_ctx = silu_cc @ w_mod[l] + b_mod[l]
        lam_init = 0.8 - 0.6 * math.exp(-0.3 * l)
        lam = (jnp.exp(jnp.sum(diff_lq1[l].astype(f32) * diff_lk1[l].astype(f32)))
               - jnp.exp(jnp.sum(diff_lq2[l].astype(f32) * diff_lk2[l].astype(f32))) + lam_init)
        x, ctx = hybrid_layer(x, ctx, mod_lat, mod_ctx, rope_mla, rope_hd, norm_g[l], w_in[l],
                              mla_q_norm[l], mla_w_uq[l], mla_kv_norm[l], mla_w_ukv[l],
                              lam, lam_init, diff_subln[l], swa_sink[l], w_branch[l], w_out[l],
                              l < DEPTH - 1)
    return rms_norm(x, final_norm)
```

```cpp
#include <hip/hip_runtime.h>
#include <hip/hip_cooperative_groups.h>
#include <cstdio>
#include <cstdint>
namespace cg = cooperative_groups;

#define DI __device__ __forceinline__
#define LAS __attribute__((address_space(3)))
__device__ __forceinline__ int tid_l() { int t = threadIdx.x; asm volatile("" : "+v"(t)); return t; }
__device__ __forceinline__ int bid_l() { int b = blockIdx.x; asm volatile("" : "+s"(b)); return b; }
__device__ __forceinline__ int grd_l() { int g = gridDim.x; asm volatile("" : "+s"(g)); return g; }
typedef unsigned short bf16_t;
typedef short bf16x8 __attribute__((ext_vector_type(8)));
typedef short s16x4 __attribute__((ext_vector_type(4)));
typedef float f32x4 __attribute__((ext_vector_type(4)));
typedef float f32x16 __attribute__((ext_vector_type(16)));
typedef unsigned u32x4 __attribute__((ext_vector_type(4)));
typedef unsigned u32x2 __attribute__((ext_vector_type(2)));

constexpr int DM = 1024, NBATCH = 8, SEQ = 8192, CTX = 256, RB = CTX + SEQ;
constexpr int GB = 2, NGRP = NBATCH / GB, R = GB * RB;
constexpr int NP = 11520;
constexpr int C_QC = 0, C_KVC = 384, C_KR = 640, C_DQ = 768, C_DK = 1792, C_DV = 2816, C_SQ = 3840, C_SK = 4864, C_SV = 5120, C_Z = 5376, C_GM = 8448;
constexpr int D_IN = 11424;
constexpr float EPS = 1e-6f, LOG2E = 1.4426950408889634f;
constexpr float QS64 = 0.125f * LOG2E, QS96 = 0.10206207261596575f * LOG2E;
constexpr float NEGBIG = -1e30f, THR = 8.0f;

constexpr size_t al256(size_t x) { return (x + 255) & ~(size_t)255; }
constexpr size_t WS_WIN = 1u << 20;
constexpr size_t WS_WUQ = al256(WS_WIN + (size_t)2 * NP * 1024 * 2);
constexpr size_t WS_WUKV = al256(WS_WUQ + (size_t)2 * 768 * 384 * 2);
constexpr size_t WS_WB = al256(WS_WUKV + (size_t)2 * 1536 * 256 * 2);
constexpr size_t WS_WO3 = al256(WS_WB + (size_t)2 * 3 * 1024 * 1024 * 2);
constexpr size_t WS_COSH = al256(WS_WO3 + (size_t)2 * 1024 * 3072 * 2);
constexpr size_t WS_SINH = al256(WS_COSH + (size_t)SEQ * 32 * 4);
constexpr size_t WS_COSM = al256(WS_SINH + (size_t)SEQ * 32 * 4);
constexpr size_t WS_SINM = al256(WS_COSM + (size_t)SEQ * 16 * 4);
constexpr size_t WS_MODP = al256(WS_SINM + (size_t)SEQ * 16 * 4);
constexpr size_t WS_MOD = al256(WS_MODP + (size_t)16 * 2 * 9 * 3072 * 4);
constexpr size_t WS_CTX = al256(WS_MOD + (size_t)2 * 9 * 3072 * 4);
constexpr size_t WS_H = al256(WS_CTX + (size_t)NBATCH * CTX * DM * 4);
constexpr size_t WS_P = al256(WS_H + (size_t)R * DM * 2);
constexpr size_t WS_AQ = al256(WS_P + (size_t)R * NP * 2);
constexpr size_t WS_AKV = al256(WS_AQ + (size_t)R * 384 * 2);
constexpr size_t WS_QM = al256(WS_AKV + (size_t)R * 256 * 2);
constexpr size_t WS_KM = al256(WS_QM + (size_t)R * 768 * 2);
constexpr size_t WS_VM = al256(WS_KM + (size_t)R * 768 * 2);
constexpr size_t WS_OD = al256(WS_VM + (size_t)R * 1024 * 2);
constexpr size_t WS_END = al256(WS_OD + (size_t)R * 2048 * 4);
static_assert(WS_END <= ((size_t)1 << 30), "workspace map exceeds 1 GiB");

constexpr int LDS_BYTES = 147456;

DI unsigned pk2(float lo, float hi) { typedef float f2_t __attribute__((ext_vector_type(2))); typedef __bf16 b2_t __attribute__((ext_vector_type(2)));
    f2_t v = {lo, hi}; b2_t b = __builtin_convertvector(v, b2_t); return __builtin_bit_cast(unsigned, b); }
DI u32x4 pack8(f32x4 a, f32x4 b) { u32x4 w; w.x = pk2(a[0], a[1]); w.y = pk2(a[2], a[3]); w.z = pk2(b[0], b[1]); w.w = pk2(b[2], b[3]); return w; }
DI float bflo(unsigned w) { return __uint_as_float(w << 16); }
DI float bfhi(unsigned w) { return __uint_as_float(w & 0xffff0000u); }
DI float wave_sum(float v) {
#pragma unroll
    for (int o = 1; o < 64; o <<= 1) v += __shfl_xor(v, o);
    return v; }
DI float silu_f(float z) { return z / (1.0f + __expf(-z)); }
DI float sigm_f(float z) { return 1.0f / (1.0f + __expf(-z)); }
DI void rope8(f32x4& v0, f32x4& v1, const f32x4 cs, const f32x4 sn) {
    float a, b;
    a = v0[0]; b = v0[1]; v0[0] = a * cs[0] - b * sn[0]; v0[1] = b * cs[0] + a * sn[0];
    a = v0[2]; b = v0[3]; v0[2] = a * cs[1] - b * sn[1]; v0[3] = b * cs[1] + a * sn[1];
    a = v1[0]; b = v1[1]; v1[0] = a * cs[2] - b * sn[2]; v1[1] = b * cs[2] + a * sn[2];
    a = v1[2]; b = v1[3]; v1[2] = a * cs[3] - b * sn[3]; v1[3] = b * cs[3] + a * sn[3];
}
namespace pg8 {
#define PG8_LAS __attribute__((address_space(3)))
typedef unsigned short bf16_t;
typedef short bf16x8 __attribute__((ext_vector_type(8)));
typedef float f32x4 __attribute__((ext_vector_type(4)));
typedef unsigned u32x4 __attribute__((ext_vector_type(4)));
constexpr int BM = 256, BK = 64, HALF = 128, HTB = HALF * BK * 2  , STAGE_BYTES = 8 * HTB, NXCD = 8, WGM = 8;

__host__ __device__ __forceinline__ int lds_byte(int r, int c) { const int st = (r >> 4) * 2 + (c >> 5), rr = r & 15, cc = c & 31, ob = rr * 64 + cc * 2; return st * 1024 + (ob ^ (((ob >> 9) & 1) << 5)); }
__host__ __device__ __forceinline__ void stage_rc(int b, int& R, int& C) { const int st = b / 1024, sb = b % 1024, swz = sb ^ (((sb >> 9) & 1) << 5); R = (st >> 1) * 16 + swz / 64; C = (st & 1) * 32 + (swz % 64) / 2; }
__host__ __device__ __forceinline__ int perm32(int rho) { const int n = rho >> 4, i = rho & 15; return 8 * (i >> 2) + 4 * n + (i & 3); }

struct Unit { int pm, pn; };
struct Gemm { int K, lda, ldb; };
struct Order {
    int nM, nN, nwg, G, c; const char* A; const char* B; unsigned tA, tB; int pnblk; unsigned ablk;
    __device__ __forceinline__ void init(int M, int N, int G_, int c_, const void* A_, int lda, const void* B_, int ldb, int pnblk_, unsigned ablk_) {
        nM = M / BM; nN = N / BM; nwg = nM * nN; G = G_; c = c_; A = (const char*)A_; B = (const char*)B_; tA = (unsigned)(BM * lda * 2); tB = (unsigned)(BM * ldb * 2); pnblk = pnblk_; ablk = ablk_; }
    __device__ __forceinline__ bool next(int i, Unit& u) const {
        const long L = (long)i * G + c; if (L >= nwg) return false;
        int wgid = (int)L; { const int q = nwg / NXCD, r = nwg % NXCD, xcd = wgid % NXCD, off = wgid / NXCD; wgid = (xcd < r ? xcd * (q + 1) : r * (q + 1) + (xcd - r) * q) + off; }
        const int nig = WGM * nN, gid = wgid / nig, fm = gid * WGM, gsz = (nM - fm) < WGM ? (nM - fm) : WGM;
        u.pm = fm + ((wgid % nig) % gsz); u.pn = (wgid % nig) / gsz; return true;
    }
    __device__ __forceinline__ const char* a_base(const Unit& u) const { return A + (size_t)u.pm * tA + (size_t)(u.pn / pnblk) * ablk; }
    __device__ __forceinline__ const char* b_base(const Unit& u) const { return B + (size_t)u.pn * tB; }
};

template <class Epi, class Sched, bool ALIGN_EPI = false, bool SP2 = false>
__device__ __forceinline__ void gemm_phase(PG8_LAS unsigned char* lds, const Gemm g, const Sched& S, const Epi& E) {
    const int tid = tid_l(), wid = __builtin_amdgcn_readfirstlane(tid >> 6), lane = tid & 63, wr = wid >> 2, wc = wid & 3, fr = lane & 15, fq = lane >> 4;
    const int K = g.K, nt = K / BK;
    unsigned voffA[2], voffB[2];
#pragma unroll
    for (int i = 0; i < 2; ++i) { int R, C; stage_rc(tid * 16 + i * 8192, R, C); const int Rb = Epi::PERM ? ((R & ~31) + perm32(R & 31)) : R;
        voffA[i] = (unsigned)(R * g.lda + C) * 2u; voffB[i] = (unsigned)(Rb * g.ldb + C) * 2u; }
    const size_t kstep = (size_t)(BK * 2);
    const size_t hstepA = (size_t)HALF * g.lda * 2, hstepB = (size_t)HALF * g.ldb * 2;
    const unsigned ldsw = (unsigned)wid * 1024u;
    const int aoff = lds_byte(wr * 64 + fr, fq * 8), boff = lds_byte(wc * 32 + fr, fq * 8);
#define PG8_SA(b, h) (((b) * 2 + (h)) * HTB)
#define PG8_SB(b, h) ((4 + (b) * 2 + (h)) * HTB)
#define PG8_STAGE(bufoff, gbase, voff) do { _Pragma("unroll") for (int _i = 0; _i < 2; ++_i) \
        __builtin_amdgcn_global_load_lds((const unsigned*)((const char*)(gbase) + (voff)[_i]), (PG8_LAS unsigned*)(lds + (bufoff) + ldsw + _i * 8192), 16, 0, 0); } while (0)
#define PG8_LDA(dst, b, h) do { _Pragma("unroll") for (int m = 0; m < 4; ++m) _Pragma("unroll") for (int k = 0; k < 2; ++k) dst[m][k] = *(const PG8_LAS bf16x8*)(lds + PG8_SA(b, h) + aoff + m * 2048 + k * 1024); } while (0)
#define PG8_LDB(dst, b, h) do { _Pragma("unroll") for (int n = 0; n < 2; ++n) _Pragma("unroll") for (int k = 0; k < 2; ++k) dst[n][k] = *(const PG8_LAS bf16x8*)(lds + PG8_SB(b, h) + boff + n * 2048 + k * 1024); } while (0)
#define PG8_MMA(ai, bj, At, Bt) do { __builtin_amdgcn_s_setprio(1); _Pragma("unroll") for (int m = 0; m < 4; ++m) _Pragma("unroll") for (int n = 0; n < 2; ++n) _Pragma("unroll") for (int k = 0; k < 2; ++k) \
        acc[ai][bj][m][n] = __builtin_amdgcn_mfma_f32_16x16x32_bf16(Bt[n][k], At[m][k], acc[ai][bj][m][n], 0, 0, 0); __builtin_amdgcn_s_setprio(0); } while (0)
#define PG8_WAIT_V(n) asm volatile("s_waitcnt vmcnt(" #n ")" ::: "memory")
#define PG8_WAIT_L(n) asm volatile("s_waitcnt lgkmcnt(" #n ")" ::: "memory")
#define PG8_BAR __builtin_amdgcn_s_barrier()
#define PG8_SCHED __builtin_amdgcn_sched_barrier(0)
    Unit cur, nxt; int ui = 0;
    if (!S.next(0, cur)) return;
    f32x4 acc[2][2][4][2];
#pragma unroll
    for (int a = 0; a < 2; ++a)
#pragma unroll
        for (int b = 0; b < 2; ++b)
#pragma unroll
            for (int m = 0; m < 4; ++m)
#pragma unroll
                for (int n = 0; n < 2; ++n) acc[a][b][m][n] = (f32x4){0.f, 0.f, 0.f, 0.f};
    bf16x8 At[4][2], B0[2][2], B1[2][2];
    const char* cA = S.a_base(cur); const char* cB = S.b_base(cur);

    if constexpr (SP2) {
        PG8_STAGE(PG8_SB(0, 0), cB, voffB); PG8_STAGE(PG8_SB(0, 1), cB + hstepB, voffB); PG8_STAGE(PG8_SA(0, 0), cA, voffA); PG8_STAGE(PG8_SA(0, 1), cA + hstepA, voffA);
        if (wr == 1) PG8_BAR;
        PG8_WAIT_V(2); PG8_BAR;
        PG8_STAGE(PG8_SB(1, 0), cB + kstep, voffB); PG8_STAGE(PG8_SA(1, 0), cA + kstep, voffA); PG8_STAGE(PG8_SB(1, 1), cB + hstepB + kstep, voffB);
        PG8_WAIT_V(6); PG8_BAR;
    } else {
        PG8_STAGE(PG8_SB(0, 0), cB, voffB); PG8_STAGE(PG8_SA(0, 0), cA, voffA); PG8_STAGE(PG8_SB(0, 1), cB + hstepB, voffB); PG8_STAGE(PG8_SA(0, 1), cA + hstepA, voffA);
        if (wr == 1) PG8_BAR;
        PG8_WAIT_V(4); PG8_BAR;
        PG8_STAGE(PG8_SB(1, 0), cB + kstep, voffB); PG8_STAGE(PG8_SA(1, 0), cA + kstep, voffA); PG8_STAGE(PG8_SB(1, 1), cB + hstepB + kstep, voffB);
        PG8_WAIT_V(6); PG8_BAR;
    }
    for (;;) {
        const bool has_next = S.next(ui + 1, nxt);
        const char* nA = has_next ? S.a_base(nxt) : cA; const char* nB = has_next ? S.b_base(nxt) : cB;
#pragma nounroll
        for (int t = 0; t < nt; t += 2) {
            const bool last = (t == nt - 2);
            const char* a1 = cA + (size_t)(t + 1) * kstep;
            const char* a2 = last ? nA : cA + (size_t)(t + 2) * kstep; const char* b2 = last ? nB : cB + (size_t)(t + 2) * kstep;
            const char* a3 = a2 + kstep; const char* b3 = b2 + kstep;

            if constexpr (SP2) {
            PG8_LDB(B0, 0, 0); PG8_LDB(B1, 0, 1); PG8_SCHED; PG8_LDA(At, 0, 0); PG8_STAGE(PG8_SA(1, 1), a1 + hstepA, voffA);
            PG8_WAIT_V(8); PG8_WAIT_L(0); PG8_BAR; PG8_MMA(0, 0, At, B0); PG8_MMA(0, 1, At, B1); PG8_BAR; PG8_SCHED;
            PG8_LDA(At, 0, 1); PG8_STAGE(PG8_SB(0, 0), b2, voffB); PG8_STAGE(PG8_SB(0, 1), b2 + hstepB, voffB); PG8_STAGE(PG8_SA(0, 0), a2, voffA);
            PG8_WAIT_V(8); PG8_WAIT_L(0); PG8_BAR; PG8_MMA(1, 0, At, B0); PG8_MMA(1, 1, At, B1); PG8_BAR; PG8_SCHED;
            PG8_LDB(B0, 1, 0); PG8_LDB(B1, 1, 1); PG8_SCHED; PG8_LDA(At, 1, 0); PG8_STAGE(PG8_SA(0, 1), a2 + hstepA, voffA);
            PG8_WAIT_V(8); PG8_WAIT_L(0); PG8_BAR; PG8_MMA(0, 0, At, B0); PG8_MMA(0, 1, At, B1); PG8_BAR; PG8_SCHED;
            PG8_LDA(At, 1, 1); PG8_STAGE(PG8_SB(1, 0), b3, voffB); PG8_STAGE(PG8_SB(1, 1), b3 + hstepB, voffB); PG8_STAGE(PG8_SA(1, 0), a3, voffA);
            PG8_WAIT_V(8); PG8_WAIT_L(0); PG8_BAR; PG8_MMA(1, 0, At, B0); PG8_MMA(1, 1, At, B1); PG8_BAR; PG8_SCHED;
            } else {
            PG8_LDB(B0, 0, 0); PG8_SCHED; PG8_LDA(At, 0, 0); PG8_STAGE(PG8_SA(1, 1), a1 + hstepA, voffA);
            PG8_WAIT_L(8); PG8_BAR; PG8_WAIT_L(0); PG8_MMA(0, 0, At, B0); PG8_BAR; PG8_SCHED;
            PG8_LDB(B1, 0, 1); PG8_STAGE(PG8_SB(0, 0), b2, voffB);
            PG8_BAR; PG8_WAIT_L(0); PG8_MMA(0, 1, At, B1); PG8_BAR;
            PG8_LDA(At, 0, 1); PG8_STAGE(PG8_SA(0, 0), a2, voffA);
            PG8_BAR; PG8_WAIT_L(0); PG8_MMA(1, 0, At, B0); PG8_BAR; PG8_SCHED;
            PG8_STAGE(PG8_SB(0, 1), b2 + hstepB, voffB);
            PG8_WAIT_V(6); PG8_BAR; PG8_MMA(1, 1, At, B1); PG8_BAR;
            PG8_LDB(B0, 1, 0); PG8_SCHED; PG8_LDA(At, 1, 0); PG8_STAGE(PG8_SA(0, 1), a2 + hstepA, voffA);
            PG8_WAIT_L(8); PG8_BAR; PG8_WAIT_L(0); PG8_MMA(0, 0, At, B0); PG8_BAR; PG8_SCHED;
            PG8_LDB(B1, 1, 1); PG8_STAGE(PG8_SB(1, 0), b3, voffB);
            PG8_BAR; PG8_WAIT_L(0); PG8_MMA(0, 1, At, B1); PG8_BAR;
            PG8_LDA(At, 1, 1); PG8_STAGE(PG8_SA(1, 0), a3, voffA);
            PG8_BAR; PG8_WAIT_L(0); PG8_MMA(1, 0, At, B0); PG8_BAR; PG8_SCHED;
            PG8_STAGE(PG8_SB(1, 1), b3 + hstepB, voffB);
            PG8_WAIT_V(6); PG8_BAR; PG8_MMA(1, 1, At, B1); PG8_BAR;
            }
        }
        if constexpr (ALIGN_EPI) { if (wr == 0) PG8_BAR; }
        if constexpr (!Epi::AFTER_DRAIN) { E(acc, cur, wr, wc, fr, fq); }
        if (!has_next) break;
#pragma unroll
        for (int a = 0; a < 2; ++a)
#pragma unroll
            for (int b = 0; b < 2; ++b)
#pragma unroll
                for (int m = 0; m < 4; ++m)
#pragma unroll
                    for (int n = 0; n < 2; ++n) acc[a][b][m][n] = (f32x4){0.f, 0.f, 0.f, 0.f};
        cur = nxt; cA = nA; cB = nB; ++ui;
        if constexpr (ALIGN_EPI) { if (wr == 1) PG8_BAR; }
    }
    PG8_WAIT_V(0);
    if constexpr (!ALIGN_EPI) { if (wr == 0) PG8_BAR; }
    PG8_BAR;
    if constexpr (Epi::AFTER_DRAIN) { E.fused(acc, cur, wr, wc, fr, fq, lds, wid, lane); }
#undef PG8_SA
#undef PG8_SB
#undef PG8_STAGE
#undef PG8_LDA
#undef PG8_LDB
#undef PG8_MMA
#undef PG8_WAIT_V
#undef PG8_WAIT_L
#undef PG8_BAR
#undef PG8_SCHED
}
}
struct EpiIn {
    static constexpr bool PERM = true, AFTER_DRAIN = false;
    unsigned char* ws;
    DI void operator()(const f32x4 (&acc)[2][2][4][2], const pg8::Unit& u, int wr, int wc, int fr, int fq) const {
        bf16_t* P = (bf16_t*)(ws + WS_P); const float* cosH = (const float*)(ws + WS_COSH); const float* sinH = (const float*)(ws + WS_SINH); const float* cosM = (const float*)(ws + WS_COSM); const float* sinM = (const float*)(ws + WS_SINM);
        const int pn = u.pn; const bool ctxt = (u.pm % 33) == 0;
        int mode = 0; float sc = 1.f;
        if ((pn >= 3 && pn <= 10) || (pn >= 15 && pn <= 19)) mode = 1;
        if (pn == 2) mode = 2;
        if ((pn >= 3 && pn <= 6) || (pn >= 15 && pn <= 18)) sc = QS64;
        if (ctxt) mode = 0;
        const int rowt = u.pm * 256 + wr * 64 + fr, colb = pn * 256 + wc * 32 + 8 * fq;
#pragma unroll
        for (int ai = 0; ai < 2; ++ai)
#pragma unroll
            for (int m = 0; m < 4; ++m) {
                const int row = rowt + ai * 128 + m * 16; const int pos = (row % RB) - CTX;
                bf16_t* rowp = P + (size_t)row * NP;
#pragma unroll
                for (int bj = 0; bj < 2; ++bj) {
                    const int col0 = colb + bj * 128;
                    f32x4 v0 = acc[ai][bj][m][0], v1 = acc[ai][bj][m][1];
                    if (mode == 1) { const int p0 = (col0 & 63) >> 1; const f32x4 cs = *(const f32x4*)(cosH + (size_t)pos * 32 + p0), sn = *(const f32x4*)(sinH + (size_t)pos * 32 + p0); rope8(v0, v1, cs, sn); }
                    else if (mode == 2 && col0 >= C_KR && col0 < C_KR + 32) { const int p0 = (col0 - C_KR) >> 1; const f32x4 cs = *(const f32x4*)(cosM + (size_t)pos * 16 + p0), sn = *(const f32x4*)(sinM + (size_t)pos * 16 + p0); rope8(v0, v1, cs, sn); }
                    v0 = v0 * sc; v1 = v1 * sc;
                    *(u32x4*)(rowp + col0) = pack8(v0, v1);
                }
            }
    }
};
struct EpiQ {
    static constexpr bool PERM = true, AFTER_DRAIN = false;
    unsigned char* ws;
    DI void operator()(const f32x4 (&acc)[2][2][4][2], const pg8::Unit& u, int wr, int wc, int fr, int fq) const {
        bf16_t* QM = (bf16_t*)(ws + WS_QM); const float* cosM = (const float*)(ws + WS_COSM); const float* sinM = (const float*)(ws + WS_SINM);
        const bool ctxt = (u.pm % 33) == 0;
        const int rowt = u.pm * 256 + wr * 64 + fr, colb = u.pn * 256 + wc * 32 + 8 * fq;
#pragma unroll
        for (int ai = 0; ai < 2; ++ai)
#pragma unroll
            for (int m = 0; m < 4; ++m) {
                const int row = rowt + ai * 128 + m * 16; const int pos = (row % RB) - CTX;
#pragma unroll
                for (int bj = 0; bj < 2; ++bj) {
                    const int col0 = colb + bj * 128, within = col0 % 96;
                    f32x4 v0 = acc[ai][bj][m][0], v1 = acc[ai][bj][m][1];
                    if (!ctxt && within >= 64) { const int p0 = (within - 64) >> 1; const f32x4 cs = *(const f32x4*)(cosM + (size_t)pos * 16 + p0), sn = *(const f32x4*)(sinM + (size_t)pos * 16 + p0); rope8(v0, v1, cs, sn); }
                    v0 = v0 * QS96; v1 = v1 * QS96;
                    *(u32x4*)(QM + (size_t)row * 768 + col0) = pack8(v0, v1);
                }
                asm volatile("" ::: "memory");
            }
    }
};
struct EpiKV {
    static constexpr bool PERM = true, AFTER_DRAIN = false;
    unsigned char* ws;
    DI void operator()(const f32x4 (&acc)[2][2][4][2], const pg8::Unit& u, int wr, int wc, int fr, int fq) const {
        bf16_t* KM = (bf16_t*)(ws + WS_KM); bf16_t* VM = (bf16_t*)(ws + WS_VM);
        const int rowt = u.pm * 256 + wr * 64 + fr, colb = u.pn * 256 + wc * 32 + 8 * fq;
#pragma unroll
        for (int ai = 0; ai < 2; ++ai)
#pragma unroll
            for (int m = 0; m < 4; ++m) {
                const int row = rowt + ai * 128 + m * 16;
#pragma unroll
                for (int bj = 0; bj < 2; ++bj) {
                    const int col0 = colb + bj * 128;
                    bf16_t* dst = (col0 < 512) ? KM + (size_t)row * 768 + (col0 >> 6) * 96 + (col0 & 63) : VM + (size_t)row * 1024 + (col0 - 512);
                    *(u32x4*)dst = pack8(acc[ai][bj][m][0], acc[ai][bj][m][1]);
                }
                asm volatile("" ::: "memory");
            }
    }
};
struct EpiBr {
    static constexpr bool PERM = true, AFTER_DRAIN = false;
    unsigned char* ws;
    DI void operator()(const f32x4 (&acc)[2][2][4][2], const pg8::Unit& u, int wr, int wc, int fr, int fq) const {
        bf16_t* P = (bf16_t*)(ws + WS_P);
        const int rowt = u.pm * 256 + wr * 64 + fr, colb = u.pn * 256 + wc * 32 + 8 * fq;
#pragma unroll
        for (int ai = 0; ai < 2; ++ai)
#pragma unroll
            for (int m = 0; m < 4; ++m) {
                const int row = rowt + ai * 128 + m * 16;
#pragma unroll
                for (int bj = 0; bj < 2; ++bj) {
                    bf16_t* p = P + (size_t)row * NP + C_GM + colb + bj * 128;
                    const u32x4 g = *(const u32x4*)p;
                    f32x4 v0 = acc[ai][bj][m][0], v1 = acc[ai][bj][m][1];
                    v0[0] *= sigm_f(bflo(g.x)); v0[1] *= sigm_f(bfhi(g.x)); v0[2] *= sigm_f(bflo(g.y)); v0[3] *= sigm_f(bfhi(g.y));
                    v1[0] *= sigm_f(bflo(g.z)); v1[1] *= sigm_f(bfhi(g.z)); v1[2] *= sigm_f(bflo(g.w)); v1[3] *= sigm_f(bfhi(g.w));
                    *(u32x4*)p = pack8(v0, v1);
                }
            }
    }
};
struct EpiOut {
    static constexpr bool PERM = true, AFTER_DRAIN = false;
    int l, g; const float* xsrc; float* xdst; const float* ctxsrc; unsigned char* ws;
    DI void operator()(const f32x4 (&acc)[2][2][4][2], const pg8::Unit& u, int wr, int wc, int fr, int fq) const {
        float* ctxdst = (float*)(ws + WS_CTX); const float* mod = (const float*)(ws + WS_MOD) + (size_t)l * 9 * 3072;
        const int pmb = u.pm % 33, b = g * GB + u.pm / 33; const bool ctxt = pmb == 0;
        if (ctxt && l != 0) return;
        const float* gate = mod + (size_t)(ctxt ? 8 : b) * 3072 + 2048;
        const int colb = u.pn * 256 + wc * 32 + 8 * fq;
#pragma unroll
        for (int ai = 0; ai < 2; ++ai)
#pragma unroll
            for (int m = 0; m < 4; ++m) {
                const int j = pmb * 256 + ai * 128 + wr * 64 + m * 16 + fr;
                const size_t idx = ctxt ? ((size_t)b * CTX + j) * DM : ((size_t)b * SEQ + (j - CTX)) * DM;
                const float* s = (ctxt ? ctxsrc : xsrc) + idx; float* d = (ctxt ? ctxdst : xdst) + idx;
#pragma unroll
                for (int bj = 0; bj < 2; ++bj) {
                    const int col0 = colb + bj * 128;
                    const f32x4 g0 = *(const f32x4*)(gate + col0), g1 = *(const f32x4*)(gate + col0 + 4);
                    const f32x4 x0 = *(const f32x4*)(s + col0), x1 = *(const f32x4*)(s + col0 + 4);
                    *(f32x4*)(d + col0) = x0 + g0 * acc[ai][bj][m][0];
                    *(f32x4*)(d + col0 + 4) = x1 + g1 * acc[ai][bj][m][1];
                }
            }
    }
};

#define MFMA32(a, b, c) __builtin_amdgcn_mfma_f32_32x32x16_bf16((a), (b), (c), 0, 0, 0)
DI s16x4 tr16(const LAS unsigned char* p) { typedef short v4i16_t __attribute__((ext_vector_type(4))); return __builtin_bit_cast(s16x4, __builtin_amdgcn_ds_read_tr16_b64_v4i16((LAS v4i16_t*)p)); }
constexpr int AT_KOFF = 0, AT_KBUFMAX = 13312, AT_VOFF = 2 * AT_KBUFMAX, AT_VBUFMAX = 20480, AT_SOFF = AT_VOFF + 2 * AT_VBUFMAX;
template <int DQK, int DV, int OUTM>
DI void attn_unit(LAS unsigned char* lds, const bf16_t* Qp, int ldq, const bf16_t* Kp, int ldk, const bf16_t* Vp, int ldv,
                  int nA, int rowB0, int nB, int posB0, int qpos0, bool masked, float m0, float l0,
                  bf16_t* Og, int ldo, float* Of, int ldof) {
    constexpr int KSTR = DQK + 8, VSTR = DV + 32, KBUF = 64 * KSTR * 2, VBUF = 64 * VSTR * 2;
    constexpr int KCH = DQK / 8, VCH = DV / 8, NKC = 64 * KCH, NVC = 64 * VCH, KRN = (NKC + 511) / 512, VRN = (NVC + 511) / 512;
    static_assert(KBUF <= AT_KBUFMAX && VBUF <= AT_VBUFMAX, "attention LDS map");
    const int tid = tid_l(), lane = tid & 63, wid = __builtin_amdgcn_readfirstlane(tid >> 6), r32 = lane & 31, hi = lane >> 5;
    bf16x8 qf[DQK / 16];
    { const bf16_t* qrow = Qp + (size_t)(32 * wid + r32) * ldq + 8 * hi;
#pragma unroll
      for (int ds = 0; ds < DQK / 16; ++ds) qf[ds] = *(const bf16x8*)(qrow + 16 * ds); }
    f32x16 o[DV / 32];
#pragma unroll
    for (int db = 0; db < DV / 32; ++db)
#pragma unroll
        for (int r = 0; r < 16; ++r) o[db][r] = 0.f;
    float mrun = m0, lrun = (hi == 0) ? l0 : 0.f;
    LAS float* scw = (LAS float*)(lds + AT_SOFF) + wid * 32;
    const int NT = nA + nB;
    u32x4 kreg[KRN], vreg[VRN];
#define AT_GLOAD(t) do { const int row0_ = (t) < nA ? 64 * (t) : rowB0 + 64 * ((t) - nA); \
        _Pragma("unroll") for (int i_ = 0; i_ < KRN; ++i_) { const int c_ = tid + 512 * i_; if (c_ < NKC) { const int r_ = c_ / KCH, cc_ = c_ % KCH; kreg[i_] = *(const u32x4*)(Kp + (size_t)(row0_ + r_) * ldk + cc_ * 8); } } \
        _Pragma("unroll") for (int i_ = 0; i_ < VRN; ++i_) { const int c_ = tid + 512 * i_; if (c_ < NVC) { const int r_ = c_ / VCH, cc_ = c_ % VCH; vreg[i_] = *(const u32x4*)(Vp + (size_t)(row0_ + r_) * ldv + cc_ * 8); } } } while (0)
#define AT_SWRITE(buf) do { \
        _Pragma("unroll") for (int i_ = 0; i_ < KRN; ++i_) { const int c_ = tid + 512 * i_; if (c_ < NKC) { const int r_ = c_ / KCH, cc_ = c_ % KCH; *(LAS u32x4*)(lds + AT_KOFF + (buf) * KBUF + r_ * (KSTR * 2) + cc_ * 16) = kreg[i_]; } } \
        _Pragma("unroll") for (int i_ = 0; i_ < VRN; ++i_) { const int c_ = tid + 512 * i_; if (c_ < NVC) { const int r_ = c_ / VCH, cc_ = c_ % VCH; *(LAS u32x4*)(lds + AT_VOFF + (buf) * VBUF + r_ * (VSTR * 2) + cc_ * 16) = vreg[i_]; } } } while (0)
    AT_GLOAD(0); AT_SWRITE(0); __syncthreads();
    for (int t = 0; t < NT; ++t) {
        const int cur = t & 1;
        if (t + 1 < NT) AT_GLOAD(t + 1);
        f32x16 s0, s1;
#pragma unroll
        for (int r = 0; r < 16; ++r) { s0[r] = 0.f; s1[r] = 0.f; }
        { const LAS unsigned char* kb = lds + AT_KOFF + cur * KBUF + r32 * (KSTR * 2) + hi * 16;
#pragma unroll
          for (int ds = 0; ds < DQK / 16; ++ds) {
              const bf16x8 k0 = *(const LAS bf16x8*)(kb + ds * 32), k1 = *(const LAS bf16x8*)(kb + 32 * (KSTR * 2) + ds * 32);
              s0 = MFMA32(k0, qf[ds], s0); s1 = MFMA32(k1, qf[ds], s1); } }
        if (masked && t >= nA) {
            const int dk = posB0 + 64 * (t - nA) + 4 * hi - (qpos0 + 32 * wid + r32);
#pragma unroll
            for (int r = 0; r < 16; ++r) { const int d = dk + (r & 3) + 8 * (r >> 2);
                if (d > 128 || d < -128) s0[r] = NEGBIG;
                if (d + 32 > 128 || d + 32 < -128) s1[r] = NEGBIG; }
        }
        float mx = fmaxf(s0[0], s1[0]);
#pragma unroll
        for (int r = 1; r < 16; ++r) mx = fmaxf(mx, fmaxf(s0[r], s1[r]));
        mx = fmaxf(mx, __shfl_xor(mx, 32));
        const float mnew = (mx > mrun + THR) ? mx : mrun;
        if (__any(mnew != mrun)) {
            const float alpha = __builtin_amdgcn_exp2f(mrun - mnew);
            lrun *= alpha; mrun = mnew;
            if (hi == 0) scw[r32] = alpha;
            __builtin_amdgcn_wave_barrier(); asm volatile("" ::: "memory");
#pragma unroll
            for (int g4 = 0; g4 < 4; ++g4) { const f32x4 a4 = *(const LAS f32x4*)(scw + 8 * g4 + 4 * hi);
#pragma unroll
                for (int db = 0; db < DV / 32; ++db) { o[db][4 * g4 + 0] *= a4[0]; o[db][4 * g4 + 1] *= a4[1]; o[db][4 * g4 + 2] *= a4[2]; o[db][4 * g4 + 3] *= a4[3]; } }
            __builtin_amdgcn_wave_barrier(); asm volatile("" ::: "memory");
        }
        float ps = 0.f;
#pragma unroll
        for (int r = 0; r < 16; ++r) { s0[r] = __builtin_amdgcn_exp2f(s0[r] - mrun); s1[r] = __builtin_amdgcn_exp2f(s1[r] - mrun); ps += s0[r] + s1[r]; }
        lrun += ps;
        bf16x8 pa[4];
        { u32x4 w;
          w.x = pk2(s0[0], s0[1]); w.y = pk2(s0[2], s0[3]); w.z = pk2(s0[4], s0[5]); w.w = pk2(s0[6], s0[7]); pa[0] = __builtin_bit_cast(bf16x8, w);
          w.x = pk2(s0[8], s0[9]); w.y = pk2(s0[10], s0[11]); w.z = pk2(s0[12], s0[13]); w.w = pk2(s0[14], s0[15]); pa[1] = __builtin_bit_cast(bf16x8, w);
          w.x = pk2(s1[0], s1[1]); w.y = pk2(s1[2], s1[3]); w.z = pk2(s1[4], s1[5]); w.w = pk2(s1[6], s1[7]); pa[2] = __builtin_bit_cast(bf16x8, w);
          w.x = pk2(s1[8], s1[9]); w.y = pk2(s1[10], s1[11]); w.z = pk2(s1[12], s1[13]); w.w = pk2(s1[14], s1[15]); pa[3] = __builtin_bit_cast(bf16x8, w); }
        { const LAS unsigned char* vb = lds + AT_VOFF + cur * VBUF + (4 * hi + ((lane & 15) >> 2)) * (VSTR * 2) + (16 * ((lane >> 4) & 1) + 4 * (lane & 3)) * 2;
#pragma unroll
          for (int db = 0; db < DV / 32; ++db)
#pragma unroll
              for (int ks = 0; ks < 4; ++ks) {
                  const s16x4 vlo = tr16(vb + (16 * ks) * (VSTR * 2) + db * 64), vhi = tr16(vb + (16 * ks + 8) * (VSTR * 2) + db * 64);
                  const bf16x8 vf = __builtin_shufflevector(vlo, vhi, 0, 1, 2, 3, 4, 5, 6, 7);
                  o[db] = MFMA32(pa[ks], vf, o[db]); } }
        if (t + 1 < NT) AT_SWRITE(cur ^ 1);
        __syncthreads();
    }
#undef AT_GLOAD
#undef AT_SWRITE
    { const float lt = lrun + __shfl_xor(lrun, 32); const float inv = 1.0f / lt;
      if (hi == 0) scw[r32] = inv;
      __builtin_amdgcn_wave_barrier(); asm volatile("" ::: "memory");
#pragma unroll
      for (int g4 = 0; g4 < 4; ++g4) { const f32x4 a4 = *(const LAS f32x4*)(scw + 8 * g4 + 4 * hi);
#pragma unroll
          for (int db = 0; db < DV / 32; ++db) { o[db][4 * g4 + 0] *= a4[0]; o[db][4 * g4 + 1] *= a4[1]; o[db][4 * g4 + 2] *= a4[2]; o[db][4 * g4 + 3] *= a4[3]; } }
      __builtin_amdgcn_wave_barrier(); asm volatile("" ::: "memory"); }
#pragma unroll
    for (int db = 0; db < DV / 32; ++db)
#pragma unroll
        for (int r = 0; r < 16; ++r) {
            const int q = (r & 3) + 8 * (r >> 2) + 4 * hi;
            if (OUTM == 0) { bf16_t* p = Og + (size_t)(32 * wid + q) * ldo + 32 * db + r32; const float z = __uint_as_float((unsigned)(*p) << 16); *p = (bf16_t)(pk2(o[db][r] * silu_f(z), 0.f) & 0xffffu); }
            else { Of[(size_t)(32 * wid + q) * ldof + 32 * db + r32] = o[db][r]; }
        }
}

struct Args { const float* in[21]; float* out; unsigned char* ws; };
typedef const __attribute__((address_space(4))) Args* ArgsP;
DI ArgsP args_ptr() { ArgsP p = (ArgsP)__builtin_amdgcn_kernarg_segment_ptr(); asm volatile("" : "+s"(p)); return p; }
enum { I_X = 0, I_C, I_CTX, I_CCTX, I_WMOD, I_BMOD, I_NORMG, I_WIN, I_QNORM, I_WUQ, I_KVNORM, I_WUKV, I_LQ1, I_LK1, I_LQ2, I_LK2, I_SUBLN, I_SINK, I_WBR, I_WOUT, I_FNORM };

DI int colmap(int kind, int n) {
    if (kind == 1) {
        if (n < C_KR) return n;
        if (n < C_KR + 32) { const int e = n - C_KR; return C_KR + (e >> 1) + 16 * (e & 1); }
        if (n < C_DQ) return -1;
        if ((n >= C_DQ && n < C_DV) || (n >= C_SQ && n < C_SV)) { const int w = n & 63; return (n - w) - 96 + (w >> 1) + 32 * (w & 1); }
        return n - 96;
    }
    if (kind == 2) { const int h = n / 96, e = n % 96; if (e < 64) return n; const int e2 = e - 64; return h * 96 + 64 + (e2 >> 1) + 16 * (e2 & 1); }
    if (kind == 3) { if (n < 512) return (n >> 6) * 192 + (n & 63); const int n2 = n - 512; return (n2 >> 7) * 192 + 64 + (n2 & 127); }
    return n;
}
DI void transpose_item(const float* W, int ldw, int kind, const float* rowscale, bf16_t* WT, int ldd, int koff, LAS float* scr, int item, int nblk, int lane) {
    const int kb = item / nblk, nb = item % nblk, k0 = 64 * kb, n0 = 32 * nb;
    const int oc = colmap(kind, n0 + (lane & 31));
#pragma unroll 8
    for (int i = 0; i < 32; ++i) { const int kk = 2 * i + (lane >> 5); float v = 0.f; if (oc >= 0) v = W[(size_t)(k0 + kk) * ldw + oc]; if (rowscale) v *= rowscale[k0 + kk]; scr[kk * 33 + (lane & 31)] = v; }
    __builtin_amdgcn_wave_barrier(); asm volatile("s_waitcnt lgkmcnt(0)" ::: "memory");
    const int c = lane & 7;
#pragma unroll
    for (int j = 0; j < 4; ++j) { const int n = (lane >> 3) + 8 * j; const LAS float* s = scr + (8 * c) * 33 + n;
        u32x4 o; o.x = pk2(s[0 * 33], s[1 * 33]); o.y = pk2(s[2 * 33], s[3 * 33]); o.z = pk2(s[4 * 33], s[5 * 33]); o.w = pk2(s[6 * 33], s[7 * 33]);
        *(u32x4*)(WT + (size_t)(n0 + n) * ldd + koff + k0 + 8 * c) = o; }
    __builtin_amdgcn_wave_barrier(); asm volatile("s_waitcnt lgkmcnt(0)" ::: "memory");
}
DI void prologue(ArgsP ap, LAS unsigned char* lds) {
    const int tid = tid_l(), lane = tid & 63, wid = __builtin_amdgcn_readfirstlane(tid >> 6);
    unsigned char* ws = ap->ws;
    LAS float* scr = (LAS float*)(lds + wid * 8448);
    const int gw = bid_l() * 8 + wid, NGW = grd_l() * 8;
    constexpr int I_IN = 16 * (NP / 32), I_UQ = 6 * 24, I_UKV = 4 * 48, I_SQ = 16 * 32, PER_L = I_IN + I_UQ + I_UKV + 6 * I_SQ;
    for (int it = gw; it < 2 * PER_L; it += NGW) {
        const int l = it / PER_L; int r = it % PER_L;
        if (r < I_IN) { transpose_item(ap->in[I_WIN] + (size_t)l * 1024 * D_IN, D_IN, 1, nullptr, (bf16_t*)(ws + WS_WIN) + (size_t)l * NP * 1024, 1024, 0, scr, r, NP / 32, lane); continue; } r -= I_IN;
        if (r < I_UQ) { transpose_item(ap->in[I_WUQ] + (size_t)l * 384 * 768, 768, 2, ap->in[I_QNORM] + l * 384, (bf16_t*)(ws + WS_WUQ) + (size_t)l * 768 * 384, 384, 0, scr, r, 24, lane); continue; } r -= I_UQ;
        if (r < I_UKV) { transpose_item(ap->in[I_WUKV] + (size_t)l * 256 * 1536, 1536, 3, ap->in[I_KVNORM] + l * 256, (bf16_t*)(ws + WS_WUKV) + (size_t)l * 1536 * 256, 256, 0, scr, r, 48, lane); continue; } r -= I_UKV;
        if (r < 3 * I_SQ) { const int br = r / I_SQ; transpose_item(ap->in[I_WBR] + ((size_t)l * 3 + br) * 1024 * 1024, 1024, 0, nullptr, (bf16_t*)(ws + WS_WB) + ((size_t)l * 3 + br) * 1024 * 1024, 1024, 0, scr, r % I_SQ, 32, lane); continue; } r -= 3 * I_SQ;
        { const int rep = r / I_SQ; transpose_item(ap->in[I_WOUT] + (size_t)l * 1024 * 1024, 1024, 0, nullptr, (bf16_t*)(ws + WS_WO3) + (size_t)l * 1024 * 3072, 3072, rep * 1024, scr, r % I_SQ, 32, lane); }
    }
    const int gt = bid_l() * 512 + tid, NGT = grd_l() * 512;
    for (int i = gt; i < SEQ * 48; i += NGT) {
        const int pos = i / 48, p = i % 48; const float frow = (float)(pos >> 6), fcol = (float)(pos & 63);
        float ang; float* cd; float* sd;
        if (p < 32) { const int f = p & 15; const float inv = powf(10000.0f, -(float)f / 16.0f); ang = (p < 16 ? frow : fcol) * inv; cd = (float*)(ws + WS_COSH) + pos * 32 + p; sd = (float*)(ws + WS_SINH) + pos * 32 + p; }
        else { const int pp = p - 32, f = pp & 7; const float inv = powf(10000.0f, -(float)f / 8.0f); ang = (pp < 8 ? frow : fcol) * inv; cd = (float*)(ws + WS_COSM) + pos * 16 + pp; sd = (float*)(ws + WS_SINM) + pos * 16 + pp; }
        *cd = __cosf(ang); *sd = __sinf(ang);
    }
    for (int it = gw; it < 2 * 16 * 48; it += NGW) {
        const int l = it / 768, rem = it % 768, kc = rem / 48, nb = rem % 48; const int k = kc * 64 + lane;
        float sv[9];
#pragma unroll
        for (int v = 0; v < 8; ++v) sv[v] = silu_f(ap->in[I_C][v * 1024 + k]);
        sv[8] = silu_f(ap->in[I_CCTX][k]);
        float acc[9];
#pragma unroll
        for (int v = 0; v < 9; ++v) acc[v] = 0.f;
        const float* w = ap->in[I_WMOD] + ((size_t)l * 1024 + kc * 64) * 3072 + nb * 64 + lane;
#pragma unroll 8
        for (int kk = 0; kk < 64; ++kk) { const float wv = w[(size_t)kk * 3072];
#pragma unroll
            for (int v = 0; v < 9; ++v) acc[v] += __uint_as_float(__builtin_amdgcn_readlane(__float_as_uint(sv[v]), kk)) * wv; }
        float* mp = (float*)(ws + WS_MODP) + ((size_t)(l * 16 + kc) * 9) * 3072 + nb * 64 + lane;
#pragma unroll
        for (int v = 0; v < 9; ++v) mp[(size_t)v * 3072] = acc[v];
    }
}
DI void mod_finalize(ArgsP ap) {
    const int tid = tid_l();
    const int gt = bid_l() * 512 + tid, NGT = grd_l() * 512;
    const float* mp = (const float*)(ap->ws + WS_MODP); float* mod = (float*)(ap->ws + WS_MOD);
    for (int i = gt; i < 2 * 9 * 3072; i += NGT) {
        const int l = i / (9 * 3072), rem = i % (9 * 3072), n = rem % 3072;
        float s = ap->in[I_BMOD][l * 3072 + n];
#pragma unroll
        for (int kc = 0; kc < 16; ++kc) s += mp[(size_t)(l * 16 + kc) * 9 * 3072 + rem];
        mod[i] = s;
    }
}
DI void ph_norm_mod(ArgsP ap, int l, int g) {
    const int tid = tid_l(), lane = tid & 63, wid = __builtin_amdgcn_readfirstlane(tid >> 6);
    const int gw = bid_l() * 8 + wid, NGW = grd_l() * 8;
    const float* ng = ap->in[I_NORMG] + l * 1024; const float* mod = (const float*)(ap->ws + WS_MOD) + (size_t)l * 9 * 3072;
    const float* xs = (l == 0) ? ap->in[I_X] : ap->out; const float* cs = (l == 0) ? ap->in[I_CTX] : (const float*)(ap->ws + WS_CTX);
    bf16_t* H = (bf16_t*)(ap->ws + WS_H);
    for (int r = gw; r < R; r += NGW) {
        const int bl = r / RB, j = r % RB, b = g * GB + bl;
        const float* src; const float* md;
        if (j < CTX) { src = cs + ((size_t)b * CTX + j) * DM; md = mod + 8 * 3072; } else { src = xs + ((size_t)b * SEQ + (j - CTX)) * DM; md = mod + (size_t)b * 3072; }
        f32x4 v[4]; float ss = 0.f;
#pragma unroll
        for (int q = 0; q < 4; ++q) { v[q] = *(const f32x4*)(src + 4 * (lane + 64 * q)); ss += (v[q][0] * v[q][0] + v[q][1] * v[q][1]) + (v[q][2] * v[q][2] + v[q][3] * v[q][3]); }
        const float rstd = 1.0f / sqrtf(wave_sum(ss) * (1.0f / DM) + EPS);
#pragma unroll
        for (int q = 0; q < 4; ++q) { const int idx = 4 * (lane + 64 * q);
            const f32x4 gg = *(const f32x4*)(ng + idx), sh = *(const f32x4*)(md + idx), sc = *(const f32x4*)(md + 1024 + idx);
            const f32x4 y = (v[q] * rstd * gg) * (sc + 1.0f) + sh;
            u32x2 w; w.x = pk2(y[0], y[1]); w.y = pk2(y[2], y[3]); *(u32x2*)(H + (size_t)r * DM + idx) = w; }
    }
}
DI void ph_mla_norm(ArgsP ap) {
    const int tid = tid_l(), lane = tid & 63, wid = __builtin_amdgcn_readfirstlane(tid >> 6);
    const int gw = bid_l() * 8 + wid, NGW = grd_l() * 8;
    const bf16_t* P = (const bf16_t*)(ap->ws + WS_P); bf16_t* AQ = (bf16_t*)(ap->ws + WS_AQ); bf16_t* AKV = (bf16_t*)(ap->ws + WS_AKV); bf16_t* KM = (bf16_t*)(ap->ws + WS_KM);
    for (int r = gw; r < R; r += NGW) {
        const bf16_t* row = P + (size_t)r * NP;
        const u32x4 c0 = *(const u32x4*)(row + 8 * lane);
        u32x4 c1 = {0u, 0u, 0u, 0u}; if (lane < 20) c1 = *(const u32x4*)(row + 8 * (64 + lane));
        float f0[8] = {bflo(c0.x), bfhi(c0.x), bflo(c0.y), bfhi(c0.y), bflo(c0.z), bfhi(c0.z), bflo(c0.w), bfhi(c0.w)};
        float f1[8] = {bflo(c1.x), bfhi(c1.x), bflo(c1.y), bfhi(c1.y), bflo(c1.z), bfhi(c1.z), bflo(c1.w), bfhi(c1.w)};
        float s0 = 0.f, s1 = 0.f;
#pragma unroll
        for (int i = 0; i < 8; ++i) { s0 += f0[i] * f0[i]; s1 += f1[i] * f1[i]; }
        const float sq = wave_sum(lane < 48 ? s0 : 0.f);
        const float skv = wave_sum((lane >= 48 ? s0 : 0.f) + (lane < 16 ? s1 : 0.f));
        const float rq = 1.0f / sqrtf(sq * (1.0f / 384.0f) + EPS), rkv = 1.0f / sqrtf(skv * (1.0f / 256.0f) + EPS);
        { const float rr = lane < 48 ? rq : rkv; u32x4 w; w.x = pk2(f0[0] * rr, f0[1] * rr); w.y = pk2(f0[2] * rr, f0[3] * rr); w.z = pk2(f0[4] * rr, f0[5] * rr); w.w = pk2(f0[6] * rr, f0[7] * rr);
          if (lane < 48) *(u32x4*)(AQ + (size_t)r * 384 + 8 * lane) = w; else *(u32x4*)(AKV + (size_t)r * 256 + 8 * (lane - 48)) = w; }
        if (lane < 16) { u32x4 w; w.x = pk2(f1[0] * rkv, f1[1] * rkv); w.y = pk2(f1[2] * rkv, f1[3] * rkv); w.z = pk2(f1[4] * rkv, f1[5] * rkv); w.w = pk2(f1[6] * rkv, f1[7] * rkv);
            *(u32x4*)(AKV + (size_t)r * 256 + 8 * (16 + lane)) = w; }
        else if (lane < 20) {
#pragma unroll
            for (int h = 0; h < 8; ++h) *(u32x4*)(KM + (size_t)r * 768 + h * 96 + 64 + 8 * (lane - 16)) = c1; }
    }
}
DI void ph_diff_post(ArgsP ap, int l) {
    const int tid = tid_l(), lane = tid & 63, wid = __builtin_amdgcn_readfirstlane(tid >> 6);
    const int gw = bid_l() * 8 + wid, NGW = grd_l() * 8;
    const float lam_init = (l == 0) ? 0.2f : (0.8f - 0.6f * 0.7408182206817179f);
    const float d1 = wave_sum(ap->in[I_LQ1][l * 64 + lane] * ap->in[I_LK1][l * 64 + lane]), d2 = wave_sum(ap->in[I_LQ2][l * 64 + lane] * ap->in[I_LK2][l * 64 + lane]);
    const float lam = expf(d1) - expf(d2) + lam_init;
    const float sl0 = ap->in[I_SUBLN][l * 128 + 2 * lane] * (1.0f - lam_init), sl1 = ap->in[I_SUBLN][l * 128 + 2 * lane + 1] * (1.0f - lam_init);
    const float* OD = (const float*)(ap->ws + WS_OD); bf16_t* P = (bf16_t*)(ap->ws + WS_P);
    for (int it = gw; it < R * 8; it += NGW) {
        const int r = it >> 3, h = it & 7;
        if (l != 0 && (r % RB) < CTX) continue;
        const float* o1 = OD + (size_t)r * 2048 + (2 * h) * 128 + 2 * lane; const float* o2 = o1 + 128;
        const float a0 = o1[0] - lam * o2[0], a1 = o1[1] - lam * o2[1];
        const float rstd = 1.0f / sqrtf(wave_sum(a0 * a0 + a1 * a1) * (1.0f / 128.0f) + EPS);
        unsigned* zp = (unsigned*)(P + (size_t)r * NP + C_Z + 1024 + h * 128 + 2 * lane); const unsigned z = *zp;
        *zp = pk2(a0 * rstd * sl0 * silu_f(bflo(z)), a1 * rstd * sl1 * silu_f(bfhi(z)));
    }
}
DI void ph_final_norm(ArgsP ap) {
    const int tid = tid_l(), lane = tid & 63, wid = __builtin_amdgcn_readfirstlane(tid >> 6);
    const int gw = bid_l() * 8 + wid, NGW = grd_l() * 8; const float* fg = ap->in[I_FNORM];
    for (int r = gw; r < NBATCH * SEQ; r += NGW) {
        float* row = ap->out + (size_t)r * DM; f32x4 v[4]; float ss = 0.f;
#pragma unroll
        for (int q = 0; q < 4; ++q) { v[q] = *(const f32x4*)(row + 4 * (lane + 64 * q)); ss += (v[q][0] * v[q][0] + v[q][1] * v[q][1]) + (v[q][2] * v[q][2] + v[q][3] * v[q][3]); }
        const float rstd = 1.0f / sqrtf(wave_sum(ss) * (1.0f / DM) + EPS);
#pragma unroll
        for (int q = 0; q < 4; ++q) { const int idx = 4 * (lane + 64 * q); *(f32x4*)(row + idx) = v[q] * rstd * *(const f32x4*)(fg + idx); }
    }
}
DI void ph_attention(ArgsP ap, int l, LAS unsigned char* lds) {
    const int G = grd_l(), bx = bid_l(), vcu = (G % 8 == 0) ? (bx % 8) * (G / 8) + bx / 8 : bx;
    bf16_t* P = (bf16_t*)(ap->ws + WS_P); const bf16_t* QM = (const bf16_t*)(ap->ws + WS_QM); const bf16_t* KM = (const bf16_t*)(ap->ws + WS_KM); const bf16_t* VM = (const bf16_t*)(ap->ws + WS_VM);
    float* OD = (float*)(ap->ws + WS_OD); const float* sink = ap->in[I_SINK] + l * 16;
    for (int u = vcu; u < GB * 8 * 32; u += G) { const int bh = u >> 5, qb = u & 31, bl = bh >> 3, h = bh & 7; const size_t rb = (size_t)bl * RB, q0 = rb + CTX + 256 * qb;
        attn_unit<96, 128, 0>(lds, QM + q0 * 768 + h * 96, 768, KM + rb * 768 + h * 96, 768, VM + rb * 1024 + h * 128, 1024, RB / 64, 0, 0, 0, 0, false, NEGBIG, 0.f, P + q0 * NP + C_Z + h * 128, NP, nullptr, 0); }
    for (int u = vcu; u < GB * 16 * 32; u += G) { const int bh = u >> 5, qb = u & 31, bl = bh >> 4, hm = bh & 15; const size_t rb = (size_t)bl * RB, q0 = rb + CTX + 256 * qb;
        attn_unit<64, 128, 1>(lds, P + q0 * NP + C_DQ + hm * 64, NP, P + rb * NP + C_DK + hm * 64, NP, P + rb * NP + C_DV + (hm >> 1) * 128, NP, RB / 64, 0, 0, 0, 0, false, NEGBIG, 0.f, nullptr, 0, OD + q0 * 2048 + hm * 128, 2048); }
    for (int u = vcu; u < GB * 16 * 32; u += G) { const int bh = u >> 5, qb = u & 31, bl = bh >> 4, h = bh & 15; const size_t rb = (size_t)bl * RB, q0 = rb + CTX + 256 * qb;
        const int lo = (256 * qb - 128 < 0) ? 0 : 256 * qb - 128, hi = (256 * qb + 384 > SEQ) ? SEQ : 256 * qb + 384;
        attn_unit<64, 64, 0>(lds, P + q0 * NP + C_SQ + h * 64, NP, P + rb * NP + C_SK + (h >> 2) * 64, NP, P + rb * NP + C_SV + (h >> 2) * 64, NP, CTX / 64, CTX + lo, (hi - lo) / 64, lo, 256 * qb, true, sink[h] * LOG2E, 1.0f,
                              P + q0 * NP + C_Z + 2048 + h * 64, NP, nullptr, 0); }
    if (l == 0) {
        for (int u = vcu; u < GB * 40; u += G) { const int bl = u / 40, k = u % 40; const size_t rb = (size_t)bl * RB;
            if (k < 8) { const int h = k;
                attn_unit<96, 128, 0>(lds, QM + rb * 768 + h * 96, 768, KM + rb * 768 + h * 96, 768, VM + rb * 1024 + h * 128, 1024, CTX / 64, 0, 0, 0, 0, false, NEGBIG, 0.f, P + rb * NP + C_Z + h * 128, NP, nullptr, 0); }
            else if (k < 24) { const int hm = k - 8;
                attn_unit<64, 128, 1>(lds, P + rb * NP + C_DQ + hm * 64, NP, P + rb * NP + C_DK + hm * 64, NP, P + rb * NP + C_DV + (hm >> 1) * 128, NP, CTX / 64, 0, 0, 0, 0, false, NEGBIG, 0.f, nullptr, 0, OD + rb * 2048 + hm * 128, 2048); }
            else { const int h = k - 24;
                attn_unit<64, 64, 0>(lds, P + rb * NP + C_SQ + h * 64, NP, P + rb * NP + C_SK + (h >> 2) * 64, NP, P + rb * NP + C_SV + (h >> 2) * 64, NP, CTX / 64, 0, 0, 0, 0, false, sink[h] * LOG2E, 1.0f, P + rb * NP + C_Z + 2048 + h * 64, NP, nullptr, 0); }
        }
    }
}

__global__ void __launch_bounds__(512, 2) hybrid_fwd(Args a_unused) {
    extern __shared__ __attribute__((aligned(16))) unsigned char lds_raw[];
    LAS unsigned char* lds = (LAS unsigned char*)lds_raw;
    cg::grid_group grid = cg::this_grid();
#ifndef NO_PRO
    prologue(args_ptr(), lds);
#endif
    grid.sync();
    mod_finalize(args_ptr());
    grid.sync();
    for (int l = 0; l < 2; ++l) {
        for (int g = 0; g < NGRP; ++g) {
            ph_norm_mod(args_ptr(), l, g);
            grid.sync();
#ifndef NO_GEMM
            {
                unsigned char* ws = args_ptr()->ws; const int G = grd_l(), bx = bid_l();
                pg8::Gemm gm{1024, 1024, 1024}; pg8::Order S; S.init(R, NP, G, bx, ws + WS_H, 1024, (bf16_t*)(ws + WS_WIN) + (size_t)l * NP * 1024, 1024, 1 << 20, 0);
                EpiIn E{ws};
                pg8::gemm_phase<EpiIn, pg8::Order, true, true>(lds, gm, S, E);
            }
#endif
            grid.sync();
            ph_mla_norm(args_ptr());
            grid.sync();
#ifndef NO_GEMM2
            {
                unsigned char* ws = args_ptr()->ws; const int G = grd_l(), bx = bid_l();
                pg8::Gemm gq{384, 384, 384}; pg8::Order Sq; Sq.init(R, 768, G, bx, ws + WS_AQ, 384, (bf16_t*)(ws + WS_WUQ) + (size_t)l * 768 * 384, 384, 1 << 20, 0);
                EpiQ Eq{ws};
#ifndef NO_GQ
                pg8::gemm_phase<EpiQ, pg8::Order, true, true>(lds, gq, Sq, Eq);
#endif
            }
            {
                unsigned char* ws = args_ptr()->ws; const int G = grd_l(), bx = bid_l();
                pg8::Gemm gk{256, 256, 256}; pg8::Order Sk; Sk.init(R, 1536, G, bx, ws + WS_AKV, 256, (bf16_t*)(ws + WS_WUKV) + (size_t)l * 1536 * 256, 256, 1 << 20, 0);
                EpiKV Ek{ws};
#ifndef NO_GK
                pg8::gemm_phase<EpiKV, pg8::Order, true, true>(lds, gk, Sk, Ek);
#endif
            }
#endif
            grid.sync();
#ifndef NO_ATT
            ph_attention(args_ptr(), l, lds);
#endif
            grid.sync();
            ph_diff_post(args_ptr(), l);
            grid.sync();
#ifndef NO_BR
            {
                unsigned char* ws = args_ptr()->ws; const int G = grd_l(), bx = bid_l();
                pg8::Gemm gb{1024, NP, 1024}; pg8::Order S; S.init(R, 3072, G, bx, (bf16_t*)(ws + WS_P) + C_Z, NP, (bf16_t*)(ws + WS_WB) + (size_t)l * 3 * 1024 * 1024, 1024, 4, 1024 * 2);
                EpiBr E{ws};
                pg8::gemm_phase<EpiBr, pg8::Order, true, true>(lds, gb, S, E);
            }
#endif
            grid.sync();
#ifndef NO_OUT
            {
                ArgsP ap = args_ptr(); unsigned char* ws = ap->ws; const int G = grd_l(), bx = bid_l();
                pg8::Gemm go{3072, NP, 3072}; pg8::Order S; S.init(R, 1024, G, bx, (bf16_t*)(ws + WS_P) + C_GM, NP, (bf16_t*)(ws + WS_WO3) + (size_t)l * 1024 * 3072, 3072, 1 << 20, 0);
                EpiOut E{l, g, (l == 0) ? ap->in[I_X] : (const float*)ap->out, ap->out, ap->in[I_CTX], ws};
                pg8::gemm_phase<EpiOut, pg8::Order, true, true>(lds, go, S, E);
            }
#endif
        }
        grid.sync();
    }
    ph_final_norm(args_ptr());
}

extern "C" void kernel_launch(void* const* d_in, const int* in_sizes, int n_in, void* d_out, int out_size, void* d_ws, size_t ws_size, hipStream_t stream) {
    static int grid = 0;
    if (grid == 0) {
        if (n_in != 21 || ws_size < WS_END) { fprintf(stderr, "kernel_launch: expected 21 inputs and >= %zu bytes of workspace (got %d, %zu)\n", (size_t)WS_END, n_in, ws_size); grid = -1; return; }
        int dev = 0, cus = 0, per_cu = 0;
        (void)hipGetDevice(&dev); (void)hipDeviceGetAttribute(&cus, hipDeviceAttributeMultiprocessorCount, dev);
        if (hipFuncSetAttribute((const void*)hybrid_fwd, hipFuncAttributeMaxDynamicSharedMemorySize, LDS_BYTES) != hipSuccess) fprintf(stderr, "kernel_launch: hipFuncSetAttribute failed\n");
        if (hipOccupancyMaxActiveBlocksPerMultiprocessor(&per_cu, (const void*)hybrid_fwd, 512, LDS_BYTES) != hipSuccess || per_cu < 1) { per_cu = 1; (void)hipGetLastError(); }
        if (cus <= 0) cus = 256;
        grid = cus * per_cu;
    }
    if (grid < 0) return;
    Args a{};
    for (int i = 0; i < 21; ++i) a.in[i] = (const float*)d_in[i];
    a.out = (float*)d_out; a.ws = (unsigned char*)d_ws;
    void* args[] = {&a};
    hipError_t e = hipLaunchCooperativeKernel((const void*)hybrid_fwd, dim3(grid), dim3(512), args, LDS_BYTES, stream);
    if (e != hipSuccess) fprintf(stderr, "kernel_launch: cooperative launch failed: %s (grid %d)\n", hipGetErrorString(e), grid);
}
```

```cpp
#include <hip/hip_runtime.h>
#include <hip/hip_cooperative_groups.h>
#include <cstdio>
#include <cstdint>
namespace cg = cooperative_groups;

#define DI __device__ __forceinline__
#define LAS __attribute__((address_space(3)))
__device__ __forceinline__ int tid_l() { int t = threadIdx.x; asm volatile("" : "+v"(t)); return t; }
__device__ __forceinline__ int bid_l() { int b = blockIdx.x; asm volatile("" : "+s"(b)); return b; }
__device__ __forceinline__ int lnd(int x) { asm volatile("" : "+s"(x)); return x; }
__device__ __forceinline__ int grd_l() { int g = gridDim.x; asm volatile("" : "+s"(g)); return g; }
typedef unsigned short bf16_t;
typedef short bf16x8 __attribute__((ext_vector_type(8)));
typedef short s16x4 __attribute__((ext_vector_type(4)));
typedef float f32x4 __attribute__((ext_vector_type(4)));
typedef float f32x16 __attribute__((ext_vector_type(16)));
typedef unsigned u32x4 __attribute__((ext_vector_type(4)));
typedef unsigned u32x2 __attribute__((ext_vector_type(2)));

constexpr int DM = 1024, NBATCH = 8, SEQ = 8192, CTX = 256, RB = CTX + SEQ;
constexpr int GB = 2, NGRP = NBATCH / GB, R = GB * RB;
constexpr int NP = 11520;
constexpr int C_QC = 0, C_KVC = 384, C_KR = 640, C_DQ = 768, C_DK = 1792, C_DV = 2816, C_SQ = 3840, C_SK = 4864, C_SV = 5120, C_Z = 5376, C_GM = 8448;
constexpr int D_IN = 11424;
constexpr float EPS = 1e-6f, LOG2E = 1.4426950408889634f;
constexpr float QS64 = 0.125f * LOG2E, QS96 = 0.10206207261596575f * LOG2E;
constexpr float NEGBIG = -1e30f, THR = 8.0f;

constexpr size_t al256(size_t x) { return (x + 255) & ~(size_t)255; }
constexpr size_t WS_WIN = 1u << 20;
constexpr size_t WS_WUQ = al256(WS_WIN + (size_t)2 * NP * 1024 * 2);
constexpr size_t WS_WUKV = al256(WS_WUQ + (size_t)2 * 768 * 384 * 2);
constexpr size_t WS_WB = al256(WS_WUKV + (size_t)2 * 1536 * 256 * 2);
constexpr size_t WS_WO3 = al256(WS_WB + (size_t)2 * 3 * 1024 * 1024 * 2);
constexpr size_t WS_COSH = al256(WS_WO3 + (size_t)2 * 1024 * 3072 * 2);
constexpr size_t WS_SINH = al256(WS_COSH + (size_t)SEQ * 32 * 4);
constexpr size_t WS_COSM = al256(WS_SINH + (size_t)SEQ * 32 * 4);
constexpr size_t WS_SINM = al256(WS_COSM + (size_t)SEQ * 16 * 4);
constexpr size_t WS_MODP = al256(WS_SINM + (size_t)SEQ * 16 * 4);
constexpr size_t WS_MOD = al256(WS_MODP + (size_t)16 * 2 * 9 * 3072 * 4);
constexpr size_t WS_CTX = al256(WS_MOD + (size_t)2 * 9 * 3072 * 4);
constexpr size_t WS_H = al256(WS_CTX + (size_t)NBATCH * CTX * DM * 4);
constexpr size_t WS_P = al256(WS_H + (size_t)R * DM * 2);
constexpr size_t WS_AQ = al256(WS_P + (size_t)R * NP * 2);
constexpr size_t WS_AKV = al256(WS_AQ + (size_t)R * 384 * 2);
constexpr size_t WS_QM = al256(WS_AKV + (size_t)R * 256 * 2);
constexpr size_t WS_KM = al256(WS_QM + (size_t)R * 768 * 2);
constexpr size_t WS_VM = al256(WS_KM + (size_t)R * 768 * 2);
constexpr size_t WS_OD = al256(WS_VM + (size_t)R * 1024 * 2);
constexpr size_t WS_END = al256(WS_OD + (size_t)R * 2048 * 4);
static_assert(WS_END <= ((size_t)1 << 30), "workspace map exceeds 1 GiB");

constexpr int LDS_BYTES = 147456;

DI unsigned pk2(float lo, float hi) { typedef float f2_t __attribute__((ext_vector_type(2))); typedef __bf16 b2_t __attribute__((ext_vector_type(2)));
    f2_t v = {lo, hi}; b2_t b = __builtin_convertvector(v, b2_t); return __builtin_bit_cast(unsigned, b); }
DI u32x4 pack8(f32x4 a, f32x4 b) { u32x4 w; w.x = pk2(a[0], a[1]); w.y = pk2(a[2], a[3]); w.z = pk2(b[0], b[1]); w.w = pk2(b[2], b[3]); return w; }
DI float bflo(unsigned w) { return __uint_as_float(w << 16); }
DI float bfhi(unsigned w) { return __uint_as_float(w & 0xffff0000u); }
DI float wave_sum(float v) {
#pragma unroll
    for (int o = 1; o < 64; o <<= 1) v += __shfl_xor(v, o);
    return v; }
DI float silu_f(float z) { return z / (1.0f + __expf(-z)); }
DI float sigm_f(float z) { return 1.0f / (1.0f + __expf(-z)); }
DI void rope8(f32x4& v0, f32x4& v1, const f32x4 cs, const f32x4 sn) {
    float a, b;
    a = v0[0]; b = v0[1]; v0[0] = a * cs[0] - b * sn[0]; v0[1] = b * cs[0] + a * sn[0];
    a = v0[2]; b = v0[3]; v0[2] = a * cs[1] - b * sn[1]; v0[3] = b * cs[1] + a * sn[1];
    a = v1[0]; b = v1[1]; v1[0] = a * cs[2] - b * sn[2]; v1[1] = b * cs[2] + a * sn[2];
    a = v1[2]; b = v1[3]; v1[2] = a * cs[3] - b * sn[3]; v1[3] = b * cs[3] + a * sn[3];
}
namespace pg8 {
#define PG8_LAS __attribute__((address_space(3)))
typedef unsigned short bf16_t;
typedef short bf16x8 __attribute__((ext_vector_type(8)));
typedef float f32x4 __attribute__((ext_vector_type(4)));
typedef unsigned u32x4 __attribute__((ext_vector_type(4)));
constexpr int BM = 256, BK = 64, HALF = 128, HTB = HALF * BK * 2  , STAGE_BYTES = 8 * HTB, NXCD = 8, WGM = 8;

__host__ __device__ __forceinline__ int lds_byte(int r, int c) { const int st = (r >> 4) * 2 + (c >> 5), rr = r & 15, cc = c & 31, ob = rr * 64 + cc * 2; return st * 1024 + (ob ^ (((ob >> 9) & 1) << 5)); }
__host__ __device__ __forceinline__ void stage_rc(int b, int& R, int& C) { const int st = b / 1024, sb = b % 1024, swz = sb ^ (((sb >> 9) & 1) << 5); R = (st >> 1) * 16 + swz / 64; C = (st & 1) * 32 + (swz % 64) / 2; }
__host__ __device__ __forceinline__ int perm32(int rho) { const int n = rho >> 4, i = rho & 15; return 8 * (i >> 2) + 4 * n + (i & 3); }

struct Unit { int pm, pn; };
struct Gemm { int K, lda, ldb; };
struct Order {
    int nM, nN, nwg, G, c; const char* A; const char* B; unsigned tA, tB; int pnblk; unsigned ablk;
    __device__ __forceinline__ void init(int M, int N, int G_, int c_, const void* A_, int lda, const void* B_, int ldb, int pnblk_, unsigned ablk_) {
        nM = M / BM; nN = N / BM; nwg = nM * nN; G = G_; c = c_; A = (const char*)A_; B = (const char*)B_; tA = (unsigned)(BM * lda * 2); tB = (unsigned)(BM * ldb * 2); pnblk = pnblk_; ablk = ablk_; }
    __device__ __forceinline__ bool next(int i, Unit& u) const {
        const long L = (long)i * G + c; if (L >= nwg) return false;
        int wgid = (int)L; { const int q = nwg / NXCD, r = nwg % NXCD, xcd = wgid % NXCD, off = wgid / NXCD; wgid = (xcd < r ? xcd * (q + 1) : r * (q + 1) + (xcd - r) * q) + off; }
        const int nig = WGM * nN, gid = wgid / nig, fm = gid * WGM, gsz = (nM - fm) < WGM ? (nM - fm) : WGM;
        u.pm = fm + ((wgid % nig) % gsz); u.pn = (wgid % nig) / gsz; return true;
    }
    __device__ __forceinline__ const char* a_base(const Unit& u) const { return A + (size_t)u.pm * tA + (size_t)(u.pn / pnblk) * ablk; }
    __device__ __forceinline__ const char* b_base(const Unit& u) const { return B + (size_t)u.pn * tB; }
};

template <class Epi, class Sched, bool ALIGN_EPI = false, bool SP2 = false>
__device__ __forceinline__ void gemm_phase(PG8_LAS unsigned char* lds, const Gemm g, const Sched& S, const Epi& E) {
    const int tid = tid_l(), wid = __builtin_amdgcn_readfirstlane(tid >> 6), lane = tid & 63, wr = wid >> 2, wc = wid & 3, fr = lane & 15, fq = lane >> 4;
    const int K = g.K, nt = K / BK;
    unsigned voffA[2], voffB[2];
#pragma unroll
    for (int i = 0; i < 2; ++i) { int R, C; stage_rc(tid * 16 + i * 8192, R, C); const int Rb = Epi::PERM ? ((R & ~31) + perm32(R & 31)) : R;
        voffA[i] = (unsigned)(R * g.lda + C) * 2u; voffB[i] = (unsigned)(Rb * g.ldb + C) * 2u; }
    const size_t kstep = (size_t)(BK * 2);
    const size_t hstepA = (size_t)HALF * g.lda * 2, hstepB = (size_t)HALF * g.ldb * 2;
    const unsigned ldsw = (unsigned)wid * 1024u;
    const int aoff = lds_byte(wr * 64 + fr, fq * 8), boff = lds_byte(wc * 32 + fr, fq * 8);
#define PG8_SA(b, h) (((b) * 2 + (h)) * HTB)
#define PG8_SB(b, h) ((4 + (b) * 2 + (h)) * HTB)
#define PG8_STAGE(bufoff, gbase, voff) do { _Pragma("unroll") for (int _i = 0; _i < 2; ++_i) \
        __builtin_amdgcn_global_load_lds((const unsigned*)((const char*)(gbase) + (voff)[_i]), (PG8_LAS unsigned*)(lds + (bufoff) + ldsw + _i * 8192), 16, 0, 0); } while (0)
#define PG8_LDA(dst, b, h) do { _Pragma("unroll") for (int m = 0; m < 4; ++m) _Pragma("unroll") for (int k = 0; k < 2; ++k) dst[m][k] = *(const PG8_LAS bf16x8*)(lds + PG8_SA(b, h) + aoff + m * 2048 + k * 1024); } while (0)
#define PG8_LDB(dst, b, h) do { _Pragma("unroll") for (int n = 0; n < 2; ++n) _Pragma("unroll") for (int k = 0; k < 2; ++k) dst[n][k] = *(const PG8_LAS bf16x8*)(lds + PG8_SB(b, h) + boff + n * 2048 + k * 1024); } while (0)
#define PG8_MMA(ai, bj, At, Bt) do { __builtin_amdgcn_s_setprio(1); _Pragma("unroll") for (int m = 0; m < 4; ++m) _Pragma("unroll") for (int n = 0; n < 2; ++n) _Pragma("unroll") for (int k = 0; k < 2; ++k) \
        acc[ai][bj][m][n] = __builtin_amdgcn_mfma_f32_16x16x32_bf16(Bt[n][k], At[m][k], acc[ai][bj][m][n], 0, 0, 0); __builtin_amdgcn_s_setprio(0); } while (0)
#define PG8_WAIT_V(n) asm volatile("s_waitcnt vmcnt(" #n ")" ::: "memory")
#define PG8_WAIT_L(n) asm volatile("s_waitcnt lgkmcnt(" #n ")" ::: "memory")
#define PG8_BAR __builtin_amdgcn_s_barrier()
#define PG8_SCHED __builtin_amdgcn_sched_barrier(0)
    Unit cur, nxt; int ui = 0;
    if (!S.next(0, cur)) return;
    f32x4 acc[2][2][4][2];
#pragma unroll
    for (int a = 0; a < 2; ++a)
#pragma unroll
        for (int b = 0; b < 2; ++b)
#pragma unroll
            for (int m = 0; m < 4; ++m)
#pragma unroll
                for (int n = 0; n < 2; ++n) acc[a][b][m][n] = (f32x4){0.f, 0.f, 0.f, 0.f};
    bf16x8 At[4][2], B0[2][2], B1[2][2];
    const char* cA = S.a_base(cur); const char* cB = S.b_base(cur);

    if constexpr (SP2) {
        PG8_STAGE(PG8_SB(0, 0), cB, voffB); PG8_STAGE(PG8_SB(0, 1), cB + hstepB, voffB); PG8_STAGE(PG8_SA(0, 0), cA, voffA); PG8_STAGE(PG8_SA(0, 1), cA + hstepA, voffA);
        if (wr == 1) PG8_BAR;
        PG8_WAIT_V(2); PG8_BAR;
        PG8_STAGE(PG8_SB(1, 0), cB + kstep, voffB); PG8_STAGE(PG8_SA(1, 0), cA + kstep, voffA); PG8_STAGE(PG8_SB(1, 1), cB + hstepB + kstep, voffB);
        PG8_WAIT_V(6); PG8_BAR;
    } else {
        PG8_STAGE(PG8_SB(0, 0), cB, voffB); PG8_STAGE(PG8_SA(0, 0), cA, voffA); PG8_STAGE(PG8_SB(0, 1), cB + hstepB, voffB); PG8_STAGE(PG8_SA(0, 1), cA + hstepA, voffA);
        if (wr == 1) PG8_BAR;
        PG8_WAIT_V(4); PG8_BAR;
        PG8_STAGE(PG8_SB(1, 0), cB + kstep, voffB); PG8_STAGE(PG8_SA(1, 0), cA + kstep, voffA); PG8_STAGE(PG8_SB(1, 1), cB + hstepB + kstep, voffB);
        PG8_WAIT_V(6); PG8_BAR;
    }
    for (;;) {
        const bool has_next = S.next(ui + 1, nxt);
        const char* nA = has_next ? S.a_base(nxt) : cA; const char* nB = has_next ? S.b_base(nxt) : cB;
#pragma nounroll
        for (int t = 0; t < nt; t += 2) {
            const bool last = (t == nt - 2);
            const char* a1 = cA + (size_t)(t + 1) * kstep;
            const char* a2 = last ? nA : cA + (size_t)(t + 2) * kstep; const char* b2 = last ? nB : cB + (size_t)(t + 2) * kstep;
            const char* a3 = a2 + kstep; const char* b3 = b2 + kstep;

            if constexpr (SP2) {
            PG8_LDB(B0, 0, 0); PG8_LDB(B1, 0, 1); PG8_SCHED; PG8_LDA(At, 0, 0); PG8_STAGE(PG8_SA(1, 1), a1 + hstepA, voffA);
            PG8_WAIT_V(8); PG8_WAIT_L(0); PG8_BAR; PG8_MMA(0, 0, At, B0); PG8_MMA(0, 1, At, B1); PG8_BAR; PG8_SCHED;
            PG8_LDA(At, 0, 1); PG8_STAGE(PG8_SB(0, 0), b2, voffB); PG8_STAGE(PG8_SB(0, 1), b2 + hstepB, voffB); PG8_STAGE(PG8_SA(0, 0), a2, voffA);
            PG8_WAIT_V(8); PG8_WAIT_L(0); PG8_BAR; PG8_MMA(1, 0, At, B0); PG8_MMA(1, 1, At, B1); PG8_BAR; PG8_SCHED;
            PG8_LDB(B0, 1, 0); PG8_LDB(B1, 1, 1); PG8_SCHED; PG8_LDA(At, 1, 0); PG8_STAGE(PG8_SA(0, 1), a2 + hstepA, voffA);
            PG8_WAIT_V(8); PG8_WAIT_L(0); PG8_BAR; PG8_MMA(0, 0, At, B0); PG8_MMA(0, 1, At, B1); PG8_BAR; PG8_SCHED;
            PG8_LDA(At, 1, 1); PG8_STAGE(PG8_SB(1, 0), b3, voffB); PG8_STAGE(PG8_SB(1, 1), b3 + hstepB, voffB); PG8_STAGE(PG8_SA(1, 0), a3, voffA);
            PG8_WAIT_V(8); PG8_WAIT_L(0); PG8_BAR; PG8_MMA(1, 0, At, B0); PG8_MMA(1, 1, At, B1); PG8_BAR; PG8_SCHED;
            } else {
            PG8_LDB(B0, 0, 0); PG8_SCHED; PG8_LDA(At, 0, 0); PG8_STAGE(PG8_SA(1, 1), a1 + hstepA, voffA);
            PG8_WAIT_L(8); PG8_BAR; PG8_WAIT_L(0); PG8_MMA(0, 0, At, B0); PG8_BAR; PG8_SCHED;
            PG8_LDB(B1, 0, 1); PG8_STAGE(PG8_SB(0, 0), b2, voffB);
            PG8_BAR; PG8_WAIT_L(0); PG8_MMA(0, 1, At, B1); PG8_BAR;
            PG8_LDA(At, 0, 1); PG8_STAGE(PG8_SA(0, 0), a2, voffA);
            PG8_BAR; PG8_WAIT_L(0); PG8_MMA(1, 0, At, B0); PG8_BAR; PG8_SCHED;
            PG8_STAGE(PG8_SB(0, 1), b2 + hstepB, voffB);
            PG8_WAIT_V(6); PG8_BAR; PG8_MMA(1, 1, At, B1); PG8_BAR;
            PG8_LDB(B0, 1, 0); PG8_SCHED; PG8_LDA(At, 1, 0); PG8_STAGE(PG8_SA(0, 1), a2 + hstepA, voffA);
            PG8_WAIT_L(8); PG8_BAR; PG8_WAIT_L(0); PG8_MMA(0, 0, At, B0); PG8_BAR; PG8_SCHED;
            PG8_LDB(B1, 1, 1); PG8_STAGE(PG8_SB(1, 0), b3, voffB);
            PG8_BAR; PG8_WAIT_L(0); PG8_MMA(0, 1, At, B1); PG8_BAR;
            PG8_LDA(At, 1, 1); PG8_STAGE(PG8_SA(1, 0), a3, voffA);
            PG8_BAR; PG8_WAIT_L(0); PG8_MMA(1, 0, At, B0); PG8_BAR; PG8_SCHED;
            PG8_STAGE(PG8_SB(1, 1), b3 + hstepB, voffB);
            PG8_WAIT_V(6); PG8_BAR; PG8_MMA(1, 1, At, B1); PG8_BAR;
            }
        }
        if constexpr (ALIGN_EPI) { if (wr == 0) PG8_BAR; }
        if constexpr (!Epi::AFTER_DRAIN) { E(acc, cur, wr, wc, fr, fq); }
        if (!has_next) break;
#pragma unroll
        for (int a = 0; a < 2; ++a)
#pragma unroll
            for (int b = 0; b < 2; ++b)
#pragma unroll
                for (int m = 0; m < 4; ++m)
#pragma unroll
                    for (int n = 0; n < 2; ++n) acc[a][b][m][n] = (f32x4){0.f, 0.f, 0.f, 0.f};
        cur = nxt; cA = nA; cB = nB; ++ui;
        if constexpr (ALIGN_EPI) { if (wr == 1) PG8_BAR; }
    }
    PG8_WAIT_V(0);
    if constexpr (!ALIGN_EPI) { if (wr == 0) PG8_BAR; }
    PG8_BAR;
    if constexpr (Epi::AFTER_DRAIN) { E.fused(acc, cur, wr, wc, fr, fq, lds, wid, lane); }
#undef PG8_SA
#undef PG8_SB
#undef PG8_STAGE
#undef PG8_LDA
#undef PG8_LDB
#undef PG8_MMA
#undef PG8_WAIT_V
#undef PG8_WAIT_L
#undef PG8_BAR
#undef PG8_SCHED
}
}
struct EpiIn {
    static constexpr bool PERM = true, AFTER_DRAIN = false;
    unsigned char* ws;
    DI void operator()(const f32x4 (&acc)[2][2][4][2], const pg8::Unit& u, int wr, int wc, int fr, int fq) const {
        bf16_t* P = (bf16_t*)(ws + WS_P); const float* cosH = (const float*)(ws + WS_COSH); const float* sinH = (const float*)(ws + WS_SINH); const float* cosM = (const float*)(ws + WS_COSM); const float* sinM = (const float*)(ws + WS_SINM);
        const int pn = u.pn; const bool ctxt = (u.pm % 33) == 0;
        int mode = 0; float sc = 1.f;
        if ((pn >= 3 && pn <= 10) || (pn >= 15 && pn <= 19)) mode = 1;
        if (pn == 2) mode = 2;
        if ((pn >= 3 && pn <= 6) || (pn >= 15 && pn <= 18)) sc = QS64;
        if (ctxt) mode = 0;
        const int rowt = u.pm * 256 + wr * 64 + fr, colb = pn * 256 + wc * 32 + 8 * fq;
#pragma unroll
        for (int ai = 0; ai < 2; ++ai)
#pragma unroll
            for (int m = 0; m < 4; ++m) {
                const int row = rowt + ai * 128 + m * 16; const int pos = (row % RB) - CTX;
                bf16_t* rowp = P + (size_t)row * NP;
#pragma unroll
                for (int bj = 0; bj < 2; ++bj) {
                    const int col0 = colb + bj * 128;
                    f32x4 v0 = acc[ai][bj][m][0], v1 = acc[ai][bj][m][1];
                    if (mode == 1) { const int p0 = (col0 & 63) >> 1; const f32x4 cs = *(const f32x4*)(cosH + (size_t)pos * 32 + p0), sn = *(const f32x4*)(sinH + (size_t)pos * 32 + p0); rope8(v0, v1, cs, sn); }
                    else if (mode == 2 && col0 >= C_KR && col0 < C_KR + 32) { const int p0 = (col0 - C_KR) >> 1; const f32x4 cs = *(const f32x4*)(cosM + (size_t)pos * 16 + p0), sn = *(const f32x4*)(sinM + (size_t)pos * 16 + p0); rope8(v0, v1, cs, sn); }
                    v0 = v0 * sc; v1 = v1 * sc;
                    *(u32x4*)(rowp + col0) = pack8(v0, v1);
                }
            }
    }
};
struct EpiQ {
    static constexpr bool PERM = true, AFTER_DRAIN = false;
    unsigned char* ws;
    DI void operator()(const f32x4 (&acc)[2][2][4][2], const pg8::Unit& u, int wr, int wc, int fr, int fq) const {
        bf16_t* QM = (bf16_t*)(ws + WS_QM); const float* cosM = (const float*)(ws + WS_COSM); const float* sinM = (const float*)(ws + WS_SINM);
        const bool ctxt = (u.pm % 33) == 0;
        const int rowt = u.pm * 256 + wr * 64 + fr, colb = u.pn * 256 + wc * 32 + 8 * fq;
#pragma unroll
        for (int ai = 0; ai < 2; ++ai)
#pragma unroll
            for (int m = 0; m < 4; ++m) {
                const int row = rowt + ai * 128 + m * 16; const int pos = (row % RB) - CTX;
#pragma unroll
                for (int bj = 0; bj < 2; ++bj) {
                    const int col0 = colb + bj * 128, within = col0 % 96;
                    f32x4 v0 = acc[ai][bj][m][0], v1 = acc[ai][bj][m][1];
                    if (!ctxt && within >= 64) { const int p0 = (within - 64) >> 1; const f32x4 cs = *(const f32x4*)(cosM + (size_t)pos * 16 + p0), sn = *(const f32x4*)(sinM + (size_t)pos * 16 + p0); rope8(v0, v1, cs, sn); }
                    v0 = v0 * QS96; v1 = v1 * QS96;
                    *(u32x4*)(QM + (size_t)row * 768 + col0) = pack8(v0, v1);
                }
                asm volatile("" ::: "memory");
            }
    }
};
struct EpiKV {
    static constexpr bool PERM = true, AFTER_DRAIN = false;
    unsigned char* ws;
    DI void operator()(const f32x4 (&acc)[2][2][4][2], const pg8::Unit& u, int wr, int wc, int fr, int fq) const {
        bf16_t* KM = (bf16_t*)(ws + WS_KM); bf16_t* VM = (bf16_t*)(ws + WS_VM);
        const int rowt = u.pm * 256 + wr * 64 + fr, colb = u.pn * 256 + wc * 32 + 8 * fq;
#pragma unroll
        for (int ai = 0; ai < 2; ++ai)
#pragma unroll
            for (int m = 0; m < 4; ++m) {
                const int row = rowt + ai * 128 + m * 16;
#pragma unroll
                for (int bj = 0; bj < 2; ++bj) {
                    const int col0 = colb + bj * 128;
                    bf16_t* dst = (col0 < 512) ? KM + (size_t)row * 768 + (col0 >> 6) * 96 + (col0 & 63) : VM + (size_t)row * 1024 + (col0 - 512);
                    *(u32x4*)dst = pack8(acc[ai][bj][m][0], acc[ai][bj][m][1]);
                }
                asm volatile("" ::: "memory");
            }
    }
};
struct EpiBr {
    static constexpr bool PERM = true, AFTER_DRAIN = false;
    unsigned char* ws;
    DI void operator()(const f32x4 (&acc)[2][2][4][2], const pg8::Unit& u, int wr, int wc, int fr, int fq) const {
        bf16_t* P = (bf16_t*)(ws + WS_P);
        const int rowt = u.pm * 256 + wr * 64 + fr, colb = u.pn * 256 + wc * 32 + 8 * fq;
#pragma unroll
        for (int ai = 0; ai < 2; ++ai)
#pragma unroll
            for (int m = 0; m < 4; ++m) {
                const int row = rowt + ai * 128 + m * 16;
#pragma unroll
                for (int bj = 0; bj < 2; ++bj) {
                    bf16_t* p = P + (size_t)row * NP + C_GM + colb + bj * 128;
                    const u32x4 g = *(const u32x4*)p;
                    f32x4 v0 = acc[ai][bj][m][0], v1 = acc[ai][bj][m][1];
                    v0[0] *= sigm_f(bflo(g.x)); v0[1] *= sigm_f(bfhi(g.x)); v0[2] *= sigm_f(bflo(g.y)); v0[3] *= sigm_f(bfhi(g.y));
                    v1[0] *= sigm_f(bflo(g.z)); v1[1] *= sigm_f(bfhi(g.z)); v1[2] *= sigm_f(bflo(g.w)); v1[3] *= sigm_f(bfhi(g.w));
                    *(u32x4*)p = pack8(v0, v1);
                }
            }
    }
};
struct EpiOut {
    static constexpr bool PERM = true, AFTER_DRAIN = false;
    int l, g; const float* xsrc; float* xdst; const float* ctxsrc; unsigned char* ws;
    DI void operator()(const f32x4 (&acc)[2][2][4][2], const pg8::Unit& u, int wr, int wc, int fr, int fq) const {
        float* ctxdst = (float*)(ws + WS_CTX); const float* mod = (const float*)(ws + WS_MOD) + (size_t)l * 9 * 3072;
        const int pmb = u.pm % 33, b = g * GB + u.pm / 33; const bool ctxt = pmb == 0;
        if (ctxt && l != 0) return;
        const float* gate = mod + (size_t)(ctxt ? 8 : b) * 3072 + 2048;
        const int colb = u.pn * 256 + wc * 32 + 8 * fq;
#pragma unroll
        for (int ai = 0; ai < 2; ++ai)
#pragma unroll
            for (int m = 0; m < 4; ++m) {
                const int j = pmb * 256 + ai * 128 + wr * 64 + m * 16 + fr;
                const size_t idx = ctxt ? ((size_t)b * CTX + j) * DM : ((size_t)b * SEQ + (j - CTX)) * DM;
                const float* s = (ctxt ? ctxsrc : xsrc) + idx; float* d = (ctxt ? ctxdst : xdst) + idx;
#pragma unroll
                for (int bj = 0; bj < 2; ++bj) {
                    const int col0 = colb + bj * 128;
                    const f32x4 g0 = *(const f32x4*)(gate + col0), g1 = *(const f32x4*)(gate + col0 + 4);
                    const f32x4 x0 = *(const f32x4*)(s + col0), x1 = *(const f32x4*)(s + col0 + 4);
                    *(f32x4*)(d + col0) = x0 + g0 * acc[ai][bj][m][0];
                    *(f32x4*)(d + col0 + 4) = x1 + g1 * acc[ai][bj][m][1];
                }
            }
    }
};

#define MFMA32(a, b, c) __builtin_amdgcn_mfma_f32_32x32x16_bf16((a), (b), (c), 0, 0, 0)
DI s16x4 tr16(const LAS unsigned char* p) { typedef short v4i16_t __attribute__((ext_vector_type(4))); return __builtin_bit_cast(s16x4, __builtin_amdgcn_ds_read_tr16_b64_v4i16((LAS v4i16_t*)p)); }
constexpr int AT_KOFF = 0, AT_KBUFMAX = 13312, AT_VOFF = 2 * AT_KBUFMAX, AT_VBUFMAX = 20480, AT_SOFF = AT_VOFF + 2 * AT_VBUFMAX, AT_QOFF = AT_SOFF + 1024;
#define SBAR() __builtin_amdgcn_sched_barrier(0)
#ifndef PROBE_MODE
#define PROBE_MODE 0
#endif
#ifndef AT_QL
#define AT_QL 1
#endif
#ifndef AT_SB
#define AT_SB 0
#endif
template <int DQK, bool QL>
DI void at_qkt(f32x16& p0, f32x16& p1, const LAS unsigned char* kb, const bf16x8* qf, const LAS unsigned char* qb) {
    constexpr int KSTR = DQK + 8;
#pragma unroll
    for (int r = 0; r < 16; ++r) { p0[r] = 0.f; p1[r] = 0.f; }
#pragma unroll
    for (int ds = 0; ds < DQK / 16; ++ds) {
        const bf16x8 k0 = *(const LAS bf16x8*)(kb + ds * 32), k1 = *(const LAS bf16x8*)(kb + 32 * (KSTR * 2) + ds * 32);
        bf16x8 q; if (QL) q = *(const LAS bf16x8*)(qb + ds * 1024); else q = qf[ds];
        p0 = MFMA32(k0, q, p0); p1 = MFMA32(k1, q, p1);
        if (AT_SB && DQK > 64 && (ds & 1)) __builtin_amdgcn_sched_barrier(0x7f); }
}
DI void at_mask(f32x16& p0, f32x16& p1, int dk) {
#pragma unroll
    for (int r = 0; r < 16; ++r) { const int d = dk + (r & 3) + 8 * (r >> 2);
        if (d > 128 || d < -128) p0[r] = NEGBIG;
        if (d + 32 > 128 || d + 32 < -128) p1[r] = NEGBIG; }
}
DI void at_psm(f32x16& p0, f32x16& p1, float& mrun, float& alpha) {
    float mx = fmaxf(p0[0], p1[0]);
#pragma unroll
    for (int r = 1; r < 16; ++r) mx = fmaxf(mx, fmaxf(p0[r], p1[r]));
    { auto rr = __builtin_amdgcn_permlane32_swap(__float_as_uint(mx), __float_as_uint(mx), false, false); mx = fmaxf(__uint_as_float(rr[0]), __uint_as_float(rr[1])); }
    const bool keep = __all(mx - mrun <= THR);
    const float mn = keep ? mrun : fmaxf(mrun, mx); alpha = __builtin_amdgcn_exp2f(mrun - mn); mrun = mn;
#pragma unroll
    for (int r = 0; r < 16; ++r) { p0[r] -= mrun; p1[r] -= mrun; }
#pragma unroll
    for (int r = 0; r < 16; ++r) p0[r] = __builtin_amdgcn_exp2f(p0[r]);
}
DI void at_fsm(f32x16& p0, f32x16& p1, float alpha, float& lrun, bf16x8* pa) {
#pragma unroll
    for (int r = 0; r < 16; ++r) p1[r] = __builtin_amdgcn_exp2f(p1[r]);
    float ps = 0.f;
#pragma unroll
    for (int r = 0; r < 16; ++r) ps += p0[r] + p1[r];
    lrun = lrun * alpha + ps;
    u32x4 w;
    w.x = pk2(p0[0], p0[1]); w.y = pk2(p0[2], p0[3]); w.z = pk2(p0[4], p0[5]); w.w = pk2(p0[6], p0[7]); pa[0] = __builtin_bit_cast(bf16x8, w);
    w.x = pk2(p0[8], p0[9]); w.y = pk2(p0[10], p0[11]); w.z = pk2(p0[12], p0[13]); w.w = pk2(p0[14], p0[15]); pa[1] = __builtin_bit_cast(bf16x8, w);
    w.x = pk2(p1[0], p1[1]); w.y = pk2(p1[2], p1[3]); w.z = pk2(p1[4], p1[5]); w.w = pk2(p1[6], p1[7]); pa[2] = __builtin_bit_cast(bf16x8, w);
    w.x = pk2(p1[8], p1[9]); w.y = pk2(p1[10], p1[11]); w.z = pk2(p1[12], p1[13]); w.w = pk2(p1[14], p1[15]); pa[3] = __builtin_bit_cast(bf16x8, w);
}
template <int DV>
DI void at_pv(f32x16* o, const LAS unsigned char* vb, const bf16x8* pa) {
    constexpr int VSTR = DV + 32;
#pragma unroll
    for (int db = 0; db < DV / 32; ++db) {
#pragma unroll
        for (int kh = 0; kh < 2; ++kh) {
            s16x4 vlo[2], vhi[2];
#pragma unroll
            for (int k2 = 0; k2 < 2; ++k2) { const int ks = 2 * kh + k2; vlo[k2] = tr16(vb + (16 * ks) * (VSTR * 2) + db * 64); vhi[k2] = tr16(vb + (16 * ks + 8) * (VSTR * 2) + db * 64); }
#pragma unroll
            for (int k2 = 0; k2 < 2; ++k2) { const bf16x8 vf = __builtin_shufflevector(vlo[k2], vhi[k2], 0, 1, 2, 3, 4, 5, 6, 7); o[db] = MFMA32(pa[2 * kh + k2], vf, o[db]); }
        }
    }
}
template <int DV>
DI void at_scale_o(f32x16* o, LAS float* scw, float val, int r32, int hi) {
    if (hi == 0) scw[r32] = val;
    __builtin_amdgcn_wave_barrier(); asm volatile("" ::: "memory");
#pragma unroll
    for (int g4 = 0; g4 < 4; ++g4) { const f32x4 a4 = *(const LAS f32x4*)(scw + 8 * g4 + 4 * hi);
#pragma unroll
        for (int db = 0; db < DV / 32; ++db) { o[db][4 * g4 + 0] *= a4[0]; o[db][4 * g4 + 1] *= a4[1]; o[db][4 * g4 + 2] *= a4[2]; o[db][4 * g4 + 3] *= a4[3]; } }
    __builtin_amdgcn_wave_barrier(); asm volatile("" ::: "memory");
}
template <int DQK, int DV, int OUTM, bool MASKED>
DI void attn_unit(LAS unsigned char* lds, const bf16_t* Qp, int ldq, const bf16_t* Kp, int ldk, const bf16_t* Vp, int ldv,
                  int nA, int rowB0, int nB, int posB0, int qpos0, float m0, float l0,
                  bf16_t* Og, int ldo, float* Of, int ldof) {
    constexpr int KSTR = DQK + 8, VSTR = DV + 32, KBUF = 64 * KSTR * 2, VBUF = 64 * VSTR * 2;
    constexpr int KCH = DQK / 8, VCH = DV / 8, NKC = 64 * KCH, NVC = 64 * VCH, KRN = (NKC + 511) / 512, VRN = (NVC + 511) / 512;
    static_assert(KBUF <= AT_KBUFMAX && VBUF <= AT_VBUFMAX, "attention LDS map");
    const int tid = tid_l(), lane = tid & 63, wid = __builtin_amdgcn_readfirstlane(tid >> 6), r32 = lane & 31, hi = lane >> 5;
#ifndef AT_QL
#define AT_QL 1
#endif
#ifndef AT_SB
#define AT_SB 0
#endif
    constexpr bool QL = AT_QL && (DQK > 64);
    bf16x8 qf[QL ? 1 : DQK / 16];
    const LAS unsigned char* qb = lds + AT_QOFF + wid * 6144 + lane * 16;
    { const bf16_t* qrow = Qp + (size_t)(32 * wid + r32) * ldq + 8 * hi;
#pragma unroll
      for (int ds = 0; ds < DQK / 16; ++ds) { const bf16x8 v = *(const bf16x8*)(qrow + 16 * ds); if (QL) *(LAS bf16x8*)(lds + AT_QOFF + wid * 6144 + lane * 16 + ds * 1024) = v; else qf[QL ? 0 : ds] = v; }
      if (QL) { __builtin_amdgcn_wave_barrier(); asm volatile("s_waitcnt lgkmcnt(0)" ::: "memory"); } }
    f32x16 o[DV / 32];
#pragma unroll
    for (int db = 0; db < DV / 32; ++db)
#pragma unroll
        for (int r = 0; r < 16; ++r) o[db][r] = 0.f;
    float mrun = m0, lrun = (hi == 0) ? l0 : 0.f;
    LAS float* scw = (LAS float*)(lds + AT_SOFF) + wid * 32;
    const int NT = nA + nB;
    const LAS unsigned char* kb0 = lds + AT_KOFF + r32 * (KSTR * 2) + hi * 16;
    const LAS unsigned char* vb0 = lds + AT_VOFF + (4 * hi + ((lane & 15) >> 2)) * (VSTR * 2) + (16 * ((lane >> 4) & 1) + 4 * (lane & 3)) * 2;
    const int dk0 = posB0 + 4 * hi - (qpos0 + 32 * wid + r32) - 64 * nA;
    u32x4 kreg[KRN], vreg[VRN];
    int kgo[KRN], klo[KRN], vgo[VRN], vlo_[VRN];
#pragma unroll
    for (int i_ = 0; i_ < KRN; ++i_) { int c_ = tid + 512 * i_; if (c_ >= NKC) c_ -= 512; const int r_ = c_ / KCH, cc_ = c_ % KCH; kgo[i_] = r_ * ldk + cc_ * 8; klo[i_] = AT_KOFF + r_ * (KSTR * 2) + cc_ * 16; }
#pragma unroll
    for (int i_ = 0; i_ < VRN; ++i_) { int c_ = tid + 512 * i_; if (c_ >= NVC) c_ -= 512; const int r_ = c_ / VCH, cc_ = c_ % VCH; vgo[i_] = r_ * ldv + cc_ * 8; vlo_[i_] = AT_VOFF + r_ * (VSTR * 2) + cc_ * 16; }
#define AT_GLOAD(t) do { const int row0_ = (t) < nA ? 64 * (t) : rowB0 + 64 * ((t) - nA); const bf16_t* kt_ = Kp + (size_t)row0_ * ldk; const bf16_t* vt_ = Vp + (size_t)row0_ * ldv; \
        _Pragma("unroll") for (int i_ = 0; i_ < KRN; ++i_) kreg[i_] = *(const u32x4*)(kt_ + kgo[i_]); \
        _Pragma("unroll") for (int i_ = 0; i_ < VRN; ++i_) vreg[i_] = *(const u32x4*)(vt_ + vgo[i_]); } while (0)
#define AT_SWRITE(buf) do { \
        _Pragma("unroll") for (int i_ = 0; i_ < KRN; ++i_) *(LAS u32x4*)(lds + (buf) * KBUF + klo[i_]) = kreg[i_]; \
        _Pragma("unroll") for (int i_ = 0; i_ < VRN; ++i_) *(LAS u32x4*)(lds + (buf) * VBUF + vlo_[i_]) = vreg[i_]; } while (0)
    unsigned pfv = 0u, pfacc = 0u;
    const int pft = tid & 255;
    const bf16_t* pfb = (pft < 128) ? Kp + (pft >> 1) * ldk + (pft & 1) * (DQK - 2) : Vp + ((pft - 128) >> 1) * ldv + (pft & 1) * (DV - 2);
    const int pfs = (pft < 128) ? ldk : ldv;
    constexpr int PFD = 4;
#define AT_PF(t) do { pfacc ^= pfv; const int tt_ = (t) < NT ? (t) : NT - 1; const int row0_ = tt_ < nA ? 64 * tt_ : rowB0 + 64 * (tt_ - nA); \
        pfv = *(const unsigned*)(pfb + (size_t)row0_ * pfs); } while (0)
#define AT_MASK(P0, P1, t) do { if (MASKED && (t) >= nA) at_mask(P0, P1, dk0 + 64 * (t)); } while (0)
#define AT_RESC(al) do { if (__any((al) < 1.f)) at_scale_o<DV>(o, scw, (al), r32, hi); } while (0)
    f32x16 pA0, pA1, pB0, pB1; float alA, alB; bf16x8 pa[4];
    AT_PF(1); AT_PF(2); AT_PF(3);
    AT_GLOAD(0); AT_SWRITE(0); __syncthreads();
    AT_GLOAD(1);
    at_qkt<DQK, QL>(pA0, pA1, kb0, qf, qb); AT_MASK(pA0, pA1, 0); at_psm(pA0, pA1, mrun, alA);
    AT_SWRITE(1); __syncthreads();
    for (int j = 1; j + 1 < NT; j += 2) {
        if (!(OUTM == 2 && PROBE_MODE == 1)) { AT_GLOAD(j + 1); AT_PF(j + PFD); }
        SBAR(); at_qkt<DQK, QL>(pB0, pB1, kb0 + KBUF, qf, qb); AT_MASK(pB0, pB1, j);
        at_fsm(pA0, pA1, alA, lrun, pa); SBAR();
        at_pv<DV>(o, vb0, pa); at_psm(pB0, pB1, mrun, alB);
        __syncthreads(); if (!(OUTM == 2 && PROBE_MODE == 1)) AT_SWRITE(0);
        AT_RESC(alB); __syncthreads();
        if (!(OUTM == 2 && PROBE_MODE == 1)) { AT_GLOAD(j + 2); AT_PF(j + 1 + PFD); }
        SBAR(); at_qkt<DQK, QL>(pA0, pA1, kb0, qf, qb); AT_MASK(pA0, pA1, j + 1);
        at_fsm(pB0, pB1, alB, lrun, pa); SBAR();
        at_pv<DV>(o, vb0 + VBUF, pa); at_psm(pA0, pA1, mrun, alA);
        __syncthreads(); if (!(OUTM == 2 && PROBE_MODE == 1)) AT_SWRITE(1);
        AT_RESC(alA); __syncthreads();
    }
    SBAR(); at_qkt<DQK, QL>(pB0, pB1, kb0 + KBUF, qf, qb); AT_MASK(pB0, pB1, NT - 1);
    at_fsm(pA0, pA1, alA, lrun, pa); SBAR();
    at_pv<DV>(o, vb0, pa); at_psm(pB0, pB1, mrun, alB);
    AT_RESC(alB);
    at_fsm(pB0, pB1, alB, lrun, pa); SBAR();
    at_pv<DV>(o, vb0 + VBUF, pa);
    pfacc ^= pfv;
    if (__builtin_expect(pfacc == 0x9e3779b9u && lrun == 12345.678f, 0)) scw[0] = 1.f;
#undef AT_GLOAD
#undef AT_PF
#undef AT_SWRITE
#undef AT_MASK
#undef AT_RESC
    { const float lt = lrun + __shfl_xor(lrun, 32); at_scale_o<DV>(o, scw, 1.0f / lt, r32, hi); }
#pragma unroll
    for (int db = 0; db < DV / 32; ++db)
#pragma unroll
        for (int r = 0; r < 16; ++r) {
            const int q = (r & 3) + 8 * (r >> 2) + 4 * hi;
            if (OUTM == 0) { bf16_t* p = Og + (size_t)(32 * wid + q) * ldo + 32 * db + r32; const float z = __uint_as_float((unsigned)(*p) << 16); *p = (bf16_t)(pk2(o[db][r] * silu_f(z), 0.f) & 0xffffu); }
            else if (OUTM == 1) { Of[(size_t)(32 * wid + q) * ldof + 32 * db + r32] = o[db][r]; }
            else { if (lrun == 12345.678f) Of[(size_t)(32 * wid + q) * ldof + 32 * db + r32] = o[db][r]; }
        }
    __syncthreads();
}

struct Args { const float* in[21]; float* out; unsigned char* ws; };
typedef const __attribute__((address_space(4))) Args* ArgsP;
DI ArgsP args_ptr() { ArgsP p = (ArgsP)__builtin_amdgcn_kernarg_segment_ptr(); asm volatile("" : "+s"(p)); return p; }
enum { I_X = 0, I_C, I_CTX, I_CCTX, I_WMOD, I_BMOD, I_NORMG, I_WIN, I_QNORM, I_WUQ, I_KVNORM, I_WUKV, I_LQ1, I_LK1, I_LQ2, I_LK2, I_SUBLN, I_SINK, I_WBR, I_WOUT, I_FNORM };

DI int colmap(int kind, int n) {
    if (kind == 1) {
        if (n < C_KR) return n;
        if (n < C_KR + 32) { const int e = n - C_KR; return C_KR + (e >> 1) + 16 * (e & 1); }
        if (n < C_DQ) return -1;
        if ((n >= C_DQ && n < C_DV) || (n >= C_SQ && n < C_SV)) { const int w = n & 63; return (n - w) - 96 + (w >> 1) + 32 * (w & 1); }
        return n - 96;
    }
    if (kind == 2) { const int h = n / 96, e = n % 96; if (e < 64) return n; const int e2 = e - 64; return h * 96 + 64 + (e2 >> 1) + 16 * (e2 & 1); }
    if (kind == 3) { if (n < 512) return (n >> 6) * 192 + (n & 63); const int n2 = n - 512; return (n2 >> 7) * 192 + 64 + (n2 & 127); }
    return n;
}
DI void transpose_item(const float* W, int ldw, int kind, const float* rowscale, bf16_t* WT, int ldd, int koff, LAS float* scr, int item, int nblk, int lane) {
    const int kb = item / nblk, nb = item % nblk, k0 = 64 * kb, n0 = 32 * nb;
    const int oc = colmap(kind, n0 + (lane & 31));
#pragma unroll 8
    for (int i = 0; i < 32; ++i) { const int kk = 2 * i + (lane >> 5); float v = 0.f; if (oc >= 0) v = W[(size_t)(k0 + kk) * ldw + oc]; if (rowscale) v *= rowscale[k0 + kk]; scr[kk * 33 + (lane & 31)] = v; }
    __builtin_amdgcn_wave_barrier(); asm volatile("s_waitcnt lgkmcnt(0)" ::: "memory");
    const int c = lane & 7;
#pragma unroll
    for (int j = 0; j < 4; ++j) { const int n = (lane >> 3) + 8 * j; const LAS float* s = scr + (8 * c) * 33 + n;
        u32x4 o; o.x = pk2(s[0 * 33], s[1 * 33]); o.y = pk2(s[2 * 33], s[3 * 33]); o.z = pk2(s[4 * 33], s[5 * 33]); o.w = pk2(s[6 * 33], s[7 * 33]);
        *(u32x4*)(WT + (size_t)(n0 + n) * ldd + koff + k0 + 8 * c) = o; }
    __builtin_amdgcn_wave_barrier(); asm volatile("s_waitcnt lgkmcnt(0)" ::: "memory");
}
DI void prologue(ArgsP ap, LAS unsigned char* lds) {
    const int tid = tid_l(), lane = tid & 63, wid = __builtin_amdgcn_readfirstlane(tid >> 6);
    unsigned char* ws = ap->ws;
    LAS float* scr = (LAS float*)(lds + wid * 8448);
    const int gw = bid_l() * 8 + wid, NGW = grd_l() * 8;
    constexpr int I_IN = 16 * (NP / 32), I_UQ = 6 * 24, I_UKV = 4 * 48, I_SQ = 16 * 32, PER_L = I_IN + I_UQ + I_UKV + 6 * I_SQ;
    for (int it = gw; it < 2 * PER_L; it += NGW) {
        const int l = it / PER_L; int r = it % PER_L;
        if (r < I_IN) { transpose_item(ap->in[I_WIN] + (size_t)l * 1024 * D_IN, D_IN, 1, nullptr, (bf16_t*)(ws + WS_WIN) + (size_t)l * NP * 1024, 1024, 0, scr, r, NP / 32, lane); continue; } r -= I_IN;
        if (r < I_UQ) { transpose_item(ap->in[I_WUQ] + (size_t)l * 384 * 768, 768, 2, ap->in[I_QNORM] + l * 384, (bf16_t*)(ws + WS_WUQ) + (size_t)l * 768 * 384, 384, 0, scr, r, 24, lane); continue; } r -= I_UQ;
        if (r < I_UKV) { transpose_item(ap->in[I_WUKV] + (size_t)l * 256 * 1536, 1536, 3, ap->in[I_KVNORM] + l * 256, (bf16_t*)(ws + WS_WUKV) + (size_t)l * 1536 * 256, 256, 0, scr, r, 48, lane); continue; } r -= I_UKV;
        if (r < 3 * I_SQ) { const int br = r / I_SQ; transpose_item(ap->in[I_WBR] + ((size_t)l * 3 + br) * 1024 * 1024, 1024, 0, nullptr, (bf16_t*)(ws + WS_WB) + ((size_t)l * 3 + br) * 1024 * 1024, 1024, 0, scr, r % I_SQ, 32, lane); continue; } r -= 3 * I_SQ;
        { const int rep = r / I_SQ; transpose_item(ap->in[I_WOUT] + (size_t)l * 1024 * 1024, 1024, 0, nullptr, (bf16_t*)(ws + WS_WO3) + (size_t)l * 1024 * 3072, 3072, rep * 1024, scr, r % I_SQ, 32, lane); }
    }
    const int gt = bid_l() * 512 + tid, NGT = grd_l() * 512;
    for (int i = gt; i < SEQ * 48; i += NGT) {
        const int pos = i / 48, p = i % 48; const float frow = (float)(pos >> 6), fcol = (float)(pos & 63);
        float ang; float* cd; float* sd;
        if (p < 32) { const int f = p & 15; const float inv = powf(10000.0f, -(float)f / 16.0f); ang = (p < 16 ? frow : fcol) * inv; cd = (float*)(ws + WS_COSH) + pos * 32 + p; sd = (float*)(ws + WS_SINH) + pos * 32 + p; }
        else { const int pp = p - 32, f = pp & 7; const float inv = powf(10000.0f, -(float)f / 8.0f); ang = (pp < 8 ? frow : fcol) * inv; cd = (float*)(ws + WS_COSM) + pos * 16 + pp; sd = (float*)(ws + WS_SINM) + pos * 16 + pp; }
        *cd = __cosf(ang); *sd = __sinf(ang);
    }
    for (int it = gw; it < 2 * 16 * 48; it += NGW) {
        const int l = it / 768, rem = it % 768, kc = rem / 48, nb = rem % 48; const int k = kc * 64 + lane;
        float sv[9];
#pragma unroll
        for (int v = 0; v < 8; ++v) sv[v] = silu_f(ap->in[I_C][v * 1024 + k]);
        sv[8] = silu_f(ap->in[I_CCTX][k]);
        float acc[9];
#pragma unroll
        for (int v = 0; v < 9; ++v) acc[v] = 0.f;
        const float* w = ap->in[I_WMOD] + ((size_t)l * 1024 + kc * 64) * 3072 + nb * 64 + lane;
#pragma unroll 8
        for (int kk = 0; kk < 64; ++kk) { const float wv = w[(size_t)kk * 3072];
#pragma unroll
            for (int v = 0; v < 9; ++v) acc[v] += __uint_as_float(__builtin_amdgcn_readlane(__float_as_uint(sv[v]), kk)) * wv; }
        float* mp = (float*)(ws + WS_MODP) + ((size_t)(l * 16 + kc) * 9) * 3072 + nb * 64 + lane;
#pragma unroll
        for (int v = 0; v < 9; ++v) mp[(size_t)v * 3072] = acc[v];
    }
}
DI void mod_finalize(ArgsP ap) {
    const int tid = tid_l();
    const int gt = bid_l() * 512 + tid, NGT = grd_l() * 512;
    const float* mp = (const float*)(ap->ws + WS_MODP); float* mod = (float*)(ap->ws + WS_MOD);
    for (int i = gt; i < 2 * 9 * 3072; i += NGT) {
        const int l = i / (9 * 3072), rem = i % (9 * 3072), n = rem % 3072;
        float s = ap->in[I_BMOD][l * 3072 + n];
#pragma unroll
        for (int kc = 0; kc < 16; ++kc) s += mp[(size_t)(l * 16 + kc) * 9 * 3072 + rem];
        mod[i] = s;
    }
}
DI void ph_norm_mod(ArgsP ap, int l, int g) {
    const int tid = tid_l(), lane = tid & 63, wid = __builtin_amdgcn_readfirstlane(tid >> 6);
    const int gw = bid_l() * 8 + wid, NGW = grd_l() * 8;
    const float* ng = ap->in[I_NORMG] + l * 1024; const float* mod = (const float*)(ap->ws + WS_MOD) + (size_t)l * 9 * 3072;
    const float* xs = (l == 0) ? ap->in[I_X] : ap->out; const float* cs = (l == 0) ? ap->in[I_CTX] : (const float*)(ap->ws + WS_CTX);
    bf16_t* H = (bf16_t*)(ap->ws + WS_H);
    for (int r = gw; r < R; r += NGW) {
        const int bl = r / RB, j = r % RB, b = g * GB + bl;
        const float* src; const float* md;
        if (j < CTX) { src = cs + ((size_t)b * CTX + j) * DM; md = mod + 8 * 3072; } else { src = xs + ((size_t)b * SEQ + (j - CTX)) * DM; md = mod + (size_t)b * 3072; }
        f32x4 v[4]; float ss = 0.f;
#pragma unroll
        for (int q = 0; q < 4; ++q) { v[q] = *(const f32x4*)(src + 4 * (lane + 64 * q)); ss += (v[q][0] * v[q][0] + v[q][1] * v[q][1]) + (v[q][2] * v[q][2] + v[q][3] * v[q][3]); }
        const float rstd = 1.0f / sqrtf(wave_sum(ss) * (1.0f / DM) + EPS);
#pragma unroll
        for (int q = 0; q < 4; ++q) { const int idx = 4 * (lane + 64 * q);
            const f32x4 gg = *(const f32x4*)(ng + idx), sh = *(const f32x4*)(md + idx), sc = *(const f32x4*)(md + 1024 + idx);
            const f32x4 y = (v[q] * rstd * gg) * (sc + 1.0f) + sh;
            u32x2 w; w.x = pk2(y[0], y[1]); w.y = pk2(y[2], y[3]); *(u32x2*)(H + (size_t)r * DM + idx) = w; }
    }
}
DI void ph_mla_norm(ArgsP ap) {
    const int tid = tid_l(), lane = tid & 63, wid = __builtin_amdgcn_readfirstlane(tid >> 6);
    const int gw = bid_l() * 8 + wid, NGW = grd_l() * 8;
    const bf16_t* P = (const bf16_t*)(ap->ws + WS_P); bf16_t* AQ = (bf16_t*)(ap->ws + WS_AQ); bf16_t* AKV = (bf16_t*)(ap->ws + WS_AKV); bf16_t* KM = (bf16_t*)(ap->ws + WS_KM);
    for (int r = gw; r < R; r += NGW) {
        const bf16_t* row = P + (size_t)r * NP;
        const u32x4 c0 = *(const u32x4*)(row + 8 * lane);
        u32x4 c1 = {0u, 0u, 0u, 0u}; if (lane < 20) c1 = *(const u32x4*)(row + 8 * (64 + lane));
        float f0[8] = {bflo(c0.x), bfhi(c0.x), bflo(c0.y), bfhi(c0.y), bflo(c0.z), bfhi(c0.z), bflo(c0.w), bfhi(c0.w)};
        float f1[8] = {bflo(c1.x), bfhi(c1.x), bflo(c1.y), bfhi(c1.y), bflo(c1.z), bfhi(c1.z), bflo(c1.w), bfhi(c1.w)};
        float s0 = 0.f, s1 = 0.f;
#pragma unroll
        for (int i = 0; i < 8; ++i) { s0 += f0[i] * f0[i]; s1 += f1[i] * f1[i]; }
        const float sq = wave_sum(lane < 48 ? s0 : 0.f);
        const float skv = wave_sum((lane >= 48 ? s0 : 0.f) + (lane < 16 ? s1 : 0.f));
        const float rq = 1.0f / sqrtf(sq * (1.0f / 384.0f) + EPS), rkv = 1.0f / sqrtf(skv * (1.0f / 256.0f) + EPS);
        { const float rr = lane < 48 ? rq : rkv; u32x4 w; w.x = pk2(f0[0] * rr, f0[1] * rr); w.y = pk2(f0[2] * rr, f0[3] * rr); w.z = pk2(f0[4] * rr, f0[5] * rr); w.w = pk2(f0[6] * rr, f0[7] * rr);
          if (lane < 48) *(u32x4*)(AQ + (size_t)r * 384 + 8 * lane) = w; else *(u32x4*)(AKV + (size_t)r * 256 + 8 * (lane - 48)) = w; }
        if (lane < 16) { u32x4 w; w.x = pk2(f1[0] * rkv, f1[1] * rkv); w.y = pk2(f1[2] * rkv, f1[3] * rkv); w.z = pk2(f1[4] * rkv, f1[5] * rkv); w.w = pk2(f1[6] * rkv, f1[7] * rkv);
            *(u32x4*)(AKV + (size_t)r * 256 + 8 * (16 + lane)) = w; }
        else if (lane < 20) {
#pragma unroll
            for (int h = 0; h < 8; ++h) *(u32x4*)(KM + (size_t)r * 768 + h * 96 + 64 + 8 * (lane - 16)) = c1; }
    }
}
DI void ph_diff_post(ArgsP ap, int l) {
    const int tid = tid_l(), lane = tid & 63, wid = __builtin_amdgcn_readfirstlane(tid >> 6);
    const int gw = bid_l() * 8 + wid, NGW = grd_l() * 8;
    const float lam_init = (l == 0) ? 0.2f : (0.8f - 0.6f * 0.7408182206817179f);
    const float d1 = wave_sum(ap->in[I_LQ1][l * 64 + lane] * ap->in[I_LK1][l * 64 + lane]), d2 = wave_sum(ap->in[I_LQ2][l * 64 + lane] * ap->in[I_LK2][l * 64 + lane]);
    const float lam = expf(d1) - expf(d2) + lam_init;
    const float sl0 = ap->in[I_SUBLN][l * 128 + 2 * lane] * (1.0f - lam_init), sl1 = ap->in[I_SUBLN][l * 128 + 2 * lane + 1] * (1.0f - lam_init);
    const float* OD = (const float*)(ap->ws + WS_OD); bf16_t* P = (bf16_t*)(ap->ws + WS_P);
    for (int it = gw; it < R * 8; it += NGW) {
        const int r = it >> 3, h = it & 7;
        if (l != 0 && (r % RB) < CTX) continue;
        const float* o1 = OD + (size_t)r * 2048 + (2 * h) * 128 + 2 * lane; const float* o2 = o1 + 128;
        const float a0 = o1[0] - lam * o2[0], a1 = o1[1] - lam * o2[1];
        const float rstd = 1.0f / sqrtf(wave_sum(a0 * a0 + a1 * a1) * (1.0f / 128.0f) + EPS);
        unsigned* zp = (unsigned*)(P + (size_t)r * NP + C_Z + 1024 + h * 128 + 2 * lane); const unsigned z = *zp;
        *zp = pk2(a0 * rstd * sl0 * silu_f(bflo(z)), a1 * rstd * sl1 * silu_f(bfhi(z)));
    }
}
DI void ph_final_norm(ArgsP ap) {
    const int tid = tid_l(), lane = tid & 63, wid = __builtin_amdgcn_readfirstlane(tid >> 6);
    const int gw = bid_l() * 8 + wid, NGW = grd_l() * 8; const float* fg = ap->in[I_FNORM];
    for (int r = gw; r < NBATCH * SEQ; r += NGW) {
        float* row = ap->out + (size_t)r * DM; f32x4 v[4]; float ss = 0.f;
#pragma unroll
        for (int q = 0; q < 4; ++q) { v[q] = *(const f32x4*)(row + 4 * (lane + 64 * q)); ss += (v[q][0] * v[q][0] + v[q][1] * v[q][1]) + (v[q][2] * v[q][2] + v[q][3] * v[q][3]); }
        const float rstd = 1.0f / sqrtf(wave_sum(ss) * (1.0f / DM) + EPS);
#pragma unroll
        for (int q = 0; q < 4; ++q) { const int idx = 4 * (lane + 64 * q); *(f32x4*)(row + idx) = v[q] * rstd * *(const f32x4*)(fg + idx); }
    }
}
template <bool DRY>
DI void ph_attention(ArgsP ap, int l, LAS unsigned char* lds) {
    constexpr int OM0 = DRY ? 2 : 0;
    const int G = grd_l(), bx = bid_l(), vcu = (G % 8 == 0) ? (bx % 8) * (G / 8) + bx / 8 : bx;
    bf16_t* P = (bf16_t*)(ap->ws + WS_P); const bf16_t* QM = (const bf16_t*)(ap->ws + WS_QM); const bf16_t* KM = (const bf16_t*)(ap->ws + WS_KM); const bf16_t* VM = (const bf16_t*)(ap->ws + WS_VM);
    float* OD = (float*)(ap->ws + WS_OD); const float* sink = ap->in[I_SINK] + l * 16;
#if !defined(ATT_ONLY) || ATT_ONLY == 1
    for (int u = vcu; u < GB * 8 * 32; u += G) { const int bh = u >> 5, qb = u & 31, bl = bh >> 3, h = bh & 7; const size_t rb = (size_t)bl * RB, q0 = rb + CTX + 256 * qb;
        attn_unit<96, 128, OM0, false>(lds, QM + q0 * 768 + h * 96, 768, KM + rb * 768 + h * 96, 768, VM + rb * 1024 + h * 128, 1024, RB / 64, 0, 0, 0, 0, NEGBIG, 0.f, P + q0 * NP + C_Z + h * 128, NP, OD, 0); }
#endif
#if !defined(ATT_ONLY) || ATT_ONLY == 2
    for (int u = vcu; u < GB * 16 * 32; u += G) { const int bh = u >> 5, qb = u & 31, bl = bh >> 4, hm = bh & 15; const size_t rb = (size_t)bl * RB, q0 = rb + CTX + 256 * qb;
        attn_unit<64, 128, 1, false>(lds, P + q0 * NP + C_DQ + hm * 64, NP, P + rb * NP + C_DK + hm * 64, NP, P + rb * NP + C_DV + (hm >> 1) * 128, NP, RB / 64, 0, 0, 0, 0, NEGBIG, 0.f, nullptr, 0, OD + q0 * 2048 + hm * 128, 2048); }
#endif
#if !defined(ATT_ONLY) || ATT_ONLY == 3
    for (int u = vcu; u < GB * 16 * 32; u += G) { const int bh = u >> 5, qb = u & 31, bl = bh >> 4, h = bh & 15; const size_t rb = (size_t)bl * RB, q0 = rb + CTX + 256 * qb;
        const int lo = (256 * qb - 128 < 0) ? 0 : 256 * qb - 128, hi = (256 * qb + 384 > SEQ) ? SEQ : 256 * qb + 384;
        attn_unit<64, 64, OM0, true>(lds, P + q0 * NP + C_SQ + h * 64, NP, P + rb * NP + C_SK + (h >> 2) * 64, NP, P + rb * NP + C_SV + (h >> 2) * 64, NP, CTX / 64, CTX + lo, (hi - lo) / 64, lo, 256 * qb, sink[h] * LOG2E, 1.0f,
                              P + q0 * NP + C_Z + 2048 + h * 64, NP, OD, 0); }
#endif
#if !defined(ATT_ONLY)
    if (l == 0) {
        for (int u = vcu; u < GB * 40; u += G) { const int bl = u / 40, k = u % 40; const size_t rb = (size_t)bl * RB;
            if (k < 8) { const int h = k;
                attn_unit<96, 128, OM0, false>(lds, QM + rb * 768 + h * 96, 768, KM + rb * 768 + h * 96, 768, VM + rb * 1024 + h * 128, 1024, CTX / 64, 0, 0, 0, 0, NEGBIG, 0.f, P + rb * NP + C_Z + h * 128, NP, OD, 0); }
            else if (k < 24) { const int hm = k - 8;
                attn_unit<64, 128, 1, false>(lds, P + rb * NP + C_DQ + hm * 64, NP, P + rb * NP + C_DK + hm * 64, NP, P + rb * NP + C_DV + (hm >> 1) * 128, NP, CTX / 64, 0, 0, 0, 0, NEGBIG, 0.f, nullptr, 0, OD + rb * 2048 + hm * 128, 2048); }
            else { const int h = k - 24;
                attn_unit<64, 64, OM0, false>(lds, P + rb * NP + C_SQ + h * 64, NP, P + rb * NP + C_SK + (h >> 2) * 64, NP, P + rb * NP + C_SV + (h >> 2) * 64, NP, CTX / 64, 0, 0, 0, 0, sink[h] * LOG2E, 1.0f, P + rb * NP + C_Z + 2048 + h * 64, NP, OD, 0); }
        }
    }
#endif
}

__global__ void __launch_bounds__(512, 2) hybrid_fwd(Args a_unused) {
    extern __shared__ __attribute__((aligned(16))) unsigned char lds_raw[];
    LAS unsigned char* lds = (LAS unsigned char*)lds_raw;
    cg::grid_group grid = cg::this_grid();
#ifndef NO_PRO
    prologue(args_ptr(), lds);
#endif
    grid.sync();
    mod_finalize(args_ptr());
    grid.sync();
    for (int l = 0; l < 2; ++l) {
        for (int g = 0; g < NGRP; ++g) {
            ph_norm_mod(args_ptr(), lnd(l), lnd(g));
            grid.sync();
#ifndef NO_GEMM
            {
                unsigned char* ws = args_ptr()->ws; const int G = grd_l(), bx = bid_l();
                pg8::Gemm gm{1024, 1024, 1024}; pg8::Order S; S.init(R, NP, G, bx, ws + WS_H, 1024, (bf16_t*)(ws + WS_WIN) + (size_t)l * NP * 1024, 1024, 1 << 20, 0);
                EpiIn E{ws};
                pg8::gemm_phase<EpiIn, pg8::Order, true, true>(lds, gm, S, E);
#ifdef PROBE_G1
                __syncthreads(); pg8::gemm_phase<EpiIn, pg8::Order, true, true>(lds, gm, S, E);
#endif
            }
#endif
            grid.sync();
            ph_mla_norm(args_ptr());
            grid.sync();
#ifndef NO_GEMM2
            {
                unsigned char* ws = args_ptr()->ws; const int G = grd_l(), bx = bid_l();
                pg8::Gemm gq{384, 384, 384}; pg8::Order Sq; Sq.init(R, 768, G, bx, ws + WS_AQ, 384, (bf16_t*)(ws + WS_WUQ) + (size_t)l * 768 * 384, 384, 1 << 20, 0);
                EpiQ Eq{ws};
#ifndef NO_GQ
                pg8::gemm_phase<EpiQ, pg8::Order, true, true>(lds, gq, Sq, Eq);
#endif
            }
            {
                unsigned char* ws = args_ptr()->ws; const int G = grd_l(), bx = bid_l();
                pg8::Gemm gk{256, 256, 256}; pg8::Order Sk; Sk.init(R, 1536, G, bx, ws + WS_AKV, 256, (bf16_t*)(ws + WS_WUKV) + (size_t)l * 1536 * 256, 256, 1 << 20, 0);
                EpiKV Ek{ws};
#ifndef NO_GK
                pg8::gemm_phase<EpiKV, pg8::Order, true, true>(lds, gk, Sk, Ek);
#endif
            }
#endif
            grid.sync();
#ifndef NO_ATT
#ifdef PROBE_ATT
            ph_attention<true>(args_ptr(), lnd(l), lds);
            grid.sync();
#endif
            ph_attention<false>(args_ptr(), lnd(l), lds);
#endif
            grid.sync();
            ph_diff_post(args_ptr(), lnd(l));
            grid.sync();
#ifndef NO_BR
            {
                unsigned char* ws = args_ptr()->ws; const int G = grd_l(), bx = bid_l();
                pg8::Gemm gb{1024, NP, 1024}; pg8::Order S; S.init(R, 3072, G, bx, (bf16_t*)(ws + WS_P) + C_Z, NP, (bf16_t*)(ws + WS_WB) + (size_t)l * 3 * 1024 * 1024, 1024, 4, 1024 * 2);
                EpiBr E{ws};
                pg8::gemm_phase<EpiBr, pg8::Order, true, true>(lds, gb, S, E);
            }
#endif
            grid.sync();
#ifndef NO_OUT
            {
                ArgsP ap = args_ptr(); unsigned char* ws = ap->ws; const int G = grd_l(), bx = bid_l();
                pg8::Gemm go{3072, NP, 3072}; pg8::Order S; S.init(R, 1024, G, bx, (bf16_t*)(ws + WS_P) + C_GM, NP, (bf16_t*)(ws + WS_WO3) + (size_t)l * 1024 * 3072, 3072, 1 << 20, 0);
                EpiOut E{l, g, (l == 0) ? ap->in[I_X] : (const float*)ap->out, ap->out, ap->in[I_CTX], ws};
                pg8::gemm_phase<EpiOut, pg8::Order, true, true>(lds, go, S, E);
            }
#endif
        }
        grid.sync();
    }
    ph_final_norm(args_ptr());
}

extern "C" void kernel_launch(void* const* d_in, const int* in_sizes, int n_in, void* d_out, int out_size, void* d_ws, size_t ws_size, hipStream_t stream) {
    static int grid = 0;
    if (grid == 0) {
        if (n_in != 21 || ws_size < WS_END) { fprintf(stderr, "kernel_launch: expected 21 inputs and >= %zu bytes of workspace (got %d, %zu)\n", (size_t)WS_END, n_in, ws_size); grid = -1; return; }
        int dev = 0, cus = 0, per_cu = 0;
        (void)hipGetDevice(&dev); (void)hipDeviceGetAttribute(&cus, hipDeviceAttributeMultiprocessorCount, dev);
        if (hipFuncSetAttribute((const void*)hybrid_fwd, hipFuncAttributeMaxDynamicSharedMemorySize, LDS_BYTES) != hipSuccess) fprintf(stderr, "kernel_launch: hipFuncSetAttribute failed\n");
        if (hipOccupancyMaxActiveBlocksPerMultiprocessor(&per_cu, (const void*)hybrid_fwd, 512, LDS_BYTES) != hipSuccess || per_cu < 1) { per_cu = 1; (void)hipGetLastError(); }
        if (cus <= 0) cus = 256;
        grid = cus * per_cu;
    }
    if (grid < 0) return;
    Args a{};
    for (int i = 0; i < 21; ++i) a.in[i] = (const float*)d_in[i];
    a.out = (float*)d_out; a.ws = (unsigned char*)d_ws;
    void* args[] = {&a};
    hipError_t e = hipLaunchCooperativeKernel((const void*)hybrid_fwd, dim3(grid), dim3(512), args, LDS_BYTES, stream);
    if (e != hipSuccess) fprintf(stderr, "kernel_launch: cooperative launch failed: %s (grid %d)\n", hipGetErrorString(e), grid);
}
```

```cpp
#define AT_PV8 1
#define AT_NOSBAR 1
#define AT_PV8 1
#define AT_NOSBAR 1
#include <hip/hip_runtime.h>
#include <hip/hip_cooperative_groups.h>
#include <cstdio>
#include <cstdint>
namespace cg = cooperative_groups;

#define DI __device__ __forceinline__
#define LAS __attribute__((address_space(3)))
__device__ __forceinline__ int tid_l() { int t = threadIdx.x; asm volatile("" : "+v"(t)); return t; }
__device__ __forceinline__ int bid_l() { int b = blockIdx.x; asm volatile("" : "+s"(b)); return b; }
__device__ __forceinline__ int lnd(int x) { asm volatile("" : "+s"(x)); return x; }
__device__ __forceinline__ int grd_l() { int g = gridDim.x; asm volatile("" : "+s"(g)); return g; }
typedef unsigned short bf16_t;
typedef short bf16x8 __attribute__((ext_vector_type(8)));
typedef short s16x4 __attribute__((ext_vector_type(4)));
typedef float f32x4 __attribute__((ext_vector_type(4)));
typedef float f32x16 __attribute__((ext_vector_type(16)));
typedef unsigned u32x4 __attribute__((ext_vector_type(4)));
typedef unsigned u32x2 __attribute__((ext_vector_type(2)));

constexpr int DM = 1024, NBATCH = 8, SEQ = 8192, CTX = 256, RB = CTX + SEQ;
constexpr int GB = 2, NGRP = NBATCH / GB, R = GB * RB;
constexpr int NP = 11520;
constexpr int C_QC = 0, C_KVC = 384, C_KR = 640, C_DQ = 768, C_DK = 1792, C_DV = 2816, C_SQ = 3840, C_SK = 4864, C_SV = 5120, C_Z = 5376, C_GM = 8448;
constexpr int D_IN = 11424;
constexpr float EPS = 1e-6f, LOG2E = 1.4426950408889634f;
constexpr float QS64 = 0.125f * LOG2E, QS96 = 0.10206207261596575f * LOG2E;
constexpr float NEGBIG = -1e30f, THR = 8.0f;

constexpr size_t al256(size_t x) { return (x + 255) & ~(size_t)255; }
constexpr size_t WS_WIN = 1u << 20;
constexpr size_t WS_WUQ = al256(WS_WIN + (size_t)2 * NP * 1024 * 2);
constexpr size_t WS_WUKV = al256(WS_WUQ + (size_t)2 * 768 * 384 * 2);
constexpr size_t WS_WB = al256(WS_WUKV + (size_t)2 * 1536 * 256 * 2);
constexpr size_t WS_WO3 = al256(WS_WB + (size_t)2 * 3 * 1024 * 1024 * 2);
constexpr size_t WS_COSH = al256(WS_WO3 + (size_t)2 * 1024 * 3072 * 2);
constexpr size_t WS_SINH = al256(WS_COSH + (size_t)SEQ * 32 * 4);
constexpr size_t WS_COSM = al256(WS_SINH + (size_t)SEQ * 32 * 4);
constexpr size_t WS_SINM = al256(WS_COSM + (size_t)SEQ * 16 * 4);
constexpr size_t WS_MODP = al256(WS_SINM + (size_t)SEQ * 16 * 4);
constexpr size_t WS_MOD = al256(WS_MODP + (size_t)16 * 2 * 9 * 3072 * 4);
constexpr size_t WS_CTX = al256(WS_MOD + (size_t)2 * 9 * 3072 * 4);
constexpr size_t WS_H = al256(WS_CTX + (size_t)NBATCH * CTX * DM * 4);
constexpr size_t WS_P = al256(WS_H + (size_t)R * DM * 2);
constexpr size_t WS_AQ = al256(WS_P + (size_t)R * NP * 2);
constexpr size_t WS_AKV = al256(WS_AQ + (size_t)R * 384 * 2);
constexpr size_t WS_QM = al256(WS_AKV + (size_t)R * 256 * 2);
constexpr size_t WS_KM = al256(WS_QM + (size_t)R * 768 * 2);
constexpr size_t WS_VM = al256(WS_KM + (size_t)R * 768 * 2);
constexpr size_t WS_OD = al256(WS_VM + (size_t)R * 1024 * 2);
constexpr size_t WS_END = al256(WS_OD + (size_t)R * 2048 * 4);
static_assert(WS_END <= ((size_t)1 << 30), "workspace map exceeds 1 GiB");

constexpr int LDS_BYTES = 155648;

DI unsigned pk2(float lo, float hi) { typedef float f2_t __attribute__((ext_vector_type(2))); typedef __bf16 b2_t __attribute__((ext_vector_type(2)));
    f2_t v = {lo, hi}; b2_t b = __builtin_convertvector(v, b2_t); return __builtin_bit_cast(unsigned, b); }
DI u32x4 pack8(f32x4 a, f32x4 b) { u32x4 w; w.x = pk2(a[0], a[1]); w.y = pk2(a[2], a[3]); w.z = pk2(b[0], b[1]); w.w = pk2(b[2], b[3]); return w; }
DI float bflo(unsigned w) { return __uint_as_float(w << 16); }
DI float bfhi(unsigned w) { return __uint_as_float(w & 0xffff0000u); }
DI float wave_sum(float v) {
#pragma unroll
    for (int o = 1; o < 64; o <<= 1) v += __shfl_xor(v, o);
    return v; }
DI float silu_f(float z) { return z / (1.0f + __expf(-z)); }
DI float sigm_f(float z) { return 1.0f / (1.0f + __expf(-z)); }
DI void rope8(f32x4& v0, f32x4& v1, const f32x4 cs, const f32x4 sn) {
    float a, b;
    a = v0[0]; b = v0[1]; v0[0] = a * cs[0] - b * sn[0]; v0[1] = b * cs[0] + a * sn[0];
    a = v0[2]; b = v0[3]; v0[2] = a * cs[1] - b * sn[1]; v0[3] = b * cs[1] + a * sn[1];
    a = v1[0]; b = v1[1]; v1[0] = a * cs[2] - b * sn[2]; v1[1] = b * cs[2] + a * sn[2];
    a = v1[2]; b = v1[3]; v1[2] = a * cs[3] - b * sn[3]; v1[3] = b * cs[3] + a * sn[3];
}
namespace pg8 {
#define PG8_LAS __attribute__((address_space(3)))
typedef unsigned short bf16_t;
typedef short bf16x8 __attribute__((ext_vector_type(8)));
typedef float f32x4 __attribute__((ext_vector_type(4)));
typedef unsigned u32x4 __attribute__((ext_vector_type(4)));
constexpr int BM = 256, BK = 64, HALF = 128, HTB = HALF * BK * 2  , STAGE_BYTES = 8 * HTB, NXCD = 8, WGM = 8;

__host__ __device__ __forceinline__ int lds_byte(int r, int c) { const int st = (r >> 4) * 2 + (c >> 5), rr = r & 15, cc = c & 31, ob = rr * 64 + cc * 2; return st * 1024 + (ob ^ (((ob >> 9) & 1) << 5)); }
__host__ __device__ __forceinline__ void stage_rc(int b, int& R, int& C) { const int st = b / 1024, sb = b % 1024, swz = sb ^ (((sb >> 9) & 1) << 5); R = (st >> 1) * 16 + swz / 64; C = (st & 1) * 32 + (swz % 64) / 2; }
__host__ __device__ __forceinline__ int perm32(int rho) { const int n = rho >> 4, i = rho & 15; return 8 * (i >> 2) + 4 * n + (i & 3); }

struct Unit { int pm, pn; };
struct Gemm { int K, lda, ldb; };
struct Order {
    int nM, nN, nwg, G, c; const char* A; const char* B; unsigned tA, tB; int pnblk; unsigned ablk;
    __device__ __forceinline__ void init(int M, int N, int G_, int c_, const void* A_, int lda, const void* B_, int ldb, int pnblk_, unsigned ablk_) {
        nM = M / BM; nN = N / BM; nwg = nM * nN; G = G_; c = c_; A = (const char*)A_; B = (const char*)B_; tA = (unsigned)(BM * lda * 2); tB = (unsigned)(BM * ldb * 2); pnblk = pnblk_; ablk = ablk_; }
    __device__ __forceinline__ bool next(int i, Unit& u) const {
        const long L = (long)i * G + c; if (L >= nwg) return false;
        int wgid = (int)L; { const int q = nwg / NXCD, r = nwg % NXCD, xcd = wgid % NXCD, off = wgid / NXCD; wgid = (xcd < r ? xcd * (q + 1) : r * (q + 1) + (xcd - r) * q) + off; }
        const int nig = WGM * nN, gid = wgid / nig, fm = gid * WGM, gsz = (nM - fm) < WGM ? (nM - fm) : WGM;
        u.pm = fm + ((wgid % nig) % gsz); u.pn = (wgid % nig) / gsz; return true;
    }
    __device__ __forceinline__ const char* a_base(const Unit& u) const { return A + (size_t)u.pm * tA + (size_t)(u.pn / pnblk) * ablk; }
    __device__ __forceinline__ const char* b_base(const Unit& u) const { return B + (size_t)u.pn * tB; }
};

template <class Epi, class Sched, bool ALIGN_EPI = false, bool SP2 = false>
__device__ __forceinline__ void gemm_phase(PG8_LAS unsigned char* lds, const Gemm g, const Sched& S, const Epi& E) {
    const int tid = tid_l(), wid = __builtin_amdgcn_readfirstlane(tid >> 6), lane = tid & 63, wr = wid >> 2, wc = wid & 3, fr = lane & 15, fq = lane >> 4;
    const int K = g.K, nt = K / BK;
    unsigned voffA[2], voffB[2];
#pragma unroll
    for (int i = 0; i < 2; ++i) { int R, C; stage_rc(tid * 16 + i * 8192, R, C); const int Rb = Epi::PERM ? ((R & ~31) + perm32(R & 31)) : R;
        voffA[i] = (unsigned)(R * g.lda + C) * 2u; voffB[i] = (unsigned)(Rb * g.ldb + C) * 2u; }
    const size_t kstep = (size_t)(BK * 2);
    const size_t hstepA = (size_t)HALF * g.lda * 2, hstepB = (size_t)HALF * g.ldb * 2;
    const unsigned ldsw = (unsigned)wid * 1024u;
    const int aoff = lds_byte(wr * 64 + fr, fq * 8), boff = lds_byte(wc * 32 + fr, fq * 8);
#define PG8_SA(b, h) (((b) * 2 + (h)) * HTB)
#define PG8_SB(b, h) ((4 + (b) * 2 + (h)) * HTB)
#define PG8_STAGE(bufoff, gbase, voff) do { _Pragma("unroll") for (int _i = 0; _i < 2; ++_i) \
        __builtin_amdgcn_global_load_lds((const unsigned*)((const char*)(gbase) + (voff)[_i]), (PG8_LAS unsigned*)(lds + (bufoff) + ldsw + _i * 8192), 16, 0, 0); } while (0)
#define PG8_LDA(dst, b, h) do { _Pragma("unroll") for (int m = 0; m < 4; ++m) _Pragma("unroll") for (int k = 0; k < 2; ++k) dst[m][k] = *(const PG8_LAS bf16x8*)(lds + PG8_SA(b, h) + aoff + m * 2048 + k * 1024); } while (0)
#define PG8_LDB(dst, b, h) do { _Pragma("unroll") for (int n = 0; n < 2; ++n) _Pragma("unroll") for (int k = 0; k < 2; ++k) dst[n][k] = *(const PG8_LAS bf16x8*)(lds + PG8_SB(b, h) + boff + n * 2048 + k * 1024); } while (0)
#define PG8_MMA(ai, bj, At, Bt) do { __builtin_amdgcn_s_setprio(1); _Pragma("unroll") for (int m = 0; m < 4; ++m) _Pragma("unroll") for (int n = 0; n < 2; ++n) _Pragma("unroll") for (int k = 0; k < 2; ++k) \
        acc[ai][bj][m][n] = __builtin_amdgcn_mfma_f32_16x16x32_bf16(Bt[n][k], At[m][k], acc[ai][bj][m][n], 0, 0, 0); __builtin_amdgcn_s_setprio(0); } while (0)
#define PG8_WAIT_V(n) asm volatile("s_waitcnt vmcnt(" #n ")" ::: "memory")
#define PG8_WAIT_L(n) asm volatile("s_waitcnt lgkmcnt(" #n ")" ::: "memory")
#define PG8_BAR __builtin_amdgcn_s_barrier()
#define PG8_SCHED __builtin_amdgcn_sched_barrier(0)
    Unit cur, nxt; int ui = 0;
    if (!S.next(0, cur)) return;
    f32x4 acc[2][2][4][2];
#pragma unroll
    for (int a = 0; a < 2; ++a)
#pragma unroll
        for (int b = 0; b < 2; ++b)
#pragma unroll
            for (int m = 0; m < 4; ++m)
#pragma unroll
                for (int n = 0; n < 2; ++n) acc[a][b][m][n] = (f32x4){0.f, 0.f, 0.f, 0.f};
    bf16x8 At[4][2], B0[2][2], B1[2][2];
    const char* cA = S.a_base(cur); const char* cB = S.b_base(cur);

    if constexpr (SP2) {
        PG8_STAGE(PG8_SB(0, 0), cB, voffB); PG8_STAGE(PG8_SB(0, 1), cB + hstepB, voffB); PG8_STAGE(PG8_SA(0, 0), cA, voffA); PG8_STAGE(PG8_SA(0, 1), cA + hstepA, voffA);
        if (wr == 1) PG8_BAR;
        PG8_WAIT_V(2); PG8_BAR;
        PG8_STAGE(PG8_SB(1, 0), cB + kstep, voffB); PG8_STAGE(PG8_SA(1, 0), cA + kstep, voffA); PG8_STAGE(PG8_SB(1, 1), cB + hstepB + kstep, voffB);
        PG8_WAIT_V(6); PG8_BAR;
    } else {
        PG8_STAGE(PG8_SB(0, 0), cB, voffB); PG8_STAGE(PG8_SA(0, 0), cA, voffA); PG8_STAGE(PG8_SB(0, 1), cB + hstepB, voffB); PG8_STAGE(PG8_SA(0, 1), cA + hstepA, voffA);
        if (wr == 1) PG8_BAR;
        PG8_WAIT_V(4); PG8_BAR;
        PG8_STAGE(PG8_SB(1, 0), cB + kstep, voffB); PG8_STAGE(PG8_SA(1, 0), cA + kstep, voffA); PG8_STAGE(PG8_SB(1, 1), cB + hstepB + kstep, voffB);
        PG8_WAIT_V(6); PG8_BAR;
    }
    for (;;) {
        const bool has_next = S.next(ui + 1, nxt);
        const char* nA = has_next ? S.a_base(nxt) : cA; const char* nB = has_next ? S.b_base(nxt) : cB;
#pragma nounroll
        for (int t = 0; t < nt; t += 2) {
            const bool last = (t == nt - 2);
            const char* a1 = cA + (size_t)(t + 1) * kstep;
            const char* a2 = last ? nA : cA + (size_t)(t + 2) * kstep; const char* b2 = last ? nB : cB + (size_t)(t + 2) * kstep;
            const char* a3 = a2 + kstep; const char* b3 = b2 + kstep;

            if constexpr (SP2) {
            PG8_LDB(B0, 0, 0); PG8_LDB(B1, 0, 1); PG8_SCHED; PG8_LDA(At, 0, 0); PG8_STAGE(PG8_SA(1, 1), a1 + hstepA, voffA);
            PG8_WAIT_V(8); PG8_WAIT_L(0); PG8_BAR; PG8_MMA(0, 0, At, B0); PG8_MMA(0, 1, At, B1); PG8_BAR; PG8_SCHED;
            PG8_LDA(At, 0, 1); PG8_STAGE(PG8_SB(0, 0), b2, voffB); PG8_STAGE(PG8_SB(0, 1), b2 + hstepB, voffB); PG8_STAGE(PG8_SA(0, 0), a2, voffA);
            PG8_WAIT_V(8); PG8_WAIT_L(0); PG8_BAR; PG8_MMA(1, 0, At, B0); PG8_MMA(1, 1, At, B1); PG8_BAR; PG8_SCHED;
            PG8_LDB(B0, 1, 0); PG8_LDB(B1, 1, 1); PG8_SCHED; PG8_LDA(At, 1, 0); PG8_STAGE(PG8_SA(0, 1), a2 + hstepA, voffA);
            PG8_WAIT_V(8); PG8_WAIT_L(0); PG8_BAR; PG8_MMA(0, 0, At, B0); PG8_MMA(0, 1, At, B1); PG8_BAR; PG8_SCHED;
            PG8_LDA(At, 1, 1); PG8_STAGE(PG8_SB(1, 0), b3, voffB); PG8_STAGE(PG8_SB(1, 1), b3 + hstepB, voffB); PG8_STAGE(PG8_SA(1, 0), a3, voffA);
            PG8_WAIT_V(8); PG8_WAIT_L(0); PG8_BAR; PG8_MMA(1, 0, At, B0); PG8_MMA(1, 1, At, B1); PG8_BAR; PG8_SCHED;
            } else {
            PG8_LDB(B0, 0, 0); PG8_SCHED; PG8_LDA(At, 0, 0); PG8_STAGE(PG8_SA(1, 1), a1 + hstepA, voffA);
            PG8_WAIT_L(8); PG8_BAR; PG8_WAIT_L(0); PG8_MMA(0, 0, At, B0); PG8_BAR; PG8_SCHED;
            PG8_LDB(B1, 0, 1); PG8_STAGE(PG8_SB(0, 0), b2, voffB);
            PG8_BAR; PG8_WAIT_L(0); PG8_MMA(0, 1, At, B1); PG8_BAR;
            PG8_LDA(At, 0, 1); PG8_STAGE(PG8_SA(0, 0), a2, voffA);
            PG8_BAR; PG8_WAIT_L(0); PG8_MMA(1, 0, At, B0); PG8_BAR; PG8_SCHED;
            PG8_STAGE(PG8_SB(0, 1), b2 + hstepB, voffB);
            PG8_WAIT_V(6); PG8_BAR; PG8_MMA(1, 1, At, B1); PG8_BAR;
            PG8_LDB(B0, 1, 0); PG8_SCHED; PG8_LDA(At, 1, 0); PG8_STAGE(PG8_SA(0, 1), a2 + hstepA, voffA);
            PG8_WAIT_L(8); PG8_BAR; PG8_WAIT_L(0); PG8_MMA(0, 0, At, B0); PG8_BAR; PG8_SCHED;
            PG8_LDB(B1, 1, 1); PG8_STAGE(PG8_SB(1, 0), b3, voffB);
            PG8_BAR; PG8_WAIT_L(0); PG8_MMA(0, 1, At, B1); PG8_BAR;
            PG8_LDA(At, 1, 1); PG8_STAGE(PG8_SA(1, 0), a3, voffA);
            PG8_BAR; PG8_WAIT_L(0); PG8_MMA(1, 0, At, B0); PG8_BAR; PG8_SCHED;
            PG8_STAGE(PG8_SB(1, 1), b3 + hstepB, voffB);
            PG8_WAIT_V(6); PG8_BAR; PG8_MMA(1, 1, At, B1); PG8_BAR;
            }
        }
        if constexpr (ALIGN_EPI) { if (wr == 0) PG8_BAR; }
        if constexpr (!Epi::AFTER_DRAIN) { E(acc, cur, wr, wc, fr, fq); }
        if (!has_next) break;
#pragma unroll
        for (int a = 0; a < 2; ++a)
#pragma unroll
            for (int b = 0; b < 2; ++b)
#pragma unroll
                for (int m = 0; m < 4; ++m)
#pragma unroll
                    for (int n = 0; n < 2; ++n) acc[a][b][m][n] = (f32x4){0.f, 0.f, 0.f, 0.f};
        cur = nxt; cA = nA; cB = nB; ++ui;
        if constexpr (ALIGN_EPI) { if (wr == 1) PG8_BAR; }
    }
    PG8_WAIT_V(0);
    if constexpr (!ALIGN_EPI) { if (wr == 0) PG8_BAR; }
    PG8_BAR;
    if constexpr (Epi::AFTER_DRAIN) { E.fused(acc, cur, wr, wc, fr, fq, lds, wid, lane); }
#undef PG8_SA
#undef PG8_SB
#undef PG8_STAGE
#undef PG8_LDA
#undef PG8_LDB
#undef PG8_MMA
#undef PG8_WAIT_V
#undef PG8_WAIT_L
#undef PG8_BAR
#undef PG8_SCHED
}
}
struct EpiIn {
    static constexpr bool PERM = true, AFTER_DRAIN = false;
    unsigned char* ws;
    DI void operator()(const f32x4 (&acc)[2][2][4][2], const pg8::Unit& u, int wr, int wc, int fr, int fq) const {
        bf16_t* P = (bf16_t*)(ws + WS_P); const float* cosH = (const float*)(ws + WS_COSH); const float* sinH = (const float*)(ws + WS_SINH); const float* cosM = (const float*)(ws + WS_COSM); const float* sinM = (const float*)(ws + WS_SINM);
        const int pn = u.pn; const bool ctxt = (u.pm % 33) == 0;
        int mode = 0; float sc = 1.f;
        if ((pn >= 3 && pn <= 10) || (pn >= 15 && pn <= 19)) mode = 1;
        if (pn == 2) mode = 2;
        if ((pn >= 3 && pn <= 6) || (pn >= 15 && pn <= 18)) sc = QS64;
        if (ctxt) mode = 0;
        const int rowt = u.pm * 256 + wr * 64 + fr, colb = pn * 256 + wc * 32 + 8 * fq;
#pragma unroll
        for (int ai = 0; ai < 2; ++ai)
#pragma unroll
            for (int m = 0; m < 4; ++m) {
                const int row = rowt + ai * 128 + m * 16; const int pos = (row % RB) - CTX;
                bf16_t* rowp = P + (size_t)row * NP;
#pragma unroll
                for (int bj = 0; bj < 2; ++bj) {
                    const int col0 = colb + bj * 128;
                    f32x4 v0 = acc[ai][bj][m][0], v1 = acc[ai][bj][m][1];
                    if (mode == 1) { const int p0 = (col0 & 63) >> 1; const f32x4 cs = *(const f32x4*)(cosH + (size_t)pos * 32 + p0), sn = *(const f32x4*)(sinH + (size_t)pos * 32 + p0); rope8(v0, v1, cs, sn); }
                    else if (mode == 2 && col0 >= C_KR && col0 < C_KR + 32) { const int p0 = (col0 - C_KR) >> 1; const f32x4 cs = *(const f32x4*)(cosM + (size_t)pos * 16 + p0), sn = *(const f32x4*)(sinM + (size_t)pos * 16 + p0); rope8(v0, v1, cs, sn); }
                    v0 = v0 * sc; v1 = v1 * sc;
                    *(u32x4*)(rowp + col0) = pack8(v0, v1);
                }
            }
    }
};
struct EpiQ {
    static constexpr bool PERM = true, AFTER_DRAIN = false;
    unsigned char* ws;
    DI void operator()(const f32x4 (&acc)[2][2][4][2], const pg8::Unit& u, int wr, int wc, int fr, int fq) const {
        bf16_t* QM = (bf16_t*)(ws + WS_QM); const float* cosM = (const float*)(ws + WS_COSM); const float* sinM = (const float*)(ws + WS_SINM);
        const bool ctxt = (u.pm % 33) == 0;
        const int rowt = u.pm * 256 + wr * 64 + fr, colb = u.pn * 256 + wc * 32 + 8 * fq;
#pragma unroll
        for (int ai = 0; ai < 2; ++ai)
#pragma unroll
            for (int m = 0; m < 4; ++m) {
                const int row = rowt + ai * 128 + m * 16; const int pos = (row % RB) - CTX;
#pragma unroll
                for (int bj = 0; bj < 2; ++bj) {
                    const int col0 = colb + bj * 128, within = col0 % 96;
                    f32x4 v0 = acc[ai][bj][m][0], v1 = acc[ai][bj][m][1];
                    if (!ctxt && within >= 64) { const int p0 = (within - 64) >> 1; const f32x4 cs = *(const f32x4*)(cosM + (size_t)pos * 16 + p0), sn = *(const f32x4*)(sinM + (size_t)pos * 16 + p0); rope8(v0, v1, cs, sn); }
                    v0 = v0 * QS96; v1 = v1 * QS96;
                    *(u32x4*)(QM + (size_t)row * 768 + col0) = pack8(v0, v1);
                }
                asm volatile("" ::: "memory");
            }
    }
};
struct EpiKV {
    static constexpr bool PERM = true, AFTER_DRAIN = false;
    unsigned char* ws;
    DI void operator()(const f32x4 (&acc)[2][2][4][2], const pg8::Unit& u, int wr, int wc, int fr, int fq) const {
        bf16_t* KM = (bf16_t*)(ws + WS_KM); bf16_t* VM = (bf16_t*)(ws + WS_VM);
        const int rowt = u.pm * 256 + wr * 64 + fr, colb = u.pn * 256 + wc * 32 + 8 * fq;
#pragma unroll
        for (int ai = 0; ai < 2; ++ai)
#pragma unroll
            for (int m = 0; m < 4; ++m) {
                const int row = rowt + ai * 128 + m * 16;
#pragma unroll
                for (int bj = 0; bj < 2; ++bj) {
                    const int col0 = colb + bj * 128;
                    bf16_t* dst = (col0 < 512) ? KM + (size_t)row * 768 + (col0 >> 6) * 96 + (col0 & 63) : VM + (size_t)row * 1024 + (col0 - 512);
                    *(u32x4*)dst = pack8(acc[ai][bj][m][0], acc[ai][bj][m][1]);
                }
                asm volatile("" ::: "memory");
            }
    }
};
struct EpiBr {
    static constexpr bool PERM = true, AFTER_DRAIN = false;
    unsigned char* ws;
    DI void operator()(const f32x4 (&acc)[2][2][4][2], const pg8::Unit& u, int wr, int wc, int fr, int fq) const {
        bf16_t* P = (bf16_t*)(ws + WS_P);
        const int rowt = u.pm * 256 + wr * 64 + fr, colb = u.pn * 256 + wc * 32 + 8 * fq;
#pragma unroll
        for (int ai = 0; ai < 2; ++ai)
#pragma unroll
            for (int m = 0; m < 4; ++m) {
                const int row = rowt + ai * 128 + m * 16;
#pragma unroll
                for (int bj = 0; bj < 2; ++bj) {
                    bf16_t* p = P + (size_t)row * NP + C_GM + colb + bj * 128;
                    const u32x4 g = *(const u32x4*)p;
                    f32x4 v0 = acc[ai][bj][m][0], v1 = acc[ai][bj][m][1];
                    v0[0] *= sigm_f(bflo(g.x)); v0[1] *= sigm_f(bfhi(g.x)); v0[2] *= sigm_f(bflo(g.y)); v0[3] *= sigm_f(bfhi(g.y));
                    v1[0] *= sigm_f(bflo(g.z)); v1[1] *= sigm_f(bfhi(g.z)); v1[2] *= sigm_f(bflo(g.w)); v1[3] *= sigm_f(bfhi(g.w));
                    *(u32x4*)p = pack8(v0, v1);
                }
            }
    }
};
struct EpiOut {
    static constexpr bool PERM = true, AFTER_DRAIN = false;
    int l, g; const float* xsrc; float* xdst; const float* ctxsrc; unsigned char* ws;
    DI void operator()(const f32x4 (&acc)[2][2][4][2], const pg8::Unit& u, int wr, int wc, int fr, int fq) const {
        float* ctxdst = (float*)(ws + WS_CTX); const float* mod = (const float*)(ws + WS_MOD) + (size_t)l * 9 * 3072;
        const int pmb = u.pm % 33, b = g * GB + u.pm / 33; const bool ctxt = pmb == 0;
        if (ctxt && l != 0) return;
        const float* gate = mod + (size_t)(ctxt ? 8 : b) * 3072 + 2048;
        const int colb = u.pn * 256 + wc * 32 + 8 * fq;
#pragma unroll
        for (int ai = 0; ai < 2; ++ai)
#pragma unroll
            for (int m = 0; m < 4; ++m) {
                const int j = pmb * 256 + ai * 128 + wr * 64 + m * 16 + fr;
                const size_t idx = ctxt ? ((size_t)b * CTX + j) * DM : ((size_t)b * SEQ + (j - CTX)) * DM;
                const float* s = (ctxt ? ctxsrc : xsrc) + idx; float* d = (ctxt ? ctxdst : xdst) + idx;
#pragma unroll
                for (int bj = 0; bj < 2; ++bj) {
                    const int col0 = colb + bj * 128;
                    const f32x4 g0 = *(const f32x4*)(gate + col0), g1 = *(const f32x4*)(gate + col0 + 4);
                    const f32x4 x0 = *(const f32x4*)(s + col0), x1 = *(const f32x4*)(s + col0 + 4);
                    *(f32x4*)(d + col0) = x0 + g0 * acc[ai][bj][m][0];
                    *(f32x4*)(d + col0 + 4) = x1 + g1 * acc[ai][bj][m][1];
                }
            }
    }
};

#define MFMA32(a, b, c) __builtin_amdgcn_mfma_f32_32x32x16_bf16((a), (b), (c), 0, 0, 0)
DI s16x4 tr16(const LAS unsigned char* p) { typedef short v4i16_t __attribute__((ext_vector_type(4))); return __builtin_bit_cast(s16x4, __builtin_amdgcn_ds_read_tr16_b64_v4i16((LAS v4i16_t*)p)); }
constexpr int AT_KOFF = 0, AT_KBUFMAX = 13312, AT_VOFF = 3 * AT_KBUFMAX, AT_VBUFMAX = 20480, AT_SOFF = AT_VOFF + 3 * AT_VBUFMAX, AT_QOFF = AT_SOFF + 1024;
static_assert(AT_QOFF + 8 * 6144 <= LDS_BYTES, "attention LDS map");
#ifndef AT_PV8
#define AT_PV8 0
#endif
#ifndef AT_NOSBAR
#define AT_NOSBAR 0
#endif
#if AT_NOSBAR
#define SBAR() do {} while (0)
#else
#define SBAR() __builtin_amdgcn_sched_barrier(0)
#endif
#ifndef PROBE_MODE
#define PROBE_MODE 0
#endif
#ifndef AT_QL
#define AT_QL 1
#endif
#ifndef AT_SB
#define AT_SB 0
#endif
template <int DQK, bool QL>
DI void at_qkt(f32x16& p0, f32x16& p1, const LAS unsigned char* kb, const bf16x8* qf, const LAS unsigned char* qb) {
    constexpr int KSTR = DQK + 8;
#pragma unroll
    for (int r = 0; r < 16; ++r) { p0[r] = 0.f; p1[r] = 0.f; }
#pragma unroll
    for (int ds = 0; ds < DQK / 16; ++ds) {
        const bf16x8 k0 = *(const LAS bf16x8*)(kb + ds * 32), k1 = *(const LAS bf16x8*)(kb + 32 * (KSTR * 2) + ds * 32);
        bf16x8 q; if (QL) q = *(const LAS bf16x8*)(qb + ds * 1024); else q = qf[ds];
        p0 = MFMA32(k0, q, p0); p1 = MFMA32(k1, q, p1);
        if (AT_SB && DQK > 64 && (ds & 1)) __builtin_amdgcn_sched_barrier(0x7f); }
}
DI void at_mask(f32x16& p0, f32x16& p1, int dk) {
#pragma unroll
    for (int r = 0; r < 16; ++r) { const int d = dk + (r & 3) + 8 * (r >> 2);
        if (d > 128 || d < -128) p0[r] = NEGBIG;
        if (d + 32 > 128 || d + 32 < -128) p1[r] = NEGBIG; }
}
DI void at_psm(f32x16& p0, f32x16& p1, float& mrun, float& alpha) {
    float ma = fmaxf(fmaxf(p0[0], p0[1]), p0[2]), mb = fmaxf(fmaxf(p1[0], p1[1]), p1[2]);
    ma = fmaxf(fmaxf(ma, p0[3]), p1[3]);
#pragma unroll
    for (int r = 4; r < 16; r += 2) { ma = fmaxf(fmaxf(ma, p0[r]), p0[r + 1]); mb = fmaxf(fmaxf(mb, p1[r]), p1[r + 1]); }
    float mx = fmaxf(ma, mb);
    { auto rr = __builtin_amdgcn_permlane32_swap(__float_as_uint(mx), __float_as_uint(mx), false, false); mx = fmaxf(__uint_as_float(rr[0]), __uint_as_float(rr[1])); }
    const bool keep = __all(mx - mrun <= THR);
    const float mn = keep ? mrun : fmaxf(mrun, mx); alpha = __builtin_amdgcn_exp2f(mrun - mn); mrun = mn;
#pragma unroll
    for (int r = 0; r < 16; ++r) { p0[r] -= mrun; p1[r] -= mrun; }
#pragma unroll
    for (int r = 0; r < 16; ++r) p0[r] = __builtin_amdgcn_exp2f(p0[r]);
}
DI void at_fsm(f32x16& p0, f32x16& p1, float alpha, float& lrun, bf16x8* pa) {
#pragma unroll
    for (int r = 0; r < 16; ++r) p1[r] = __builtin_amdgcn_exp2f(p1[r]);
    float ps = 0.f;
#pragma unroll
    for (int r = 0; r < 16; ++r) ps += p0[r] + p1[r];
    lrun = lrun * alpha + ps;
    u32x4 w;
    w.x = pk2(p0[0], p0[1]); w.y = pk2(p0[2], p0[3]); w.z = pk2(p0[4], p0[5]); w.w = pk2(p0[6], p0[7]); pa[0] = __builtin_bit_cast(bf16x8, w);
    w.x = pk2(p0[8], p0[9]); w.y = pk2(p0[10], p0[11]); w.z = pk2(p0[12], p0[13]); w.w = pk2(p0[14], p0[15]); pa[1] = __builtin_bit_cast(bf16x8, w);
    w.x = pk2(p1[0], p1[1]); w.y = pk2(p1[2], p1[3]); w.z = pk2(p1[4], p1[5]); w.w = pk2(p1[6], p1[7]); pa[2] = __builtin_bit_cast(bf16x8, w);
    w.x = pk2(p1[8], p1[9]); w.y = pk2(p1[10], p1[11]); w.z = pk2(p1[12], p1[13]); w.w = pk2(p1[14], p1[15]); pa[3] = __builtin_bit_cast(bf16x8, w);
}
template <int DV>
DI void at_pv(f32x16* o, const LAS unsigned char* vb, const bf16x8* pa) {
    constexpr int VSTR = DV + 32;
#pragma unroll
    for (int db = 0; db < DV / 32; ++db) {
#if AT_PV8
        s16x4 vlo[4], vhi[4];
#pragma unroll
        for (int ks = 0; ks < 4; ++ks) { vlo[ks] = tr16(vb + (16 * ks) * (VSTR * 2) + db * 64); vhi[ks] = tr16(vb + (16 * ks + 8) * (VSTR * 2) + db * 64); }
#pragma unroll
        for (int ks = 0; ks < 4; ++ks) { const bf16x8 vf = __builtin_shufflevector(vlo[ks], vhi[ks], 0, 1, 2, 3, 4, 5, 6, 7); o[db] = MFMA32(pa[ks], vf, o[db]); }
#else
#pragma unroll
        for (int kh = 0; kh < 2; ++kh) {
            s16x4 vlo[2], vhi[2];
#pragma unroll
            for (int k2 = 0; k2 < 2; ++k2) { const int ks = 2 * kh + k2; vlo[k2] = tr16(vb + (16 * ks) * (VSTR * 2) + db * 64); vhi[k2] = tr16(vb + (16 * ks + 8) * (VSTR * 2) + db * 64); }
#pragma unroll
            for (int k2 = 0; k2 < 2; ++k2) { const bf16x8 vf = __builtin_shufflevector(vlo[k2], vhi[k2], 0, 1, 2, 3, 4, 5, 6, 7); o[db] = MFMA32(pa[2 * kh + k2], vf, o[db]); }
        }
#endif
    }
}
template <int DV>
DI void at_scale_o(f32x16* o, LAS float* scw, float val, int r32, int hi) {
    if (hi == 0) scw[r32] = val;
    __builtin_amdgcn_wave_barrier(); asm volatile("" ::: "memory");
#pragma unroll
    for (int g4 = 0; g4 < 4; ++g4) { const f32x4 a4 = *(const LAS f32x4*)(scw + 8 * g4 + 4 * hi);
#pragma unroll
        for (int db = 0; db < DV / 32; ++db) { o[db][4 * g4 + 0] *= a4[0]; o[db][4 * g4 + 1] *= a4[1]; o[db][4 * g4 + 2] *= a4[2]; o[db][4 * g4 + 3] *= a4[3]; } }
    __builtin_amdgcn_wave_barrier(); asm volatile("" ::: "memory");
}
template <int DQK, int DV, int OUTM, bool MASKED>
DI void attn_unit(LAS unsigned char* lds, const bf16_t* Qp, int ldq, const bf16_t* Kp, int ldk, const bf16_t* Vp, int ldv,
                  int nA, int rowB0, int nB, int posB0, int qpos0, float m0, float l0,
                  bf16_t* Og, int ldo, float* Of, int ldof) {
    constexpr int KSTR = DQK + 8, VSTR = DV + 32, KBUF = 64 * KSTR * 2, VBUF = 64 * VSTR * 2;
    constexpr int KCH = DQK / 8, VCH = DV / 8, NKC = 64 * KCH, NVC = 64 * VCH, KRN = (NKC + 511) / 512, VRN = (NVC + 511) / 512;
    static_assert(KBUF <= AT_KBUFMAX && VBUF <= AT_VBUFMAX, "attention LDS map");
    const int tid = tid_l(), lane = tid & 63, wid = __builtin_amdgcn_readfirstlane(tid >> 6), r32 = lane & 31, hi = lane >> 5;
#ifndef AT_QL
#define AT_QL 1
#endif
#ifndef AT_SB
#define AT_SB 0
#endif
    constexpr bool QL = AT_QL && (DQK > 64);
    bf16x8 qf[QL ? 1 : DQK / 16];
    const LAS unsigned char* qb = lds + AT_QOFF + wid * 6144 + lane * 16;
    { const bf16_t* qrow = Qp + (size_t)(32 * wid + r32) * ldq + 8 * hi;
#pragma unroll
      for (int ds = 0; ds < DQK / 16; ++ds) { const bf16x8 v = *(const bf16x8*)(qrow + 16 * ds); if (QL) *(LAS bf16x8*)(lds + AT_QOFF + wid * 6144 + lane * 16 + ds * 1024) = v; else qf[QL ? 0 : ds] = v; }
      if (QL) { __builtin_amdgcn_wave_barrier(); asm volatile("s_waitcnt lgkmcnt(0)" ::: "memory"); } }
    f32x16 o[DV / 32];
#pragma unroll
    for (int db = 0; db < DV / 32; ++db)
#pragma unroll
        for (int r = 0; r < 16; ++r) o[db][r] = 0.f;
    float mrun = m0, lrun = (hi == 0) ? l0 : 0.f;
    LAS float* scw = (LAS float*)(lds + AT_SOFF) + wid * 32;
    const int NT = nA + nB;
    const LAS unsigned char* kb0 = lds + AT_KOFF + r32 * (KSTR * 2) + hi * 16;
    const LAS unsigned char* vb0 = lds + AT_VOFF + (4 * hi + ((lane & 15) >> 2)) * (VSTR * 2) + (16 * ((lane >> 4) & 1) + 4 * (lane & 3)) * 2;
    const int dk0 = posB0 + 4 * hi - (qpos0 + 32 * wid + r32) - 64 * nA;
    u32x4 kreg[KRN], vreg[VRN];
    int kgo[KRN], klo[KRN], vgo[VRN], vlo_[VRN];
#pragma unroll
    for (int i_ = 0; i_ < KRN; ++i_) { int c_ = tid + 512 * i_; if (c_ >= NKC) c_ -= 512; const int r_ = c_ / KCH, cc_ = c_ % KCH; kgo[i_] = r_ * ldk + cc_ * 8; klo[i_] = AT_KOFF + r_ * (KSTR * 2) + cc_ * 16; }
#pragma unroll
    for (int i_ = 0; i_ < VRN; ++i_) { int c_ = tid + 512 * i_; if (c_ >= NVC) c_ -= 512; const int r_ = c_ / VCH, cc_ = c_ % VCH; vgo[i_] = r_ * ldv + cc_ * 8; vlo_[i_] = AT_VOFF + r_ * (VSTR * 2) + cc_ * 16; }
#define AT_GLOAD(t) do { const int row0_ = (t) < nA ? 64 * (t) : rowB0 + 64 * ((t) - nA); const bf16_t* kt_ = Kp + (size_t)row0_ * ldk; const bf16_t* vt_ = Vp + (size_t)row0_ * ldv; \
        _Pragma("unroll") for (int i_ = 0; i_ < KRN; ++i_) kreg[i_] = *(const u32x4*)(kt_ + kgo[i_]); \
        _Pragma("unroll") for (int i_ = 0; i_ < VRN; ++i_) vreg[i_] = *(const u32x4*)(vt_ + vgo[i_]); } while (0)
#define AT_SWRITE(buf) do { \
        _Pragma("unroll") for (int i_ = 0; i_ < KRN; ++i_) *(LAS u32x4*)(lds + (buf) * KBUF + klo[i_]) = kreg[i_]; \
        _Pragma("unroll") for (int i_ = 0; i_ < VRN; ++i_) *(LAS u32x4*)(lds + (buf) * VBUF + vlo_[i_]) = vreg[i_]; } while (0)
    unsigned pfv = 0u, pfacc = 0u;
    const int pft = tid & 255;
    const bf16_t* pfb = (pft < 128) ? Kp + (pft >> 1) * ldk + (pft & 1) * (DQK - 2) : Vp + ((pft - 128) >> 1) * ldv + (pft & 1) * (DV - 2);
    const int pfs = (pft < 128) ? ldk : ldv;
    constexpr int PFD = 4;
#define AT_PF(t) do { pfacc ^= pfv; const int tt_ = (t) < NT ? (t) : NT - 1; const int row0_ = tt_ < nA ? 64 * tt_ : rowB0 + 64 * (tt_ - nA); \
        pfv = *(const unsigned*)(pfb + (size_t)row0_ * pfs); } while (0)
#define AT_MASK(P0, P1, t) do { if (MASKED && (t) >= nA) at_mask(P0, P1, dk0 + 64 * (t)); } while (0)
#define AT_RESC(al) do { if (__any((al) < 1.f)) at_scale_o<DV>(o, scw, (al), r32, hi); } while (0)
    f32x16 pA0, pA1, pB0, pB1; float alA, alB; bf16x8 pa[4];
    AT_PF(1); AT_PF(2); AT_PF(3);
    AT_GLOAD(0); AT_SWRITE(0); __syncthreads();
    AT_GLOAD(1);
    at_qkt<DQK, QL>(pA0, pA1, kb0, qf, qb); AT_MASK(pA0, pA1, 0); at_psm(pA0, pA1, mrun, alA);
    AT_SWRITE(1); __syncthreads();
    int bp = 0, bc = 1, bn = 2;
#define AT_ROT() do { bp = bc; bc = bn; bn = (bn == 2) ? 0 : bn + 1; } while (0)
    for (int j = 1; j + 1 < NT; j += 2) {
        AT_GLOAD(j + 1); AT_PF(j + PFD);
        SBAR(); at_qkt<DQK, QL>(pB0, pB1, kb0 + bc * KBUF, qf, qb); AT_MASK(pB0, pB1, j);
        at_fsm(pA0, pA1, alA, lrun, pa); SBAR();
        at_pv<DV>(o, vb0 + bp * VBUF, pa); at_psm(pB0, pB1, mrun, alB);
        AT_SWRITE(bn);
        AT_RESC(alB); __syncthreads(); AT_ROT();
        AT_GLOAD(j + 2); AT_PF(j + 1 + PFD);
        SBAR(); at_qkt<DQK, QL>(pA0, pA1, kb0 + bc * KBUF, qf, qb); AT_MASK(pA0, pA1, j + 1);
        at_fsm(pB0, pB1, alB, lrun, pa); SBAR();
        at_pv<DV>(o, vb0 + bp * VBUF, pa); at_psm(pA0, pA1, mrun, alA);
        AT_SWRITE(bn);
        AT_RESC(alA); __syncthreads(); AT_ROT();
    }
    SBAR(); at_qkt<DQK, QL>(pB0, pB1, kb0 + bc * KBUF, qf, qb); AT_MASK(pB0, pB1, NT - 1);
    at_fsm(pA0, pA1, alA, lrun, pa); SBAR();
    at_pv<DV>(o, vb0 + bp * VBUF, pa); at_psm(pB0, pB1, mrun, alB);
    AT_RESC(alB);
    at_fsm(pB0, pB1, alB, lrun, pa); SBAR();
    at_pv<DV>(o, vb0 + bc * VBUF, pa);
#undef AT_ROT
    pfacc ^= pfv;
    if (__builtin_expect(pfacc == 0x9e3779b9u && lrun == 12345.678f, 0)) scw[0] = 1.f;
#undef AT_GLOAD
#undef AT_PF
#undef AT_SWRITE
#undef AT_MASK
#undef AT_RESC
    { const float lt = lrun + __shfl_xor(lrun, 32); at_scale_o<DV>(o, scw, 1.0f / lt, r32, hi); }
#pragma unroll
    for (int db = 0; db < DV / 32; ++db)
#pragma unroll
        for (int r = 0; r < 16; ++r) {
            const int q = (r & 3) + 8 * (r >> 2) + 4 * hi;
            if (OUTM == 0) { bf16_t* p = Og + (size_t)(32 * wid + q) * ldo + 32 * db + r32; const float z = __uint_as_float((unsigned)(*p) << 16); *p = (bf16_t)(pk2(o[db][r] * silu_f(z), 0.f) & 0xffffu); }
            else if (OUTM == 1) { Of[(size_t)(32 * wid + q) * ldof + 32 * db + r32] = o[db][r]; }
            else { if (lrun == 12345.678f) Of[(size_t)(32 * wid + q) * ldof + 32 * db + r32] = o[db][r]; }
        }
    __syncthreads();
}

struct Args { const float* in[21]; float* out; unsigned char* ws; };
typedef const __attribute__((address_space(4))) Args* ArgsP;
DI ArgsP args_ptr() { ArgsP p = (ArgsP)__builtin_amdgcn_kernarg_segment_ptr(); asm volatile("" : "+s"(p)); return p; }
enum { I_X = 0, I_C, I_CTX, I_CCTX, I_WMOD, I_BMOD, I_NORMG, I_WIN, I_QNORM, I_WUQ, I_KVNORM, I_WUKV, I_LQ1, I_LK1, I_LQ2, I_LK2, I_SUBLN, I_SINK, I_WBR, I_WOUT, I_FNORM };

DI int colmap(int kind, int n) {
    if (kind == 1) {
        if (n < C_KR) return n;
        if (n < C_KR + 32) { const int e = n - C_KR; return C_KR + (e >> 1) + 16 * (e & 1); }
        if (n < C_DQ) return -1;
        if ((n >= C_DQ && n < C_DV) || (n >= C_SQ && n < C_SV)) { const int w = n & 63; return (n - w) - 96 + (w >> 1) + 32 * (w & 1); }
        return n - 96;
    }
    if (kind == 2) { const int h = n / 96, e = n % 96; if (e < 64) return n; const int e2 = e - 64; return h * 96 + 64 + (e2 >> 1) + 16 * (e2 & 1); }
    if (kind == 3) { if (n < 512) return (n >> 6) * 192 + (n & 63); const int n2 = n - 512; return (n2 >> 7) * 192 + 64 + (n2 & 127); }
    return n;
}
DI void transpose_item(const float* W, int ldw, int kind, const float* rowscale, bf16_t* WT, int ldd, int koff, LAS float* scr, int item, int nblk, int lane) {
    const int kb = item / nblk, nb = item % nblk, k0 = 64 * kb, n0 = 32 * nb;
    const int oc = colmap(kind, n0 + (lane & 31));
#pragma unroll 8
    for (int i = 0; i < 32; ++i) { const int kk = 2 * i + (lane >> 5); float v = 0.f; if (oc >= 0) v = W[(size_t)(k0 + kk) * ldw + oc]; if (rowscale) v *= rowscale[k0 + kk]; scr[kk * 33 + (lane & 31)] = v; }
    __builtin_amdgcn_wave_barrier(); asm volatile("s_waitcnt lgkmcnt(0)" ::: "memory");
    const int c = lane & 7;
#pragma unroll
    for (int j = 0; j < 4; ++j) { const int n = (lane >> 3) + 8 * j; const LAS float* s = scr + (8 * c) * 33 + n;
        u32x4 o; o.x = pk2(s[0 * 33], s[1 * 33]); o.y = pk2(s[2 * 33], s[3 * 33]); o.z = pk2(s[4 * 33], s[5 * 33]); o.w = pk2(s[6 * 33], s[7 * 33]);
        *(u32x4*)(WT + (size_t)(n0 + n) * ldd + koff + k0 + 8 * c) = o; }
    __builtin_amdgcn_wave_barrier(); asm volatile("s_waitcnt lgkmcnt(0)" ::: "memory");
}
DI void prologue(ArgsP ap, LAS unsigned char* lds) {
    const int tid = tid_l(), lane = tid & 63, wid = __builtin_amdgcn_readfirstlane(tid >> 6);
    unsigned char* ws = ap->ws;
    LAS float* scr = (LAS float*)(lds + wid * 8448);
    const int gw = bid_l() * 8 + wid, NGW = grd_l() * 8;
    constexpr int I_IN = 16 * (NP / 32), I_UQ = 6 * 24, I_UKV = 4 * 48, I_SQ = 16 * 32, PER_L = I_IN + I_UQ + I_UKV + 6 * I_SQ;
    for (int it = gw; it < 2 * PER_L; it += NGW) {
        const int l = it / PER_L; int r = it % PER_L;
        if (r < I_IN) { transpose_item(ap->in[I_WIN] + (size_t)l * 1024 * D_IN, D_IN, 1, nullptr, (bf16_t*)(ws + WS_WIN) + (size_t)l * NP * 1024, 1024, 0, scr, r, NP / 32, lane); continue; } r -= I_IN;
        if (r < I_UQ) { transpose_item(ap->in[I_WUQ] + (size_t)l * 384 * 768, 768, 2, ap->in[I_QNORM] + l * 384, (bf16_t*)(ws + WS_WUQ) + (size_t)l * 768 * 384, 384, 0, scr, r, 24, lane); continue; } r -= I_UQ;
        if (r < I_UKV) { transpose_item(ap->in[I_WUKV] + (size_t)l * 256 * 1536, 1536, 3, ap->in[I_KVNORM] + l * 256, (bf16_t*)(ws + WS_WUKV) + (size_t)l * 1536 * 256, 256, 0, scr, r, 48, lane); continue; } r -= I_UKV;
        if (r < 3 * I_SQ) { const int br = r / I_SQ; transpose_item(ap->in[I_WBR] + ((size_t)l * 3 + br) * 1024 * 1024, 1024, 0, nullptr, (bf16_t*)(ws + WS_WB) + ((size_t)l * 3 + br) * 1024 * 1024, 1024, 0, scr, r % I_SQ, 32, lane); continue; } r -= 3 * I_SQ;
        { const int rep = r / I_SQ; transpose_item(ap->in[I_WOUT] + (size_t)l * 1024 * 1024, 1024, 0, nullptr, (bf16_t*)(ws + WS_WO3) + (size_t)l * 1024 * 3072, 3072, rep * 1024, scr, r % I_SQ, 32, lane); }
    }
    const int gt = bid_l() * 512 + tid, NGT = grd_l() * 512;
    for (int i = gt; i < SEQ * 48; i += NGT) {
        const int pos = i / 48, p = i % 48; const float frow = (float)(pos >> 6), fcol = (float)(pos & 63);
        float ang; float* cd; float* sd;
        if (p < 32) { const int f = p & 15; const float inv = powf(10000.0f, -(float)f / 16.0f); ang = (p < 16 ? frow : fcol) * inv; cd = (float*)(ws + WS_COSH) + pos * 32 + p; sd = (float*)(ws + WS_SINH) + pos * 32 + p; }
        else { const int pp = p - 32, f = pp & 7; const float inv = powf(10000.0f, -(float)f / 8.0f); ang = (pp < 8 ? frow : fcol) * inv; cd = (float*)(ws + WS_COSM) + pos * 16 + pp; sd = (float*)(ws + WS_SINM) + pos * 16 + pp; }
        *cd = __cosf(ang); *sd = __sinf(ang);
    }
    for (int it = gw; it < 2 * 16 * 48; it += NGW) {
        const int l = it / 768, rem = it % 768, kc = rem / 48, nb = rem % 48; const int k = kc * 64 + lane;
        float sv[9];
#pragma unroll
        for (int v = 0; v < 8; ++v) sv[v] = silu_f(ap->in[I_C][v * 1024 + k]);
        sv[8] = silu_f(ap->in[I_CCTX][k]);
        float acc[9];
#pragma unroll
        for (int v = 0; v < 9; ++v) acc[v] = 0.f;
        const float* w = ap->in[I_WMOD] + ((size_t)l * 1024 + kc * 64) * 3072 + nb * 64 + lane;
#pragma unroll 8
        for (int kk = 0; kk < 64; ++kk) { const float wv = w[(size_t)kk * 3072];
#pragma unroll
            for (int v = 0; v < 9; ++v) acc[v] += __uint_as_float(__builtin_amdgcn_readlane(__float_as_uint(sv[v]), kk)) * wv; }
        float* mp = (float*)(ws + WS_MODP) + ((size_t)(l * 16 + kc) * 9) * 3072 + nb * 64 + lane;
#pragma unroll
        for (int v = 0; v < 9; ++v) mp[(size_t)v * 3072] = acc[v];
    }
}
DI void mod_finalize(ArgsP ap) {
    const int tid = tid_l();
    const int gt = bid_l() * 512 + tid, NGT = grd_l() * 512;
    const float* mp = (const float*)(ap->ws + WS_MODP); float* mod = (float*)(ap->ws + WS_MOD);
    for (int i = gt; i < 2 * 9 * 3072; i += NGT) {
        const int l = i / (9 * 3072), rem = i % (9 * 3072), n = rem % 3072;
        float s = ap->in[I_BMOD][l * 3072 + n];
#pragma unroll
        for (int kc = 0; kc < 16; ++kc) s += mp[(size_t)(l * 16 + kc) * 9 * 3072 + rem];
        mod[i] = s;
    }
}
DI void ph_norm_mod(ArgsP ap, int l, int g) {
    const int tid = tid_l(), lane = tid & 63, wid = __builtin_amdgcn_readfirstlane(tid >> 6);
    const int gw = bid_l() * 8 + wid, NGW = grd_l() * 8;
    const float* ng = ap->in[I_NORMG] + l * 1024; const float* mod = (const float*)(ap->ws + WS_MOD) + (size_t)l * 9 * 3072;
    const float* xs = (l == 0) ? ap->in[I_X] : ap->out; const float* cs = (l == 0) ? ap->in[I_CTX] : (const float*)(ap->ws + WS_CTX);
    bf16_t* H = (bf16_t*)(ap->ws + WS_H);
    for (int r = gw; r < R; r += NGW) {
        const int bl = r / RB, j = r % RB, b = g * GB + bl;
        const float* src; const float* md;
        if (j < CTX) { src = cs + ((size_t)b * CTX + j) * DM; md = mod + 8 * 3072; } else { src = xs + ((size_t)b * SEQ + (j - CTX)) * DM; md = mod + (size_t)b * 3072; }
        f32x4 v[4]; float ss = 0.f;
#pragma unroll
        for (int q = 0; q < 4; ++q) { v[q] = *(const f32x4*)(src + 4 * (lane + 64 * q)); ss += (v[q][0] * v[q][0] + v[q][1] * v[q][1]) + (v[q][2] * v[q][2] + v[q][3] * v[q][3]); }
        const float rstd = 1.0f / sqrtf(wave_sum(ss) * (1.0f / DM) + EPS);
#pragma unroll
        for (int q = 0; q < 4; ++q) { const int idx = 4 * (lane + 64 * q);
            const f32x4 gg = *(const f32x4*)(ng + idx), sh = *(const f32x4*)(md + idx), sc = *(const f32x4*)(md + 1024 + idx);
            const f32x4 y = (v[q] * rstd * gg) * (sc + 1.0f) + sh;
            u32x2 w; w.x = pk2(y[0], y[1]); w.y = pk2(y[2], y[3]); *(u32x2*)(H + (size_t)r * DM + idx) = w; }
    }
}
DI void ph_mla_norm(ArgsP ap) {
    const int tid = tid_l(), lane = tid & 63, wid = __builtin_amdgcn_readfirstlane(tid >> 6);
    const int gw = bid_l() * 8 + wid, NGW = grd_l() * 8;
    const bf16_t* P = (const bf16_t*)(ap->ws + WS_P); bf16_t* AQ = (bf16_t*)(ap->ws + WS_AQ); bf16_t* AKV = (bf16_t*)(ap->ws + WS_AKV); bf16_t* KM = (bf16_t*)(ap->ws + WS_KM);
    for (int r = gw; r < R; r += NGW) {
        const bf16_t* row = P + (size_t)r * NP;
        const u32x4 c0 = *(const u32x4*)(row + 8 * lane);
        u32x4 c1 = {0u, 0u, 0u, 0u}; if (lane < 20) c1 = *(const u32x4*)(row + 8 * (64 + lane));
        float f0[8] = {bflo(c0.x), bfhi(c0.x), bflo(c0.y), bfhi(c0.y), bflo(c0.z), bfhi(c0.z), bflo(c0.w), bfhi(c0.w)};
        float f1[8] = {bflo(c1.x), bfhi(c1.x), bflo(c1.y), bfhi(c1.y), bflo(c1.z), bfhi(c1.z), bflo(c1.w), bfhi(c1.w)};
        float s0 = 0.f, s1 = 0.f;
#pragma unroll
        for (int i = 0; i < 8; ++i) { s0 += f0[i] * f0[i]; s1 += f1[i] * f1[i]; }
        const float sq = wave_sum(lane < 48 ? s0 : 0.f);
        const float skv = wave_sum((lane >= 48 ? s0 : 0.f) + (lane < 16 ? s1 : 0.f));
        const float rq = 1.0f / sqrtf(sq * (1.0f / 384.0f) + EPS), rkv = 1.0f / sqrtf(skv * (1.0f / 256.0f) + EPS);
        { const float rr = lane < 48 ? rq : rkv; u32x4 w; w.x = pk2(f0[0] * rr, f0[1] * rr); w.y = pk2(f0[2] * rr, f0[3] * rr); w.z = pk2(f0[4] * rr, f0[5] * rr); w.w = pk2(f0[6] * rr, f0[7] * rr);
          if (lane < 48) *(u32x4*)(AQ + (size_t)r * 384 + 8 * lane) = w; else *(u32x4*)(AKV + (size_t)r * 256 + 8 * (lane - 48)) = w; }
        if (lane < 16) { u32x4 w; w.x = pk2(f1[0] * rkv, f1[1] * rkv); w.y = pk2(f1[2] * rkv, f1[3] * rkv); w.z = pk2(f1[4] * rkv, f1[5] * rkv); w.w = pk2(f1[6] * rkv, f1[7] * rkv);
            *(u32x4*)(AKV + (size_t)r * 256 + 8 * (16 + lane)) = w; }
        else if (lane < 20) {
#pragma unroll
            for (int h = 0; h < 8; ++h) *(u32x4*)(KM + (size_t)r * 768 + h * 96 + 64 + 8 * (lane - 16)) = c1; }
    }
}
DI void ph_diff_post(ArgsP ap, int l) {
    const int tid = tid_l(), lane = tid & 63, wid = __builtin_amdgcn_readfirstlane(tid >> 6);
    const int gw = bid_l() * 8 + wid, NGW = grd_l() * 8;
    const float lam_init = (l == 0) ? 0.2f : (0.8f - 0.6f * 0.7408182206817179f);
    const float d1 = wave_sum(ap->in[I_LQ1][l * 64 + lane] * ap->in[I_LK1][l * 64 + lane]), d2 = wave_sum(ap->in[I_LQ2][l * 64 + lane] * ap->in[I_LK2][l * 64 + lane]);
    const float lam = expf(d1) - expf(d2) + lam_init;
    const float sl0 = ap->in[I_SUBLN][l * 128 + 2 * lane] * (1.0f - lam_init), sl1 = ap->in[I_SUBLN][l * 128 + 2 * lane + 1] * (1.0f - lam_init);
    const float* OD = (const float*)(ap->ws + WS_OD); bf16_t* P = (bf16_t*)(ap->ws + WS_P);
    for (int it = gw; it < R * 8; it += NGW) {
        const int r = it >> 3, h = it & 7;
        if (l != 0 && (r % RB) < CTX) continue;
        const float* o1 = OD + (size_t)r * 2048 + (2 * h) * 128 + 2 * lane; const float* o2 = o1 + 128;
        const float a0 = o1[0] - lam * o2[0], a1 = o1[1] - lam * o2[1];
        const float rstd = 1.0f / sqrtf(wave_sum(a0 * a0 + a1 * a1) * (1.0f / 128.0f) + EPS);
        unsigned* zp = (unsigned*)(P + (size_t)r * NP + C_Z + 1024 + h * 128 + 2 * lane); const unsigned z = *zp;
        *zp = pk2(a0 * rstd * sl0 * silu_f(bflo(z)), a1 * rstd * sl1 * silu_f(bfhi(z)));
    }
}
DI void ph_final_norm(ArgsP ap) {
    const int tid = tid_l(), lane = tid & 63, wid = __builtin_amdgcn_readfirstlane(tid >> 6);
    const int gw = bid_l() * 8 + wid, NGW = grd_l() * 8; const float* fg = ap->in[I_FNORM];
    for (int r = gw; r < NBATCH * SEQ; r += NGW) {
        float* row = ap->out + (size_t)r * DM; f32x4 v[4]; float ss = 0.f;
#pragma unroll
        for (int q = 0; q < 4; ++q) { v[q] = *(const f32x4*)(row + 4 * (lane + 64 * q)); ss += (v[q][0] * v[q][0] + v[q][1] * v[q][1]) + (v[q][2] * v[q][2] + v[q][3] * v[q][3]); }
        const float rstd = 1.0f / sqrtf(wave_sum(ss) * (1.0f / DM) + EPS);
#pragma unroll
        for (int q = 0; q < 4; ++q) { const int idx = 4 * (lane + 64 * q); *(f32x4*)(row + idx) = v[q] * rstd * *(const f32x4*)(fg + idx); }
    }
}
template <bool DRY>
DI void ph_attention(ArgsP ap, int l, LAS unsigned char* lds) {
    constexpr int OM0 = DRY ? 2 : 0;
    const int G = grd_l(), bx = bid_l(), vcu = (G % 8 == 0) ? (bx % 8) * (G / 8) + bx / 8 : bx;
    bf16_t* P = (bf16_t*)(ap->ws + WS_P); const bf16_t* QM = (const bf16_t*)(ap->ws + WS_QM); const bf16_t* KM = (const bf16_t*)(ap->ws + WS_KM); const bf16_t* VM = (const bf16_t*)(ap->ws + WS_VM);
    float* OD = (float*)(ap->ws + WS_OD); const float* sink = ap->in[I_SINK] + l * 16;
#if !defined(ATT_ONLY) || ATT_ONLY == 1
    for (int u = vcu; u < GB * 8 * 32; u += G) { const int bh = u >> 5, qb = u & 31, bl = bh >> 3, h = bh & 7; const size_t rb = (size_t)bl * RB, q0 = rb + CTX + 256 * qb;
        attn_unit<96, 128, OM0, false>(lds, QM + q0 * 768 + h * 96, 768, KM + rb * 768 + h * 96, 768, VM + rb * 1024 + h * 128, 1024, RB / 64, 0, 0, 0, 0, NEGBIG, 0.f, P + q0 * NP + C_Z + h * 128, NP, OD, 0); }
#endif
#if !defined(ATT_ONLY) || ATT_ONLY == 2
    for (int u = vcu; u < GB * 16 * 32; u += G) { const int bh = u >> 5, qb = u & 31, bl = bh >> 4, hm = bh & 15; const size_t rb = (size_t)bl * RB, q0 = rb + CTX + 256 * qb;
        attn_unit<64, 128, 1, false>(lds, P + q0 * NP + C_DQ + hm * 64, NP, P + rb * NP + C_DK + hm * 64, NP, P + rb * NP + C_DV + (hm >> 1) * 128, NP, RB / 64, 0, 0, 0, 0, NEGBIG, 0.f, nullptr, 0, OD + q0 * 2048 + hm * 128, 2048); }
#endif
#if !defined(ATT_ONLY) || ATT_ONLY == 3
    for (int u = vcu; u < GB * 16 * 32; u += G) { const int bh = u >> 5, qb = u & 31, bl = bh >> 4, h = bh & 15; const size_t rb = (size_t)bl * RB, q0 = rb + CTX + 256 * qb;
        const int lo = (256 * qb - 128 < 0) ? 0 : 256 * qb - 128, hi = (256 * qb + 384 > SEQ) ? SEQ : 256 * qb + 384;
        attn_unit<64, 64, OM0, true>(lds, P + q0 * NP + C_SQ + h * 64, NP, P + rb * NP + C_SK + (h >> 2) * 64, NP, P + rb * NP + C_SV + (h >> 2) * 64, NP, CTX / 64, CTX + lo, (hi - lo) / 64, lo, 256 * qb, sink[h] * LOG2E, 1.0f,
                              P + q0 * NP + C_Z + 2048 + h * 64, NP, OD, 0); }
#endif
#if !defined(ATT_ONLY)
    if (l == 0) {
        for (int u = vcu; u < GB * 40; u += G) { const int bl = u / 40, k = u % 40; const size_t rb = (size_t)bl * RB;
            if (k < 8) { const int h = k;
                attn_unit<96, 128, OM0, false>(lds, QM + rb * 768 + h * 96, 768, KM + rb * 768 + h * 96, 768, VM + rb * 1024 + h * 128, 1024, CTX / 64, 0, 0, 0, 0, NEGBIG, 0.f, P + rb * NP + C_Z + h * 128, NP, OD, 0); }
            else if (k < 24) { const int hm = k - 8;
                attn_unit<64, 128, 1, false>(lds, P + rb * NP + C_DQ + hm * 64, NP, P + rb * NP + C_DK + hm * 64, NP, P + rb * NP + C_DV + (hm >> 1) * 128, NP, CTX / 64, 0, 0, 0, 0, NEGBIG, 0.f, nullptr, 0, OD + rb * 2048 + hm * 128, 2048); }
            else { const int h = k - 24;
                attn_unit<64, 64, OM0, false>(lds, P + rb * NP + C_SQ + h * 64, NP, P + rb * NP + C_SK + (h >> 2) * 64, NP, P + rb * NP + C_SV + (h >> 2) * 64, NP, CTX / 64, 0, 0, 0, 0, sink[h] * LOG2E, 1.0f, P + rb * NP + C_Z + 2048 + h * 64, NP, OD, 0); }
        }
    }
#endif
}

__global__ void __launch_bounds__(512, 2) hybrid_fwd(Args a_unused) {
    extern __shared__ __attribute__((aligned(16))) unsigned char lds_raw[];
    LAS unsigned char* lds = (LAS unsigned char*)lds_raw;
    cg::grid_group grid = cg::this_grid();
#ifndef NO_PRO
    prologue(args_ptr(), lds);
#endif
    grid.sync();
    mod_finalize(args_ptr());
    grid.sync();
    for (int l = 0; l < 2; ++l) {
        for (int g = 0; g < NGRP; ++g) {
            ph_norm_mod(args_ptr(), lnd(l), lnd(g));
            grid.sync();
#ifndef NO_GEMM
            {
                unsigned char* ws = args_ptr()->ws; const int G = grd_l(), bx = bid_l();
                pg8::Gemm gm{1024, 1024, 1024}; pg8::Order S; S.init(R, NP, G, bx, ws + WS_H, 1024, (bf16_t*)(ws + WS_WIN) + (size_t)l * NP * 1024, 1024, 1 << 20, 0);
                EpiIn E{ws};
                pg8::gemm_phase<EpiIn, pg8::Order, true, true>(lds, gm, S, E);
#ifdef PROBE_G1
                __syncthreads(); pg8::gemm_phase<EpiIn, pg8::Order, true, true>(lds, gm, S, E);
#endif
            }
#endif
            grid.sync();
            ph_mla_norm(args_ptr());
            grid.sync();
#ifndef NO_GEMM2
            {
                unsigned char* ws = args_ptr()->ws; const int G = grd_l(), bx = bid_l();
                pg8::Gemm gq{384, 384, 384}; pg8::Order Sq; Sq.init(R, 768, G, bx, ws + WS_AQ, 384, (bf16_t*)(ws + WS_WUQ) + (size_t)l * 768 * 384, 384, 1 << 20, 0);
                EpiQ Eq{ws};
#ifndef NO_GQ
                pg8::gemm_phase<EpiQ, pg8::Order, true, true>(lds, gq, Sq, Eq);
#endif
            }
            {
                unsigned char* ws = args_ptr()->ws; const int G = grd_l(), bx = bid_l();
                pg8::Gemm gk{256, 256, 256}; pg8::Order Sk; Sk.init(R, 1536, G, bx, ws + WS_AKV, 256, (bf16_t*)(ws + WS_WUKV) + (size_t)l * 1536 * 256, 256, 1 << 20, 0);
                EpiKV Ek{ws};
#ifndef NO_GK
                pg8::gemm_phase<EpiKV, pg8::Order, true, true>(lds, gk, Sk, Ek);
#endif
            }
#endif
            grid.sync();
#ifndef NO_ATT
#ifdef PROBE_ATT
            ph_attention<true>(args_ptr(), lnd(l), lds);
            grid.sync();
#endif
            ph_attention<false>(args_ptr(), lnd(l), lds);
#endif
            grid.sync();
            ph_diff_post(args_ptr(), lnd(l));
            grid.sync();
#ifndef NO_BR
            {
                unsigned char* ws = args_ptr()->ws; const int G = grd_l(), bx = bid_l();
                pg8::Gemm gb{1024, NP, 1024}; pg8::Order S; S.init(R, 3072, G, bx, (bf16_t*)(ws + WS_P) + C_Z, NP, (bf16_t*)(ws + WS_WB) + (size_t)l * 3 * 1024 * 1024, 1024, 4, 1024 * 2);
                EpiBr E{ws};
                pg8::gemm_phase<EpiBr, pg8::Order, true, true>(lds, gb, S, E);
            }
#endif
            grid.sync();
#ifndef NO_OUT
            {
                ArgsP ap = args_ptr(); unsigned char* ws = ap->ws; const int G = grd_l(), bx = bid_l();
                pg8::Gemm go{3072, NP, 3072}; pg8::Order S; S.init(R, 1024, G, bx, (bf16_t*)(ws + WS_P) + C_GM, NP, (bf16_t*)(ws + WS_WO3) + (size_t)l * 1024 * 3072, 3072, 1 << 20, 0);
                EpiOut E{l, g, (l == 0) ? ap->in[I_X] : (const float*)ap->out, ap->out, ap->in[I_CTX], ws};
                pg8::gemm_phase<EpiOut, pg8::Order, true, true>(lds, go, S, E);
            }
#endif
        }
        grid.sync();
    }
    ph_final_norm(args_ptr());
}

extern "C" void kernel_launch(void* const* d_in, const int* in_sizes, int n_in, void* d_out, int out_size, void* d_ws, size_t ws_size, hipStream_t stream) {
    static int grid = 0;
    if (grid == 0) {
        if (n_in != 21 || ws_size < WS_END) { fprintf(stderr, "kernel_launch: expected 21 inputs and >= %zu bytes of workspace (got %d, %zu)\n", (size_t)WS_END, n_in, ws_size); grid = -1; return; }
        int dev = 0, cus = 0, per_cu = 0;
        (void)hipGetDevice(&dev); (void)hipDeviceGetAttribute(&cus, hipDeviceAttributeMultiprocessorCount, dev);
        if (hipFuncSetAttribute((const void*)hybrid_fwd, hipFuncAttributeMaxDynamicSharedMemorySize, LDS_BYTES) != hipSuccess) fprintf(stderr, "kernel_launch: hipFuncSetAttribute failed\n");
        if (hipOccupancyMaxActiveBlocksPerMultiprocessor(&per_cu, (const void*)hybrid_fwd, 512, LDS_BYTES) != hipSuccess || per_cu < 1) { per_cu = 1; (void)hipGetLastError(); }
        if (cus <= 0) cus = 256;
        grid = cus * per_cu;
    }
    if (grid < 0) return;
    Args a{};
    for (int i = 0; i < 21; ++i) a.in[i] = (const float*)d_in[i];
    a.out = (float*)d_out; a.ws = (unsigned char*)d_ws;
    void* args[] = {&a};
    hipError_t e = hipLaunchCooperativeKernel((const void*)hybrid_fwd, dim3(grid), dim3(512), args, LDS_BYTES, stream);
    if (e != hipSuccess) fprintf(stderr, "kernel_launch: cooperative launch failed: %s (grid %d)\n", hipGetErrorString(e), grid);
}
```

```cpp
#define AT_PV8 1
#define AT_NOSBAR 1
#define AT_PV8 1
#define AT_NOSBAR 1
#include <hip/hip_runtime.h>
#include <hip/hip_cooperative_groups.h>
#include <cstdio>
#include <cstdint>
namespace cg = cooperative_groups;

#define DI __device__ __forceinline__
#define LAS __attribute__((address_space(3)))
__device__ __forceinline__ int tid_l() { int t = threadIdx.x; asm volatile("" : "+v"(t)); return t; }
__device__ __forceinline__ int bid_l() { int b = blockIdx.x; asm volatile("" : "+s"(b)); return b; }
__device__ __forceinline__ int lnd(int x) { asm volatile("" : "+s"(x)); return x; }
__device__ __forceinline__ int grd_l() { int g = gridDim.x; asm volatile("" : "+s"(g)); return g; }
typedef unsigned short bf16_t;
typedef short bf16x8 __attribute__((ext_vector_type(8)));
typedef short s16x4 __attribute__((ext_vector_type(4)));
typedef float f32x4 __attribute__((ext_vector_type(4)));
typedef float f32x16 __attribute__((ext_vector_type(16)));
typedef unsigned u32x4 __attribute__((ext_vector_type(4)));
typedef unsigned u32x2 __attribute__((ext_vector_type(2)));

constexpr int DM = 1024, NBATCH = 8, SEQ = 8192, CTX = 256, RB = CTX + SEQ;
constexpr int GB = 2, NGRP = NBATCH / GB, R = GB * RB;
constexpr int NP = 11520;
constexpr int C_QC = 0, C_KVC = 384, C_KR = 640, C_DQ = 768, C_DK = 1792, C_DV = 2816, C_SQ = 3840, C_SK = 4864, C_SV = 5120, C_Z = 5376, C_GM = 8448;
constexpr int D_IN = 11424;
constexpr float EPS = 1e-6f, LOG2E = 1.4426950408889634f;
constexpr float QS64 = 0.125f * LOG2E, QS96 = 0.10206207261596575f * LOG2E;
constexpr float NEGBIG = -1e30f, THR = 8.0f;

constexpr size_t al256(size_t x) { return (x + 255) & ~(size_t)255; }
constexpr size_t WS_WIN = 1u << 20;
constexpr size_t WS_WUQ = al256(WS_WIN + (size_t)2 * NP * 1024 * 2);
constexpr size_t WS_WUKV = al256(WS_WUQ + (size_t)2 * 768 * 384 * 2);
constexpr size_t WS_WB = al256(WS_WUKV + (size_t)2 * 1536 * 256 * 2);
constexpr size_t WS_WO3 = al256(WS_WB + (size_t)2 * 3 * 1024 * 1024 * 2);
constexpr size_t WS_COSH = al256(WS_WO3 + (size_t)2 * 1024 * 3072 * 2);
constexpr size_t WS_SINH = al256(WS_COSH + (size_t)SEQ * 32 * 4);
constexpr size_t WS_COSM = al256(WS_SINH + (size_t)SEQ * 32 * 4);
constexpr size_t WS_SINM = al256(WS_COSM + (size_t)SEQ * 16 * 4);
constexpr size_t WS_MODP = al256(WS_SINM + (size_t)SEQ * 16 * 4);
constexpr size_t WS_MOD = al256(WS_MODP + (size_t)16 * 2 * 9 * 3072 * 4);
constexpr size_t WS_CTX = al256(WS_MOD + (size_t)2 * 9 * 3072 * 4);
constexpr size_t WS_H = al256(WS_CTX + (size_t)NBATCH * CTX * DM * 4);
constexpr size_t WS_P = al256(WS_H + (size_t)R * DM * 2);
constexpr size_t WS_AQ = al256(WS_P + (size_t)R * NP * 2);
constexpr size_t WS_AKV = al256(WS_AQ + (size_t)R * 384 * 2);
constexpr size_t WS_QM = al256(WS_AKV + (size_t)R * 256 * 2);
constexpr size_t WS_KM = al256(WS_QM + (size_t)R * 768 * 2);
constexpr size_t WS_VM = al256(WS_KM + (size_t)R * 768 * 2);
constexpr size_t WS_OD = al256(WS_VM + (size_t)R * 1024 * 2);
constexpr size_t WS_END = al256(WS_OD + (size_t)R * 2048 * 4);
static_assert(WS_END <= ((size_t)1 << 30), "workspace map exceeds 1 GiB");

constexpr int LDS_BYTES = 155648, XB_LDS_OFF = 155136;

DI unsigned pk2(float lo, float hi) { typedef float f2_t __attribute__((ext_vector_type(2))); typedef __bf16 b2_t __attribute__((ext_vector_type(2)));
    f2_t v = {lo, hi}; b2_t b = __builtin_convertvector(v, b2_t); return __builtin_bit_cast(unsigned, b); }
DI u32x4 pack8(f32x4 a, f32x4 b) { u32x4 w; w.x = pk2(a[0], a[1]); w.y = pk2(a[2], a[3]); w.z = pk2(b[0], b[1]); w.w = pk2(b[2], b[3]); return w; }
DI float bflo(unsigned w) { return __uint_as_float(w << 16); }
DI float bfhi(unsigned w) { return __uint_as_float(w & 0xffff0000u); }
DI float wave_sum(float v) {
#pragma unroll
    for (int o = 1; o < 64; o <<= 1) v += __shfl_xor(v, o);
    return v; }
DI float silu_f(float z) { return z / (1.0f + __expf(-z)); }
DI float sigm_f(float z) { return 1.0f / (1.0f + __expf(-z)); }
DI void rope8(f32x4& v0, f32x4& v1, const f32x4 cs, const f32x4 sn) {
    float a, b;
    a = v0[0]; b = v0[1]; v0[0] = a * cs[0] - b * sn[0]; v0[1] = b * cs[0] + a * sn[0];
    a = v0[2]; b = v0[3]; v0[2] = a * cs[1] - b * sn[1]; v0[3] = b * cs[1] + a * sn[1];
    a = v1[0]; b = v1[1]; v1[0] = a * cs[2] - b * sn[2]; v1[1] = b * cs[2] + a * sn[2];
    a = v1[2]; b = v1[3]; v1[2] = a * cs[3] - b * sn[3]; v1[3] = b * cs[3] + a * sn[3];
}
namespace pg8 {
#define PG8_LAS __attribute__((address_space(3)))
typedef unsigned short bf16_t;
typedef short bf16x8 __attribute__((ext_vector_type(8)));
typedef float f32x4 __attribute__((ext_vector_type(4)));
typedef unsigned u32x4 __attribute__((ext_vector_type(4)));
constexpr int BM = 256, BK = 64, HALF = 128, HTB = HALF * BK * 2  , STAGE_BYTES = 8 * HTB, NXCD = 8, WGM = 8;

__host__ __device__ __forceinline__ int lds_byte(int r, int c) { const int st = (r >> 4) * 2 + (c >> 5), rr = r & 15, cc = c & 31, ob = rr * 64 + cc * 2; return st * 1024 + (ob ^ (((ob >> 9) & 1) << 5)); }
__host__ __device__ __forceinline__ void stage_rc(int b, int& R, int& C) { const int st = b / 1024, sb = b % 1024, swz = sb ^ (((sb >> 9) & 1) << 5); R = (st >> 1) * 16 + swz / 64; C = (st & 1) * 32 + (swz % 64) / 2; }
__host__ __device__ __forceinline__ int perm32(int rho) { const int n = rho >> 4, i = rho & 15; return 8 * (i >> 2) + 4 * n + (i & 3); }

struct Unit { int pm, pn; };
struct Gemm { int K, lda, ldb; };
struct Order {
    int nM, nN, nwg, G, c; const char* A; const char* B; unsigned tA, tB; int pnblk; unsigned ablk; int skipctx;
    __device__ __forceinline__ void init(int M, int N, int G_, int c_, const void* A_, int lda, const void* B_, int ldb, int pnblk_, unsigned ablk_, int skipctx_ = 0) {
        skipctx = skipctx_; nM = M / BM; if (skipctx) nM -= nM / 33;
        nN = N / BM; nwg = nM * nN; G = G_; c = c_; A = (const char*)A_; B = (const char*)B_; tA = (unsigned)(BM * lda * 2); tB = (unsigned)(BM * ldb * 2); pnblk = pnblk_; ablk = ablk_; }
    __device__ __forceinline__ bool next(int i, Unit& u) const {
        const long L = (long)i * G + c; if (L >= nwg) return false;
        int wgid = (int)L; { const int q = nwg / NXCD, r = nwg % NXCD, xcd = wgid % NXCD, off = wgid / NXCD; wgid = (xcd < r ? xcd * (q + 1) : r * (q + 1) + (xcd - r) * q) + off; }
        const int nig = WGM * nN, gid = wgid / nig, fm = gid * WGM, gsz = (nM - fm) < WGM ? (nM - fm) : WGM;
        u.pm = fm + ((wgid % nig) % gsz); u.pn = (wgid % nig) / gsz; if (skipctx) u.pm += u.pm / 32 + 1; return true;
    }
    __device__ __forceinline__ const char* a_base(const Unit& u) const { return A + (size_t)u.pm * tA + (size_t)(u.pn / pnblk) * ablk; }
    __device__ __forceinline__ const char* b_base(const Unit& u) const { return B + (size_t)u.pn * tB; }
};

template <class Epi, class Sched, bool ALIGN_EPI = false, bool SP2 = false>
__device__ __forceinline__ void gemm_phase(PG8_LAS unsigned char* lds, const Gemm g, const Sched& S, const Epi& E) {
    const int tid = tid_l(), wid = __builtin_amdgcn_readfirstlane(tid >> 6), lane = tid & 63, wr = wid >> 2, wc = wid & 3, fr = lane & 15, fq = lane >> 4;
    const int K = g.K, nt = K / BK;
    unsigned voffA[2], voffB[2];
#pragma unroll
    for (int i = 0; i < 2; ++i) { int R, C; stage_rc(tid * 16 + i * 8192, R, C); const int Rb = Epi::PERM ? ((R & ~31) + perm32(R & 31)) : R;
        voffA[i] = (unsigned)(R * g.lda + C) * 2u; voffB[i] = (unsigned)(Rb * g.ldb + C) * 2u; }
    const size_t kstep = (size_t)(BK * 2);
    const size_t hstepA = (size_t)HALF * g.lda * 2, hstepB = (size_t)HALF * g.ldb * 2;
    const unsigned ldsw = (unsigned)wid * 1024u;
    const int aoff = lds_byte(wr * 64 + fr, fq * 8), boff = lds_byte(wc * 32 + fr, fq * 8);
#define PG8_SA(b, h) (((b) * 2 + (h)) * HTB)
#define PG8_SB(b, h) ((4 + (b) * 2 + (h)) * HTB)
#define PG8_STAGE(bufoff, gbase, voff) do { _Pragma("unroll") for (int _i = 0; _i < 2; ++_i) \
        __builtin_amdgcn_global_load_lds((const unsigned*)((const char*)(gbase) + (voff)[_i]), (PG8_LAS unsigned*)(lds + (bufoff) + ldsw + _i * 8192), 16, 0, 0); } while (0)
#define PG8_LDA(dst, b, h) do { _Pragma("unroll") for (int m = 0; m < 4; ++m) _Pragma("unroll") for (int k = 0; k < 2; ++k) dst[m][k] = *(const PG8_LAS bf16x8*)(lds + PG8_SA(b, h) + aoff + m * 2048 + k * 1024); } while (0)
#define PG8_LDB(dst, b, h) do { _Pragma("unroll") for (int n = 0; n < 2; ++n) _Pragma("unroll") for (int k = 0; k < 2; ++k) dst[n][k] = *(const PG8_LAS bf16x8*)(lds + PG8_SB(b, h) + boff + n * 2048 + k * 1024); } while (0)
#define PG8_MMA(ai, bj, At, Bt) do { __builtin_amdgcn_s_setprio(1); _Pragma("unroll") for (int m = 0; m < 4; ++m) _Pragma("unroll") for (int n = 0; n < 2; ++n) _Pragma("unroll") for (int k = 0; k < 2; ++k) \
        acc[ai][bj][m][n] = __builtin_amdgcn_mfma_f32_16x16x32_bf16(Bt[n][k], At[m][k], acc[ai][bj][m][n], 0, 0, 0); __builtin_amdgcn_s_setprio(0); } while (0)
#define PG8_WAIT_V(n) asm volatile("s_waitcnt vmcnt(" #n ")" ::: "memory")
#define PG8_WAIT_L(n) asm volatile("s_waitcnt lgkmcnt(" #n ")" ::: "memory")
#define PG8_BAR __builtin_amdgcn_s_barrier()
#define PG8_SCHED __builtin_amdgcn_sched_barrier(0)
    Unit cur, nxt; int ui = 0;
    if (!S.next(0, cur)) return;
    f32x4 acc[2][2][4][2];
#pragma unroll
    for (int a = 0; a < 2; ++a)
#pragma unroll
        for (int b = 0; b < 2; ++b)
#pragma unroll
            for (int m = 0; m < 4; ++m)
#pragma unroll
                for (int n = 0; n < 2; ++n) acc[a][b][m][n] = (f32x4){0.f, 0.f, 0.f, 0.f};
    bf16x8 At[4][2], B0[2][2], B1[2][2];
    const char* cA = S.a_base(cur); const char* cB = S.b_base(cur);

    if constexpr (SP2) {
        PG8_STAGE(PG8_SB(0, 0), cB, voffB); PG8_STAGE(PG8_SB(0, 1), cB + hstepB, voffB); PG8_STAGE(PG8_SA(0, 0), cA, voffA); PG8_STAGE(PG8_SA(0, 1), cA + hstepA, voffA);
        if (wr == 1) PG8_BAR;
        PG8_WAIT_V(2); PG8_BAR;
        PG8_STAGE(PG8_SB(1, 0), cB + kstep, voffB); PG8_STAGE(PG8_SA(1, 0), cA + kstep, voffA); PG8_STAGE(PG8_SB(1, 1), cB + hstepB + kstep, voffB);
        PG8_WAIT_V(6); PG8_BAR;
    } else {
        PG8_STAGE(PG8_SB(0, 0), cB, voffB); PG8_STAGE(PG8_SA(0, 0), cA, voffA); PG8_STAGE(PG8_SB(0, 1), cB + hstepB, voffB); PG8_STAGE(PG8_SA(0, 1), cA + hstepA, voffA);
        if (wr == 1) PG8_BAR;
        PG8_WAIT_V(4); PG8_BAR;
        PG8_STAGE(PG8_SB(1, 0), cB + kstep, voffB); PG8_STAGE(PG8_SA(1, 0), cA + kstep, voffA); PG8_STAGE(PG8_SB(1, 1), cB + hstepB + kstep, voffB);
        PG8_WAIT_V(6); PG8_BAR;
    }
    for (;;) {
        const bool has_next = S.next(ui + 1, nxt);
        const char* nA = has_next ? S.a_base(nxt) : cA; const char* nB = has_next ? S.b_base(nxt) : cB;
#pragma nounroll
        for (int t = 0; t < nt; t += 2) {
            const bool last = (t == nt - 2);
            const char* a1 = cA + (size_t)(t + 1) * kstep;
            const char* a2 = last ? nA : cA + (size_t)(t + 2) * kstep; const char* b2 = last ? nB : cB + (size_t)(t + 2) * kstep;
            const char* a3 = a2 + kstep; const char* b3 = b2 + kstep;

            if constexpr (SP2) {
            PG8_LDB(B0, 0, 0); PG8_LDB(B1, 0, 1); PG8_SCHED; PG8_LDA(At, 0, 0); PG8_STAGE(PG8_SA(1, 1), a1 + hstepA, voffA);
            PG8_WAIT_V(8); PG8_WAIT_L(0); PG8_BAR; PG8_MMA(0, 0, At, B0); PG8_MMA(0, 1, At, B1); PG8_BAR; PG8_SCHED;
            PG8_LDA(At, 0, 1); PG8_STAGE(PG8_SB(0, 0), b2, voffB); PG8_STAGE(PG8_SB(0, 1), b2 + hstepB, voffB); PG8_STAGE(PG8_SA(0, 0), a2, voffA);
            PG8_WAIT_V(8); PG8_WAIT_L(0); PG8_BAR; PG8_MMA(1, 0, At, B0); PG8_MMA(1, 1, At, B1); PG8_BAR; PG8_SCHED;
            PG8_LDB(B0, 1, 0); PG8_LDB(B1, 1, 1); PG8_SCHED; PG8_LDA(At, 1, 0); PG8_STAGE(PG8_SA(0, 1), a2 + hstepA, voffA);
            PG8_WAIT_V(8); PG8_WAIT_L(0); PG8_BAR; PG8_MMA(0, 0, At, B0); PG8_MMA(0, 1, At, B1); PG8_BAR; PG8_SCHED;
            PG8_LDA(At, 1, 1); PG8_STAGE(PG8_SB(1, 0), b3, voffB); PG8_STAGE(PG8_SB(1, 1), b3 + hstepB, voffB); PG8_STAGE(PG8_SA(1, 0), a3, voffA);
            PG8_WAIT_V(8); PG8_WAIT_L(0); PG8_BAR; PG8_MMA(1, 0, At, B0); PG8_MMA(1, 1, At, B1); PG8_BAR; PG8_SCHED;
            } else {
            PG8_LDB(B0, 0, 0); PG8_SCHED; PG8_LDA(At, 0, 0); PG8_STAGE(PG8_SA(1, 1), a1 + hstepA, voffA);
            PG8_WAIT_L(8); PG8_BAR; PG8_WAIT_L(0); PG8_MMA(0, 0, At, B0); PG8_BAR; PG8_SCHED;
            PG8_LDB(B1, 0, 1); PG8_STAGE(PG8_SB(0, 0), b2, voffB);
            PG8_BAR; PG8_WAIT_L(0); PG8_MMA(0, 1, At, B1); PG8_BAR;
            PG8_LDA(At, 0, 1); PG8_STAGE(PG8_SA(0, 0), a2, voffA);
            PG8_BAR; PG8_WAIT_L(0); PG8_MMA(1, 0, At, B0); PG8_BAR; PG8_SCHED;
            PG8_STAGE(PG8_SB(0, 1), b2 + hstepB, voffB);
            PG8_WAIT_V(6); PG8_BAR; PG8_MMA(1, 1, At, B1); PG8_BAR;
            PG8_LDB(B0, 1, 0); PG8_SCHED; PG8_LDA(At, 1, 0); PG8_STAGE(PG8_SA(0, 1), a2 + hstepA, voffA);
            PG8_WAIT_L(8); PG8_BAR; PG8_WAIT_L(0); PG8_MMA(0, 0, At, B0); PG8_BAR; PG8_SCHED;
            PG8_LDB(B1, 1, 1); PG8_STAGE(PG8_SB(1, 0), b3, voffB);
            PG8_BAR; PG8_WAIT_L(0); PG8_MMA(0, 1, At, B1); PG8_BAR;
            PG8_LDA(At, 1, 1); PG8_STAGE(PG8_SA(1, 0), a3, voffA);
            PG8_BAR; PG8_WAIT_L(0); PG8_MMA(1, 0, At, B0); PG8_BAR; PG8_SCHED;
            PG8_STAGE(PG8_SB(1, 1), b3 + hstepB, voffB);
            PG8_WAIT_V(6); PG8_BAR; PG8_MMA(1, 1, At, B1); PG8_BAR;
            }
        }
        if constexpr (ALIGN_EPI) { if (wr == 0) PG8_BAR; }
        if constexpr (!Epi::AFTER_DRAIN) { E(acc, cur, wr, wc, fr, fq); }
        if (!has_next) break;
#pragma unroll
        for (int a = 0; a < 2; ++a)
#pragma unroll
            for (int b = 0; b < 2; ++b)
#pragma unroll
                for (int m = 0; m < 4; ++m)
#pragma unroll
                    for (int n = 0; n < 2; ++n) acc[a][b][m][n] = (f32x4){0.f, 0.f, 0.f, 0.f};
        cur = nxt; cA = nA; cB = nB; ++ui;
        if constexpr (ALIGN_EPI) { if (wr == 1) PG8_BAR; }
    }
    PG8_WAIT_V(0);
    if constexpr (!ALIGN_EPI) { if (wr == 0) PG8_BAR; }
    PG8_BAR;
    if constexpr (Epi::AFTER_DRAIN) { E.fused(acc, cur, wr, wc, fr, fq, lds, wid, lane); }
#undef PG8_SA
#undef PG8_SB
#undef PG8_STAGE
#undef PG8_LDA
#undef PG8_LDB
#undef PG8_MMA
#undef PG8_WAIT_V
#undef PG8_WAIT_L
#undef PG8_BAR
#undef PG8_SCHED
}
}
struct EpiIn {
    static constexpr bool PERM = true, AFTER_DRAIN = false;
    unsigned char* ws;
    DI void operator()(const f32x4 (&acc)[2][2][4][2], const pg8::Unit& u, int wr, int wc, int fr, int fq) const {
        bf16_t* P = (bf16_t*)(ws + WS_P); const float* cosH = (const float*)(ws + WS_COSH); const float* sinH = (const float*)(ws + WS_SINH); const float* cosM = (const float*)(ws + WS_COSM); const float* sinM = (const float*)(ws + WS_SINM);
        const int pn = u.pn; const bool ctxt = (u.pm % 33) == 0;
        int mode = 0; float sc = 1.f;
        if ((pn >= 3 && pn <= 10) || (pn >= 15 && pn <= 19)) mode = 1;
        if (pn == 2) mode = 2;
        if ((pn >= 3 && pn <= 6) || (pn >= 15 && pn <= 18)) sc = QS64;
        if (ctxt) mode = 0;
        const int rowt = u.pm * 256 + wr * 64 + fr, colb = pn * 256 + wc * 32 + 8 * fq;
#pragma unroll
        for (int ai = 0; ai < 2; ++ai)
#pragma unroll
            for (int m = 0; m < 4; ++m) {
                const int row = rowt + ai * 128 + m * 16; const int pos = (row % RB) - CTX;
                bf16_t* rowp = P + (size_t)row * NP;
#pragma unroll
                for (int bj = 0; bj < 2; ++bj) {
                    const int col0 = colb + bj * 128;
                    f32x4 v0 = acc[ai][bj][m][0], v1 = acc[ai][bj][m][1];
                    if (mode == 1) { const int p0 = (col0 & 63) >> 1; const f32x4 cs = *(const f32x4*)(cosH + (size_t)pos * 32 + p0), sn = *(const f32x4*)(sinH + (size_t)pos * 32 + p0); rope8(v0, v1, cs, sn); }
                    else if (mode == 2 && col0 >= C_KR && col0 < C_KR + 32) { const int p0 = (col0 - C_KR) >> 1; const f32x4 cs = *(const f32x4*)(cosM + (size_t)pos * 16 + p0), sn = *(const f32x4*)(sinM + (size_t)pos * 16 + p0); rope8(v0, v1, cs, sn); }
                    v0 = v0 * sc; v1 = v1 * sc;
                    *(u32x4*)(rowp + col0) = pack8(v0, v1);
                }
            }
    }
};
struct EpiQ {
    static constexpr bool PERM = true, AFTER_DRAIN = false;
    unsigned char* ws;
    DI void operator()(const f32x4 (&acc)[2][2][4][2], const pg8::Unit& u, int wr, int wc, int fr, int fq) const {
        bf16_t* QM = (bf16_t*)(ws + WS_QM); const float* cosM = (const float*)(ws + WS_COSM); const float* sinM = (const float*)(ws + WS_SINM);
        const bool ctxt = (u.pm % 33) == 0;
        const int rowt = u.pm * 256 + wr * 64 + fr, colb = u.pn * 256 + wc * 32 + 8 * fq;
#pragma unroll
        for (int ai = 0; ai < 2; ++ai)
#pragma unroll
            for (int m = 0; m < 4; ++m) {
                const int row = rowt + ai * 128 + m * 16; const int pos = (row % RB) - CTX;
#pragma unroll
                for (int bj = 0; bj < 2; ++bj) {
                    const int col0 = colb + bj * 128, within = col0 % 96;
                    f32x4 v0 = acc[ai][bj][m][0], v1 = acc[ai][bj][m][1];
                    if (!ctxt && within >= 64) { const int p0 = (within - 64) >> 1; const f32x4 cs = *(const f32x4*)(cosM + (size_t)pos * 16 + p0), sn = *(const f32x4*)(sinM + (size_t)pos * 16 + p0); rope8(v0, v1, cs, sn); }
                    v0 = v0 * QS96; v1 = v1 * QS96;
                    *(u32x4*)(QM + (size_t)row * 768 + col0) = pack8(v0, v1);
                }
                asm volatile("" ::: "memory");
            }
    }
};
struct EpiKV {
    static constexpr bool PERM = true, AFTER_DRAIN = false;
    unsigned char* ws;
    DI void operator()(const f32x4 (&acc)[2][2][4][2], const pg8::Unit& u, int wr, int wc, int fr, int fq) const {
        bf16_t* KM = (bf16_t*)(ws + WS_KM); bf16_t* VM = (bf16_t*)(ws + WS_VM);
        const int rowt = u.pm * 256 + wr * 64 + fr, colb = u.pn * 256 + wc * 32 + 8 * fq;
#pragma unroll
        for (int ai = 0; ai < 2; ++ai)
#pragma unroll
            for (int m = 0; m < 4; ++m) {
                const int row = rowt + ai * 128 + m * 16;
#pragma unroll
                for (int bj = 0; bj < 2; ++bj) {
                    const int col0 = colb + bj * 128;
                    bf16_t* dst = (col0 < 512) ? KM + (size_t)row * 768 + (col0 >> 6) * 96 + (col0 & 63) : VM + (size_t)row * 1024 + (col0 - 512);
                    *(u32x4*)dst = pack8(acc[ai][bj][m][0], acc[ai][bj][m][1]);
                }
                asm volatile("" ::: "memory");
            }
    }
};
struct EpiBr {
    static constexpr bool PERM = true, AFTER_DRAIN = false;
    unsigned char* ws;
    DI void operator()(const f32x4 (&acc)[2][2][4][2], const pg8::Unit& u, int wr, int wc, int fr, int fq) const {
        bf16_t* P = (bf16_t*)(ws + WS_P);
        const int rowt = u.pm * 256 + wr * 64 + fr, colb = u.pn * 256 + wc * 32 + 8 * fq;
#pragma unroll
        for (int ai = 0; ai < 2; ++ai)
#pragma unroll
            for (int m = 0; m < 4; ++m) {
                const int row = rowt + ai * 128 + m * 16;
#pragma unroll
                for (int bj = 0; bj < 2; ++bj) {
                    bf16_t* p = P + (size_t)row * NP + C_GM + colb + bj * 128;
                    const u32x4 g = *(const u32x4*)p;
                    f32x4 v0 = acc[ai][bj][m][0], v1 = acc[ai][bj][m][1];
                    v0[0] *= sigm_f(bflo(g.x)); v0[1] *= sigm_f(bfhi(g.x)); v0[2] *= sigm_f(bflo(g.y)); v0[3] *= sigm_f(bfhi(g.y));
                    v1[0] *= sigm_f(bflo(g.z)); v1[1] *= sigm_f(bfhi(g.z)); v1[2] *= sigm_f(bflo(g.w)); v1[3] *= sigm_f(bfhi(g.w));
                    *(u32x4*)p = pack8(v0, v1);
                }
            }
    }
};
struct EpiOut {
    static constexpr bool PERM = true, AFTER_DRAIN = false;
    int l, g; const float* xsrc; float* xdst; const float* ctxsrc; unsigned char* ws;
    DI void operator()(const f32x4 (&acc)[2][2][4][2], const pg8::Unit& u, int wr, int wc, int fr, int fq) const {
        float* ctxdst = (float*)(ws + WS_CTX); const float* mod = (const float*)(ws + WS_MOD) + (size_t)l * 9 * 3072;
        const int pmb = u.pm % 33, b = g * GB + u.pm / 33; const bool ctxt = pmb == 0;
        if (ctxt && l != 0) return;
        const float* gate = mod + (size_t)(ctxt ? 8 : b) * 3072 + 2048;
        const int colb = u.pn * 256 + wc * 32 + 8 * fq;
#pragma unroll
        for (int ai = 0; ai < 2; ++ai)
#pragma unroll
            for (int m = 0; m < 4; ++m) {
                const int j = pmb * 256 + ai * 128 + wr * 64 + m * 16 + fr;
                const size_t idx = ctxt ? ((size_t)b * CTX + j) * DM : ((size_t)b * SEQ + (j - CTX)) * DM;
                const float* s = (ctxt ? ctxsrc : xsrc) + idx; float* d = (ctxt ? ctxdst : xdst) + idx;
#pragma unroll
                for (int bj = 0; bj < 2; ++bj) {
                    const int col0 = colb + bj * 128;
                    const f32x4 g0 = *(const f32x4*)(gate + col0), g1 = *(const f32x4*)(gate + col0 + 4);
                    const f32x4 x0 = *(const f32x4*)(s + col0), x1 = *(const f32x4*)(s + col0 + 4);
                    *(f32x4*)(d + col0) = x0 + g0 * acc[ai][bj][m][0];
                    *(f32x4*)(d + col0 + 4) = x1 + g1 * acc[ai][bj][m][1];
                }
            }
    }
};

#define MFMA32(a, b, c) __builtin_amdgcn_mfma_f32_32x32x16_bf16((a), (b), (c), 0, 0, 0)
DI s16x4 tr16(const LAS unsigned char* p) { typedef short v4i16_t __attribute__((ext_vector_type(4))); return __builtin_bit_cast(s16x4, __builtin_amdgcn_ds_read_tr16_b64_v4i16((LAS v4i16_t*)p)); }
constexpr int AT_KOFF = 0, AT_KBUFMAX = 13312, AT_VOFF = 3 * AT_KBUFMAX, AT_VBUFMAX = 20480, AT_SOFF = AT_VOFF + 3 * AT_VBUFMAX, AT_QOFF = AT_SOFF + 1024;
static_assert(AT_QOFF + 8 * 6144 <= LDS_BYTES, "attention LDS map");
#ifndef AT_PV8
#define AT_PV8 0
#endif
#ifndef AT_NOSBAR
#define AT_NOSBAR 0
#endif
#if AT_NOSBAR
#define SBAR() do {} while (0)
#else
#define SBAR() __builtin_amdgcn_sched_barrier(0)
#endif
#ifndef PROBE_MODE
#define PROBE_MODE 0
#endif
#ifndef AT_QL
#define AT_QL 1
#endif
#ifndef AT_SB
#define AT_SB 0
#endif
template <int DQK, bool QL>
DI void at_qkt(f32x16& p0, f32x16& p1, const LAS unsigned char* kb, const bf16x8* qf, const LAS unsigned char* qb) {
    constexpr int KSTR = DQK + 8;
#pragma unroll
    for (int r = 0; r < 16; ++r) { p0[r] = 0.f; p1[r] = 0.f; }
#pragma unroll
    for (int ds = 0; ds < DQK / 16; ++ds) {
        const bf16x8 k0 = *(const LAS bf16x8*)(kb + ds * 32), k1 = *(const LAS bf16x8*)(kb + 32 * (KSTR * 2) + ds * 32);
        bf16x8 q; if (QL) q = *(const LAS bf16x8*)(qb + ds * 1024); else q = qf[ds];
        p0 = MFMA32(k0, q, p0); p1 = MFMA32(k1, q, p1);
        if (AT_SB && DQK > 64 && (ds & 1)) __builtin_amdgcn_sched_barrier(0x7f); }
}
DI void at_mask(f32x16& p0, f32x16& p1, int dk) {
#pragma unroll
    for (int r = 0; r < 16; ++r) { const int d = dk + (r & 3) + 8 * (r >> 2);
        if (d > 128 || d < -128) p0[r] = NEGBIG;
        if (d + 32 > 128 || d + 32 < -128) p1[r] = NEGBIG; }
}
DI void at_psm(f32x16& p0, f32x16& p1, float& mrun, float& alpha) {
    float ma = fmaxf(fmaxf(p0[0], p0[1]), p0[2]), mb = fmaxf(fmaxf(p1[0], p1[1]), p1[2]);
    ma = fmaxf(fmaxf(ma, p0[3]), p1[3]);
#pragma unroll
    for (int r = 4; r < 16; r += 2) { ma = fmaxf(fmaxf(ma, p0[r]), p0[r + 1]); mb = fmaxf(fmaxf(mb, p1[r]), p1[r + 1]); }
    float mx = fmaxf(ma, mb);
    { auto rr = __builtin_amdgcn_permlane32_swap(__float_as_uint(mx), __float_as_uint(mx), false, false); mx = fmaxf(__uint_as_float(rr[0]), __uint_as_float(rr[1])); }
    const bool keep = __all(mx - mrun <= THR);
    const float mn = keep ? mrun : fmaxf(mrun, mx); alpha = __builtin_amdgcn_exp2f(mrun - mn); mrun = mn;
#pragma unroll
    for (int r = 0; r < 16; ++r) { p0[r] -= mrun; p1[r] -= mrun; }
#pragma unroll
    for (int r = 0; r < 16; ++r) p0[r] = __builtin_amdgcn_exp2f(p0[r]);
}
DI void at_fsm(f32x16& p0, f32x16& p1, float alpha, float& lrun, bf16x8* pa) {
#pragma unroll
    for (int r = 0; r < 16; ++r) p1[r] = __builtin_amdgcn_exp2f(p1[r]);
    float ps = 0.f;
#pragma unroll
    for (int r = 0; r < 16; ++r) ps += p0[r] + p1[r];
    lrun = lrun * alpha + ps;
    u32x4 w;
    w.x = pk2(p0[0], p0[1]); w.y = pk2(p0[2], p0[3]); w.z = pk2(p0[4], p0[5]); w.w = pk2(p0[6], p0[7]); pa[0] = __builtin_bit_cast(bf16x8, w);
    w.x = pk2(p0[8], p0[9]); w.y = pk2(p0[10], p0[11]); w.z = pk2(p0[12], p0[13]); w.w = pk2(p0[14], p0[15]); pa[1] = __builtin_bit_cast(bf16x8, w);
    w.x = pk2(p1[0], p1[1]); w.y = pk2(p1[2], p1[3]); w.z = pk2(p1[4], p1[5]); w.w = pk2(p1[6], p1[7]); pa[2] = __builtin_bit_cast(bf16x8, w);
    w.x = pk2(p1[8], p1[9]); w.y = pk2(p1[10], p1[11]); w.z = pk2(p1[12], p1[13]); w.w = pk2(p1[14], p1[15]); pa[3] = __builtin_bit_cast(bf16x8, w);
}
template <int DV>
DI void at_pv(f32x16* o, const LAS unsigned char* vb, const bf16x8* pa) {
    constexpr int VSTR = DV + 32;
#pragma unroll
    for (int db = 0; db < DV / 32; ++db) {
#if AT_PV8
        s16x4 vlo[4], vhi[4];
#pragma unroll
        for (int ks = 0; ks < 4; ++ks) { vlo[ks] = tr16(vb + (16 * ks) * (VSTR * 2) + db * 64); vhi[ks] = tr16(vb + (16 * ks + 8) * (VSTR * 2) + db * 64); }
#pragma unroll
        for (int ks = 0; ks < 4; ++ks) { const bf16x8 vf = __builtin_shufflevector(vlo[ks], vhi[ks], 0, 1, 2, 3, 4, 5, 6, 7); o[db] = MFMA32(pa[ks], vf, o[db]); }
#else
#pragma unroll
        for (int kh = 0; kh < 2; ++kh) {
            s16x4 vlo[2], vhi[2];
#pragma unroll
            for (int k2 = 0; k2 < 2; ++k2) { const int ks = 2 * kh + k2; vlo[k2] = tr16(vb + (16 * ks) * (VSTR * 2) + db * 64); vhi[k2] = tr16(vb + (16 * ks + 8) * (VSTR * 2) + db * 64); }
#pragma unroll
            for (int k2 = 0; k2 < 2; ++k2) { const bf16x8 vf = __builtin_shufflevector(vlo[k2], vhi[k2], 0, 1, 2, 3, 4, 5, 6, 7); o[db] = MFMA32(pa[2 * kh + k2], vf, o[db]); }
        }
#endif
    }
}
template <int DV>
DI void at_scale_o(f32x16* o, LAS float* scw, float val, int r32, int hi) {
    if (hi == 0) scw[r32] = val;
    __builtin_amdgcn_wave_barrier(); asm volatile("" ::: "memory");
#pragma unroll
    for (int g4 = 0; g4 < 4; ++g4) { const f32x4 a4 = *(const LAS f32x4*)(scw + 8 * g4 + 4 * hi);
#pragma unroll
        for (int db = 0; db < DV / 32; ++db) { o[db][4 * g4 + 0] *= a4[0]; o[db][4 * g4 + 1] *= a4[1]; o[db][4 * g4 + 2] *= a4[2]; o[db][4 * g4 + 3] *= a4[3]; } }
    __builtin_amdgcn_wave_barrier(); asm volatile("" ::: "memory");
}
template <int DQK, int DV, int OUTM, bool MASKED>
DI void attn_unit(LAS unsigned char* lds, const bf16_t* Qp, int ldq, const bf16_t* Kp, int ldk, const bf16_t* Vp, int ldv,
                  int nA, int rowB0, int nB, int posB0, int qpos0, float m0, float l0,
                  bf16_t* Og, int ldo, float* Of, int ldof) {
    constexpr int KSTR = DQK + 8, VSTR = DV + 32, KBUF = 64 * KSTR * 2, VBUF = 64 * VSTR * 2;
    constexpr int KCH = DQK / 8, VCH = DV / 8, NKC = 64 * KCH, NVC = 64 * VCH, KRN = (NKC + 511) / 512, VRN = (NVC + 511) / 512;
    static_assert(KBUF <= AT_KBUFMAX && VBUF <= AT_VBUFMAX, "attention LDS map");
    const int tid = tid_l(), lane = tid & 63, wid = __builtin_amdgcn_readfirstlane(tid >> 6), r32 = lane & 31, hi = lane >> 5;
#ifndef AT_QL
#define AT_QL 1
#endif
#ifndef AT_SB
#define AT_SB 0
#endif
    constexpr bool QL = AT_QL && (DQK > 64);
    bf16x8 qf[QL ? 1 : DQK / 16];
    const LAS unsigned char* qb = lds + AT_QOFF + wid * 6144 + lane * 16;
    { const bf16_t* qrow = Qp + (size_t)(32 * wid + r32) * ldq + 8 * hi;
#pragma unroll
      for (int ds = 0; ds < DQK / 16; ++ds) { const bf16x8 v = *(const bf16x8*)(qrow + 16 * ds); if (QL) *(LAS bf16x8*)(lds + AT_QOFF + wid * 6144 + lane * 16 + ds * 1024) = v; else qf[QL ? 0 : ds] = v; }
      if (QL) { __builtin_amdgcn_wave_barrier(); asm volatile("s_waitcnt lgkmcnt(0)" ::: "memory"); } }
    f32x16 o[DV / 32];
#pragma unroll
    for (int db = 0; db < DV / 32; ++db)
#pragma unroll
        for (int r = 0; r < 16; ++r) o[db][r] = 0.f;
    float mrun = m0, lrun = (hi == 0) ? l0 : 0.f;
    LAS float* scw = (LAS float*)(lds + AT_SOFF) + wid * 32;
    const int NT = nA + nB;
    const LAS unsigned char* kb0 = lds + AT_KOFF + r32 * (KSTR * 2) + hi * 16;
    const LAS unsigned char* vb0 = lds + AT_VOFF + (4 * hi + ((lane & 15) >> 2)) * (VSTR * 2) + (16 * ((lane >> 4) & 1) + 4 * (lane & 3)) * 2;
    const int dk0 = posB0 + 4 * hi - (qpos0 + 32 * wid + r32) - 64 * nA;
    u32x4 kreg[KRN], vreg[VRN];
    int kgo[KRN], klo[KRN], vgo[VRN], vlo_[VRN];
#pragma unroll
    for (int i_ = 0; i_ < KRN; ++i_) { int c_ = tid + 512 * i_; if (c_ >= NKC) c_ -= 512; const int r_ = c_ / KCH, cc_ = c_ % KCH; kgo[i_] = r_ * ldk + cc_ * 8; klo[i_] = AT_KOFF + r_ * (KSTR * 2) + cc_ * 16; }
#pragma unroll
    for (int i_ = 0; i_ < VRN; ++i_) { int c_ = tid + 512 * i_; if (c_ >= NVC) c_ -= 512; const int r_ = c_ / VCH, cc_ = c_ % VCH; vgo[i_] = r_ * ldv + cc_ * 8; vlo_[i_] = AT_VOFF + r_ * (VSTR * 2) + cc_ * 16; }
#define AT_GLOAD(t) do { const int row0_ = (t) < nA ? 64 * (t) : rowB0 + 64 * ((t) - nA); const bf16_t* kt_ = Kp + (size_t)row0_ * ldk; const bf16_t* vt_ = Vp + (size_t)row0_ * ldv; \
        _Pragma("unroll") for (int i_ = 0; i_ < KRN; ++i_) kreg[i_] = *(const u32x4*)(kt_ + kgo[i_]); \
        _Pragma("unroll") for (int i_ = 0; i_ < VRN; ++i_) vreg[i_] = *(const u32x4*)(vt_ + vgo[i_]); } while (0)
#define AT_SWRITE(buf) do { \
        _Pragma("unroll") for (int i_ = 0; i_ < KRN; ++i_) *(LAS u32x4*)(lds + (buf) * KBUF + klo[i_]) = kreg[i_]; \
        _Pragma("unroll") for (int i_ = 0; i_ < VRN; ++i_) *(LAS u32x4*)(lds + (buf) * VBUF + vlo_[i_]) = vreg[i_]; } while (0)
    unsigned pfv = 0u, pfacc = 0u;
    const int pft = tid & 255;
    const bf16_t* pfb = (pft < 128) ? Kp + (pft >> 1) * ldk + (pft & 1) * (DQK - 2) : Vp + ((pft - 128) >> 1) * ldv + (pft & 1) * (DV - 2);
    const int pfs = (pft < 128) ? ldk : ldv;
    constexpr int PFD = 4;
#define AT_PF(t) do { pfacc ^= pfv; const int tt_ = (t) < NT ? (t) : NT - 1; const int row0_ = tt_ < nA ? 64 * tt_ : rowB0 + 64 * (tt_ - nA); \
        pfv = *(const unsigned*)(pfb + (size_t)row0_ * pfs); } while (0)
#define AT_MASK(P0, P1, t) do { if (MASKED && (t) >= nA) at_mask(P0, P1, dk0 + 64 * (t)); } while (0)
#define AT_RESC(al) do { if (__any((al) < 1.f)) at_scale_o<DV>(o, scw, (al), r32, hi); } while (0)
    f32x16 pA0, pA1, pB0, pB1; float alA, alB; bf16x8 pa[4];
    AT_PF(1); AT_PF(2); AT_PF(3);
    AT_GLOAD(0); AT_SWRITE(0); __syncthreads();
    AT_GLOAD(1);
    at_qkt<DQK, QL>(pA0, pA1, kb0, qf, qb); AT_MASK(pA0, pA1, 0); at_psm(pA0, pA1, mrun, alA);
    AT_SWRITE(1); __syncthreads();
    int bp = 0, bc = 1, bn = 2;
#define AT_ROT() do { bp = bc; bc = bn; bn = (bn == 2) ? 0 : bn + 1; } while (0)
    for (int j = 1; j + 1 < NT; j += 2) {
        AT_GLOAD(j + 1); AT_PF(j + PFD);
        SBAR(); at_qkt<DQK, QL>(pB0, pB1, kb0 + bc * KBUF, qf, qb); AT_MASK(pB0, pB1, j);
        at_fsm(pA0, pA1, alA, lrun, pa); SBAR();
        at_pv<DV>(o, vb0 + bp * VBUF, pa); at_psm(pB0, pB1, mrun, alB);
        AT_SWRITE(bn);
        AT_RESC(alB); __syncthreads(); AT_ROT();
        AT_GLOAD(j + 2); AT_PF(j + 1 + PFD);
        SBAR(); at_qkt<DQK, QL>(pA0, pA1, kb0 + bc * KBUF, qf, qb); AT_MASK(pA0, pA1, j + 1);
        at_fsm(pB0, pB1, alB, lrun, pa); SBAR();
        at_pv<DV>(o, vb0 + bp * VBUF, pa); at_psm(pA0, pA1, mrun, alA);
        AT_SWRITE(bn);
        AT_RESC(alA); __syncthreads(); AT_ROT();
    }
    SBAR(); at_qkt<DQK, QL>(pB0, pB1, kb0 + bc * KBUF, qf, qb); AT_MASK(pB0, pB1, NT - 1);
    at_fsm(pA0, pA1, alA, lrun, pa); SBAR();
    at_pv<DV>(o, vb0 + bp * VBUF, pa); at_psm(pB0, pB1, mrun, alB);
    AT_RESC(alB);
    at_fsm(pB0, pB1, alB, lrun, pa); SBAR();
    at_pv<DV>(o, vb0 + bc * VBUF, pa);
#undef AT_ROT
    pfacc ^= pfv;
    if (__builtin_expect(pfacc == 0x9e3779b9u && lrun == 12345.678f, 0)) scw[0] = 1.f;
#undef AT_GLOAD
#undef AT_PF
#undef AT_SWRITE
#undef AT_MASK
#undef AT_RESC
    { const float lt = lrun + __shfl_xor(lrun, 32); at_scale_o<DV>(o, scw, 1.0f / lt, r32, hi); }
#pragma unroll
    for (int db = 0; db < DV / 32; ++db)
#pragma unroll
        for (int r = 0; r < 16; ++r) {
            const int q = (r & 3) + 8 * (r >> 2) + 4 * hi;
            if (OUTM == 0) { bf16_t* p = Og + (size_t)(32 * wid + q) * ldo + 32 * db + r32; const float z = __uint_as_float((unsigned)(*p) << 16); *p = (bf16_t)(pk2(o[db][r] * silu_f(z), 0.f) & 0xffffu); }
            else if (OUTM == 1) { Of[(size_t)(32 * wid + q) * ldof + 32 * db + r32] = o[db][r]; }
            else { if (lrun == 12345.678f) Of[(size_t)(32 * wid + q) * ldof + 32 * db + r32] = o[db][r]; }
        }
    __syncthreads();
}

struct Args { const float* in[21]; float* out; unsigned char* ws; };
typedef const __attribute__((address_space(4))) Args* ArgsP;
DI ArgsP args_ptr() { ArgsP p = (ArgsP)__builtin_amdgcn_kernarg_segment_ptr(); asm volatile("" : "+s"(p)); return p; }
enum { I_X = 0, I_C, I_CTX, I_CCTX, I_WMOD, I_BMOD, I_NORMG, I_WIN, I_QNORM, I_WUQ, I_KVNORM, I_WUKV, I_LQ1, I_LK1, I_LQ2, I_LK2, I_SUBLN, I_SINK, I_WBR, I_WOUT, I_FNORM };

DI int colmap(int kind, int n) {
    if (kind == 1) {
        if (n < C_KR) return n;
        if (n < C_KR + 32) { const int e = n - C_KR; return C_KR + (e >> 1) + 16 * (e & 1); }
        if (n < C_DQ) return -1;
        if ((n >= C_DQ && n < C_DV) || (n >= C_SQ && n < C_SV)) { const int w = n & 63; return (n - w) - 96 + (w >> 1) + 32 * (w & 1); }
        return n - 96;
    }
    if (kind == 2) { const int h = n / 96, e = n % 96; if (e < 64) return n; const int e2 = e - 64; return h * 96 + 64 + (e2 >> 1) + 16 * (e2 & 1); }
    if (kind == 3) { if (n < 512) return (n >> 6) * 192 + (n & 63); const int n2 = n - 512; return (n2 >> 7) * 192 + 64 + (n2 & 127); }
    return n;
}
DI void transpose_item(const float* W, int ldw, int kind, const float* rowscale, bf16_t* WT, int ldd, int koff, LAS float* scr, int item, int nblk, int lane) {
    const int kb = item / nblk, nb = item % nblk, k0 = 64 * kb, n0 = 32 * nb;
    const int oc = colmap(kind, n0 + (lane & 31));
#pragma unroll 8
    for (int i = 0; i < 32; ++i) { const int kk = 2 * i + (lane >> 5); float v = 0.f; if (oc >= 0) v = W[(size_t)(k0 + kk) * ldw + oc]; if (rowscale) v *= rowscale[k0 + kk]; scr[kk * 33 + (lane & 31)] = v; }
    __builtin_amdgcn_wave_barrier(); asm volatile("s_waitcnt lgkmcnt(0)" ::: "memory");
    const int c = lane & 7;
#pragma unroll
    for (int j = 0; j < 4; ++j) { const int n = (lane >> 3) + 8 * j; const LAS float* s = scr + (8 * c) * 33 + n;
        u32x4 o; o.x = pk2(s[0 * 33], s[1 * 33]); o.y = pk2(s[2 * 33], s[3 * 33]); o.z = pk2(s[4 * 33], s[5 * 33]); o.w = pk2(s[6 * 33], s[7 * 33]);
        *(u32x4*)(WT + (size_t)(n0 + n) * ldd + koff + k0 + 8 * c) = o; }
    __builtin_amdgcn_wave_barrier(); asm volatile("s_waitcnt lgkmcnt(0)" ::: "memory");
}
DI void prologue(ArgsP ap, LAS unsigned char* lds) {
    const int tid = tid_l(), lane = tid & 63, wid = __builtin_amdgcn_readfirstlane(tid >> 6);
    unsigned char* ws = ap->ws;
    LAS float* scr = (LAS float*)(lds + wid * 8448);
    const int gw = bid_l() * 8 + wid, NGW = grd_l() * 8;
    constexpr int I_IN = 16 * (NP / 32), I_UQ = 6 * 24, I_UKV = 4 * 48, I_SQ = 16 * 32, PER_L = I_IN + I_UQ + I_UKV + 6 * I_SQ;
    for (int it = gw; it < 2 * PER_L; it += NGW) {
        const int l = it / PER_L; int r = it % PER_L;
        if (r < I_IN) { transpose_item(ap->in[I_WIN] + (size_t)l * 1024 * D_IN, D_IN, 1, nullptr, (bf16_t*)(ws + WS_WIN) + (size_t)l * NP * 1024, 1024, 0, scr, r, NP / 32, lane); continue; } r -= I_IN;
        if (r < I_UQ) { transpose_item(ap->in[I_WUQ] + (size_t)l * 384 * 768, 768, 2, ap->in[I_QNORM] + l * 384, (bf16_t*)(ws + WS_WUQ) + (size_t)l * 768 * 384, 384, 0, scr, r, 24, lane); continue; } r -= I_UQ;
        if (r < I_UKV) { transpose_item(ap->in[I_WUKV] + (size_t)l * 256 * 1536, 1536, 3, ap->in[I_KVNORM] + l * 256, (bf16_t*)(ws + WS_WUKV) + (size_t)l * 1536 * 256, 256, 0, scr, r, 48, lane); continue; } r -= I_UKV;
        if (r < 3 * I_SQ) { const int br = r / I_SQ; transpose_item(ap->in[I_WBR] + ((size_t)l * 3 + br) * 1024 * 1024, 1024, 0, nullptr, (bf16_t*)(ws + WS_WB) + ((size_t)l * 3 + br) * 1024 * 1024, 1024, 0, scr, r % I_SQ, 32, lane); continue; } r -= 3 * I_SQ;
        { const int rep = r / I_SQ; transpose_item(ap->in[I_WOUT] + (size_t)l * 1024 * 1024, 1024, 0, nullptr, (bf16_t*)(ws + WS_WO3) + (size_t)l * 1024 * 3072, 3072, rep * 1024, scr, r % I_SQ, 32, lane); }
    }
    const int gt = bid_l() * 512 + tid, NGT = grd_l() * 512;
    for (int i = gt; i < SEQ * 48; i += NGT) {
        const int pos = i / 48, p = i % 48; const float frow = (float)(pos >> 6), fcol = (float)(pos & 63);
        float ang; float* cd; float* sd;
        if (p < 32) { const int f = p & 15; const float inv = powf(10000.0f, -(float)f / 16.0f); ang = (p < 16 ? frow : fcol) * inv; cd = (float*)(ws + WS_COSH) + pos * 32 + p; sd = (float*)(ws + WS_SINH) + pos * 32 + p; }
        else { const int pp = p - 32, f = pp & 7; const float inv = powf(10000.0f, -(float)f / 8.0f); ang = (pp < 8 ? frow : fcol) * inv; cd = (float*)(ws + WS_COSM) + pos * 16 + pp; sd = (float*)(ws + WS_SINM) + pos * 16 + pp; }
        *cd = __cosf(ang); *sd = __sinf(ang);
    }
    for (int it = gw; it < 2 * 16 * 48; it += NGW) {
        const int l = it / 768, rem = it % 768, kc = rem / 48, nb = rem % 48; const int k = kc * 64 + lane;
        float sv[9];
#pragma unroll
        for (int v = 0; v < 8; ++v) sv[v] = silu_f(ap->in[I_C][v * 1024 + k]);
        sv[8] = silu_f(ap->in[I_CCTX][k]);
        float acc[9];
#pragma unroll
        for (int v = 0; v < 9; ++v) acc[v] = 0.f;
        const float* w = ap->in[I_WMOD] + ((size_t)l * 1024 + kc * 64) * 3072 + nb * 64 + lane;
#pragma unroll 8
        for (int kk = 0; kk < 64; ++kk) { const float wv = w[(size_t)kk * 3072];
#pragma unroll
            for (int v = 0; v < 9; ++v) acc[v] += __uint_as_float(__builtin_amdgcn_readlane(__float_as_uint(sv[v]), kk)) * wv; }
        float* mp = (float*)(ws + WS_MODP) + ((size_t)(l * 16 + kc) * 9) * 3072 + nb * 64 + lane;
#pragma unroll
        for (int v = 0; v < 9; ++v) mp[(size_t)v * 3072] = acc[v];
    }
}
DI void mod_finalize(ArgsP ap) {
    const int tid = tid_l();
    const int gt = bid_l() * 512 + tid, NGT = grd_l() * 512;
    const float* mp = (const float*)(ap->ws + WS_MODP); float* mod = (float*)(ap->ws + WS_MOD);
    for (int i = gt; i < 2 * 9 * 3072; i += NGT) {
        const int l = i / (9 * 3072), rem = i % (9 * 3072), n = rem % 3072;
        float s = ap->in[I_BMOD][l * 3072 + n];
#pragma unroll
        for (int kc = 0; kc < 16; ++kc) s += mp[(size_t)(l * 16 + kc) * 9 * 3072 + rem];
        mod[i] = s;
    }
}
DI void ph_norm_mod(ArgsP ap, int l, int g) {
    const int tid = tid_l(), lane = tid & 63, wid = __builtin_amdgcn_readfirstlane(tid >> 6);
    const int gw = bid_l() * 8 + wid, NGW = grd_l() * 8;
    const float* ng = ap->in[I_NORMG] + l * 1024; const float* mod = (const float*)(ap->ws + WS_MOD) + (size_t)l * 9 * 3072;
    const float* xs = (l == 0) ? ap->in[I_X] : ap->out; const float* cs = (l == 0) ? ap->in[I_CTX] : (const float*)(ap->ws + WS_CTX);
    bf16_t* H = (bf16_t*)(ap->ws + WS_H);
    for (int r = gw; r < R; r += NGW) {
        const int bl = r / RB, j = r % RB, b = g * GB + bl;
        const float* src; const float* md;
        if (j < CTX) { src = cs + ((size_t)b * CTX + j) * DM; md = mod + 8 * 3072; } else { src = xs + ((size_t)b * SEQ + (j - CTX)) * DM; md = mod + (size_t)b * 3072; }
        f32x4 v[4]; float ss = 0.f;
#pragma unroll
        for (int q = 0; q < 4; ++q) { v[q] = *(const f32x4*)(src + 4 * (lane + 64 * q)); ss += (v[q][0] * v[q][0] + v[q][1] * v[q][1]) + (v[q][2] * v[q][2] + v[q][3] * v[q][3]); }
        const float rstd = 1.0f / sqrtf(wave_sum(ss) * (1.0f / DM) + EPS);
#pragma unroll
        for (int q = 0; q < 4; ++q) { const int idx = 4 * (lane + 64 * q);
            const f32x4 gg = *(const f32x4*)(ng + idx), sh = *(const f32x4*)(md + idx), sc = *(const f32x4*)(md + 1024 + idx);
            const f32x4 y = (v[q] * rstd * gg) * (sc + 1.0f) + sh;
            u32x2 w; w.x = pk2(y[0], y[1]); w.y = pk2(y[2], y[3]); *(u32x2*)(H + (size_t)r * DM + idx) = w; }
    }
}
DI void ph_mla_norm(ArgsP ap) {
    const int tid = tid_l(), lane = tid & 63, wid = __builtin_amdgcn_readfirstlane(tid >> 6);
    const int gw = bid_l() * 8 + wid, NGW = grd_l() * 8;
    const bf16_t* P = (const bf16_t*)(ap->ws + WS_P); bf16_t* AQ = (bf16_t*)(ap->ws + WS_AQ); bf16_t* AKV = (bf16_t*)(ap->ws + WS_AKV); bf16_t* KM = (bf16_t*)(ap->ws + WS_KM);
    for (int r = gw; r < R; r += NGW) {
        const bf16_t* row = P + (size_t)r * NP;
        const u32x4 c0 = *(const u32x4*)(row + 8 * lane);
        u32x4 c1 = {0u, 0u, 0u, 0u}; if (lane < 20) c1 = *(const u32x4*)(row + 8 * (64 + lane));
        float f0[8] = {bflo(c0.x), bfhi(c0.x), bflo(c0.y), bfhi(c0.y), bflo(c0.z), bfhi(c0.z), bflo(c0.w), bfhi(c0.w)};
        float f1[8] = {bflo(c1.x), bfhi(c1.x), bflo(c1.y), bfhi(c1.y), bflo(c1.z), bfhi(c1.z), bflo(c1.w), bfhi(c1.w)};
        float s0 = 0.f, s1 = 0.f;
#pragma unroll
        for (int i = 0; i < 8; ++i) { s0 += f0[i] * f0[i]; s1 += f1[i] * f1[i]; }
        const float sq = wave_sum(lane < 48 ? s0 : 0.f);
        const float skv = wave_sum((lane >= 48 ? s0 : 0.f) + (lane < 16 ? s1 : 0.f));
        const float rq = 1.0f / sqrtf(sq * (1.0f / 384.0f) + EPS), rkv = 1.0f / sqrtf(skv * (1.0f / 256.0f) + EPS);
        { const float rr = lane < 48 ? rq : rkv; u32x4 w; w.x = pk2(f0[0] * rr, f0[1] * rr); w.y = pk2(f0[2] * rr, f0[3] * rr); w.z = pk2(f0[4] * rr, f0[5] * rr); w.w = pk2(f0[6] * rr, f0[7] * rr);
          if (lane < 48) *(u32x4*)(AQ + (size_t)r * 384 + 8 * lane) = w; else *(u32x4*)(AKV + (size_t)r * 256 + 8 * (lane - 48)) = w; }
        if (lane < 16) { u32x4 w; w.x = pk2(f1[0] * rkv, f1[1] * rkv); w.y = pk2(f1[2] * rkv, f1[3] * rkv); w.z = pk2(f1[4] * rkv, f1[5] * rkv); w.w = pk2(f1[6] * rkv, f1[7] * rkv);
            *(u32x4*)(AKV + (size_t)r * 256 + 8 * (16 + lane)) = w; }
        else if (lane < 20) {
#pragma unroll
            for (int h = 0; h < 8; ++h) *(u32x4*)(KM + (size_t)r * 768 + h * 96 + 64 + 8 * (lane - 16)) = c1; }
    }
}
DI void ph_diff_post(ArgsP ap, int l) {
    const int tid = tid_l(), lane = tid & 63, wid = __builtin_amdgcn_readfirstlane(tid >> 6);
    const int gw = bid_l() * 8 + wid, NGW = grd_l() * 8;
    const float lam_init = (l == 0) ? 0.2f : (0.8f - 0.6f * 0.7408182206817179f);
    const float d1 = wave_sum(ap->in[I_LQ1][l * 64 + lane] * ap->in[I_LK1][l * 64 + lane]), d2 = wave_sum(ap->in[I_LQ2][l * 64 + lane] * ap->in[I_LK2][l * 64 + lane]);
    const float lam = expf(d1) - expf(d2) + lam_init;
    const float sl0 = ap->in[I_SUBLN][l * 128 + 2 * lane] * (1.0f - lam_init), sl1 = ap->in[I_SUBLN][l * 128 + 2 * lane + 1] * (1.0f - lam_init);
    const float* OD = (const float*)(ap->ws + WS_OD); bf16_t* P = (bf16_t*)(ap->ws + WS_P);
    typedef float f32x2 __attribute__((ext_vector_type(2)));
    for (int r = gw; r < R; r += NGW) {
        if (l != 0 && (r % RB) < CTX) continue;
        const float* ob = OD + (size_t)r * 2048 + 2 * lane; unsigned* zb = (unsigned*)(P + (size_t)r * NP + C_Z + 1024 + 2 * lane);
        f32x2 o1[8], o2[8]; unsigned z[8];
#pragma unroll
        for (int h = 0; h < 8; ++h) { o1[h] = *(const f32x2*)(ob + (2 * h) * 128); o2[h] = *(const f32x2*)(ob + (2 * h + 1) * 128); z[h] = zb[h * 64]; }
#pragma unroll
        for (int h = 0; h < 8; ++h) {
            const float a0 = o1[h][0] - lam * o2[h][0], a1 = o1[h][1] - lam * o2[h][1];
            const float rstd = 1.0f / sqrtf(wave_sum(a0 * a0 + a1 * a1) * (1.0f / 128.0f) + EPS);
            zb[h * 64] = pk2(a0 * rstd * sl0 * silu_f(bflo(z[h])), a1 * rstd * sl1 * silu_f(bfhi(z[h])));
        }
    }
}
DI void ph_final_norm(ArgsP ap) {
    const int tid = tid_l(), lane = tid & 63, wid = __builtin_amdgcn_readfirstlane(tid >> 6);
    const int gw = bid_l() * 8 + wid, NGW = grd_l() * 8; const float* fg = ap->in[I_FNORM];
    for (int r = gw; r < NBATCH * SEQ; r += NGW) {
        float* row = ap->out + (size_t)r * DM; f32x4 v[4]; float ss = 0.f;
#pragma unroll
        for (int q = 0; q < 4; ++q) { v[q] = *(const f32x4*)(row + 4 * (lane + 64 * q)); ss += (v[q][0] * v[q][0] + v[q][1] * v[q][1]) + (v[q][2] * v[q][2] + v[q][3] * v[q][3]); }
        const float rstd = 1.0f / sqrtf(wave_sum(ss) * (1.0f / DM) + EPS);
#pragma unroll
        for (int q = 0; q < 4; ++q) { const int idx = 4 * (lane + 64 * q); *(f32x4*)(row + idx) = v[q] * rstd * *(const f32x4*)(fg + idx); }
    }
}
template <bool DRY>
DI void ph_attention(ArgsP ap, int l, LAS unsigned char* lds) {
    constexpr int OM0 = DRY ? 2 : 0;
    const int G = grd_l(), bx = bid_l(), vcu = (G % 8 == 0) ? (bx % 8) * (G / 8) + bx / 8 : bx;
    bf16_t* P = (bf16_t*)(ap->ws + WS_P); const bf16_t* QM = (const bf16_t*)(ap->ws + WS_QM); const bf16_t* KM = (const bf16_t*)(ap->ws + WS_KM); const bf16_t* VM = (const bf16_t*)(ap->ws + WS_VM);
    float* OD = (float*)(ap->ws + WS_OD); const float* sink = ap->in[I_SINK] + l * 16;
#if !defined(ATT_ONLY) || ATT_ONLY == 1
    for (int u = vcu; u < GB * 8 * 32; u += G) { const int bh = u >> 5, qb = u & 31, bl = bh >> 3, h = bh & 7; const size_t rb = (size_t)bl * RB, q0 = rb + CTX + 256 * qb;
        attn_unit<96, 128, OM0, false>(lds, QM + q0 * 768 + h * 96, 768, KM + rb * 768 + h * 96, 768, VM + rb * 1024 + h * 128, 1024, RB / 64, 0, 0, 0, 0, NEGBIG, 0.f, P + q0 * NP + C_Z + h * 128, NP, OD, 0); }
#endif
#if !defined(ATT_ONLY) || ATT_ONLY == 2
    for (int u = vcu; u < GB * 16 * 32; u += G) { const int bh = u >> 5, qb = u & 31, bl = bh >> 4, hm = bh & 15; const size_t rb = (size_t)bl * RB, q0 = rb + CTX + 256 * qb;
        attn_unit<64, 128, 1, false>(lds, P + q0 * NP + C_DQ + hm * 64, NP, P + rb * NP + C_DK + hm * 64, NP, P + rb * NP + C_DV + (hm >> 1) * 128, NP, RB / 64, 0, 0, 0, 0, NEGBIG, 0.f, nullptr, 0, OD + q0 * 2048 + hm * 128, 2048); }
#endif
#if !defined(ATT_ONLY) || ATT_ONLY == 3
    for (int u = vcu; u < GB * 16 * 32; u += G) { const int bh = u >> 5, qb = u & 31, bl = bh >> 4, h = bh & 15; const size_t rb = (size_t)bl * RB, q0 = rb + CTX + 256 * qb;
        const int lo = (256 * qb - 128 < 0) ? 0 : 256 * qb - 128, hi = (256 * qb + 384 > SEQ) ? SEQ : 256 * qb + 384;
        attn_unit<64, 64, OM0, true>(lds, P + q0 * NP + C_SQ + h * 64, NP, P + rb * NP + C_SK + (h >> 2) * 64, NP, P + rb * NP + C_SV + (h >> 2) * 64, NP, CTX / 64, CTX + lo, (hi - lo) / 64, lo, 256 * qb, sink[h] * LOG2E, 1.0f,
                              P + q0 * NP + C_Z + 2048 + h * 64, NP, OD, 0); }
#endif
#if !defined(ATT_ONLY)
    if (l == 0) {
        for (int u = vcu; u < GB * 40; u += G) { const int bl = u / 40, k = u % 40; const size_t rb = (size_t)bl * RB;
            if (k < 8) { const int h = k;
                attn_unit<96, 128, OM0, false>(lds, QM + rb * 768 + h * 96, 768, KM + rb * 768 + h * 96, 768, VM + rb * 1024 + h * 128, 1024, CTX / 64, 0, 0, 0, 0, NEGBIG, 0.f, P + rb * NP + C_Z + h * 128, NP, OD, 0); }
            else if (k < 24) { const int hm = k - 8;
                attn_unit<64, 128, 1, false>(lds, P + rb * NP + C_DQ + hm * 64, NP, P + rb * NP + C_DK + hm * 64, NP, P + rb * NP + C_DV + (hm >> 1) * 128, NP, CTX / 64, 0, 0, 0, 0, NEGBIG, 0.f, nullptr, 0, OD + rb * 2048 + hm * 128, 2048); }
            else { const int h = k - 24;
                attn_unit<64, 64, OM0, false>(lds, P + rb * NP + C_SQ + h * 64, NP, P + rb * NP + C_SK + (h >> 2) * 64, NP, P + rb * NP + C_SV + (h >> 2) * 64, NP, CTX / 64, 0, 0, 0, 0, sink[h] * LOG2E, 1.0f, P + rb * NP + C_Z + 2048 + h * 64, NP, OD, 0); }
        }
    }
#endif
}

#define RLX_AGENT __ATOMIC_RELAXED, __HIP_MEMORY_SCOPE_AGENT
#define XB_TMO      128
#define XB_XCNT(j)  (256  + 64 * (j))
#define XB_XSUB(j)  (1280 + 64 * (j))
#define XB_XGEN(j)  (2304 + 64 * (j))
#define XB_TOP      3328
#define XB_TOPGEN   3392
#define XCD_BAR_WORDS 3456
#define XB_SPIN_CAP (1u << 18)

__device__ __forceinline__ unsigned xb_ld(unsigned* p)              { return __hip_atomic_load(p, __ATOMIC_RELAXED, __HIP_MEMORY_SCOPE_AGENT); }
__device__ __forceinline__ unsigned xb_add(unsigned* p, unsigned v) { return __hip_atomic_fetch_add(p, v, __ATOMIC_RELAXED, __HIP_MEMORY_SCOPE_AGENT); }
__device__ __forceinline__ unsigned xb_xcc_id() { return (unsigned)__builtin_amdgcn_s_getreg((3 << 11) | 20) & 0xFu; }
#define XB_SPIN(cond, bar) do { unsigned _sp = 0; while (cond) { __builtin_amdgcn_s_sleep(1); \
    if ((++_sp & 255u) == 0u) { if (xb_ld(&(bar)[XB_TMO])) break; if (_sp > XB_SPIN_CAP) { atomicAdd(&(bar)[XB_TMO], 1u); break; } } } } while (0)

struct XcdBarrier {
    unsigned* bar; unsigned x;
    volatile LAS unsigned* st;
};

__device__ __forceinline__ XcdBarrier xcd_barrier_post(unsigned* bar, volatile LAS unsigned* st) {
    XcdBarrier b; b.bar = bar; b.x = xb_xcc_id(); b.st = st;
    if (threadIdx.x == 0) (void)xb_add(&bar[XB_XCNT(b.x)], 1u);
    return b;
}
__device__ __forceinline__ void xcd_barrier_complete(unsigned* bar, unsigned x, unsigned& nloc, unsigned& nx) {
    const unsigned G = gridDim.x * gridDim.y * gridDim.z;
    unsigned sum, cnt, mine, sp = 0u;
    for (;;) {
        sum = 0u; cnt = 0u; mine = 0u;
#pragma unroll
        for (unsigned j = 0; j < 16; ++j) { const unsigned c = xb_ld(&bar[XB_XCNT(j)]); sum += c; cnt += (c > 0u) ? 1u : 0u; mine = (j == x) ? c : mine; }
        if (sum == G) break;
        __builtin_amdgcn_s_sleep(1);
        if ((++sp & 255u) == 0u) { if (xb_ld(&bar[XB_TMO])) break; if (sp > XB_SPIN_CAP) { atomicAdd(&bar[XB_TMO], 1u); break; } }
    }
    nloc = mine > 0u ? mine : 1u; nx = cnt > 0u ? cnt : 1u;
}

__device__ __forceinline__ void xcd_barrier(const XcdBarrier& b) {
    asm volatile("s_waitcnt vmcnt(0)" ::: "memory");
    __syncthreads();
    if (threadIdx.x == 0) {
        unsigned* bar = b.bar;
        __builtin_amdgcn_s_waitcnt(0);
        unsigned nloc = b.st[0], nx = b.st[1];
        if (nloc == 0u) { xcd_barrier_complete(bar, b.x, nloc, nx); b.st[0] = nloc; b.st[1] = nx; }
        const unsigned old = xb_add(&bar[XB_XSUB(b.x)], 1u);
        const unsigned gen = old / nloc;
        if (old + 1u == (gen + 1u) * nloc) {
            __builtin_amdgcn_fence(__ATOMIC_RELEASE, "agent");
            asm volatile("s_waitcnt vmcnt(0)" ::: "memory");
            const unsigned og = xb_add(&bar[XB_TOP], 1u);
            const unsigned tg = og / nx;
            if (og + 1u == (tg + 1u) * nx) xb_add(&bar[XB_TOPGEN], 1u);
            else XB_SPIN(xb_ld(&bar[XB_TOPGEN]) == tg, bar);
            __builtin_amdgcn_fence(__ATOMIC_ACQUIRE, "agent");
            xb_add(&bar[XB_XGEN(b.x)], 1u);
            asm volatile("s_waitcnt vmcnt(0)" ::: "memory");
        } else {
            XB_SPIN(xb_ld(&bar[XB_XGEN(b.x)]) == gen, bar);
            __builtin_amdgcn_fence(__ATOMIC_ACQUIRE, "agent");
            asm volatile("s_waitcnt vmcnt(0)" ::: "memory");
        }
    }
    __syncthreads();
}


__global__ void __launch_bounds__(512, 2) hybrid_fwd(Args a_unused) {
    extern __shared__ __attribute__((aligned(16))) unsigned char lds_raw[];
    LAS unsigned char* lds = (LAS unsigned char*)lds_raw;
    cg::grid_group grid = cg::this_grid();
    { volatile LAS unsigned* xst = (volatile LAS unsigned*)(lds + XB_LDS_OFF);
      if (threadIdx.x < 2) xst[threadIdx.x] = 0u;
      __syncthreads();
      (void)xcd_barrier_post((unsigned*)(args_ptr()->ws), xst); }
#define GSYNC() do { XcdBarrier b_; b_.bar = (unsigned*)(args_ptr()->ws); b_.x = xb_xcc_id(); b_.st = (volatile LAS unsigned*)(lds + XB_LDS_OFF); xcd_barrier(b_); } while (0)
#ifndef NO_PRO
    prologue(args_ptr(), lds);
#endif
    grid.sync();
    mod_finalize(args_ptr());
    GSYNC();
    for (int l = 0; l < 2; ++l) {
        for (int g = 0; g < NGRP; ++g) {
            ph_norm_mod(args_ptr(), lnd(l), lnd(g));
            GSYNC();
#ifndef NO_GEMM
            {
                unsigned char* ws = args_ptr()->ws; const int G = grd_l(), bx = bid_l();
                pg8::Gemm gm{1024, 1024, 1024}; pg8::Order S; S.init(R, NP, G, bx, ws + WS_H, 1024, (bf16_t*)(ws + WS_WIN) + (size_t)l * NP * 1024, 1024, 1 << 20, 0);
                EpiIn E{ws};
                pg8::gemm_phase<EpiIn, pg8::Order, true, true>(lds, gm, S, E);
#ifdef PROBE_G1
                __syncthreads(); pg8::gemm_phase<EpiIn, pg8::Order, true, true>(lds, gm, S, E);
#endif
            }
#endif
            GSYNC();
            ph_mla_norm(args_ptr());
            GSYNC();
#ifndef NO_GEMM2
            {
                unsigned char* ws = args_ptr()->ws; const int G = grd_l(), bx = bid_l();
                pg8::Gemm gq{384, 384, 384}; pg8::Order Sq; Sq.init(R, 768, G, bx, ws + WS_AQ, 384, (bf16_t*)(ws + WS_WUQ) + (size_t)l * 768 * 384, 384, 1 << 20, 0);
                EpiQ Eq{ws};
#ifndef NO_GQ
                pg8::gemm_phase<EpiQ, pg8::Order, true, true>(lds, gq, Sq, Eq);
#endif
            }
            {
                unsigned char* ws = args_ptr()->ws; const int G = grd_l(), bx = bid_l();
                pg8::Gemm gk{256, 256, 256}; pg8::Order Sk; Sk.init(R, 1536, G, bx, ws + WS_AKV, 256, (bf16_t*)(ws + WS_WUKV) + (size_t)l * 1536 * 256, 256, 1 << 20, 0);
                EpiKV Ek{ws};
#ifndef NO_GK
                pg8::gemm_phase<EpiKV, pg8::Order, true, true>(lds, gk, Sk, Ek);
#endif
            }
#endif
            GSYNC();
#ifndef NO_ATT
#ifdef PROBE_ATT
            ph_attention<true>(args_ptr(), lnd(l), lds);
            GSYNC();
#endif
            ph_attention<false>(args_ptr(), lnd(l), lds);
#endif
            GSYNC();
            ph_diff_post(args_ptr(), lnd(l));
            GSYNC();
#ifndef NO_BR
            {
                unsigned char* ws = args_ptr()->ws; const int G = grd_l(), bx = bid_l();
                pg8::Gemm gb{1024, NP, 1024}; pg8::Order S; S.init(R, 3072, G, bx, (bf16_t*)(ws + WS_P) + C_Z, NP, (bf16_t*)(ws + WS_WB) + (size_t)l * 3 * 1024 * 1024, 1024, 4, 1024 * 2, l != 0);
                EpiBr E{ws};
                pg8::gemm_phase<EpiBr, pg8::Order, true, true>(lds, gb, S, E);
            }
#endif
            GSYNC();
#ifndef NO_OUT
            {
                ArgsP ap = args_ptr(); unsigned char* ws = ap->ws; const int G = grd_l(), bx = bid_l();
                pg8::Gemm go{3072, NP, 3072}; pg8::Order S; S.init(R, 1024, G, bx, (bf16_t*)(ws + WS_P) + C_GM, NP, (bf16_t*)(ws + WS_WO3) + (size_t)l * 1024 * 3072, 3072, 1 << 20, 0, l != 0);
                EpiOut E{l, g, (l == 0) ? ap->in[I_X] : (const float*)ap->out, ap->out, ap->in[I_CTX], ws};
                pg8::gemm_phase<EpiOut, pg8::Order, true, true>(lds, go, S, E);
            }
#endif
        }
        GSYNC();
    }
    ph_final_norm(args_ptr());
}

extern "C" void kernel_launch(void* const* d_in, const int* in_sizes, int n_in, void* d_out, int out_size, void* d_ws, size_t ws_size, hipStream_t stream) {
    static int grid = 0;
    if (grid == 0) {
        if (n_in != 21 || ws_size < WS_END) { fprintf(stderr, "kernel_launch: expected 21 inputs and >= %zu bytes of workspace (got %d, %zu)\n", (size_t)WS_END, n_in, ws_size); grid = -1; return; }
        int dev = 0, cus = 0, per_cu = 0;
        (void)hipGetDevice(&dev); (void)hipDeviceGetAttribute(&cus, hipDeviceAttributeMultiprocessorCount, dev);
        if (hipFuncSetAttribute((const void*)hybrid_fwd, hipFuncAttributeMaxDynamicSharedMemorySize, LDS_BYTES) != hipSuccess) fprintf(stderr, "kernel_launch: hipFuncSetAttribute failed\n");
        if (hipOccupancyMaxActiveBlocksPerMultiprocessor(&per_cu, (const void*)hybrid_fwd, 512, LDS_BYTES) != hipSuccess || per_cu < 1) { per_cu = 1; (void)hipGetLastError(); }
        if (cus <= 0) cus = 256;
        grid = cus * per_cu;
    }
    if (grid < 0) return;
    Args a{};
    for (int i = 0; i < 21; ++i) a.in[i] = (const float*)d_in[i];
    a.out = (float*)d_out; a.ws = (unsigned char*)d_ws;
    (void)hipMemsetAsync(d_ws, 0, 16384, stream);
    void* args[] = {&a};
    hipError_t e = hipLaunchCooperativeKernel((const void*)hybrid_fwd, dim3(grid), dim3(512), args, LDS_BYTES, stream);
    if (e != hipSuccess) fprintf(stderr, "kernel_launch: cooperative launch failed: %s (grid %d)\n", hipGetErrorString(e), grid);
}
```

```cpp
#define AT_PV8 1
#define AT_NOSBAR 1
#define AT_PV8 1
#define AT_NOSBAR 1
#define AT_PV8 1
#define AT_NOSBAR 1
#include <hip/hip_runtime.h>
#include <hip/hip_cooperative_groups.h>
#include <cstdio>
#include <cstdint>
namespace cg = cooperative_groups;

#define DI __device__ __forceinline__
#define LAS __attribute__((address_space(3)))
__device__ __forceinline__ int tid_l() { int t = threadIdx.x; asm volatile("" : "+v"(t)); return t; }
__device__ __forceinline__ int bid_l() { int b = blockIdx.x; asm volatile("" : "+s"(b)); return b; }
__device__ __forceinline__ int lnd(int x) { asm volatile("" : "+s"(x)); return x; }
__device__ __forceinline__ int grd_l() { int g = gridDim.x; asm volatile("" : "+s"(g)); return g; }
typedef unsigned short bf16_t;
typedef short bf16x8 __attribute__((ext_vector_type(8)));
typedef short s16x4 __attribute__((ext_vector_type(4)));
typedef float f32x4 __attribute__((ext_vector_type(4)));
typedef float f32x16 __attribute__((ext_vector_type(16)));
typedef unsigned u32x4 __attribute__((ext_vector_type(4)));
typedef unsigned u32x2 __attribute__((ext_vector_type(2)));

constexpr int DM = 1024, NBATCH = 8, SEQ = 8192, CTX = 256, RB = CTX + SEQ;
constexpr int GB = 2, NGRP = NBATCH / GB, R = GB * RB;
constexpr int NP = 11520;
constexpr int C_QC = 0, C_KVC = 384, C_KR = 640, C_DQ = 768, C_DK = 1792, C_DV = 2816, C_SQ = 3840, C_SK = 4864, C_SV = 5120, C_Z = 5376, C_GM = 8448;
constexpr int D_IN = 11424;
constexpr float EPS = 1e-6f, LOG2E = 1.4426950408889634f;
constexpr float QS64 = 0.125f * LOG2E, QS96 = 0.10206207261596575f * LOG2E;
constexpr float NEGBIG = -1e30f, THR = 8.0f;

constexpr size_t al256(size_t x) { return (x + 255) & ~(size_t)255; }
constexpr size_t WS_WIN = 1u << 20;
constexpr size_t WS_WUQ = al256(WS_WIN + (size_t)2 * NP * 1024 * 2);
constexpr size_t WS_WUKV = al256(WS_WUQ + (size_t)2 * 768 * 384 * 2);
constexpr size_t WS_WB = al256(WS_WUKV + (size_t)2 * 1536 * 256 * 2);
constexpr size_t WS_WO3 = al256(WS_WB + (size_t)2 * 3 * 1024 * 1024 * 2);
constexpr size_t WS_COSH = al256(WS_WO3 + (size_t)2 * 1024 * 3072 * 2);
constexpr size_t WS_SINH = al256(WS_COSH + (size_t)SEQ * 32 * 4);
constexpr size_t WS_COSM = al256(WS_SINH + (size_t)SEQ * 32 * 4);
constexpr size_t WS_SINM = al256(WS_COSM + (size_t)SEQ * 16 * 4);
constexpr size_t WS_MODP = al256(WS_SINM + (size_t)SEQ * 16 * 4);
constexpr size_t WS_MOD = al256(WS_MODP + (size_t)16 * 2 * 9 * 3072 * 4);
constexpr size_t WS_CTX = al256(WS_MOD + (size_t)2 * 9 * 3072 * 4);
constexpr size_t WS_H = al256(WS_CTX + (size_t)NBATCH * CTX * DM * 4);
constexpr size_t WS_P = al256(WS_H + (size_t)R * DM * 2);
constexpr size_t WS_AQ = al256(WS_P + (size_t)R * NP * 2);
constexpr size_t WS_AKV = al256(WS_AQ + (size_t)R * 384 * 2);
constexpr size_t WS_QM = al256(WS_AKV + (size_t)R * 256 * 2);
constexpr size_t WS_KM = al256(WS_QM + (size_t)R * 768 * 2);
constexpr size_t WS_VM = al256(WS_KM + (size_t)R * 768 * 2);
constexpr size_t WS_OD = al256(WS_VM + (size_t)R * 1024 * 2);
constexpr size_t WS_END = al256(WS_OD + (size_t)R * 2048 * 4);
static_assert(WS_END <= ((size_t)1 << 30), "workspace map exceeds 1 GiB");

constexpr int LDS_BYTES = 155648, XB_LDS_OFF = 155136;

DI unsigned pk2(float lo, float hi) { typedef float f2_t __attribute__((ext_vector_type(2))); typedef __bf16 b2_t __attribute__((ext_vector_type(2)));
    f2_t v = {lo, hi}; b2_t b = __builtin_convertvector(v, b2_t); return __builtin_bit_cast(unsigned, b); }
DI u32x4 pack8(f32x4 a, f32x4 b) { u32x4 w; w.x = pk2(a[0], a[1]); w.y = pk2(a[2], a[3]); w.z = pk2(b[0], b[1]); w.w = pk2(b[2], b[3]); return w; }
DI float bflo(unsigned w) { return __uint_as_float(w << 16); }
DI float bfhi(unsigned w) { return __uint_as_float(w & 0xffff0000u); }
DI float wave_sum(float v) {
#pragma unroll
    for (int o = 1; o < 64; o <<= 1) v += __shfl_xor(v, o);
    return v; }
DI float silu_f(float z) { return z * __builtin_amdgcn_rcpf(1.0f + __expf(-z)); }
DI float sigm_f(float z) { return __builtin_amdgcn_rcpf(1.0f + __expf(-z)); }
DI void rope8(f32x4& v0, f32x4& v1, const f32x4 cs, const f32x4 sn) {
    float a, b;
    a = v0[0]; b = v0[1]; v0[0] = a * cs[0] - b * sn[0]; v0[1] = b * cs[0] + a * sn[0];
    a = v0[2]; b = v0[3]; v0[2] = a * cs[1] - b * sn[1]; v0[3] = b * cs[1] + a * sn[1];
    a = v1[0]; b = v1[1]; v1[0] = a * cs[2] - b * sn[2]; v1[1] = b * cs[2] + a * sn[2];
    a = v1[2]; b = v1[3]; v1[2] = a * cs[3] - b * sn[3]; v1[3] = b * cs[3] + a * sn[3];
}
namespace pg8 {
#define PG8_LAS __attribute__((address_space(3)))
typedef unsigned short bf16_t;
typedef short bf16x8 __attribute__((ext_vector_type(8)));
typedef float f32x4 __attribute__((ext_vector_type(4)));
typedef unsigned u32x4 __attribute__((ext_vector_type(4)));
constexpr int BM = 256, BK = 64, HALF = 128, HTB = HALF * BK * 2  , STAGE_BYTES = 8 * HTB, NXCD = 8, WGM = 8;

__host__ __device__ __forceinline__ int lds_byte(int r, int c) { const int st = (r >> 4) * 2 + (c >> 5), rr = r & 15, cc = c & 31, ob = rr * 64 + cc * 2; return st * 1024 + (ob ^ (((ob >> 9) & 1) << 5)); }
__host__ __device__ __forceinline__ void stage_rc(int b, int& R, int& C) { const int st = b / 1024, sb = b % 1024, swz = sb ^ (((sb >> 9) & 1) << 5); R = (st >> 1) * 16 + swz / 64; C = (st & 1) * 32 + (swz % 64) / 2; }
__host__ __device__ __forceinline__ int perm32(int rho) { const int n = rho >> 4, i = rho & 15; return 8 * (i >> 2) + 4 * n + (i & 3); }

struct Unit { int pm, pn; };
struct Gemm { int K, lda, ldb; };
struct Order {
    int nM, nN, nwg, G, c; const char* A; const char* B; unsigned tA, tB; int pnblk; unsigned ablk; int skipctx;
    __device__ __forceinline__ void init(int M, int N, int G_, int c_, const void* A_, int lda, const void* B_, int ldb, int pnblk_, unsigned ablk_, int skipctx_ = 0) {
        skipctx = skipctx_; nM = M / BM; if (skipctx) nM -= nM / 33;
        nN = N / BM; nwg = nM * nN; G = G_; c = c_; A = (const char*)A_; B = (const char*)B_; tA = (unsigned)(BM * lda * 2); tB = (unsigned)(BM * ldb * 2); pnblk = pnblk_; ablk = ablk_; }
    __device__ __forceinline__ bool next(int i, Unit& u) const {
        const long L = (long)i * G + c; if (L >= nwg) return false;
        int wgid = (int)L; { const int q = nwg / NXCD, r = nwg % NXCD, xcd = wgid % NXCD, off = wgid / NXCD; wgid = (xcd < r ? xcd * (q + 1) : r * (q + 1) + (xcd - r) * q) + off; }
        const int nig = WGM * nN, gid = wgid / nig, fm = gid * WGM, gsz = (nM - fm) < WGM ? (nM - fm) : WGM;
        u.pm = fm + ((wgid % nig) % gsz); u.pn = (wgid % nig) / gsz; if (skipctx) u.pm += u.pm / 32 + 1; return true;
    }
    __device__ __forceinline__ const char* a_base(const Unit& u) const { return A + (size_t)u.pm * tA + (size_t)(u.pn / pnblk) * ablk; }
    __device__ __forceinline__ const char* b_base(const Unit& u) const { return B + (size_t)u.pn * tB; }
};

template <class Epi, class Sched, bool ALIGN_EPI = false, bool SP2 = false>
__device__ __forceinline__ void gemm_phase(PG8_LAS unsigned char* lds, const Gemm g, const Sched& S, const Epi& E) {
    const int tid = tid_l(), wid = __builtin_amdgcn_readfirstlane(tid >> 6), lane = tid & 63, wr = wid >> 2, wc = wid & 3, fr = lane & 15, fq = lane >> 4;
    const int K = g.K, nt = K / BK;
    unsigned voffA[2], voffB[2];
#pragma unroll
    for (int i = 0; i < 2; ++i) { int R, C; stage_rc(tid * 16 + i * 8192, R, C); const int Rb = Epi::PERM ? ((R & ~31) + perm32(R & 31)) : R;
        voffA[i] = (unsigned)(R * g.lda + C) * 2u; voffB[i] = (unsigned)(Rb * g.ldb + C) * 2u; }
    const size_t kstep = (size_t)(BK * 2);
    const size_t hstepA = (size_t)HALF * g.lda * 2, hstepB = (size_t)HALF * g.ldb * 2;
    const unsigned ldsw = (unsigned)wid * 1024u;
    const int aoff = lds_byte(wr * 64 + fr, fq * 8), boff = lds_byte(wc * 32 + fr, fq * 8);
#define PG8_SA(b, h) (((b) * 2 + (h)) * HTB)
#define PG8_SB(b, h) ((4 + (b) * 2 + (h)) * HTB)
#define PG8_STAGE(bufoff, gbase, voff) do { _Pragma("unroll") for (int _i = 0; _i < 2; ++_i) \
        __builtin_amdgcn_global_load_lds((const unsigned*)((const char*)(gbase) + (voff)[_i]), (PG8_LAS unsigned*)(lds + (bufoff) + ldsw + _i * 8192), 16, 0, 0); } while (0)
#define PG8_LDA(dst, b, h) do { _Pragma("unroll") for (int m = 0; m < 4; ++m) _Pragma("unroll") for (int k = 0; k < 2; ++k) dst[m][k] = *(const PG8_LAS bf16x8*)(lds + PG8_SA(b, h) + aoff + m * 2048 + k * 1024); } while (0)
#define PG8_LDB(dst, b, h) do { _Pragma("unroll") for (int n = 0; n < 2; ++n) _Pragma("unroll") for (int k = 0; k < 2; ++k) dst[n][k] = *(const PG8_LAS bf16x8*)(lds + PG8_SB(b, h) + boff + n * 2048 + k * 1024); } while (0)
#define PG8_MMA(ai, bj, At, Bt) do { __builtin_amdgcn_s_setprio(1); _Pragma("unroll") for (int m = 0; m < 4; ++m) _Pragma("unroll") for (int n = 0; n < 2; ++n) _Pragma("unroll") for (int k = 0; k < 2; ++k) \
        acc[ai][bj][m][n] = __builtin_amdgcn_mfma_f32_16x16x32_bf16(Bt[n][k], At[m][k], acc[ai][bj][m][n], 0, 0, 0); __builtin_amdgcn_s_setprio(0); } while (0)
#define PG8_WAIT_V(n) asm volatile("s_waitcnt vmcnt(" #n ")" ::: "memory")
#define PG8_WAIT_L(n) asm volatile("s_waitcnt lgkmcnt(" #n ")" ::: "memory")
#define PG8_BAR __builtin_amdgcn_s_barrier()
#define PG8_SCHED __builtin_amdgcn_sched_barrier(0)
    Unit cur, nxt; int ui = 0;
    if (!S.next(0, cur)) return;
    f32x4 acc[2][2][4][2];
#pragma unroll
    for (int a = 0; a < 2; ++a)
#pragma unroll
        for (int b = 0; b < 2; ++b)
#pragma unroll
            for (int m = 0; m < 4; ++m)
#pragma unroll
                for (int n = 0; n < 2; ++n) acc[a][b][m][n] = (f32x4){0.f, 0.f, 0.f, 0.f};
    bf16x8 At[4][2], B0[2][2], B1[2][2];
    const char* cA = S.a_base(cur); const char* cB = S.b_base(cur);

    if constexpr (SP2) {
        PG8_STAGE(PG8_SB(0, 0), cB, voffB); PG8_STAGE(PG8_SB(0, 1), cB + hstepB, voffB); PG8_STAGE(PG8_SA(0, 0), cA, voffA); PG8_STAGE(PG8_SA(0, 1), cA + hstepA, voffA);
        if (wr == 1) PG8_BAR;
        PG8_WAIT_V(2); PG8_BAR;
        PG8_STAGE(PG8_SB(1, 0), cB + kstep, voffB); PG8_STAGE(PG8_SA(1, 0), cA + kstep, voffA); PG8_STAGE(PG8_SB(1, 1), cB + hstepB + kstep, voffB);
        PG8_WAIT_V(6); PG8_BAR;
    } else {
        PG8_STAGE(PG8_SB(0, 0), cB, voffB); PG8_STAGE(PG8_SA(0, 0), cA, voffA); PG8_STAGE(PG8_SB(0, 1), cB + hstepB, voffB); PG8_STAGE(PG8_SA(0, 1), cA + hstepA, voffA);
        if (wr == 1) PG8_BAR;
        PG8_WAIT_V(4); PG8_BAR;
        PG8_STAGE(PG8_SB(1, 0), cB + kstep, voffB); PG8_STAGE(PG8_SA(1, 0), cA + kstep, voffA); PG8_STAGE(PG8_SB(1, 1), cB + hstepB + kstep, voffB);
        PG8_WAIT_V(6); PG8_BAR;
    }
    for (;;) {
        const bool has_next = S.next(ui + 1, nxt);
        const char* nA = has_next ? S.a_base(nxt) : cA; const char* nB = has_next ? S.b_base(nxt) : cB;
#pragma nounroll
        for (int t = 0; t < nt; t += 2) {
            const bool last = (t == nt - 2);
            const char* a1 = cA + (size_t)(t + 1) * kstep;
            const char* a2 = last ? nA : cA + (size_t)(t + 2) * kstep; const char* b2 = last ? nB : cB + (size_t)(t + 2) * kstep;
            const char* a3 = a2 + kstep; const char* b3 = b2 + kstep;

            if constexpr (SP2) {
            PG8_LDB(B0, 0, 0); PG8_LDB(B1, 0, 1); PG8_SCHED; PG8_LDA(At, 0, 0); PG8_STAGE(PG8_SA(1, 1), a1 + hstepA, voffA);
            PG8_WAIT_V(8); PG8_WAIT_L(0); PG8_BAR; PG8_MMA(0, 0, At, B0); PG8_MMA(0, 1, At, B1); PG8_BAR; PG8_SCHED;
            PG8_LDA(At, 0, 1); PG8_STAGE(PG8_SB(0, 0), b2, voffB); PG8_STAGE(PG8_SB(0, 1), b2 + hstepB, voffB); PG8_STAGE(PG8_SA(0, 0), a2, voffA);
            PG8_WAIT_V(8); PG8_WAIT_L(0); PG8_BAR; PG8_MMA(1, 0, At, B0); PG8_MMA(1, 1, At, B1); PG8_BAR; PG8_SCHED;
            PG8_LDB(B0, 1, 0); PG8_LDB(B1, 1, 1); PG8_SCHED; PG8_LDA(At, 1, 0); PG8_STAGE(PG8_SA(0, 1), a2 + hstepA, voffA);
            PG8_WAIT_V(8); PG8_WAIT_L(0); PG8_BAR; PG8_MMA(0, 0, At, B0); PG8_MMA(0, 1, At, B1); PG8_BAR; PG8_SCHED;
            PG8_LDA(At, 1, 1); PG8_STAGE(PG8_SB(1, 0), b3, voffB); PG8_STAGE(PG8_SB(1, 1), b3 + hstepB, voffB); PG8_STAGE(PG8_SA(1, 0), a3, voffA);
            PG8_WAIT_V(8); PG8_WAIT_L(0); PG8_BAR; PG8_MMA(1, 0, At, B0); PG8_MMA(1, 1, At, B1); PG8_BAR; PG8_SCHED;
            } else {
            PG8_LDB(B0, 0, 0); PG8_SCHED; PG8_LDA(At, 0, 0); PG8_STAGE(PG8_SA(1, 1), a1 + hstepA, voffA);
            PG8_WAIT_L(8); PG8_BAR; PG8_WAIT_L(0); PG8_MMA(0, 0, At, B0); PG8_BAR; PG8_SCHED;
            PG8_LDB(B1, 0, 1); PG8_STAGE(PG8_SB(0, 0), b2, voffB);
            PG8_BAR; PG8_WAIT_L(0); PG8_MMA(0, 1, At, B1); PG8_BAR;
            PG8_LDA(At, 0, 1); PG8_STAGE(PG8_SA(0, 0), a2, voffA);
            PG8_BAR; PG8_WAIT_L(0); PG8_MMA(1, 0, At, B0); PG8_BAR; PG8_SCHED;
            PG8_STAGE(PG8_SB(0, 1), b2 + hstepB, voffB);
            PG8_WAIT_V(6); PG8_BAR; PG8_MMA(1, 1, At, B1); PG8_BAR;
            PG8_LDB(B0, 1, 0); PG8_SCHED; PG8_LDA(At, 1, 0); PG8_STAGE(PG8_SA(0, 1), a2 + hstepA, voffA);
            PG8_WAIT_L(8); PG8_BAR; PG8_WAIT_L(0); PG8_MMA(0, 0, At, B0); PG8_BAR; PG8_SCHED;
            PG8_LDB(B1, 1, 1); PG8_STAGE(PG8_SB(1, 0), b3, voffB);
            PG8_BAR; PG8_WAIT_L(0); PG8_MMA(0, 1, At, B1); PG8_BAR;
            PG8_LDA(At, 1, 1); PG8_STAGE(PG8_SA(1, 0), a3, voffA);
            PG8_BAR; PG8_WAIT_L(0); PG8_MMA(1, 0, At, B0); PG8_BAR; PG8_SCHED;
            PG8_STAGE(PG8_SB(1, 1), b3 + hstepB, voffB);
            PG8_WAIT_V(6); PG8_BAR; PG8_MMA(1, 1, At, B1); PG8_BAR;
            }
        }
        if constexpr (ALIGN_EPI) { if (wr == 0) PG8_BAR; }
        if constexpr (!Epi::AFTER_DRAIN) { E(acc, cur, wr, wc, fr, fq); }
        if (!has_next) break;
#pragma unroll
        for (int a = 0; a < 2; ++a)
#pragma unroll
            for (int b = 0; b < 2; ++b)
#pragma unroll
                for (int m = 0; m < 4; ++m)
#pragma unroll
                    for (int n = 0; n < 2; ++n) acc[a][b][m][n] = (f32x4){0.f, 0.f, 0.f, 0.f};
        cur = nxt; cA = nA; cB = nB; ++ui;
        if constexpr (ALIGN_EPI) { if (wr == 1) PG8_BAR; }
    }
    PG8_WAIT_V(0);
    if constexpr (!ALIGN_EPI) { if (wr == 0) PG8_BAR; }
    PG8_BAR;
    if constexpr (Epi::AFTER_DRAIN) { E.fused(acc, cur, wr, wc, fr, fq, lds, wid, lane); }
#undef PG8_SA
#undef PG8_SB
#undef PG8_STAGE
#undef PG8_LDA
#undef PG8_LDB
#undef PG8_MMA
#undef PG8_WAIT_V
#undef PG8_WAIT_L
#undef PG8_BAR
#undef PG8_SCHED
}
}
struct EpiIn {
    static constexpr bool PERM = true, AFTER_DRAIN = false;
    unsigned char* ws;
    DI void operator()(const f32x4 (&acc)[2][2][4][2], const pg8::Unit& u, int wr, int wc, int fr, int fq) const {
        bf16_t* P = (bf16_t*)(ws + WS_P); const float* cosH = (const float*)(ws + WS_COSH); const float* sinH = (const float*)(ws + WS_SINH); const float* cosM = (const float*)(ws + WS_COSM); const float* sinM = (const float*)(ws + WS_SINM);
        const int pn = u.pn; const bool ctxt = (u.pm % 33) == 0;
        int mode = 0; float sc = 1.f;
        if ((pn >= 3 && pn <= 10) || (pn >= 15 && pn <= 19)) mode = 1;
        if (pn == 2) mode = 2;
        if ((pn >= 3 && pn <= 6) || (pn >= 15 && pn <= 18)) sc = QS64;
        if (ctxt) mode = 0;
        const int rowt = u.pm * 256 + wr * 64 + fr, colb = pn * 256 + wc * 32 + 8 * fq;
#pragma unroll
        for (int ai = 0; ai < 2; ++ai)
#pragma unroll
            for (int m = 0; m < 4; ++m) {
                const int row = rowt + ai * 128 + m * 16; const int pos = (row % RB) - CTX;
                bf16_t* rowp = P + (size_t)row * NP;
#pragma unroll
                for (int bj = 0; bj < 2; ++bj) {
                    const int col0 = colb + bj * 128;
                    f32x4 v0 = acc[ai][bj][m][0], v1 = acc[ai][bj][m][1];
                    if (mode == 1) { const int p0 = (col0 & 63) >> 1; const f32x4 cs = *(const f32x4*)(cosH + (size_t)pos * 32 + p0), sn = *(const f32x4*)(sinH + (size_t)pos * 32 + p0); rope8(v0, v1, cs, sn); }
                    else if (mode == 2 && col0 >= C_KR && col0 < C_KR + 32) { const int p0 = (col0 - C_KR) >> 1; const f32x4 cs = *(const f32x4*)(cosM + (size_t)pos * 16 + p0), sn = *(const f32x4*)(sinM + (size_t)pos * 16 + p0); rope8(v0, v1, cs, sn); }
                    v0 = v0 * sc; v1 = v1 * sc;
                    *(u32x4*)(rowp + col0) = pack8(v0, v1);
                }
            }
    }
};
struct EpiQ {
    static constexpr bool PERM = true, AFTER_DRAIN = false;
    unsigned char* ws;
    DI void operator()(const f32x4 (&acc)[2][2][4][2], const pg8::Unit& u, int wr, int wc, int fr, int fq) const {
        bf16_t* QM = (bf16_t*)(ws + WS_QM); const float* cosM = (const float*)(ws + WS_COSM); const float* sinM = (const float*)(ws + WS_SINM);
        const bool ctxt = (u.pm % 33) == 0;
        const int rowt = u.pm * 256 + wr * 64 + fr, colb = u.pn * 256 + wc * 32 + 8 * fq;
#pragma unroll
        for (int ai = 0; ai < 2; ++ai)
#pragma unroll
            for (int m = 0; m < 4; ++m) {
                const int row = rowt + ai * 128 + m * 16; const int pos = (row % RB) - CTX;
#pragma unroll
                for (int bj = 0; bj < 2; ++bj) {
                    const int col0 = colb + bj * 128, within = col0 % 96;
                    f32x4 v0 = acc[ai][bj][m][0], v1 = acc[ai][bj][m][1];
                    if (!ctxt && within >= 64) { const int p0 = (within - 64) >> 1; const f32x4 cs = *(const f32x4*)(cosM + (size_t)pos * 16 + p0), sn = *(const f32x4*)(sinM + (size_t)pos * 16 + p0); rope8(v0, v1, cs, sn); }
                    v0 = v0 * QS96; v1 = v1 * QS96;
                    *(u32x4*)(QM + (size_t)row * 768 + col0) = pack8(v0, v1);
                }
                asm volatile("" ::: "memory");
            }
    }
};
struct EpiKV {
    static constexpr bool PERM = true, AFTER_DRAIN = false;
    unsigned char* ws;
    DI void operator()(const f32x4 (&acc)[2][2][4][2], const pg8::Unit& u, int wr, int wc, int fr, int fq) const {
        bf16_t* KM = (bf16_t*)(ws + WS_KM); bf16_t* VM = (bf16_t*)(ws + WS_VM);
        const int rowt = u.pm * 256 + wr * 64 + fr, colb = u.pn * 256 + wc * 32 + 8 * fq;
#pragma unroll
        for (int ai = 0; ai < 2; ++ai)
#pragma unroll
            for (int m = 0; m < 4; ++m) {
                const int row = rowt + ai * 128 + m * 16;
#pragma unroll
                for (int bj = 0; bj < 2; ++bj) {
                    const int col0 = colb + bj * 128;
                    bf16_t* dst = (col0 < 512) ? KM + (size_t)row * 768 + (col0 >> 6) * 96 + (col0 & 63) : VM + (size_t)row * 1024 + (col0 - 512);
                    *(u32x4*)dst = pack8(acc[ai][bj][m][0], acc[ai][bj][m][1]);
                }
                asm volatile("" ::: "memory");
            }
    }
};
template <bool DRYE> struct EpiBrT {
    static constexpr bool PERM = true, AFTER_DRAIN = false;
    unsigned char* ws;
    DI void operator()(const f32x4 (&acc)[2][2][4][2], const pg8::Unit& u, int wr, int wc, int fr, int fq) const {
        bf16_t* P = (bf16_t*)(ws + WS_P);
        unsigned chk = 0u;
        const int rowt = u.pm * 256 + wr * 64 + fr, colb = u.pn * 256 + wc * 32 + 8 * fq;
#pragma unroll
        for (int ai = 0; ai < 2; ++ai)
#pragma unroll
            for (int m = 0; m < 4; ++m) {
                const int row = rowt + ai * 128 + m * 16;
#pragma unroll
                for (int bj = 0; bj < 2; ++bj) {
                    bf16_t* p = P + (size_t)row * NP + C_GM + colb + bj * 128;
                    const u32x4 g = *(const u32x4*)p;
                    f32x4 v0 = acc[ai][bj][m][0], v1 = acc[ai][bj][m][1];
                    v0[0] *= sigm_f(bflo(g.x)); v0[1] *= sigm_f(bfhi(g.x)); v0[2] *= sigm_f(bflo(g.y)); v0[3] *= sigm_f(bfhi(g.y));
                    v1[0] *= sigm_f(bflo(g.z)); v1[1] *= sigm_f(bfhi(g.z)); v1[2] *= sigm_f(bflo(g.w)); v1[3] *= sigm_f(bfhi(g.w));
                    { const u32x4 w_ = pack8(v0, v1); if (!DRYE) *(u32x4*)p = w_; else chk ^= w_.x ^ w_.y ^ w_.z ^ w_.w; }
                }
            }
        if (DRYE && chk == 0x12345678u) *(unsigned*)P = chk;
    }
};
template <bool DRYE> struct EpiOutT {
    static constexpr bool PERM = true, AFTER_DRAIN = false;
    int l, g; const float* xsrc; float* xdst; const float* ctxsrc; unsigned char* ws;
    DI void operator()(const f32x4 (&acc)[2][2][4][2], const pg8::Unit& u, int wr, int wc, int fr, int fq) const {
        float* ctxdst = (float*)(ws + WS_CTX); const float* mod = (const float*)(ws + WS_MOD) + (size_t)l * 9 * 3072;
        const int pmb = u.pm % 33, b = g * GB + u.pm / 33; const bool ctxt = pmb == 0;
        if (ctxt && l != 0) return;
        const float* gate = mod + (size_t)(ctxt ? 8 : b) * 3072 + 2048;
        const int colb = u.pn * 256 + wc * 32 + 8 * fq;
#pragma unroll
        for (int ai = 0; ai < 2; ++ai)
#pragma unroll
            for (int m = 0; m < 4; ++m) {
                const int j = pmb * 256 + ai * 128 + wr * 64 + m * 16 + fr;
                const size_t idx = ctxt ? ((size_t)b * CTX + j) * DM : ((size_t)b * SEQ + (j - CTX)) * DM;
                const float* s = (ctxt ? ctxsrc : xsrc) + idx; float* d = (ctxt ? ctxdst : xdst) + idx;
#pragma unroll
                for (int bj = 0; bj < 2; ++bj) {
                    const int col0 = colb + bj * 128;
                    const f32x4 g0 = *(const f32x4*)(gate + col0), g1 = *(const f32x4*)(gate + col0 + 4);
                    const f32x4 x0 = *(const f32x4*)(s + col0), x1 = *(const f32x4*)(s + col0 + 4);
                    if (!DRYE || x0[0] == 12345.678f) { *(f32x4*)(d + col0) = x0 + g0 * acc[ai][bj][m][0];
                    *(f32x4*)(d + col0 + 4) = x1 + g1 * acc[ai][bj][m][1]; }
                }
            }
    }
};

#define MFMA32(a, b, c) __builtin_amdgcn_mfma_f32_32x32x16_bf16((a), (b), (c), 0, 0, 0)
DI s16x4 tr16(const LAS unsigned char* p) { typedef short v4i16_t __attribute__((ext_vector_type(4))); return __builtin_bit_cast(s16x4, __builtin_amdgcn_ds_read_tr16_b64_v4i16((LAS v4i16_t*)p)); }
constexpr int AT_KOFF = 0, AT_KBUFMAX = 13312, AT_VOFF = 3 * AT_KBUFMAX, AT_VBUFMAX = 20480, AT_SOFF = AT_VOFF + 3 * AT_VBUFMAX, AT_QOFF = AT_SOFF + 1024;
static_assert(AT_QOFF + 8 * 6144 <= LDS_BYTES, "attention LDS map");
#ifndef AT_SGB
#define AT_SGB 0
#endif
#ifndef AT_PV8
#define AT_PV8 0
#endif
#ifndef AT_NOSBAR
#define AT_NOSBAR 0
#endif
#if AT_NOSBAR
#define SBAR() do {} while (0)
#else
#define SBAR() __builtin_amdgcn_sched_barrier(0)
#endif
#ifndef PROBE_MODE
#define PROBE_MODE 0
#endif
#ifndef DRY_SEL
#define DRY_SEL 7
#endif
#ifndef AT_QL
#define AT_QL 1
#endif
#ifndef AT_SB
#define AT_SB 0
#endif
template <int DQK, bool QL>
DI void at_qkt(f32x16& p0, f32x16& p1, const LAS unsigned char* kb, const bf16x8* qf, const LAS unsigned char* qb) {
    constexpr int KSTR = DQK + 8;
#pragma unroll
    for (int r = 0; r < 16; ++r) { p0[r] = 0.f; p1[r] = 0.f; }
#pragma unroll
    for (int ds = 0; ds < DQK / 16; ++ds) {
        const bf16x8 k0 = *(const LAS bf16x8*)(kb + ds * 32), k1 = *(const LAS bf16x8*)(kb + 32 * (KSTR * 2) + ds * 32);
        bf16x8 q; if (QL) q = *(const LAS bf16x8*)(qb + ds * 1024); else q = qf[ds];
        p0 = MFMA32(k0, q, p0); p1 = MFMA32(k1, q, p1);
        if (AT_SB && DQK > 64 && (ds & 1)) __builtin_amdgcn_sched_barrier(0x7f); }
}
DI void at_mask(f32x16& p0, f32x16& p1, int dk) {
#pragma unroll
    for (int r = 0; r < 16; ++r) { const int d = dk + (r & 3) + 8 * (r >> 2);
        if (d > 128 || d < -128) p0[r] = NEGBIG;
        if (d + 32 > 128 || d + 32 < -128) p1[r] = NEGBIG; }
}
DI void at_psm(f32x16& p0, f32x16& p1, float& mrun, float& alpha) {
    float ma = fmaxf(fmaxf(p0[0], p0[1]), p0[2]), mb = fmaxf(fmaxf(p1[0], p1[1]), p1[2]);
    ma = fmaxf(fmaxf(ma, p0[3]), p1[3]);
#pragma unroll
    for (int r = 4; r < 16; r += 2) { ma = fmaxf(fmaxf(ma, p0[r]), p0[r + 1]); mb = fmaxf(fmaxf(mb, p1[r]), p1[r + 1]); }
    float mx = fmaxf(ma, mb);
    { auto rr = __builtin_amdgcn_permlane32_swap(__float_as_uint(mx), __float_as_uint(mx), false, false); mx = fmaxf(__uint_as_float(rr[0]), __uint_as_float(rr[1])); }
    const bool keep = __all(mx - mrun <= THR);
    const float mn = keep ? mrun : fmaxf(mrun, mx); alpha = __builtin_amdgcn_exp2f(mrun - mn); mrun = mn;
#pragma unroll
    for (int r = 0; r < 16; ++r) { p0[r] -= mrun; p1[r] -= mrun; }
#pragma unroll
    for (int r = 0; r < 16; ++r) p0[r] = __builtin_amdgcn_exp2f(p0[r]);
}
DI void at_fsm(f32x16& p0, f32x16& p1, float alpha, float& lrun, bf16x8* pa) {
#pragma unroll
    for (int r = 0; r < 16; ++r) p1[r] = __builtin_amdgcn_exp2f(p1[r]);
    float ps = 0.f;
#pragma unroll
    for (int r = 0; r < 16; ++r) ps += p0[r] + p1[r];
    lrun = lrun * alpha + ps;
    u32x4 w;
    w.x = pk2(p0[0], p0[1]); w.y = pk2(p0[2], p0[3]); w.z = pk2(p0[4], p0[5]); w.w = pk2(p0[6], p0[7]); pa[0] = __builtin_bit_cast(bf16x8, w);
    w.x = pk2(p0[8], p0[9]); w.y = pk2(p0[10], p0[11]); w.z = pk2(p0[12], p0[13]); w.w = pk2(p0[14], p0[15]); pa[1] = __builtin_bit_cast(bf16x8, w);
    w.x = pk2(p1[0], p1[1]); w.y = pk2(p1[2], p1[3]); w.z = pk2(p1[4], p1[5]); w.w = pk2(p1[6], p1[7]); pa[2] = __builtin_bit_cast(bf16x8, w);
    w.x = pk2(p1[8], p1[9]); w.y = pk2(p1[10], p1[11]); w.z = pk2(p1[12], p1[13]); w.w = pk2(p1[14], p1[15]); pa[3] = __builtin_bit_cast(bf16x8, w);
}
DI void at_fsm_fake(f32x16& p0, f32x16& p1, bf16x8* pa) {
    u32x4 w;
    w.x = pk2(p0[0], p0[1]); w.y = pk2(p0[2], p0[3]); w.z = pk2(p0[4], p0[5]); w.w = pk2(p0[6], p0[7]); pa[0] = __builtin_bit_cast(bf16x8, w);
    w.x = pk2(p0[8], p0[9]); w.y = pk2(p0[10], p0[11]); w.z = pk2(p0[12], p0[13]); w.w = pk2(p0[14], p0[15]); pa[1] = __builtin_bit_cast(bf16x8, w);
    w.x = pk2(p1[0], p1[1]); w.y = pk2(p1[2], p1[3]); w.z = pk2(p1[4], p1[5]); w.w = pk2(p1[6], p1[7]); pa[2] = __builtin_bit_cast(bf16x8, w);
    w.x = pk2(p1[8], p1[9]); w.y = pk2(p1[10], p1[11]); w.z = pk2(p1[12], p1[13]); w.w = pk2(p1[14], p1[15]); pa[3] = __builtin_bit_cast(bf16x8, w);
}
template <int DV>
DI void at_pv(f32x16* o, const LAS unsigned char* vb, const bf16x8* pa) {
    constexpr int VSTR = DV + 32;
#pragma unroll
    for (int db = 0; db < DV / 32; ++db) {
#if AT_PV8
        s16x4 vlo[4], vhi[4];
#pragma unroll
        for (int ks = 0; ks < 4; ++ks) { vlo[ks] = tr16(vb + (16 * ks) * (VSTR * 2) + db * 64); vhi[ks] = tr16(vb + (16 * ks + 8) * (VSTR * 2) + db * 64); }
#pragma unroll
        for (int ks = 0; ks < 4; ++ks) { const bf16x8 vf = __builtin_shufflevector(vlo[ks], vhi[ks], 0, 1, 2, 3, 4, 5, 6, 7); o[db] = MFMA32(pa[ks], vf, o[db]); }
#else
#pragma unroll
        for (int kh = 0; kh < 2; ++kh) {
            s16x4 vlo[2], vhi[2];
#pragma unroll
            for (int k2 = 0; k2 < 2; ++k2) { const int ks = 2 * kh + k2; vlo[k2] = tr16(vb + (16 * ks) * (VSTR * 2) + db * 64); vhi[k2] = tr16(vb + (16 * ks + 8) * (VSTR * 2) + db * 64); }
#pragma unroll
            for (int k2 = 0; k2 < 2; ++k2) { const bf16x8 vf = __builtin_shufflevector(vlo[k2], vhi[k2], 0, 1, 2, 3, 4, 5, 6, 7); o[db] = MFMA32(pa[2 * kh + k2], vf, o[db]); }
        }
#endif
    }
}
template <int DV>
DI void at_scale_o(f32x16* o, LAS float* scw, float val, int r32, int hi) {
    if (hi == 0) scw[r32] = val;
    __builtin_amdgcn_wave_barrier(); asm volatile("" ::: "memory");
#pragma unroll
    for (int g4 = 0; g4 < 4; ++g4) { const f32x4 a4 = *(const LAS f32x4*)(scw + 8 * g4 + 4 * hi);
#pragma unroll
        for (int db = 0; db < DV / 32; ++db) { o[db][4 * g4 + 0] *= a4[0]; o[db][4 * g4 + 1] *= a4[1]; o[db][4 * g4 + 2] *= a4[2]; o[db][4 * g4 + 3] *= a4[3]; } }
    __builtin_amdgcn_wave_barrier(); asm volatile("" ::: "memory");
}
template <int DQK, int DV, int OUTM, bool MASKED>
DI void attn_unit(LAS unsigned char* lds, const bf16_t* Qp, int ldq, const bf16_t* Kp, int ldk, const bf16_t* Vp, int ldv,
                  int nA, int rowB0, int nB, int posB0, int qpos0, float m0, float l0,
                  bf16_t* Og, int ldo, float* Of, int ldof) {
    constexpr int KSTR = DQK + 8, VSTR = DV + 32, KBUF = 64 * KSTR * 2, VBUF = 64 * VSTR * 2;
    constexpr int KCH = DQK / 8, VCH = DV / 8, NKC = 64 * KCH, NVC = 64 * VCH, KRN = (NKC + 511) / 512, VRN = (NVC + 511) / 512;
    static_assert(KBUF <= AT_KBUFMAX && VBUF <= AT_VBUFMAX, "attention LDS map");
    const int tid = tid_l(), lane = tid & 63, wid = __builtin_amdgcn_readfirstlane(tid >> 6), r32 = lane & 31, hi = lane >> 5;
#ifndef AT_QL
#define AT_QL 1
#endif
#ifndef AT_SB
#define AT_SB 0
#endif
    constexpr bool QL = AT_QL && (DQK > 64);
    bf16x8 qf[QL ? 1 : DQK / 16];
    const LAS unsigned char* qb = lds + AT_QOFF + wid * 6144 + lane * 16;
    { const bf16_t* qrow = Qp + (size_t)(32 * wid + r32) * ldq + 8 * hi;
#pragma unroll
      for (int ds = 0; ds < DQK / 16; ++ds) { const bf16x8 v = *(const bf16x8*)(qrow + 16 * ds); if (QL) *(LAS bf16x8*)(lds + AT_QOFF + wid * 6144 + lane * 16 + ds * 1024) = v; else qf[QL ? 0 : ds] = v; }
      if (QL) { __builtin_amdgcn_wave_barrier(); asm volatile("s_waitcnt lgkmcnt(0)" ::: "memory"); } }
    f32x16 o[DV / 32];
#pragma unroll
    for (int db = 0; db < DV / 32; ++db)
#pragma unroll
        for (int r = 0; r < 16; ++r) o[db][r] = 0.f;
    float mrun = m0, lrun = (hi == 0) ? l0 : 0.f;
    LAS float* scw = (LAS float*)(lds + AT_SOFF) + wid * 32;
    const int NT = nA + nB;
    const LAS unsigned char* kb0 = lds + AT_KOFF + r32 * (KSTR * 2) + hi * 16;
    const LAS unsigned char* vb0 = lds + AT_VOFF + (4 * hi + ((lane & 15) >> 2)) * (VSTR * 2) + (16 * ((lane >> 4) & 1) + 4 * (lane & 3)) * 2;
    const int dk0 = posB0 + 4 * hi - (qpos0 + 32 * wid + r32) - 64 * nA;
    u32x4 kreg[KRN], vreg[VRN];
    int kgo[KRN], klo[KRN], vgo[VRN], vlo_[VRN];
#pragma unroll
    for (int i_ = 0; i_ < KRN; ++i_) { int c_ = tid + 512 * i_; if (c_ >= NKC) c_ -= 512; const int r_ = c_ / KCH, cc_ = c_ % KCH; kgo[i_] = r_ * ldk + cc_ * 8; klo[i_] = AT_KOFF + r_ * (KSTR * 2) + cc_ * 16; }
#pragma unroll
    for (int i_ = 0; i_ < VRN; ++i_) { int c_ = tid + 512 * i_; if (c_ >= NVC) c_ -= 512; const int r_ = c_ / VCH, cc_ = c_ % VCH; vgo[i_] = r_ * ldv + cc_ * 8; vlo_[i_] = AT_VOFF + r_ * (VSTR * 2) + cc_ * 16; }
#define AT_GLOAD(t) do { const int row0_ = (t) < nA ? 64 * (t) : rowB0 + 64 * ((t) - nA); const bf16_t* kt_ = Kp + (size_t)row0_ * ldk; const bf16_t* vt_ = Vp + (size_t)row0_ * ldv; \
        _Pragma("unroll") for (int i_ = 0; i_ < KRN; ++i_) kreg[i_] = *(const u32x4*)(kt_ + kgo[i_]); \
        _Pragma("unroll") for (int i_ = 0; i_ < VRN; ++i_) vreg[i_] = *(const u32x4*)(vt_ + vgo[i_]); } while (0)
#define AT_SWRITE(buf) do { \
        _Pragma("unroll") for (int i_ = 0; i_ < KRN; ++i_) *(LAS u32x4*)(lds + (buf) * KBUF + klo[i_]) = kreg[i_]; \
        _Pragma("unroll") for (int i_ = 0; i_ < VRN; ++i_) *(LAS u32x4*)(lds + (buf) * VBUF + vlo_[i_]) = vreg[i_]; } while (0)
    unsigned pfv = 0u, pfacc = 0u;
    const int pft = tid & 255;
    const bf16_t* pfb = (pft < 128) ? Kp + (pft >> 1) * ldk + (pft & 1) * (DQK - 2) : Vp + ((pft - 128) >> 1) * ldv + (pft & 1) * (DV - 2);
    const int pfs = (pft < 128) ? ldk : ldv;
    constexpr int PFD = 4;
#define AT_PF(t) do { pfacc ^= pfv; const int tt_ = (t) < NT ? (t) : NT - 1; const int row0_ = tt_ < nA ? 64 * tt_ : rowB0 + 64 * (tt_ - nA); \
        pfv = *(const unsigned*)(pfb + (size_t)row0_ * pfs); } while (0)
#define AT_MASK(P0, P1, t) do { if (MASKED && (t) >= nA) at_mask(P0, P1, dk0 + 64 * (t)); } while (0)
#define AT_RESC(al) do { if (__any((al) < 1.f)) at_scale_o<DV>(o, scw, (al), r32, hi); } while (0)
    constexpr int DRYP = (OUTM == 2) ? PROBE_MODE : 0;
    f32x16 pA0, pA1, pB0, pB1; float alA, alB; bf16x8 pa[4];
    AT_PF(1); AT_PF(2); AT_PF(3);
    AT_GLOAD(0); AT_SWRITE(0); __syncthreads();
    AT_GLOAD(1);
    at_qkt<DQK, QL>(pA0, pA1, kb0, qf, qb); AT_MASK(pA0, pA1, 0); at_psm(pA0, pA1, mrun, alA);
    AT_SWRITE(1); __syncthreads();
    int bp = 0, bc = 1, bn = 2;
    constexpr int NMF = 2 * (DQK / 16) + 4 * (DV / 32);
#if AT_SGB
#define AT_SCHED() do { _Pragma("unroll") for (int i_ = 0; i_ < NMF; ++i_) { __builtin_amdgcn_sched_group_barrier(0x008, 1, 0); __builtin_amdgcn_sched_group_barrier(0x100, 2, 0); __builtin_amdgcn_sched_group_barrier(0x002, AT_SGB, 0); } } while (0)
#else
#define AT_SCHED() do {} while (0)
#endif
#define AT_ROT() do { bp = bc; bc = bn; bn = (bn == 2) ? 0 : bn + 1; } while (0)
    for (int j = 1; j + 1 < ((DRYP == 6) ? 2 : NT); j += 2) {
        if (!(DRYP >= 1)) { AT_GLOAD(j + 1); AT_PF(j + PFD); }
        SBAR(); if (DRYP != 5) at_qkt<DQK, QL>(pB0, pB1, kb0 + bc * KBUF, qf, qb); else { _Pragma("unroll") for (int r_ = 0; r_ < 16; ++r_) { pB0[r_] = o[0][r_] * 1e-3f; pB1[r_] = o[1][r_] * 1e-3f; } } AT_MASK(pB0, pB1, j);
        if (DRYP != 3) at_fsm(pA0, pA1, alA, lrun, pa); else at_fsm_fake(pA0, pA1, pa); SBAR();
        if (DRYP != 4) at_pv<DV>(o, vb0 + bp * VBUF, pa); else { o[0][0] += __builtin_bit_cast(float, (int)pa[0][0] + (int)pa[1][1] + (int)pa[2][2] + (int)pa[3][3]); } if (DRYP != 3) at_psm(pB0, pB1, mrun, alB); else alB = 1.f;
        AT_SCHED();
        if (!(DRYP >= 1)) AT_SWRITE(bn);
        AT_RESC(alB); if (DRYP != 2) __syncthreads(); AT_ROT();
        if (!(DRYP >= 1)) { AT_GLOAD(j + 2); AT_PF(j + 1 + PFD); }
        SBAR(); if (DRYP != 5) at_qkt<DQK, QL>(pA0, pA1, kb0 + bc * KBUF, qf, qb); else { _Pragma("unroll") for (int r_ = 0; r_ < 16; ++r_) { pA0[r_] = o[0][r_] * 1e-3f; pA1[r_] = o[1][r_] * 1e-3f; } } AT_MASK(pA0, pA1, j + 1);
        if (DRYP != 3) at_fsm(pB0, pB1, alB, lrun, pa); else at_fsm_fake(pB0, pB1, pa); SBAR();
        if (DRYP != 4) at_pv<DV>(o, vb0 + bp * VBUF, pa); else { o[0][0] += __builtin_bit_cast(float, (int)pa[0][0] + (int)pa[1][1] + (int)pa[2][2] + (int)pa[3][3]); } if (DRYP != 3) at_psm(pA0, pA1, mrun, alA); else alA = 1.f;
        AT_SCHED();
        if (!(DRYP >= 1)) AT_SWRITE(bn);
        AT_RESC(alA); if (DRYP != 2) __syncthreads(); AT_ROT();
    }
    SBAR(); at_qkt<DQK, QL>(pB0, pB1, kb0 + bc * KBUF, qf, qb); AT_MASK(pB0, pB1, NT - 1);
    at_fsm(pA0, pA1, alA, lrun, pa); SBAR();
    at_pv<DV>(o, vb0 + bp * VBUF, pa); at_psm(pB0, pB1, mrun, alB);
    AT_RESC(alB);
    at_fsm(pB0, pB1, alB, lrun, pa); SBAR();
    at_pv<DV>(o, vb0 + bc * VBUF, pa);
#undef AT_ROT
#undef AT_SCHED
    pfacc ^= pfv;
    if (__builtin_expect(pfacc == 0x9e3779b9u && lrun == 12345.678f, 0)) scw[0] = 1.f;
#undef AT_GLOAD
#undef AT_PF
#undef AT_SWRITE
#undef AT_MASK
#undef AT_RESC
    { const float lt = lrun + __shfl_xor(lrun, 32); at_scale_o<DV>(o, scw, 1.0f / lt, r32, hi); }
    if (OUTM == 0) {
#pragma unroll
        for (int db = 0; db < DV / 32; ++db) {
            bf16_t* pb = Og + (size_t)(32 * wid + 4 * hi) * ldo + 32 * db + r32;
            bf16_t zz[16];
#pragma unroll
            for (int r = 0; r < 16; ++r) zz[r] = pb[(size_t)((r & 3) + 8 * (r >> 2)) * ldo];
#pragma unroll
            for (int r = 0; r < 16; ++r) { const float z = __uint_as_float((unsigned)zz[r] << 16); pb[(size_t)((r & 3) + 8 * (r >> 2)) * ldo] = (bf16_t)(pk2(o[db][r] * silu_f(z), 0.f) & 0xffffu); }
        }
    } else {
#pragma unroll
        for (int db = 0; db < DV / 32; ++db)
#pragma unroll
            for (int r = 0; r < 16; ++r) {
                const int q = (r & 3) + 8 * (r >> 2) + 4 * hi;
                if (OUTM == 1) { Of[(size_t)(32 * wid + q) * ldof + 32 * db + r32] = o[db][r]; }
                else { if (lrun == 12345.678f) Of[(size_t)(32 * wid + q) * ldof + 32 * db + r32] = o[db][r]; }
            }
    }
    __syncthreads();
}

struct Args { const float* in[21]; float* out; unsigned char* ws; };
typedef const __attribute__((address_space(4))) Args* ArgsP;
DI ArgsP args_ptr() { ArgsP p = (ArgsP)__builtin_amdgcn_kernarg_segment_ptr(); asm volatile("" : "+s"(p)); return p; }
enum { I_X = 0, I_C, I_CTX, I_CCTX, I_WMOD, I_BMOD, I_NORMG, I_WIN, I_QNORM, I_WUQ, I_KVNORM, I_WUKV, I_LQ1, I_LK1, I_LQ2, I_LK2, I_SUBLN, I_SINK, I_WBR, I_WOUT, I_FNORM };

DI int colmap(int kind, int n) {
    if (kind == 1) {
        if (n < C_KR) return n;
        if (n < C_KR + 32) { const int e = n - C_KR; return C_KR + (e >> 1) + 16 * (e & 1); }
        if (n < C_DQ) return -1;
        if ((n >= C_DQ && n < C_DV) || (n >= C_SQ && n < C_SV)) { const int w = n & 63; return (n - w) - 96 + (w >> 1) + 32 * (w & 1); }
        return n - 96;
    }
    if (kind == 2) { const int h = n / 96, e = n % 96; if (e < 64) return n; const int e2 = e - 64; return h * 96 + 64 + (e2 >> 1) + 16 * (e2 & 1); }
    if (kind == 3) { if (n < 512) return (n >> 6) * 192 + (n & 63); const int n2 = n - 512; return (n2 >> 7) * 192 + 64 + (n2 & 127); }
    return n;
}
DI void transpose_item(const float* W, int ldw, int kind, const float* rowscale, bf16_t* WT, int ldd, int koff, LAS float* scr, int item, int nblk, int lane) {
    const int kb = item / nblk, nb = item % nblk, k0 = 64 * kb, n0 = 32 * nb;
    const int oc = colmap(kind, n0 + (lane & 31));
#pragma unroll 8
    for (int i = 0; i < 32; ++i) { const int kk = 2 * i + (lane >> 5); float v = 0.f; if (oc >= 0) v = W[(size_t)(k0 + kk) * ldw + oc]; if (rowscale) v *= rowscale[k0 + kk]; scr[kk * 33 + (lane & 31)] = v; }
    __builtin_amdgcn_wave_barrier(); asm volatile("s_waitcnt lgkmcnt(0)" ::: "memory");
    const int c = lane & 7;
#pragma unroll
    for (int j = 0; j < 4; ++j) { const int n = (lane >> 3) + 8 * j; const LAS float* s = scr + (8 * c) * 33 + n;
        u32x4 o; o.x = pk2(s[0 * 33], s[1 * 33]); o.y = pk2(s[2 * 33], s[3 * 33]); o.z = pk2(s[4 * 33], s[5 * 33]); o.w = pk2(s[6 * 33], s[7 * 33]);
        *(u32x4*)(WT + (size_t)(n0 + n) * ldd + koff + k0 + 8 * c) = o; }
    __builtin_amdgcn_wave_barrier(); asm volatile("s_waitcnt lgkmcnt(0)" ::: "memory");
}
DI void prologue(ArgsP ap, LAS unsigned char* lds) {
    const int tid = tid_l(), lane = tid & 63, wid = __builtin_amdgcn_readfirstlane(tid >> 6);
    unsigned char* ws = ap->ws;
    LAS float* scr = (LAS float*)(lds + wid * 8448);
    const int gw = bid_l() * 8 + wid, NGW = grd_l() * 8;
    constexpr int I_IN = 16 * (NP / 32), I_UQ = 6 * 24, I_UKV = 4 * 48, I_SQ = 16 * 32, PER_L = I_IN + I_UQ + I_UKV + 6 * I_SQ;
    for (int it = gw; it < 2 * PER_L; it += NGW) {
        const int l = it / PER_L; int r = it % PER_L;
        if (r < I_IN) { transpose_item(ap->in[I_WIN] + (size_t)l * 1024 * D_IN, D_IN, 1, nullptr, (bf16_t*)(ws + WS_WIN) + (size_t)l * NP * 1024, 1024, 0, scr, r, NP / 32, lane); continue; } r -= I_IN;
        if (r < I_UQ) { transpose_item(ap->in[I_WUQ] + (size_t)l * 384 * 768, 768, 2, ap->in[I_QNORM] + l * 384, (bf16_t*)(ws + WS_WUQ) + (size_t)l * 768 * 384, 384, 0, scr, r, 24, lane); continue; } r -= I_UQ;
        if (r < I_UKV) { transpose_item(ap->in[I_WUKV] + (size_t)l * 256 * 1536, 1536, 3, ap->in[I_KVNORM] + l * 256, (bf16_t*)(ws + WS_WUKV) + (size_t)l * 1536 * 256, 256, 0, scr, r, 48, lane); continue; } r -= I_UKV;
        if (r < 3 * I_SQ) { const int br = r / I_SQ; transpose_item(ap->in[I_WBR] + ((size_t)l * 3 + br) * 1024 * 1024, 1024, 0, nullptr, (bf16_t*)(ws + WS_WB) + ((size_t)l * 3 + br) * 1024 * 1024, 1024, 0, scr, r % I_SQ, 32, lane); continue; } r -= 3 * I_SQ;
        { const int rep = r / I_SQ; transpose_item(ap->in[I_WOUT] + (size_t)l * 1024 * 1024, 1024, 0, nullptr, (bf16_t*)(ws + WS_WO3) + (size_t)l * 1024 * 3072, 3072, rep * 1024, scr, r % I_SQ, 32, lane); }
    }
    const int gt = bid_l() * 512 + tid, NGT = grd_l() * 512;
    for (int i = gt; i < SEQ * 48; i += NGT) {
        const int pos = i / 48, p = i % 48; const float frow = (float)(pos >> 6), fcol = (float)(pos & 63);
        float ang; float* cd; float* sd;
        if (p < 32) { const int f = p & 15; const float inv = powf(10000.0f, -(float)f / 16.0f); ang = (p < 16 ? frow : fcol) * inv; cd = (float*)(ws + WS_COSH) + pos * 32 + p; sd = (float*)(ws + WS_SINH) + pos * 32 + p; }
        else { const int pp = p - 32, f = pp & 7; const float inv = powf(10000.0f, -(float)f / 8.0f); ang = (pp < 8 ? frow : fcol) * inv; cd = (float*)(ws + WS_COSM) + pos * 16 + pp; sd = (float*)(ws + WS_SINM) + pos * 16 + pp; }
        *cd = __cosf(ang); *sd = __sinf(ang);
    }
    for (int it = gw; it < 2 * 16 * 48; it += NGW) {
        const int l = it / 768, rem = it % 768, kc = rem / 48, nb = rem % 48; const int k = kc * 64 + lane;
        float sv[9];
#pragma unroll
        for (int v = 0; v < 8; ++v) sv[v] = silu_f(ap->in[I_C][v * 1024 + k]);
        sv[8] = silu_f(ap->in[I_CCTX][k]);
        float acc[9];
#pragma unroll
        for (int v = 0; v < 9; ++v) acc[v] = 0.f;
        const float* w = ap->in[I_WMOD] + ((size_t)l * 1024 + kc * 64) * 3072 + nb * 64 + lane;
#pragma unroll 8
        for (int kk = 0; kk < 64; ++kk) { const float wv = w[(size_t)kk * 3072];
#pragma unroll
            for (int v = 0; v < 9; ++v) acc[v] += __uint_as_float(__builtin_amdgcn_readlane(__float_as_uint(sv[v]), kk)) * wv; }
        float* mp = (float*)(ws + WS_MODP) + ((size_t)(l * 16 + kc) * 9) * 3072 + nb * 64 + lane;
#pragma unroll
        for (int v = 0; v < 9; ++v) mp[(size_t)v * 3072] = acc[v];
    }
}
DI void mod_finalize(ArgsP ap) {
    const int tid = tid_l();
    const int gt = bid_l() * 512 + tid, NGT = grd_l() * 512;
    const float* mp = (const float*)(ap->ws + WS_MODP); float* mod = (float*)(ap->ws + WS_MOD);
    for (int i = gt; i < 2 * 9 * 3072; i += NGT) {
        const int l = i / (9 * 3072), rem = i % (9 * 3072), n = rem % 3072;
        float s = ap->in[I_BMOD][l * 3072 + n];
#pragma unroll
        for (int kc = 0; kc < 16; ++kc) s += mp[(size_t)(l * 16 + kc) * 9 * 3072 + rem];
        mod[i] = s;
    }
}
DI void ph_norm_mod(ArgsP ap, int l, int g) {
    const int tid = tid_l(), lane = tid & 63, wid = __builtin_amdgcn_readfirstlane(tid >> 6);
    const int gw = bid_l() * 8 + wid, NGW = grd_l() * 8;
    const float* ng = ap->in[I_NORMG] + l * 1024; const float* mod = (const float*)(ap->ws + WS_MOD) + (size_t)l * 9 * 3072;
    const float* xs = (l == 0) ? ap->in[I_X] : ap->out; const float* cs = (l == 0) ? ap->in[I_CTX] : (const float*)(ap->ws + WS_CTX);
    bf16_t* H = (bf16_t*)(ap->ws + WS_H);
    for (int r = gw; r < R; r += NGW) {
        const int bl = r / RB, j = r % RB, b = g * GB + bl;
        const float* src; const float* md;
        if (j < CTX) { src = cs + ((size_t)b * CTX + j) * DM; md = mod + 8 * 3072; } else { src = xs + ((size_t)b * SEQ + (j - CTX)) * DM; md = mod + (size_t)b * 3072; }
        f32x4 v[4]; float ss = 0.f;
#pragma unroll
        for (int q = 0; q < 4; ++q) { v[q] = *(const f32x4*)(src + 4 * (lane + 64 * q)); ss += (v[q][0] * v[q][0] + v[q][1] * v[q][1]) + (v[q][2] * v[q][2] + v[q][3] * v[q][3]); }
        const float rstd = 1.0f / sqrtf(wave_sum(ss) * (1.0f / DM) + EPS);
#pragma unroll
        for (int q = 0; q < 4; ++q) { const int idx = 4 * (lane + 64 * q);
            const f32x4 gg = *(const f32x4*)(ng + idx), sh = *(const f32x4*)(md + idx), sc = *(const f32x4*)(md + 1024 + idx);
            const f32x4 y = (v[q] * rstd * gg) * (sc + 1.0f) + sh;
            u32x2 w; w.x = pk2(y[0], y[1]); w.y = pk2(y[2], y[3]); *(u32x2*)(H + (size_t)r * DM + idx) = w; }
    }
}
DI void ph_mla_norm(ArgsP ap) {
    const int tid = tid_l(), lane = tid & 63, wid = __builtin_amdgcn_readfirstlane(tid >> 6);
    const int gw = bid_l() * 8 + wid, NGW = grd_l() * 8;
    const bf16_t* P = (const bf16_t*)(ap->ws + WS_P); bf16_t* AQ = (bf16_t*)(ap->ws + WS_AQ); bf16_t* AKV = (bf16_t*)(ap->ws + WS_AKV); bf16_t* KM = (bf16_t*)(ap->ws + WS_KM);
    for (int r = gw; r < R; r += NGW) {
        const bf16_t* row = P + (size_t)r * NP;
        const u32x4 c0 = *(const u32x4*)(row + 8 * lane);
        u32x4 c1 = {0u, 0u, 0u, 0u}; if (lane < 20) c1 = *(const u32x4*)(row + 8 * (64 + lane));
        float f0[8] = {bflo(c0.x), bfhi(c0.x), bflo(c0.y), bfhi(c0.y), bflo(c0.z), bfhi(c0.z), bflo(c0.w), bfhi(c0.w)};
        float f1[8] = {bflo(c1.x), bfhi(c1.x), bflo(c1.y), bfhi(c1.y), bflo(c1.z), bfhi(c1.z), bflo(c1.w), bfhi(c1.w)};
        float s0 = 0.f, s1 = 0.f;
#pragma unroll
        for (int i = 0; i < 8; ++i) { s0 += f0[i] * f0[i]; s1 += f1[i] * f1[i]; }
        const float sq = wave_sum(lane < 48 ? s0 : 0.f);
        const float skv = wave_sum((lane >= 48 ? s0 : 0.f) + (lane < 16 ? s1 : 0.f));
        const float rq = 1.0f / sqrtf(sq * (1.0f / 384.0f) + EPS), rkv = 1.0f / sqrtf(skv * (1.0f / 256.0f) + EPS);
        { const float rr = lane < 48 ? rq : rkv; u32x4 w; w.x = pk2(f0[0] * rr, f0[1] * rr); w.y = pk2(f0[2] * rr, f0[3] * rr); w.z = pk2(f0[4] * rr, f0[5] * rr); w.w = pk2(f0[6] * rr, f0[7] * rr);
          if (lane < 48) *(u32x4*)(AQ + (size_t)r * 384 + 8 * lane) = w; else *(u32x4*)(AKV + (size_t)r * 256 + 8 * (lane - 48)) = w; }
        if (lane < 16) { u32x4 w; w.x = pk2(f1[0] * rkv, f1[1] * rkv); w.y = pk2(f1[2] * rkv, f1[3] * rkv); w.z = pk2(f1[4] * rkv, f1[5] * rkv); w.w = pk2(f1[6] * rkv, f1[7] * rkv);
            *(u32x4*)(AKV + (size_t)r * 256 + 8 * (16 + lane)) = w; }
        else if (lane < 20) {
#pragma unroll
            for (int h = 0; h < 8; ++h) *(u32x4*)(KM + (size_t)r * 768 + h * 96 + 64 + 8 * (lane - 16)) = c1; }
    }
}
template <bool DRYE>
DI void ph_diff_post(ArgsP ap, int l) {
    const int tid = tid_l(), lane = tid & 63, wid = __builtin_amdgcn_readfirstlane(tid >> 6);
    const int gw = bid_l() * 8 + wid, NGW = grd_l() * 8;
    const float lam_init = (l == 0) ? 0.2f : (0.8f - 0.6f * 0.7408182206817179f);
    const float d1 = wave_sum(ap->in[I_LQ1][l * 64 + lane] * ap->in[I_LK1][l * 64 + lane]), d2 = wave_sum(ap->in[I_LQ2][l * 64 + lane] * ap->in[I_LK2][l * 64 + lane]);
    const float lam = expf(d1) - expf(d2) + lam_init;
    const float sl0 = ap->in[I_SUBLN][l * 128 + 2 * lane] * (1.0f - lam_init), sl1 = ap->in[I_SUBLN][l * 128 + 2 * lane + 1] * (1.0f - lam_init);
    const float* OD = (const float*)(ap->ws + WS_OD); bf16_t* P = (bf16_t*)(ap->ws + WS_P);
    typedef float f32x2 __attribute__((ext_vector_type(2)));
    for (int r = gw; r < R; r += NGW) {
        if (l != 0 && (r % RB) < CTX) continue;
        const float* ob = OD + (size_t)r * 2048 + 2 * lane; unsigned* zb = (unsigned*)(P + (size_t)r * NP + C_Z + 1024 + 2 * lane);
        f32x2 o1[8], o2[8]; unsigned z[8];
#pragma unroll
        for (int h = 0; h < 8; ++h) { o1[h] = *(const f32x2*)(ob + (2 * h) * 128); o2[h] = *(const f32x2*)(ob + (2 * h + 1) * 128); z[h] = zb[h * 64]; }
#pragma unroll
        for (int h = 0; h < 8; ++h) {
            const float a0 = o1[h][0] - lam * o2[h][0], a1 = o1[h][1] - lam * o2[h][1];
            const float rstd = 1.0f / sqrtf(wave_sum(a0 * a0 + a1 * a1) * (1.0f / 128.0f) + EPS);
            if (!DRYE || rstd == 12345.678f) zb[h * 64] = pk2(a0 * rstd * sl0 * silu_f(bflo(z[h])), a1 * rstd * sl1 * silu_f(bfhi(z[h])));
        }
    }
}
template <bool DRYE>
DI void ph_final_norm(ArgsP ap) {
    const int tid = tid_l(), lane = tid & 63, wid = __builtin_amdgcn_readfirstlane(tid >> 6);
    const int gw = bid_l() * 8 + wid, NGW = grd_l() * 8; const float* fg = ap->in[I_FNORM];
    for (int r = gw; r < NBATCH * SEQ; r += NGW) {
        float* row = ap->out + (size_t)r * DM; f32x4 v[4]; float ss = 0.f;
#pragma unroll
        for (int q = 0; q < 4; ++q) { v[q] = *(const f32x4*)(row + 4 * (lane + 64 * q)); ss += (v[q][0] * v[q][0] + v[q][1] * v[q][1]) + (v[q][2] * v[q][2] + v[q][3] * v[q][3]); }
        const float rstd = 1.0f / sqrtf(wave_sum(ss) * (1.0f / DM) + EPS);
#pragma unroll
        for (int q = 0; q < 4; ++q) { const int idx = 4 * (lane + 64 * q); if (!DRYE || rstd == 12345.678f) *(f32x4*)(row + idx) = v[q] * rstd * *(const f32x4*)(fg + idx); }
    }
}
template <bool DRY>
DI void ph_attention(ArgsP ap, int l, LAS unsigned char* lds) {
    constexpr int OM0 = DRY ? 2 : 0;
    const int G = grd_l(), bx = bid_l(), vcu = (G % 8 == 0) ? (bx % 8) * (G / 8) + bx / 8 : bx;
    bf16_t* P = (bf16_t*)(ap->ws + WS_P); const bf16_t* QM = (const bf16_t*)(ap->ws + WS_QM); const bf16_t* KM = (const bf16_t*)(ap->ws + WS_KM); const bf16_t* VM = (const bf16_t*)(ap->ws + WS_VM);
    float* OD = (float*)(ap->ws + WS_OD); const float* sink = ap->in[I_SINK] + l * 16;
#if !defined(ATT_ONLY) || ATT_ONLY == 1
    if (!DRY || (DRY_SEL & 1))
    for (int u = vcu; u < GB * 8 * 32; u += G) { const int bh = u >> 5, qb = u & 31, bl = bh >> 3, h = bh & 7; const size_t rb = (size_t)bl * RB, q0 = rb + CTX + 256 * qb;
        attn_unit<96, 128, OM0, false>(lds, QM + q0 * 768 + h * 96, 768, KM + rb * 768 + h * 96, 768, VM + rb * 1024 + h * 128, 1024, RB / 64, 0, 0, 0, 0, NEGBIG, 0.f, P + q0 * NP + C_Z + h * 128, NP, OD, 0); }
#endif
#if !defined(ATT_ONLY) || ATT_ONLY == 2
    if (!DRY || (DRY_SEL & 2))
    for (int u = vcu; u < GB * 16 * 32; u += G) { const int bh = u >> 5, qb = u & 31, bl = bh >> 4, hm = bh & 15; const size_t rb = (size_t)bl * RB, q0 = rb + CTX + 256 * qb;
        attn_unit<64, 128, 1, false>(lds, P + q0 * NP + C_DQ + hm * 64, NP, P + rb * NP + C_DK + hm * 64, NP, P + rb * NP + C_DV + (hm >> 1) * 128, NP, RB / 64, 0, 0, 0, 0, NEGBIG, 0.f, nullptr, 0, OD + q0 * 2048 + hm * 128, 2048); }
#endif
#if !defined(ATT_ONLY) || ATT_ONLY == 3
    if (!DRY || (DRY_SEL & 4))
    for (int u = vcu; u < GB * 16 * 32; u += G) { const int bh = u >> 5, qb = u & 31, bl = bh >> 4, h = bh & 15; const size_t rb = (size_t)bl * RB, q0 = rb + CTX + 256 * qb;
        const int lo = (256 * qb - 128 < 0) ? 0 : 256 * qb - 128, hi = (256 * qb + 384 > SEQ) ? SEQ : 256 * qb + 384;
        attn_unit<64, 64, OM0, true>(lds, P + q0 * NP + C_SQ + h * 64, NP, P + rb * NP + C_SK + (h >> 2) * 64, NP, P + rb * NP + C_SV + (h >> 2) * 64, NP, CTX / 64, CTX + lo, (hi - lo) / 64, lo, 256 * qb, sink[h] * LOG2E, 1.0f,
                              P + q0 * NP + C_Z + 2048 + h * 64, NP, OD, 0); }
#endif
#if !defined(ATT_ONLY)
    if (l == 0) {
        for (int u = vcu; u < GB * 40; u += G) { const int bl = u / 40, k = u % 40; const size_t rb = (size_t)bl * RB;
            if (k < 8) { const int h = k;
                attn_unit<96, 128, OM0, false>(lds, QM + rb * 768 + h * 96, 768, KM + rb * 768 + h * 96, 768, VM + rb * 1024 + h * 128, 1024, CTX / 64, 0, 0, 0, 0, NEGBIG, 0.f, P + rb * NP + C_Z + h * 128, NP, OD, 0); }
            else if (k < 24) { const int hm = k - 8;
                attn_unit<64, 128, 1, false>(lds, P + rb * NP + C_DQ + hm * 64, NP, P + rb * NP + C_DK + hm * 64, NP, P + rb * NP + C_DV + (hm >> 1) * 128, NP, CTX / 64, 0, 0, 0, 0, NEGBIG, 0.f, nullptr, 0, OD + rb * 2048 + hm * 128, 2048); }
            else { const int h = k - 24;
                attn_unit<64, 64, OM0, false>(lds, P + rb * NP + C_SQ + h * 64, NP, P + rb * NP + C_SK + (h >> 2) * 64, NP, P + rb * NP + C_SV + (h >> 2) * 64, NP, CTX / 64, 0, 0, 0, 0, sink[h] * LOG2E, 1.0f, P + rb * NP + C_Z + 2048 + h * 64, NP, OD, 0); }
        }
    }
#endif
}

#define RLX_AGENT __ATOMIC_RELAXED, __HIP_MEMORY_SCOPE_AGENT
#define XB_TMO      128
#define XB_XCNT(j)  (256  + 64 * (j))
#define XB_XSUB(j)  (1280 + 64 * (j))
#define XB_XGEN(j)  (2304 + 64 * (j))
#define XB_TOP      3328
#define XB_TOPGEN   3392
#define XCD_BAR_WORDS 3456
#define XB_SPIN_CAP (1u << 18)

__device__ __forceinline__ unsigned xb_ld(unsigned* p)              { return __hip_atomic_load(p, __ATOMIC_RELAXED, __HIP_MEMORY_SCOPE_AGENT); }
__device__ __forceinline__ unsigned xb_add(unsigned* p, unsigned v) { return __hip_atomic_fetch_add(p, v, __ATOMIC_RELAXED, __HIP_MEMORY_SCOPE_AGENT); }
__device__ __forceinline__ unsigned xb_xcc_id() { return (unsigned)__builtin_amdgcn_s_getreg((3 << 11) | 20) & 0xFu; }
#define XB_SPIN(cond, bar) do { unsigned _sp = 0; while (cond) { __builtin_amdgcn_s_sleep(1); \
    if ((++_sp & 255u) == 0u) { if (xb_ld(&(bar)[XB_TMO])) break; if (_sp > XB_SPIN_CAP) { atomicAdd(&(bar)[XB_TMO], 1u); break; } } } } while (0)

struct XcdBarrier {
    unsigned* bar; unsigned x;
    volatile LAS unsigned* st;
};

__device__ __forceinline__ XcdBarrier xcd_barrier_post(unsigned* bar, volatile LAS unsigned* st) {
    XcdBarrier b; b.bar = bar; b.x = xb_xcc_id(); b.st = st;
    if (threadIdx.x == 0) (void)xb_add(&bar[XB_XCNT(b.x)], 1u);
    return b;
}
__device__ __forceinline__ void xcd_barrier_complete(unsigned* bar, unsigned x, unsigned& nloc, unsigned& nx) {
    const unsigned G = gridDim.x * gridDim.y * gridDim.z;
    unsigned sum, cnt, mine, sp = 0u;
    for (;;) {
        sum = 0u; cnt = 0u; mine = 0u;
#pragma unroll
        for (unsigned j = 0; j < 16; ++j) { const unsigned c = xb_ld(&bar[XB_XCNT(j)]); sum += c; cnt += (c > 0u) ? 1u : 0u; mine = (j == x) ? c : mine; }
        if (sum == G) break;
        __builtin_amdgcn_s_sleep(1);
        if ((++sp & 255u) == 0u) { if (xb_ld(&bar[XB_TMO])) break; if (sp > XB_SPIN_CAP) { atomicAdd(&bar[XB_TMO], 1u); break; } }
    }
    nloc = mine > 0u ? mine : 1u; nx = cnt > 0u ? cnt : 1u;
}

__device__ __forceinline__ void xcd_barrier(const XcdBarrier& b) {
    asm volatile("s_waitcnt vmcnt(0)" ::: "memory");
    __syncthreads();
    if (threadIdx.x == 0) {
        unsigned* bar = b.bar;
        __builtin_amdgcn_s_waitcnt(0);
        unsigned nloc = b.st[0], nx = b.st[1];
        if (nloc == 0u) { xcd_barrier_complete(bar, b.x, nloc, nx); b.st[0] = nloc; b.st[1] = nx; }
        const unsigned old = xb_add(&bar[XB_XSUB(b.x)], 1u);
        const unsigned gen = old / nloc;
        if (old + 1u == (gen + 1u) * nloc) {
            __builtin_amdgcn_fence(__ATOMIC_RELEASE, "agent");
            asm volatile("s_waitcnt vmcnt(0)" ::: "memory");
            const unsigned og = xb_add(&bar[XB_TOP], 1u);
            const unsigned tg = og / nx;
            if (og + 1u == (tg + 1u) * nx) xb_add(&bar[XB_TOPGEN], 1u);
            else XB_SPIN(xb_ld(&bar[XB_TOPGEN]) == tg, bar);
            __builtin_amdgcn_fence(__ATOMIC_ACQUIRE, "agent");
            xb_add(&bar[XB_XGEN(b.x)], 1u);
            asm volatile("s_waitcnt vmcnt(0)" ::: "memory");
        } else {
            XB_SPIN(xb_ld(&bar[XB_XGEN(b.x)]) == gen, bar);
            __builtin_amdgcn_fence(__ATOMIC_ACQUIRE, "agent");
            asm volatile("s_waitcnt vmcnt(0)" ::: "memory");
        }
    }
    __syncthreads();
}


__global__ void __launch_bounds__(512, 2) hybrid_fwd(Args a_unused) {
    extern __shared__ __attribute__((aligned(16))) unsigned char lds_raw[];
    LAS unsigned char* lds = (LAS unsigned char*)lds_raw;
    cg::grid_group grid = cg::this_grid();
    { volatile LAS unsigned* xst = (volatile LAS unsigned*)(lds + XB_LDS_OFF);
      if (threadIdx.x < 2) xst[threadIdx.x] = 0u;
      __syncthreads();
      (void)xcd_barrier_post((unsigned*)(args_ptr()->ws), xst); }
#define GSYNC() do { XcdBarrier b_; b_.bar = (unsigned*)(args_ptr()->ws); b_.x = xb_xcc_id(); b_.st = (volatile LAS unsigned*)(lds + XB_LDS_OFF); xcd_barrier(b_); } while (0)
#ifndef NO_PRO
    prologue(args_ptr(), lds);
#ifdef PROBE_PRO
    __syncthreads(); prologue(args_ptr(), lds);
#endif
#endif
    grid.sync();
    mod_finalize(args_ptr());
    GSYNC();
    for (int l = 0; l < 2; ++l) {
        for (int g = 0; g < NGRP; ++g) {
            ph_norm_mod(args_ptr(), lnd(l), lnd(g));
#ifdef PROBE_R1
            GSYNC(); ph_norm_mod(args_ptr(), lnd(l), lnd(g));
#endif
            GSYNC();
#ifndef NO_GEMM
            {
                unsigned char* ws = args_ptr()->ws; const int G = grd_l(), bx = bid_l();
                pg8::Gemm gm{1024, 1024, 1024}; pg8::Order S; S.init(R, NP, G, bx, ws + WS_H, 1024, (bf16_t*)(ws + WS_WIN) + (size_t)l * NP * 1024, 1024, 1 << 20, 0);
                EpiIn E{ws};
                pg8::gemm_phase<EpiIn, pg8::Order, true, true>(lds, gm, S, E);
#ifdef PROBE_G1
                __syncthreads(); pg8::gemm_phase<EpiIn, pg8::Order, true, true>(lds, gm, S, E);
#endif
            }
#endif
            GSYNC();
            ph_mla_norm(args_ptr());
#ifdef PROBE_R1
            GSYNC(); ph_mla_norm(args_ptr());
#endif
            GSYNC();
#ifndef NO_GEMM2
            {
                unsigned char* ws = args_ptr()->ws; const int G = grd_l(), bx = bid_l();
                pg8::Gemm gq{384, 384, 384}; pg8::Order Sq; Sq.init(R, 768, G, bx, ws + WS_AQ, 384, (bf16_t*)(ws + WS_WUQ) + (size_t)l * 768 * 384, 384, 1 << 20, 0);
                EpiQ Eq{ws};
#ifndef NO_GQ
                pg8::gemm_phase<EpiQ, pg8::Order, true, true>(lds, gq, Sq, Eq);
#ifdef PROBE_G2
                __syncthreads(); pg8::gemm_phase<EpiQ, pg8::Order, true, true>(lds, gq, Sq, Eq);
#endif
#endif
            }
            {
                unsigned char* ws = args_ptr()->ws; const int G = grd_l(), bx = bid_l();
                pg8::Gemm gk{256, 256, 256}; pg8::Order Sk; Sk.init(R, 1536, G, bx, ws + WS_AKV, 256, (bf16_t*)(ws + WS_WUKV) + (size_t)l * 1536 * 256, 256, 1 << 20, 0);
                EpiKV Ek{ws};
#ifndef NO_GK
                pg8::gemm_phase<EpiKV, pg8::Order, true, true>(lds, gk, Sk, Ek);
#ifdef PROBE_G2
                __syncthreads(); pg8::gemm_phase<EpiKV, pg8::Order, true, true>(lds, gk, Sk, Ek);
#endif
#endif
            }
#endif
            GSYNC();
#ifndef NO_ATT
#ifdef PROBE_ATT
            ph_attention<true>(args_ptr(), lnd(l), lds);
            GSYNC();
#endif
            ph_attention<false>(args_ptr(), lnd(l), lds);
#endif
            GSYNC();
#ifdef PROBE_R2
            ph_diff_post<true>(args_ptr(), lnd(l)); GSYNC();
#endif
            ph_diff_post<false>(args_ptr(), lnd(l));
            GSYNC();
#ifndef NO_BR
            {
                unsigned char* ws = args_ptr()->ws; const int G = grd_l(), bx = bid_l();
                pg8::Gemm gb{1024, NP, 1024}; pg8::Order S; S.init(R, 3072, G, bx, (bf16_t*)(ws + WS_P) + C_Z, NP, (bf16_t*)(ws + WS_WB) + (size_t)l * 3 * 1024 * 1024, 1024, 4, 1024 * 2, l != 0);
#ifdef PROBE_BR
                { EpiBrT<true> Ed{ws}; pg8::gemm_phase<EpiBrT<true>, pg8::Order, true, true>(lds, gb, S, Ed); __syncthreads(); }
#endif
                EpiBrT<false> E{ws};
                pg8::gemm_phase<EpiBrT<false>, pg8::Order, true, true>(lds, gb, S, E);
            }
#endif
            GSYNC();
#ifndef NO_OUT
            {
                ArgsP ap = args_ptr(); unsigned char* ws = ap->ws; const int G = grd_l(), bx = bid_l();
                pg8::Gemm go{3072, NP, 3072}; pg8::Order S; S.init(R, 1024, G, bx, (bf16_t*)(ws + WS_P) + C_GM, NP, (bf16_t*)(ws + WS_WO3) + (size_t)l * 1024 * 3072, 3072, 1 << 20, 0, l != 0);
#ifdef PROBE_OUT
                { EpiOutT<true> Ed{l, g, (l == 0) ? ap->in[I_X] : (const float*)ap->out, ap->out, ap->in[I_CTX], ws}; pg8::gemm_phase<EpiOutT<true>, pg8::Order, true, true>(lds, go, S, Ed); __syncthreads(); }
#endif
                EpiOutT<false> E{l, g, (l == 0) ? ap->in[I_X] : (const float*)ap->out, ap->out, ap->in[I_CTX], ws};
                pg8::gemm_phase<EpiOutT<false>, pg8::Order, true, true>(lds, go, S, E);
            }
#endif
        }
        GSYNC();
    }
#ifdef PROBE_R2
    ph_final_norm<true>(args_ptr()); GSYNC();
#endif
    ph_final_norm<false>(args_ptr());
}

extern "C" void kernel_launch(void* const* d_in, const int* in_sizes, int n_in, void* d_out, int out_size, void* d_ws, size_t ws_size, hipStream_t stream) {
    static int grid = 0;
    if (grid == 0) {
        if (n_in != 21 || ws_size < WS_END) { fprintf(stderr, "kernel_launch: expected 21 inputs and >= %zu bytes of workspace (got %d, %zu)\n", (size_t)WS_END, n_in, ws_size); grid = -1; return; }
        int dev = 0, cus = 0, per_cu = 0;
        (void)hipGetDevice(&dev); (void)hipDeviceGetAttribute(&cus, hipDeviceAttributeMultiprocessorCount, dev);
        if (hipFuncSetAttribute((const void*)hybrid_fwd, hipFuncAttributeMaxDynamicSharedMemorySize, LDS_BYTES) != hipSuccess) fprintf(stderr, "kernel_launch: hipFuncSetAttribute failed\n");
        if (hipOccupancyMaxActiveBlocksPerMultiprocessor(&per_cu, (const void*)hybrid_fwd, 512, LDS_BYTES) != hipSuccess || per_cu < 1) { per_cu = 1; (void)hipGetLastError(); }
        if (cus <= 0) cus = 256;
        grid = cus * per_cu;
    }
    if (grid < 0) return;
    Args a{};
    for (int i = 0; i < 21; ++i) a.in[i] = (const float*)d_in[i];
    a.out = (float*)d_out; a.ws = (unsigned char*)d_ws;
    (void)hipMemsetAsync(d_ws, 0, 16384, stream);
    void* args[] = {&a};
    hipError_t e = hipLaunchCooperativeKernel((const void*)hybrid_fwd, dim3(grid), dim3(512), args, LDS_BYTES, stream);
    if (e != hipSuccess) fprintf(stderr, "kernel_launch: cooperative launch failed: %s (grid %d)\n", hipGetErrorString(e), grid);
}
```

```cpp
#include <hip/hip_runtime.h>
#include <hip/hip_cooperative_groups.h>
#include <cstdio>
#include <cstdint>
namespace cg = cooperative_groups;

#define DI __device__ __forceinline__
#define LAS __attribute__((address_space(3)))
__device__ __forceinline__ int tid_l() { int t = threadIdx.x; asm volatile("" : "+v"(t)); return t; }
__device__ __forceinline__ int bid_l() { int b = blockIdx.x; asm volatile("" : "+s"(b)); return b; }
__device__ __forceinline__ int lnd(int x) { asm volatile("" : "+s"(x)); return x; }
__device__ __forceinline__ int grd_l() { int g = gridDim.x; asm volatile("" : "+s"(g)); return g; }
typedef unsigned short bf16_t;
typedef short bf16x8 __attribute__((ext_vector_type(8)));
typedef short s16x4 __attribute__((ext_vector_type(4)));
typedef float f32x4 __attribute__((ext_vector_type(4)));
typedef float f32x16 __attribute__((ext_vector_type(16)));
typedef unsigned u32x4 __attribute__((ext_vector_type(4)));
typedef unsigned u32x2 __attribute__((ext_vector_type(2)));

constexpr int DM = 1024, NBATCH = 8, SEQ = 8192, CTX = 256, RB = CTX + SEQ;
constexpr int GB = 2, NGRP = NBATCH / GB, R = GB * RB;
constexpr int NP = 11520;
constexpr int C_QC = 0, C_KVC = 384, C_KR = 640, C_DQ = 768, C_DK = 1792, C_DV = 2816, C_SQ = 3840, C_SK = 4864, C_SV = 5120, C_Z = 5376, C_GM = 8448;
constexpr int D_IN = 11424;
constexpr float EPS = 1e-6f, LOG2E = 1.4426950408889634f;
constexpr float QS64 = 0.125f * LOG2E, QS96 = 0.10206207261596575f * LOG2E;
constexpr float NEGBIG = -1e30f, THR = 8.0f;

constexpr size_t al256(size_t x) { return (x + 255) & ~(size_t)255; }
constexpr size_t WS_WIN = 1u << 20;
constexpr size_t WS_WUQ = al256(WS_WIN + (size_t)2 * NP * 1024 * 2);
constexpr size_t WS_WUKV = al256(WS_WUQ + (size_t)2 * 768 * 384 * 2);
constexpr size_t WS_WB = al256(WS_WUKV + (size_t)2 * 1536 * 256 * 2);
constexpr size_t WS_WO3 = al256(WS_WB + (size_t)2 * 3 * 1024 * 1024 * 2);
constexpr size_t WS_COSH = al256(WS_WO3 + (size_t)2 * 1024 * 3072 * 2);
constexpr size_t WS_SINH = al256(WS_COSH + (size_t)SEQ * 32 * 4);
constexpr size_t WS_COSM = al256(WS_SINH + (size_t)SEQ * 32 * 4);
constexpr size_t WS_SINM = al256(WS_COSM + (size_t)SEQ * 16 * 4);
constexpr size_t WS_MODP = al256(WS_SINM + (size_t)SEQ * 16 * 4);
constexpr size_t WS_MOD = al256(WS_MODP + (size_t)16 * 2 * 9 * 3072 * 4);
constexpr size_t WS_CTX = al256(WS_MOD + (size_t)2 * 9 * 3072 * 4);
constexpr size_t WS_H = al256(WS_CTX + (size_t)NBATCH * CTX * DM * 4);
constexpr size_t WS_P = al256(WS_H + (size_t)R * DM * 2);
constexpr size_t WS_AQ = al256(WS_P + (size_t)R * NP * 2);
constexpr size_t WS_AKV = al256(WS_AQ + (size_t)R * 384 * 2);
constexpr size_t WS_QM = al256(WS_AKV + (size_t)R * 256 * 2);
constexpr size_t WS_KM = al256(WS_QM + (size_t)R * 768 * 2);
constexpr size_t WS_VM = al256(WS_KM + (size_t)R * 768 * 2);
constexpr size_t WS_OD = al256(WS_VM + (size_t)R * 1024 * 2);
constexpr size_t WS_END = al256(WS_OD + (size_t)R * 2048 * 4);
static_assert(WS_END <= ((size_t)1 << 30), "workspace map exceeds 1 GiB");

constexpr int LDS_BYTES = 155648, XB_LDS_OFF = 155136;

DI unsigned pk2(float lo, float hi) { typedef float f2_t __attribute__((ext_vector_type(2))); typedef __bf16 b2_t __attribute__((ext_vector_type(2)));
    f2_t v = {lo, hi}; b2_t b = __builtin_convertvector(v, b2_t); return __builtin_bit_cast(unsigned, b); }
DI u32x4 pack8(f32x4 a, f32x4 b) { u32x4 w; w.x = pk2(a[0], a[1]); w.y = pk2(a[2], a[3]); w.z = pk2(b[0], b[1]); w.w = pk2(b[2], b[3]); return w; }
DI float bflo(unsigned w) { return __uint_as_float(w << 16); }
DI float bfhi(unsigned w) { return __uint_as_float(w & 0xffff0000u); }
DI float wave_sum(float v) {
#pragma unroll
    for (int o = 1; o < 64; o <<= 1) v += __shfl_xor(v, o);
    return v; }
DI float silu_f(float z) { return z * __builtin_amdgcn_rcpf(1.0f + __expf(-z)); }
DI float sigm_f(float z) { return __builtin_amdgcn_rcpf(1.0f + __expf(-z)); }
DI void rope8(f32x4& v0, f32x4& v1, const f32x4 cs, const f32x4 sn) {
    float a, b;
    a = v0[0]; b = v0[1]; v0[0] = a * cs[0] - b * sn[0]; v0[1] = b * cs[0] + a * sn[0];
    a = v0[2]; b = v0[3]; v0[2] = a * cs[1] - b * sn[1]; v0[3] = b * cs[1] + a * sn[1];
    a = v1[0]; b = v1[1]; v1[0] = a * cs[2] - b * sn[2]; v1[1] = b * cs[2] + a * sn[2];
    a = v1[2]; b = v1[3]; v1[2] = a * cs[3] - b * sn[3]; v1[3] = b * cs[3] + a * sn[3];
}
namespace pg8 {
#define PG8_LAS __attribute__((address_space(3)))
typedef unsigned short bf16_t;
typedef short bf16x8 __attribute__((ext_vector_type(8)));
typedef float f32x4 __attribute__((ext_vector_type(4)));
typedef unsigned u32x4 __attribute__((ext_vector_type(4)));
constexpr int BM = 256, BK = 64, HALF = 128, HTB = HALF * BK * 2  , STAGE_BYTES = 8 * HTB, NXCD = 8, WGM = 8;

__host__ __device__ __forceinline__ int lds_byte(int r, int c) { const int st = (r >> 4) * 2 + (c >> 5), rr = r & 15, cc = c & 31, ob = rr * 64 + cc * 2; return st * 1024 + (ob ^ (((ob >> 9) & 1) << 5)); }
__host__ __device__ __forceinline__ void stage_rc(int b, int& R, int& C) { const int st = b / 1024, sb = b % 1024, swz = sb ^ (((sb >> 9) & 1) << 5); R = (st >> 1) * 16 + swz / 64; C = (st & 1) * 32 + (swz % 64) / 2; }
__host__ __device__ __forceinline__ int perm32(int rho) { const int n = rho >> 4, i = rho & 15; return 8 * (i >> 2) + 4 * n + (i & 3); }

struct Unit { int pm, pn; };
struct Gemm { int K, lda, ldb; };
struct Order {
    int nM, nN, nwg, G, c; const char* A; const char* B; unsigned tA, tB; int pnblk; unsigned ablk; int skipctx;
    __device__ __forceinline__ void init(int M, int N, int G_, int c_, const void* A_, int lda, const void* B_, int ldb, int pnblk_, unsigned ablk_, int skipctx_ = 0) {
        skipctx = skipctx_; nM = M / BM; if (skipctx) nM -= nM / 33;
        nN = N / BM; nwg = nM * nN; G = G_; c = c_; A = (const char*)A_; B = (const char*)B_; tA = (unsigned)(BM * lda * 2); tB = (unsigned)(BM * ldb * 2); pnblk = pnblk_; ablk = ablk_; }
    __device__ __forceinline__ bool next(int i, Unit& u) const {
        const long L = (long)i * G + c; if (L >= nwg) return false;
        int wgid = (int)L; { const int q = nwg / NXCD, r = nwg % NXCD, xcd = wgid % NXCD, off = wgid / NXCD; wgid = (xcd < r ? xcd * (q + 1) : r * (q + 1) + (xcd - r) * q) + off; }
        const int nig = WGM * nN, gid = wgid / nig, fm = gid * WGM, gsz = (nM - fm) < WGM ? (nM - fm) : WGM;
        u.pm = fm + ((wgid % nig) % gsz); u.pn = (wgid % nig) / gsz; if (skipctx) u.pm += u.pm / 32 + 1; return true;
    }
    __device__ __forceinline__ const char* a_base(const Unit& u) const { return A + (size_t)u.pm * tA + (size_t)(u.pn / pnblk) * ablk; }
    __device__ __forceinline__ const char* b_base(const Unit& u) const { return B + (size_t)u.pn * tB; }
};

template <class Epi, class Sched, bool ALIGN_EPI = false, bool SP2 = false>
__device__ __forceinline__ void gemm_phase(PG8_LAS unsigned char* lds, const Gemm g, const Sched& S, const Epi& E) {
    const int tid = tid_l(), wid = __builtin_amdgcn_readfirstlane(tid >> 6), lane = tid & 63, wr = wid >> 2, wc = wid & 3, fr = lane & 15, fq = lane >> 4;
    const int K = g.K, nt = K / BK;
    unsigned voffA[2], voffB[2];
#pragma unroll
    for (int i = 0; i < 2; ++i) { int R, C; stage_rc(tid * 16 + i * 8192, R, C); const int Rb = Epi::PERM ? ((R & ~31) + perm32(R & 31)) : R;
        voffA[i] = (unsigned)(R * g.lda + C) * 2u; voffB[i] = (unsigned)(Rb * g.ldb + C) * 2u; }
    const size_t kstep = (size_t)(BK * 2);
    const size_t hstepA = (size_t)HALF * g.lda * 2, hstepB = (size_t)HALF * g.ldb * 2;
    const unsigned ldsw = (unsigned)wid * 1024u;
    const int aoff = lds_byte(wr * 64 + fr, fq * 8), boff = lds_byte(wc * 32 + fr, fq * 8);
#define PG8_SA(b, h) (((b) * 2 + (h)) * HTB)
#define PG8_SB(b, h) ((4 + (b) * 2 + (h)) * HTB)
#define PG8_STAGE(bufoff, gbase, voff) do { _Pragma("unroll") for (int _i = 0; _i < 2; ++_i) \
        __builtin_amdgcn_global_load_lds((const unsigned*)((const char*)(gbase) + (voff)[_i]), (PG8_LAS unsigned*)(lds + (bufoff) + ldsw + _i * 8192), 16, 0, 0); } while (0)
#define PG8_LDA(dst, b, h) do { _Pragma("unroll") for (int m = 0; m < 4; ++m) _Pragma("unroll") for (int k = 0; k < 2; ++k) dst[m][k] = *(const PG8_LAS bf16x8*)(lds + PG8_SA(b, h) + aoff + m * 2048 + k * 1024); } while (0)
#define PG8_LDB(dst, b, h) do { _Pragma("unroll") for (int n = 0; n < 2; ++n) _Pragma("unroll") for (int k = 0; k < 2; ++k) dst[n][k] = *(const PG8_LAS bf16x8*)(lds + PG8_SB(b, h) + boff + n * 2048 + k * 1024); } while (0)
#define PG8_MMA(ai, bj, At, Bt) do { __builtin_amdgcn_s_setprio(1); _Pragma("unroll") for (int m = 0; m < 4; ++m) _Pragma("unroll") for (int n = 0; n < 2; ++n) _Pragma("unroll") for (int k = 0; k < 2; ++k) \
        acc[ai][bj][m][n] = __builtin_amdgcn_mfma_f32_16x16x32_bf16(Bt[n][k], At[m][k], acc[ai][bj][m][n], 0, 0, 0); __builtin_amdgcn_s_setprio(0); } while (0)
#define PG8_WAIT_V(n) asm volatile("s_waitcnt vmcnt(" #n ")" ::: "memory")
#define PG8_WAIT_L(n) asm volatile("s_waitcnt lgkmcnt(" #n ")" ::: "memory")
#define PG8_BAR __builtin_amdgcn_s_barrier()
#define PG8_SCHED __builtin_amdgcn_sched_barrier(0)
    Unit cur, nxt; int ui = 0;
    if (!S.next(0, cur)) return;
    f32x4 acc[2][2][4][2];
#pragma unroll
    for (int a = 0; a < 2; ++a)
#pragma unroll
        for (int b = 0; b < 2; ++b)
#pragma unroll
            for (int m = 0; m < 4; ++m)
#pragma unroll
                for (int n = 0; n < 2; ++n) acc[a][b][m][n] = (f32x4){0.f, 0.f, 0.f, 0.f};
    bf16x8 At[4][2], B0[2][2], B1[2][2];
    const char* cA = S.a_base(cur); const char* cB = S.b_base(cur);

    if constexpr (SP2) {
        PG8_STAGE(PG8_SB(0, 0), cB, voffB); PG8_STAGE(PG8_SB(0, 1), cB + hstepB, voffB); PG8_STAGE(PG8_SA(0, 0), cA, voffA); PG8_STAGE(PG8_SA(0, 1), cA + hstepA, voffA);
        if (wr == 1) PG8_BAR;
        PG8_WAIT_V(2); PG8_BAR;
        PG8_STAGE(PG8_SB(1, 0), cB + kstep, voffB); PG8_STAGE(PG8_SA(1, 0), cA + kstep, voffA); PG8_STAGE(PG8_SB(1, 1), cB + hstepB + kstep, voffB);
        PG8_WAIT_V(6); PG8_BAR;
    } else {
        PG8_STAGE(PG8_SB(0, 0), cB, voffB); PG8_STAGE(PG8_SA(0, 0), cA, voffA); PG8_STAGE(PG8_SB(0, 1), cB + hstepB, voffB); PG8_STAGE(PG8_SA(0, 1), cA + hstepA, voffA);
        if (wr == 1) PG8_BAR;
        PG8_WAIT_V(4); PG8_BAR;
        PG8_STAGE(PG8_SB(1, 0), cB + kstep, voffB); PG8_STAGE(PG8_SA(1, 0), cA + kstep, voffA); PG8_STAGE(PG8_SB(1, 1), cB + hstepB + kstep, voffB);
        PG8_WAIT_V(6); PG8_BAR;
    }
    for (;;) {
        const bool has_next = S.next(ui + 1, nxt);
        const char* nA = has_next ? S.a_base(nxt) : cA; const char* nB = has_next ? S.b_base(nxt) : cB;
#pragma nounroll
        for (int t = 0; t < nt; t += 2) {
            const bool last = (t == nt - 2);
            const char* a1 = cA + (size_t)(t + 1) * kstep;
            const char* a2 = last ? nA : cA + (size_t)(t + 2) * kstep; const char* b2 = last ? nB : cB + (size_t)(t + 2) * kstep;
            const char* a3 = a2 + kstep; const char* b3 = b2 + kstep;

            if constexpr (SP2) {
            PG8_LDB(B0, 0, 0); PG8_LDB(B1, 0, 1); PG8_SCHED; PG8_LDA(At, 0, 0); PG8_STAGE(PG8_SA(1, 1), a1 + hstepA, voffA);
            PG8_WAIT_V(8); PG8_WAIT_L(0); PG8_BAR; PG8_MMA(0, 0, At, B0); PG8_MMA(0, 1, At, B1); PG8_BAR; PG8_SCHED;
            PG8_LDA(At, 0, 1); PG8_STAGE(PG8_SB(0, 0), b2, voffB); PG8_STAGE(PG8_SB(0, 1), b2 + hstepB, voffB); PG8_STAGE(PG8_SA(0, 0), a2, voffA);
            PG8_WAIT_V(8); PG8_WAIT_L(0); PG8_BAR; PG8_MMA(1, 0, At, B0); PG8_MMA(1, 1, At, B1); PG8_BAR; PG8_SCHED;
            PG8_LDB(B0, 1, 0); PG8_LDB(B1, 1, 1); PG8_SCHED; PG8_LDA(At, 1, 0); PG8_STAGE(PG8_SA(0, 1), a2 + hstepA, voffA);
            PG8_WAIT_V(8); PG8_WAIT_L(0); PG8_BAR; PG8_MMA(0, 0, At, B0); PG8_MMA(0, 1, At, B1); PG8_BAR; PG8_SCHED;
            PG8_LDA(At, 1, 1); PG8_STAGE(PG8_SB(1, 0), b3, voffB); PG8_STAGE(PG8_SB(1, 1), b3 + hstepB, voffB); PG8_STAGE(PG8_SA(1, 0), a3, voffA);
            PG8_WAIT_V(8); PG8_WAIT_L(0); PG8_BAR; PG8_MMA(1, 0, At, B0); PG8_MMA(1, 1, At, B1); PG8_BAR; PG8_SCHED;
            } else {
            PG8_LDB(B0, 0, 0); PG8_SCHED; PG8_LDA(At, 0, 0); PG8_STAGE(PG8_SA(1, 1), a1 + hstepA, voffA);
            PG8_WAIT_L(8); PG8_BAR; PG8_WAIT_L(0); PG8_MMA(0, 0, At, B0); PG8_BAR; PG8_SCHED;
            PG8_LDB(B1, 0, 1); PG8_STAGE(PG8_SB(0, 0), b2, voffB);
            PG8_BAR; PG8_WAIT_L(0); PG8_MMA(0, 1, At, B1); PG8_BAR;
            PG8_LDA(At, 0, 1); PG8_STAGE(PG8_SA(0, 0), a2, voffA);
            PG8_BAR; PG8_WAIT_L(0); PG8_MMA(1, 0, At, B0); PG8_BAR; PG8_SCHED;
            PG8_STAGE(PG8_SB(0, 1), b2 + hstepB, voffB);
            PG8_WAIT_V(6); PG8_BAR; PG8_MMA(1, 1, At, B1); PG8_BAR;
            PG8_LDB(B0, 1, 0); PG8_SCHED; PG8_LDA(At, 1, 0); PG8_STAGE(PG8_SA(0, 1), a2 + hstepA, voffA);
            PG8_WAIT_L(8); PG8_BAR; PG8_WAIT_L(0); PG8_MMA(0, 0, At, B0); PG8_BAR; PG8_SCHED;
            PG8_LDB(B1, 1, 1); PG8_STAGE(PG8_SB(1, 0), b3, voffB);
            PG8_BAR; PG8_WAIT_L(0); PG8_MMA(0, 1, At, B1); PG8_BAR;
            PG8_LDA(At, 1, 1); PG8_STAGE(PG8_SA(1, 0), a3, voffA);
            PG8_BAR; PG8_WAIT_L(0); PG8_MMA(1, 0, At, B0); PG8_BAR; PG8_SCHED;
            PG8_STAGE(PG8_SB(1, 1), b3 + hstepB, voffB);
            PG8_WAIT_V(6); PG8_BAR; PG8_MMA(1, 1, At, B1); PG8_BAR;
            }
        }
        if constexpr (ALIGN_EPI) { if (wr == 0) PG8_BAR; }
        if constexpr (!Epi::AFTER_DRAIN) { E(acc, cur, wr, wc, fr, fq); }
        if (!has_next) break;
#pragma unroll
        for (int a = 0; a < 2; ++a)
#pragma unroll
            for (int b = 0; b < 2; ++b)
#pragma unroll
                for (int m = 0; m < 4; ++m)
#pragma unroll
                    for (int n = 0; n < 2; ++n) acc[a][b][m][n] = (f32x4){0.f, 0.f, 0.f, 0.f};
        cur = nxt; cA = nA; cB = nB; ++ui;
        if constexpr (ALIGN_EPI) { if (wr == 1) PG8_BAR; }
    }
    PG8_WAIT_V(0);
    if constexpr (!ALIGN_EPI) { if (wr == 0) PG8_BAR; }
    PG8_BAR;
    if constexpr (Epi::AFTER_DRAIN) { E.fused(acc, cur, wr, wc, fr, fq, lds, wid, lane); }
#undef PG8_SA
#undef PG8_SB
#undef PG8_STAGE
#undef PG8_LDA
#undef PG8_LDB
#undef PG8_MMA
#undef PG8_WAIT_V
#undef PG8_WAIT_L
#undef PG8_BAR
#undef PG8_SCHED
}
}
struct EpiIn {
    static constexpr bool PERM = true, AFTER_DRAIN = false;
    unsigned char* ws;
    DI void operator()(const f32x4 (&acc)[2][2][4][2], const pg8::Unit& u, int wr, int wc, int fr, int fq) const {
        bf16_t* P = (bf16_t*)(ws + WS_P); const float* cosH = (const float*)(ws + WS_COSH); const float* sinH = (const float*)(ws + WS_SINH); const float* cosM = (const float*)(ws + WS_COSM); const float* sinM = (const float*)(ws + WS_SINM);
        const int pn = u.pn; const bool ctxt = (u.pm % 33) == 0;
        int mode = 0; float sc = 1.f;
        if ((pn >= 3 && pn <= 10) || (pn >= 15 && pn <= 19)) mode = 1;
        if (pn == 2) mode = 2;
        if ((pn >= 3 && pn <= 6) || (pn >= 15 && pn <= 18)) sc = QS64;
        if (ctxt) mode = 0;
        const int rowt = u.pm * 256 + wr * 64 + fr, colb = pn * 256 + wc * 32 + 8 * fq;
#pragma unroll
        for (int ai = 0; ai < 2; ++ai)
#pragma unroll
            for (int m = 0; m < 4; ++m) {
                const int row = rowt + ai * 128 + m * 16; const int pos = (row % RB) - CTX;
                bf16_t* rowp = P + (size_t)row * NP;
#pragma unroll
                for (int bj = 0; bj < 2; ++bj) {
                    const int col0 = colb + bj * 128;
                    f32x4 v0 = acc[ai][bj][m][0], v1 = acc[ai][bj][m][1];
                    if (mode == 1) { const int p0 = (col0 & 63) >> 1; const f32x4 cs = *(const f32x4*)(cosH + (size_t)pos * 32 + p0), sn = *(const f32x4*)(sinH + (size_t)pos * 32 + p0); rope8(v0, v1, cs, sn); }
                    else if (mode == 2 && col0 >= C_KR && col0 < C_KR + 32) { const int p0 = (col0 - C_KR) >> 1; const f32x4 cs = *(const f32x4*)(cosM + (size_t)pos * 16 + p0), sn = *(const f32x4*)(sinM + (size_t)pos * 16 + p0); rope8(v0, v1, cs, sn); }
                    v0 = v0 * sc; v1 = v1 * sc;
                    *(u32x4*)(rowp + col0) = pack8(v0, v1);
                }
            }
    }
};
struct EpiQ {
    static constexpr bool PERM = true, AFTER_DRAIN = false;
    unsigned char* ws;
    DI void operator()(const f32x4 (&acc)[2][2][4][2], const pg8::Unit& u, int wr, int wc, int fr, int fq) const {
        bf16_t* QM = (bf16_t*)(ws + WS_QM); const float* cosM = (const float*)(ws + WS_COSM); const float* sinM = (const float*)(ws + WS_SINM);
        const bool ctxt = (u.pm % 33) == 0;
        const int rowt = u.pm * 256 + wr * 64 + fr, colb = u.pn * 256 + wc * 32 + 8 * fq;
#pragma unroll
        for (int ai = 0; ai < 2; ++ai)
#pragma unroll
            for (int m = 0; m < 4; ++m) {
                const int row = rowt + ai * 128 + m * 16; const int pos = (row % RB) - CTX;
#pragma unroll
                for (int bj = 0; bj < 2; ++bj) {
                    const int col0 = colb + bj * 128, within = col0 % 96;
                    f32x4 v0 = acc[ai][bj][m][0], v1 = acc[ai][bj][m][1];
                    if (!ctxt && within >= 64) { const int p0 = (within - 64) >> 1; const f32x4 cs = *(const f32x4*)(cosM + (size_t)pos * 16 + p0), sn = *(const f32x4*)(sinM + (size_t)pos * 16 + p0); rope8(v0, v1, cs, sn); }
                    v0 = v0 * QS96; v1 = v1 * QS96;
                    *(u32x4*)(QM + (size_t)row * 768 + col0) = pack8(v0, v1);
                }
                asm volatile("" ::: "memory");
            }
    }
};
struct EpiKV {
    static constexpr bool PERM = true, AFTER_DRAIN = false;
    unsigned char* ws;
    DI void operator()(const f32x4 (&acc)[2][2][4][2], const pg8::Unit& u, int wr, int wc, int fr, int fq) const {
        bf16_t* KM = (bf16_t*)(ws + WS_KM); bf16_t* VM = (bf16_t*)(ws + WS_VM);
        const int rowt = u.pm * 256 + wr * 64 + fr, colb = u.pn * 256 + wc * 32 + 8 * fq;
#pragma unroll
        for (int ai = 0; ai < 2; ++ai)
#pragma unroll
            for (int m = 0; m < 4; ++m) {
                const int row = rowt + ai * 128 + m * 16;
#pragma unroll
                for (int bj = 0; bj < 2; ++bj) {
                    const int col0 = colb + bj * 128;
                    bf16_t* dst = (col0 < 512) ? KM + (size_t)row * 768 + (col0 >> 6) * 96 + (col0 & 63) : VM + (size_t)row * 1024 + (col0 - 512);
                    *(u32x4*)dst = pack8(acc[ai][bj][m][0], acc[ai][bj][m][1]);
                }
                asm volatile("" ::: "memory");
            }
    }
};
template <bool DRYE> struct EpiBrT {
    static constexpr bool PERM = true, AFTER_DRAIN = false;
    unsigned char* ws;
    DI void operator()(const f32x4 (&acc)[2][2][4][2], const pg8::Unit& u, int wr, int wc, int fr, int fq) const {
        bf16_t* P = (bf16_t*)(ws + WS_P);
        unsigned chk = 0u;
        const int rowt = u.pm * 256 + wr * 64 + fr, colb = u.pn * 256 + wc * 32 + 8 * fq;
#pragma unroll
        for (int ai = 0; ai < 2; ++ai)
#pragma unroll
            for (int m = 0; m < 4; ++m) {
                const int row = rowt + ai * 128 + m * 16;
#pragma unroll
                for (int bj = 0; bj < 2; ++bj) {
                    bf16_t* p = P + (size_t)row * NP + C_GM + colb + bj * 128;
                    const u32x4 g = *(const u32x4*)p;
                    f32x4 v0 = acc[ai][bj][m][0], v1 = acc[ai][bj][m][1];
                    v0[0] *= sigm_f(bflo(g.x)); v0[1] *= sigm_f(bfhi(g.x)); v0[2] *= sigm_f(bflo(g.y)); v0[3] *= sigm_f(bfhi(g.y));
                    v1[0] *= sigm_f(bflo(g.z)); v1[1] *= sigm_f(bfhi(g.z)); v1[2] *= sigm_f(bflo(g.w)); v1[3] *= sigm_f(bfhi(g.w));
                    { const u32x4 w_ = pack8(v0, v1); if (!DRYE) *(u32x4*)p = w_; else chk ^= w_.x ^ w_.y ^ w_.z ^ w_.w; }
                }
            }
        if (DRYE && chk == 0x12345678u) *(unsigned*)P = chk;
    }
};
template <bool DRYE> struct EpiOutT {
    static constexpr bool PERM = true, AFTER_DRAIN = false;
    int l, g; const float* xsrc; float* xdst; const float* ctxsrc; unsigned char* ws;
    DI void operator()(const f32x4 (&acc)[2][2][4][2], const pg8::Unit& u, int wr, int wc, int fr, int fq) const {
        float* ctxdst = (float*)(ws + WS_CTX); const float* mod = (const float*)(ws + WS_MOD) + (size_t)l * 9 * 3072;
        const int pmb = u.pm % 33, b = g * GB + u.pm / 33; const bool ctxt = pmb == 0;
        if (ctxt && l != 0) return;
        const float* gate = mod + (size_t)(ctxt ? 8 : b) * 3072 + 2048;
        const int colb = u.pn * 256 + wc * 32 + 8 * fq;
#pragma unroll
        for (int ai = 0; ai < 2; ++ai)
#pragma unroll
            for (int m = 0; m < 4; ++m) {
                const int j = pmb * 256 + ai * 128 + wr * 64 + m * 16 + fr;
                const size_t idx = ctxt ? ((size_t)b * CTX + j) * DM : ((size_t)b * SEQ + (j - CTX)) * DM;
                const float* s = (ctxt ? ctxsrc : xsrc) + idx; float* d = (ctxt ? ctxdst : xdst) + idx;
#pragma unroll
                for (int bj = 0; bj < 2; ++bj) {
                    const int col0 = colb + bj * 128;
                    const f32x4 g0 = *(const f32x4*)(gate + col0), g1 = *(const f32x4*)(gate + col0 + 4);
                    const f32x4 x0 = *(const f32x4*)(s + col0), x1 = *(const f32x4*)(s + col0 + 4);
                    if (!DRYE || x0[0] == 12345.678f) { *(f32x4*)(d + col0) = x0 + g0 * acc[ai][bj][m][0];
                    *(f32x4*)(d + col0 + 4) = x1 + g1 * acc[ai][bj][m][1]; }
                }
            }
    }
};

#define MFMA32(a, b, c) __builtin_amdgcn_mfma_f32_32x32x16_bf16((a), (b), (c), 0, 0, 0)
DI s16x4 tr16(const LAS unsigned char* p) { typedef short v4i16_t __attribute__((ext_vector_type(4))); return __builtin_bit_cast(s16x4, __builtin_amdgcn_ds_read_tr16_b64_v4i16((LAS v4i16_t*)p)); }
constexpr int AT_KOFF = 0, AT_KBUFMAX = 13312, AT_VOFF = 3 * AT_KBUFMAX, AT_VBUFMAX = 20480, AT_SOFF = AT_VOFF + 3 * AT_VBUFMAX, AT_QOFF = AT_SOFF + 1024;
static_assert(AT_QOFF + 8 * 6144 <= LDS_BYTES, "attention LDS map");
#ifndef AT_IGLP
#define AT_IGLP -1
#endif
#ifndef AT_QLMIN
#define AT_QLMIN 64
#endif
#ifndef AT_PVKS
#define AT_PVKS 1
#endif
#ifndef AT_SGB
#define AT_SGB 0
#endif
#ifndef AT_PV8
#define AT_PV8 1
#endif
#ifndef AT_NOSBAR
#define AT_NOSBAR 1
#endif
#if AT_NOSBAR
#define SBAR() do {} while (0)
#else
#define SBAR() __builtin_amdgcn_sched_barrier(0)
#endif
#ifndef PROBE_MODE
#define PROBE_MODE 0
#endif
#ifndef DRY_SEL
#define DRY_SEL 7
#endif
#ifndef AT_QL
#define AT_QL 1
#endif
#ifndef AT_SB
#define AT_SB 0
#endif
template <int DQK, bool QL>
DI void at_qkt(f32x16& p0, f32x16& p1, const LAS unsigned char* kb, const bf16x8* qf, const LAS unsigned char* qb) {
    constexpr int KSTR = DQK + 8;
#pragma unroll
    for (int r = 0; r < 16; ++r) { p0[r] = 0.f; p1[r] = 0.f; }
#pragma unroll
    for (int ds = 0; ds < DQK / 16; ++ds) {
        const bf16x8 k0 = *(const LAS bf16x8*)(kb + ds * 32), k1 = *(const LAS bf16x8*)(kb + 32 * (KSTR * 2) + ds * 32);
        bf16x8 q; if (QL) q = *(const LAS bf16x8*)(qb + ds * 1024); else q = qf[ds];
        p0 = MFMA32(k0, q, p0); p1 = MFMA32(k1, q, p1);
        if (AT_SB && DQK > 64 && (ds & 1)) __builtin_amdgcn_sched_barrier(0x7f); }
}
DI void at_mask(f32x16& p0, f32x16& p1, int dk) {
#pragma unroll
    for (int r = 0; r < 16; ++r) { const int d = dk + (r & 3) + 8 * (r >> 2);
        if (d > 128 || d < -128) p0[r] = NEGBIG;
        if (d + 32 > 128 || d + 32 < -128) p1[r] = NEGBIG; }
}
DI void at_psm(f32x16& p0, f32x16& p1, float& mrun, float& alpha) {
    float ma = fmaxf(fmaxf(p0[0], p0[1]), p0[2]), mb = fmaxf(fmaxf(p1[0], p1[1]), p1[2]);
    ma = fmaxf(fmaxf(ma, p0[3]), p1[3]);
#pragma unroll
    for (int r = 4; r < 16; r += 2) { ma = fmaxf(fmaxf(ma, p0[r]), p0[r + 1]); mb = fmaxf(fmaxf(mb, p1[r]), p1[r + 1]); }
    float mx = fmaxf(ma, mb);
    { auto rr = __builtin_amdgcn_permlane32_swap(__float_as_uint(mx), __float_as_uint(mx), false, false); mx = fmaxf(__uint_as_float(rr[0]), __uint_as_float(rr[1])); }
    const bool keep = __all(mx - mrun <= THR);
    const float mn = keep ? mrun : fmaxf(mrun, mx); alpha = __builtin_amdgcn_exp2f(mrun - mn); mrun = mn;
#pragma unroll
    for (int r = 0; r < 16; ++r) { p0[r] -= mrun; p1[r] -= mrun; }
#pragma unroll
    for (int r = 0; r < 16; ++r) p0[r] = __builtin_amdgcn_exp2f(p0[r]);
}
DI void at_fsm(f32x16& p0, f32x16& p1, float alpha, float& lrun, bf16x8* pa) {
#pragma unroll
    for (int r = 0; r < 16; ++r) p1[r] = __builtin_amdgcn_exp2f(p1[r]);
    float ps = 0.f;
#pragma unroll
    for (int r = 0; r < 16; ++r) ps += p0[r] + p1[r];
    lrun = lrun * alpha + ps;
    u32x4 w;
    w.x = pk2(p0[0], p0[1]); w.y = pk2(p0[2], p0[3]); w.z = pk2(p0[4], p0[5]); w.w = pk2(p0[6], p0[7]); pa[0] = __builtin_bit_cast(bf16x8, w);
    w.x = pk2(p0[8], p0[9]); w.y = pk2(p0[10], p0[11]); w.z = pk2(p0[12], p0[13]); w.w = pk2(p0[14], p0[15]); pa[1] = __builtin_bit_cast(bf16x8, w);
    w.x = pk2(p1[0], p1[1]); w.y = pk2(p1[2], p1[3]); w.z = pk2(p1[4], p1[5]); w.w = pk2(p1[6], p1[7]); pa[2] = __builtin_bit_cast(bf16x8, w);
    w.x = pk2(p1[8], p1[9]); w.y = pk2(p1[10], p1[11]); w.z = pk2(p1[12], p1[13]); w.w = pk2(p1[14], p1[15]); pa[3] = __builtin_bit_cast(bf16x8, w);
}
DI void at_fsm_fake(f32x16& p0, f32x16& p1, bf16x8* pa) {
    u32x4 w;
    w.x = pk2(p0[0], p0[1]); w.y = pk2(p0[2], p0[3]); w.z = pk2(p0[4], p0[5]); w.w = pk2(p0[6], p0[7]); pa[0] = __builtin_bit_cast(bf16x8, w);
    w.x = pk2(p0[8], p0[9]); w.y = pk2(p0[10], p0[11]); w.z = pk2(p0[12], p0[13]); w.w = pk2(p0[14], p0[15]); pa[1] = __builtin_bit_cast(bf16x8, w);
    w.x = pk2(p1[0], p1[1]); w.y = pk2(p1[2], p1[3]); w.z = pk2(p1[4], p1[5]); w.w = pk2(p1[6], p1[7]); pa[2] = __builtin_bit_cast(bf16x8, w);
    w.x = pk2(p1[8], p1[9]); w.y = pk2(p1[10], p1[11]); w.z = pk2(p1[12], p1[13]); w.w = pk2(p1[14], p1[15]); pa[3] = __builtin_bit_cast(bf16x8, w);
}
template <int DV>
DI void at_pv(f32x16* o, const LAS unsigned char* vb, const bf16x8* pa) {
    constexpr int VSTR = DV + 32;
#if AT_PVKS
#pragma unroll
    for (int ks = 0; ks < 4; ++ks) {
        s16x4 vlo[DV / 32], vhi[DV / 32];
#pragma unroll
        for (int db = 0; db < DV / 32; ++db) { vlo[db] = tr16(vb + (16 * ks) * (VSTR * 2) + db * 64); vhi[db] = tr16(vb + (16 * ks + 8) * (VSTR * 2) + db * 64); }
#pragma unroll
        for (int db = 0; db < DV / 32; ++db) { const bf16x8 vf = __builtin_shufflevector(vlo[db], vhi[db], 0, 1, 2, 3, 4, 5, 6, 7); o[db] = MFMA32(pa[ks], vf, o[db]); }
    }
#else
#pragma unroll
    for (int db = 0; db < DV / 32; ++db) {
        s16x4 vlo[4], vhi[4];
#pragma unroll
        for (int ks = 0; ks < 4; ++ks) { vlo[ks] = tr16(vb + (16 * ks) * (VSTR * 2) + db * 64); vhi[ks] = tr16(vb + (16 * ks + 8) * (VSTR * 2) + db * 64); }
#pragma unroll
        for (int ks = 0; ks < 4; ++ks) { const bf16x8 vf = __builtin_shufflevector(vlo[ks], vhi[ks], 0, 1, 2, 3, 4, 5, 6, 7); o[db] = MFMA32(pa[ks], vf, o[db]); }
    }
#endif
}
template <int DV>
DI void at_scale_o(f32x16* o, LAS float* scw, float val, int r32, int hi) {
    if (hi == 0) scw[r32] = val;
    __builtin_amdgcn_wave_barrier(); asm volatile("" ::: "memory");
#pragma unroll
    for (int g4 = 0; g4 < 4; ++g4) { const f32x4 a4 = *(const LAS f32x4*)(scw + 8 * g4 + 4 * hi);
#pragma unroll
        for (int db = 0; db < DV / 32; ++db) { o[db][4 * g4 + 0] *= a4[0]; o[db][4 * g4 + 1] *= a4[1]; o[db][4 * g4 + 2] *= a4[2]; o[db][4 * g4 + 3] *= a4[3]; } }
    __builtin_amdgcn_wave_barrier(); asm volatile("" ::: "memory");
}
template <int DQK, int DV, int OUTM, bool MASKED>
DI void attn_unit(LAS unsigned char* lds, const bf16_t* Qp, int ldq, const bf16_t* Kp, int ldk, const bf16_t* Vp, int ldv,
                  int nA, int rowB0, int nB, int posB0, int qpos0, float m0, float l0,
                  bf16_t* Og, int ldo, float* Of, int ldof) {
    constexpr int KSTR = DQK + 8, VSTR = DV + 32, KBUF = 64 * KSTR * 2, VBUF = 64 * VSTR * 2;
    constexpr int KCH = DQK / 8, VCH = DV / 8, NKC = 64 * KCH, NVC = 64 * VCH, KRN = (NKC + 511) / 512, VRN = (NVC + 511) / 512;
    static_assert(KBUF <= AT_KBUFMAX && VBUF <= AT_VBUFMAX, "attention LDS map");
    const int tid = tid_l(), lane = tid & 63, wid = __builtin_amdgcn_readfirstlane(tid >> 6), r32 = lane & 31, hi = lane >> 5;
#ifndef AT_QL
#define AT_QL 1
#endif
#ifndef AT_SB
#define AT_SB 0
#endif
    constexpr bool QL = AT_QL && (DQK > AT_QLMIN);
    bf16x8 qf[QL ? 1 : DQK / 16];
    const LAS unsigned char* qb = lds + AT_QOFF + wid * 6144 + lane * 16;
    { const bf16_t* qrow = Qp + (size_t)(32 * wid + r32) * ldq + 8 * hi;
#pragma unroll
      for (int ds = 0; ds < DQK / 16; ++ds) { const bf16x8 v = *(const bf16x8*)(qrow + 16 * ds); if (QL) *(LAS bf16x8*)(lds + AT_QOFF + wid * 6144 + lane * 16 + ds * 1024) = v; else qf[QL ? 0 : ds] = v; }
      if (QL) { __builtin_amdgcn_wave_barrier(); asm volatile("s_waitcnt lgkmcnt(0)" ::: "memory"); } }
    f32x16 o[DV / 32];
#pragma unroll
    for (int db = 0; db < DV / 32; ++db)
#pragma unroll
        for (int r = 0; r < 16; ++r) o[db][r] = 0.f;
    float mrun = m0, lrun = (hi == 0) ? l0 : 0.f;
    LAS float* scw = (LAS float*)(lds + AT_SOFF) + wid * 32;
    const int NT = nA + nB;
    const LAS unsigned char* kb0 = lds + AT_KOFF + r32 * (KSTR * 2) + hi * 16;
    const LAS unsigned char* vb0 = lds + AT_VOFF + (4 * hi + ((lane & 15) >> 2)) * (VSTR * 2) + (16 * ((lane >> 4) & 1) + 4 * (lane & 3)) * 2;
    const int dk0 = posB0 + 4 * hi - (qpos0 + 32 * wid + r32) - 64 * nA;
    u32x4 kreg[KRN], vreg[VRN];
    int kgo[KRN], klo[KRN], vgo[VRN], vlo_[VRN];
#pragma unroll
    for (int i_ = 0; i_ < KRN; ++i_) { int c_ = tid + 512 * i_; if (c_ >= NKC) c_ -= 512; const int r_ = c_ / KCH, cc_ = c_ % KCH; kgo[i_] = r_ * ldk + cc_ * 8; klo[i_] = AT_KOFF + r_ * (KSTR * 2) + cc_ * 16; }
#pragma unroll
    for (int i_ = 0; i_ < VRN; ++i_) { int c_ = tid + 512 * i_; if (c_ >= NVC) c_ -= 512; const int r_ = c_ / VCH, cc_ = c_ % VCH; vgo[i_] = r_ * ldv + cc_ * 8; vlo_[i_] = AT_VOFF + r_ * (VSTR * 2) + cc_ * 16; }
#define AT_GLOAD(t) do { const int row0_ = (t) < nA ? 64 * (t) : rowB0 + 64 * ((t) - nA); const bf16_t* kt_ = Kp + (size_t)row0_ * ldk; const bf16_t* vt_ = Vp + (size_t)row0_ * ldv; \
        _Pragma("unroll") for (int i_ = 0; i_ < KRN; ++i_) kreg[i_] = *(const u32x4*)(kt_ + kgo[i_]); \
        _Pragma("unroll") for (int i_ = 0; i_ < VRN; ++i_) vreg[i_] = *(const u32x4*)(vt_ + vgo[i_]); } while (0)
#define AT_SWRITE(buf) do { \
        _Pragma("unroll") for (int i_ = 0; i_ < KRN; ++i_) *(LAS u32x4*)(lds + (buf) * KBUF + klo[i_]) = kreg[i_]; \
        _Pragma("unroll") for (int i_ = 0; i_ < VRN; ++i_) *(LAS u32x4*)(lds + (buf) * VBUF + vlo_[i_]) = vreg[i_]; } while (0)
    unsigned pfv = 0u, pfacc = 0u;
    const int pft = tid & 255;
    const bf16_t* pfb = (pft < 128) ? Kp + (pft >> 1) * ldk + (pft & 1) * (DQK - 2) : Vp + ((pft - 128) >> 1) * ldv + (pft & 1) * (DV - 2);
    const int pfs = (pft < 128) ? ldk : ldv;
    constexpr int PFD = 4;
#define AT_PF(t) do { pfacc ^= pfv; const int tt_ = (t) < NT ? (t) : NT - 1; const int row0_ = tt_ < nA ? 64 * tt_ : rowB0 + 64 * (tt_ - nA); \
        pfv = *(const unsigned*)(pfb + (size_t)row0_ * pfs); } while (0)
#define AT_MASK(P0, P1, t) do { if (MASKED && (t) >= nA) at_mask(P0, P1, dk0 + 64 * (t)); } while (0)
#define AT_RESC(al) do { if (__any((al) < 1.f)) at_scale_o<DV>(o, scw, (al), r32, hi); } while (0)
    constexpr int DRYP = (OUTM == 2) ? PROBE_MODE : 0;
    f32x16 pA0, pA1, pB0, pB1; float alA, alB; bf16x8 pa[4];
    AT_PF(1); AT_PF(2); AT_PF(3);
    AT_GLOAD(0); AT_SWRITE(0); __syncthreads();
    AT_GLOAD(1);
    at_qkt<DQK, QL>(pA0, pA1, kb0, qf, qb); AT_MASK(pA0, pA1, 0); at_psm(pA0, pA1, mrun, alA);
    AT_SWRITE(1); __syncthreads();
    int bp = 0, bc = 1, bn = 2;
    constexpr int NMF = 2 * (DQK / 16) + 4 * (DV / 32);
#if AT_IGLP >= 0
#define AT_SCHED() __builtin_amdgcn_iglp_opt(AT_IGLP)
#elif AT_SGB
#define AT_SCHED() do { _Pragma("unroll") for (int i_ = 0; i_ < NMF; ++i_) { __builtin_amdgcn_sched_group_barrier(0x008, 1, 0); __builtin_amdgcn_sched_group_barrier(0x100, 2, 0); __builtin_amdgcn_sched_group_barrier(0x002, AT_SGB, 0); } } while (0)
#else
#define AT_SCHED() do {} while (0)
#endif
#define AT_ROT() do { bp = bc; bc = bn; bn = (bn == 2) ? 0 : bn + 1; } while (0)
    for (int j = 1; j + 1 < ((DRYP == 6) ? 2 : NT); j += 2) {
        if (!(DRYP >= 1)) { AT_GLOAD(j + 1); AT_PF(j + PFD); }
        SBAR(); if (DRYP != 5) at_qkt<DQK, QL>(pB0, pB1, kb0 + bc * KBUF, qf, qb); else { _Pragma("unroll") for (int r_ = 0; r_ < 16; ++r_) { pB0[r_] = o[0][r_] * 1e-3f; pB1[r_] = o[1][r_] * 1e-3f; } } AT_MASK(pB0, pB1, j);
        if (DRYP != 3) at_fsm(pA0, pA1, alA, lrun, pa); else at_fsm_fake(pA0, pA1, pa); SBAR();
        if (DRYP != 4) at_pv<DV>(o, vb0 + bp * VBUF, pa); else { o[0][0] += __builtin_bit_cast(float, (int)pa[0][0] + (int)pa[1][1] + (int)pa[2][2] + (int)pa[3][3]); } if (DRYP != 3) at_psm(pB0, pB1, mrun, alB); else alB = 1.f;
        AT_SCHED();
        if (!(DRYP >= 1)) AT_SWRITE(bn);
        AT_RESC(alB); if (DRYP != 2) __syncthreads(); AT_ROT();
        if (!(DRYP >= 1)) { AT_GLOAD(j + 2); AT_PF(j + 1 + PFD); }
        SBAR(); if (DRYP != 5) at_qkt<DQK, QL>(pA0, pA1, kb0 + bc * KBUF, qf, qb); else { _Pragma("unroll") for (int r_ = 0; r_ < 16; ++r_) { pA0[r_] = o[0][r_] * 1e-3f; pA1[r_] = o[1][r_] * 1e-3f; } } AT_MASK(pA0, pA1, j + 1);
        if (DRYP != 3) at_fsm(pB0, pB1, alB, lrun, pa); else at_fsm_fake(pB0, pB1, pa); SBAR();
        if (DRYP != 4) at_pv<DV>(o, vb0 + bp * VBUF, pa); else { o[0][0] += __builtin_bit_cast(float, (int)pa[0][0] + (int)pa[1][1] + (int)pa[2][2] + (int)pa[3][3]); } if (DRYP != 3) at_psm(pA0, pA1, mrun, alA); else alA = 1.f;
        AT_SCHED();
        if (!(DRYP >= 1)) AT_SWRITE(bn);
        AT_RESC(alA); if (DRYP != 2) __syncthreads(); AT_ROT();
    }
    SBAR(); at_qkt<DQK, QL>(pB0, pB1, kb0 + bc * KBUF, qf, qb); AT_MASK(pB0, pB1, NT - 1);
    at_fsm(pA0, pA1, alA, lrun, pa); SBAR();
    at_pv<DV>(o, vb0 + bp * VBUF, pa); at_psm(pB0, pB1, mrun, alB);
    AT_RESC(alB);
    at_fsm(pB0, pB1, alB, lrun, pa); SBAR();
    at_pv<DV>(o, vb0 + bc * VBUF, pa);
#undef AT_ROT
#undef AT_SCHED
    pfacc ^= pfv;
    if (__builtin_expect(pfacc == 0x9e3779b9u && lrun == 12345.678f, 0)) scw[0] = 1.f;
#undef AT_GLOAD
#undef AT_PF
#undef AT_SWRITE
#undef AT_MASK
#undef AT_RESC
    { const float lt = lrun + __shfl_xor(lrun, 32); at_scale_o<DV>(o, scw, 1.0f / lt, r32, hi); }
    if (OUTM == 0) {
#pragma unroll
        for (int db = 0; db < DV / 32; ++db) {
            bf16_t* pb = Og + (size_t)(32 * wid + 4 * hi) * ldo + 32 * db + r32;
            bf16_t zz[16];
#pragma unroll
            for (int r = 0; r < 16; ++r) zz[r] = pb[(size_t)((r & 3) + 8 * (r >> 2)) * ldo];
#pragma unroll
            for (int r = 0; r < 16; ++r) { const float z = __uint_as_float((unsigned)zz[r] << 16); pb[(size_t)((r & 3) + 8 * (r >> 2)) * ldo] = (bf16_t)(pk2(o[db][r] * silu_f(z), 0.f) & 0xffffu); }
        }
    } else {
#pragma unroll
        for (int db = 0; db < DV / 32; ++db)
#pragma unroll
            for (int r = 0; r < 16; ++r) {
                const int q = (r & 3) + 8 * (r >> 2) + 4 * hi;
                if (OUTM == 1) { Of[(size_t)(32 * wid + q) * ldof + 32 * db + r32] = o[db][r]; }
                else { if (lrun == 12345.678f) Of[(size_t)(32 * wid + q) * ldof + 32 * db + r32] = o[db][r]; }
            }
    }
    __syncthreads();
}

struct Args { const float* in[21]; float* out; unsigned char* ws; };
typedef const __attribute__((address_space(4))) Args* ArgsP;
DI ArgsP args_ptr() { ArgsP p = (ArgsP)__builtin_amdgcn_kernarg_segment_ptr(); asm volatile("" : "+s"(p)); return p; }
enum { I_X = 0, I_C, I_CTX, I_CCTX, I_WMOD, I_BMOD, I_NORMG, I_WIN, I_QNORM, I_WUQ, I_KVNORM, I_WUKV, I_LQ1, I_LK1, I_LQ2, I_LK2, I_SUBLN, I_SINK, I_WBR, I_WOUT, I_FNORM };

DI int colmap(int kind, int n) {
    if (kind == 1) {
        if (n < C_KR) return n;
        if (n < C_KR + 32) { const int e = n - C_KR; return C_KR + (e >> 1) + 16 * (e & 1); }
        if (n < C_DQ) return -1;
        if ((n >= C_DQ && n < C_DV) || (n >= C_SQ && n < C_SV)) { const int w = n & 63; return (n - w) - 96 + (w >> 1) + 32 * (w & 1); }
        return n - 96;
    }
    if (kind == 2) { const int h = n / 96, e = n % 96; if (e < 64) return n; const int e2 = e - 64; return h * 96 + 64 + (e2 >> 1) + 16 * (e2 & 1); }
    if (kind == 3) { if (n < 512) return (n >> 6) * 192 + (n & 63); const int n2 = n - 512; return (n2 >> 7) * 192 + 64 + (n2 & 127); }
    return n;
}
DI void transpose_item(const float* W, int ldw, int kind, const float* rowscale, bf16_t* WT, int ldd, int koff, LAS float* scr, int item, int nblk, int lane) {
    const int kb = item / nblk, nb = item % nblk, k0 = 64 * kb, n0 = 32 * nb;
    const int oc = colmap(kind, n0 + (lane & 31));
#pragma unroll 8
    for (int i = 0; i < 32; ++i) { const int kk = 2 * i + (lane >> 5); float v = 0.f; if (oc >= 0) v = W[(size_t)(k0 + kk) * ldw + oc]; if (rowscale) v *= rowscale[k0 + kk]; scr[kk * 33 + (lane & 31)] = v; }
    __builtin_amdgcn_wave_barrier(); asm volatile("s_waitcnt lgkmcnt(0)" ::: "memory");
    const int c = lane & 7;
#pragma unroll
    for (int j = 0; j < 4; ++j) { const int n = (lane >> 3) + 8 * j; const LAS float* s = scr + (8 * c) * 33 + n;
        u32x4 o; o.x = pk2(s[0 * 33], s[1 * 33]); o.y = pk2(s[2 * 33], s[3 * 33]); o.z = pk2(s[4 * 33], s[5 * 33]); o.w = pk2(s[6 * 33], s[7 * 33]);
        *(u32x4*)(WT + (size_t)(n0 + n) * ldd + koff + k0 + 8 * c) = o; }
    __builtin_amdgcn_wave_barrier(); asm volatile("s_waitcnt lgkmcnt(0)" ::: "memory");
}
DI void prologue(ArgsP ap, LAS unsigned char* lds) {
    const int tid = tid_l(), lane = tid & 63, wid = __builtin_amdgcn_readfirstlane(tid >> 6);
    unsigned char* ws = ap->ws;
    LAS float* scr = (LAS float*)(lds + wid * 8448);
    const int gw = bid_l() * 8 + wid, NGW = grd_l() * 8;
    constexpr int I_IN = 16 * (NP / 32), I_UQ = 6 * 24, I_UKV = 4 * 48, I_SQ = 16 * 32, PER_L = I_IN + I_UQ + I_UKV + 6 * I_SQ;
    for (int it = gw; it < 2 * PER_L; it += NGW) {
        const int l = it / PER_L; int r = it % PER_L;
        if (r < I_IN) { transpose_item(ap->in[I_WIN] + (size_t)l * 1024 * D_IN, D_IN, 1, nullptr, (bf16_t*)(ws + WS_WIN) + (size_t)l * NP * 1024, 1024, 0, scr, r, NP / 32, lane); continue; } r -= I_IN;
        if (r < I_UQ) { transpose_item(ap->in[I_WUQ] + (size_t)l * 384 * 768, 768, 2, ap->in[I_QNORM] + l * 384, (bf16_t*)(ws + WS_WUQ) + (size_t)l * 768 * 384, 384, 0, scr, r, 24, lane); continue; } r -= I_UQ;
        if (r < I_UKV) { transpose_item(ap->in[I_WUKV] + (size_t)l * 256 * 1536, 1536, 3, ap->in[I_KVNORM] + l * 256, (bf16_t*)(ws + WS_WUKV) + (size_t)l * 1536 * 256, 256, 0, scr, r, 48, lane); continue; } r -= I_UKV;
        if (r < 3 * I_SQ) { const int br = r / I_SQ; transpose_item(ap->in[I_WBR] + ((size_t)l * 3 + br) * 1024 * 1024, 1024, 0, nullptr, (bf16_t*)(ws + WS_WB) + ((size_t)l * 3 + br) * 1024 * 1024, 1024, 0, scr, r % I_SQ, 32, lane); continue; } r -= 3 * I_SQ;
        { const int rep = r / I_SQ; transpose_item(ap->in[I_WOUT] + (size_t)l * 1024 * 1024, 1024, 0, nullptr, (bf16_t*)(ws + WS_WO3) + (size_t)l * 1024 * 3072, 3072, rep * 1024, scr, r % I_SQ, 32, lane); }
    }
    const int gt = bid_l() * 512 + tid, NGT = grd_l() * 512;
    for (int i = gt; i < SEQ * 48; i += NGT) {
        const int pos = i / 48, p = i % 48; const float frow = (float)(pos >> 6), fcol = (float)(pos & 63);
        float ang; float* cd; float* sd;
        if (p < 32) { const int f = p & 15; const float inv = powf(10000.0f, -(float)f / 16.0f); ang = (p < 16 ? frow : fcol) * inv; cd = (float*)(ws + WS_COSH) + pos * 32 + p; sd = (float*)(ws + WS_SINH) + pos * 32 + p; }
        else { const int pp = p - 32, f = pp & 7; const float inv = powf(10000.0f, -(float)f / 8.0f); ang = (pp < 8 ? frow : fcol) * inv; cd = (float*)(ws + WS_COSM) + pos * 16 + pp; sd = (float*)(ws + WS_SINM) + pos * 16 + pp; }
        *cd = __cosf(ang); *sd = __sinf(ang);
    }
    for (int it = gw; it < 2 * 16 * 48; it += NGW) {
        const int l = it / 768, rem = it % 768, kc = rem / 48, nb = rem % 48; const int k = kc * 64 + lane;
        float sv[9];
#pragma unroll
        for (int v = 0; v < 8; ++v) sv[v] = silu_f(ap->in[I_C][v * 1024 + k]);
        sv[8] = silu_f(ap->in[I_CCTX][k]);
        float acc[9];
#pragma unroll
        for (int v = 0; v < 9; ++v) acc[v] = 0.f;
        const float* w = ap->in[I_WMOD] + ((size_t)l * 1024 + kc * 64) * 3072 + nb * 64 + lane;
#pragma unroll 8
        for (int kk = 0; kk < 64; ++kk) { const float wv = w[(size_t)kk * 3072];
#pragma unroll
            for (int v = 0; v < 9; ++v) acc[v] += __uint_as_float(__builtin_amdgcn_readlane(__float_as_uint(sv[v]), kk)) * wv; }
        float* mp = (float*)(ws + WS_MODP) + ((size_t)(l * 16 + kc) * 9) * 3072 + nb * 64 + lane;
#pragma unroll
        for (int v = 0; v < 9; ++v) mp[(size_t)v * 3072] = acc[v];
    }
}
DI void mod_finalize(ArgsP ap) {
    const int tid = tid_l();
    const int gt = bid_l() * 512 + tid, NGT = grd_l() * 512;
    const float* mp = (const float*)(ap->ws + WS_MODP); float* mod = (float*)(ap->ws + WS_MOD);
    for (int i = gt; i < 2 * 9 * 3072; i += NGT) {
        const int l = i / (9 * 3072), rem = i % (9 * 3072), n = rem % 3072;
        float s = ap->in[I_BMOD][l * 3072 + n];
#pragma unroll
        for (int kc = 0; kc < 16; ++kc) s += mp[(size_t)(l * 16 + kc) * 9 * 3072 + rem];
        mod[i] = s;
    }
}
DI void ph_norm_mod(ArgsP ap, int l, int g) {
    const int tid = tid_l(), lane = tid & 63, wid = __builtin_amdgcn_readfirstlane(tid >> 6);
    const int gw = bid_l() * 8 + wid, NGW = grd_l() * 8;
    const float* ng = ap->in[I_NORMG] + l * 1024; const float* mod = (const float*)(ap->ws + WS_MOD) + (size_t)l * 9 * 3072;
    const float* xs = (l == 0) ? ap->in[I_X] : ap->out; const float* cs = (l == 0) ? ap->in[I_CTX] : (const float*)(ap->ws + WS_CTX);
    bf16_t* H = (bf16_t*)(ap->ws + WS_H);
    for (int r = gw; r < R; r += NGW) {
        const int bl = r / RB, j = r % RB, b = g * GB + bl;
        const float* src; const float* md;
        if (j < CTX) { src = cs + ((size_t)b * CTX + j) * DM; md = mod + 8 * 3072; } else { src = xs + ((size_t)b * SEQ + (j - CTX)) * DM; md = mod + (size_t)b * 3072; }
        f32x4 v[4]; float ss = 0.f;
#pragma unroll
        for (int q = 0; q < 4; ++q) { v[q] = *(const f32x4*)(src + 4 * (lane + 64 * q)); ss += (v[q][0] * v[q][0] + v[q][1] * v[q][1]) + (v[q][2] * v[q][2] + v[q][3] * v[q][3]); }
        const float rstd = 1.0f / sqrtf(wave_sum(ss) * (1.0f / DM) + EPS);
#pragma unroll
        for (int q = 0; q < 4; ++q) { const int idx = 4 * (lane + 64 * q);
            const f32x4 gg = *(const f32x4*)(ng + idx), sh = *(const f32x4*)(md + idx), sc = *(const f32x4*)(md + 1024 + idx);
            const f32x4 y = (v[q] * rstd * gg) * (sc + 1.0f) + sh;
            u32x2 w; w.x = pk2(y[0], y[1]); w.y = pk2(y[2], y[3]); *(u32x2*)(H + (size_t)r * DM + idx) = w; }
    }
}
DI void ph_mla_norm(ArgsP ap) {
    const int tid = tid_l(), lane = tid & 63, wid = __builtin_amdgcn_readfirstlane(tid >> 6);
    const int gw = bid_l() * 8 + wid, NGW = grd_l() * 8;
    const bf16_t* P = (const bf16_t*)(ap->ws + WS_P); bf16_t* AQ = (bf16_t*)(ap->ws + WS_AQ); bf16_t* AKV = (bf16_t*)(ap->ws + WS_AKV); bf16_t* KM = (bf16_t*)(ap->ws + WS_KM);
    for (int r = gw; r < R; r += NGW) {
        const bf16_t* row = P + (size_t)r * NP;
        const u32x4 c0 = *(const u32x4*)(row + 8 * lane);
        u32x4 c1 = {0u, 0u, 0u, 0u}; if (lane < 20) c1 = *(const u32x4*)(row + 8 * (64 + lane));
        float f0[8] = {bflo(c0.x), bfhi(c0.x), bflo(c0.y), bfhi(c0.y), bflo(c0.z), bfhi(c0.z), bflo(c0.w), bfhi(c0.w)};
        float f1[8] = {bflo(c1.x), bfhi(c1.x), bflo(c1.y), bfhi(c1.y), bflo(c1.z), bfhi(c1.z), bflo(c1.w), bfhi(c1.w)};
        float s0 = 0.f, s1 = 0.f;
#pragma unroll
        for (int i = 0; i < 8; ++i) { s0 += f0[i] * f0[i]; s1 += f1[i] * f1[i]; }
        const float sq = wave_sum(lane < 48 ? s0 : 0.f);
        const float skv = wave_sum((lane >= 48 ? s0 : 0.f) + (lane < 16 ? s1 : 0.f));
        const float rq = 1.0f / sqrtf(sq * (1.0f / 384.0f) + EPS), rkv = 1.0f / sqrtf(skv * (1.0f / 256.0f) + EPS);
        { const float rr = lane < 48 ? rq : rkv; u32x4 w; w.x = pk2(f0[0] * rr, f0[1] * rr); w.y = pk2(f0[2] * rr, f0[3] * rr); w.z = pk2(f0[4] * rr, f0[5] * rr); w.w = pk2(f0[6] * rr, f0[7] * rr);
          if (lane < 48) *(u32x4*)(AQ + (size_t)r * 384 + 8 * lane) = w; else *(u32x4*)(AKV + (size_t)r * 256 + 8 * (lane - 48)) = w; }
        if (lane < 16) { u32x4 w; w.x = pk2(f1[0] * rkv, f1[1] * rkv); w.y = pk2(f1[2] * rkv, f1[3] * rkv); w.z = pk2(f1[4] * rkv, f1[5] * rkv); w.w = pk2(f1[6] * rkv, f1[7] * rkv);
            *(u32x4*)(AKV + (size_t)r * 256 + 8 * (16 + lane)) = w; }
        else if (lane < 20) {
#pragma unroll
            for (int h = 0; h < 8; ++h) *(u32x4*)(KM + (size_t)r * 768 + h * 96 + 64 + 8 * (lane - 16)) = c1; }
    }
}
template <bool DRYE>
DI void ph_diff_post(ArgsP ap, int l) {
    const int tid = tid_l(), lane = tid & 63, wid = __builtin_amdgcn_readfirstlane(tid >> 6);
    const int gw = bid_l() * 8 + wid, NGW = grd_l() * 8;
    const float lam_init = (l == 0) ? 0.2f : (0.8f - 0.6f * 0.7408182206817179f);
    const float d1 = wave_sum(ap->in[I_LQ1][l * 64 + lane] * ap->in[I_LK1][l * 64 + lane]), d2 = wave_sum(ap->in[I_LQ2][l * 64 + lane] * ap->in[I_LK2][l * 64 + lane]);
    const float lam = expf(d1) - expf(d2) + lam_init;
    const float sl0 = ap->in[I_SUBLN][l * 128 + 2 * lane] * (1.0f - lam_init), sl1 = ap->in[I_SUBLN][l * 128 + 2 * lane + 1] * (1.0f - lam_init);
    const float* OD = (const float*)(ap->ws + WS_OD); bf16_t* P = (bf16_t*)(ap->ws + WS_P);
    typedef float f32x2 __attribute__((ext_vector_type(2)));
    for (int r = gw; r < R; r += NGW) {
        if (l != 0 && (r % RB) < CTX) continue;
        const float* ob = OD + (size_t)r * 2048 + 2 * lane; unsigned* zb = (unsigned*)(P + (size_t)r * NP + C_Z + 1024 + 2 * lane);
        f32x2 o1[8], o2[8]; unsigned z[8];
#pragma unroll
        for (int h = 0; h < 8; ++h) { o1[h] = *(const f32x2*)(ob + (2 * h) * 128); o2[h] = *(const f32x2*)(ob + (2 * h + 1) * 128); z[h] = zb[h * 64]; }
#pragma unroll
        for (int h = 0; h < 8; ++h) {
            const float a0 = o1[h][0] - lam * o2[h][0], a1 = o1[h][1] - lam * o2[h][1];
            const float rstd = 1.0f / sqrtf(wave_sum(a0 * a0 + a1 * a1) * (1.0f / 128.0f) + EPS);
            if (!DRYE || rstd == 12345.678f) zb[h * 64] = pk2(a0 * rstd * sl0 * silu_f(bflo(z[h])), a1 * rstd * sl1 * silu_f(bfhi(z[h])));
        }
    }
}
template <bool DRYE>
DI void ph_final_norm(ArgsP ap) {
    const int tid = tid_l(), lane = tid & 63, wid = __builtin_amdgcn_readfirstlane(tid >> 6);
    const int gw = bid_l() * 8 + wid, NGW = grd_l() * 8; const float* fg = ap->in[I_FNORM];
    for (int r = gw; r < NBATCH * SEQ; r += NGW) {
        float* row = ap->out + (size_t)r * DM; f32x4 v[4]; float ss = 0.f;
#pragma unroll
        for (int q = 0; q < 4; ++q) { v[q] = *(const f32x4*)(row + 4 * (lane + 64 * q)); ss += (v[q][0] * v[q][0] + v[q][1] * v[q][1]) + (v[q][2] * v[q][2] + v[q][3] * v[q][3]); }
        const float rstd = 1.0f / sqrtf(wave_sum(ss) * (1.0f / DM) + EPS);
#pragma unroll
        for (int q = 0; q < 4; ++q) { const int idx = 4 * (lane + 64 * q); if (!DRYE || rstd == 12345.678f) *(f32x4*)(row + idx) = v[q] * rstd * *(const f32x4*)(fg + idx); }
    }
}
template <bool DRY>
DI void ph_attention(ArgsP ap, int l, LAS unsigned char* lds) {
    constexpr int OM0 = DRY ? 2 : 0;
    const int G = grd_l(), bx = bid_l(), vcu = (G % 8 == 0) ? (bx % 8) * (G / 8) + bx / 8 : bx;
    bf16_t* P = (bf16_t*)(ap->ws + WS_P); const bf16_t* QM = (const bf16_t*)(ap->ws + WS_QM); const bf16_t* KM = (const bf16_t*)(ap->ws + WS_KM); const bf16_t* VM = (const bf16_t*)(ap->ws + WS_VM);
    float* OD = (float*)(ap->ws + WS_OD); const float* sink = ap->in[I_SINK] + l * 16;
#if !defined(ATT_ONLY) || ATT_ONLY == 1
    if (!DRY || (DRY_SEL & 1))
    for (int u = vcu; u < GB * 8 * 32; u += G) { const int bh = u >> 5, qb = u & 31, bl = bh >> 3, h = bh & 7; const size_t rb = (size_t)bl * RB, q0 = rb + CTX + 256 * qb;
        attn_unit<96, 128, OM0, false>(lds, QM + q0 * 768 + h * 96, 768, KM + rb * 768 + h * 96, 768, VM + rb * 1024 + h * 128, 1024, RB / 64, 0, 0, 0, 0, NEGBIG, 0.f, P + q0 * NP + C_Z + h * 128, NP, OD, 0); }
#endif
#if !defined(ATT_ONLY) || ATT_ONLY == 2
    if (!DRY || (DRY_SEL & 2))
    for (int u = vcu; u < GB * 16 * 32; u += G) { const int bh = u >> 5, qb = u & 31, bl = bh >> 4, hm = bh & 15; const size_t rb = (size_t)bl * RB, q0 = rb + CTX + 256 * qb;
        attn_unit<64, 128, 1, false>(lds, P + q0 * NP + C_DQ + hm * 64, NP, P + rb * NP + C_DK + hm * 64, NP, P + rb * NP + C_DV + (hm >> 1) * 128, NP, RB / 64, 0, 0, 0, 0, NEGBIG, 0.f, nullptr, 0, OD + q0 * 2048 + hm * 128, 2048); }
#endif
#if !defined(ATT_ONLY) || ATT_ONLY == 3
    if (!DRY || (DRY_SEL & 4))
    for (int u = vcu; u < GB * 16 * 32; u += G) { const int bh = u >> 5, qb = u & 31, bl = bh >> 4, h = bh & 15; const size_t rb = (size_t)bl * RB, q0 = rb + CTX + 256 * qb;
        const int lo = (256 * qb - 128 < 0) ? 0 : 256 * qb - 128, hi = (256 * qb + 384 > SEQ) ? SEQ : 256 * qb + 384;
        attn_unit<64, 64, OM0, true>(lds, P + q0 * NP + C_SQ + h * 64, NP, P + rb * NP + C_SK + (h >> 2) * 64, NP, P + rb * NP + C_SV + (h >> 2) * 64, NP, CTX / 64, CTX + lo, (hi - lo) / 64, lo, 256 * qb, sink[h] * LOG2E, 1.0f,
                              P + q0 * NP + C_Z + 2048 + h * 64, NP, OD, 0); }
#endif
#if !defined(ATT_ONLY)
    if (l == 0) {
        for (int u = vcu; u < GB * 40; u += G) { const int bl = u / 40, k = u % 40; const size_t rb = (size_t)bl * RB;
            if (k < 8) { const int h = k;
                attn_unit<96, 128, OM0, false>(lds, QM + rb * 768 + h * 96, 768, KM + rb * 768 + h * 96, 768, VM + rb * 1024 + h * 128, 1024, CTX / 64, 0, 0, 0, 0, NEGBIG, 0.f, P + rb * NP + C_Z + h * 128, NP, OD, 0); }
            else if (k < 24) { const int hm = k - 8;
                attn_unit<64, 128, 1, false>(lds, P + rb * NP + C_DQ + hm * 64, NP, P + rb * NP + C_DK + hm * 64, NP, P + rb * NP + C_DV + (hm >> 1) * 128, NP, CTX / 64, 0, 0, 0, 0, NEGBIG, 0.f, nullptr, 0, OD + rb * 2048 + hm * 128, 2048); }
            else { const int h = k - 24;
                attn_unit<64, 64, OM0, false>(lds, P + rb * NP + C_SQ + h * 64, NP, P + rb * NP + C_SK + (h >> 2) * 64, NP, P + rb * NP + C_SV + (h >> 2) * 64, NP, CTX / 64, 0, 0, 0, 0, sink[h] * LOG2E, 1.0f, P + rb * NP + C_Z + 2048 + h * 64, NP, OD, 0); }
        }
    }
#endif
}

#define RLX_AGENT __ATOMIC_RELAXED, __HIP_MEMORY_SCOPE_AGENT
#define XB_TMO      128
#define XB_XCNT(j)  (256  + 64 * (j))
#define XB_XSUB(j)  (1280 + 64 * (j))
#define XB_XGEN(j)  (2304 + 64 * (j))
#define XB_TOP      3328
#define XB_TOPGEN   3392
#define XCD_BAR_WORDS 3456
#define XB_SPIN_CAP (1u << 18)

__device__ __forceinline__ unsigned xb_ld(unsigned* p)              { return __hip_atomic_load(p, __ATOMIC_RELAXED, __HIP_MEMORY_SCOPE_AGENT); }
__device__ __forceinline__ unsigned xb_add(unsigned* p, unsigned v) { return __hip_atomic_fetch_add(p, v, __ATOMIC_RELAXED, __HIP_MEMORY_SCOPE_AGENT); }
__device__ __forceinline__ unsigned xb_xcc_id() { return (unsigned)__builtin_amdgcn_s_getreg((3 << 11) | 20) & 0xFu; }
#define XB_SPIN(cond, bar) do { unsigned _sp = 0; while (cond) { __builtin_amdgcn_s_sleep(1); \
    if ((++_sp & 255u) == 0u) { if (xb_ld(&(bar)[XB_TMO])) break; if (_sp > XB_SPIN_CAP) { atomicAdd(&(bar)[XB_TMO], 1u); break; } } } } while (0)

struct XcdBarrier {
    unsigned* bar; unsigned x;
    volatile LAS unsigned* st;
};

__device__ __forceinline__ XcdBarrier xcd_barrier_post(unsigned* bar, volatile LAS unsigned* st) {
    XcdBarrier b; b.bar = bar; b.x = xb_xcc_id(); b.st = st;
    if (threadIdx.x == 0) (void)xb_add(&bar[XB_XCNT(b.x)], 1u);
    return b;
}
__device__ __forceinline__ void xcd_barrier_complete(unsigned* bar, unsigned x, unsigned& nloc, unsigned& nx) {
    const unsigned G = gridDim.x * gridDim.y * gridDim.z;
    unsigned sum, cnt, mine, sp = 0u;
    for (;;) {
        sum = 0u; cnt = 0u; mine = 0u;
#pragma unroll
        for (unsigned j = 0; j < 16; ++j) { const unsigned c = xb_ld(&bar[XB_XCNT(j)]); sum += c; cnt += (c > 0u) ? 1u : 0u; mine = (j == x) ? c : mine; }
        if (sum == G) break;
        __builtin_amdgcn_s_sleep(1);
        if ((++sp & 255u) == 0u) { if (xb_ld(&bar[XB_TMO])) break; if (sp > XB_SPIN_CAP) { atomicAdd(&bar[XB_TMO], 1u); break; } }
    }
    nloc = mine > 0u ? mine : 1u; nx = cnt > 0u ? cnt : 1u;
}

__device__ __forceinline__ void xcd_barrier(const XcdBarrier& b) {
    asm volatile("s_waitcnt vmcnt(0)" ::: "memory");
    __syncthreads();
    if (threadIdx.x == 0) {
        unsigned* bar = b.bar;
        __builtin_amdgcn_s_waitcnt(0);
        unsigned nloc = b.st[0], nx = b.st[1];
        if (nloc == 0u) { xcd_barrier_complete(bar, b.x, nloc, nx); b.st[0] = nloc; b.st[1] = nx; }
        const unsigned old = xb_add(&bar[XB_XSUB(b.x)], 1u);
        const unsigned gen = old / nloc;
        if (old + 1u == (gen + 1u) * nloc) {
            __builtin_amdgcn_fence(__ATOMIC_RELEASE, "agent");
            asm volatile("s_waitcnt vmcnt(0)" ::: "memory");
            const unsigned og = xb_add(&bar[XB_TOP], 1u);
            const unsigned tg = og / nx;
            if (og + 1u == (tg + 1u) * nx) xb_add(&bar[XB_TOPGEN], 1u);
            else XB_SPIN(xb_ld(&bar[XB_TOPGEN]) == tg, bar);
            __builtin_amdgcn_fence(__ATOMIC_ACQUIRE, "agent");
            xb_add(&bar[XB_XGEN(b.x)], 1u);
            asm volatile("s_waitcnt vmcnt(0)" ::: "memory");
        } else {
            XB_SPIN(xb_ld(&bar[XB_XGEN(b.x)]) == gen, bar);
            __builtin_amdgcn_fence(__ATOMIC_ACQUIRE, "agent");
            asm volatile("s_waitcnt vmcnt(0)" ::: "memory");
        }
    }
    __syncthreads();
}


__global__ void __launch_bounds__(512, 2) hybrid_fwd(Args a_unused) {
    extern __shared__ __attribute__((aligned(16))) unsigned char lds_raw[];
    LAS unsigned char* lds = (LAS unsigned char*)lds_raw;
    cg::grid_group grid = cg::this_grid();
    { volatile LAS unsigned* xst = (volatile LAS unsigned*)(lds + XB_LDS_OFF);
      if (threadIdx.x < 2) xst[threadIdx.x] = 0u;
      __syncthreads();
      (void)xcd_barrier_post((unsigned*)(args_ptr()->ws), xst); }
#define GSYNC() do { XcdBarrier b_; b_.bar = (unsigned*)(args_ptr()->ws); b_.x = xb_xcc_id(); b_.st = (volatile LAS unsigned*)(lds + XB_LDS_OFF); xcd_barrier(b_); } while (0)
#ifndef NO_PRO
    prologue(args_ptr(), lds);
#ifdef PROBE_PRO
    __syncthreads(); prologue(args_ptr(), lds);
#endif
#endif
    grid.sync();
    mod_finalize(args_ptr());
    GSYNC();
    for (int l = 0; l < 2; ++l) {
        for (int g = 0; g < NGRP; ++g) {
            ph_norm_mod(args_ptr(), lnd(l), lnd(g));
#ifdef PROBE_R1
            GSYNC(); ph_norm_mod(args_ptr(), lnd(l), lnd(g));
#endif
            GSYNC();
#ifndef NO_GEMM
            {
                unsigned char* ws = args_ptr()->ws; const int G = grd_l(), bx = bid_l();
                pg8::Gemm gm{1024, 1024, 1024}; pg8::Order S; S.init(R, NP, G, bx, ws + WS_H, 1024, (bf16_t*)(ws + WS_WIN) + (size_t)l * NP * 1024, 1024, 1 << 20, 0);
                EpiIn E{ws};
                pg8::gemm_phase<EpiIn, pg8::Order, true, true>(lds, gm, S, E);
#ifdef PROBE_G1
                __syncthreads(); pg8::gemm_phase<EpiIn, pg8::Order, true, true>(lds, gm, S, E);
#endif
            }
#endif
            GSYNC();
            ph_mla_norm(args_ptr());
#ifdef PROBE_R1
            GSYNC(); ph_mla_norm(args_ptr());
#endif
            GSYNC();
#ifndef NO_GEMM2
            {
                unsigned char* ws = args_ptr()->ws; const int G = grd_l(), bx = bid_l();
                pg8::Gemm gq{384, 384, 384}; pg8::Order Sq; Sq.init(R, 768, G, bx, ws + WS_AQ, 384, (bf16_t*)(ws + WS_WUQ) + (size_t)l * 768 * 384, 384, 1 << 20, 0);
                EpiQ Eq{ws};
#ifndef NO_GQ
                pg8::gemm_phase<EpiQ, pg8::Order, true, true>(lds, gq, Sq, Eq);
#ifdef PROBE_G2
                __syncthreads(); pg8::gemm_phase<EpiQ, pg8::Order, true, true>(lds, gq, Sq, Eq);
#endif
#endif
            }
            {
                unsigned char* ws = args_ptr()->ws; const int G = grd_l(), bx = bid_l();
                pg8::Gemm gk{256, 256, 256}; pg8::Order Sk; Sk.init(R, 1536, G, bx, ws + WS_AKV, 256, (bf16_t*)(ws + WS_WUKV) + (size_t)l * 1536 * 256, 256, 1 << 20, 0);
                EpiKV Ek{ws};
#ifndef NO_GK
                pg8::gemm_phase<EpiKV, pg8::Order, true, true>(lds, gk, Sk, Ek);
#ifdef PROBE_G2
                __syncthreads(); pg8::gemm_phase<EpiKV, pg8::Order, true, true>(lds, gk, Sk, Ek);
#endif
#endif
            }
#endif
            GSYNC();
#ifndef NO_ATT
#ifdef PROBE_ATT
            ph_attention<true>(args_ptr(), lnd(l), lds);
            GSYNC();
#endif
            ph_attention<false>(args_ptr(), lnd(l), lds);
#endif
            GSYNC();
#ifdef PROBE_R2
            ph_diff_post<true>(args_ptr(), lnd(l)); GSYNC();
#endif
            ph_diff_post<false>(args_ptr(), lnd(l));
            GSYNC();
#ifndef NO_BR
            {
                unsigned char* ws = args_ptr()->ws; const int G = grd_l(), bx = bid_l();
                pg8::Gemm gb{1024, NP, 1024}; pg8::Order S; S.init(R, 3072, G, bx, (bf16_t*)(ws + WS_P) + C_Z, NP, (bf16_t*)(ws + WS_WB) + (size_t)l * 3 * 1024 * 1024, 1024, 4, 1024 * 2, l != 0);
#ifdef PROBE_BR
                { EpiBrT<true> Ed{ws}; pg8::gemm_phase<EpiBrT<true>, pg8::Order, true, true>(lds, gb, S, Ed); __syncthreads(); }
#endif
                EpiBrT<false> E{ws};
                pg8::gemm_phase<EpiBrT<false>, pg8::Order, true, true>(lds, gb, S, E);
            }
#endif
            GSYNC();
#ifndef NO_OUT
            {
                ArgsP ap = args_ptr(); unsigned char* ws = ap->ws; const int G = grd_l(), bx = bid_l();
                pg8::Gemm go{3072, NP, 3072}; pg8::Order S; S.init(R, 1024, G, bx, (bf16_t*)(ws + WS_P) + C_GM, NP, (bf16_t*)(ws + WS_WO3) + (size_t)l * 1024 * 3072, 3072, 1 << 20, 0, l != 0);
#ifdef PROBE_OUT
                { EpiOutT<true> Ed{l, g, (l == 0) ? ap->in[I_X] : (const float*)ap->out, ap->out, ap->in[I_CTX], ws}; pg8::gemm_phase<EpiOutT<true>, pg8::Order, true, true>(lds, go, S, Ed); __syncthreads(); }
#endif
                EpiOutT<false> E{l, g, (l == 0) ? ap->in[I_X] : (const float*)ap->out, ap->out, ap->in[I_CTX], ws};
                pg8::gemm_phase<EpiOutT<false>, pg8::Order, true, true>(lds, go, S, E);
            }
#endif
        }
        GSYNC();
    }
#ifdef PROBE_R2
    ph_final_norm<true>(args_ptr()); GSYNC();
#endif
    ph_final_norm<false>(args_ptr());
}

extern "C" void kernel_launch(void* const* d_in, const int* in_sizes, int n_in, void* d_out, int out_size, void* d_ws, size_t ws_size, hipStream_t stream) {
    static int grid = 0;
    if (grid == 0) {
        if (n_in != 21 || ws_size < WS_END) { fprintf(stderr, "kernel_launch: expected 21 inputs and >= %zu bytes of workspace (got %d, %zu)\n", (size_t)WS_END, n_in, ws_size); grid = -1; return; }
        int dev = 0, cus = 0, per_cu = 0;
        (void)hipGetDevice(&dev); (void)hipDeviceGetAttribute(&cus, hipDeviceAttributeMultiprocessorCount, dev);
        if (hipFuncSetAttribute((const void*)hybrid_fwd, hipFuncAttributeMaxDynamicSharedMemorySize, LDS_BYTES) != hipSuccess) fprintf(stderr, "kernel_launch: hipFuncSetAttribute failed\n");
        if (hipOccupancyMaxActiveBlocksPerMultiprocessor(&per_cu, (const void*)hybrid_fwd, 512, LDS_BYTES) != hipSuccess || per_cu < 1) { per_cu = 1; (void)hipGetLastError(); }
        if (cus <= 0) cus = 256;
        grid = cus * per_cu;
    }
    if (grid < 0) return;
    Args a{};
    for (int i = 0; i < 21; ++i) a.in[i] = (const float*)d_in[i];
    a.out = (float*)d_out; a.ws = (unsigned char*)d_ws;
    (void)hipMemsetAsync(d_ws, 0, 16384, stream);
    void* args[] = {&a};
    hipError_t e = hipLaunchCooperativeKernel((const void*)hybrid_fwd, dim3(grid), dim3(512), args, LDS_BYTES, stream);
    if (e != hipSuccess) fprintf(stderr, "kernel_launch: cooperative launch failed: %s (grid %d)\n", hipGetErrorString(e), grid);
}
```

```cpp
#include <hip/hip_runtime.h>
#include <hip/hip_cooperative_groups.h>
#include <cstdio>
#include <cstdint>
namespace cg = cooperative_groups;

#define DI __device__ __forceinline__
#define LAS __attribute__((address_space(3)))
__device__ __forceinline__ int tid_l() { int t = threadIdx.x; asm volatile("" : "+v"(t)); return t; }
__device__ __forceinline__ int bid_l() { int b = blockIdx.x; asm volatile("" : "+s"(b)); return b; }
__device__ __forceinline__ int lnd(int x) { asm volatile("" : "+s"(x)); return x; }
__device__ __forceinline__ int grd_l() { int g = gridDim.x; asm volatile("" : "+s"(g)); return g; }
typedef unsigned short bf16_t;
typedef short bf16x8 __attribute__((ext_vector_type(8)));
typedef short s16x4 __attribute__((ext_vector_type(4)));
typedef float f32x4 __attribute__((ext_vector_type(4)));
typedef float f32x16 __attribute__((ext_vector_type(16)));
typedef unsigned u32x4 __attribute__((ext_vector_type(4)));
typedef unsigned u32x2 __attribute__((ext_vector_type(2)));

constexpr int DM = 1024, NBATCH = 8, SEQ = 8192, CTX = 256, RB = CTX + SEQ;
constexpr int GB = 2, NGRP = NBATCH / GB, R = GB * RB;
constexpr int NP = 11520;
constexpr int C_QC = 0, C_KVC = 384, C_KR = 640, C_DQ = 768, C_DK = 1792, C_DV = 2816, C_SQ = 3840, C_SK = 4864, C_SV = 5120, C_Z = 5376, C_GM = 8448;
constexpr int D_IN = 11424;
constexpr float EPS = 1e-6f, LOG2E = 1.4426950408889634f;
constexpr float QS64 = 0.125f * LOG2E, QS96 = 0.10206207261596575f * LOG2E;
constexpr float NEGBIG = -1e30f, THR = 8.0f;

constexpr size_t al256(size_t x) { return (x + 255) & ~(size_t)255; }
constexpr size_t WS_WIN = 1u << 20;
constexpr size_t WS_WUQ = al256(WS_WIN + (size_t)2 * NP * 1024 * 2);
constexpr size_t WS_WUKV = al256(WS_WUQ + (size_t)2 * 768 * 384 * 2);
constexpr size_t WS_WB = al256(WS_WUKV + (size_t)2 * 1536 * 256 * 2);
constexpr size_t WS_WO3 = al256(WS_WB + (size_t)2 * 3 * 1024 * 1024 * 2);
constexpr size_t WS_COSH = al256(WS_WO3 + (size_t)2 * 1024 * 3072 * 2);
constexpr size_t WS_SINH = al256(WS_COSH + (size_t)SEQ * 32 * 4);
constexpr size_t WS_COSM = al256(WS_SINH + (size_t)SEQ * 32 * 4);
constexpr size_t WS_SINM = al256(WS_COSM + (size_t)SEQ * 16 * 4);
constexpr size_t WS_MODP = al256(WS_SINM + (size_t)SEQ * 16 * 4);
constexpr size_t WS_MOD = al256(WS_MODP + (size_t)16 * 2 * 9 * 3072 * 4);
constexpr size_t WS_CTX = al256(WS_MOD + (size_t)2 * 9 * 3072 * 4);
constexpr size_t WS_H = al256(WS_CTX + (size_t)NBATCH * CTX * DM * 4);
constexpr size_t WS_P = al256(WS_H + (size_t)R * DM * 2);
constexpr size_t WS_AQ = al256(WS_P + (size_t)R * NP * 2);
constexpr size_t WS_AKV = al256(WS_AQ + (size_t)R * 384 * 2);
constexpr size_t WS_QM = al256(WS_AKV + (size_t)R * 256 * 2);
constexpr size_t WS_KM = al256(WS_QM + (size_t)R * 768 * 2);
constexpr size_t WS_VM = al256(WS_KM + (size_t)R * 768 * 2);
constexpr size_t WS_OD = al256(WS_VM + (size_t)R * 1024 * 2);
constexpr size_t WS_END = al256(WS_OD + (size_t)R * 2048 * 4);
static_assert(WS_END <= ((size_t)1 << 30), "workspace map exceeds 1 GiB");

constexpr int LDS_BYTES = 155648, XB_LDS_OFF = 155136;

DI unsigned pk2(float lo, float hi) { typedef float f2_t __attribute__((ext_vector_type(2))); typedef __bf16 b2_t __attribute__((ext_vector_type(2)));
    f2_t v = {lo, hi}; b2_t b = __builtin_convertvector(v, b2_t); return __builtin_bit_cast(unsigned, b); }
DI u32x4 pack8(f32x4 a, f32x4 b) { u32x4 w; w.x = pk2(a[0], a[1]); w.y = pk2(a[2], a[3]); w.z = pk2(b[0], b[1]); w.w = pk2(b[2], b[3]); return w; }
DI float bflo(unsigned w) { return __uint_as_float(w << 16); }
DI float bfhi(unsigned w) { return __uint_as_float(w & 0xffff0000u); }
DI float wave_sum(float v) {
#pragma unroll
    for (int o = 1; o < 64; o <<= 1) v += __shfl_xor(v, o);
    return v; }
DI float silu_f(float z) { return z * __builtin_amdgcn_rcpf(1.0f + __expf(-z)); }
DI float sigm_f(float z) { return __builtin_amdgcn_rcpf(1.0f + __expf(-z)); }
DI void rope8(f32x4& v0, f32x4& v1, const f32x4 cs, const f32x4 sn) {
    float a, b;
    a = v0[0]; b = v0[1]; v0[0] = a * cs[0] - b * sn[0]; v0[1] = b * cs[0] + a * sn[0];
    a = v0[2]; b = v0[3]; v0[2] = a * cs[1] - b * sn[1]; v0[3] = b * cs[1] + a * sn[1];
    a = v1[0]; b = v1[1]; v1[0] = a * cs[2] - b * sn[2]; v1[1] = b * cs[2] + a * sn[2];
    a = v1[2]; b = v1[3]; v1[2] = a * cs[3] - b * sn[3]; v1[3] = b * cs[3] + a * sn[3];
}
namespace pg8 {
#define PG8_LAS __attribute__((address_space(3)))
typedef unsigned short bf16_t;
typedef short bf16x8 __attribute__((ext_vector_type(8)));
typedef float f32x4 __attribute__((ext_vector_type(4)));
typedef unsigned u32x4 __attribute__((ext_vector_type(4)));
constexpr int BM = 256, BK = 64, HALF = 128, HTB = HALF * BK * 2  , STAGE_BYTES = 8 * HTB, NXCD = 8, WGM = 8;

__host__ __device__ __forceinline__ int lds_byte(int r, int c) { const int st = (r >> 4) * 2 + (c >> 5), rr = r & 15, cc = c & 31, ob = rr * 64 + cc * 2; return st * 1024 + (ob ^ (((ob >> 9) & 1) << 5)); }
__host__ __device__ __forceinline__ void stage_rc(int b, int& R, int& C) { const int st = b / 1024, sb = b % 1024, swz = sb ^ (((sb >> 9) & 1) << 5); R = (st >> 1) * 16 + swz / 64; C = (st & 1) * 32 + (swz % 64) / 2; }
__host__ __device__ __forceinline__ int perm32(int rho) { const int n = rho >> 4, i = rho & 15; return 8 * (i >> 2) + 4 * n + (i & 3); }

struct Unit { int pm, pn; };
struct Gemm { int K, lda, ldb; };
struct Order {
    int nM, nN, nwg, G, c; const char* A; const char* B; unsigned tA, tB; int pnblk; unsigned ablk; int skipctx;
    __device__ __forceinline__ void init(int M, int N, int G_, int c_, const void* A_, int lda, const void* B_, int ldb, int pnblk_, unsigned ablk_, int skipctx_ = 0) {
        skipctx = skipctx_; nM = M / BM; if (skipctx) nM -= nM / 33;
        nN = N / BM; nwg = nM * nN; G = G_; c = c_; A = (const char*)A_; B = (const char*)B_; tA = (unsigned)(BM * lda * 2); tB = (unsigned)(BM * ldb * 2); pnblk = pnblk_; ablk = ablk_; }
    __device__ __forceinline__ bool next(int i, Unit& u) const {
        const long L = (long)i * G + c; if (L >= nwg) return false;
        int wgid = (int)L; { const int q = nwg / NXCD, r = nwg % NXCD, xcd = wgid % NXCD, off = wgid / NXCD; wgid = (xcd < r ? xcd * (q + 1) : r * (q + 1) + (xcd - r) * q) + off; }
        const int nig = WGM * nN, gid = wgid / nig, fm = gid * WGM, gsz = (nM - fm) < WGM ? (nM - fm) : WGM;
        u.pm = fm + ((wgid % nig) % gsz); u.pn = (wgid % nig) / gsz; if (skipctx) u.pm += u.pm / 32 + 1; return true;
    }
    __device__ __forceinline__ const char* a_base(const Unit& u) const { return A + (size_t)u.pm * tA + (size_t)(u.pn / pnblk) * ablk; }
    __device__ __forceinline__ const char* b_base(const Unit& u) const { return B + (size_t)u.pn * tB; }
};

template <class Epi, class Sched, bool ALIGN_EPI = false, bool SP2 = false>
__device__ __forceinline__ void gemm_phase(PG8_LAS unsigned char* lds, const Gemm g, const Sched& S, const Epi& E) {
    const int tid = tid_l(), wid = __builtin_amdgcn_readfirstlane(tid >> 6), lane = tid & 63, wr = wid >> 2, wc = wid & 3, fr = lane & 15, fq = lane >> 4;
    const int K = g.K, nt = K / BK;
    unsigned voffA[2], voffB[2];
#pragma unroll
    for (int i = 0; i < 2; ++i) { int R, C; stage_rc(tid * 16 + i * 8192, R, C); const int Rb = Epi::PERM ? ((R & ~31) + perm32(R & 31)) : R;
        voffA[i] = (unsigned)(R * g.lda + C) * 2u; voffB[i] = (unsigned)(Rb * g.ldb + C) * 2u; }
    const size_t kstep = (size_t)(BK * 2);
    const size_t hstepA = (size_t)HALF * g.lda * 2, hstepB = (size_t)HALF * g.ldb * 2;
    const unsigned ldsw = (unsigned)wid * 1024u;
    const int aoff = lds_byte(wr * 64 + fr, fq * 8), boff = lds_byte(wc * 32 + fr, fq * 8);
#define PG8_SA(b, h) (((b) * 2 + (h)) * HTB)
#define PG8_SB(b, h) ((4 + (b) * 2 + (h)) * HTB)
#define PG8_STAGE(bufoff, gbase, voff) do { _Pragma("unroll") for (int _i = 0; _i < 2; ++_i) \
        __builtin_amdgcn_global_load_lds((const unsigned*)((const char*)(gbase) + (voff)[_i]), (PG8_LAS unsigned*)(lds + (bufoff) + ldsw + _i * 8192), 16, 0, 0); } while (0)
#define PG8_LDA(dst, b, h) do { _Pragma("unroll") for (int m = 0; m < 4; ++m) _Pragma("unroll") for (int k = 0; k < 2; ++k) dst[m][k] = *(const PG8_LAS bf16x8*)(lds + PG8_SA(b, h) + aoff + m * 2048 + k * 1024); } while (0)
#define PG8_LDB(dst, b, h) do { _Pragma("unroll") for (int n = 0; n < 2; ++n) _Pragma("unroll") for (int k = 0; k < 2; ++k) dst[n][k] = *(const PG8_LAS bf16x8*)(lds + PG8_SB(b, h) + boff + n * 2048 + k * 1024); } while (0)
#define PG8_MMA(ai, bj, At, Bt) do { __builtin_amdgcn_s_setprio(1); _Pragma("unroll") for (int m = 0; m < 4; ++m) _Pragma("unroll") for (int n = 0; n < 2; ++n) _Pragma("unroll") for (int k = 0; k < 2; ++k) \
        acc[ai][bj][m][n] = __builtin_amdgcn_mfma_f32_16x16x32_bf16(Bt[n][k], At[m][k], acc[ai][bj][m][n], 0, 0, 0); __builtin_amdgcn_s_setprio(0); } while (0)
#define PG8_WAIT_V(n) asm volatile("s_waitcnt vmcnt(" #n ")" ::: "memory")
#define PG8_WAIT_L(n) asm volatile("s_waitcnt lgkmcnt(" #n ")" ::: "memory")
#define PG8_BAR __builtin_amdgcn_s_barrier()
#define PG8_SCHED __builtin_amdgcn_sched_barrier(0)
    Unit cur, nxt; int ui = 0;
    if (!S.next(0, cur)) return;
    f32x4 acc[2][2][4][2];
#pragma unroll
    for (int a = 0; a < 2; ++a)
#pragma unroll
        for (int b = 0; b < 2; ++b)
#pragma unroll
            for (int m = 0; m < 4; ++m)
#pragma unroll
                for (int n = 0; n < 2; ++n) acc[a][b][m][n] = (f32x4){0.f, 0.f, 0.f, 0.f};
    bf16x8 At[4][2], B0[2][2], B1[2][2];
    const char* cA = S.a_base(cur); const char* cB = S.b_base(cur);

    if constexpr (SP2) {
        PG8_STAGE(PG8_SB(0, 0), cB, voffB); PG8_STAGE(PG8_SB(0, 1), cB + hstepB, voffB); PG8_STAGE(PG8_SA(0, 0), cA, voffA); PG8_STAGE(PG8_SA(0, 1), cA + hstepA, voffA);
        if (wr == 1) PG8_BAR;
        PG8_WAIT_V(2); PG8_BAR;
        PG8_STAGE(PG8_SB(1, 0), cB + kstep, voffB); PG8_STAGE(PG8_SA(1, 0), cA + kstep, voffA); PG8_STAGE(PG8_SB(1, 1), cB + hstepB + kstep, voffB);
        PG8_WAIT_V(6); PG8_BAR;
    } else {
        PG8_STAGE(PG8_SB(0, 0), cB, voffB); PG8_STAGE(PG8_SA(0, 0), cA, voffA); PG8_STAGE(PG8_SB(0, 1), cB + hstepB, voffB); PG8_STAGE(PG8_SA(0, 1), cA + hstepA, voffA);
        if (wr == 1) PG8_BAR;
        PG8_WAIT_V(4); PG8_BAR;
        PG8_STAGE(PG8_SB(1, 0), cB + kstep, voffB); PG8_STAGE(PG8_SA(1, 0), cA + kstep, voffA); PG8_STAGE(PG8_SB(1, 1), cB + hstepB + kstep, voffB);
        PG8_WAIT_V(6); PG8_BAR;
    }
    for (;;) {
        const bool has_next = S.next(ui + 1, nxt);
        const char* nA = has_next ? S.a_base(nxt) : cA; const char* nB = has_next ? S.b_base(nxt) : cB;
#pragma nounroll
        for (int t = 0; t < nt; t += 2) {
            const bool last = (t == nt - 2);
            const char* a1 = cA + (size_t)(t + 1) * kstep;
            const char* a2 = last ? nA : cA + (size_t)(t + 2) * kstep; const char* b2 = last ? nB : cB + (size_t)(t + 2) * kstep;
            const char* a3 = a2 + kstep; const char* b3 = b2 + kstep;

            if constexpr (SP2) {
            PG8_LDB(B0, 0, 0); PG8_LDB(B1, 0, 1); PG8_SCHED; PG8_LDA(At, 0, 0); PG8_STAGE(PG8_SA(1, 1), a1 + hstepA, voffA);
            PG8_WAIT_V(8); PG8_WAIT_L(0); PG8_BAR; PG8_MMA(0, 0, At, B0); PG8_MMA(0, 1, At, B1); PG8_BAR; PG8_SCHED;
            PG8_LDA(At, 0, 1); PG8_STAGE(PG8_SB(0, 0), b2, voffB); PG8_STAGE(PG8_SB(0, 1), b2 + hstepB, voffB); PG8_STAGE(PG8_SA(0, 0), a2, voffA);
            PG8_WAIT_V(8); PG8_WAIT_L(0); PG8_BAR; PG8_MMA(1, 0, At, B0); PG8_MMA(1, 1, At, B1); PG8_BAR; PG8_SCHED;
            PG8_LDB(B0, 1, 0); PG8_LDB(B1, 1, 1); PG8_SCHED; PG8_LDA(At, 1, 0); PG8_STAGE(PG8_SA(0, 1), a2 + hstepA, voffA);
            PG8_WAIT_V(8); PG8_WAIT_L(0); PG8_BAR; PG8_MMA(0, 0, At, B0); PG8_MMA(0, 1, At, B1); PG8_BAR; PG8_SCHED;
            PG8_LDA(At, 1, 1); PG8_STAGE(PG8_SB(1, 0), b3, voffB); PG8_STAGE(PG8_SB(1, 1), b3 + hstepB, voffB); PG8_STAGE(PG8_SA(1, 0), a3, voffA);
            PG8_WAIT_V(8); PG8_WAIT_L(0); PG8_BAR; PG8_MMA(1, 0, At, B0); PG8_MMA(1, 1, At, B1); PG8_BAR; PG8_SCHED;
            } else {
            PG8_LDB(B0, 0, 0); PG8_SCHED; PG8_LDA(At, 0, 0); PG8_STAGE(PG8_SA(1, 1), a1 + hstepA, voffA);
            PG8_WAIT_L(8); PG8_BAR; PG8_WAIT_L(0); PG8_MMA(0, 0, At, B0); PG8_BAR; PG8_SCHED;
            PG8_LDB(B1, 0, 1); PG8_STAGE(PG8_SB(0, 0), b2, voffB);
            PG8_BAR; PG8_WAIT_L(0); PG8_MMA(0, 1, At, B1); PG8_BAR;
            PG8_LDA(At, 0, 1); PG8_STAGE(PG8_SA(0, 0), a2, voffA);
            PG8_BAR; PG8_WAIT_L(0); PG8_MMA(1, 0, At, B0); PG8_BAR; PG8_SCHED;
            PG8_STAGE(PG8_SB(0, 1), b2 + hstepB, voffB);
            PG8_WAIT_V(6); PG8_BAR; PG8_MMA(1, 1, At, B1); PG8_BAR;
            PG8_LDB(B0, 1, 0); PG8_SCHED; PG8_LDA(At, 1, 0); PG8_STAGE(PG8_SA(0, 1), a2 + hstepA, voffA);
            PG8_WAIT_L(8); PG8_BAR; PG8_WAIT_L(0); PG8_MMA(0, 0, At, B0); PG8_BAR; PG8_SCHED;
            PG8_LDB(B1, 1, 1); PG8_STAGE(PG8_SB(1, 0), b3, voffB);
            PG8_BAR; PG8_WAIT_L(0); PG8_MMA(0, 1, At, B1); PG8_BAR;
            PG8_LDA(At, 1, 1); PG8_STAGE(PG8_SA(1, 0), a3, voffA);
            PG8_BAR; PG8_WAIT_L(0); PG8_MMA(1, 0, At, B0); PG8_BAR; PG8_SCHED;
            PG8_STAGE(PG8_SB(1, 1), b3 + hstepB, voffB);
            PG8_WAIT_V(6); PG8_BAR; PG8_MMA(1, 1, At, B1); PG8_BAR;
            }
        }
        if constexpr (ALIGN_EPI) { if (wr == 0) PG8_BAR; }
        if constexpr (!Epi::AFTER_DRAIN) { E(acc, cur, wr, wc, fr, fq); }
        if (!has_next) break;
#pragma unroll
        for (int a = 0; a < 2; ++a)
#pragma unroll
            for (int b = 0; b < 2; ++b)
#pragma unroll
                for (int m = 0; m < 4; ++m)
#pragma unroll
                    for (int n = 0; n < 2; ++n) acc[a][b][m][n] = (f32x4){0.f, 0.f, 0.f, 0.f};
        cur = nxt; cA = nA; cB = nB; ++ui;
        if constexpr (ALIGN_EPI) { if (wr == 1) PG8_BAR; }
    }
    PG8_WAIT_V(0);
    if constexpr (!ALIGN_EPI) { if (wr == 0) PG8_BAR; }
    PG8_BAR;
    if constexpr (Epi::AFTER_DRAIN) { E.fused(acc, cur, wr, wc, fr, fq, lds, wid, lane); }
#undef PG8_SA
#undef PG8_SB
#undef PG8_STAGE
#undef PG8_LDA
#undef PG8_LDB
#undef PG8_MMA
#undef PG8_WAIT_V
#undef PG8_WAIT_L
#undef PG8_BAR
#undef PG8_SCHED
}
}
struct EpiIn {
    static constexpr bool PERM = true, AFTER_DRAIN = false;
    unsigned char* ws;
    DI void operator()(const f32x4 (&acc)[2][2][4][2], const pg8::Unit& u, int wr, int wc, int fr, int fq) const {
        bf16_t* P = (bf16_t*)(ws + WS_P); const float* cosH = (const float*)(ws + WS_COSH); const float* sinH = (const float*)(ws + WS_SINH); const float* cosM = (const float*)(ws + WS_COSM); const float* sinM = (const float*)(ws + WS_SINM);
        const int pn = u.pn; const bool ctxt = (u.pm % 33) == 0;
        int mode = 0; float sc = 1.f;
        if ((pn >= 3 && pn <= 10) || (pn >= 15 && pn <= 19)) mode = 1;
        if (pn == 2) mode = 2;
        if ((pn >= 3 && pn <= 6) || (pn >= 15 && pn <= 18)) sc = QS64;
        if (ctxt) mode = 0;
        const int rowt = u.pm * 256 + wr * 64 + fr, colb = pn * 256 + wc * 32 + 8 * fq;
#pragma unroll
        for (int ai = 0; ai < 2; ++ai)
#pragma unroll
            for (int m = 0; m < 4; ++m) {
                const int row = rowt + ai * 128 + m * 16; const int pos = (row % RB) - CTX;
                bf16_t* rowp = P + (size_t)row * NP;
#pragma unroll
                for (int bj = 0; bj < 2; ++bj) {
                    const int col0 = colb + bj * 128;
                    f32x4 v0 = acc[ai][bj][m][0], v1 = acc[ai][bj][m][1];
                    if (mode == 1) { const int p0 = (col0 & 63) >> 1; const f32x4 cs = *(const f32x4*)(cosH + (size_t)pos * 32 + p0), sn = *(const f32x4*)(sinH + (size_t)pos * 32 + p0); rope8(v0, v1, cs, sn); }
                    else if (mode == 2 && col0 >= C_KR && col0 < C_KR + 32) { const int p0 = (col0 - C_KR) >> 1; const f32x4 cs = *(const f32x4*)(cosM + (size_t)pos * 16 + p0), sn = *(const f32x4*)(sinM + (size_t)pos * 16 + p0); rope8(v0, v1, cs, sn); }
                    v0 = v0 * sc; v1 = v1 * sc;
                    *(u32x4*)(rowp + col0) = pack8(v0, v1);
                }
            }
    }
};
struct EpiQ {
    static constexpr bool PERM = true, AFTER_DRAIN = false;
    unsigned char* ws;
    DI void operator()(const f32x4 (&acc)[2][2][4][2], const pg8::Unit& u, int wr, int wc, int fr, int fq) const {
        bf16_t* QM = (bf16_t*)(ws + WS_QM); const float* cosM = (const float*)(ws + WS_COSM); const float* sinM = (const float*)(ws + WS_SINM);
        const bool ctxt = (u.pm % 33) == 0;
        const int rowt = u.pm * 256 + wr * 64 + fr, colb = u.pn * 256 + wc * 32 + 8 * fq;
#pragma unroll
        for (int ai = 0; ai < 2; ++ai)
#pragma unroll
            for (int m = 0; m < 4; ++m) {
                const int row = rowt + ai * 128 + m * 16; const int pos = (row % RB) - CTX;
#pragma unroll
                for (int bj = 0; bj < 2; ++bj) {
                    const int col0 = colb + bj * 128, within = col0 % 96;
                    f32x4 v0 = acc[ai][bj][m][0], v1 = acc[ai][bj][m][1];
                    if (!ctxt && within >= 64) { const int p0 = (within - 64) >> 1; const f32x4 cs = *(const f32x4*)(cosM + (size_t)pos * 16 + p0), sn = *(const f32x4*)(sinM + (size_t)pos * 16 + p0); rope8(v0, v1, cs, sn); }
                    v0 = v0 * QS96; v1 = v1 * QS96;
                    *(u32x4*)(QM + (size_t)row * 768 + col0) = pack8(v0, v1);
                }
                asm volatile("" ::: "memory");
            }
    }
};
struct EpiKV {
    static constexpr bool PERM = true, AFTER_DRAIN = false;
    unsigned char* ws;
    DI void operator()(const f32x4 (&acc)[2][2][4][2], const pg8::Unit& u, int wr, int wc, int fr, int fq) const {
        bf16_t* KM = (bf16_t*)(ws + WS_KM); bf16_t* VM = (bf16_t*)(ws + WS_VM);
        const int rowt = u.pm * 256 + wr * 64 + fr, colb = u.pn * 256 + wc * 32 + 8 * fq;
#pragma unroll
        for (int ai = 0; ai < 2; ++ai)
#pragma unroll
            for (int m = 0; m < 4; ++m) {
                const int row = rowt + ai * 128 + m * 16;
#pragma unroll
                for (int bj = 0; bj < 2; ++bj) {
                    const int col0 = colb + bj * 128;
                    bf16_t* dst = (col0 < 512) ? KM + (size_t)row * 768 + (col0 >> 6) * 96 + (col0 & 63) : VM + (size_t)row * 1024 + (col0 - 512);
                    *(u32x4*)dst = pack8(acc[ai][bj][m][0], acc[ai][bj][m][1]);
                }
                asm volatile("" ::: "memory");
            }
    }
};
template <bool DRYE> struct EpiBrT {
    static constexpr bool PERM = true, AFTER_DRAIN = false;
    unsigned char* ws;
    DI void operator()(const f32x4 (&acc)[2][2][4][2], const pg8::Unit& u, int wr, int wc, int fr, int fq) const {
        bf16_t* P = (bf16_t*)(ws + WS_P);
        unsigned chk = 0u;
        const int rowt = u.pm * 256 + wr * 64 + fr, colb = u.pn * 256 + wc * 32 + 8 * fq;
#pragma unroll
        for (int ai = 0; ai < 2; ++ai)
#pragma unroll
            for (int m = 0; m < 4; ++m) {
                const int row = rowt + ai * 128 + m * 16;
#pragma unroll
                for (int bj = 0; bj < 2; ++bj) {
                    bf16_t* p = P + (size_t)row * NP + C_GM + colb + bj * 128;
                    const u32x4 g = *(const u32x4*)p;
                    f32x4 v0 = acc[ai][bj][m][0], v1 = acc[ai][bj][m][1];
                    v0[0] *= sigm_f(bflo(g.x)); v0[1] *= sigm_f(bfhi(g.x)); v0[2] *= sigm_f(bflo(g.y)); v0[3] *= sigm_f(bfhi(g.y));
                    v1[0] *= sigm_f(bflo(g.z)); v1[1] *= sigm_f(bfhi(g.z)); v1[2] *= sigm_f(bflo(g.w)); v1[3] *= sigm_f(bfhi(g.w));
                    { const u32x4 w_ = pack8(v0, v1); if (!DRYE) *(u32x4*)p = w_; else chk ^= w_.x ^ w_.y ^ w_.z ^ w_.w; }
                }
            }
        if (DRYE && chk == 0x12345678u) *(unsigned*)P = chk;
    }
};
template <bool DRYE> struct EpiOutT {
    static constexpr bool PERM = true, AFTER_DRAIN = false;
    int l, g; const float* xsrc; float* xdst; const float* ctxsrc; unsigned char* ws;
    DI void operator()(const f32x4 (&acc)[2][2][4][2], const pg8::Unit& u, int wr, int wc, int fr, int fq) const {
        float* ctxdst = (float*)(ws + WS_CTX); const float* mod = (const float*)(ws + WS_MOD) + (size_t)l * 9 * 3072;
        const int pmb = u.pm % 33, b = g * GB + u.pm / 33; const bool ctxt = pmb == 0;
        if (ctxt && l != 0) return;
        const float* gate = mod + (size_t)(ctxt ? 8 : b) * 3072 + 2048;
        const int colb = u.pn * 256 + wc * 32 + 8 * fq;
#pragma unroll
        for (int ai = 0; ai < 2; ++ai)
#pragma unroll
            for (int m = 0; m < 4; ++m) {
                const int j = pmb * 256 + ai * 128 + wr * 64 + m * 16 + fr;
                const size_t idx = ctxt ? ((size_t)b * CTX + j) * DM : ((size_t)b * SEQ + (j - CTX)) * DM;
                const float* s = (ctxt ? ctxsrc : xsrc) + idx; float* d = (ctxt ? ctxdst : xdst) + idx;
#pragma unroll
                for (int bj = 0; bj < 2; ++bj) {
                    const int col0 = colb + bj * 128;
                    const f32x4 g0 = *(const f32x4*)(gate + col0), g1 = *(const f32x4*)(gate + col0 + 4);
                    const f32x4 x0 = *(const f32x4*)(s + col0), x1 = *(const f32x4*)(s + col0 + 4);
                    if (!DRYE || x0[0] == 12345.678f) { *(f32x4*)(d + col0) = x0 + g0 * acc[ai][bj][m][0];
                    *(f32x4*)(d + col0 + 4) = x1 + g1 * acc[ai][bj][m][1]; }
                }
            }
    }
};

#define MFMA32(a, b, c) __builtin_amdgcn_mfma_f32_32x32x16_bf16((a), (b), (c), 0, 0, 0)
DI s16x4 tr16(const LAS unsigned char* p) { typedef short v4i16_t __attribute__((ext_vector_type(4))); return __builtin_bit_cast(s16x4, __builtin_amdgcn_ds_read_tr16_b64_v4i16((LAS v4i16_t*)p)); }
constexpr int AT_KOFF = 0, AT_KBUFMAX = 13312, AT_VOFF = 3 * AT_KBUFMAX, AT_VBUFMAX = 20480, AT_SOFF = AT_VOFF + 3 * AT_VBUFMAX, AT_QOFF = AT_SOFF + 1024;
static_assert(AT_QOFF + 8 * 6144 <= LDS_BYTES, "attention LDS map");
#ifndef AT_NOPF
#define AT_NOPF 1
#endif
#ifndef AT_IGLP
#define AT_IGLP -1
#endif
#ifndef AT_QLMIN
#define AT_QLMIN 64
#endif
#ifndef AT_PVKS
#define AT_PVKS 1
#endif
#ifndef AT_SGB
#define AT_SGB 0
#endif
#ifndef AT_PV8
#define AT_PV8 1
#endif
#ifndef AT_NOSBAR
#define AT_NOSBAR 1
#endif
#if AT_NOSBAR
#define SBAR() do {} while (0)
#else
#define SBAR() __builtin_amdgcn_sched_barrier(0)
#endif
#ifndef PROBE_MODE
#define PROBE_MODE 0
#endif
#ifndef DRY_SEL
#define DRY_SEL 7
#endif
#ifndef AT_QL
#define AT_QL 1
#endif
#ifndef AT_SB
#define AT_SB 0
#endif
template <int DQK, bool QL>
DI void at_qkt(f32x16& p0, f32x16& p1, const LAS unsigned char* kb, const bf16x8* qf, const LAS unsigned char* qb) {
    constexpr int KSTR = DQK + 8;
#pragma unroll
    for (int r = 0; r < 16; ++r) { p0[r] = 0.f; p1[r] = 0.f; }
#pragma unroll
    for (int ds = 0; ds < DQK / 16; ++ds) {
        const bf16x8 k0 = *(const LAS bf16x8*)(kb + ds * 32), k1 = *(const LAS bf16x8*)(kb + 32 * (KSTR * 2) + ds * 32);
        bf16x8 q; if (QL) q = *(const LAS bf16x8*)(qb + ds * 1024); else q = qf[ds];
        p0 = MFMA32(k0, q, p0); p1 = MFMA32(k1, q, p1);
        if (AT_SB && DQK > 64 && (ds & 1)) __builtin_amdgcn_sched_barrier(0x7f); }
}
DI void at_mask(f32x16& p0, f32x16& p1, int dk) {
#pragma unroll
    for (int r = 0; r < 16; ++r) { const int d = dk + (r & 3) + 8 * (r >> 2);
        if (d > 128 || d < -128) p0[r] = NEGBIG;
        if (d + 32 > 128 || d + 32 < -128) p1[r] = NEGBIG; }
}
DI void at_psm(f32x16& p0, f32x16& p1, float& mrun, float& alpha) {
    float ma = fmaxf(fmaxf(p0[0], p0[1]), p0[2]), mb = fmaxf(fmaxf(p1[0], p1[1]), p1[2]);
    ma = fmaxf(fmaxf(ma, p0[3]), p1[3]);
#pragma unroll
    for (int r = 4; r < 16; r += 2) { ma = fmaxf(fmaxf(ma, p0[r]), p0[r + 1]); mb = fmaxf(fmaxf(mb, p1[r]), p1[r + 1]); }
    float mx = fmaxf(ma, mb);
    { auto rr = __builtin_amdgcn_permlane32_swap(__float_as_uint(mx), __float_as_uint(mx), false, false); mx = fmaxf(__uint_as_float(rr[0]), __uint_as_float(rr[1])); }
    const bool keep = __all(mx - mrun <= THR);
    const float mn = keep ? mrun : fmaxf(mrun, mx); alpha = __builtin_amdgcn_exp2f(mrun - mn); mrun = mn;
#pragma unroll
    for (int r = 0; r < 16; ++r) { p0[r] -= mrun; p1[r] -= mrun; }
#pragma unroll
    for (int r = 0; r < 16; ++r) p0[r] = __builtin_amdgcn_exp2f(p0[r]);
}
DI void at_fsm(f32x16& p0, f32x16& p1, float alpha, float& lrun, bf16x8* pa) {
#pragma unroll
    for (int r = 0; r < 16; ++r) p1[r] = __builtin_amdgcn_exp2f(p1[r]);
    float ps = 0.f;
#pragma unroll
    for (int r = 0; r < 16; ++r) ps += p0[r] + p1[r];
    lrun = lrun * alpha + ps;
    u32x4 w;
    w.x = pk2(p0[0], p0[1]); w.y = pk2(p0[2], p0[3]); w.z = pk2(p0[4], p0[5]); w.w = pk2(p0[6], p0[7]); pa[0] = __builtin_bit_cast(bf16x8, w);
    w.x = pk2(p0[8], p0[9]); w.y = pk2(p0[10], p0[11]); w.z = pk2(p0[12], p0[13]); w.w = pk2(p0[14], p0[15]); pa[1] = __builtin_bit_cast(bf16x8, w);
    w.x = pk2(p1[0], p1[1]); w.y = pk2(p1[2], p1[3]); w.z = pk2(p1[4], p1[5]); w.w = pk2(p1[6], p1[7]); pa[2] = __builtin_bit_cast(bf16x8, w);
    w.x = pk2(p1[8], p1[9]); w.y = pk2(p1[10], p1[11]); w.z = pk2(p1[12], p1[13]); w.w = pk2(p1[14], p1[15]); pa[3] = __builtin_bit_cast(bf16x8, w);
}
DI void at_fsm_fake(f32x16& p0, f32x16& p1, bf16x8* pa) {
    u32x4 w;
    w.x = pk2(p0[0], p0[1]); w.y = pk2(p0[2], p0[3]); w.z = pk2(p0[4], p0[5]); w.w = pk2(p0[6], p0[7]); pa[0] = __builtin_bit_cast(bf16x8, w);
    w.x = pk2(p0[8], p0[9]); w.y = pk2(p0[10], p0[11]); w.z = pk2(p0[12], p0[13]); w.w = pk2(p0[14], p0[15]); pa[1] = __builtin_bit_cast(bf16x8, w);
    w.x = pk2(p1[0], p1[1]); w.y = pk2(p1[2], p1[3]); w.z = pk2(p1[4], p1[5]); w.w = pk2(p1[6], p1[7]); pa[2] = __builtin_bit_cast(bf16x8, w);
    w.x = pk2(p1[8], p1[9]); w.y = pk2(p1[10], p1[11]); w.z = pk2(p1[12], p1[13]); w.w = pk2(p1[14], p1[15]); pa[3] = __builtin_bit_cast(bf16x8, w);
}
template <int DV>
DI void at_pv(f32x16* o, const LAS unsigned char* vb, const bf16x8* pa) {
    constexpr int VSTR = DV + 32;
#if AT_PVKS
#pragma unroll
    for (int ks = 0; ks < 4; ++ks) {
        s16x4 vlo[DV / 32], vhi[DV / 32];
#pragma unroll
        for (int db = 0; db < DV / 32; ++db) { vlo[db] = tr16(vb + (16 * ks) * (VSTR * 2) + db * 64); vhi[db] = tr16(vb + (16 * ks + 8) * (VSTR * 2) + db * 64); }
#pragma unroll
        for (int db = 0; db < DV / 32; ++db) { const bf16x8 vf = __builtin_shufflevector(vlo[db], vhi[db], 0, 1, 2, 3, 4, 5, 6, 7); o[db] = MFMA32(pa[ks], vf, o[db]); }
    }
#else
#pragma unroll
    for (int db = 0; db < DV / 32; ++db) {
        s16x4 vlo[4], vhi[4];
#pragma unroll
        for (int ks = 0; ks < 4; ++ks) { vlo[ks] = tr16(vb + (16 * ks) * (VSTR * 2) + db * 64); vhi[ks] = tr16(vb + (16 * ks + 8) * (VSTR * 2) + db * 64); }
#pragma unroll
        for (int ks = 0; ks < 4; ++ks) { const bf16x8 vf = __builtin_shufflevector(vlo[ks], vhi[ks], 0, 1, 2, 3, 4, 5, 6, 7); o[db] = MFMA32(pa[ks], vf, o[db]); }
    }
#endif
}
template <int DV>
DI void at_scale_o(f32x16* o, LAS float* scw, float val, int r32, int hi) {
    if (hi == 0) scw[r32] = val;
    __builtin_amdgcn_wave_barrier(); asm volatile("" ::: "memory");
#pragma unroll
    for (int g4 = 0; g4 < 4; ++g4) { const f32x4 a4 = *(const LAS f32x4*)(scw + 8 * g4 + 4 * hi);
#pragma unroll
        for (int db = 0; db < DV / 32; ++db) { o[db][4 * g4 + 0] *= a4[0]; o[db][4 * g4 + 1] *= a4[1]; o[db][4 * g4 + 2] *= a4[2]; o[db][4 * g4 + 3] *= a4[3]; } }
    __builtin_amdgcn_wave_barrier(); asm volatile("" ::: "memory");
}
template <int DQK, int DV, int OUTM, bool MASKED>
DI void attn_unit(LAS unsigned char* lds, const bf16_t* Qp, int ldq, const bf16_t* Kp, int ldk, const bf16_t* Vp, int ldv,
                  int nA, int rowB0, int nB, int posB0, int qpos0, float m0, float l0,
                  bf16_t* Og, int ldo, float* Of, int ldof) {
    constexpr int KSTR = DQK + 8, VSTR = DV + 32, KBUF = 64 * KSTR * 2, VBUF = 64 * VSTR * 2;
    constexpr int KCH = DQK / 8, VCH = DV / 8, NKC = 64 * KCH, NVC = 64 * VCH, KRN = (NKC + 511) / 512, VRN = (NVC + 511) / 512;
    static_assert(KBUF <= AT_KBUFMAX && VBUF <= AT_VBUFMAX, "attention LDS map");
    const int tid = tid_l(), lane = tid & 63, wid = __builtin_amdgcn_readfirstlane(tid >> 6), r32 = lane & 31, hi = lane >> 5;
#ifndef AT_QL
#define AT_QL 1
#endif
#ifndef AT_SB
#define AT_SB 0
#endif
    constexpr bool QL = AT_QL && (DQK > AT_QLMIN);
    bf16x8 qf[QL ? 1 : DQK / 16];
    const LAS unsigned char* qb = lds + AT_QOFF + wid * 6144 + lane * 16;
    { const bf16_t* qrow = Qp + (size_t)(32 * wid + r32) * ldq + 8 * hi;
#pragma unroll
      for (int ds = 0; ds < DQK / 16; ++ds) { const bf16x8 v = *(const bf16x8*)(qrow + 16 * ds); if (QL) *(LAS bf16x8*)(lds + AT_QOFF + wid * 6144 + lane * 16 + ds * 1024) = v; else qf[QL ? 0 : ds] = v; }
      if (QL) { __builtin_amdgcn_wave_barrier(); asm volatile("s_waitcnt lgkmcnt(0)" ::: "memory"); } }
    f32x16 o[DV / 32];
#pragma unroll
    for (int db = 0; db < DV / 32; ++db)
#pragma unroll
        for (int r = 0; r < 16; ++r) o[db][r] = 0.f;
    float mrun = m0, lrun = (hi == 0) ? l0 : 0.f;
    LAS float* scw = (LAS float*)(lds + AT_SOFF) + wid * 32;
    const int NT = nA + nB;
    const LAS unsigned char* kb0 = lds + AT_KOFF + r32 * (KSTR * 2) + hi * 16;
    const LAS unsigned char* vb0 = lds + AT_VOFF + (4 * hi + ((lane & 15) >> 2)) * (VSTR * 2) + (16 * ((lane >> 4) & 1) + 4 * (lane & 3)) * 2;
    const int dk0 = posB0 + 4 * hi - (qpos0 + 32 * wid + r32) - 64 * nA;
    u32x4 kreg[KRN], vreg[VRN];
    int kgo[KRN], klo[KRN], vgo[VRN], vlo_[VRN];
#pragma unroll
    for (int i_ = 0; i_ < KRN; ++i_) { int c_ = tid + 512 * i_; if (c_ >= NKC) c_ -= 512; const int r_ = c_ / KCH, cc_ = c_ % KCH; kgo[i_] = r_ * ldk + cc_ * 8; klo[i_] = AT_KOFF + r_ * (KSTR * 2) + cc_ * 16; }
#pragma unroll
    for (int i_ = 0; i_ < VRN; ++i_) { int c_ = tid + 512 * i_; if (c_ >= NVC) c_ -= 512; const int r_ = c_ / VCH, cc_ = c_ % VCH; vgo[i_] = r_ * ldv + cc_ * 8; vlo_[i_] = AT_VOFF + r_ * (VSTR * 2) + cc_ * 16; }
#define AT_GLOAD(t) do { const int row0_ = (t) < nA ? 64 * (t) : rowB0 + 64 * ((t) - nA); const bf16_t* kt_ = Kp + (size_t)row0_ * ldk; const bf16_t* vt_ = Vp + (size_t)row0_ * ldv; \
        _Pragma("unroll") for (int i_ = 0; i_ < KRN; ++i_) kreg[i_] = *(const u32x4*)(kt_ + kgo[i_]); \
        _Pragma("unroll") for (int i_ = 0; i_ < VRN; ++i_) vreg[i_] = *(const u32x4*)(vt_ + vgo[i_]); } while (0)
#define AT_SWRITE(buf) do { \
        _Pragma("unroll") for (int i_ = 0; i_ < KRN; ++i_) *(LAS u32x4*)(lds + (buf) * KBUF + klo[i_]) = kreg[i_]; \
        _Pragma("unroll") for (int i_ = 0; i_ < VRN; ++i_) *(LAS u32x4*)(lds + (buf) * VBUF + vlo_[i_]) = vreg[i_]; } while (0)
    unsigned pfv = 0u, pfacc = 0u;
    const int pft = tid & 255;
    const bf16_t* pfb = (pft < 128) ? Kp + (pft >> 1) * ldk + (pft & 1) * (DQK - 2) : Vp + ((pft - 128) >> 1) * ldv + (pft & 1) * (DV - 2);
    const int pfs = (pft < 128) ? ldk : ldv;
    constexpr int PFD = 4;
#if AT_NOPF
#define AT_PF(t) do {} while (0)
#else
#define AT_PF(t) do { pfacc ^= pfv; const int tt_ = (t) < NT ? (t) : NT - 1; const int row0_ = tt_ < nA ? 64 * tt_ : rowB0 + 64 * (tt_ - nA); \
        pfv = *(const unsigned*)(pfb + (size_t)row0_ * pfs); } while (0)
#endif
#define AT_MASK(P0, P1, t) do { if (MASKED && (t) >= nA) at_mask(P0, P1, dk0 + 64 * (t)); } while (0)
#define AT_RESC(al) do { if (__any((al) < 1.f)) at_scale_o<DV>(o, scw, (al), r32, hi); } while (0)
    constexpr int DRYP = (OUTM == 2) ? PROBE_MODE : 0;
    f32x16 pA0, pA1, pB0, pB1; float alA, alB; bf16x8 pa[4];
    AT_PF(1); AT_PF(2); AT_PF(3);
    AT_GLOAD(0); AT_SWRITE(0); __syncthreads();
    AT_GLOAD(1);
    at_qkt<DQK, QL>(pA0, pA1, kb0, qf, qb); AT_MASK(pA0, pA1, 0); at_psm(pA0, pA1, mrun, alA);
    AT_SWRITE(1); __syncthreads();
    int bp = 0, bc = 1, bn = 2;
    constexpr int NMF = 2 * (DQK / 16) + 4 * (DV / 32);
#if AT_IGLP >= 0
#define AT_SCHED() __builtin_amdgcn_iglp_opt(AT_IGLP)
#elif AT_SGB
#define AT_SCHED() do { _Pragma("unroll") for (int i_ = 0; i_ < NMF; ++i_) { __builtin_amdgcn_sched_group_barrier(0x008, 1, 0); __builtin_amdgcn_sched_group_barrier(0x100, 2, 0); __builtin_amdgcn_sched_group_barrier(0x002, AT_SGB, 0); } } while (0)
#else
#define AT_SCHED() do {} while (0)
#endif
#define AT_ROT() do { bp = bc; bc = bn; bn = (bn == 2) ? 0 : bn + 1; } while (0)
    for (int j = 1; j + 1 < ((DRYP == 6) ? 2 : NT); j += 2) {
        if (!(DRYP >= 1)) { AT_GLOAD(j + 1); AT_PF(j + PFD); }
        SBAR(); if (DRYP != 5) at_qkt<DQK, QL>(pB0, pB1, kb0 + bc * KBUF, qf, qb); else { _Pragma("unroll") for (int r_ = 0; r_ < 16; ++r_) { pB0[r_] = o[0][r_] * 1e-3f; pB1[r_] = o[1][r_] * 1e-3f; } } AT_MASK(pB0, pB1, j);
        if (DRYP != 3) at_fsm(pA0, pA1, alA, lrun, pa); else at_fsm_fake(pA0, pA1, pa); SBAR();
        if (DRYP != 4) at_pv<DV>(o, vb0 + bp * VBUF, pa); else { o[0][0] += __builtin_bit_cast(float, (int)pa[0][0] + (int)pa[1][1] + (int)pa[2][2] + (int)pa[3][3]); } if (DRYP != 3) at_psm(pB0, pB1, mrun, alB); else alB = 1.f;
        AT_SCHED();
        if (!(DRYP >= 1)) AT_SWRITE(bn);
        AT_RESC(alB); if (DRYP != 2) __syncthreads(); AT_ROT();
        if (!(DRYP >= 1)) { AT_GLOAD(j + 2); AT_PF(j + 1 + PFD); }
        SBAR(); if (DRYP != 5) at_qkt<DQK, QL>(pA0, pA1, kb0 + bc * KBUF, qf, qb); else { _Pragma("unroll") for (int r_ = 0; r_ < 16; ++r_) { pA0[r_] = o[0][r_] * 1e-3f; pA1[r_] = o[1][r_] * 1e-3f; } } AT_MASK(pA0, pA1, j + 1);
        if (DRYP != 3) at_fsm(pB0, pB1, alB, lrun, pa); else at_fsm_fake(pB0, pB1, pa); SBAR();
        if (DRYP != 4) at_pv<DV>(o, vb0 + bp * VBUF, pa); else { o[0][0] += __builtin_bit_cast(float, (int)pa[0][0] + (int)pa[1][1] + (int)pa[2][2] + (int)pa[3][3]); } if (DRYP != 3) at_psm(pA0, pA1, mrun, alA); else alA = 1.f;
        AT_SCHED();
        if (!(DRYP >= 1)) AT_SWRITE(bn);
        AT_RESC(alA); if (DRYP != 2) __syncthreads(); AT_ROT();
    }
    SBAR(); at_qkt<DQK, QL>(pB0, pB1, kb0 + bc * KBUF, qf, qb); AT_MASK(pB0, pB1, NT - 1);
    at_fsm(pA0, pA1, alA, lrun, pa); SBAR();
    at_pv<DV>(o, vb0 + bp * VBUF, pa); at_psm(pB0, pB1, mrun, alB);
    AT_RESC(alB);
    at_fsm(pB0, pB1, alB, lrun, pa); SBAR();
    at_pv<DV>(o, vb0 + bc * VBUF, pa);
#undef AT_ROT
#undef AT_SCHED
    pfacc ^= pfv;
    if (__builtin_expect(pfacc == 0x9e3779b9u && lrun == 12345.678f, 0)) scw[0] = 1.f;
#undef AT_GLOAD
#undef AT_PF
#undef AT_SWRITE
#undef AT_MASK
#undef AT_RESC
    { const float lt = lrun + __shfl_xor(lrun, 32); at_scale_o<DV>(o, scw, 1.0f / lt, r32, hi); }
    if (OUTM == 0) {
#pragma unroll
        for (int db = 0; db < DV / 32; ++db) {
            bf16_t* pb = Og + (size_t)(32 * wid + 4 * hi) * ldo + 32 * db + r32;
            bf16_t zz[16];
#pragma unroll
            for (int r = 0; r < 16; ++r) zz[r] = pb[(size_t)((r & 3) + 8 * (r >> 2)) * ldo];
#pragma unroll
            for (int r = 0; r < 16; ++r) { const float z = __uint_as_float((unsigned)zz[r] << 16); pb[(size_t)((r & 3) + 8 * (r >> 2)) * ldo] = (bf16_t)(pk2(o[db][r] * silu_f(z), 0.f) & 0xffffu); }
        }
    } else {
#pragma unroll
        for (int db = 0; db < DV / 32; ++db)
#pragma unroll
            for (int r = 0; r < 16; ++r) {
                const int q = (r & 3) + 8 * (r >> 2) + 4 * hi;
                if (OUTM == 1) { Of[(size_t)(32 * wid + q) * ldof + 32 * db + r32] = o[db][r]; }
                else { if (lrun == 12345.678f) Of[(size_t)(32 * wid + q) * ldof + 32 * db + r32] = o[db][r]; }
            }
    }
    __syncthreads();
}

struct Args { const float* in[21]; float* out; unsigned char* ws; };
typedef const __attribute__((address_space(4))) Args* ArgsP;
DI ArgsP args_ptr() { ArgsP p = (ArgsP)__builtin_amdgcn_kernarg_segment_ptr(); asm volatile("" : "+s"(p)); return p; }
enum { I_X = 0, I_C, I_CTX, I_CCTX, I_WMOD, I_BMOD, I_NORMG, I_WIN, I_QNORM, I_WUQ, I_KVNORM, I_WUKV, I_LQ1, I_LK1, I_LQ2, I_LK2, I_SUBLN, I_SINK, I_WBR, I_WOUT, I_FNORM };

DI int colmap(int kind, int n) {
    if (kind == 1) {
        if (n < C_KR) return n;
        if (n < C_KR + 32) { const int e = n - C_KR; return C_KR + (e >> 1) + 16 * (e & 1); }
        if (n < C_DQ) return -1;
        if ((n >= C_DQ && n < C_DV) || (n >= C_SQ && n < C_SV)) { const int w = n & 63; return (n - w) - 96 + (w >> 1) + 32 * (w & 1); }
        return n - 96;
    }
    if (kind == 2) { const int h = n / 96, e = n % 96; if (e < 64) return n; const int e2 = e - 64; return h * 96 + 64 + (e2 >> 1) + 16 * (e2 & 1); }
    if (kind == 3) { if (n < 512) return (n >> 6) * 192 + (n & 63); const int n2 = n - 512; return (n2 >> 7) * 192 + 64 + (n2 & 127); }
    return n;
}
DI void transpose_item(const float* W, int ldw, int kind, const float* rowscale, bf16_t* WT, int ldd, int koff, LAS float* scr, int item, int nblk, int lane) {
    const int kb = item / nblk, nb = item % nblk, k0 = 64 * kb, n0 = 32 * nb;
    const int oc = colmap(kind, n0 + (lane & 31));
#pragma unroll 8
    for (int i = 0; i < 32; ++i) { const int kk = 2 * i + (lane >> 5); float v = 0.f; if (oc >= 0) v = W[(size_t)(k0 + kk) * ldw + oc]; if (rowscale) v *= rowscale[k0 + kk]; scr[kk * 33 + (lane & 31)] = v; }
    __builtin_amdgcn_wave_barrier(); asm volatile("s_waitcnt lgkmcnt(0)" ::: "memory");
    const int c = lane & 7;
#pragma unroll
    for (int j = 0; j < 4; ++j) { const int n = (lane >> 3) + 8 * j; const LAS float* s = scr + (8 * c) * 33 + n;
        u32x4 o; o.x = pk2(s[0 * 33], s[1 * 33]); o.y = pk2(s[2 * 33], s[3 * 33]); o.z = pk2(s[4 * 33], s[5 * 33]); o.w = pk2(s[6 * 33], s[7 * 33]);
        *(u32x4*)(WT + (size_t)(n0 + n) * ldd + koff + k0 + 8 * c) = o; }
    __builtin_amdgcn_wave_barrier(); asm volatile("s_waitcnt lgkmcnt(0)" ::: "memory");
}
DI void prologue(ArgsP ap, LAS unsigned char* lds) {
    const int tid = tid_l(), lane = tid & 63, wid = __builtin_amdgcn_readfirstlane(tid >> 6);
    unsigned char* ws = ap->ws;
    LAS float* scr = (LAS float*)(lds + wid * 8448);
    const int gw = bid_l() * 8 + wid, NGW = grd_l() * 8;
    constexpr int I_IN = 16 * (NP / 32), I_UQ = 6 * 24, I_UKV = 4 * 48, I_SQ = 16 * 32, PER_L = I_IN + I_UQ + I_UKV + 6 * I_SQ;
    for (int it = gw; it < 2 * PER_L; it += NGW) {
        const int l = it / PER_L; int r = it % PER_L;
        if (r < I_IN) { transpose_item(ap->in[I_WIN] + (size_t)l * 1024 * D_IN, D_IN, 1, nullptr, (bf16_t*)(ws + WS_WIN) + (size_t)l * NP * 1024, 1024, 0, scr, r, NP / 32, lane); continue; } r -= I_IN;
        if (r < I_UQ) { transpose_item(ap->in[I_WUQ] + (size_t)l * 384 * 768, 768, 2, ap->in[I_QNORM] + l * 384, (bf16_t*)(ws + WS_WUQ) + (size_t)l * 768 * 384, 384, 0, scr, r, 24, lane); continue; } r -= I_UQ;
        if (r < I_UKV) { transpose_item(ap->in[I_WUKV] + (size_t)l * 256 * 1536, 1536, 3, ap->in[I_KVNORM] + l * 256, (bf16_t*)(ws + WS_WUKV) + (size_t)l * 1536 * 256, 256, 0, scr, r, 48, lane); continue; } r -= I_UKV;
        if (r < 3 * I_SQ) { const int br = r / I_SQ; transpose_item(ap->in[I_WBR] + ((size_t)l * 3 + br) * 1024 * 1024, 1024, 0, nullptr, (bf16_t*)(ws + WS_WB) + ((size_t)l * 3 + br) * 1024 * 1024, 1024, 0, scr, r % I_SQ, 32, lane); continue; } r -= 3 * I_SQ;
        { const int rep = r / I_SQ; transpose_item(ap->in[I_WOUT] + (size_t)l * 1024 * 1024, 1024, 0, nullptr, (bf16_t*)(ws + WS_WO3) + (size_t)l * 1024 * 3072, 3072, rep * 1024, scr, r % I_SQ, 32, lane); }
    }
    const int gt = bid_l() * 512 + tid, NGT = grd_l() * 512;
    for (int i = gt; i < SEQ * 48; i += NGT) {
        const int pos = i / 48, p = i % 48; const float frow = (float)(pos >> 6), fcol = (float)(pos & 63);
        float ang; float* cd; float* sd;
        if (p < 32) { const int f = p & 15; const float inv = powf(10000.0f, -(float)f / 16.0f); ang = (p < 16 ? frow : fcol) * inv; cd = (float*)(ws + WS_COSH) + pos * 32 + p; sd = (float*)(ws + WS_SINH) + pos * 32 + p; }
        else { const int pp = p - 32, f = pp & 7; const float inv = powf(10000.0f, -(float)f / 8.0f); ang = (pp < 8 ? frow : fcol) * inv; cd = (float*)(ws + WS_COSM) + pos * 16 + pp; sd = (float*)(ws + WS_SINM) + pos * 16 + pp; }
        *cd = __cosf(ang); *sd = __sinf(ang);
    }
    for (int it = gw; it < 2 * 16 * 48; it += NGW) {
        const int l = it / 768, rem = it % 768, kc = rem / 48, nb = rem % 48; const int k = kc * 64 + lane;
        float sv[9];
#pragma unroll
        for (int v = 0; v < 8; ++v) sv[v] = silu_f(ap->in[I_C][v * 1024 + k]);
        sv[8] = silu_f(ap->in[I_CCTX][k]);
        float acc[9];
#pragma unroll
        for (int v = 0; v < 9; ++v) acc[v] = 0.f;
        const float* w = ap->in[I_WMOD] + ((size_t)l * 1024 + kc * 64) * 3072 + nb * 64 + lane;
#pragma unroll 8
        for (int kk = 0; kk < 64; ++kk) { const float wv = w[(size_t)kk * 3072];
#pragma unroll
            for (int v = 0; v < 9; ++v) acc[v] += __uint_as_float(__builtin_amdgcn_readlane(__float_as_uint(sv[v]), kk)) * wv; }
        float* mp = (float*)(ws + WS_MODP) + ((size_t)(l * 16 + kc) * 9) * 3072 + nb * 64 + lane;
#pragma unroll
        for (int v = 0; v < 9; ++v) mp[(size_t)v * 3072] = acc[v];
    }
}
DI void mod_finalize(ArgsP ap) {
    const int tid = tid_l();
    const int gt = bid_l() * 512 + tid, NGT = grd_l() * 512;
    const float* mp = (const float*)(ap->ws + WS_MODP); float* mod = (float*)(ap->ws + WS_MOD);
    for (int i = gt; i < 2 * 9 * 3072; i += NGT) {
        const int l = i / (9 * 3072), rem = i % (9 * 3072), n = rem % 3072;
        float s = ap->in[I_BMOD][l * 3072 + n];
#pragma unroll
        for (int kc = 0; kc < 16; ++kc) s += mp[(size_t)(l * 16 + kc) * 9 * 3072 + rem];
        mod[i] = s;
    }
}
DI void ph_norm_mod(ArgsP ap, int l, int g) {
    const int tid = tid_l(), lane = tid & 63, wid = __builtin_amdgcn_readfirstlane(tid >> 6);
    const int gw = bid_l() * 8 + wid, NGW = grd_l() * 8;
    const float* ng = ap->in[I_NORMG] + l * 1024; const float* mod = (const float*)(ap->ws + WS_MOD) + (size_t)l * 9 * 3072;
    const float* xs = (l == 0) ? ap->in[I_X] : ap->out; const float* cs = (l == 0) ? ap->in[I_CTX] : (const float*)(ap->ws + WS_CTX);
    bf16_t* H = (bf16_t*)(ap->ws + WS_H);
    for (int r = gw; r < R; r += NGW) {
        const int bl = r / RB, j = r % RB, b = g * GB + bl;
        const float* src; const float* md;
        if (j < CTX) { src = cs + ((size_t)b * CTX + j) * DM; md = mod + 8 * 3072; } else { src = xs + ((size_t)b * SEQ + (j - CTX)) * DM; md = mod + (size_t)b * 3072; }
        f32x4 v[4]; float ss = 0.f;
#pragma unroll
        for (int q = 0; q < 4; ++q) { v[q] = *(const f32x4*)(src + 4 * (lane + 64 * q)); ss += (v[q][0] * v[q][0] + v[q][1] * v[q][1]) + (v[q][2] * v[q][2] + v[q][3] * v[q][3]); }
        const float rstd = 1.0f / sqrtf(wave_sum(ss) * (1.0f / DM) + EPS);
#pragma unroll
        for (int q = 0; q < 4; ++q) { const int idx = 4 * (lane + 64 * q);
            const f32x4 gg = *(const f32x4*)(ng + idx), sh = *(const f32x4*)(md + idx), sc = *(const f32x4*)(md + 1024 + idx);
            const f32x4 y = (v[q] * rstd * gg) * (sc + 1.0f) + sh;
            u32x2 w; w.x = pk2(y[0], y[1]); w.y = pk2(y[2], y[3]); *(u32x2*)(H + (size_t)r * DM + idx) = w; }
    }
}
DI void ph_mla_norm(ArgsP ap) {
    const int tid = tid_l(), lane = tid & 63, wid = __builtin_amdgcn_readfirstlane(tid >> 6);
    const int gw = bid_l() * 8 + wid, NGW = grd_l() * 8;
    const bf16_t* P = (const bf16_t*)(ap->ws + WS_P); bf16_t* AQ = (bf16_t*)(ap->ws + WS_AQ); bf16_t* AKV = (bf16_t*)(ap->ws + WS_AKV); bf16_t* KM = (bf16_t*)(ap->ws + WS_KM);
    for (int r = gw; r < R; r += NGW) {
        const bf16_t* row = P + (size_t)r * NP;
        const u32x4 c0 = *(const u32x4*)(row + 8 * lane);
        u32x4 c1 = {0u, 0u, 0u, 0u}; if (lane < 20) c1 = *(const u32x4*)(row + 8 * (64 + lane));
        float f0[8] = {bflo(c0.x), bfhi(c0.x), bflo(c0.y), bfhi(c0.y), bflo(c0.z), bfhi(c0.z), bflo(c0.w), bfhi(c0.w)};
        float f1[8] = {bflo(c1.x), bfhi(c1.x), bflo(c1.y), bfhi(c1.y), bflo(c1.z), bfhi(c1.z), bflo(c1.w), bfhi(c1.w)};
        float s0 = 0.f, s1 = 0.f;
#pragma unroll
        for (int i = 0; i < 8; ++i) { s0 += f0[i] * f0[i]; s1 += f1[i] * f1[i]; }
        const float sq = wave_sum(lane < 48 ? s0 : 0.f);
        const float skv = wave_sum((lane >= 48 ? s0 : 0.f) + (lane < 16 ? s1 : 0.f));
        const float rq = 1.0f / sqrtf(sq * (1.0f / 384.0f) + EPS), rkv = 1.0f / sqrtf(skv * (1.0f / 256.0f) + EPS);
        { const float rr = lane < 48 ? rq : rkv; u32x4 w; w.x = pk2(f0[0] * rr, f0[1] * rr); w.y = pk2(f0[2] * rr, f0[3] * rr); w.z = pk2(f0[4] * rr, f0[5] * rr); w.w = pk2(f0[6] * rr, f0[7] * rr);
          if (lane < 48) *(u32x4*)(AQ + (size_t)r * 384 + 8 * lane) = w; else *(u32x4*)(AKV + (size_t)r * 256 + 8 * (lane - 48)) = w; }
        if (lane < 16) { u32x4 w; w.x = pk2(f1[0] * rkv, f1[1] * rkv); w.y = pk2(f1[2] * rkv, f1[3] * rkv); w.z = pk2(f1[4] * rkv, f1[5] * rkv); w.w = pk2(f1[6] * rkv, f1[7] * rkv);
            *(u32x4*)(AKV + (size_t)r * 256 + 8 * (16 + lane)) = w; }
        else if (lane < 20) {
#pragma unroll
            for (int h = 0; h < 8; ++h) *(u32x4*)(KM + (size_t)r * 768 + h * 96 + 64 + 8 * (lane - 16)) = c1; }
    }
}
template <bool DRYE>
DI void ph_diff_post(ArgsP ap, int l) {
    const int tid = tid_l(), lane = tid & 63, wid = __builtin_amdgcn_readfirstlane(tid >> 6);
    const int gw = bid_l() * 8 + wid, NGW = grd_l() * 8;
    const float lam_init = (l == 0) ? 0.2f : (0.8f - 0.6f * 0.7408182206817179f);
    const float d1 = wave_sum(ap->in[I_LQ1][l * 64 + lane] * ap->in[I_LK1][l * 64 + lane]), d2 = wave_sum(ap->in[I_LQ2][l * 64 + lane] * ap->in[I_LK2][l * 64 + lane]);
    const float lam = expf(d1) - expf(d2) + lam_init;
    const float sl0 = ap->in[I_SUBLN][l * 128 + 2 * lane] * (1.0f - lam_init), sl1 = ap->in[I_SUBLN][l * 128 + 2 * lane + 1] * (1.0f - lam_init);
    const float* OD = (const float*)(ap->ws + WS_OD); bf16_t* P = (bf16_t*)(ap->ws + WS_P);
    typedef float f32x2 __attribute__((ext_vector_type(2)));
    for (int r = gw; r < R; r += NGW) {
        if (l != 0 && (r % RB) < CTX) continue;
        const float* ob = OD + (size_t)r * 2048 + 2 * lane; unsigned* zb = (unsigned*)(P + (size_t)r * NP + C_Z + 1024 + 2 * lane);
        f32x2 o1[8], o2[8]; unsigned z[8];
#pragma unroll
        for (int h = 0; h < 8; ++h) { o1[h] = *(const f32x2*)(ob + (2 * h) * 128); o2[h] = *(const f32x2*)(ob + (2 * h + 1) * 128); z[h] = zb[h * 64]; }
#pragma unroll
        for (int h = 0; h < 8; ++h) {
            const float a0 = o1[h][0] - lam * o2[h][0], a1 = o1[h][1] - lam * o2[h][1];
            const float rstd = 1.0f / sqrtf(wave_sum(a0 * a0 + a1 * a1) * (1.0f / 128.0f) + EPS);
            if (!DRYE || rstd == 12345.678f) zb[h * 64] = pk2(a0 * rstd * sl0 * silu_f(bflo(z[h])), a1 * rstd * sl1 * silu_f(bfhi(z[h])));
        }
    }
}
template <bool DRYE>
DI void ph_final_norm(ArgsP ap) {
    const int tid = tid_l(), lane = tid & 63, wid = __builtin_amdgcn_readfirstlane(tid >> 6);
    const int gw = bid_l() * 8 + wid, NGW = grd_l() * 8; const float* fg = ap->in[I_FNORM];
    for (int r = gw; r < NBATCH * SEQ; r += NGW) {
        float* row = ap->out + (size_t)r * DM; f32x4 v[4]; float ss = 0.f;
#pragma unroll
        for (int q = 0; q < 4; ++q) { v[q] = *(const f32x4*)(row + 4 * (lane + 64 * q)); ss += (v[q][0] * v[q][0] + v[q][1] * v[q][1]) + (v[q][2] * v[q][2] + v[q][3] * v[q][3]); }
        const float rstd = 1.0f / sqrtf(wave_sum(ss) * (1.0f / DM) + EPS);
#pragma unroll
        for (int q = 0; q < 4; ++q) { const int idx = 4 * (lane + 64 * q); if (!DRYE || rstd == 12345.678f) *(f32x4*)(row + idx) = v[q] * rstd * *(const f32x4*)(fg + idx); }
    }
}
template <bool DRY>
DI void ph_attention(ArgsP ap, int l, LAS unsigned char* lds) {
    constexpr int OM0 = DRY ? 2 : 0;
    const int G = grd_l(), bx = bid_l(), vcu = (G % 8 == 0) ? (bx % 8) * (G / 8) + bx / 8 : bx;
    bf16_t* P = (bf16_t*)(ap->ws + WS_P); const bf16_t* QM = (const bf16_t*)(ap->ws + WS_QM); const bf16_t* KM = (const bf16_t*)(ap->ws + WS_KM); const bf16_t* VM = (const bf16_t*)(ap->ws + WS_VM);
    float* OD = (float*)(ap->ws + WS_OD); const float* sink = ap->in[I_SINK] + l * 16;
#if !defined(ATT_ONLY) || ATT_ONLY == 1
    if (!DRY || (DRY_SEL & 1))
    for (int u = vcu; u < GB * 8 * 32; u += G) { const int bh = u >> 5, qb = u & 31, bl = bh >> 3, h = bh & 7; const size_t rb = (size_t)bl * RB, q0 = rb + CTX + 256 * qb;
        attn_unit<96, 128, OM0, false>(lds, QM + q0 * 768 + h * 96, 768, KM + rb * 768 + h * 96, 768, VM + rb * 1024 + h * 128, 1024, RB / 64, 0, 0, 0, 0, NEGBIG, 0.f, P + q0 * NP + C_Z + h * 128, NP, OD, 0); }
#endif
#if !defined(ATT_ONLY) || ATT_ONLY == 2
    if (!DRY || (DRY_SEL & 2))
    for (int u = vcu; u < GB * 16 * 32; u += G) { const int bh = u >> 5, qb = u & 31, bl = bh >> 4, hm = bh & 15; const size_t rb = (size_t)bl * RB, q0 = rb + CTX + 256 * qb;
        attn_unit<64, 128, 1, false>(lds, P + q0 * NP + C_DQ + hm * 64, NP, P + rb * NP + C_DK + hm * 64, NP, P + rb * NP + C_DV + (hm >> 1) * 128, NP, RB / 64, 0, 0, 0, 0, NEGBIG, 0.f, nullptr, 0, OD + q0 * 2048 + hm * 128, 2048); }
#endif
#if !defined(ATT_ONLY) || ATT_ONLY == 3
    if (!DRY || (DRY_SEL & 4))
    for (int u = vcu; u < GB * 16 * 32; u += G) { const int bh = u >> 5, qb = u & 31, bl = bh >> 4, h = bh & 15; const size_t rb = (size_t)bl * RB, q0 = rb + CTX + 256 * qb;
        const int lo = (256 * qb - 128 < 0) ? 0 : 256 * qb - 128, hi = (256 * qb + 384 > SEQ) ? SEQ : 256 * qb + 384;
        attn_unit<64, 64, OM0, true>(lds, P + q0 * NP + C_SQ + h * 64, NP, P + rb * NP + C_SK + (h >> 2) * 64, NP, P + rb * NP + C_SV + (h >> 2) * 64, NP, CTX / 64, CTX + lo, (hi - lo) / 64, lo, 256 * qb, sink[h] * LOG2E, 1.0f,
                              P + q0 * NP + C_Z + 2048 + h * 64, NP, OD, 0); }
#endif
#if !defined(ATT_ONLY)
    if (l == 0) {
        for (int u = vcu; u < GB * 40; u += G) { const int bl = u / 40, k = u % 40; const size_t rb = (size_t)bl * RB;
            if (k < 8) { const int h = k;
                attn_unit<96, 128, OM0, false>(lds, QM + rb * 768 + h * 96, 768, KM + rb * 768 + h * 96, 768, VM + rb * 1024 + h * 128, 1024, CTX / 64, 0, 0, 0, 0, NEGBIG, 0.f, P + rb * NP + C_Z + h * 128, NP, OD, 0); }
            else if (k < 24) { const int hm = k - 8;
                attn_unit<64, 128, 1, false>(lds, P + rb * NP + C_DQ + hm * 64, NP, P + rb * NP + C_DK + hm * 64, NP, P + rb * NP + C_DV + (hm >> 1) * 128, NP, CTX / 64, 0, 0, 0, 0, NEGBIG, 0.f, nullptr, 0, OD + rb * 2048 + hm * 128, 2048); }
            else { const int h = k - 24;
                attn_unit<64, 64, OM0, false>(lds, P + rb * NP + C_SQ + h * 64, NP, P + rb * NP + C_SK + (h >> 2) * 64, NP, P + rb * NP + C_SV + (h >> 2) * 64, NP, CTX / 64, 0, 0, 0, 0, sink[h] * LOG2E, 1.0f, P + rb * NP + C_Z + 2048 + h * 64, NP, OD, 0); }
        }
    }
#endif
}

#define RLX_AGENT __ATOMIC_RELAXED, __HIP_MEMORY_SCOPE_AGENT
#define XB_TMO      128
#define XB_XCNT(j)  (256  + 64 * (j))
#define XB_XSUB(j)  (1280 + 64 * (j))
#define XB_XGEN(j)  (2304 + 64 * (j))
#define XB_TOP      3328
#define XB_TOPGEN   3392
#define XCD_BAR_WORDS 3456
#define XB_SPIN_CAP (1u << 18)

__device__ __forceinline__ unsigned xb_ld(unsigned* p)              { return __hip_atomic_load(p, __ATOMIC_RELAXED, __HIP_MEMORY_SCOPE_AGENT); }
__device__ __forceinline__ unsigned xb_add(unsigned* p, unsigned v) { return __hip_atomic_fetch_add(p, v, __ATOMIC_RELAXED, __HIP_MEMORY_SCOPE_AGENT); }
__device__ __forceinline__ unsigned xb_xcc_id() { return (unsigned)__builtin_amdgcn_s_getreg((3 << 11) | 20) & 0xFu; }
#define XB_SPIN(cond, bar) do { unsigned _sp = 0; while (cond) { __builtin_amdgcn_s_sleep(1); \
    if ((++_sp & 255u) == 0u) { if (xb_ld(&(bar)[XB_TMO])) break; if (_sp > XB_SPIN_CAP) { atomicAdd(&(bar)[XB_TMO], 1u); break; } } } } while (0)

struct XcdBarrier {
    unsigned* bar; unsigned x;
    volatile LAS unsigned* st;
};

__device__ __forceinline__ XcdBarrier xcd_barrier_post(unsigned* bar, volatile LAS unsigned* st) {
    XcdBarrier b; b.bar = bar; b.x = xb_xcc_id(); b.st = st;
    if (threadIdx.x == 0) (void)xb_add(&bar[XB_XCNT(b.x)], 1u);
    return b;
}
__device__ __forceinline__ void xcd_barrier_complete(unsigned* bar, unsigned x, unsigned& nloc, unsigned& nx) {
    const unsigned G = gridDim.x * gridDim.y * gridDim.z;
    unsigned sum, cnt, mine, sp = 0u;
    for (;;) {
        sum = 0u; cnt = 0u; mine = 0u;
#pragma unroll
        for (unsigned j = 0; j < 16; ++j) { const unsigned c = xb_ld(&bar[XB_XCNT(j)]); sum += c; cnt += (c > 0u) ? 1u : 0u; mine = (j == x) ? c : mine; }
        if (sum == G) break;
        __builtin_amdgcn_s_sleep(1);
        if ((++sp & 255u) == 0u) { if (xb_ld(&bar[XB_TMO])) break; if (sp > XB_SPIN_CAP) { atomicAdd(&bar[XB_TMO], 1u); break; } }
    }
    nloc = mine > 0u ? mine : 1u; nx = cnt > 0u ? cnt : 1u;
}

__device__ __forceinline__ void xcd_barrier(const XcdBarrier& b) {
    asm volatile("s_waitcnt vmcnt(0)" ::: "memory");
    __syncthreads();
    if (threadIdx.x == 0) {
        unsigned* bar = b.bar;
        __builtin_amdgcn_s_waitcnt(0);
        unsigned nloc = b.st[0], nx = b.st[1];
        if (nloc == 0u) { xcd_barrier_complete(bar, b.x, nloc, nx); b.st[0] = nloc; b.st[1] = nx; }
        const unsigned old = xb_add(&bar[XB_XSUB(b.x)], 1u);
        const unsigned gen = old / nloc;
        if (old + 1u == (gen + 1u) * nloc) {
            __builtin_amdgcn_fence(__ATOMIC_RELEASE, "agent");
            asm volatile("s_waitcnt vmcnt(0)" ::: "memory");
            const unsigned og = xb_add(&bar[XB_TOP], 1u);
            const unsigned tg = og / nx;
            if (og + 1u == (tg + 1u) * nx) xb_add(&bar[XB_TOPGEN], 1u);
            else XB_SPIN(xb_ld(&bar[XB_TOPGEN]) == tg, bar);
            __builtin_amdgcn_fence(__ATOMIC_ACQUIRE, "agent");
            xb_add(&bar[XB_XGEN(b.x)], 1u);
            asm volatile("s_waitcnt vmcnt(0)" ::: "memory");
        } else {
            XB_SPIN(xb_ld(&bar[XB_XGEN(b.x)]) == gen, bar);
            __builtin_amdgcn_fence(__ATOMIC_ACQUIRE, "agent");
            asm volatile("s_waitcnt vmcnt(0)" ::: "memory");
        }
    }
    __syncthreads();
}


__global__ void __launch_bounds__(512, 2) hybrid_fwd(Args a_unused) {
    extern __shared__ __attribute__((aligned(16))) unsigned char lds_raw[];
    LAS unsigned char* lds = (LAS unsigned char*)lds_raw;
    cg::grid_group grid = cg::this_grid();
    { volatile LAS unsigned* xst = (volatile LAS unsigned*)(lds + XB_LDS_OFF);
      if (threadIdx.x < 2) xst[threadIdx.x] = 0u;
      __syncthreads();
      (void)xcd_barrier_post((unsigned*)(args_ptr()->ws), xst); }
#define GSYNC() do { XcdBarrier b_; b_.bar = (unsigned*)(args_ptr()->ws); b_.x = xb_xcc_id(); b_.st = (volatile LAS unsigned*)(lds + XB_LDS_OFF); xcd_barrier(b_); } while (0)
#ifndef NO_PRO
    prologue(args_ptr(), lds);
#ifdef PROBE_PRO
    __syncthreads(); prologue(args_ptr(), lds);
#endif
#endif
    grid.sync();
    mod_finalize(args_ptr());
    GSYNC();
    for (int l = 0; l < 2; ++l) {
        for (int g = 0; g < NGRP; ++g) {
            ph_norm_mod(args_ptr(), lnd(l), lnd(g));
#ifdef PROBE_R1
            GSYNC(); ph_norm_mod(args_ptr(), lnd(l), lnd(g));
#endif
            GSYNC();
#ifndef NO_GEMM
            {
                unsigned char* ws = args_ptr()->ws; const int G = grd_l(), bx = bid_l();
                pg8::Gemm gm{1024, 1024, 1024}; pg8::Order S; S.init(R, NP, G, bx, ws + WS_H, 1024, (bf16_t*)(ws + WS_WIN) + (size_t)l * NP * 1024, 1024, 1 << 20, 0);
                EpiIn E{ws};
                pg8::gemm_phase<EpiIn, pg8::Order, true, true>(lds, gm, S, E);
#ifdef PROBE_G1
                __syncthreads(); pg8::gemm_phase<EpiIn, pg8::Order, true, true>(lds, gm, S, E);
#endif
            }
#endif
            GSYNC();
            ph_mla_norm(args_ptr());
#ifdef PROBE_R1
            GSYNC(); ph_mla_norm(args_ptr());
#endif
            GSYNC();
#ifndef NO_GEMM2
            {
                unsigned char* ws = args_ptr()->ws; const int G = grd_l(), bx = bid_l();
                pg8::Gemm gq{384, 384, 384}; pg8::Order Sq; Sq.init(R, 768, G, bx, ws + WS_AQ, 384, (bf16_t*)(ws + WS_WUQ) + (size_t)l * 768 * 384, 384, 1 << 20, 0);
                EpiQ Eq{ws};
#ifndef NO_GQ
                pg8::gemm_phase<EpiQ, pg8::Order, true, true>(lds, gq, Sq, Eq);
#ifdef PROBE_G2
                __syncthreads(); pg8::gemm_phase<EpiQ, pg8::Order, true, true>(lds, gq, Sq, Eq);
#endif
#endif
            }
            {
                unsigned char* ws = args_ptr()->ws; const int G = grd_l(), bx = bid_l();
                pg8::Gemm gk{256, 256, 256}; pg8::Order Sk; Sk.init(R, 1536, G, bx, ws + WS_AKV, 256, (bf16_t*)(ws + WS_WUKV) + (size_t)l * 1536 * 256, 256, 1 << 20, 0);
                EpiKV Ek{ws};
#ifndef NO_GK
                pg8::gemm_phase<EpiKV, pg8::Order, true, true>(lds, gk, Sk, Ek);
#ifdef PROBE_G2
                __syncthreads(); pg8::gemm_phase<EpiKV, pg8::Order, true, true>(lds, gk, Sk, Ek);
#endif
#endif
            }
#endif
            GSYNC();
#ifndef NO_ATT
#ifdef PROBE_ATT
            ph_attention<true>(args_ptr(), lnd(l), lds);
            GSYNC();
#endif
            ph_attention<false>(args_ptr(), lnd(l), lds);
#endif
            GSYNC();
#ifdef PROBE_R2
            ph_diff_post<true>(args_ptr(), lnd(l)); GSYNC();
#endif
            ph_diff_post<false>(args_ptr(), lnd(l));
            GSYNC();
#ifndef NO_BR
            {
                unsigned char* ws = args_ptr()->ws; const int G = grd_l(), bx = bid_l();
                pg8::Gemm gb{1024, NP, 1024}; pg8::Order S; S.init(R, 3072, G, bx, (bf16_t*)(ws + WS_P) + C_Z, NP, (bf16_t*)(ws + WS_WB) + (size_t)l * 3 * 1024 * 1024, 1024, 4, 1024 * 2, l != 0);
#ifdef PROBE_BR
                { EpiBrT<true> Ed{ws}; pg8::gemm_phase<EpiBrT<true>, pg8::Order, true, true>(lds, gb, S, Ed); __syncthreads(); }
#endif
                EpiBrT<false> E{ws};
                pg8::gemm_phase<EpiBrT<false>, pg8::Order, true, true>(lds, gb, S, E);
            }
#endif
            GSYNC();
#ifndef NO_OUT
            {
                ArgsP ap = args_ptr(); unsigned char* ws = ap->ws; const int G = grd_l(), bx = bid_l();
                pg8::Gemm go{3072, NP, 3072}; pg8::Order S; S.init(R, 1024, G, bx, (bf16_t*)(ws + WS_P) + C_GM, NP, (bf16_t*)(ws + WS_WO3) + (size_t)l * 1024 * 3072, 3072, 1 << 20, 0, l != 0);
#ifdef PROBE_OUT
                { EpiOutT<true> Ed{l, g, (l == 0) ? ap->in[I_X] : (const float*)ap->out, ap->out, ap->in[I_CTX], ws}; pg8::gemm_phase<EpiOutT<true>, pg8::Order, true, true>(lds, go, S, Ed); __syncthreads(); }
#endif
                EpiOutT<false> E{l, g, (l == 0) ? ap->in[I_X] : (const float*)ap->out, ap->out, ap->in[I_CTX], ws};
                pg8::gemm_phase<EpiOutT<false>, pg8::Order, true, true>(lds, go, S, E);
            }
#endif
        }
        GSYNC();
    }
#ifdef PROBE_R2
    ph_final_norm<true>(args_ptr()); GSYNC();
#endif
    ph_final_norm<false>(args_ptr());
}

extern "C" void kernel_launch(void* const* d_in, const int* in_sizes, int n_in, void* d_out, int out_size, void* d_ws, size_t ws_size, hipStream_t stream) {
    static int grid = 0;
    if (grid == 0) {
        if (n_in != 21 || ws_size < WS_END) { fprintf(stderr, "kernel_launch: expected 21 inputs and >= %zu bytes of workspace (got %d, %zu)\n", (size_t)WS_END, n_in, ws_size); grid = -1; return; }
        int dev = 0, cus = 0, per_cu = 0;
        (void)hipGetDevice(&dev); (void)hipDeviceGetAttribute(&cus, hipDeviceAttributeMultiprocessorCount, dev);
        if (hipFuncSetAttribute((const void*)hybrid_fwd, hipFuncAttributeMaxDynamicSharedMemorySize, LDS_BYTES) != hipSuccess) fprintf(stderr, "kernel_launch: hipFuncSetAttribute failed\n");
        if (hipOccupancyMaxActiveBlocksPerMultiprocessor(&per_cu, (const void*)hybrid_fwd, 512, LDS_BYTES) != hipSuccess || per_cu < 1) { per_cu = 1; (void)hipGetLastError(); }
        if (cus <= 0) cus = 256;
        grid = cus * per_cu;
    }
    if (grid < 0) return;
    Args a{};
    for (int i = 0; i < 21; ++i) a.in[i] = (const float*)d_in[i];
    a.out = (float*)d_out; a.ws = (unsigned char*)d_ws;
    (void)hipMemsetAsync(d_ws, 0, 16384, stream);
    void* args[] = {&a};
    hipError_t e = hipLaunchCooperativeKernel((const void*)hybrid_fwd, dim3(grid), dim3(512), args, LDS_BYTES, stream);
    if (e != hipSuccess) fprintf(stderr, "kernel_launch: cooperative launch failed: %s (grid %d)\n", hipGetErrorString(e), grid);
}
```

```cpp
#include <hip/hip_runtime.h>
#include <hip/hip_cooperative_groups.h>
#include <cstdio>
#include <cstdint>
namespace cg = cooperative_groups;

#define DI __device__ __forceinline__
#define LAS __attribute__((address_space(3)))
__device__ __forceinline__ int tid_l() { int t = threadIdx.x; asm volatile("" : "+v"(t)); return t; }
__device__ __forceinline__ int bid_l() { int b = blockIdx.x; asm volatile("" : "+s"(b)); return b; }
__device__ __forceinline__ int lnd(int x) { asm volatile("" : "+s"(x)); return x; }
__device__ __forceinline__ int grd_l() { int g = gridDim.x; asm volatile("" : "+s"(g)); return g; }
typedef unsigned short bf16_t;
typedef short bf16x8 __attribute__((ext_vector_type(8)));
typedef short s16x4 __attribute__((ext_vector_type(4)));
typedef float f32x4 __attribute__((ext_vector_type(4)));
typedef float f32x16 __attribute__((ext_vector_type(16)));
typedef unsigned u32x4 __attribute__((ext_vector_type(4)));
typedef unsigned u32x2 __attribute__((ext_vector_type(2)));

constexpr int DM = 1024, NBATCH = 8, SEQ = 8192, CTX = 256, RB = CTX + SEQ;
constexpr int GB = 2, NGRP = NBATCH / GB, R = GB * RB;
constexpr int NP = 11520;
constexpr int C_QC = 0, C_KVC = 384, C_KR = 640, C_DQ = 768, C_DK = 1792, C_DV = 2816, C_SQ = 3840, C_SK = 4864, C_SV = 5120, C_Z = 5376, C_GM = 8448;
constexpr int D_IN = 11424;
constexpr float EPS = 1e-6f, LOG2E = 1.4426950408889634f;
constexpr float QS64 = 0.125f * LOG2E, QS96 = 0.10206207261596575f * LOG2E;
constexpr float NEGBIG = -1e30f, THR = 8.0f;

constexpr size_t al256(size_t x) { return (x + 255) & ~(size_t)255; }
constexpr size_t WS_WIN = 1u << 20;
constexpr size_t WS_WUQ = al256(WS_WIN + (size_t)2 * NP * 1024 * 2);
constexpr size_t WS_WUKV = al256(WS_WUQ + (size_t)2 * 768 * 384 * 2);
constexpr size_t WS_WB = al256(WS_WUKV + (size_t)2 * 1536 * 256 * 2);
constexpr size_t WS_WO3 = al256(WS_WB + (size_t)2 * 3 * 1024 * 1024 * 2);
constexpr size_t WS_COSH = al256(WS_WO3 + (size_t)2 * 1024 * 3072 * 2);
constexpr size_t WS_SINH = al256(WS_COSH + (size_t)SEQ * 32 * 4);
constexpr size_t WS_COSM = al256(WS_SINH + (size_t)SEQ * 32 * 4);
constexpr size_t WS_SINM = al256(WS_COSM + (size_t)SEQ * 16 * 4);
constexpr size_t WS_MODP = al256(WS_SINM + (size_t)SEQ * 16 * 4);
constexpr size_t WS_MOD = al256(WS_MODP + (size_t)16 * 2 * 9 * 3072 * 4);
constexpr size_t WS_CTX = al256(WS_MOD + (size_t)2 * 9 * 3072 * 4);
constexpr size_t WS_H = al256(WS_CTX + (size_t)NBATCH * CTX * DM * 4);
constexpr size_t WS_P = al256(WS_H + (size_t)R * DM * 2);
constexpr size_t WS_AQ = al256(WS_P + (size_t)R * NP * 2);
constexpr size_t WS_AKV = al256(WS_AQ + (size_t)R * 384 * 2);
constexpr size_t WS_QM = al256(WS_AKV + (size_t)R * 256 * 2);
constexpr size_t WS_KM = al256(WS_QM + (size_t)R * 768 * 2);
constexpr size_t WS_VM = al256(WS_KM + (size_t)R * 768 * 2);
constexpr size_t WS_OD = al256(WS_VM + (size_t)R * 1024 * 2);
constexpr size_t WS_END = al256(WS_OD + (size_t)R * 2048 * 4);
static_assert(WS_END <= ((size_t)1 << 30), "workspace map exceeds 1 GiB");

constexpr int LDS_BYTES = 155648, XB_LDS_OFF = 155136;

DI unsigned pk2(float lo, float hi) { typedef float f2_t __attribute__((ext_vector_type(2))); typedef __bf16 b2_t __attribute__((ext_vector_type(2)));
    f2_t v = {lo, hi}; b2_t b = __builtin_convertvector(v, b2_t); return __builtin_bit_cast(unsigned, b); }
DI u32x4 pack8(f32x4 a, f32x4 b) { u32x4 w; w.x = pk2(a[0], a[1]); w.y = pk2(a[2], a[3]); w.z = pk2(b[0], b[1]); w.w = pk2(b[2], b[3]); return w; }
DI float bflo(unsigned w) { return __uint_as_float(w << 16); }
DI float bfhi(unsigned w) { return __uint_as_float(w & 0xffff0000u); }
DI float wave_sum(float v) {
#pragma unroll
    for (int o = 1; o < 64; o <<= 1) v += __shfl_xor(v, o);
    return v; }
DI float silu_f(float z) { return z * __builtin_amdgcn_rcpf(1.0f + __expf(-z)); }
DI float sigm_f(float z) { return __builtin_amdgcn_rcpf(1.0f + __expf(-z)); }
DI void rope8(f32x4& v0, f32x4& v1, const f32x4 cs, const f32x4 sn) {
    float a, b;
    a = v0[0]; b = v0[1]; v0[0] = a * cs[0] - b * sn[0]; v0[1] = b * cs[0] + a * sn[0];
    a = v0[2]; b = v0[3]; v0[2] = a * cs[1] - b * sn[1]; v0[3] = b * cs[1] + a * sn[1];
    a = v1[0]; b = v1[1]; v1[0] = a * cs[2] - b * sn[2]; v1[1] = b * cs[2] + a * sn[2];
    a = v1[2]; b = v1[3]; v1[2] = a * cs[3] - b * sn[3]; v1[3] = b * cs[3] + a * sn[3];
}
namespace pg8 {
#define PG8_LAS __attribute__((address_space(3)))
typedef unsigned short bf16_t;
typedef short bf16x8 __attribute__((ext_vector_type(8)));
typedef float f32x4 __attribute__((ext_vector_type(4)));
typedef unsigned u32x4 __attribute__((ext_vector_type(4)));
constexpr int BM = 256, BK = 64, HALF = 128, HTB = HALF * BK * 2  , STAGE_BYTES = 8 * HTB, NXCD = 8, WGM = 8;

__host__ __device__ __forceinline__ int lds_byte(int r, int c) { const int st = (r >> 4) * 2 + (c >> 5), rr = r & 15, cc = c & 31, ob = rr * 64 + cc * 2; return st * 1024 + (ob ^ (((ob >> 9) & 1) << 5)); }
__host__ __device__ __forceinline__ void stage_rc(int b, int& R, int& C) { const int st = b / 1024, sb = b % 1024, swz = sb ^ (((sb >> 9) & 1) << 5); R = (st >> 1) * 16 + swz / 64; C = (st & 1) * 32 + (swz % 64) / 2; }
__host__ __device__ __forceinline__ int perm32(int rho) { const int n = rho >> 4, i = rho & 15; return 8 * (i >> 2) + 4 * n + (i & 3); }

struct Unit { int pm, pn; };
struct Gemm { int K, lda, ldb; };
struct Order {
    int nM, nN, nwg, G, c; const char* A; const char* B; unsigned tA, tB; int pnblk; unsigned ablk; int skipctx;
    __device__ __forceinline__ void init(int M, int N, int G_, int c_, const void* A_, int lda, const void* B_, int ldb, int pnblk_, unsigned ablk_, int skipctx_ = 0) {
        skipctx = skipctx_; nM = M / BM; if (skipctx) nM -= nM / 33;
        nN = N / BM; nwg = nM * nN; G = G_; c = c_; A = (const char*)A_; B = (const char*)B_; tA = (unsigned)(BM * lda * 2); tB = (unsigned)(BM * ldb * 2); pnblk = pnblk_; ablk = ablk_; }
    __device__ __forceinline__ bool next(int i, Unit& u) const {
        const long L = (long)i * G + c; if (L >= nwg) return false;
        int wgid = (int)L; { const int q = nwg / NXCD, r = nwg % NXCD, xcd = wgid % NXCD, off = wgid / NXCD; wgid = (xcd < r ? xcd * (q + 1) : r * (q + 1) + (xcd - r) * q) + off; }
        const int nig = WGM * nN, gid = wgid / nig, fm = gid * WGM, gsz = (nM - fm) < WGM ? (nM - fm) : WGM;
        u.pm = fm + ((wgid % nig) % gsz); u.pn = (wgid % nig) / gsz; if (skipctx) u.pm += u.pm / 32 + 1; return true;
    }
    __device__ __forceinline__ const char* a_base(const Unit& u) const { return A + (size_t)u.pm * tA + (size_t)(u.pn / pnblk) * ablk; }
    __device__ __forceinline__ const char* b_base(const Unit& u) const { return B + (size_t)u.pn * tB; }
};

template <class Epi, class Sched, bool ALIGN_EPI = false, bool SP2 = false>
__device__ __forceinline__ void gemm_phase(PG8_LAS unsigned char* lds, const Gemm g, const Sched& S, const Epi& E) {
    const int tid = tid_l(), wid = __builtin_amdgcn_readfirstlane(tid >> 6), lane = tid & 63, wr = wid >> 2, wc = wid & 3, fr = lane & 15, fq = lane >> 4;
    const int K = g.K, nt = K / BK;
    unsigned voffA[2], voffB[2];
#pragma unroll
    for (int i = 0; i < 2; ++i) { int R, C; stage_rc(tid * 16 + i * 8192, R, C); const int Rb = Epi::PERM ? ((R & ~31) + perm32(R & 31)) : R;
        voffA[i] = (unsigned)(R * g.lda + C) * 2u; voffB[i] = (unsigned)(Rb * g.ldb + C) * 2u; }
    const size_t kstep = (size_t)(BK * 2);
    const size_t hstepA = (size_t)HALF * g.lda * 2, hstepB = (size_t)HALF * g.ldb * 2;
    const unsigned ldsw = (unsigned)wid * 1024u;
    const int aoff = lds_byte(wr * 64 + fr, fq * 8), boff = lds_byte(wc * 32 + fr, fq * 8);
#define PG8_SA(b, h) (((b) * 2 + (h)) * HTB)
#define PG8_SB(b, h) ((4 + (b) * 2 + (h)) * HTB)
#define PG8_STAGE(bufoff, gbase, voff) do { _Pragma("unroll") for (int _i = 0; _i < 2; ++_i) \
        __builtin_amdgcn_global_load_lds((const unsigned*)((const char*)(gbase) + (voff)[_i]), (PG8_LAS unsigned*)(lds + (bufoff) + ldsw + _i * 8192), 16, 0, 0); } while (0)
#define PG8_LDA(dst, b, h) do { _Pragma("unroll") for (int m = 0; m < 4; ++m) _Pragma("unroll") for (int k = 0; k < 2; ++k) dst[m][k] = *(const PG8_LAS bf16x8*)(lds + PG8_SA(b, h) + aoff + m * 2048 + k * 1024); } while (0)
#define PG8_LDB(dst, b, h) do { _Pragma("unroll") for (int n = 0; n < 2; ++n) _Pragma("unroll") for (int k = 0; k < 2; ++k) dst[n][k] = *(const PG8_LAS bf16x8*)(lds + PG8_SB(b, h) + boff + n * 2048 + k * 1024); } while (0)
#define PG8_MMA(ai, bj, At, Bt) do { __builtin_amdgcn_s_setprio(1); _Pragma("unroll") for (int m = 0; m < 4; ++m) _Pragma("unroll") for (int n = 0; n < 2; ++n) _Pragma("unroll") for (int k = 0; k < 2; ++k) \
        acc[ai][bj][m][n] = __builtin_amdgcn_mfma_f32_16x16x32_bf16(Bt[n][k], At[m][k], acc[ai][bj][m][n], 0, 0, 0); __builtin_amdgcn_s_setprio(0); } while (0)
#define PG8_WAIT_V(n) asm volatile("s_waitcnt vmcnt(" #n ")" ::: "memory")
#define PG8_WAIT_L(n) asm volatile("s_waitcnt lgkmcnt(" #n ")" ::: "memory")
#define PG8_BAR __builtin_amdgcn_s_barrier()
#define PG8_SCHED __builtin_amdgcn_sched_barrier(0)
    Unit cur, nxt; int ui = 0;
    if (!S.next(0, cur)) return;
    f32x4 acc[2][2][4][2];
#pragma unroll
    for (int a = 0; a < 2; ++a)
#pragma unroll
        for (int b = 0; b < 2; ++b)
#pragma unroll
            for (int m = 0; m < 4; ++m)
#pragma unroll
                for (int n = 0; n < 2; ++n) acc[a][b][m][n] = (f32x4){0.f, 0.f, 0.f, 0.f};
    bf16x8 At[4][2], B0[2][2], B1[2][2];
    const char* cA = S.a_base(cur); const char* cB = S.b_base(cur);

    if constexpr (SP2) {
        PG8_STAGE(PG8_SB(0, 0), cB, voffB); PG8_STAGE(PG8_SB(0, 1), cB + hstepB, voffB); PG8_STAGE(PG8_SA(0, 0), cA, voffA); PG8_STAGE(PG8_SA(0, 1), cA + hstepA, voffA);
        if (wr == 1) PG8_BAR;
        PG8_WAIT_V(2); PG8_BAR;
        PG8_STAGE(PG8_SB(1, 0), cB + kstep, voffB); PG8_STAGE(PG8_SA(1, 0), cA + kstep, voffA); PG8_STAGE(PG8_SB(1, 1), cB + hstepB + kstep, voffB);
        PG8_WAIT_V(6); PG8_BAR;
    } else {
        PG8_STAGE(PG8_SB(0, 0), cB, voffB); PG8_STAGE(PG8_SA(0, 0), cA, voffA); PG8_STAGE(PG8_SB(0, 1), cB + hstepB, voffB); PG8_STAGE(PG8_SA(0, 1), cA + hstepA, voffA);
        if (wr == 1) PG8_BAR;
        PG8_WAIT_V(4); PG8_BAR;
        PG8_STAGE(PG8_SB(1, 0), cB + kstep, voffB); PG8_STAGE(PG8_SA(1, 0), cA + kstep, voffA); PG8_STAGE(PG8_SB(1, 1), cB + hstepB + kstep, voffB);
        PG8_WAIT_V(6); PG8_BAR;
    }
    for (;;) {
        const bool has_next = S.next(ui + 1, nxt);
        const char* nA = has_next ? S.a_base(nxt) : cA; const char* nB = has_next ? S.b_base(nxt) : cB;
#pragma nounroll
        for (int t = 0; t < nt; t += 2) {
            const bool last = (t == nt - 2);
            const char* a1 = cA + (size_t)(t + 1) * kstep;
            const char* a2 = last ? nA : cA + (size_t)(t + 2) * kstep; const char* b2 = last ? nB : cB + (size_t)(t + 2) * kstep;
            const char* a3 = a2 + kstep; const char* b3 = b2 + kstep;

            if constexpr (SP2) {
            PG8_LDB(B0, 0, 0); PG8_LDB(B1, 0, 1); PG8_SCHED; PG8_LDA(At, 0, 0); PG8_STAGE(PG8_SA(1, 1), a1 + hstepA, voffA);
            PG8_WAIT_V(8); PG8_WAIT_L(0); PG8_BAR; PG8_MMA(0, 0, At, B0); PG8_MMA(0, 1, At, B1); PG8_BAR; PG8_SCHED;
            PG8_LDA(At, 0, 1); PG8_STAGE(PG8_SB(0, 0), b2, voffB); PG8_STAGE(PG8_SB(0, 1), b2 + hstepB, voffB); PG8_STAGE(PG8_SA(0, 0), a2, voffA);
            PG8_WAIT_V(8); PG8_WAIT_L(0); PG8_BAR; PG8_MMA(1, 0, At, B0); PG8_MMA(1, 1, At, B1); PG8_BAR; PG8_SCHED;
            PG8_LDB(B0, 1, 0); PG8_LDB(B1, 1, 1); PG8_SCHED; PG8_LDA(At, 1, 0); PG8_STAGE(PG8_SA(0, 1), a2 + hstepA, voffA);
            PG8_WAIT_V(8); PG8_WAIT_L(0); PG8_BAR; PG8_MMA(0, 0, At, B0); PG8_MMA(0, 1, At, B1); PG8_BAR; PG8_SCHED;
            PG8_LDA(At, 1, 1); PG8_STAGE(PG8_SB(1, 0), b3, voffB); PG8_STAGE(PG8_SB(1, 1), b3 + hstepB, voffB); PG8_STAGE(PG8_SA(1, 0), a3, voffA);
            PG8_WAIT_V(8); PG8_WAIT_L(0); PG8_BAR; PG8_MMA(1, 0, At, B0); PG8_MMA(1, 1, At, B1); PG8_BAR; PG8_SCHED;
            } else {
            PG8_LDB(B0, 0, 0); PG8_SCHED; PG8_LDA(At, 0, 0); PG8_STAGE(PG8_SA(1, 1), a1 + hstepA, voffA);
            PG8_WAIT_L(8); PG8_BAR; PG8_WAIT_L(0); PG8_MMA(0, 0, At, B0); PG8_BAR; PG8_SCHED;
            PG8_LDB(B1, 0, 1); PG8_STAGE(PG8_SB(0, 0), b2, voffB);
            PG8_BAR; PG8_WAIT_L(0); PG8_MMA(0, 1, At, B1); PG8_BAR;
            PG8_LDA(At, 0, 1); PG8_STAGE(PG8_SA(0, 0), a2, voffA);
            PG8_BAR; PG8_WAIT_L(0); PG8_MMA(1, 0, At, B0); PG8_BAR; PG8_SCHED;
            PG8_STAGE(PG8_SB(0, 1), b2 + hstepB, voffB);
            PG8_WAIT_V(6); PG8_BAR; PG8_MMA(1, 1, At, B1); PG8_BAR;
            PG8_LDB(B0, 1, 0); PG8_SCHED; PG8_LDA(At, 1, 0); PG8_STAGE(PG8_SA(0, 1), a2 + hstepA, voffA);
            PG8_WAIT_L(8); PG8_BAR; PG8_WAIT_L(0); PG8_MMA(0, 0, At, B0); PG8_BAR; PG8_SCHED;
            PG8_LDB(B1, 1, 1); PG8_STAGE(PG8_SB(1, 0), b3, voffB);
            PG8_BAR; PG8_WAIT_L(0); PG8_MMA(0, 1, At, B1); PG8_BAR;
            PG8_LDA(At, 1, 1); PG8_STAGE(PG8_SA(1, 0), a3, voffA);
            PG8_BAR; PG8_WAIT_L(0); PG8_MMA(1, 0, At, B0); PG8_BAR; PG8_SCHED;
            PG8_STAGE(PG8_SB(1, 1), b3 + hstepB, voffB);
            PG8_WAIT_V(6); PG8_BAR; PG8_MMA(1, 1, At, B1); PG8_BAR;
            }
        }
        if constexpr (ALIGN_EPI) { if (wr == 0) PG8_BAR; }
        if constexpr (!Epi::AFTER_DRAIN) { E(acc, cur, wr, wc, fr, fq); }
        if (!has_next) break;
#pragma unroll
        for (int a = 0; a < 2; ++a)
#pragma unroll
            for (int b = 0; b < 2; ++b)
#pragma unroll
                for (int m = 0; m < 4; ++m)
#pragma unroll
                    for (int n = 0; n < 2; ++n) acc[a][b][m][n] = (f32x4){0.f, 0.f, 0.f, 0.f};
        cur = nxt; cA = nA; cB = nB; ++ui;
        if constexpr (ALIGN_EPI) { if (wr == 1) PG8_BAR; }
    }
    PG8_WAIT_V(0);
    if constexpr (!ALIGN_EPI) { if (wr == 0) PG8_BAR; }
    PG8_BAR;
    if constexpr (Epi::AFTER_DRAIN) { E.fused(acc, cur, wr, wc, fr, fq, lds, wid, lane); }
#undef PG8_SA
#undef PG8_SB
#undef PG8_STAGE
#undef PG8_LDA
#undef PG8_LDB
#undef PG8_MMA
#undef PG8_WAIT_V
#undef PG8_WAIT_L
#undef PG8_BAR
#undef PG8_SCHED
}
}
struct EpiIn {
    static constexpr bool PERM = true, AFTER_DRAIN = false;
    unsigned char* ws;
    DI void operator()(const f32x4 (&acc)[2][2][4][2], const pg8::Unit& u, int wr, int wc, int fr, int fq) const {
        bf16_t* P = (bf16_t*)(ws + WS_P); const float* cosH = (const float*)(ws + WS_COSH); const float* sinH = (const float*)(ws + WS_SINH); const float* cosM = (const float*)(ws + WS_COSM); const float* sinM = (const float*)(ws + WS_SINM);
        const int pn = u.pn; const bool ctxt = (u.pm % 33) == 0;
        int mode = 0; float sc = 1.f;
        if ((pn >= 3 && pn <= 10) || (pn >= 15 && pn <= 19)) mode = 1;
        if (pn == 2) mode = 2;
        if ((pn >= 3 && pn <= 6) || (pn >= 15 && pn <= 18)) sc = QS64;
        if (ctxt) mode = 0;
        const int rowt = u.pm * 256 + wr * 64 + fr, colb = pn * 256 + wc * 32 + 8 * fq;
#pragma unroll
        for (int ai = 0; ai < 2; ++ai)
#pragma unroll
            for (int m = 0; m < 4; ++m) {
                const int row = rowt + ai * 128 + m * 16; const int pos = (row % RB) - CTX;
                bf16_t* rowp = P + (size_t)row * NP;
#pragma unroll
                for (int bj = 0; bj < 2; ++bj) {
                    const int col0 = colb + bj * 128;
                    f32x4 v0 = acc[ai][bj][m][0], v1 = acc[ai][bj][m][1];
                    if (mode == 1) { const int p0 = (col0 & 63) >> 1; const f32x4 cs = *(const f32x4*)(cosH + (size_t)pos * 32 + p0), sn = *(const f32x4*)(sinH + (size_t)pos * 32 + p0); rope8(v0, v1, cs, sn); }
                    else if (mode == 2 && col0 >= C_KR && col0 < C_KR + 32) { const int p0 = (col0 - C_KR) >> 1; const f32x4 cs = *(const f32x4*)(cosM + (size_t)pos * 16 + p0), sn = *(const f32x4*)(sinM + (size_t)pos * 16 + p0); rope8(v0, v1, cs, sn); }
                    v0 = v0 * sc; v1 = v1 * sc;
                    *(u32x4*)(rowp + col0) = pack8(v0, v1);
                }
            }
    }
};
struct EpiQ {
    static constexpr bool PERM = true, AFTER_DRAIN = false;
    unsigned char* ws;
    DI void operator()(const f32x4 (&acc)[2][2][4][2], const pg8::Unit& u, int wr, int wc, int fr, int fq) const {
        bf16_t* QM = (bf16_t*)(ws + WS_QM); const float* cosM = (const float*)(ws + WS_COSM); const float* sinM = (const float*)(ws + WS_SINM);
        const bool ctxt = (u.pm % 33) == 0;
        const int rowt = u.pm * 256 + wr * 64 + fr, colb = u.pn * 256 + wc * 32 + 8 * fq;
#pragma unroll
        for (int ai = 0; ai < 2; ++ai)
#pragma unroll
            for (int m = 0; m < 4; ++m) {
                const int row = rowt + ai * 128 + m * 16; const int pos = (row % RB) - CTX;
#pragma unroll
                for (int bj = 0; bj < 2; ++bj) {
                    const int col0 = colb + bj * 128, within = col0 % 96;
                    f32x4 v0 = acc[ai][bj][m][0], v1 = acc[ai][bj][m][1];
                    if (!ctxt && within >= 64) { const int p0 = (within - 64) >> 1; const f32x4 cs = *(const f32x4*)(cosM + (size_t)pos * 16 + p0), sn = *(const f32x4*)(sinM + (size_t)pos * 16 + p0); rope8(v0, v1, cs, sn); }
                    v0 = v0 * QS96; v1 = v1 * QS96;
                    *(u32x4*)(QM + (size_t)row * 768 + col0) = pack8(v0, v1);
                }
                asm volatile("" ::: "memory");
            }
    }
};
struct EpiKV {
    static constexpr bool PERM = true, AFTER_DRAIN = false;
    unsigned char* ws;
    DI void operator()(const f32x4 (&acc)[2][2][4][2], const pg8::Unit& u, int wr, int wc, int fr, int fq) const {
        bf16_t* KM = (bf16_t*)(ws + WS_KM); bf16_t* VM = (bf16_t*)(ws + WS_VM);
        const int rowt = u.pm * 256 + wr * 64 + fr, colb = u.pn * 256 + wc * 32 + 8 * fq;
#pragma unroll
        for (int ai = 0; ai < 2; ++ai)
#pragma unroll
            for (int m = 0; m < 4; ++m) {
                const int row = rowt + ai * 128 + m * 16;
#pragma unroll
                for (int bj = 0; bj < 2; ++bj) {
                    const int col0 = colb + bj * 128;
                    bf16_t* dst = (col0 < 512) ? KM + (size_t)row * 768 + (col0 >> 6) * 96 + (col0 & 63) : VM + (size_t)row * 1024 + (col0 - 512);
                    *(u32x4*)dst = pack8(acc[ai][bj][m][0], acc[ai][bj][m][1]);
                }
                asm volatile("" ::: "memory");
            }
    }
};
template <bool DRYE> struct EpiBrT {
    static constexpr bool PERM = true, AFTER_DRAIN = false;
    unsigned char* ws;
    DI void operator()(const f32x4 (&acc)[2][2][4][2], const pg8::Unit& u, int wr, int wc, int fr, int fq) const {
        bf16_t* P = (bf16_t*)(ws + WS_P);
        unsigned chk = 0u;
        const int rowt = u.pm * 256 + wr * 64 + fr, colb = u.pn * 256 + wc * 32 + 8 * fq;
#pragma unroll
        for (int ai = 0; ai < 2; ++ai)
#pragma unroll
            for (int m = 0; m < 4; ++m) {
                const int row = rowt + ai * 128 + m * 16;
#pragma unroll
                for (int bj = 0; bj < 2; ++bj) {
                    bf16_t* p = P + (size_t)row * NP + C_GM + colb + bj * 128;
                    const u32x4 g = *(const u32x4*)p;
                    f32x4 v0 = acc[ai][bj][m][0], v1 = acc[ai][bj][m][1];
                    v0[0] *= sigm_f(bflo(g.x)); v0[1] *= sigm_f(bfhi(g.x)); v0[2] *= sigm_f(bflo(g.y)); v0[3] *= sigm_f(bfhi(g.y));
                    v1[0] *= sigm_f(bflo(g.z)); v1[1] *= sigm_f(bfhi(g.z)); v1[2] *= sigm_f(bflo(g.w)); v1[3] *= sigm_f(bfhi(g.w));
                    { const u32x4 w_ = pack8(v0, v1); if (!DRYE) *(u32x4*)p = w_; else chk ^= w_.x ^ w_.y ^ w_.z ^ w_.w; }
                }
            }
        if (DRYE && chk == 0x12345678u) *(unsigned*)P = chk;
    }
};
template <bool DRYE> struct EpiOutT {
    static constexpr bool PERM = true, AFTER_DRAIN = false;
    int l, g; const float* xsrc; float* xdst; const float* ctxsrc; unsigned char* ws;
    DI void operator()(const f32x4 (&acc)[2][2][4][2], const pg8::Unit& u, int wr, int wc, int fr, int fq) const {
        float* ctxdst = (float*)(ws + WS_CTX); const float* mod = (const float*)(ws + WS_MOD) + (size_t)l * 9 * 3072;
        const int pmb = u.pm % 33, b = g * GB + u.pm / 33; const bool ctxt = pmb == 0;
        if (ctxt && l != 0) return;
        const float* gate = mod + (size_t)(ctxt ? 8 : b) * 3072 + 2048;
        const int colb = u.pn * 256 + wc * 32 + 8 * fq;
#pragma unroll
        for (int ai = 0; ai < 2; ++ai)
#pragma unroll
            for (int m = 0; m < 4; ++m) {
                const int j = pmb * 256 + ai * 128 + wr * 64 + m * 16 + fr;
                const size_t idx = ctxt ? ((size_t)b * CTX + j) * DM : ((size_t)b * SEQ + (j - CTX)) * DM;
                const float* s = (ctxt ? ctxsrc : xsrc) + idx; float* d = (ctxt ? ctxdst : xdst) + idx;
#pragma unroll
                for (int bj = 0; bj < 2; ++bj) {
                    const int col0 = colb + bj * 128;
                    const f32x4 g0 = *(const f32x4*)(gate + col0), g1 = *(const f32x4*)(gate + col0 + 4);
                    const f32x4 x0 = *(const f32x4*)(s + col0), x1 = *(const f32x4*)(s + col0 + 4);
                    if (!DRYE || x0[0] == 12345.678f) { *(f32x4*)(d + col0) = x0 + g0 * acc[ai][bj][m][0];
                    *(f32x4*)(d + col0 + 4) = x1 + g1 * acc[ai][bj][m][1]; }
                }
            }
    }
};

#define MFMA32(a, b, c) __builtin_amdgcn_mfma_f32_32x32x16_bf16((a), (b), (c), 0, 0, 0)
DI s16x4 tr16(const LAS unsigned char* p) { typedef short v4i16_t __attribute__((ext_vector_type(4))); return __builtin_bit_cast(s16x4, __builtin_amdgcn_ds_read_tr16_b64_v4i16((LAS v4i16_t*)p)); }
constexpr int AT_KOFF = 0, AT_KBUFMAX = 13312, AT_VOFF = 3 * AT_KBUFMAX, AT_VBUFMAX = 20480, AT_SOFF = AT_VOFF + 3 * AT_VBUFMAX, AT_QOFF = AT_SOFF + 1024;
static_assert(AT_QOFF + 8 * 6144 <= LDS_BYTES, "attention LDS map");
#ifndef AT_NOPF
#define AT_NOPF 1
#endif
#ifndef AT_IGLP
#define AT_IGLP -1
#endif
#ifndef AT_QLMIN
#define AT_QLMIN 64
#endif
#ifndef AT_PVKS
#define AT_PVKS 1
#endif
#ifndef AT_SGB
#define AT_SGB 0
#endif
#ifndef AT_PV8
#define AT_PV8 1
#endif
#ifndef AT_NOSBAR
#define AT_NOSBAR 1
#endif
#if AT_NOSBAR
#define SBAR() do {} while (0)
#else
#define SBAR() __builtin_amdgcn_sched_barrier(0)
#endif
#ifndef PROBE_MODE
#define PROBE_MODE 0
#endif
#ifndef DRY_SEL
#define DRY_SEL 7
#endif
#ifndef AT_QL
#define AT_QL 1
#endif
#ifndef AT_SB
#define AT_SB 0
#endif
template <int DQK, bool QL>
DI void at_qkt(f32x16& p0, f32x16& p1, const LAS unsigned char* kb, const bf16x8* qf, const LAS unsigned char* qb) {
    constexpr int KSTR = DQK + 8;
#pragma unroll
    for (int r = 0; r < 16; ++r) { p0[r] = 0.f; p1[r] = 0.f; }
#pragma unroll
    for (int ds = 0; ds < DQK / 16; ++ds) {
        const bf16x8 k0 = *(const LAS bf16x8*)(kb + ds * 32), k1 = *(const LAS bf16x8*)(kb + 32 * (KSTR * 2) + ds * 32);
        bf16x8 q; if (QL) q = *(const LAS bf16x8*)(qb + ds * 1024); else q = qf[ds];
        p0 = MFMA32(k0, q, p0); p1 = MFMA32(k1, q, p1);
        if (AT_SB && DQK > 64 && (ds & 1)) __builtin_amdgcn_sched_barrier(0x7f); }
}
DI void at_mask(f32x16& p0, f32x16& p1, int dk) {
#pragma unroll
    for (int r = 0; r < 16; ++r) { const int d = dk + (r & 3) + 8 * (r >> 2);
        if (d > 128 || d < -128) p0[r] = NEGBIG;
        if (d + 32 > 128 || d + 32 < -128) p1[r] = NEGBIG; }
}
DI void at_psm(f32x16& p0, f32x16& p1, float& mrun, float& alpha) {
    float ma = fmaxf(fmaxf(p0[0], p0[1]), p0[2]), mb = fmaxf(fmaxf(p1[0], p1[1]), p1[2]);
    ma = fmaxf(fmaxf(ma, p0[3]), p1[3]);
#pragma unroll
    for (int r = 4; r < 16; r += 2) { ma = fmaxf(fmaxf(ma, p0[r]), p0[r + 1]); mb = fmaxf(fmaxf(mb, p1[r]), p1[r + 1]); }
    float mx = fmaxf(ma, mb);
    { auto rr = __builtin_amdgcn_permlane32_swap(__float_as_uint(mx), __float_as_uint(mx), false, false); mx = fmaxf(__uint_as_float(rr[0]), __uint_as_float(rr[1])); }
    const bool keep = __all(mx - mrun <= THR);
    const float mn = keep ? mrun : fmaxf(mrun, mx); alpha = __builtin_amdgcn_exp2f(mrun - mn); mrun = mn;
#pragma unroll
    for (int r = 0; r < 16; ++r) { p0[r] -= mrun; p1[r] -= mrun; }
#pragma unroll
    for (int r = 0; r < 16; ++r) p0[r] = __builtin_amdgcn_exp2f(p0[r]);
}
DI void at_fsm(f32x16& p0, f32x16& p1, float alpha, float& lrun, bf16x8* pa) {
#pragma unroll
    for (int r = 0; r < 16; ++r) p1[r] = __builtin_amdgcn_exp2f(p1[r]);
    float ps = 0.f;
#pragma unroll
    for (int r = 0; r < 16; ++r) ps += p0[r] + p1[r];
    lrun = lrun * alpha + ps;
    u32x4 w;
    w.x = pk2(p0[0], p0[1]); w.y = pk2(p0[2], p0[3]); w.z = pk2(p0[4], p0[5]); w.w = pk2(p0[6], p0[7]); pa[0] = __builtin_bit_cast(bf16x8, w);
    w.x = pk2(p0[8], p0[9]); w.y = pk2(p0[10], p0[11]); w.z = pk2(p0[12], p0[13]); w.w = pk2(p0[14], p0[15]); pa[1] = __builtin_bit_cast(bf16x8, w);
    w.x = pk2(p1[0], p1[1]); w.y = pk2(p1[2], p1[3]); w.z = pk2(p1[4], p1[5]); w.w = pk2(p1[6], p1[7]); pa[2] = __builtin_bit_cast(bf16x8, w);
    w.x = pk2(p1[8], p1[9]); w.y = pk2(p1[10], p1[11]); w.z = pk2(p1[12], p1[13]); w.w = pk2(p1[14], p1[15]); pa[3] = __builtin_bit_cast(bf16x8, w);
}
DI void at_fsm_fake(f32x16& p0, f32x16& p1, bf16x8* pa) {
    u32x4 w;
    w.x = pk2(p0[0], p0[1]); w.y = pk2(p0[2], p0[3]); w.z = pk2(p0[4], p0[5]); w.w = pk2(p0[6], p0[7]); pa[0] = __builtin_bit_cast(bf16x8, w);
    w.x = pk2(p0[8], p0[9]); w.y = pk2(p0[10], p0[11]); w.z = pk2(p0[12], p0[13]); w.w = pk2(p0[14], p0[15]); pa[1] = __builtin_bit_cast(bf16x8, w);
    w.x = pk2(p1[0], p1[1]); w.y = pk2(p1[2], p1[3]); w.z = pk2(p1[4], p1[5]); w.w = pk2(p1[6], p1[7]); pa[2] = __builtin_bit_cast(bf16x8, w);
    w.x = pk2(p1[8], p1[9]); w.y = pk2(p1[10], p1[11]); w.z = pk2(p1[12], p1[13]); w.w = pk2(p1[14], p1[15]); pa[3] = __builtin_bit_cast(bf16x8, w);
}
template <int DV>
DI void at_pv(f32x16* o, const LAS unsigned char* vb, const bf16x8* pa) {
    constexpr int VSTR = DV + 32;
#if AT_PVKS
#pragma unroll
    for (int ks = 0; ks < 4; ++ks) {
        s16x4 vlo[DV / 32], vhi[DV / 32];
#pragma unroll
        for (int db = 0; db < DV / 32; ++db) { vlo[db] = tr16(vb + (16 * ks) * (VSTR * 2) + db * 64); vhi[db] = tr16(vb + (16 * ks + 8) * (VSTR * 2) + db * 64); }
#pragma unroll
        for (int db = 0; db < DV / 32; ++db) { const bf16x8 vf = __builtin_shufflevector(vlo[db], vhi[db], 0, 1, 2, 3, 4, 5, 6, 7); o[db] = MFMA32(pa[ks], vf, o[db]); }
    }
#else
#pragma unroll
    for (int db = 0; db < DV / 32; ++db) {
        s16x4 vlo[4], vhi[4];
#pragma unroll
        for (int ks = 0; ks < 4; ++ks) { vlo[ks] = tr16(vb + (16 * ks) * (VSTR * 2) + db * 64); vhi[ks] = tr16(vb + (16 * ks + 8) * (VSTR * 2) + db * 64); }
#pragma unroll
        for (int ks = 0; ks < 4; ++ks) { const bf16x8 vf = __builtin_shufflevector(vlo[ks], vhi[ks], 0, 1, 2, 3, 4, 5, 6, 7); o[db] = MFMA32(pa[ks], vf, o[db]); }
    }
#endif
}
template <int DV>
DI void at_scale_o(f32x16* o, LAS float* scw, float val, int r32, int hi) {
    if (hi == 0) scw[r32] = val;
    __builtin_amdgcn_wave_barrier(); asm volatile("" ::: "memory");
#pragma unroll
    for (int g4 = 0; g4 < 4; ++g4) { const f32x4 a4 = *(const LAS f32x4*)(scw + 8 * g4 + 4 * hi);
#pragma unroll
        for (int db = 0; db < DV / 32; ++db) { o[db][4 * g4 + 0] *= a4[0]; o[db][4 * g4 + 1] *= a4[1]; o[db][4 * g4 + 2] *= a4[2]; o[db][4 * g4 + 3] *= a4[3]; } }
    __builtin_amdgcn_wave_barrier(); asm volatile("" ::: "memory");
}
template <int DQK, int DV, int OUTM, bool MASKED>
DI void attn_unit(LAS unsigned char* lds, const bf16_t* Qp, int ldq, const bf16_t* Kp, int ldk, const bf16_t* Vp, int ldv,
                  int nA, int rowB0, int nB, int posB0, int qpos0, float m0, float l0,
                  bf16_t* Og, int ldo, float* Of, int ldof) {
    constexpr int KSTR = DQK + 8, VSTR = DV + 32, KBUF = 64 * KSTR * 2, VBUF = 64 * VSTR * 2;
    constexpr int KCH = DQK / 8, VCH = DV / 8, NKC = 64 * KCH, NVC = 64 * VCH, KRN = (NKC + 511) / 512, VRN = (NVC + 511) / 512;
    static_assert(KBUF <= AT_KBUFMAX && VBUF <= AT_VBUFMAX, "attention LDS map");
    const int tid = tid_l(), lane = tid & 63, wid = __builtin_amdgcn_readfirstlane(tid >> 6), r32 = lane & 31, hi = lane >> 5;
#ifndef AT_QL
#define AT_QL 1
#endif
#ifndef AT_SB
#define AT_SB 0
#endif
    constexpr bool QL = AT_QL && (DQK > AT_QLMIN);
    bf16x8 qf[QL ? 1 : DQK / 16];
    const LAS unsigned char* qb = lds + AT_QOFF + wid * 6144 + lane * 16;
    { const bf16_t* qrow = Qp + (size_t)(32 * wid + r32) * ldq + 8 * hi;
#pragma unroll
      for (int ds = 0; ds < DQK / 16; ++ds) { const bf16x8 v = *(const bf16x8*)(qrow + 16 * ds); if (QL) *(LAS bf16x8*)(lds + AT_QOFF + wid * 6144 + lane * 16 + ds * 1024) = v; else qf[QL ? 0 : ds] = v; }
      if (QL) { __builtin_amdgcn_wave_barrier(); asm volatile("s_waitcnt lgkmcnt(0)" ::: "memory"); } }
    f32x16 o[DV / 32];
#pragma unroll
    for (int db = 0; db < DV / 32; ++db)
#pragma unroll
        for (int r = 0; r < 16; ++r) o[db][r] = 0.f;
    float mrun = m0, lrun = (hi == 0) ? l0 : 0.f;
    LAS float* scw = (LAS float*)(lds + AT_SOFF) + wid * 32;
    const int NT = nA + nB;
    const LAS unsigned char* kb0 = lds + AT_KOFF + r32 * (KSTR * 2) + hi * 16;
    const LAS unsigned char* vb0 = lds + AT_VOFF + (4 * hi + ((lane & 15) >> 2)) * (VSTR * 2) + (16 * ((lane >> 4) & 1) + 4 * (lane & 3)) * 2;
    const int dk0 = posB0 + 4 * hi - (qpos0 + 32 * wid + r32) - 64 * nA;
    u32x4 kreg[KRN], vreg[VRN];
    int kgo[KRN], klo[KRN], vgo[VRN], vlo_[VRN];
#pragma unroll
    for (int i_ = 0; i_ < KRN; ++i_) { int c_ = tid + 512 * i_; if (c_ >= NKC) c_ -= 512; const int r_ = c_ / KCH, cc_ = c_ % KCH; kgo[i_] = r_ * ldk + cc_ * 8; klo[i_] = AT_KOFF + r_ * (KSTR * 2) + cc_ * 16; }
#pragma unroll
    for (int i_ = 0; i_ < VRN; ++i_) { int c_ = tid + 512 * i_; if (c_ >= NVC) c_ -= 512; const int r_ = c_ / VCH, cc_ = c_ % VCH; vgo[i_] = r_ * ldv + cc_ * 8; vlo_[i_] = AT_VOFF + r_ * (VSTR * 2) + cc_ * 16; }
    const __amdgpu_buffer_rsrc_t rK = __builtin_amdgcn_make_buffer_rsrc((void*)Kp, 0, 0x7fffffff, 0x00020000), rV = __builtin_amdgcn_make_buffer_rsrc((void*)Vp, 0, 0x7fffffff, 0x00020000);
#define AT_GLOAD(t) do { const int row0_ = (t) < nA ? 64 * (t) : rowB0 + 64 * ((t) - nA); const int sk_ = row0_ * ldk * 2, sv_ = row0_ * ldv * 2; \
        _Pragma("unroll") for (int i_ = 0; i_ < KRN; ++i_) kreg[i_] = __builtin_amdgcn_raw_buffer_load_b128(rK, kgo[i_] * 2, sk_, 0); \
        _Pragma("unroll") for (int i_ = 0; i_ < VRN; ++i_) vreg[i_] = __builtin_amdgcn_raw_buffer_load_b128(rV, vgo[i_] * 2, sv_, 0); } while (0)
#define AT_SWRITE(buf) do { \
        _Pragma("unroll") for (int i_ = 0; i_ < KRN; ++i_) *(LAS u32x4*)(lds + (buf) * KBUF + klo[i_]) = kreg[i_]; \
        _Pragma("unroll") for (int i_ = 0; i_ < VRN; ++i_) *(LAS u32x4*)(lds + (buf) * VBUF + vlo_[i_]) = vreg[i_]; } while (0)
    unsigned pfv = 0u, pfacc = 0u;
    const int pft = tid & 255;
    const bf16_t* pfb = (pft < 128) ? Kp + (pft >> 1) * ldk + (pft & 1) * (DQK - 2) : Vp + ((pft - 128) >> 1) * ldv + (pft & 1) * (DV - 2);
    const int pfs = (pft < 128) ? ldk : ldv;
    constexpr int PFD = 4;
#if AT_NOPF
#define AT_PF(t) do {} while (0)
#else
#define AT_PF(t) do { pfacc ^= pfv; const int tt_ = (t) < NT ? (t) : NT - 1; const int row0_ = tt_ < nA ? 64 * tt_ : rowB0 + 64 * (tt_ - nA); \
        pfv = *(const unsigned*)(pfb + (size_t)row0_ * pfs); } while (0)
#endif
#define AT_MASK(P0, P1, t) do { if (MASKED && (t) >= nA) at_mask(P0, P1, dk0 + 64 * (t)); } while (0)
#define AT_RESC(al) do { if (__any((al) < 1.f)) at_scale_o<DV>(o, scw, (al), r32, hi); } while (0)
    constexpr int DRYP = (OUTM == 2) ? PROBE_MODE : 0;
    f32x16 pA0, pA1, pB0, pB1; float alA, alB; bf16x8 pa[4];
    AT_PF(1); AT_PF(2); AT_PF(3);
    AT_GLOAD(0); AT_SWRITE(0); __syncthreads();
    AT_GLOAD(1);
    at_qkt<DQK, QL>(pA0, pA1, kb0, qf, qb); AT_MASK(pA0, pA1, 0); at_psm(pA0, pA1, mrun, alA);
    AT_SWRITE(1); __syncthreads();
    int bp = 0, bc = 1, bn = 2;
    constexpr int NMF = 2 * (DQK / 16) + 4 * (DV / 32);
#if AT_IGLP >= 0
#define AT_SCHED() __builtin_amdgcn_iglp_opt(AT_IGLP)
#elif AT_SGB
#define AT_SCHED() do { _Pragma("unroll") for (int i_ = 0; i_ < NMF; ++i_) { __builtin_amdgcn_sched_group_barrier(0x008, 1, 0); __builtin_amdgcn_sched_group_barrier(0x100, 2, 0); __builtin_amdgcn_sched_group_barrier(0x002, AT_SGB, 0); } } while (0)
#else
#define AT_SCHED() do {} while (0)
#endif
#define AT_ROT() do { bp = bc; bc = bn; bn = (bn == 2) ? 0 : bn + 1; } while (0)
    for (int j = 1; j + 1 < ((DRYP == 6) ? 2 : NT); j += 2) {
        SBAR(); if (DRYP != 5) at_qkt<DQK, QL>(pB0, pB1, kb0 + bc * KBUF, qf, qb); else { _Pragma("unroll") for (int r_ = 0; r_ < 16; ++r_) { pB0[r_] = o[0][r_] * 1e-3f; pB1[r_] = o[1][r_] * 1e-3f; } } AT_MASK(pB0, pB1, j);
        if (!(DRYP >= 1)) { AT_GLOAD(j + 1); AT_PF(j + PFD); }
        if (DRYP != 3) at_fsm(pA0, pA1, alA, lrun, pa); else at_fsm_fake(pA0, pA1, pa); SBAR();
        if (DRYP != 4) at_pv<DV>(o, vb0 + bp * VBUF, pa); else { o[0][0] += __builtin_bit_cast(float, (int)pa[0][0] + (int)pa[1][1] + (int)pa[2][2] + (int)pa[3][3]); } if (DRYP != 3) at_psm(pB0, pB1, mrun, alB); else alB = 1.f;
        AT_SCHED();
        if (!(DRYP >= 1)) AT_SWRITE(bn);
        AT_RESC(alB); if (DRYP != 2) __syncthreads(); AT_ROT();
        SBAR(); if (DRYP != 5) at_qkt<DQK, QL>(pA0, pA1, kb0 + bc * KBUF, qf, qb); else { _Pragma("unroll") for (int r_ = 0; r_ < 16; ++r_) { pA0[r_] = o[0][r_] * 1e-3f; pA1[r_] = o[1][r_] * 1e-3f; } } AT_MASK(pA0, pA1, j + 1);
        if (!(DRYP >= 1)) { AT_GLOAD(j + 2); AT_PF(j + 1 + PFD); }
        if (DRYP != 3) at_fsm(pB0, pB1, alB, lrun, pa); else at_fsm_fake(pB0, pB1, pa); SBAR();
        if (DRYP != 4) at_pv<DV>(o, vb0 + bp * VBUF, pa); else { o[0][0] += __builtin_bit_cast(float, (int)pa[0][0] + (int)pa[1][1] + (int)pa[2][2] + (int)pa[3][3]); } if (DRYP != 3) at_psm(pA0, pA1, mrun, alA); else alA = 1.f;
        AT_SCHED();
        if (!(DRYP >= 1)) AT_SWRITE(bn);
        AT_RESC(alA); if (DRYP != 2) __syncthreads(); AT_ROT();
    }
    SBAR(); at_qkt<DQK, QL>(pB0, pB1, kb0 + bc * KBUF, qf, qb); AT_MASK(pB0, pB1, NT - 1);
    at_fsm(pA0, pA1, alA, lrun, pa); SBAR();
    at_pv<DV>(o, vb0 + bp * VBUF, pa); at_psm(pB0, pB1, mrun, alB);
    AT_RESC(alB);
    at_fsm(pB0, pB1, alB, lrun, pa); SBAR();
    at_pv<DV>(o, vb0 + bc * VBUF, pa);
#undef AT_ROT
#undef AT_SCHED
    pfacc ^= pfv;
    if (__builtin_expect(pfacc == 0x9e3779b9u && lrun == 12345.678f, 0)) scw[0] = 1.f;
#undef AT_GLOAD
#undef AT_PF
#undef AT_SWRITE
#undef AT_MASK
#undef AT_RESC
    { const float lt = lrun + __shfl_xor(lrun, 32); at_scale_o<DV>(o, scw, 1.0f / lt, r32, hi); }
    if (OUTM == 0) {
#pragma unroll
        for (int db = 0; db < DV / 32; ++db) {
            bf16_t* pb = Og + (size_t)(32 * wid + 4 * hi) * ldo + 32 * db + r32;
            bf16_t zz[16];
#pragma unroll
            for (int r = 0; r < 16; ++r) zz[r] = pb[(size_t)((r & 3) + 8 * (r >> 2)) * ldo];
#pragma unroll
            for (int r = 0; r < 16; ++r) { const float z = __uint_as_float((unsigned)zz[r] << 16); pb[(size_t)((r & 3) + 8 * (r >> 2)) * ldo] = (bf16_t)(pk2(o[db][r] * silu_f(z), 0.f) & 0xffffu); }
        }
    } else {
#pragma unroll
        for (int db = 0; db < DV / 32; ++db)
#pragma unroll
            for (int r = 0; r < 16; ++r) {
                const int q = (r & 3) + 8 * (r >> 2) + 4 * hi;
                if (OUTM == 1) { Of[(size_t)(32 * wid + q) * ldof + 32 * db + r32] = o[db][r]; }
                else { if (lrun == 12345.678f) Of[(size_t)(32 * wid + q) * ldof + 32 * db + r32] = o[db][r]; }
            }
    }
    __syncthreads();
}

struct Args { const float* in[21]; float* out; unsigned char* ws; };
typedef const __attribute__((address_space(4))) Args* ArgsP;
DI ArgsP args_ptr() { ArgsP p = (ArgsP)__builtin_amdgcn_kernarg_segment_ptr(); asm volatile("" : "+s"(p)); return p; }
enum { I_X = 0, I_C, I_CTX, I_CCTX, I_WMOD, I_BMOD, I_NORMG, I_WIN, I_QNORM, I_WUQ, I_KVNORM, I_WUKV, I_LQ1, I_LK1, I_LQ2, I_LK2, I_SUBLN, I_SINK, I_WBR, I_WOUT, I_FNORM };

DI int colmap(int kind, int n) {
    if (kind == 1) {
        if (n < C_KR) return n;
        if (n < C_KR + 32) { const int e = n - C_KR; return C_KR + (e >> 1) + 16 * (e & 1); }
        if (n < C_DQ) return -1;
        if ((n >= C_DQ && n < C_DV) || (n >= C_SQ && n < C_SV)) { const int w = n & 63; return (n - w) - 96 + (w >> 1) + 32 * (w & 1); }
        return n - 96;
    }
    if (kind == 2) { const int h = n / 96, e = n % 96; if (e < 64) return n; const int e2 = e - 64; return h * 96 + 64 + (e2 >> 1) + 16 * (e2 & 1); }
    if (kind == 3) { if (n < 512) return (n >> 6) * 192 + (n & 63); const int n2 = n - 512; return (n2 >> 7) * 192 + 64 + (n2 & 127); }
    return n;
}
DI void transpose_item(const float* W, int ldw, int kind, const float* rowscale, bf16_t* WT, int ldd, int koff, LAS float* scr, int item, int nblk, int lane) {
    const int kb = item / nblk, nb = item % nblk, k0 = 64 * kb, n0 = 32 * nb;
    const int oc = colmap(kind, n0 + (lane & 31));
#pragma unroll 8
    for (int i = 0; i < 32; ++i) { const int kk = 2 * i + (lane >> 5); float v = 0.f; if (oc >= 0) v = W[(size_t)(k0 + kk) * ldw + oc]; if (rowscale) v *= rowscale[k0 + kk]; scr[kk * 33 + (lane & 31)] = v; }
    __builtin_amdgcn_wave_barrier(); asm volatile("s_waitcnt lgkmcnt(0)" ::: "memory");
    const int c = lane & 7;
#pragma unroll
    for (int j = 0; j < 4; ++j) { const int n = (lane >> 3) + 8 * j; const LAS float* s = scr + (8 * c) * 33 + n;
        u32x4 o; o.x = pk2(s[0 * 33], s[1 * 33]); o.y = pk2(s[2 * 33], s[3 * 33]); o.z = pk2(s[4 * 33], s[5 * 33]); o.w = pk2(s[6 * 33], s[7 * 33]);
        *(u32x4*)(WT + (size_t)(n0 + n) * ldd + koff + k0 + 8 * c) = o; }
    __builtin_amdgcn_wave_barrier(); asm volatile("s_waitcnt lgkmcnt(0)" ::: "memory");
}
DI void prologue(ArgsP ap, LAS unsigned char* lds) {
    const int tid = tid_l(), lane = tid & 63, wid = __builtin_amdgcn_readfirstlane(tid >> 6);
    unsigned char* ws = ap->ws;
    LAS float* scr = (LAS float*)(lds + wid * 8448);
    const int gw = bid_l() * 8 + wid, NGW = grd_l() * 8;
    constexpr int I_IN = 16 * (NP / 32), I_UQ = 6 * 24, I_UKV = 4 * 48, I_SQ = 16 * 32, PER_L = I_IN + I_UQ + I_UKV + 6 * I_SQ;
    for (int it = gw; it < 2 * PER_L; it += NGW) {
        const int l = it / PER_L; int r = it % PER_L;
        if (r < I_IN) { transpose_item(ap->in[I_WIN] + (size_t)l * 1024 * D_IN, D_IN, 1, nullptr, (bf16_t*)(ws + WS_WIN) + (size_t)l * NP * 1024, 1024, 0, scr, r, NP / 32, lane); continue; } r -= I_IN;
        if (r < I_UQ) { transpose_item(ap->in[I_WUQ] + (size_t)l * 384 * 768, 768, 2, ap->in[I_QNORM] + l * 384, (bf16_t*)(ws + WS_WUQ) + (size_t)l * 768 * 384, 384, 0, scr, r, 24, lane); continue; } r -= I_UQ;
        if (r < I_UKV) { transpose_item(ap->in[I_WUKV] + (size_t)l * 256 * 1536, 1536, 3, ap->in[I_KVNORM] + l * 256, (bf16_t*)(ws + WS_WUKV) + (size_t)l * 1536 * 256, 256, 0, scr, r, 48, lane); continue; } r -= I_UKV;
        if (r < 3 * I_SQ) { const int br = r / I_SQ; transpose_item(ap->in[I_WBR] + ((size_t)l * 3 + br) * 1024 * 1024, 1024, 0, nullptr, (bf16_t*)(ws + WS_WB) + ((size_t)l * 3 + br) * 1024 * 1024, 1024, 0, scr, r % I_SQ, 32, lane); continue; } r -= 3 * I_SQ;
        { const int rep = r / I_SQ; transpose_item(ap->in[I_WOUT] + (size_t)l * 1024 * 1024, 1024, 0, nullptr, (bf16_t*)(ws + WS_WO3) + (size_t)l * 1024 * 3072, 3072, rep * 1024, scr, r % I_SQ, 32, lane); }
    }
    const int gt = bid_l() * 512 + tid, NGT = grd_l() * 512;
    for (int i = gt; i < SEQ * 48; i += NGT) {
        const int pos = i / 48, p = i % 48; const float frow = (float)(pos >> 6), fcol = (float)(pos & 63);
        float ang; float* cd; float* sd;
        if (p < 32) { const int f = p & 15; const float inv = powf(10000.0f, -(float)f / 16.0f); ang = (p < 16 ? frow : fcol) * inv; cd = (float*)(ws + WS_COSH) + pos * 32 + p; sd = (float*)(ws + WS_SINH) + pos * 32 + p; }
        else { const int pp = p - 32, f = pp & 7; const float inv = powf(10000.0f, -(float)f / 8.0f); ang = (pp < 8 ? frow : fcol) * inv; cd = (float*)(ws + WS_COSM) + pos * 16 + pp; sd = (float*)(ws + WS_SINM) + pos * 16 + pp; }
        *cd = __cosf(ang); *sd = __sinf(ang);
    }
    for (int it = gw; it < 2 * 16 * 48; it += NGW) {
        const int l = it / 768, rem = it % 768, kc = rem / 48, nb = rem % 48; const int k = kc * 64 + lane;
        float sv[9];
#pragma unroll
        for (int v = 0; v < 8; ++v) sv[v] = silu_f(ap->in[I_C][v * 1024 + k]);
        sv[8] = silu_f(ap->in[I_CCTX][k]);
        float acc[9];
#pragma unroll
        for (int v = 0; v < 9; ++v) acc[v] = 0.f;
        const float* w = ap->in[I_WMOD] + ((size_t)l * 1024 + kc * 64) * 3072 + nb * 64 + lane;
#pragma unroll 8
        for (int kk = 0; kk < 64; ++kk) { const float wv = w[(size_t)kk * 3072];
#pragma unroll
            for (int v = 0; v < 9; ++v) acc[v] += __uint_as_float(__builtin_amdgcn_readlane(__float_as_uint(sv[v]), kk)) * wv; }
        float* mp = (float*)(ws + WS_MODP) + ((size_t)(l * 16 + kc) * 9) * 3072 + nb * 64 + lane;
#pragma unroll
        for (int v = 0; v < 9; ++v) mp[(size_t)v * 3072] = acc[v];
    }
}
DI void mod_finalize(ArgsP ap) {
    const int tid = tid_l();
    const int gt = bid_l() * 512 + tid, NGT = grd_l() * 512;
    const float* mp = (const float*)(ap->ws + WS_MODP); float* mod = (float*)(ap->ws + WS_MOD);
    for (int i = gt; i < 2 * 9 * 3072; i += NGT) {
        const int l = i / (9 * 3072), rem = i % (9 * 3072), n = rem % 3072;
        float s = ap->in[I_BMOD][l * 3072 + n];
#pragma unroll
        for (int kc = 0; kc < 16; ++kc) s += mp[(size_t)(l * 16 + kc) * 9 * 3072 + rem];
        mod[i] = s;
    }
}
DI void ph_norm_mod(ArgsP ap, int l, int g) {
    const int tid = tid_l(), lane = tid & 63, wid = __builtin_amdgcn_readfirstlane(tid >> 6);
    const int gw = bid_l() * 8 + wid, NGW = grd_l() * 8;
    const float* ng = ap->in[I_NORMG] + l * 1024; const float* mod = (const float*)(ap->ws + WS_MOD) + (size_t)l * 9 * 3072;
    const float* xs = (l == 0) ? ap->in[I_X] : ap->out; const float* cs = (l == 0) ? ap->in[I_CTX] : (const float*)(ap->ws + WS_CTX);
    bf16_t* H = (bf16_t*)(ap->ws + WS_H);
    for (int r = gw; r < R; r += NGW) {
        const int bl = r / RB, j = r % RB, b = g * GB + bl;
        const float* src; const float* md;
        if (j < CTX) { src = cs + ((size_t)b * CTX + j) * DM; md = mod + 8 * 3072; } else { src = xs + ((size_t)b * SEQ + (j - CTX)) * DM; md = mod + (size_t)b * 3072; }
        f32x4 v[4]; float ss = 0.f;
#pragma unroll
        for (int q = 0; q < 4; ++q) { v[q] = *(const f32x4*)(src + 4 * (lane + 64 * q)); ss += (v[q][0] * v[q][0] + v[q][1] * v[q][1]) + (v[q][2] * v[q][2] + v[q][3] * v[q][3]); }
        const float rstd = 1.0f / sqrtf(wave_sum(ss) * (1.0f / DM) + EPS);
#pragma unroll
        for (int q = 0; q < 4; ++q) { const int idx = 4 * (lane + 64 * q);
            const f32x4 gg = *(const f32x4*)(ng + idx), sh = *(const f32x4*)(md + idx), sc = *(const f32x4*)(md + 1024 + idx);
            const f32x4 y = (v[q] * rstd * gg) * (sc + 1.0f) + sh;
            u32x2 w; w.x = pk2(y[0], y[1]); w.y = pk2(y[2], y[3]); *(u32x2*)(H + (size_t)r * DM + idx) = w; }
    }
}
DI void ph_mla_norm(ArgsP ap) {
    const int tid = tid_l(), lane = tid & 63, wid = __builtin_amdgcn_readfirstlane(tid >> 6);
    const int gw = bid_l() * 8 + wid, NGW = grd_l() * 8;
    const bf16_t* P = (const bf16_t*)(ap->ws + WS_P); bf16_t* AQ = (bf16_t*)(ap->ws + WS_AQ); bf16_t* AKV = (bf16_t*)(ap->ws + WS_AKV); bf16_t* KM = (bf16_t*)(ap->ws + WS_KM);
    for (int r = gw; r < R; r += NGW) {
        const bf16_t* row = P + (size_t)r * NP;
        const u32x4 c0 = *(const u32x4*)(row + 8 * lane);
        u32x4 c1 = {0u, 0u, 0u, 0u}; if (lane < 20) c1 = *(const u32x4*)(row + 8 * (64 + lane));
        float f0[8] = {bflo(c0.x), bfhi(c0.x), bflo(c0.y), bfhi(c0.y), bflo(c0.z), bfhi(c0.z), bflo(c0.w), bfhi(c0.w)};
        float f1[8] = {bflo(c1.x), bfhi(c1.x), bflo(c1.y), bfhi(c1.y), bflo(c1.z), bfhi(c1.z), bflo(c1.w), bfhi(c1.w)};
        float s0 = 0.f, s1 = 0.f;
#pragma unroll
        for (int i = 0; i < 8; ++i) { s0 += f0[i] * f0[i]; s1 += f1[i] * f1[i]; }
        const float sq = wave_sum(lane < 48 ? s0 : 0.f);
        const float skv = wave_sum((lane >= 48 ? s0 : 0.f) + (lane < 16 ? s1 : 0.f));
        const float rq = 1.0f / sqrtf(sq * (1.0f / 384.0f) + EPS), rkv = 1.0f / sqrtf(skv * (1.0f / 256.0f) + EPS);
        { const float rr = lane < 48 ? rq : rkv; u32x4 w; w.x = pk2(f0[0] * rr, f0[1] * rr); w.y = pk2(f0[2] * rr, f0[3] * rr); w.z = pk2(f0[4] * rr, f0[5] * rr); w.w = pk2(f0[6] * rr, f0[7] * rr);
          if (lane < 48) *(u32x4*)(AQ + (size_t)r * 384 + 8 * lane) = w; else *(u32x4*)(AKV + (size_t)r * 256 + 8 * (lane - 48)) = w; }
        if (lane < 16) { u32x4 w; w.x = pk2(f1[0] * rkv, f1[1] * rkv); w.y = pk2(f1[2] * rkv, f1[3] * rkv); w.z = pk2(f1[4] * rkv, f1[5] * rkv); w.w = pk2(f1[6] * rkv, f1[7] * rkv);
            *(u32x4*)(AKV + (size_t)r * 256 + 8 * (16 + lane)) = w; }
        else if (lane < 20) {
#pragma unroll
            for (int h = 0; h < 8; ++h) *(u32x4*)(KM + (size_t)r * 768 + h * 96 + 64 + 8 * (lane - 16)) = c1; }
    }
}
template <bool DRYE>
DI void ph_diff_post(ArgsP ap, int l) {
    const int tid = tid_l(), lane = tid & 63, wid = __builtin_amdgcn_readfirstlane(tid >> 6);
    const int gw = bid_l() * 8 + wid, NGW = grd_l() * 8;
    const float lam_init = (l == 0) ? 0.2f : (0.8f - 0.6f * 0.7408182206817179f);
    const float d1 = wave_sum(ap->in[I_LQ1][l * 64 + lane] * ap->in[I_LK1][l * 64 + lane]), d2 = wave_sum(ap->in[I_LQ2][l * 64 + lane] * ap->in[I_LK2][l * 64 + lane]);
    const float lam = expf(d1) - expf(d2) + lam_init;
    const float sl0 = ap->in[I_SUBLN][l * 128 + 2 * lane] * (1.0f - lam_init), sl1 = ap->in[I_SUBLN][l * 128 + 2 * lane + 1] * (1.0f - lam_init);
    const float* OD = (const float*)(ap->ws + WS_OD); bf16_t* P = (bf16_t*)(ap->ws + WS_P);
    typedef float f32x2 __attribute__((ext_vector_type(2)));
    for (int r = gw; r < R; r += NGW) {
        if (l != 0 && (r % RB) < CTX) continue;
        const float* ob = OD + (size_t)r * 2048 + 2 * lane; unsigned* zb = (unsigned*)(P + (size_t)r * NP + C_Z + 1024 + 2 * lane);
        f32x2 o1[8], o2[8]; unsigned z[8];
#pragma unroll
        for (int h = 0; h < 8; ++h) { o1[h] = *(const f32x2*)(ob + (2 * h) * 128); o2[h] = *(const f32x2*)(ob + (2 * h + 1) * 128); z[h] = zb[h * 64]; }
#pragma unroll
        for (int h = 0; h < 8; ++h) {
            const float a0 = o1[h][0] - lam * o2[h][0], a1 = o1[h][1] - lam * o2[h][1];
            const float rstd = 1.0f / sqrtf(wave_sum(a0 * a0 + a1 * a1) * (1.0f / 128.0f) + EPS);
            if (!DRYE || rstd == 12345.678f) zb[h * 64] = pk2(a0 * rstd * sl0 * silu_f(bflo(z[h])), a1 * rstd * sl1 * silu_f(bfhi(z[h])));
        }
    }
}
template <bool DRYE>
DI void ph_final_norm(ArgsP ap) {
    const int tid = tid_l(), lane = tid & 63, wid = __builtin_amdgcn_readfirstlane(tid >> 6);
    const int gw = bid_l() * 8 + wid, NGW = grd_l() * 8; const float* fg = ap->in[I_FNORM];
    for (int r = gw; r < NBATCH * SEQ; r += NGW) {
        float* row = ap->out + (size_t)r * DM; f32x4 v[4]; float ss = 0.f;
#pragma unroll
        for (int q = 0; q < 4; ++q) { v[q] = *(const f32x4*)(row + 4 * (lane + 64 * q)); ss += (v[q][0] * v[q][0] + v[q][1] * v[q][1]) + (v[q][2] * v[q][2] + v[q][3] * v[q][3]); }
        const float rstd = 1.0f / sqrtf(wave_sum(ss) * (1.0f / DM) + EPS);
#pragma unroll
        for (int q = 0; q < 4; ++q) { const int idx = 4 * (lane + 64 * q); if (!DRYE || rstd == 12345.678f) *(f32x4*)(row + idx) = v[q] * rstd * *(const f32x4*)(fg + idx); }
    }
}
template <bool DRY>
DI void ph_attention(ArgsP ap, int l, LAS unsigned char* lds) {
    constexpr int OM0 = DRY ? 2 : 0;
    const int G = grd_l(), bx = bid_l(), vcu = (G % 8 == 0) ? (bx % 8) * (G / 8) + bx / 8 : bx;
    bf16_t* P = (bf16_t*)(ap->ws + WS_P); const bf16_t* QM = (const bf16_t*)(ap->ws + WS_QM); const bf16_t* KM = (const bf16_t*)(ap->ws + WS_KM); const bf16_t* VM = (const bf16_t*)(ap->ws + WS_VM);
    float* OD = (float*)(ap->ws + WS_OD); const float* sink = ap->in[I_SINK] + l * 16;
#if !defined(ATT_ONLY) || ATT_ONLY == 1
    if (!DRY || (DRY_SEL & 1))
    for (int u = vcu; u < GB * 8 * 32; u += G) { const int bh = u >> 5, qb = u & 31, bl = bh >> 3, h = bh & 7; const size_t rb = (size_t)bl * RB, q0 = rb + CTX + 256 * qb;
        attn_unit<96, 128, OM0, false>(lds, QM + q0 * 768 + h * 96, 768, KM + rb * 768 + h * 96, 768, VM + rb * 1024 + h * 128, 1024, RB / 64, 0, 0, 0, 0, NEGBIG, 0.f, P + q0 * NP + C_Z + h * 128, NP, OD, 0); }
#endif
#if !defined(ATT_ONLY) || ATT_ONLY == 2
    if (!DRY || (DRY_SEL & 2))
    for (int u = vcu; u < GB * 16 * 32; u += G) { const int bh = u >> 5, qb = u & 31, bl = bh >> 4, hm = bh & 15; const size_t rb = (size_t)bl * RB, q0 = rb + CTX + 256 * qb;
        attn_unit<64, 128, 1, false>(lds, P + q0 * NP + C_DQ + hm * 64, NP, P + rb * NP + C_DK + hm * 64, NP, P + rb * NP + C_DV + (hm >> 1) * 128, NP, RB / 64, 0, 0, 0, 0, NEGBIG, 0.f, nullptr, 0, OD + q0 * 2048 + hm * 128, 2048); }
#endif
#if !defined(ATT_ONLY) || ATT_ONLY == 3
    if (!DRY || (DRY_SEL & 4))
    for (int u = vcu; u < GB * 16 * 32; u += G) { const int bh = u >> 5, qb = u & 31, bl = bh >> 4, h = bh & 15; const size_t rb = (size_t)bl * RB, q0 = rb + CTX + 256 * qb;
        const int lo = (256 * qb - 128 < 0) ? 0 : 256 * qb - 128, hi = (256 * qb + 384 > SEQ) ? SEQ : 256 * qb + 384;
        attn_unit<64, 64, OM0, true>(lds, P + q0 * NP + C_SQ + h * 64, NP, P + rb * NP + C_SK + (h >> 2) * 64, NP, P + rb * NP + C_SV + (h >> 2) * 64, NP, CTX / 64, CTX + lo, (hi - lo) / 64, lo, 256 * qb, sink[h] * LOG2E, 1.0f,
                              P + q0 * NP + C_Z + 2048 + h * 64, NP, OD, 0); }
#endif
#if !defined(ATT_ONLY)
    if (l == 0) {
        for (int u = vcu; u < GB * 40; u += G) { const int bl = u / 40, k = u % 40; const size_t rb = (size_t)bl * RB;
            if (k < 8) { const int h = k;
                attn_unit<96, 128, OM0, false>(lds, QM + rb * 768 + h * 96, 768, KM + rb * 768 + h * 96, 768, VM + rb * 1024 + h * 128, 1024, CTX / 64, 0, 0, 0, 0, NEGBIG, 0.f, P + rb * NP + C_Z + h * 128, NP, OD, 0); }
            else if (k < 24) { const int hm = k - 8;
                attn_unit<64, 128, 1, false>(lds, P + rb * NP + C_DQ + hm * 64, NP, P + rb * NP + C_DK + hm * 64, NP, P + rb * NP + C_DV + (hm >> 1) * 128, NP, CTX / 64, 0, 0, 0, 0, NEGBIG, 0.f, nullptr, 0, OD + rb * 2048 + hm * 128, 2048); }
            else { const int h = k - 24;
                attn_unit<64, 64, OM0, false>(lds, P + rb * NP + C_SQ + h * 64, NP, P + rb * NP + C_SK + (h >> 2) * 64, NP, P + rb * NP + C_SV + (h >> 2) * 64, NP, CTX / 64, 0, 0, 0, 0, sink[h] * LOG2E, 1.0f, P + rb * NP + C_Z + 2048 + h * 64, NP, OD, 0); }
        }
    }
#endif
}

#define RLX_AGENT __ATOMIC_RELAXED, __HIP_MEMORY_SCOPE_AGENT
#define XB_TMO      128
#define XB_XCNT(j)  (256  + 64 * (j))
#define XB_XSUB(j)  (1280 + 64 * (j))
#define XB_XGEN(j)  (2304 + 64 * (j))
#define XB_TOP      3328
#define XB_TOPGEN   3392
#define XCD_BAR_WORDS 3456
#define XB_SPIN_CAP (1u << 18)

__device__ __forceinline__ unsigned xb_ld(unsigned* p)              { return __hip_atomic_load(p, __ATOMIC_RELAXED, __HIP_MEMORY_SCOPE_AGENT); }
__device__ __forceinline__ unsigned xb_add(unsigned* p, unsigned v) { return __hip_atomic_fetch_add(p, v, __ATOMIC_RELAXED, __HIP_MEMORY_SCOPE_AGENT); }
__device__ __forceinline__ unsigned xb_xcc_id() { return (unsigned)__builtin_amdgcn_s_getreg((3 << 11) | 20) & 0xFu; }
#define XB_SPIN(cond, bar) do { unsigned _sp = 0; while (cond) { __builtin_amdgcn_s_sleep(1); \
    if ((++_sp & 255u) == 0u) { if (xb_ld(&(bar)[XB_TMO])) break; if (_sp > XB_SPIN_CAP) { atomicAdd(&(bar)[XB_TMO], 1u); break; } } } } while (0)

struct XcdBarrier {
    unsigned* bar; unsigned x;
    volatile LAS unsigned* st;
};

__device__ __forceinline__ XcdBarrier xcd_barrier_post(unsigned* bar, volatile LAS unsigned* st) {
    XcdBarrier b; b.bar = bar; b.x = xb_xcc_id(); b.st = st;
    if (threadIdx.x == 0) (void)xb_add(&bar[XB_XCNT(b.x)], 1u);
    return b;
}
__device__ __forceinline__ void xcd_barrier_complete(unsigned* bar, unsigned x, unsigned& nloc, unsigned& nx) {
    const unsigned G = gridDim.x * gridDim.y * gridDim.z;
    unsigned sum, cnt, mine, sp = 0u;
    for (;;) {
        sum = 0u; cnt = 0u; mine = 0u;
#pragma unroll
        for (unsigned j = 0; j < 16; ++j) { const unsigned c = xb_ld(&bar[XB_XCNT(j)]); sum += c; cnt += (c > 0u) ? 1u : 0u; mine = (j == x) ? c : mine; }
        if (sum == G) break;
        __builtin_amdgcn_s_sleep(1);
        if ((++sp & 255u) == 0u) { if (xb_ld(&bar[XB_TMO])) break; if (sp > XB_SPIN_CAP) { atomicAdd(&bar[XB_TMO], 1u); break; } }
    }
    nloc = mine > 0u ? mine : 1u; nx = cnt > 0u ? cnt : 1u;
}

__device__ __forceinline__ void xcd_barrier(const XcdBarrier& b) {
    asm volatile("s_waitcnt vmcnt(0)" ::: "memory");
    __syncthreads();
    if (threadIdx.x == 0) {
        unsigned* bar = b.bar;
        __builtin_amdgcn_s_waitcnt(0);
        unsigned nloc = b.st[0], nx = b.st[1];
        if (nloc == 0u) { xcd_barrier_complete(bar, b.x, nloc, nx); b.st[0] = nloc; b.st[1] = nx; }
        const unsigned old = xb_add(&bar[XB_XSUB(b.x)], 1u);
        const unsigned gen = old / nloc;
        if (old + 1u == (gen + 1u) * nloc) {
            __builtin_amdgcn_fence(__ATOMIC_RELEASE, "agent");
            asm volatile("s_waitcnt vmcnt(0)" ::: "memory");
            const unsigned og = xb_add(&bar[XB_TOP], 1u);
            const unsigned tg = og / nx;
            if (og + 1u == (tg + 1u) * nx) xb_add(&bar[XB_TOPGEN], 1u);
            else XB_SPIN(xb_ld(&bar[XB_TOPGEN]) == tg, bar);
            __builtin_amdgcn_fence(__ATOMIC_ACQUIRE, "agent");
            xb_add(&bar[XB_XGEN(b.x)], 1u);
            asm volatile("s_waitcnt vmcnt(0)" ::: "memory");
        } else {
            XB_SPIN(xb_ld(&bar[XB_XGEN(b.x)]) == gen, bar);
            __builtin_amdgcn_fence(__ATOMIC_ACQUIRE, "agent");
            asm volatile("s_waitcnt vmcnt(0)" ::: "memory");
        }
    }
    __syncthreads();
}


__global__ void __launch_bounds__(512, 2) hybrid_fwd(Args a_unused) {
    extern __shared__ __attribute__((aligned(16))) unsigned char lds_raw[];
    LAS unsigned char* lds = (LAS unsigned char*)lds_raw;
    cg::grid_group grid = cg::this_grid();
    { volatile LAS unsigned* xst = (volatile LAS unsigned*)(lds + XB_LDS_OFF);
      if (threadIdx.x < 2) xst[threadIdx.x] = 0u;
      __syncthreads();
      (void)xcd_barrier_post((unsigned*)(args_ptr()->ws), xst); }
#define GSYNC() do { XcdBarrier b_; b_.bar = (unsigned*)(args_ptr()->ws); b_.x = xb_xcc_id(); b_.st = (volatile LAS unsigned*)(lds + XB_LDS_OFF); xcd_barrier(b_); } while (0)
#ifndef NO_PRO
    prologue(args_ptr(), lds);
#ifdef PROBE_PRO
    __syncthreads(); prologue(args_ptr(), lds);
#endif
#endif
    grid.sync();
    mod_finalize(args_ptr());
    GSYNC();
    for (int l = 0; l < 2; ++l) {
        for (int g = 0; g < NGRP; ++g) {
            ph_norm_mod(args_ptr(), lnd(l), lnd(g));
#ifdef PROBE_R1
            GSYNC(); ph_norm_mod(args_ptr(), lnd(l), lnd(g));
#endif
            GSYNC();
#ifndef NO_GEMM
            {
                unsigned char* ws = args_ptr()->ws; const int G = grd_l(), bx = bid_l();
                pg8::Gemm gm{1024, 1024, 1024}; pg8::Order S; S.init(R, NP, G, bx, ws + WS_H, 1024, (bf16_t*)(ws + WS_WIN) + (size_t)l * NP * 1024, 1024, 1 << 20, 0);
                EpiIn E{ws};
                pg8::gemm_phase<EpiIn, pg8::Order, true, true>(lds, gm, S, E);
#ifdef PROBE_G1
                __syncthreads(); pg8::gemm_phase<EpiIn, pg8::Order, true, true>(lds, gm, S, E);
#endif
            }
#endif
            GSYNC();
            ph_mla_norm(args_ptr());
#ifdef PROBE_R1
            GSYNC(); ph_mla_norm(args_ptr());
#endif
            GSYNC();
#ifndef NO_GEMM2
            {
                unsigned char* ws = args_ptr()->ws; const int G = grd_l(), bx = bid_l();
                pg8::Gemm gq{384, 384, 384}; pg8::Order Sq; Sq.init(R, 768, G, bx, ws + WS_AQ, 384, (bf16_t*)(ws + WS_WUQ) + (size_t)l * 768 * 384, 384, 1 << 20, 0);
                EpiQ Eq{ws};
#ifndef NO_GQ
                pg8::gemm_phase<EpiQ, pg8::Order, true, true>(lds, gq, Sq, Eq);
#ifdef PROBE_G2
                __syncthreads(); pg8::gemm_phase<EpiQ, pg8::Order, true, true>(lds, gq, Sq, Eq);
#endif
#endif
            }
            {
                unsigned char* ws = args_ptr()->ws; const int G = grd_l(), bx = bid_l();
                pg8::Gemm gk{256, 256, 256}; pg8::Order Sk; Sk.init(R, 1536, G, bx, ws + WS_AKV, 256, (bf16_t*)(ws + WS_WUKV) + (size_t)l * 1536 * 256, 256, 1 << 20, 0);
                EpiKV Ek{ws};
#ifndef NO_GK
                pg8::gemm_phase<EpiKV, pg8::Order, true, true>(lds, gk, Sk, Ek);
#ifdef PROBE_G2
                __syncthreads(); pg8::gemm_phase<EpiKV, pg8::Order, true, true>(lds, gk, Sk, Ek);
#endif
#endif
            }
#endif
            GSYNC();
#ifndef NO_ATT
#ifdef PROBE_ATT
            ph_attention<true>(args_ptr(), lnd(l), lds);
            GSYNC();
#endif
            ph_attention<false>(args_ptr(), lnd(l), lds);
#endif
            GSYNC();
#ifdef PROBE_R2
            ph_diff_post<true>(args_ptr(), lnd(l)); GSYNC();
#endif
            ph_diff_post<false>(args_ptr(), lnd(l));
            GSYNC();
#ifndef NO_BR
            {
                unsigned char* ws = args_ptr()->ws; const int G = grd_l(), bx = bid_l();
                pg8::Gemm gb{1024, NP, 1024}; pg8::Order S; S.init(R, 3072, G, bx, (bf16_t*)(ws + WS_P) + C_Z, NP, (bf16_t*)(ws + WS_WB) + (size_t)l * 3 * 1024 * 1024, 1024, 4, 1024 * 2, l != 0);
#ifdef PROBE_BR
                { EpiBrT<true> Ed{ws}; pg8::gemm_phase<EpiBrT<true>, pg8::Order, true, true>(lds, gb, S, Ed); __syncthreads(); }
#endif
                EpiBrT<false> E{ws};
                pg8::gemm_phase<EpiBrT<false>, pg8::Order, true, true>(lds, gb, S, E);
            }
#endif
            GSYNC();
#ifndef NO_OUT
            {
                ArgsP ap = args_ptr(); unsigned char* ws = ap->ws; const int G = grd_l(), bx = bid_l();
                pg8::Gemm go{3072, NP, 3072}; pg8::Order S; S.init(R, 1024, G, bx, (bf16_t*)(ws + WS_P) + C_GM, NP, (bf16_t*)(ws + WS_WO3) + (size_t)l * 1024 * 3072, 3072, 1 << 20, 0, l != 0);
#ifdef PROBE_OUT
                { EpiOutT<true> Ed{l, g, (l == 0) ? ap->in[I_X] : (const float*)ap->out, ap->out, ap->in[I_CTX], ws}; pg8::gemm_phase<EpiOutT<true>, pg8::Order, true, true>(lds, go, S, Ed); __syncthreads(); }
#endif
                EpiOutT<false> E{l, g, (l == 0) ? ap->in[I_X] : (const float*)ap->out, ap->out, ap->in[I_CTX], ws};
                pg8::gemm_phase<EpiOutT<false>, pg8::Order, true, true>(lds, go, S, E);
            }
#endif
        }
        GSYNC();
    }
#ifdef PROBE_R2
    ph_final_norm<true>(args_ptr()); GSYNC();
#endif
    ph_final_norm<false>(args_ptr());
}

extern "C" void kernel_launch(void* const* d_in, const int* in_sizes, int n_in, void* d_out, int out_size, void* d_ws, size_t ws_size, hipStream_t stream) {
    static int grid = 0;
    if (grid == 0) {
        if (n_in != 21 || ws_size < WS_END) { fprintf(stderr, "kernel_launch: expected 21 inputs and >= %zu bytes of workspace (got %d, %zu)\n", (size_t)WS_END, n_in, ws_size); grid = -1; return; }
        int dev = 0, cus = 0, per_cu = 0;
        (void)hipGetDevice(&dev); (void)hipDeviceGetAttribute(&cus, hipDeviceAttributeMultiprocessorCount, dev);
        if (hipFuncSetAttribute((const void*)hybrid_fwd, hipFuncAttributeMaxDynamicSharedMemorySize, LDS_BYTES) != hipSuccess) fprintf(stderr, "kernel_launch: hipFuncSetAttribute failed\n");
        if (hipOccupancyMaxActiveBlocksPerMultiprocessor(&per_cu, (const void*)hybrid_fwd, 512, LDS_BYTES) != hipSuccess || per_cu < 1) { per_cu = 1; (void)hipGetLastError(); }
        if (cus <= 0) cus = 256;
        grid = cus * per_cu;
    }
    if (grid < 0) return;
    Args a{};
    for (int i = 0; i < 21; ++i) a.in[i] = (const float*)d_in[i];
    a.out = (float*)d_out; a.ws = (unsigned char*)d_ws;
    (void)hipMemsetAsync(d_ws, 0, 16384, stream);
    void* args[] = {&a};
    hipError_t e = hipLaunchCooperativeKernel((const void*)hybrid_fwd, dim3(grid), dim3(512), args, LDS_BYTES, stream);
    if (e != hipSuccess) fprintf(stderr, "kernel_launch: cooperative launch failed: %s (grid %d)\n", hipGetErrorString(e), grid);
}
```

```cpp
#include <hip/hip_runtime.h>
#include <hip/hip_cooperative_groups.h>
#include <cstdio>
#include <cstdint>
namespace cg = cooperative_groups;

#define DI __device__ __forceinline__
#define LAS __attribute__((address_space(3)))
__device__ __forceinline__ int tid_l() { int t = threadIdx.x; asm volatile("" : "+v"(t)); return t; }
__device__ __forceinline__ int bid_l() { int b = blockIdx.x; asm volatile("" : "+s"(b)); return b; }
__device__ __forceinline__ int lnd(int x) { asm volatile("" : "+s"(x)); return x; }
__device__ __forceinline__ int grd_l() { int g = gridDim.x; asm volatile("" : "+s"(g)); return g; }
typedef unsigned short bf16_t;
typedef short bf16x8 __attribute__((ext_vector_type(8)));
typedef short s16x4 __attribute__((ext_vector_type(4)));
typedef float f32x4 __attribute__((ext_vector_type(4)));
typedef float f32x16 __attribute__((ext_vector_type(16)));
typedef unsigned u32x4 __attribute__((ext_vector_type(4)));
typedef unsigned u32x2 __attribute__((ext_vector_type(2)));

constexpr int DM = 1024, NBATCH = 8, SEQ = 8192, CTX = 256, RB = CTX + SEQ;
constexpr int GB = 2, NGRP = NBATCH / GB, R = GB * RB;
constexpr int NP = 11520;
constexpr int C_QC = 0, C_KVC = 384, C_KR = 640, C_DQ = 768, C_DK = 1792, C_DV = 2816, C_SQ = 3840, C_SK = 4864, C_SV = 5120, C_Z = 5376, C_GM = 8448;
constexpr int D_IN = 11424;
constexpr float EPS = 1e-6f, LOG2E = 1.4426950408889634f;
constexpr float QS64 = 0.125f * LOG2E, QS96 = 0.10206207261596575f * LOG2E;
constexpr float NEGBIG = -1e30f, THR = 8.0f;

constexpr size_t al256(size_t x) { return (x + 255) & ~(size_t)255; }
constexpr size_t WS_WIN = 1u << 20;
constexpr size_t WS_WUQ = al256(WS_WIN + (size_t)2 * NP * 1024 * 2);
constexpr size_t WS_WUKV = al256(WS_WUQ + (size_t)2 * 768 * 384 * 2);
constexpr size_t WS_WB = al256(WS_WUKV + (size_t)2 * 1536 * 256 * 2);
constexpr size_t WS_WO3 = al256(WS_WB + (size_t)2 * 3 * 1024 * 1024 * 2);
constexpr size_t WS_COSH = al256(WS_WO3 + (size_t)2 * 1024 * 3072 * 2);
constexpr size_t WS_SINH = al256(WS_COSH + (size_t)SEQ * 32 * 4);
constexpr size_t WS_COSM = al256(WS_SINH + (size_t)SEQ * 32 * 4);
constexpr size_t WS_SINM = al256(WS_COSM + (size_t)SEQ * 16 * 4);
constexpr size_t WS_MODP = al256(WS_SINM + (size_t)SEQ * 16 * 4);
constexpr size_t WS_MOD = al256(WS_MODP + (size_t)16 * 2 * 9 * 3072 * 4);
constexpr size_t WS_CTX = al256(WS_MOD + (size_t)2 * 9 * 3072 * 4);
constexpr size_t WS_H = al256(WS_CTX + (size_t)NBATCH * CTX * DM * 4);
constexpr size_t WS_P = al256(WS_H + (size_t)R * DM * 2);
constexpr size_t WS_AQ = al256(WS_P + (size_t)R * NP * 2);
constexpr size_t WS_AKV = al256(WS_AQ + (size_t)R * 384 * 2);
constexpr size_t WS_QM = al256(WS_AKV + (size_t)R * 256 * 2);
constexpr size_t WS_KM = al256(WS_QM + (size_t)R * 768 * 2);
constexpr size_t WS_VM = al256(WS_KM + (size_t)R * 768 * 2);
constexpr size_t WS_OD = al256(WS_VM + (size_t)R * 1024 * 2);
constexpr size_t WS_END = al256(WS_OD + (size_t)R * 2048 * 4);
constexpr size_t WS_PART = WS_AQ;
static_assert(WS_END <= ((size_t)1 << 30), "workspace map exceeds 1 GiB");

constexpr int LDS_BYTES = 155648, XB_LDS_OFF = 155136;

DI unsigned pk2(float lo, float hi) { typedef float f2_t __attribute__((ext_vector_type(2))); typedef __bf16 b2_t __attribute__((ext_vector_type(2)));
    f2_t v = {lo, hi}; b2_t b = __builtin_convertvector(v, b2_t); return __builtin_bit_cast(unsigned, b); }
DI u32x4 pack8(f32x4 a, f32x4 b) { u32x4 w; w.x = pk2(a[0], a[1]); w.y = pk2(a[2], a[3]); w.z = pk2(b[0], b[1]); w.w = pk2(b[2], b[3]); return w; }
DI float bflo(unsigned w) { return __uint_as_float(w << 16); }
DI float bfhi(unsigned w) { return __uint_as_float(w & 0xffff0000u); }
DI float wave_sum(float v) {
#pragma unroll
    for (int o = 1; o < 64; o <<= 1) v += __shfl_xor(v, o);
    return v; }
DI float silu_f(float z) { return z * __builtin_amdgcn_rcpf(1.0f + __expf(-z)); }
DI float sigm_f(float z) { return __builtin_amdgcn_rcpf(1.0f + __expf(-z)); }
DI void rope8(f32x4& v0, f32x4& v1, const f32x4 cs, const f32x4 sn) {
    float a, b;
    a = v0[0]; b = v0[1]; v0[0] = a * cs[0] - b * sn[0]; v0[1] = b * cs[0] + a * sn[0];
    a = v0[2]; b = v0[3]; v0[2] = a * cs[1] - b * sn[1]; v0[3] = b * cs[1] + a * sn[1];
    a = v1[0]; b = v1[1]; v1[0] = a * cs[2] - b * sn[2]; v1[1] = b * cs[2] + a * sn[2];
    a = v1[2]; b = v1[3]; v1[2] = a * cs[3] - b * sn[3]; v1[3] = b * cs[3] + a * sn[3];
}
namespace pg8 {
#define PG8_LAS __attribute__((address_space(3)))
typedef unsigned short bf16_t;
typedef short bf16x8 __attribute__((ext_vector_type(8)));
typedef float f32x4 __attribute__((ext_vector_type(4)));
typedef unsigned u32x4 __attribute__((ext_vector_type(4)));
constexpr int BM = 256, BK = 64, HALF = 128, HTB = HALF * BK * 2  , STAGE_BYTES = 8 * HTB, NXCD = 8, WGM = 8;

__host__ __device__ __forceinline__ int lds_byte(int r, int c) { const int st = (r >> 4) * 2 + (c >> 5), rr = r & 15, cc = c & 31, ob = rr * 64 + cc * 2; return st * 1024 + (ob ^ (((ob >> 9) & 1) << 5)); }
__host__ __device__ __forceinline__ void stage_rc(int b, int& R, int& C) { const int st = b / 1024, sb = b % 1024, swz = sb ^ (((sb >> 9) & 1) << 5); R = (st >> 1) * 16 + swz / 64; C = (st & 1) * 32 + (swz % 64) / 2; }
__host__ __device__ __forceinline__ int perm32(int rho) { const int n = rho >> 4, i = rho & 15; return 8 * (i >> 2) + 4 * n + (i & 3); }

struct Unit { int pm, pn; };
struct Gemm { int K, lda, ldb; };
struct Order {
    int nM, nN, nwg, G, c; const char* A; const char* B; unsigned tA, tB; int pnblk; unsigned ablk; int skipctx;
    __device__ __forceinline__ void init(int M, int N, int G_, int c_, const void* A_, int lda, const void* B_, int ldb, int pnblk_, unsigned ablk_, int skipctx_ = 0) {
        skipctx = skipctx_; nM = M / BM; if (skipctx) nM -= nM / 33;
        nN = N / BM; nwg = nM * nN; G = G_; c = c_; A = (const char*)A_; B = (const char*)B_; tA = (unsigned)(BM * lda * 2); tB = (unsigned)(BM * ldb * 2); pnblk = pnblk_; ablk = ablk_; }
    __device__ __forceinline__ bool next(int i, Unit& u) const {
        const long L = (long)i * G + c; if (L >= nwg) return false;
        int wgid = (int)L; { const int q = nwg / NXCD, r = nwg % NXCD, xcd = wgid % NXCD, off = wgid / NXCD; wgid = (xcd < r ? xcd * (q + 1) : r * (q + 1) + (xcd - r) * q) + off; }
        const int nig = WGM * nN, gid = wgid / nig, fm = gid * WGM, gsz = (nM - fm) < WGM ? (nM - fm) : WGM;
        u.pm = fm + ((wgid % nig) % gsz); u.pn = (wgid % nig) / gsz; if (skipctx) u.pm += u.pm / 32 + 1; return true;
    }
    __device__ __forceinline__ const char* a_base(const Unit& u) const { return A + (size_t)u.pm * tA + (size_t)(u.pn / pnblk) * ablk; }
    __device__ __forceinline__ const char* b_base(const Unit& u) const { return B + (size_t)u.pn * tB; }
};

template <class Epi, class Sched, bool ALIGN_EPI = false, bool SP2 = false>
__device__ __forceinline__ void gemm_phase(PG8_LAS unsigned char* lds, const Gemm g, const Sched& S, const Epi& E) {
    const int tid = tid_l(), wid = __builtin_amdgcn_readfirstlane(tid >> 6), lane = tid & 63, wr = wid >> 2, wc = wid & 3, fr = lane & 15, fq = lane >> 4;
    const int K = g.K, nt = K / BK;
    unsigned voffA[2], voffB[2];
#pragma unroll
    for (int i = 0; i < 2; ++i) { int R, C; stage_rc(tid * 16 + i * 8192, R, C); const int Rb = Epi::PERM ? ((R & ~31) + perm32(R & 31)) : R;
        voffA[i] = (unsigned)(R * g.lda + C) * 2u; voffB[i] = (unsigned)(Rb * g.ldb + C) * 2u; }
    const size_t kstep = (size_t)(BK * 2);
    const size_t hstepA = (size_t)HALF * g.lda * 2, hstepB = (size_t)HALF * g.ldb * 2;
    const unsigned ldsw = (unsigned)wid * 1024u;
    const int aoff = lds_byte(wr * 64 + fr, fq * 8), boff = lds_byte(wc * 32 + fr, fq * 8);
#define PG8_SA(b, h) (((b) * 2 + (h)) * HTB)
#define PG8_SB(b, h) ((4 + (b) * 2 + (h)) * HTB)
#define PG8_STAGE(bufoff, gbase, voff) do { _Pragma("unroll") for (int _i = 0; _i < 2; ++_i) \
        __builtin_amdgcn_global_load_lds((const unsigned*)((const char*)(gbase) + (voff)[_i]), (PG8_LAS unsigned*)(lds + (bufoff) + ldsw + _i * 8192), 16, 0, 0); } while (0)
#define PG8_LDA(dst, b, h) do { _Pragma("unroll") for (int m = 0; m < 4; ++m) _Pragma("unroll") for (int k = 0; k < 2; ++k) dst[m][k] = *(const PG8_LAS bf16x8*)(lds + PG8_SA(b, h) + aoff + m * 2048 + k * 1024); } while (0)
#define PG8_LDB(dst, b, h) do { _Pragma("unroll") for (int n = 0; n < 2; ++n) _Pragma("unroll") for (int k = 0; k < 2; ++k) dst[n][k] = *(const PG8_LAS bf16x8*)(lds + PG8_SB(b, h) + boff + n * 2048 + k * 1024); } while (0)
#define PG8_MMA(ai, bj, At, Bt) do { __builtin_amdgcn_s_setprio(1); _Pragma("unroll") for (int m = 0; m < 4; ++m) _Pragma("unroll") for (int n = 0; n < 2; ++n) _Pragma("unroll") for (int k = 0; k < 2; ++k) \
        acc[ai][bj][m][n] = __builtin_amdgcn_mfma_f32_16x16x32_bf16(Bt[n][k], At[m][k], acc[ai][bj][m][n], 0, 0, 0); __builtin_amdgcn_s_setprio(0); } while (0)
#define PG8_WAIT_V(n) asm volatile("s_waitcnt vmcnt(" #n ")" ::: "memory")
#define PG8_WAIT_L(n) asm volatile("s_waitcnt lgkmcnt(" #n ")" ::: "memory")
#define PG8_BAR __builtin_amdgcn_s_barrier()
#define PG8_SCHED __builtin_amdgcn_sched_barrier(0)
    Unit cur, nxt; int ui = 0;
    if (!S.next(0, cur)) return;
    f32x4 acc[2][2][4][2];
#pragma unroll
    for (int a = 0; a < 2; ++a)
#pragma unroll
        for (int b = 0; b < 2; ++b)
#pragma unroll
            for (int m = 0; m < 4; ++m)
#pragma unroll
                for (int n = 0; n < 2; ++n) acc[a][b][m][n] = (f32x4){0.f, 0.f, 0.f, 0.f};
    bf16x8 At[4][2], B0[2][2], B1[2][2];
    const char* cA = S.a_base(cur); const char* cB = S.b_base(cur);

    if constexpr (SP2) {
        PG8_STAGE(PG8_SB(0, 0), cB, voffB); PG8_STAGE(PG8_SB(0, 1), cB + hstepB, voffB); PG8_STAGE(PG8_SA(0, 0), cA, voffA); PG8_STAGE(PG8_SA(0, 1), cA + hstepA, voffA);
        if (wr == 1) PG8_BAR;
        PG8_WAIT_V(2); PG8_BAR;
        PG8_STAGE(PG8_SB(1, 0), cB + kstep, voffB); PG8_STAGE(PG8_SA(1, 0), cA + kstep, voffA); PG8_STAGE(PG8_SB(1, 1), cB + hstepB + kstep, voffB);
        PG8_WAIT_V(6); PG8_BAR;
    } else {
        PG8_STAGE(PG8_SB(0, 0), cB, voffB); PG8_STAGE(PG8_SA(0, 0), cA, voffA); PG8_STAGE(PG8_SB(0, 1), cB + hstepB, voffB); PG8_STAGE(PG8_SA(0, 1), cA + hstepA, voffA);
        if (wr == 1) PG8_BAR;
        PG8_WAIT_V(4); PG8_BAR;
        PG8_STAGE(PG8_SB(1, 0), cB + kstep, voffB); PG8_STAGE(PG8_SA(1, 0), cA + kstep, voffA); PG8_STAGE(PG8_SB(1, 1), cB + hstepB + kstep, voffB);
        PG8_WAIT_V(6); PG8_BAR;
    }
    for (;;) {
        const bool has_next = S.next(ui + 1, nxt);
        const char* nA = has_next ? S.a_base(nxt) : cA; const char* nB = has_next ? S.b_base(nxt) : cB;
#pragma nounroll
        for (int t = 0; t < nt; t += 2) {
            const bool last = (t == nt - 2);
            const char* a1 = cA + (size_t)(t + 1) * kstep;
            const char* a2 = last ? nA : cA + (size_t)(t + 2) * kstep; const char* b2 = last ? nB : cB + (size_t)(t + 2) * kstep;
            const char* a3 = a2 + kstep; const char* b3 = b2 + kstep;

            if constexpr (SP2) {
            PG8_LDB(B0, 0, 0); PG8_LDB(B1, 0, 1); PG8_SCHED; PG8_LDA(At, 0, 0); PG8_STAGE(PG8_SA(1, 1), a1 + hstepA, voffA);
            PG8_WAIT_V(8); PG8_WAIT_L(0); PG8_BAR; PG8_MMA(0, 0, At, B0); PG8_MMA(0, 1, At, B1); PG8_BAR; PG8_SCHED;
            PG8_LDA(At, 0, 1); PG8_STAGE(PG8_SB(0, 0), b2, voffB); PG8_STAGE(PG8_SB(0, 1), b2 + hstepB, voffB); PG8_STAGE(PG8_SA(0, 0), a2, voffA);
            PG8_WAIT_V(8); PG8_WAIT_L(0); PG8_BAR; PG8_MMA(1, 0, At, B0); PG8_MMA(1, 1, At, B1); PG8_BAR; PG8_SCHED;
            PG8_LDB(B0, 1, 0); PG8_LDB(B1, 1, 1); PG8_SCHED; PG8_LDA(At, 1, 0); PG8_STAGE(PG8_SA(0, 1), a2 + hstepA, voffA);
            PG8_WAIT_V(8); PG8_WAIT_L(0); PG8_BAR; PG8_MMA(0, 0, At, B0); PG8_MMA(0, 1, At, B1); PG8_BAR; PG8_SCHED;
            PG8_LDA(At, 1, 1); PG8_STAGE(PG8_SB(1, 0), b3, voffB); PG8_STAGE(PG8_SB(1, 1), b3 + hstepB, voffB); PG8_STAGE(PG8_SA(1, 0), a3, voffA);
            PG8_WAIT_V(8); PG8_WAIT_L(0); PG8_BAR; PG8_MMA(1, 0, At, B0); PG8_MMA(1, 1, At, B1); PG8_BAR; PG8_SCHED;
            } else {
            PG8_LDB(B0, 0, 0); PG8_SCHED; PG8_LDA(At, 0, 0); PG8_STAGE(PG8_SA(1, 1), a1 + hstepA, voffA);
            PG8_WAIT_L(8); PG8_BAR; PG8_WAIT_L(0); PG8_MMA(0, 0, At, B0); PG8_BAR; PG8_SCHED;
            PG8_LDB(B1, 0, 1); PG8_STAGE(PG8_SB(0, 0), b2, voffB);
            PG8_BAR; PG8_WAIT_L(0); PG8_MMA(0, 1, At, B1); PG8_BAR;
            PG8_LDA(At, 0, 1); PG8_STAGE(PG8_SA(0, 0), a2, voffA);
            PG8_BAR; PG8_WAIT_L(0); PG8_MMA(1, 0, At, B0); PG8_BAR; PG8_SCHED;
            PG8_STAGE(PG8_SB(0, 1), b2 + hstepB, voffB);
            PG8_WAIT_V(6); PG8_BAR; PG8_MMA(1, 1, At, B1); PG8_BAR;
            PG8_LDB(B0, 1, 0); PG8_SCHED; PG8_LDA(At, 1, 0); PG8_STAGE(PG8_SA(0, 1), a2 + hstepA, voffA);
            PG8_WAIT_L(8); PG8_BAR; PG8_WAIT_L(0); PG8_MMA(0, 0, At, B0); PG8_BAR; PG8_SCHED;
            PG8_LDB(B1, 1, 1); PG8_STAGE(PG8_SB(1, 0), b3, voffB);
            PG8_BAR; PG8_WAIT_L(0); PG8_MMA(0, 1, At, B1); PG8_BAR;
            PG8_LDA(At, 1, 1); PG8_STAGE(PG8_SA(1, 0), a3, voffA);
            PG8_BAR; PG8_WAIT_L(0); PG8_MMA(1, 0, At, B0); PG8_BAR; PG8_SCHED;
            PG8_STAGE(PG8_SB(1, 1), b3 + hstepB, voffB);
            PG8_WAIT_V(6); PG8_BAR; PG8_MMA(1, 1, At, B1); PG8_BAR;
            }
        }
        if constexpr (ALIGN_EPI) { if (wr == 0) PG8_BAR; }
        if constexpr (!Epi::AFTER_DRAIN) { E(acc, cur, wr, wc, fr, fq); }
        if (!has_next) break;
#pragma unroll
        for (int a = 0; a < 2; ++a)
#pragma unroll
            for (int b = 0; b < 2; ++b)
#pragma unroll
                for (int m = 0; m < 4; ++m)
#pragma unroll
                    for (int n = 0; n < 2; ++n) acc[a][b][m][n] = (f32x4){0.f, 0.f, 0.f, 0.f};
        cur = nxt; cA = nA; cB = nB; ++ui;
        if constexpr (ALIGN_EPI) { if (wr == 1) PG8_BAR; }
    }
    PG8_WAIT_V(0);
    if constexpr (!ALIGN_EPI) { if (wr == 0) PG8_BAR; }
    PG8_BAR;
    if constexpr (Epi::AFTER_DRAIN) { E.fused(acc, cur, wr, wc, fr, fq, lds, wid, lane); }
#undef PG8_SA
#undef PG8_SB
#undef PG8_STAGE
#undef PG8_LDA
#undef PG8_LDB
#undef PG8_MMA
#undef PG8_WAIT_V
#undef PG8_WAIT_L
#undef PG8_BAR
#undef PG8_SCHED
}
}
struct EpiIn {
    static constexpr bool PERM = true, AFTER_DRAIN = false;
    unsigned char* ws;
    DI void operator()(const f32x4 (&acc)[2][2][4][2], const pg8::Unit& u, int wr, int wc, int fr, int fq) const {
        bf16_t* P = (bf16_t*)(ws + WS_P); const float* cosH = (const float*)(ws + WS_COSH); const float* sinH = (const float*)(ws + WS_SINH); const float* cosM = (const float*)(ws + WS_COSM); const float* sinM = (const float*)(ws + WS_SINM);
        const int pn = u.pn; const bool ctxt = (u.pm % 33) == 0;
        int mode = 0; float sc = 1.f;
        if ((pn >= 3 && pn <= 10) || (pn >= 15 && pn <= 19)) mode = 1;
        if (pn == 2) mode = 2;
        if ((pn >= 3 && pn <= 6) || (pn >= 15 && pn <= 18)) sc = QS64;
        if (ctxt) mode = 0;
        const int rowt = u.pm * 256 + wr * 64 + fr, colb = pn * 256 + wc * 32 + 8 * fq;
#pragma unroll
        for (int ai = 0; ai < 2; ++ai)
#pragma unroll
            for (int m = 0; m < 4; ++m) {
                const int row = rowt + ai * 128 + m * 16; const int pos = (row % RB) - CTX;
                bf16_t* rowp = P + (size_t)row * NP;
#pragma unroll
                for (int bj = 0; bj < 2; ++bj) {
                    const int col0 = colb + bj * 128;
                    f32x4 v0 = acc[ai][bj][m][0], v1 = acc[ai][bj][m][1];
                    if (pn <= 2) {
                        float s8 = (v0[0] * v0[0] + v0[1] * v0[1]) + (v0[2] * v0[2] + v0[3] * v0[3]) + (v1[0] * v1[0] + v1[1] * v1[1]) + (v1[2] * v1[2] + v1[3] * v1[3]);
                        s8 += __shfl_xor(s8, 16); s8 += __shfl_xor(s8, 32);
                        const int slice = pn * 8 + bj * 4 + wc;
                        if (fq == 0 && slice < 20) ((float*)(ws + WS_PART))[(size_t)row * 20 + slice] = s8;
                    }
                    if (mode == 1) { const int p0 = (col0 & 63) >> 1; const f32x4 cs = *(const f32x4*)(cosH + (size_t)pos * 32 + p0), sn = *(const f32x4*)(sinH + (size_t)pos * 32 + p0); rope8(v0, v1, cs, sn); }
                    else if (mode == 2 && col0 >= C_KR && col0 < C_KR + 32) { const int p0 = (col0 - C_KR) >> 1; const f32x4 cs = *(const f32x4*)(cosM + (size_t)pos * 16 + p0), sn = *(const f32x4*)(sinM + (size_t)pos * 16 + p0); rope8(v0, v1, cs, sn); }
                    v0 = v0 * sc; v1 = v1 * sc;
                    const u32x4 w8 = pack8(v0, v1);
                    *(u32x4*)(rowp + col0) = w8;
                    if (pn == 2 && col0 >= C_KR && col0 < C_KR + 32) {
                        bf16_t* km = (bf16_t*)(ws + WS_KM) + (size_t)row * 768 + 64 + (col0 - C_KR);
#pragma unroll
                        for (int h = 0; h < 8; ++h) *(u32x4*)(km + h * 96) = w8;
                    }
                }
            }
    }
};
struct EpiQ {
    static constexpr bool PERM = true, AFTER_DRAIN = false;
    unsigned char* ws;
    DI void operator()(const f32x4 (&acc)[2][2][4][2], const pg8::Unit& u, int wr, int wc, int fr, int fq) const {
        bf16_t* QM = (bf16_t*)(ws + WS_QM); const float* cosM = (const float*)(ws + WS_COSM); const float* sinM = (const float*)(ws + WS_SINM);
        const bool ctxt = (u.pm % 33) == 0;
        const int rowt = u.pm * 256 + wr * 64 + fr, colb = u.pn * 256 + wc * 32 + 8 * fq;
#pragma unroll
        for (int ai = 0; ai < 2; ++ai)
#pragma unroll
            for (int m = 0; m < 4; ++m) {
                const int row = rowt + ai * 128 + m * 16; const int pos = (row % RB) - CTX;
                const float* pr = (const float*)(ws + WS_PART) + (size_t)row * 20;
                const f32x4 q0 = *(const f32x4*)pr, q1 = *(const f32x4*)(pr + 4), q2 = *(const f32x4*)(pr + 8);
                const float rq = QS96 / sqrtf((((q0[0] + q0[1]) + (q0[2] + q0[3])) + ((q1[0] + q1[1]) + (q1[2] + q1[3])) + ((q2[0] + q2[1]) + (q2[2] + q2[3]))) * (1.0f / 384.0f) + EPS);
#pragma unroll
                for (int bj = 0; bj < 2; ++bj) {
                    const int col0 = colb + bj * 128, within = col0 % 96;
                    f32x4 v0 = acc[ai][bj][m][0], v1 = acc[ai][bj][m][1];
                    if (!ctxt && within >= 64) { const int p0 = (within - 64) >> 1; const f32x4 cs = *(const f32x4*)(cosM + (size_t)pos * 16 + p0), sn = *(const f32x4*)(sinM + (size_t)pos * 16 + p0); rope8(v0, v1, cs, sn); }
                    v0 = v0 * rq; v1 = v1 * rq;
                    *(u32x4*)(QM + (size_t)row * 768 + col0) = pack8(v0, v1);
                }
                asm volatile("" ::: "memory");
            }
    }
};
struct EpiKV {
    static constexpr bool PERM = true, AFTER_DRAIN = false;
    unsigned char* ws;
    DI void operator()(const f32x4 (&acc)[2][2][4][2], const pg8::Unit& u, int wr, int wc, int fr, int fq) const {
        bf16_t* KM = (bf16_t*)(ws + WS_KM); bf16_t* VM = (bf16_t*)(ws + WS_VM);
        const int rowt = u.pm * 256 + wr * 64 + fr, colb = u.pn * 256 + wc * 32 + 8 * fq;
#pragma unroll
        for (int ai = 0; ai < 2; ++ai)
#pragma unroll
            for (int m = 0; m < 4; ++m) {
                const int row = rowt + ai * 128 + m * 16;
                const float* pr = (const float*)(ws + WS_PART) + (size_t)row * 20 + 12;
                const f32x4 k0 = *(const f32x4*)pr, k1 = *(const f32x4*)(pr + 4);
                const float rkv = 1.0f / sqrtf((((k0[0] + k0[1]) + (k0[2] + k0[3])) + ((k1[0] + k1[1]) + (k1[2] + k1[3]))) * (1.0f / 256.0f) + EPS);
#pragma unroll
                for (int bj = 0; bj < 2; ++bj) {
                    const int col0 = colb + bj * 128;
                    bf16_t* dst = (col0 < 512) ? KM + (size_t)row * 768 + (col0 >> 6) * 96 + (col0 & 63) : VM + (size_t)row * 1024 + (col0 - 512);
                    *(u32x4*)dst = pack8(acc[ai][bj][m][0] * rkv, acc[ai][bj][m][1] * rkv);
                }
                asm volatile("" ::: "memory");
            }
    }
};
template <bool DRYE> struct EpiBrT {
    static constexpr bool PERM = true, AFTER_DRAIN = false;
    unsigned char* ws;
    DI void operator()(const f32x4 (&acc)[2][2][4][2], const pg8::Unit& u, int wr, int wc, int fr, int fq) const {
        bf16_t* P = (bf16_t*)(ws + WS_P);
        unsigned chk = 0u;
        const int rowt = u.pm * 256 + wr * 64 + fr, colb = u.pn * 256 + wc * 32 + 8 * fq;
#pragma unroll
        for (int ai = 0; ai < 2; ++ai)
#pragma unroll
            for (int m = 0; m < 4; ++m) {
                const int row = rowt + ai * 128 + m * 16;
#pragma unroll
                for (int bj = 0; bj < 2; ++bj) {
                    bf16_t* p = P + (size_t)row * NP + C_GM + colb + bj * 128;
                    const u32x4 g = *(const u32x4*)p;
                    f32x4 v0 = acc[ai][bj][m][0], v1 = acc[ai][bj][m][1];
                    v0[0] *= sigm_f(bflo(g.x)); v0[1] *= sigm_f(bfhi(g.x)); v0[2] *= sigm_f(bflo(g.y)); v0[3] *= sigm_f(bfhi(g.y));
                    v1[0] *= sigm_f(bflo(g.z)); v1[1] *= sigm_f(bfhi(g.z)); v1[2] *= sigm_f(bflo(g.w)); v1[3] *= sigm_f(bfhi(g.w));
                    { const u32x4 w_ = pack8(v0, v1); if (!DRYE) *(u32x4*)p = w_; else chk ^= w_.x ^ w_.y ^ w_.z ^ w_.w; }
                }
            }
        if (DRYE && chk == 0x12345678u) *(unsigned*)P = chk;
    }
};
template <bool DRYE> struct EpiOutT {
    static constexpr bool PERM = true, AFTER_DRAIN = false;
    int l, g; const float* xsrc; float* xdst; const float* ctxsrc; unsigned char* ws;
    DI void operator()(const f32x4 (&acc)[2][2][4][2], const pg8::Unit& u, int wr, int wc, int fr, int fq) const {
        float* ctxdst = (float*)(ws + WS_CTX); const float* mod = (const float*)(ws + WS_MOD) + (size_t)l * 9 * 3072;
        const int pmb = u.pm % 33, b = g * GB + u.pm / 33; const bool ctxt = pmb == 0;
        if (ctxt && l != 0) return;
        const float* gate = mod + (size_t)(ctxt ? 8 : b) * 3072 + 2048;
        const int colb = u.pn * 256 + wc * 32 + 8 * fq;
#pragma unroll
        for (int ai = 0; ai < 2; ++ai)
#pragma unroll
            for (int m = 0; m < 4; ++m) {
                const int j = pmb * 256 + ai * 128 + wr * 64 + m * 16 + fr;
                const size_t idx = ctxt ? ((size_t)b * CTX + j) * DM : ((size_t)b * SEQ + (j - CTX)) * DM;
                const float* s = (ctxt ? ctxsrc : xsrc) + idx; float* d = (ctxt ? ctxdst : xdst) + idx;
#pragma unroll
                for (int bj = 0; bj < 2; ++bj) {
                    const int col0 = colb + bj * 128;
                    const f32x4 g0 = *(const f32x4*)(gate + col0), g1 = *(const f32x4*)(gate + col0 + 4);
                    const f32x4 x0 = *(const f32x4*)(s + col0), x1 = *(const f32x4*)(s + col0 + 4);
                    if (!DRYE || x0[0] == 12345.678f) { *(f32x4*)(d + col0) = x0 + g0 * acc[ai][bj][m][0];
                    *(f32x4*)(d + col0 + 4) = x1 + g1 * acc[ai][bj][m][1]; }
                }
            }
    }
};

#define MFMA32(a, b, c) __builtin_amdgcn_mfma_f32_32x32x16_bf16((a), (b), (c), 0, 0, 0)
DI s16x4 tr16(const LAS unsigned char* p) { typedef short v4i16_t __attribute__((ext_vector_type(4))); return __builtin_bit_cast(s16x4, __builtin_amdgcn_ds_read_tr16_b64_v4i16((LAS v4i16_t*)p)); }
constexpr int AT_KOFF = 0, AT_KBUFMAX = 13312, AT_VOFF = 3 * AT_KBUFMAX, AT_VBUFMAX = 20480, AT_SOFF = AT_VOFF + 3 * AT_VBUFMAX, AT_QOFF = AT_SOFF + 1024;
static_assert(AT_QOFF + 8 * 6144 <= LDS_BYTES, "attention LDS map");
#ifndef AT_NOPF
#define AT_NOPF 1
#endif
#ifndef AT_IGLP
#define AT_IGLP -1
#endif
#ifndef AT_QLMIN
#define AT_QLMIN 64
#endif
#ifndef AT_PVKS
#define AT_PVKS 1
#endif
#ifndef AT_SGB
#define AT_SGB 0
#endif
#ifndef AT_PV8
#define AT_PV8 1
#endif
#ifndef AT_NOSBAR
#define AT_NOSBAR 1
#endif
#if AT_NOSBAR
#define SBAR() do {} while (0)
#else
#define SBAR() __builtin_amdgcn_sched_barrier(0)
#endif
#ifndef PROBE_MODE
#define PROBE_MODE 0
#endif
#ifndef DRY_SEL
#define DRY_SEL 7
#endif
#ifndef AT_QL
#define AT_QL 1
#endif
#ifndef AT_SB
#define AT_SB 0
#endif
template <int DQK, bool QL>
DI void at_qkt(f32x16& p0, f32x16& p1, const LAS unsigned char* kb, const bf16x8* qf, const LAS unsigned char* qb) {
    constexpr int KSTR = DQK + 8;
#pragma unroll
    for (int r = 0; r < 16; ++r) { p0[r] = 0.f; p1[r] = 0.f; }
#pragma unroll
    for (int ds = 0; ds < DQK / 16; ++ds) {
        const bf16x8 k0 = *(const LAS bf16x8*)(kb + ds * 32), k1 = *(const LAS bf16x8*)(kb + 32 * (KSTR * 2) + ds * 32);
        bf16x8 q; if (QL) q = *(const LAS bf16x8*)(qb + ds * 1024); else q = qf[ds];
        p0 = MFMA32(k0, q, p0); p1 = MFMA32(k1, q, p1);
        if (AT_SB && DQK > 64 && (ds & 1)) __builtin_amdgcn_sched_barrier(0x7f); }
}
DI void at_mask(f32x16& p0, f32x16& p1, int dk) {
#pragma unroll
    for (int r = 0; r < 16; ++r) { const int d = dk + (r & 3) + 8 * (r >> 2);
        if (d > 128 || d < -128) p0[r] = NEGBIG;
        if (d + 32 > 128 || d + 32 < -128) p1[r] = NEGBIG; }
}
DI void at_psm(f32x16& p0, f32x16& p1, float& mrun, float& alpha) {
    float ma = fmaxf(fmaxf(p0[0], p0[1]), p0[2]), mb = fmaxf(fmaxf(p1[0], p1[1]), p1[2]);
    ma = fmaxf(fmaxf(ma, p0[3]), p1[3]);
#pragma unroll
    for (int r = 4; r < 16; r += 2) { ma = fmaxf(fmaxf(ma, p0[r]), p0[r + 1]); mb = fmaxf(fmaxf(mb, p1[r]), p1[r + 1]); }
    float mx = fmaxf(ma, mb);
    { auto rr = __builtin_amdgcn_permlane32_swap(__float_as_uint(mx), __float_as_uint(mx), false, false); mx = fmaxf(__uint_as_float(rr[0]), __uint_as_float(rr[1])); }
    const bool keep = __all(mx - mrun <= THR);
    const float mn = keep ? mrun : fmaxf(mrun, mx); alpha = __builtin_amdgcn_exp2f(mrun - mn); mrun = mn;
#pragma unroll
    for (int r = 0; r < 16; ++r) { p0[r] -= mrun; p1[r] -= mrun; }
#pragma unroll
    for (int r = 0; r < 16; ++r) p0[r] = __builtin_amdgcn_exp2f(p0[r]);
}
DI void at_fsm(f32x16& p0, f32x16& p1, float alpha, float& lrun, bf16x8* pa) {
#pragma unroll
    for (int r = 0; r < 16; ++r) p1[r] = __builtin_amdgcn_exp2f(p1[r]);
    float ps = 0.f;
#pragma unroll
    for (int r = 0; r < 16; ++r) ps += p0[r] + p1[r];
    lrun = lrun * alpha + ps;
    u32x4 w;
    w.x = pk2(p0[0], p0[1]); w.y = pk2(p0[2], p0[3]); w.z = pk2(p0[4], p0[5]); w.w = pk2(p0[6], p0[7]); pa[0] = __builtin_bit_cast(bf16x8, w);
    w.x = pk2(p0[8], p0[9]); w.y = pk2(p0[10], p0[11]); w.z = pk2(p0[12], p0[13]); w.w = pk2(p0[14], p0[15]); pa[1] = __builtin_bit_cast(bf16x8, w);
    w.x = pk2(p1[0], p1[1]); w.y = pk2(p1[2], p1[3]); w.z = pk2(p1[4], p1[5]); w.w = pk2(p1[6], p1[7]); pa[2] = __builtin_bit_cast(bf16x8, w);
    w.x = pk2(p1[8], p1[9]); w.y = pk2(p1[10], p1[11]); w.z = pk2(p1[12], p1[13]); w.w = pk2(p1[14], p1[15]); pa[3] = __builtin_bit_cast(bf16x8, w);
}
DI void at_fsm_fake(f32x16& p0, f32x16& p1, bf16x8* pa) {
    u32x4 w;
    w.x = pk2(p0[0], p0[1]); w.y = pk2(p0[2], p0[3]); w.z = pk2(p0[4], p0[5]); w.w = pk2(p0[6], p0[7]); pa[0] = __builtin_bit_cast(bf16x8, w);
    w.x = pk2(p0[8], p0[9]); w.y = pk2(p0[10], p0[11]); w.z = pk2(p0[12], p0[13]); w.w = pk2(p0[14], p0[15]); pa[1] = __builtin_bit_cast(bf16x8, w);
    w.x = pk2(p1[0], p1[1]); w.y = pk2(p1[2], p1[3]); w.z = pk2(p1[4], p1[5]); w.w = pk2(p1[6], p1[7]); pa[2] = __builtin_bit_cast(bf16x8, w);
    w.x = pk2(p1[8], p1[9]); w.y = pk2(p1[10], p1[11]); w.z = pk2(p1[12], p1[13]); w.w = pk2(p1[14], p1[15]); pa[3] = __builtin_bit_cast(bf16x8, w);
}
template <int DV>
DI void at_pv(f32x16* o, const LAS unsigned char* vb, const bf16x8* pa) {
    constexpr int VSTR = DV + 32;
#if AT_PVKS
#pragma unroll
    for (int ks = 0; ks < 4; ++ks) {
        s16x4 vlo[DV / 32], vhi[DV / 32];
#pragma unroll
        for (int db = 0; db < DV / 32; ++db) { vlo[db] = tr16(vb + (16 * ks) * (VSTR * 2) + db * 64); vhi[db] = tr16(vb + (16 * ks + 8) * (VSTR * 2) + db * 64); }
#pragma unroll
        for (int db = 0; db < DV / 32; ++db) { const bf16x8 vf = __builtin_shufflevector(vlo[db], vhi[db], 0, 1, 2, 3, 4, 5, 6, 7); o[db] = MFMA32(pa[ks], vf, o[db]); }
    }
#else
#pragma unroll
    for (int db = 0; db < DV / 32; ++db) {
        s16x4 vlo[4], vhi[4];
#pragma unroll
        for (int ks = 0; ks < 4; ++ks) { vlo[ks] = tr16(vb + (16 * ks) * (VSTR * 2) + db * 64); vhi[ks] = tr16(vb + (16 * ks + 8) * (VSTR * 2) + db * 64); }
#pragma unroll
        for (int ks = 0; ks < 4; ++ks) { const bf16x8 vf = __builtin_shufflevector(vlo[ks], vhi[ks], 0, 1, 2, 3, 4, 5, 6, 7); o[db] = MFMA32(pa[ks], vf, o[db]); }
    }
#endif
}
template <int DV>
DI void at_scale_o(f32x16* o, LAS float* scw, float val, int r32, int hi) {
    if (hi == 0) scw[r32] = val;
    __builtin_amdgcn_wave_barrier(); asm volatile("" ::: "memory");
#pragma unroll
    for (int g4 = 0; g4 < 4; ++g4) { const f32x4 a4 = *(const LAS f32x4*)(scw + 8 * g4 + 4 * hi);
#pragma unroll
        for (int db = 0; db < DV / 32; ++db) { o[db][4 * g4 + 0] *= a4[0]; o[db][4 * g4 + 1] *= a4[1]; o[db][4 * g4 + 2] *= a4[2]; o[db][4 * g4 + 3] *= a4[3]; } }
    __builtin_amdgcn_wave_barrier(); asm volatile("" ::: "memory");
}
template <int DQK, int DV, int OUTM, bool MASKED>
DI void attn_unit(LAS unsigned char* lds, const bf16_t* Qp, int ldq, const bf16_t* Kp, int ldk, const bf16_t* Vp, int ldv,
                  int nA, int rowB0, int nB, int posB0, int qpos0, float m0, float l0,
                  bf16_t* Og, int ldo, float* Of, int ldof) {
    constexpr int KSTR = DQK + 8, VSTR = DV + 32, KBUF = 64 * KSTR * 2, VBUF = 64 * VSTR * 2;
    constexpr int KCH = DQK / 8, VCH = DV / 8, NKC = 64 * KCH, NVC = 64 * VCH, KRN = (NKC + 511) / 512, VRN = (NVC + 511) / 512;
    static_assert(KBUF <= AT_KBUFMAX && VBUF <= AT_VBUFMAX, "attention LDS map");
    const int tid = tid_l(), lane = tid & 63, wid = __builtin_amdgcn_readfirstlane(tid >> 6), r32 = lane & 31, hi = lane >> 5;
#ifndef AT_QL
#define AT_QL 1
#endif
#ifndef AT_SB
#define AT_SB 0
#endif
    constexpr bool QL = AT_QL && (DQK > AT_QLMIN);
    bf16x8 qf[QL ? 1 : DQK / 16];
    const LAS unsigned char* qb = lds + AT_QOFF + wid * 6144 + lane * 16;
    { const bf16_t* qrow = Qp + (size_t)(32 * wid + r32) * ldq + 8 * hi;
#pragma unroll
      for (int ds = 0; ds < DQK / 16; ++ds) { const bf16x8 v = *(const bf16x8*)(qrow + 16 * ds); if (QL) *(LAS bf16x8*)(lds + AT_QOFF + wid * 6144 + lane * 16 + ds * 1024) = v; else qf[QL ? 0 : ds] = v; }
      if (QL) { __builtin_amdgcn_wave_barrier(); asm volatile("s_waitcnt lgkmcnt(0)" ::: "memory"); } }
    f32x16 o[DV / 32];
#pragma unroll
    for (int db = 0; db < DV / 32; ++db)
#pragma unroll
        for (int r = 0; r < 16; ++r) o[db][r] = 0.f;
    float mrun = m0, lrun = (hi == 0) ? l0 : 0.f;
    LAS float* scw = (LAS float*)(lds + AT_SOFF) + wid * 32;
    const int NT = nA + nB;
    const LAS unsigned char* kb0 = lds + AT_KOFF + r32 * (KSTR * 2) + hi * 16;
    const LAS unsigned char* vb0 = lds + AT_VOFF + (4 * hi + ((lane & 15) >> 2)) * (VSTR * 2) + (16 * ((lane >> 4) & 1) + 4 * (lane & 3)) * 2;
    const int dk0 = posB0 + 4 * hi - (qpos0 + 32 * wid + r32) - 64 * nA;
    u32x4 kreg[KRN], vreg[VRN];
    int kgo[KRN], klo[KRN], vgo[VRN], vlo_[VRN];
#pragma unroll
    for (int i_ = 0; i_ < KRN; ++i_) { int c_ = tid + 512 * i_; if (c_ >= NKC) c_ -= 512; const int r_ = c_ / KCH, cc_ = c_ % KCH; kgo[i_] = r_ * ldk + cc_ * 8; klo[i_] = AT_KOFF + r_ * (KSTR * 2) + cc_ * 16; }
#pragma unroll
    for (int i_ = 0; i_ < VRN; ++i_) { int c_ = tid + 512 * i_; if (c_ >= NVC) c_ -= 512; const int r_ = c_ / VCH, cc_ = c_ % VCH; vgo[i_] = r_ * ldv + cc_ * 8; vlo_[i_] = AT_VOFF + r_ * (VSTR * 2) + cc_ * 16; }
    const __amdgpu_buffer_rsrc_t rK = __builtin_amdgcn_make_buffer_rsrc((void*)Kp, 0, 0x7fffffff, 0x00020000), rV = __builtin_amdgcn_make_buffer_rsrc((void*)Vp, 0, 0x7fffffff, 0x00020000);
#define AT_GLOAD(t) do { const int row0_ = (t) < nA ? 64 * (t) : rowB0 + 64 * ((t) - nA); const int sk_ = row0_ * ldk * 2, sv_ = row0_ * ldv * 2; \
        _Pragma("unroll") for (int i_ = 0; i_ < KRN; ++i_) kreg[i_] = __builtin_amdgcn_raw_buffer_load_b128(rK, kgo[i_] * 2, sk_, 0); \
        _Pragma("unroll") for (int i_ = 0; i_ < VRN; ++i_) vreg[i_] = __builtin_amdgcn_raw_buffer_load_b128(rV, vgo[i_] * 2, sv_, 0); } while (0)
#define AT_SWRITE(buf) do { \
        _Pragma("unroll") for (int i_ = 0; i_ < KRN; ++i_) *(LAS u32x4*)(lds + (buf) * KBUF + klo[i_]) = kreg[i_]; \
        _Pragma("unroll") for (int i_ = 0; i_ < VRN; ++i_) *(LAS u32x4*)(lds + (buf) * VBUF + vlo_[i_]) = vreg[i_]; } while (0)
    unsigned pfv = 0u, pfacc = 0u;
    const int pft = tid & 255;
    const bf16_t* pfb = (pft < 128) ? Kp + (pft >> 1) * ldk + (pft & 1) * (DQK - 2) : Vp + ((pft - 128) >> 1) * ldv + (pft & 1) * (DV - 2);
    const int pfs = (pft < 128) ? ldk : ldv;
    constexpr int PFD = 4;
#if AT_NOPF
#define AT_PF(t) do {} while (0)
#else
#define AT_PF(t) do { pfacc ^= pfv; const int tt_ = (t) < NT ? (t) : NT - 1; const int row0_ = tt_ < nA ? 64 * tt_ : rowB0 + 64 * (tt_ - nA); \
        pfv = *(const unsigned*)(pfb + (size_t)row0_ * pfs); } while (0)
#endif
#define AT_MASK(P0, P1, t) do { if (MASKED && (t) >= nA) at_mask(P0, P1, dk0 + 64 * (t)); } while (0)
#define AT_RESC(al) do { if (__any((al) < 1.f)) at_scale_o<DV>(o, scw, (al), r32, hi); } while (0)
    constexpr int DRYP = (OUTM == 2) ? PROBE_MODE : 0;
    f32x16 pA0, pA1, pB0, pB1; float alA, alB; bf16x8 pa[4];
    AT_PF(1); AT_PF(2); AT_PF(3);
    AT_GLOAD(0); AT_SWRITE(0); __syncthreads();
    AT_GLOAD(1);
    at_qkt<DQK, QL>(pA0, pA1, kb0, qf, qb); AT_MASK(pA0, pA1, 0); at_psm(pA0, pA1, mrun, alA);
    AT_SWRITE(1); __syncthreads();
    int bp = 0, bc = 1, bn = 2;
    constexpr int NMF = 2 * (DQK / 16) + 4 * (DV / 32);
#if AT_IGLP >= 0
#define AT_SCHED() __builtin_amdgcn_iglp_opt(AT_IGLP)
#elif AT_SGB
#define AT_SCHED() do { _Pragma("unroll") for (int i_ = 0; i_ < NMF; ++i_) { __builtin_amdgcn_sched_group_barrier(0x008, 1, 0); __builtin_amdgcn_sched_group_barrier(0x100, 2, 0); __builtin_amdgcn_sched_group_barrier(0x002, AT_SGB, 0); } } while (0)
#else
#define AT_SCHED() do {} while (0)
#endif
#define AT_ROT() do { bp = bc; bc = bn; bn = (bn == 2) ? 0 : bn + 1; } while (0)
    for (int j = 1; j + 1 < ((DRYP == 6) ? 2 : NT); j += 2) {
        SBAR(); if (DRYP != 5) at_qkt<DQK, QL>(pB0, pB1, kb0 + bc * KBUF, qf, qb); else { _Pragma("unroll") for (int r_ = 0; r_ < 16; ++r_) { pB0[r_] = o[0][r_] * 1e-3f; pB1[r_] = o[1][r_] * 1e-3f; } } AT_MASK(pB0, pB1, j);
        if (!(DRYP >= 1)) { AT_GLOAD(j + 1); AT_PF(j + PFD); }
        if (DRYP != 3) at_fsm(pA0, pA1, alA, lrun, pa); else at_fsm_fake(pA0, pA1, pa); SBAR();
        if (DRYP != 4) at_pv<DV>(o, vb0 + bp * VBUF, pa); else { o[0][0] += __builtin_bit_cast(float, (int)pa[0][0] + (int)pa[1][1] + (int)pa[2][2] + (int)pa[3][3]); } if (DRYP != 3) at_psm(pB0, pB1, mrun, alB); else alB = 1.f;
        AT_SCHED();
        if (!(DRYP >= 1)) AT_SWRITE(bn);
        AT_RESC(alB); if (DRYP != 2) __syncthreads(); AT_ROT();
        SBAR(); if (DRYP != 5) at_qkt<DQK, QL>(pA0, pA1, kb0 + bc * KBUF, qf, qb); else { _Pragma("unroll") for (int r_ = 0; r_ < 16; ++r_) { pA0[r_] = o[0][r_] * 1e-3f; pA1[r_] = o[1][r_] * 1e-3f; } } AT_MASK(pA0, pA1, j + 1);
        if (!(DRYP >= 1)) { AT_GLOAD(j + 2); AT_PF(j + 1 + PFD); }
        if (DRYP != 3) at_fsm(pB0, pB1, alB, lrun, pa); else at_fsm_fake(pB0, pB1, pa); SBAR();
        if (DRYP != 4) at_pv<DV>(o, vb0 + bp * VBUF, pa); else { o[0][0] += __builtin_bit_cast(float, (int)pa[0][0] + (int)pa[1][1] + (int)pa[2][2] + (int)pa[3][3]); } if (DRYP != 3) at_psm(pA0, pA1, mrun, alA); else alA = 1.f;
        AT_SCHED();
        if (!(DRYP >= 1)) AT_SWRITE(bn);
        AT_RESC(alA); if (DRYP != 2) __syncthreads(); AT_ROT();
    }
    SBAR(); at_qkt<DQK, QL>(pB0, pB1, kb0 + bc * KBUF, qf, qb); AT_MASK(pB0, pB1, NT - 1);
    at_fsm(pA0, pA1, alA, lrun, pa); SBAR();
    at_pv<DV>(o, vb0 + bp * VBUF, pa); at_psm(pB0, pB1, mrun, alB);
    AT_RESC(alB);
    at_fsm(pB0, pB1, alB, lrun, pa); SBAR();
    at_pv<DV>(o, vb0 + bc * VBUF, pa);
#undef AT_ROT
#undef AT_SCHED
    pfacc ^= pfv;
    if (__builtin_expect(pfacc == 0x9e3779b9u && lrun == 12345.678f, 0)) scw[0] = 1.f;
#undef AT_GLOAD
#undef AT_PF
#undef AT_SWRITE
#undef AT_MASK
#undef AT_RESC
    { const float lt = lrun + __shfl_xor(lrun, 32); at_scale_o<DV>(o, scw, 1.0f / lt, r32, hi); }
    if (OUTM == 0) {
#pragma unroll
        for (int db = 0; db < DV / 32; ++db) {
            bf16_t* pb = Og + (size_t)(32 * wid + 4 * hi) * ldo + 32 * db + r32;
            bf16_t zz[16];
#pragma unroll
            for (int r = 0; r < 16; ++r) zz[r] = pb[(size_t)((r & 3) + 8 * (r >> 2)) * ldo];
#pragma unroll
            for (int r = 0; r < 16; ++r) { const float z = __uint_as_float((unsigned)zz[r] << 16); pb[(size_t)((r & 3) + 8 * (r >> 2)) * ldo] = (bf16_t)(pk2(o[db][r] * silu_f(z), 0.f) & 0xffffu); }
        }
    } else {
#pragma unroll
        for (int db = 0; db < DV / 32; ++db)
#pragma unroll
            for (int r = 0; r < 16; ++r) {
                const int q = (r & 3) + 8 * (r >> 2) + 4 * hi;
                if (OUTM == 1) { Of[(size_t)(32 * wid + q) * ldof + 32 * db + r32] = o[db][r]; }
                else { if (lrun == 12345.678f) Of[(size_t)(32 * wid + q) * ldof + 32 * db + r32] = o[db][r]; }
            }
    }
    __syncthreads();
}

struct Args { const float* in[21]; float* out; unsigned char* ws; };
typedef const __attribute__((address_space(4))) Args* ArgsP;
DI ArgsP args_ptr() { ArgsP p = (ArgsP)__builtin_amdgcn_kernarg_segment_ptr(); asm volatile("" : "+s"(p)); return p; }
enum { I_X = 0, I_C, I_CTX, I_CCTX, I_WMOD, I_BMOD, I_NORMG, I_WIN, I_QNORM, I_WUQ, I_KVNORM, I_WUKV, I_LQ1, I_LK1, I_LQ2, I_LK2, I_SUBLN, I_SINK, I_WBR, I_WOUT, I_FNORM };

DI int colmap(int kind, int n) {
    if (kind == 1) {
        if (n < C_KR) return n;
        if (n < C_KR + 32) { const int e = n - C_KR; return C_KR + (e >> 1) + 16 * (e & 1); }
        if (n < C_DQ) return -1;
        if ((n >= C_DQ && n < C_DV) || (n >= C_SQ && n < C_SV)) { const int w = n & 63; return (n - w) - 96 + (w >> 1) + 32 * (w & 1); }
        return n - 96;
    }
    if (kind == 2) { const int h = n / 96, e = n % 96; if (e < 64) return n; const int e2 = e - 64; return h * 96 + 64 + (e2 >> 1) + 16 * (e2 & 1); }
    if (kind == 3) { if (n < 512) return (n >> 6) * 192 + (n & 63); const int n2 = n - 512; return (n2 >> 7) * 192 + 64 + (n2 & 127); }
    return n;
}
DI void transpose_item(const float* W, int ldw, int kind, const float* rowscale, bf16_t* WT, int ldd, int koff, LAS float* scr, int item, int nblk, int lane) {
    const int kb = item / nblk, nb = item % nblk, k0 = 64 * kb, n0 = 32 * nb;
    const int oc = colmap(kind, n0 + (lane & 31));
#pragma unroll 8
    for (int i = 0; i < 32; ++i) { const int kk = 2 * i + (lane >> 5); float v = 0.f; if (oc >= 0) v = W[(size_t)(k0 + kk) * ldw + oc]; if (rowscale) v *= rowscale[k0 + kk]; scr[kk * 33 + (lane & 31)] = v; }
    __builtin_amdgcn_wave_barrier(); asm volatile("s_waitcnt lgkmcnt(0)" ::: "memory");
    const int c = lane & 7;
#pragma unroll
    for (int j = 0; j < 4; ++j) { const int n = (lane >> 3) + 8 * j; const LAS float* s = scr + (8 * c) * 33 + n;
        u32x4 o; o.x = pk2(s[0 * 33], s[1 * 33]); o.y = pk2(s[2 * 33], s[3 * 33]); o.z = pk2(s[4 * 33], s[5 * 33]); o.w = pk2(s[6 * 33], s[7 * 33]);
        *(u32x4*)(WT + (size_t)(n0 + n) * ldd + koff + k0 + 8 * c) = o; }
    __builtin_amdgcn_wave_barrier(); asm volatile("s_waitcnt lgkmcnt(0)" ::: "memory");
}
DI void prologue(ArgsP ap, LAS unsigned char* lds) {
    const int tid = tid_l(), lane = tid & 63, wid = __builtin_amdgcn_readfirstlane(tid >> 6);
    unsigned char* ws = ap->ws;
    LAS float* scr = (LAS float*)(lds + wid * 8448);
    const int gw = bid_l() * 8 + wid, NGW = grd_l() * 8;
    constexpr int I_IN = 16 * (NP / 32), I_UQ = 6 * 24, I_UKV = 4 * 48, I_SQ = 16 * 32, PER_L = I_IN + I_UQ + I_UKV + 6 * I_SQ;
    for (int it = gw; it < 2 * PER_L; it += NGW) {
        const int l = it / PER_L; int r = it % PER_L;
        if (r < I_IN) { transpose_item(ap->in[I_WIN] + (size_t)l * 1024 * D_IN, D_IN, 1, nullptr, (bf16_t*)(ws + WS_WIN) + (size_t)l * NP * 1024, 1024, 0, scr, r, NP / 32, lane); continue; } r -= I_IN;
        if (r < I_UQ) { transpose_item(ap->in[I_WUQ] + (size_t)l * 384 * 768, 768, 2, ap->in[I_QNORM] + l * 384, (bf16_t*)(ws + WS_WUQ) + (size_t)l * 768 * 384, 384, 0, scr, r, 24, lane); continue; } r -= I_UQ;
        if (r < I_UKV) { transpose_item(ap->in[I_WUKV] + (size_t)l * 256 * 1536, 1536, 3, ap->in[I_KVNORM] + l * 256, (bf16_t*)(ws + WS_WUKV) + (size_t)l * 1536 * 256, 256, 0, scr, r, 48, lane); continue; } r -= I_UKV;
        if (r < 3 * I_SQ) { const int br = r / I_SQ; transpose_item(ap->in[I_WBR] + ((size_t)l * 3 + br) * 1024 * 1024, 1024, 0, nullptr, (bf16_t*)(ws + WS_WB) + ((size_t)l * 3 + br) * 1024 * 1024, 1024, 0, scr, r % I_SQ, 32, lane); continue; } r -= 3 * I_SQ;
        { const int rep = r / I_SQ; transpose_item(ap->in[I_WOUT] + (size_t)l * 1024 * 1024, 1024, 0, nullptr, (bf16_t*)(ws + WS_WO3) + (size_t)l * 1024 * 3072, 3072, rep * 1024, scr, r % I_SQ, 32, lane); }
    }
    const int gt = bid_l() * 512 + tid, NGT = grd_l() * 512;
    for (int i = gt; i < SEQ * 48; i += NGT) {
        const int pos = i / 48, p = i % 48; const float frow = (float)(pos >> 6), fcol = (float)(pos & 63);
        float ang; float* cd; float* sd;
        if (p < 32) { const int f = p & 15; const float inv = powf(10000.0f, -(float)f / 16.0f); ang = (p < 16 ? frow : fcol) * inv; cd = (float*)(ws + WS_COSH) + pos * 32 + p; sd = (float*)(ws + WS_SINH) + pos * 32 + p; }
        else { const int pp = p - 32, f = pp & 7; const float inv = powf(10000.0f, -(float)f / 8.0f); ang = (pp < 8 ? frow : fcol) * inv; cd = (float*)(ws + WS_COSM) + pos * 16 + pp; sd = (float*)(ws + WS_SINM) + pos * 16 + pp; }
        *cd = __cosf(ang); *sd = __sinf(ang);
    }
    for (int it = gw; it < 2 * 16 * 48; it += NGW) {
        const int l = it / 768, rem = it % 768, kc = rem / 48, nb = rem % 48; const int k = kc * 64 + lane;
        float sv[9];
#pragma unroll
        for (int v = 0; v < 8; ++v) sv[v] = silu_f(ap->in[I_C][v * 1024 + k]);
        sv[8] = silu_f(ap->in[I_CCTX][k]);
        float acc[9];
#pragma unroll
        for (int v = 0; v < 9; ++v) acc[v] = 0.f;
        const float* w = ap->in[I_WMOD] + ((size_t)l * 1024 + kc * 64) * 3072 + nb * 64 + lane;
#pragma unroll 8
        for (int kk = 0; kk < 64; ++kk) { const float wv = w[(size_t)kk * 3072];
#pragma unroll
            for (int v = 0; v < 9; ++v) acc[v] += __uint_as_float(__builtin_amdgcn_readlane(__float_as_uint(sv[v]), kk)) * wv; }
        float* mp = (float*)(ws + WS_MODP) + ((size_t)(l * 16 + kc) * 9) * 3072 + nb * 64 + lane;
#pragma unroll
        for (int v = 0; v < 9; ++v) mp[(size_t)v * 3072] = acc[v];
    }
}
DI void mod_finalize(ArgsP ap) {
    const int tid = tid_l();
    const int gt = bid_l() * 512 + tid, NGT = grd_l() * 512;
    const float* mp = (const float*)(ap->ws + WS_MODP); float* mod = (float*)(ap->ws + WS_MOD);
    for (int i = gt; i < 2 * 9 * 3072; i += NGT) {
        const int l = i / (9 * 3072), rem = i % (9 * 3072), n = rem % 3072;
        float s = ap->in[I_BMOD][l * 3072 + n];
#pragma unroll
        for (int kc = 0; kc < 16; ++kc) s += mp[(size_t)(l * 16 + kc) * 9 * 3072 + rem];
        mod[i] = s;
    }
}
DI void ph_norm_mod(ArgsP ap, int l, int g) {
    const int tid = tid_l(), lane = tid & 63, wid = __builtin_amdgcn_readfirstlane(tid >> 6);
    const int gw = bid_l() * 8 + wid, NGW = grd_l() * 8;
    const float* ng = ap->in[I_NORMG] + l * 1024; const float* mod = (const float*)(ap->ws + WS_MOD) + (size_t)l * 9 * 3072;
    const float* xs = (l == 0) ? ap->in[I_X] : ap->out; const float* cs = (l == 0) ? ap->in[I_CTX] : (const float*)(ap->ws + WS_CTX);
    bf16_t* H = (bf16_t*)(ap->ws + WS_H);
    for (int r = gw; r < R; r += NGW) {
        const int bl = r / RB, j = r % RB, b = g * GB + bl;
        const float* src; const float* md;
        if (j < CTX) { src = cs + ((size_t)b * CTX + j) * DM; md = mod + 8 * 3072; } else { src = xs + ((size_t)b * SEQ + (j - CTX)) * DM; md = mod + (size_t)b * 3072; }
        f32x4 v[4]; float ss = 0.f;
#pragma unroll
        for (int q = 0; q < 4; ++q) { v[q] = *(const f32x4*)(src + 4 * (lane + 64 * q)); ss += (v[q][0] * v[q][0] + v[q][1] * v[q][1]) + (v[q][2] * v[q][2] + v[q][3] * v[q][3]); }
        const float rstd = 1.0f / sqrtf(wave_sum(ss) * (1.0f / DM) + EPS);
#pragma unroll
        for (int q = 0; q < 4; ++q) { const int idx = 4 * (lane + 64 * q);
            const f32x4 gg = *(const f32x4*)(ng + idx), sh = *(const f32x4*)(md + idx), sc = *(const f32x4*)(md + 1024 + idx);
            const f32x4 y = (v[q] * rstd * gg) * (sc + 1.0f) + sh;
            u32x2 w; w.x = pk2(y[0], y[1]); w.y = pk2(y[2], y[3]); *(u32x2*)(H + (size_t)r * DM + idx) = w; }
    }
}
DI void ph_mla_norm(ArgsP ap) {
    const int tid = tid_l(), lane = tid & 63, wid = __builtin_amdgcn_readfirstlane(tid >> 6);
    const int gw = bid_l() * 8 + wid, NGW = grd_l() * 8;
    const bf16_t* P = (const bf16_t*)(ap->ws + WS_P); bf16_t* AQ = (bf16_t*)(ap->ws + WS_AQ); bf16_t* AKV = (bf16_t*)(ap->ws + WS_AKV); bf16_t* KM = (bf16_t*)(ap->ws + WS_KM);
    for (int r = gw; r < R; r += NGW) {
        const bf16_t* row = P + (size_t)r * NP;
        const u32x4 c0 = *(const u32x4*)(row + 8 * lane);
        u32x4 c1 = {0u, 0u, 0u, 0u}; if (lane < 20) c1 = *(const u32x4*)(row + 8 * (64 + lane));
        float f0[8] = {bflo(c0.x), bfhi(c0.x), bflo(c0.y), bfhi(c0.y), bflo(c0.z), bfhi(c0.z), bflo(c0.w), bfhi(c0.w)};
        float f1[8] = {bflo(c1.x), bfhi(c1.x), bflo(c1.y), bfhi(c1.y), bflo(c1.z), bfhi(c1.z), bflo(c1.w), bfhi(c1.w)};
        float s0 = 0.f, s1 = 0.f;
#pragma unroll
        for (int i = 0; i < 8; ++i) { s0 += f0[i] * f0[i]; s1 += f1[i] * f1[i]; }
        const float sq = wave_sum(lane < 48 ? s0 : 0.f);
        const float skv = wave_sum((lane >= 48 ? s0 : 0.f) + (lane < 16 ? s1 : 0.f));
        const float rq = 1.0f / sqrtf(sq * (1.0f / 384.0f) + EPS), rkv = 1.0f / sqrtf(skv * (1.0f / 256.0f) + EPS);
        { const float rr = lane < 48 ? rq : rkv; u32x4 w; w.x = pk2(f0[0] * rr, f0[1] * rr); w.y = pk2(f0[2] * rr, f0[3] * rr); w.z = pk2(f0[4] * rr, f0[5] * rr); w.w = pk2(f0[6] * rr, f0[7] * rr);
          if (lane < 48) *(u32x4*)(AQ + (size_t)r * 384 + 8 * lane) = w; else *(u32x4*)(AKV + (size_t)r * 256 + 8 * (lane - 48)) = w; }
        if (lane < 16) { u32x4 w; w.x = pk2(f1[0] * rkv, f1[1] * rkv); w.y = pk2(f1[2] * rkv, f1[3] * rkv); w.z = pk2(f1[4] * rkv, f1[5] * rkv); w.w = pk2(f1[6] * rkv, f1[7] * rkv);
            *(u32x4*)(AKV + (size_t)r * 256 + 8 * (16 + lane)) = w; }
        else if (lane < 20) {
#pragma unroll
            for (int h = 0; h < 8; ++h) *(u32x4*)(KM + (size_t)r * 768 + h * 96 + 64 + 8 * (lane - 16)) = c1; }
    }
}
template <bool DRYE>
DI void ph_diff_post(ArgsP ap, int l) {
    const int tid = tid_l(), lane = tid & 63, wid = __builtin_amdgcn_readfirstlane(tid >> 6);
    const int gw = bid_l() * 8 + wid, NGW = grd_l() * 8;
    const float lam_init = (l == 0) ? 0.2f : (0.8f - 0.6f * 0.7408182206817179f);
    const float d1 = wave_sum(ap->in[I_LQ1][l * 64 + lane] * ap->in[I_LK1][l * 64 + lane]), d2 = wave_sum(ap->in[I_LQ2][l * 64 + lane] * ap->in[I_LK2][l * 64 + lane]);
    const float lam = expf(d1) - expf(d2) + lam_init;
    const float sl0 = ap->in[I_SUBLN][l * 128 + 2 * lane] * (1.0f - lam_init), sl1 = ap->in[I_SUBLN][l * 128 + 2 * lane + 1] * (1.0f - lam_init);
    const float* OD = (const float*)(ap->ws + WS_OD); bf16_t* P = (bf16_t*)(ap->ws + WS_P);
    typedef float f32x2 __attribute__((ext_vector_type(2)));
    for (int r = gw; r < R; r += NGW) {
        if (l != 0 && (r % RB) < CTX) continue;
        const float* ob = OD + (size_t)r * 2048 + 2 * lane; unsigned* zb = (unsigned*)(P + (size_t)r * NP + C_Z + 1024 + 2 * lane);
        f32x2 o1[8], o2[8]; unsigned z[8];
#pragma unroll
        for (int h = 0; h < 8; ++h) { o1[h] = *(const f32x2*)(ob + (2 * h) * 128); o2[h] = *(const f32x2*)(ob + (2 * h + 1) * 128); z[h] = zb[h * 64]; }
#pragma unroll
        for (int h = 0; h < 8; ++h) {
            const float a0 = o1[h][0] - lam * o2[h][0], a1 = o1[h][1] - lam * o2[h][1];
            const float rstd = 1.0f / sqrtf(wave_sum(a0 * a0 + a1 * a1) * (1.0f / 128.0f) + EPS);
            if (!DRYE || rstd == 12345.678f) zb[h * 64] = pk2(a0 * rstd * sl0 * silu_f(bflo(z[h])), a1 * rstd * sl1 * silu_f(bfhi(z[h])));
        }
    }
}
template <bool DRYE>
DI void ph_final_norm(ArgsP ap) {
    const int tid = tid_l(), lane = tid & 63, wid = __builtin_amdgcn_readfirstlane(tid >> 6);
    const int gw = bid_l() * 8 + wid, NGW = grd_l() * 8; const float* fg = ap->in[I_FNORM];
    for (int r = gw; r < NBATCH * SEQ; r += NGW) {
        float* row = ap->out + (size_t)r * DM; f32x4 v[4]; float ss = 0.f;
#pragma unroll
        for (int q = 0; q < 4; ++q) { v[q] = *(const f32x4*)(row + 4 * (lane + 64 * q)); ss += (v[q][0] * v[q][0] + v[q][1] * v[q][1]) + (v[q][2] * v[q][2] + v[q][3] * v[q][3]); }
        const float rstd = 1.0f / sqrtf(wave_sum(ss) * (1.0f / DM) + EPS);
#pragma unroll
        for (int q = 0; q < 4; ++q) { const int idx = 4 * (lane + 64 * q); if (!DRYE || rstd == 12345.678f) *(f32x4*)(row + idx) = v[q] * rstd * *(const f32x4*)(fg + idx); }
    }
}
template <bool DRY>
DI void ph_attention(ArgsP ap, int l, LAS unsigned char* lds) {
    constexpr int OM0 = DRY ? 2 : 0;
    const int G = grd_l(), bx = bid_l(), vcu = (G % 8 == 0) ? (bx % 8) * (G / 8) + bx / 8 : bx;
    bf16_t* P = (bf16_t*)(ap->ws + WS_P); const bf16_t* QM = (const bf16_t*)(ap->ws + WS_QM); const bf16_t* KM = (const bf16_t*)(ap->ws + WS_KM); const bf16_t* VM = (const bf16_t*)(ap->ws + WS_VM);
    float* OD = (float*)(ap->ws + WS_OD); const float* sink = ap->in[I_SINK] + l * 16;
#if !defined(ATT_ONLY) || ATT_ONLY == 1
    if (!DRY || (DRY_SEL & 1))
    for (int u = vcu; u < GB * 8 * 32; u += G) { const int bh = u >> 5, qb = u & 31, bl = bh >> 3, h = bh & 7; const size_t rb = (size_t)bl * RB, q0 = rb + CTX + 256 * qb;
        attn_unit<96, 128, OM0, false>(lds, QM + q0 * 768 + h * 96, 768, KM + rb * 768 + h * 96, 768, VM + rb * 1024 + h * 128, 1024, RB / 64, 0, 0, 0, 0, NEGBIG, 0.f, P + q0 * NP + C_Z + h * 128, NP, OD, 0); }
#endif
#if !defined(ATT_ONLY) || ATT_ONLY == 2
    if (!DRY || (DRY_SEL & 2))
    for (int u = vcu; u < GB * 16 * 32; u += G) { const int bh = u >> 5, qb = u & 31, bl = bh >> 4, hm = bh & 15; const size_t rb = (size_t)bl * RB, q0 = rb + CTX + 256 * qb;
        attn_unit<64, 128, 1, false>(lds, P + q0 * NP + C_DQ + hm * 64, NP, P + rb * NP + C_DK + hm * 64, NP, P + rb * NP + C_DV + (hm >> 1) * 128, NP, RB / 64, 0, 0, 0, 0, NEGBIG, 0.f, nullptr, 0, OD + q0 * 2048 + hm * 128, 2048); }
#endif
#if !defined(ATT_ONLY) || ATT_ONLY == 3
    if (!DRY || (DRY_SEL & 4))
    for (int u = vcu; u < GB * 16 * 32; u += G) { const int bh = u >> 5, qb = u & 31, bl = bh >> 4, h = bh & 15; const size_t rb = (size_t)bl * RB, q0 = rb + CTX + 256 * qb;
        const int lo = (256 * qb - 128 < 0) ? 0 : 256 * qb - 128, hi = (256 * qb + 384 > SEQ) ? SEQ : 256 * qb + 384;
        attn_unit<64, 64, OM0, true>(lds, P + q0 * NP + C_SQ + h * 64, NP, P + rb * NP + C_SK + (h >> 2) * 64, NP, P + rb * NP + C_SV + (h >> 2) * 64, NP, CTX / 64, CTX + lo, (hi - lo) / 64, lo, 256 * qb, sink[h] * LOG2E, 1.0f,
                              P + q0 * NP + C_Z + 2048 + h * 64, NP, OD, 0); }
#endif
#if !defined(ATT_ONLY)
    if (l == 0) {
        for (int u = vcu; u < GB * 40; u += G) { const int bl = u / 40, k = u % 40; const size_t rb = (size_t)bl * RB;
            if (k < 8) { const int h = k;
                attn_unit<96, 128, OM0, false>(lds, QM + rb * 768 + h * 96, 768, KM + rb * 768 + h * 96, 768, VM + rb * 1024 + h * 128, 1024, CTX / 64, 0, 0, 0, 0, NEGBIG, 0.f, P + rb * NP + C_Z + h * 128, NP, OD, 0); }
            else if (k < 24) { const int hm = k - 8;
                attn_unit<64, 128, 1, false>(lds, P + rb * NP + C_DQ + hm * 64, NP, P + rb * NP + C_DK + hm * 64, NP, P + rb * NP + C_DV + (hm >> 1) * 128, NP, CTX / 64, 0, 0, 0, 0, NEGBIG, 0.f, nullptr, 0, OD + rb * 2048 + hm * 128, 2048); }
            else { const int h = k - 24;
                attn_unit<64, 64, OM0, false>(lds, P + rb * NP + C_SQ + h * 64, NP, P + rb * NP + C_SK + (h >> 2) * 64, NP, P + rb * NP + C_SV + (h >> 2) * 64, NP, CTX / 64, 0, 0, 0, 0, sink[h] * LOG2E, 1.0f, P + rb * NP + C_Z + 2048 + h * 64, NP, OD, 0); }
        }
    }
#endif
}

#define RLX_AGENT __ATOMIC_RELAXED, __HIP_MEMORY_SCOPE_AGENT
#define XB_TMO      128
#define XB_XCNT(j)  (256  + 64 * (j))
#define XB_XSUB(j)  (1280 + 64 * (j))
#define XB_XGEN(j)  (2304 + 64 * (j))
#define XB_TOP      3328
#define XB_TOPGEN   3392
#define XCD_BAR_WORDS 3456
#define XB_SPIN_CAP (1u << 18)

__device__ __forceinline__ unsigned xb_ld(unsigned* p)              { return __hip_atomic_load(p, __ATOMIC_RELAXED, __HIP_MEMORY_SCOPE_AGENT); }
__device__ __forceinline__ unsigned xb_add(unsigned* p, unsigned v) { return __hip_atomic_fetch_add(p, v, __ATOMIC_RELAXED, __HIP_MEMORY_SCOPE_AGENT); }
__device__ __forceinline__ unsigned xb_xcc_id() { return (unsigned)__builtin_amdgcn_s_getreg((3 << 11) | 20) & 0xFu; }
#define XB_SPIN(cond, bar) do { unsigned _sp = 0; while (cond) { __builtin_amdgcn_s_sleep(1); \
    if ((++_sp & 255u) == 0u) { if (xb_ld(&(bar)[XB_TMO])) break; if (_sp > XB_SPIN_CAP) { atomicAdd(&(bar)[XB_TMO], 1u); break; } } } } while (0)

struct XcdBarrier {
    unsigned* bar; unsigned x;
    volatile LAS unsigned* st;
};

__device__ __forceinline__ XcdBarrier xcd_barrier_post(unsigned* bar, volatile LAS unsigned* st) {
    XcdBarrier b; b.bar = bar; b.x = xb_xcc_id(); b.st = st;
    if (threadIdx.x == 0) (void)xb_add(&bar[XB_XCNT(b.x)], 1u);
    return b;
}
__device__ __forceinline__ void xcd_barrier_complete(unsigned* bar, unsigned x, unsigned& nloc, unsigned& nx) {
    const unsigned G = gridDim.x * gridDim.y * gridDim.z;
    unsigned sum, cnt, mine, sp = 0u;
    for (;;) {
        sum = 0u; cnt = 0u; mine = 0u;
#pragma unroll
        for (unsigned j = 0; j < 16; ++j) { const unsigned c = xb_ld(&bar[XB_XCNT(j)]); sum += c; cnt += (c > 0u) ? 1u : 0u; mine = (j == x) ? c : mine; }
        if (sum == G) break;
        __builtin_amdgcn_s_sleep(1);
        if ((++sp & 255u) == 0u) { if (xb_ld(&bar[XB_TMO])) break; if (sp > XB_SPIN_CAP) { atomicAdd(&bar[XB_TMO], 1u); break; } }
    }
    nloc = mine > 0u ? mine : 1u; nx = cnt > 0u ? cnt : 1u;
}

__device__ __forceinline__ void xcd_barrier(const XcdBarrier& b) {
    asm volatile("s_waitcnt vmcnt(0)" ::: "memory");
    __syncthreads();
    if (threadIdx.x == 0) {
        unsigned* bar = b.bar;
        __builtin_amdgcn_s_waitcnt(0);
        unsigned nloc = b.st[0], nx = b.st[1];
        if (nloc == 0u) { xcd_barrier_complete(bar, b.x, nloc, nx); b.st[0] = nloc; b.st[1] = nx; }
        const unsigned old = xb_add(&bar[XB_XSUB(b.x)], 1u);
        const unsigned gen = old / nloc;
        if (old + 1u == (gen + 1u) * nloc) {
            __builtin_amdgcn_fence(__ATOMIC_RELEASE, "agent");
            asm volatile("s_waitcnt vmcnt(0)" ::: "memory");
            const unsigned og = xb_add(&bar[XB_TOP], 1u);
            const unsigned tg = og / nx;
            if (og + 1u == (tg + 1u) * nx) xb_add(&bar[XB_TOPGEN], 1u);
            else XB_SPIN(xb_ld(&bar[XB_TOPGEN]) == tg, bar);
            __builtin_amdgcn_fence(__ATOMIC_ACQUIRE, "agent");
            xb_add(&bar[XB_XGEN(b.x)], 1u);
            asm volatile("s_waitcnt vmcnt(0)" ::: "memory");
        } else {
            XB_SPIN(xb_ld(&bar[XB_XGEN(b.x)]) == gen, bar);
            __builtin_amdgcn_fence(__ATOMIC_ACQUIRE, "agent");
            asm volatile("s_waitcnt vmcnt(0)" ::: "memory");
        }
    }
    __syncthreads();
}


__global__ void __launch_bounds__(512, 2) hybrid_fwd(Args a_unused) {
    extern __shared__ __attribute__((aligned(16))) unsigned char lds_raw[];
    LAS unsigned char* lds = (LAS unsigned char*)lds_raw;
    cg::grid_group grid = cg::this_grid();
    { volatile LAS unsigned* xst = (volatile LAS unsigned*)(lds + XB_LDS_OFF);
      if (threadIdx.x < 2) xst[threadIdx.x] = 0u;
      __syncthreads();
      (void)xcd_barrier_post((unsigned*)(args_ptr()->ws), xst); }
#define GSYNC() do { XcdBarrier b_; b_.bar = (unsigned*)(args_ptr()->ws); b_.x = xb_xcc_id(); b_.st = (volatile LAS unsigned*)(lds + XB_LDS_OFF); xcd_barrier(b_); } while (0)
#ifndef NO_PRO
    prologue(args_ptr(), lds);
#ifdef PROBE_PRO
    __syncthreads(); prologue(args_ptr(), lds);
#endif
#endif
    grid.sync();
    mod_finalize(args_ptr());
    GSYNC();
    for (int l = 0; l < 2; ++l) {
        for (int g = 0; g < NGRP; ++g) {
            ph_norm_mod(args_ptr(), lnd(l), lnd(g));
#ifdef PROBE_R1
            GSYNC(); ph_norm_mod(args_ptr(), lnd(l), lnd(g));
#endif
            GSYNC();
#ifndef NO_GEMM
            {
                unsigned char* ws = args_ptr()->ws; const int G = grd_l(), bx = bid_l();
                pg8::Gemm gm{1024, 1024, 1024}; pg8::Order S; S.init(R, NP, G, bx, ws + WS_H, 1024, (bf16_t*)(ws + WS_WIN) + (size_t)l * NP * 1024, 1024, 1 << 20, 0);
                EpiIn E{ws};
                pg8::gemm_phase<EpiIn, pg8::Order, true, true>(lds, gm, S, E);
#ifdef PROBE_G1
                __syncthreads(); pg8::gemm_phase<EpiIn, pg8::Order, true, true>(lds, gm, S, E);
#endif
            }
#endif
            GSYNC();
#ifndef NO_GEMM2
            {
                unsigned char* ws = args_ptr()->ws; const int G = grd_l(), bx = bid_l();
                pg8::Gemm gq{384, NP, 384}; pg8::Order Sq; Sq.init(R, 768, G, bx, (bf16_t*)(ws + WS_P) + C_QC, NP, (bf16_t*)(ws + WS_WUQ) + (size_t)l * 768 * 384, 384, 1 << 20, 0);
                EpiQ Eq{ws};
#ifndef NO_GQ
                pg8::gemm_phase<EpiQ, pg8::Order, true, true>(lds, gq, Sq, Eq);
#ifdef PROBE_G2
                __syncthreads(); pg8::gemm_phase<EpiQ, pg8::Order, true, true>(lds, gq, Sq, Eq);
#endif
#endif
            }
            {
                unsigned char* ws = args_ptr()->ws; const int G = grd_l(), bx = bid_l();
                pg8::Gemm gk{256, NP, 256}; pg8::Order Sk; Sk.init(R, 1536, G, bx, (bf16_t*)(ws + WS_P) + C_KVC, NP, (bf16_t*)(ws + WS_WUKV) + (size_t)l * 1536 * 256, 256, 1 << 20, 0);
                EpiKV Ek{ws};
#ifndef NO_GK
                pg8::gemm_phase<EpiKV, pg8::Order, true, true>(lds, gk, Sk, Ek);
#ifdef PROBE_G2
                __syncthreads(); pg8::gemm_phase<EpiKV, pg8::Order, true, true>(lds, gk, Sk, Ek);
#endif
#endif
            }
#endif
            GSYNC();
#ifndef NO_ATT
#ifdef PROBE_ATT
            ph_attention<true>(args_ptr(), lnd(l), lds);
            GSYNC();
#endif
            ph_attention<false>(args_ptr(), lnd(l), lds);
#endif
            GSYNC();
#ifdef PROBE_R2
            ph_diff_post<true>(args_ptr(), lnd(l)); GSYNC();
#endif
            ph_diff_post<false>(args_ptr(), lnd(l));
            GSYNC();
#ifndef NO_BR
            {
                unsigned char* ws = args_ptr()->ws; const int G = grd_l(), bx = bid_l();
                pg8::Gemm gb{1024, NP, 1024}; pg8::Order S; S.init(R, 3072, G, bx, (bf16_t*)(ws + WS_P) + C_Z, NP, (bf16_t*)(ws + WS_WB) + (size_t)l * 3 * 1024 * 1024, 1024, 4, 1024 * 2, l != 0);
#ifdef PROBE_BR
                { EpiBrT<true> Ed{ws}; pg8::gemm_phase<EpiBrT<true>, pg8::Order, true, true>(lds, gb, S, Ed); __syncthreads(); }
#endif
                EpiBrT<false> E{ws};
                pg8::gemm_phase<EpiBrT<false>, pg8::Order, true, true>(lds, gb, S, E);
            }
#endif
            GSYNC();
#ifndef NO_OUT
            {
                ArgsP ap = args_ptr(); unsigned char* ws = ap->ws; const int G = grd_l(), bx = bid_l();
                pg8::Gemm go{3072, NP, 3072}; pg8::Order S; S.init(R, 1024, G, bx, (bf16_t*)(ws + WS_P) + C_GM, NP, (bf16_t*)(ws + WS_WO3) + (size_t)l * 1024 * 3072, 3072, 1 << 20, 0, l != 0);
#ifdef PROBE_OUT
                { EpiOutT<true> Ed{l, g, (l == 0) ? ap->in[I_X] : (const float*)ap->out, ap->out, ap->in[I_CTX], ws}; pg8::gemm_phase<EpiOutT<true>, pg8::Order, true, true>(lds, go, S, Ed); __syncthreads(); }
#endif
                EpiOutT<false> E{l, g, (l == 0) ? ap->in[I_X] : (const float*)ap->out, ap->out, ap->in[I_CTX], ws};
                pg8::gemm_phase<EpiOutT<false>, pg8::Order, true, true>(lds, go, S, E);
            }
#endif
        }
        GSYNC();
    }
#ifdef PROBE_R2
    ph_final_norm<true>(args_ptr()); GSYNC();
#endif
    ph_final_norm<false>(args_ptr());
}

extern "C" void kernel_launch(void* const* d_in, const int* in_sizes, int n_in, void* d_out, int out_size, void* d_ws, size_t ws_size, hipStream_t stream) {
    static int grid = 0;
    if (grid == 0) {
        if (n_in != 21 || ws_size < WS_END) { fprintf(stderr, "kernel_launch: expected 21 inputs and >= %zu bytes of workspace (got %d, %zu)\n", (size_t)WS_END, n_in, ws_size); grid = -1; return; }
        int dev = 0, cus = 0, per_cu = 0;
        (void)hipGetDevice(&dev); (void)hipDeviceGetAttribute(&cus, hipDeviceAttributeMultiprocessorCount, dev);
        if (hipFuncSetAttribute((const void*)hybrid_fwd, hipFuncAttributeMaxDynamicSharedMemorySize, LDS_BYTES) != hipSuccess) fprintf(stderr, "kernel_launch: hipFuncSetAttribute failed\n");
        if (hipOccupancyMaxActiveBlocksPerMultiprocessor(&per_cu, (const void*)hybrid_fwd, 512, LDS_BYTES) != hipSuccess || per_cu < 1) { per_cu = 1; (void)hipGetLastError(); }
        if (cus <= 0) cus = 256;
        grid = cus * per_cu;
    }
    if (grid < 0) return;
    Args a{};
    for (int i = 0; i < 21; ++i) a.in[i] = (const float*)d_in[i];
    a.out = (float*)d_out; a.ws = (unsigned char*)d_ws;
    (void)hipMemsetAsync(d_ws, 0, 16384, stream);
    void* args[] = {&a};
    hipError_t e = hipLaunchCooperativeKernel((const void*)hybrid_fwd, dim3(grid), dim3(512), args, LDS_BYTES, stream);
    if (e != hipSuccess) fprintf(stderr, "kernel_launch: cooperative launch failed: %s (grid %d)\n", hipGetErrorString(e), grid);
}
```

```cpp
#include <hip/hip_runtime.h>
#include <hip/hip_cooperative_groups.h>
#include <cstdio>
#include <cstdint>
namespace cg = cooperative_groups;

#define DI __device__ __forceinline__
#define LAS __attribute__((address_space(3)))
__device__ __forceinline__ int tid_l() { int t = threadIdx.x; asm volatile("" : "+v"(t)); return t; }
__device__ __forceinline__ int bid_l() { int b = blockIdx.x; asm volatile("" : "+s"(b)); return b; }
__device__ __forceinline__ int lnd(int x) { asm volatile("" : "+s"(x)); return x; }
__device__ __forceinline__ int grd_l() { int g = gridDim.x; asm volatile("" : "+s"(g)); return g; }
typedef unsigned short bf16_t;
typedef short bf16x8 __attribute__((ext_vector_type(8)));
typedef short s16x4 __attribute__((ext_vector_type(4)));
typedef float f32x4 __attribute__((ext_vector_type(4)));
typedef float f32x16 __attribute__((ext_vector_type(16)));
typedef unsigned u32x4 __attribute__((ext_vector_type(4)));
typedef unsigned u32x2 __attribute__((ext_vector_type(2)));

constexpr int DM = 1024, NBATCH = 8, SEQ = 8192, CTX = 256, RB = CTX + SEQ;
constexpr int GB = 2, NGRP = NBATCH / GB, R = GB * RB;
constexpr int NP = 11520;
constexpr int C_QC = 0, C_KVC = 384, C_KR = 640, C_DQ = 768, C_DK = 1792, C_DV = 2816, C_SQ = 3840, C_SK = 4864, C_SV = 5120, C_Z = 5376, C_GM = 8448;
constexpr int D_IN = 11424;
constexpr float EPS = 1e-6f, LOG2E = 1.4426950408889634f;
constexpr float QS64 = 0.125f * LOG2E, QS96 = 0.10206207261596575f * LOG2E;
constexpr float NEGBIG = -1e30f, THR = 8.0f;

constexpr size_t al256(size_t x) { return (x + 255) & ~(size_t)255; }
constexpr size_t WS_WIN = 1u << 20;
constexpr size_t WS_WUQ = al256(WS_WIN + (size_t)2 * NP * 1024 * 2);
constexpr size_t WS_WUKV = al256(WS_WUQ + (size_t)2 * 768 * 384 * 2);
constexpr size_t WS_WB = al256(WS_WUKV + (size_t)2 * 1536 * 256 * 2);
constexpr size_t WS_WO3 = al256(WS_WB + (size_t)2 * 3 * 1024 * 1024 * 2);
constexpr size_t WS_COSH = al256(WS_WO3 + (size_t)2 * 1024 * 3072 * 2);
constexpr size_t WS_SINH = al256(WS_COSH + (size_t)SEQ * 32 * 4);
constexpr size_t WS_COSM = al256(WS_SINH + (size_t)SEQ * 32 * 4);
constexpr size_t WS_SINM = al256(WS_COSM + (size_t)SEQ * 16 * 4);
constexpr size_t WS_MODP = al256(WS_SINM + (size_t)SEQ * 16 * 4);
constexpr size_t WS_MOD = al256(WS_MODP + (size_t)16 * 2 * 9 * 3072 * 4);
constexpr size_t WS_CTX = al256(WS_MOD + (size_t)2 * 9 * 3072 * 4);
constexpr size_t WS_H = al256(WS_CTX + (size_t)NBATCH * CTX * DM * 4);
constexpr size_t WS_P = al256(WS_H + (size_t)R * DM * 2);
constexpr size_t WS_AQ = al256(WS_P + (size_t)R * NP * 2);
constexpr size_t WS_AKV = al256(WS_AQ + (size_t)R * 384 * 2);
constexpr size_t WS_QM = al256(WS_AKV + (size_t)R * 256 * 2);
constexpr size_t WS_KM = al256(WS_QM + (size_t)R * 768 * 2);
constexpr size_t WS_VM = al256(WS_KM + (size_t)R * 768 * 2);
constexpr size_t WS_OD = al256(WS_VM + (size_t)R * 1024 * 2);
constexpr size_t WS_END = al256(WS_OD + (size_t)R * 2048 * 4);
constexpr size_t WS_PART = WS_AQ;
static_assert(WS_END <= ((size_t)1 << 30), "workspace map exceeds 1 GiB");

constexpr int LDS_BYTES = 155648, XB_LDS_OFF = 155136;

DI unsigned pk2(float lo, float hi) { typedef float f2_t __attribute__((ext_vector_type(2))); typedef __bf16 b2_t __attribute__((ext_vector_type(2)));
    f2_t v = {lo, hi}; b2_t b = __builtin_convertvector(v, b2_t); return __builtin_bit_cast(unsigned, b); }
DI u32x4 pack8(f32x4 a, f32x4 b) { u32x4 w; w.x = pk2(a[0], a[1]); w.y = pk2(a[2], a[3]); w.z = pk2(b[0], b[1]); w.w = pk2(b[2], b[3]); return w; }
DI float bflo(unsigned w) { return __uint_as_float(w << 16); }
DI float bfhi(unsigned w) { return __uint_as_float(w & 0xffff0000u); }
DI float wave_sum(float v) {
#pragma unroll
    for (int o = 1; o < 64; o <<= 1) v += __shfl_xor(v, o);
    return v; }
DI float silu_f(float z) { return z * __builtin_amdgcn_rcpf(1.0f + __expf(-z)); }
DI float sigm_f(float z) { return __builtin_amdgcn_rcpf(1.0f + __expf(-z)); }
DI void rope8(f32x4& v0, f32x4& v1, const f32x4 cs, const f32x4 sn) {
    float a, b;
    a = v0[0]; b = v0[1]; v0[0] = a * cs[0] - b * sn[0]; v0[1] = b * cs[0] + a * sn[0];
    a = v0[2]; b = v0[3]; v0[2] = a * cs[1] - b * sn[1]; v0[3] = b * cs[1] + a * sn[1];
    a = v1[0]; b = v1[1]; v1[0] = a * cs[2] - b * sn[2]; v1[1] = b * cs[2] + a * sn[2];
    a = v1[2]; b = v1[3]; v1[2] = a * cs[3] - b * sn[3]; v1[3] = b * cs[3] + a * sn[3];
}
namespace pg8 {
#define PG8_LAS __attribute__((address_space(3)))
typedef unsigned short bf16_t;
typedef short bf16x8 __attribute__((ext_vector_type(8)));
typedef float f32x4 __attribute__((ext_vector_type(4)));
typedef unsigned u32x4 __attribute__((ext_vector_type(4)));
constexpr int BM = 256, BK = 64, HALF = 128, HTB = HALF * BK * 2  , STAGE_BYTES = 8 * HTB, NXCD = 8, WGM = 8;

__host__ __device__ __forceinline__ int lds_byte(int r, int c) { const int st = (r >> 4) * 2 + (c >> 5), rr = r & 15, cc = c & 31, ob = rr * 64 + cc * 2; return st * 1024 + (ob ^ (((ob >> 9) & 1) << 5)); }
__host__ __device__ __forceinline__ void stage_rc(int b, int& R, int& C) { const int st = b / 1024, sb = b % 1024, swz = sb ^ (((sb >> 9) & 1) << 5); R = (st >> 1) * 16 + swz / 64; C = (st & 1) * 32 + (swz % 64) / 2; }
__host__ __device__ __forceinline__ int perm32(int rho) { const int n = rho >> 4, i = rho & 15; return 8 * (i >> 2) + 4 * n + (i & 3); }

struct Unit { int pm, pn; };
struct Gemm { int K, lda, ldb; };
struct Order {
    int nM, nN, nwg, G, c; const char* A; const char* B; unsigned tA, tB; int pnblk; unsigned ablk; int skipctx;
    __device__ __forceinline__ void init(int M, int N, int G_, int c_, const void* A_, int lda, const void* B_, int ldb, int pnblk_, unsigned ablk_, int skipctx_ = 0) {
        skipctx = skipctx_; nM = M / BM; if (skipctx) nM -= nM / 33;
        nN = N / BM; nwg = nM * nN; G = G_; c = c_; A = (const char*)A_; B = (const char*)B_; tA = (unsigned)(BM * lda * 2); tB = (unsigned)(BM * ldb * 2); pnblk = pnblk_; ablk = ablk_; }
    __device__ __forceinline__ bool next(int i, Unit& u) const {
        const long L = (long)i * G + c; if (L >= nwg) return false;
        int wgid = (int)L; { const int q = nwg / NXCD, r = nwg % NXCD, xcd = wgid % NXCD, off = wgid / NXCD; wgid = (xcd < r ? xcd * (q + 1) : r * (q + 1) + (xcd - r) * q) + off; }
        const int nig = WGM * nN, gid = wgid / nig, fm = gid * WGM, gsz = (nM - fm) < WGM ? (nM - fm) : WGM;
        u.pm = fm + ((wgid % nig) % gsz); u.pn = (wgid % nig) / gsz; if (skipctx) u.pm += u.pm / 32 + 1; return true;
    }
    __device__ __forceinline__ const char* a_base(const Unit& u) const { return A + (size_t)u.pm * tA + (size_t)(u.pn / pnblk) * ablk; }
    __device__ __forceinline__ const char* b_base(const Unit& u) const { return B + (size_t)u.pn * tB; }
};

template <class Epi, class Sched, bool ALIGN_EPI = false, bool SP2 = false>
__device__ __forceinline__ void gemm_phase(PG8_LAS unsigned char* lds, const Gemm g, const Sched& S, const Epi& E) {
    const int tid = tid_l(), wid = __builtin_amdgcn_readfirstlane(tid >> 6), lane = tid & 63, wr = wid >> 2, wc = wid & 3, fr = lane & 15, fq = lane >> 4;
    const int K = g.K, nt = K / BK;
    unsigned voffA[2], voffB[2];
#pragma unroll
    for (int i = 0; i < 2; ++i) { int R, C; stage_rc(tid * 16 + i * 8192, R, C); const int Rb = Epi::PERM ? ((R & ~31) + perm32(R & 31)) : R;
        voffA[i] = (unsigned)(R * g.lda + C) * 2u; voffB[i] = (unsigned)(Rb * g.ldb + C) * 2u; }
    const size_t kstep = (size_t)(BK * 2);
    const size_t hstepA = (size_t)HALF * g.lda * 2, hstepB = (size_t)HALF * g.ldb * 2;
    const unsigned ldsw = (unsigned)wid * 1024u;
    const int aoff = lds_byte(wr * 64 + fr, fq * 8), boff = lds_byte(wc * 32 + fr, fq * 8);
#define PG8_SA(b, h) (((b) * 2 + (h)) * HTB)
#define PG8_SB(b, h) ((4 + (b) * 2 + (h)) * HTB)
#define PG8_STAGE(bufoff, gbase, voff) do { _Pragma("unroll") for (int _i = 0; _i < 2; ++_i) \
        __builtin_amdgcn_global_load_lds((const unsigned*)((const char*)(gbase) + (voff)[_i]), (PG8_LAS unsigned*)(lds + (bufoff) + ldsw + _i * 8192), 16, 0, 0); } while (0)
#define PG8_LDA(dst, b, h) do { _Pragma("unroll") for (int m = 0; m < 4; ++m) _Pragma("unroll") for (int k = 0; k < 2; ++k) dst[m][k] = *(const PG8_LAS bf16x8*)(lds + PG8_SA(b, h) + aoff + m * 2048 + k * 1024); } while (0)
#define PG8_LDB(dst, b, h) do { _Pragma("unroll") for (int n = 0; n < 2; ++n) _Pragma("unroll") for (int k = 0; k < 2; ++k) dst[n][k] = *(const PG8_LAS bf16x8*)(lds + PG8_SB(b, h) + boff + n * 2048 + k * 1024); } while (0)
#define PG8_MMA(ai, bj, At, Bt) do { __builtin_amdgcn_s_setprio(1); _Pragma("unroll") for (int m = 0; m < 4; ++m) _Pragma("unroll") for (int n = 0; n < 2; ++n) _Pragma("unroll") for (int k = 0; k < 2; ++k) \
        acc[ai][bj][m][n] = __builtin_amdgcn_mfma_f32_16x16x32_bf16(Bt[n][k], At[m][k], acc[ai][bj][m][n], 0, 0, 0); __builtin_amdgcn_s_setprio(0); } while (0)
#define PG8_WAIT_V(n) asm volatile("s_waitcnt vmcnt(" #n ")" ::: "memory")
#define PG8_WAIT_L(n) asm volatile("s_waitcnt lgkmcnt(" #n ")" ::: "memory")
#define PG8_BAR __builtin_amdgcn_s_barrier()
#define PG8_SCHED __builtin_amdgcn_sched_barrier(0)
    Unit cur, nxt; int ui = 0;
    if (!S.next(0, cur)) return;
    f32x4 acc[2][2][4][2];
#pragma unroll
    for (int a = 0; a < 2; ++a)
#pragma unroll
        for (int b = 0; b < 2; ++b)
#pragma unroll
            for (int m = 0; m < 4; ++m)
#pragma unroll
                for (int n = 0; n < 2; ++n) acc[a][b][m][n] = (f32x4){0.f, 0.f, 0.f, 0.f};
    bf16x8 At[4][2], B0[2][2], B1[2][2];
    const char* cA = S.a_base(cur); const char* cB = S.b_base(cur);

    if constexpr (SP2) {
        PG8_STAGE(PG8_SB(0, 0), cB, voffB); PG8_STAGE(PG8_SB(0, 1), cB + hstepB, voffB); PG8_STAGE(PG8_SA(0, 0), cA, voffA); PG8_STAGE(PG8_SA(0, 1), cA + hstepA, voffA);
        if (wr == 1) PG8_BAR;
        PG8_WAIT_V(2); PG8_BAR;
        PG8_STAGE(PG8_SB(1, 0), cB + kstep, voffB); PG8_STAGE(PG8_SA(1, 0), cA + kstep, voffA); PG8_STAGE(PG8_SB(1, 1), cB + hstepB + kstep, voffB);
        PG8_WAIT_V(6); PG8_BAR;
    } else {
        PG8_STAGE(PG8_SB(0, 0), cB, voffB); PG8_STAGE(PG8_SA(0, 0), cA, voffA); PG8_STAGE(PG8_SB(0, 1), cB + hstepB, voffB); PG8_STAGE(PG8_SA(0, 1), cA + hstepA, voffA);
        if (wr == 1) PG8_BAR;
        PG8_WAIT_V(4); PG8_BAR;
        PG8_STAGE(PG8_SB(1, 0), cB + kstep, voffB); PG8_STAGE(PG8_SA(1, 0), cA + kstep, voffA); PG8_STAGE(PG8_SB(1, 1), cB + hstepB + kstep, voffB);
        PG8_WAIT_V(6); PG8_BAR;
    }
    for (;;) {
        const bool has_next = S.next(ui + 1, nxt);
        const char* nA = has_next ? S.a_base(nxt) : cA; const char* nB = has_next ? S.b_base(nxt) : cB;
#pragma nounroll
        for (int t = 0; t < nt; t += 2) {
            const bool last = (t == nt - 2);
            const char* a1 = cA + (size_t)(t + 1) * kstep;
            const char* a2 = last ? nA : cA + (size_t)(t + 2) * kstep; const char* b2 = last ? nB : cB + (size_t)(t + 2) * kstep;
            const char* a3 = a2 + kstep; const char* b3 = b2 + kstep;

            if constexpr (SP2) {
            PG8_LDB(B0, 0, 0); PG8_LDB(B1, 0, 1); PG8_SCHED; PG8_LDA(At, 0, 0); PG8_STAGE(PG8_SA(1, 1), a1 + hstepA, voffA);
            PG8_WAIT_V(8); PG8_WAIT_L(0); PG8_BAR; PG8_MMA(0, 0, At, B0); PG8_MMA(0, 1, At, B1); PG8_BAR; PG8_SCHED;
            PG8_LDA(At, 0, 1); PG8_STAGE(PG8_SB(0, 0), b2, voffB); PG8_STAGE(PG8_SB(0, 1), b2 + hstepB, voffB); PG8_STAGE(PG8_SA(0, 0), a2, voffA);
            PG8_WAIT_V(8); PG8_WAIT_L(0); PG8_BAR; PG8_MMA(1, 0, At, B0); PG8_MMA(1, 1, At, B1); PG8_BAR; PG8_SCHED;
            PG8_LDB(B0, 1, 0); PG8_LDB(B1, 1, 1); PG8_SCHED; PG8_LDA(At, 1, 0); PG8_STAGE(PG8_SA(0, 1), a2 + hstepA, voffA);
            PG8_WAIT_V(8); PG8_WAIT_L(0); PG8_BAR; PG8_MMA(0, 0, At, B0); PG8_MMA(0, 1, At, B1); PG8_BAR; PG8_SCHED;
            PG8_LDA(At, 1, 1); PG8_STAGE(PG8_SB(1, 0), b3, voffB); PG8_STAGE(PG8_SB(1, 1), b3 + hstepB, voffB); PG8_STAGE(PG8_SA(1, 0), a3, voffA);
            PG8_WAIT_V(8); PG8_WAIT_L(0); PG8_BAR; PG8_MMA(1, 0, At, B0); PG8_MMA(1, 1, At, B1); PG8_BAR; PG8_SCHED;
            } else {
            PG8_LDB(B0, 0, 0); PG8_SCHED; PG8_LDA(At, 0, 0); PG8_STAGE(PG8_SA(1, 1), a1 + hstepA, voffA);
            PG8_WAIT_L(8); PG8_BAR; PG8_WAIT_L(0); PG8_MMA(0, 0, At, B0); PG8_BAR; PG8_SCHED;
            PG8_LDB(B1, 0, 1); PG8_STAGE(PG8_SB(0, 0), b2, voffB);
            PG8_BAR; PG8_WAIT_L(0); PG8_MMA(0, 1, At, B1); PG8_BAR;
            PG8_LDA(At, 0, 1); PG8_STAGE(PG8_SA(0, 0), a2, voffA);
            PG8_BAR; PG8_WAIT_L(0); PG8_MMA(1, 0, At, B0); PG8_BAR; PG8_SCHED;
            PG8_STAGE(PG8_SB(0, 1), b2 + hstepB, voffB);
            PG8_WAIT_V(6); PG8_BAR; PG8_MMA(1, 1, At, B1); PG8_BAR;
            PG8_LDB(B0, 1, 0); PG8_SCHED; PG8_LDA(At, 1, 0); PG8_STAGE(PG8_SA(0, 1), a2 + hstepA, voffA);
            PG8_WAIT_L(8); PG8_BAR; PG8_WAIT_L(0); PG8_MMA(0, 0, At, B0); PG8_BAR; PG8_SCHED;
            PG8_LDB(B1, 1, 1); PG8_STAGE(PG8_SB(1, 0), b3, voffB);
            PG8_BAR; PG8_WAIT_L(0); PG8_MMA(0, 1, At, B1); PG8_BAR;
            PG8_LDA(At, 1, 1); PG8_STAGE(PG8_SA(1, 0), a3, voffA);
            PG8_BAR; PG8_WAIT_L(0); PG8_MMA(1, 0, At, B0); PG8_BAR; PG8_SCHED;
            PG8_STAGE(PG8_SB(1, 1), b3 + hstepB, voffB);
            PG8_WAIT_V(6); PG8_BAR; PG8_MMA(1, 1, At, B1); PG8_BAR;
            }
        }
        if constexpr (ALIGN_EPI) { if (wr == 0) PG8_BAR; }
        if constexpr (!Epi::AFTER_DRAIN) { E(acc, cur, wr, wc, fr, fq); }
        if (!has_next) break;
#pragma unroll
        for (int a = 0; a < 2; ++a)
#pragma unroll
            for (int b = 0; b < 2; ++b)
#pragma unroll
                for (int m = 0; m < 4; ++m)
#pragma unroll
                    for (int n = 0; n < 2; ++n) acc[a][b][m][n] = (f32x4){0.f, 0.f, 0.f, 0.f};
        cur = nxt; cA = nA; cB = nB; ++ui;
        if constexpr (ALIGN_EPI) { if (wr == 1) PG8_BAR; }
    }
    PG8_WAIT_V(0);
    if constexpr (!ALIGN_EPI) { if (wr == 0) PG8_BAR; }
    PG8_BAR;
    if constexpr (Epi::AFTER_DRAIN) { E.fused(acc, cur, wr, wc, fr, fq, lds, wid, lane); }
#undef PG8_SA
#undef PG8_SB
#undef PG8_STAGE
#undef PG8_LDA
#undef PG8_LDB
#undef PG8_MMA
#undef PG8_WAIT_V
#undef PG8_WAIT_L
#undef PG8_BAR
#undef PG8_SCHED
}
}
struct EpiIn {
    static constexpr bool PERM = true, AFTER_DRAIN = false;
    unsigned char* ws;
    DI void operator()(const f32x4 (&acc)[2][2][4][2], const pg8::Unit& u, int wr, int wc, int fr, int fq) const {
        bf16_t* P = (bf16_t*)(ws + WS_P); const float* cosH = (const float*)(ws + WS_COSH); const float* sinH = (const float*)(ws + WS_SINH); const float* cosM = (const float*)(ws + WS_COSM); const float* sinM = (const float*)(ws + WS_SINM);
        const int pn = u.pn; const bool ctxt = (u.pm % 33) == 0;
        int mode = 0; float sc = 1.f;
        if ((pn >= 3 && pn <= 10) || (pn >= 15 && pn <= 19)) mode = 1;
        if (pn == 2) mode = 2;
        if ((pn >= 3 && pn <= 6) || (pn >= 15 && pn <= 18)) sc = QS64;
        if (ctxt) mode = 0;
        const int rowt = u.pm * 256 + wr * 64 + fr, colb = pn * 256 + wc * 32 + 8 * fq;
#pragma unroll
        for (int ai = 0; ai < 2; ++ai)
#pragma unroll
            for (int m = 0; m < 4; ++m) {
                const int row = rowt + ai * 128 + m * 16; const int pos = (row % RB) - CTX;
                bf16_t* rowp = P + (size_t)row * NP;
#pragma unroll
                for (int bj = 0; bj < 2; ++bj) {
                    const int col0 = colb + bj * 128;
                    f32x4 v0 = acc[ai][bj][m][0], v1 = acc[ai][bj][m][1];
                    if (pn <= 2) {
                        float s8 = (v0[0] * v0[0] + v0[1] * v0[1]) + (v0[2] * v0[2] + v0[3] * v0[3]) + (v1[0] * v1[0] + v1[1] * v1[1]) + (v1[2] * v1[2] + v1[3] * v1[3]);
                        s8 += __shfl_xor(s8, 16); s8 += __shfl_xor(s8, 32);
                        const int slice = pn * 8 + bj * 4 + wc;
                        if (fq == 0 && slice < 20) ((float*)(ws + WS_PART))[(size_t)row * 20 + slice] = s8;
                    }
                    if (mode == 1) { const int p0 = (col0 & 63) >> 1; const f32x4 cs = *(const f32x4*)(cosH + (size_t)pos * 32 + p0), sn = *(const f32x4*)(sinH + (size_t)pos * 32 + p0); rope8(v0, v1, cs, sn); }
                    else if (mode == 2 && col0 >= C_KR && col0 < C_KR + 32) { const int p0 = (col0 - C_KR) >> 1; const f32x4 cs = *(const f32x4*)(cosM + (size_t)pos * 16 + p0), sn = *(const f32x4*)(sinM + (size_t)pos * 16 + p0); rope8(v0, v1, cs, sn); }
                    v0 = v0 * sc; v1 = v1 * sc;
                    const u32x4 w8 = pack8(v0, v1);
                    *(u32x4*)(rowp + col0) = w8;
                    if (pn == 2 && col0 >= C_KR && col0 < C_KR + 32) {
                        bf16_t* km = (bf16_t*)(ws + WS_KM) + (size_t)row * 768 + 64 + (col0 - C_KR);
#pragma unroll
                        for (int h = 0; h < 8; ++h) *(u32x4*)(km + h * 96) = w8;
                    }
                }
            }
    }
};
struct EpiQ {
    static constexpr bool PERM = true, AFTER_DRAIN = false;
    unsigned char* ws;
    DI void operator()(const f32x4 (&acc)[2][2][4][2], const pg8::Unit& u, int wr, int wc, int fr, int fq) const {
        bf16_t* QM = (bf16_t*)(ws + WS_QM); const float* cosM = (const float*)(ws + WS_COSM); const float* sinM = (const float*)(ws + WS_SINM);
        const bool ctxt = (u.pm % 33) == 0;
        const int rowt = u.pm * 256 + wr * 64 + fr, colb = u.pn * 256 + wc * 32 + 8 * fq;
#pragma unroll
        for (int ai = 0; ai < 2; ++ai)
#pragma unroll
            for (int m = 0; m < 4; ++m) {
                const int row = rowt + ai * 128 + m * 16; const int pos = (row % RB) - CTX;
                const float* pr = (const float*)(ws + WS_PART) + (size_t)row * 20;
                const f32x4 q0 = *(const f32x4*)pr, q1 = *(const f32x4*)(pr + 4), q2 = *(const f32x4*)(pr + 8);
                const float rq = QS96 / sqrtf((((q0[0] + q0[1]) + (q0[2] + q0[3])) + ((q1[0] + q1[1]) + (q1[2] + q1[3])) + ((q2[0] + q2[1]) + (q2[2] + q2[3]))) * (1.0f / 384.0f) + EPS);
#pragma unroll
                for (int bj = 0; bj < 2; ++bj) {
                    const int col0 = colb + bj * 128, within = col0 % 96;
                    f32x4 v0 = acc[ai][bj][m][0], v1 = acc[ai][bj][m][1];
                    if (!ctxt && within >= 64) { const int p0 = (within - 64) >> 1; const f32x4 cs = *(const f32x4*)(cosM + (size_t)pos * 16 + p0), sn = *(const f32x4*)(sinM + (size_t)pos * 16 + p0); rope8(v0, v1, cs, sn); }
                    v0 = v0 * rq; v1 = v1 * rq;
                    *(u32x4*)(QM + (size_t)row * 768 + col0) = pack8(v0, v1);
                }
                asm volatile("" ::: "memory");
            }
    }
};
struct EpiKV {
    static constexpr bool PERM = true, AFTER_DRAIN = false;
    unsigned char* ws;
    DI void operator()(const f32x4 (&acc)[2][2][4][2], const pg8::Unit& u, int wr, int wc, int fr, int fq) const {
        bf16_t* KM = (bf16_t*)(ws + WS_KM); bf16_t* VM = (bf16_t*)(ws + WS_VM);
        const int rowt = u.pm * 256 + wr * 64 + fr, colb = u.pn * 256 + wc * 32 + 8 * fq;
#pragma unroll
        for (int ai = 0; ai < 2; ++ai)
#pragma unroll
            for (int m = 0; m < 4; ++m) {
                const int row = rowt + ai * 128 + m * 16;
                const float* pr = (const float*)(ws + WS_PART) + (size_t)row * 20 + 12;
                const f32x4 k0 = *(const f32x4*)pr, k1 = *(const f32x4*)(pr + 4);
                const float rkv = 1.0f / sqrtf((((k0[0] + k0[1]) + (k0[2] + k0[3])) + ((k1[0] + k1[1]) + (k1[2] + k1[3]))) * (1.0f / 256.0f) + EPS);
#pragma unroll
                for (int bj = 0; bj < 2; ++bj) {
                    const int col0 = colb + bj * 128;
                    bf16_t* dst = (col0 < 512) ? KM + (size_t)row * 768 + (col0 >> 6) * 96 + (col0 & 63) : VM + (size_t)row * 1024 + (col0 - 512);
                    *(u32x4*)dst = pack8(acc[ai][bj][m][0] * rkv, acc[ai][bj][m][1] * rkv);
                }
                asm volatile("" ::: "memory");
            }
    }
};
template <bool DRYE> struct EpiBrT {
    static constexpr bool PERM = true, AFTER_DRAIN = false;
    unsigned char* ws;
    DI void operator()(const f32x4 (&acc)[2][2][4][2], const pg8::Unit& u, int wr, int wc, int fr, int fq) const {
        bf16_t* P = (bf16_t*)(ws + WS_P);
        unsigned chk = 0u;
        const int rowt = u.pm * 256 + wr * 64 + fr, colb = u.pn * 256 + wc * 32 + 8 * fq;
#pragma unroll
        for (int ai = 0; ai < 2; ++ai)
#pragma unroll
            for (int m = 0; m < 4; ++m) {
                const int row = rowt + ai * 128 + m * 16;
#pragma unroll
                for (int bj = 0; bj < 2; ++bj) {
                    bf16_t* p = P + (size_t)row * NP + C_GM + colb + bj * 128;
                    const u32x4 g = *(const u32x4*)p;
                    f32x4 v0 = acc[ai][bj][m][0], v1 = acc[ai][bj][m][1];
                    v0[0] *= sigm_f(bflo(g.x)); v0[1] *= sigm_f(bfhi(g.x)); v0[2] *= sigm_f(bflo(g.y)); v0[3] *= sigm_f(bfhi(g.y));
                    v1[0] *= sigm_f(bflo(g.z)); v1[1] *= sigm_f(bfhi(g.z)); v1[2] *= sigm_f(bflo(g.w)); v1[3] *= sigm_f(bfhi(g.w));
                    { const u32x4 w_ = pack8(v0, v1); if (!DRYE) *(u32x4*)p = w_; else chk ^= w_.x ^ w_.y ^ w_.z ^ w_.w; }
                }
            }
        if (DRYE && chk == 0x12345678u) *(unsigned*)P = chk;
    }
};
template <bool DRYE> struct EpiOutT {
    static constexpr bool PERM = true, AFTER_DRAIN = false;
    int l, g; const float* xsrc; float* xdst; const float* ctxsrc; unsigned char* ws;
    DI void operator()(const f32x4 (&acc)[2][2][4][2], const pg8::Unit& u, int wr, int wc, int fr, int fq) const {
        float* ctxdst = (float*)(ws + WS_CTX); const float* mod = (const float*)(ws + WS_MOD) + (size_t)l * 9 * 3072;
        const int pmb = u.pm % 33, b = g * GB + u.pm / 33; const bool ctxt = pmb == 0;
        if (ctxt && l != 0) return;
        const float* gate = mod + (size_t)(ctxt ? 8 : b) * 3072 + 2048;
        const int colb = u.pn * 256 + wc * 32 + 8 * fq;
#pragma unroll
        for (int ai = 0; ai < 2; ++ai)
#pragma unroll
            for (int m = 0; m < 4; ++m) {
                const int j = pmb * 256 + ai * 128 + wr * 64 + m * 16 + fr;
                const size_t idx = ctxt ? ((size_t)b * CTX + j) * DM : ((size_t)b * SEQ + (j - CTX)) * DM;
                const float* s = (ctxt ? ctxsrc : xsrc) + idx; float* d = (ctxt ? ctxdst : xdst) + idx;
#pragma unroll
                for (int bj = 0; bj < 2; ++bj) {
                    const int col0 = colb + bj * 128;
                    const f32x4 g0 = *(const f32x4*)(gate + col0), g1 = *(const f32x4*)(gate + col0 + 4);
                    const f32x4 x0 = *(const f32x4*)(s + col0), x1 = *(const f32x4*)(s + col0 + 4);
                    if (!DRYE || x0[0] == 12345.678f) { *(f32x4*)(d + col0) = x0 + g0 * acc[ai][bj][m][0];
                    *(f32x4*)(d + col0 + 4) = x1 + g1 * acc[ai][bj][m][1]; }
                }
            }
    }
};

#define MFMA32(a, b, c) __builtin_amdgcn_mfma_f32_32x32x16_bf16((a), (b), (c), 0, 0, 0)
DI s16x4 tr16(const LAS unsigned char* p) { typedef short v4i16_t __attribute__((ext_vector_type(4))); return __builtin_bit_cast(s16x4, __builtin_amdgcn_ds_read_tr16_b64_v4i16((LAS v4i16_t*)p)); }
constexpr int AT_KOFF = 0, AT_KBUFMAX = 13312, AT_VOFF = 3 * AT_KBUFMAX, AT_VBUFMAX = 20480, AT_SOFF = AT_VOFF + 3 * AT_VBUFMAX, AT_QOFF = AT_SOFF + 1024;
static_assert(AT_QOFF + 8 * 6144 <= LDS_BYTES, "attention LDS map");
#ifndef AT_LAZY
#define AT_LAZY 1
#endif
#ifndef AT_NOPF
#define AT_NOPF 1
#endif
#ifndef AT_IGLP
#define AT_IGLP -1
#endif
#ifndef AT_QLMIN
#define AT_QLMIN 64
#endif
#ifndef AT_PVKS
#define AT_PVKS 1
#endif
#ifndef AT_SGB
#define AT_SGB 0
#endif
#ifndef AT_PV8
#define AT_PV8 1
#endif
#ifndef AT_NOSBAR
#define AT_NOSBAR 1
#endif
#if AT_NOSBAR
#define SBAR() do {} while (0)
#else
#define SBAR() __builtin_amdgcn_sched_barrier(0)
#endif
#ifndef PROBE_MODE
#define PROBE_MODE 0
#endif
#ifndef DRY_SEL
#define DRY_SEL 7
#endif
#ifndef AT_QL
#define AT_QL 1
#endif
#ifndef AT_SB
#define AT_SB 0
#endif
template <int DQK, bool QL>
DI void at_qkt(f32x16& p0, f32x16& p1, const LAS unsigned char* kb, const bf16x8* qf, const LAS unsigned char* qb) {
    constexpr int KSTR = DQK + 8;
#pragma unroll
    for (int r = 0; r < 16; ++r) { p0[r] = 0.f; p1[r] = 0.f; }
#pragma unroll
    for (int ds = 0; ds < DQK / 16; ++ds) {
        const bf16x8 k0 = *(const LAS bf16x8*)(kb + ds * 32), k1 = *(const LAS bf16x8*)(kb + 32 * (KSTR * 2) + ds * 32);
        bf16x8 q; if (QL) q = *(const LAS bf16x8*)(qb + ds * 1024); else q = qf[ds];
        p0 = MFMA32(k0, q, p0); p1 = MFMA32(k1, q, p1);
        if (AT_SB && DQK > 64 && (ds & 1)) __builtin_amdgcn_sched_barrier(0x7f); }
}
DI void at_mask(f32x16& p0, f32x16& p1, int dk) {
#pragma unroll
    for (int r = 0; r < 16; ++r) { const int d = dk + (r & 3) + 8 * (r >> 2);
        if (d > 128 || d < -128) p0[r] = NEGBIG;
        if (d + 32 > 128 || d + 32 < -128) p1[r] = NEGBIG; }
}
DI void at_psm(f32x16& p0, f32x16& p1, float& mrun, float& alpha) {
    float ma = fmaxf(fmaxf(p0[0], p0[1]), p0[2]), mb = fmaxf(fmaxf(p1[0], p1[1]), p1[2]);
    ma = fmaxf(fmaxf(ma, p0[3]), p1[3]);
#pragma unroll
    for (int r = 4; r < 16; r += 2) { ma = fmaxf(fmaxf(ma, p0[r]), p0[r + 1]); mb = fmaxf(fmaxf(mb, p1[r]), p1[r + 1]); }
    float mx = fmaxf(ma, mb);
    { auto rr = __builtin_amdgcn_permlane32_swap(__float_as_uint(mx), __float_as_uint(mx), false, false); mx = fmaxf(__uint_as_float(rr[0]), __uint_as_float(rr[1])); }
    const bool keep = __all(mx - mrun <= THR);
    const float mn = keep ? mrun : fmaxf(mrun, mx); alpha = __builtin_amdgcn_exp2f(mrun - mn); mrun = mn;
#pragma unroll
    for (int r = 0; r < 16; ++r) { p0[r] -= mrun; p1[r] -= mrun; }
#pragma unroll
    for (int r = 0; r < 16; ++r) p0[r] = __builtin_amdgcn_exp2f(p0[r]);
}
DI void at_psm_lazy(f32x16& p0, f32x16& p1, float mrun) {
#pragma unroll
    for (int r = 0; r < 16; ++r) { p0[r] -= mrun; p1[r] -= mrun; }
#pragma unroll
    for (int r = 0; r < 16; ++r) p0[r] = __builtin_amdgcn_exp2f(p0[r]);
}
DI void at_fsm_lazy(f32x16& p0, f32x16& p1, float& mrun, float& alpha, float& lrun, bf16x8* pa) {
#pragma unroll
    for (int r = 0; r < 16; ++r) p1[r] = __builtin_amdgcn_exp2f(p1[r]);
    float ps = 0.f;
#pragma unroll
    for (int r = 0; r < 16; ++r) ps += p0[r] + p1[r];
    alpha = 1.f;
    if (__builtin_expect(__any(!(ps <= 1048576.0f)), 0)) {
        float ma = fmaxf(fmaxf(p0[0], p0[1]), p0[2]), mb = fmaxf(fmaxf(p1[0], p1[1]), p1[2]);
        ma = fmaxf(fmaxf(ma, p0[3]), p1[3]);
#pragma unroll
        for (int r = 4; r < 16; r += 2) { ma = fmaxf(fmaxf(ma, p0[r]), p0[r + 1]); mb = fmaxf(fmaxf(mb, p1[r]), p1[r + 1]); }
        float mx = fmaxf(ma, mb);
        { auto rr = __builtin_amdgcn_permlane32_swap(__float_as_uint(mx), __float_as_uint(mx), false, false); mx = fmaxf(__uint_as_float(rr[0]), __uint_as_float(rr[1])); }
        const float d = fmaxf(__builtin_amdgcn_logf(mx), 0.f);
        alpha = __builtin_amdgcn_exp2f(-d); mrun += d; ps *= alpha;
#pragma unroll
        for (int r = 0; r < 16; ++r) { p0[r] *= alpha; p1[r] *= alpha; }
    }
    lrun = lrun * alpha + ps;
    u32x4 w;
    w.x = pk2(p0[0], p0[1]); w.y = pk2(p0[2], p0[3]); w.z = pk2(p0[4], p0[5]); w.w = pk2(p0[6], p0[7]); pa[0] = __builtin_bit_cast(bf16x8, w);
    w.x = pk2(p0[8], p0[9]); w.y = pk2(p0[10], p0[11]); w.z = pk2(p0[12], p0[13]); w.w = pk2(p0[14], p0[15]); pa[1] = __builtin_bit_cast(bf16x8, w);
    w.x = pk2(p1[0], p1[1]); w.y = pk2(p1[2], p1[3]); w.z = pk2(p1[4], p1[5]); w.w = pk2(p1[6], p1[7]); pa[2] = __builtin_bit_cast(bf16x8, w);
    w.x = pk2(p1[8], p1[9]); w.y = pk2(p1[10], p1[11]); w.z = pk2(p1[12], p1[13]); w.w = pk2(p1[14], p1[15]); pa[3] = __builtin_bit_cast(bf16x8, w);
}
DI void at_fsm(f32x16& p0, f32x16& p1, float alpha, float& lrun, bf16x8* pa) {
#pragma unroll
    for (int r = 0; r < 16; ++r) p1[r] = __builtin_amdgcn_exp2f(p1[r]);
    float ps = 0.f;
#pragma unroll
    for (int r = 0; r < 16; ++r) ps += p0[r] + p1[r];
    lrun = lrun * alpha + ps;
    u32x4 w;
    w.x = pk2(p0[0], p0[1]); w.y = pk2(p0[2], p0[3]); w.z = pk2(p0[4], p0[5]); w.w = pk2(p0[6], p0[7]); pa[0] = __builtin_bit_cast(bf16x8, w);
    w.x = pk2(p0[8], p0[9]); w.y = pk2(p0[10], p0[11]); w.z = pk2(p0[12], p0[13]); w.w = pk2(p0[14], p0[15]); pa[1] = __builtin_bit_cast(bf16x8, w);
    w.x = pk2(p1[0], p1[1]); w.y = pk2(p1[2], p1[3]); w.z = pk2(p1[4], p1[5]); w.w = pk2(p1[6], p1[7]); pa[2] = __builtin_bit_cast(bf16x8, w);
    w.x = pk2(p1[8], p1[9]); w.y = pk2(p1[10], p1[11]); w.z = pk2(p1[12], p1[13]); w.w = pk2(p1[14], p1[15]); pa[3] = __builtin_bit_cast(bf16x8, w);
}
DI void at_fsm_fake(f32x16& p0, f32x16& p1, bf16x8* pa) {
    u32x4 w;
    w.x = pk2(p0[0], p0[1]); w.y = pk2(p0[2], p0[3]); w.z = pk2(p0[4], p0[5]); w.w = pk2(p0[6], p0[7]); pa[0] = __builtin_bit_cast(bf16x8, w);
    w.x = pk2(p0[8], p0[9]); w.y = pk2(p0[10], p0[11]); w.z = pk2(p0[12], p0[13]); w.w = pk2(p0[14], p0[15]); pa[1] = __builtin_bit_cast(bf16x8, w);
    w.x = pk2(p1[0], p1[1]); w.y = pk2(p1[2], p1[3]); w.z = pk2(p1[4], p1[5]); w.w = pk2(p1[6], p1[7]); pa[2] = __builtin_bit_cast(bf16x8, w);
    w.x = pk2(p1[8], p1[9]); w.y = pk2(p1[10], p1[11]); w.z = pk2(p1[12], p1[13]); w.w = pk2(p1[14], p1[15]); pa[3] = __builtin_bit_cast(bf16x8, w);
}
template <int DV>
DI void at_pv(f32x16* o, const LAS unsigned char* vb, const bf16x8* pa) {
    constexpr int VSTR = DV + 32;
#if AT_PVKS
#pragma unroll
    for (int ks = 0; ks < 4; ++ks) {
        s16x4 vlo[DV / 32], vhi[DV / 32];
#pragma unroll
        for (int db = 0; db < DV / 32; ++db) { vlo[db] = tr16(vb + (16 * ks) * (VSTR * 2) + db * 64); vhi[db] = tr16(vb + (16 * ks + 8) * (VSTR * 2) + db * 64); }
#pragma unroll
        for (int db = 0; db < DV / 32; ++db) { const bf16x8 vf = __builtin_shufflevector(vlo[db], vhi[db], 0, 1, 2, 3, 4, 5, 6, 7); o[db] = MFMA32(pa[ks], vf, o[db]); }
    }
#else
#pragma unroll
    for (int db = 0; db < DV / 32; ++db) {
        s16x4 vlo[4], vhi[4];
#pragma unroll
        for (int ks = 0; ks < 4; ++ks) { vlo[ks] = tr16(vb + (16 * ks) * (VSTR * 2) + db * 64); vhi[ks] = tr16(vb + (16 * ks + 8) * (VSTR * 2) + db * 64); }
#pragma unroll
        for (int ks = 0; ks < 4; ++ks) { const bf16x8 vf = __builtin_shufflevector(vlo[ks], vhi[ks], 0, 1, 2, 3, 4, 5, 6, 7); o[db] = MFMA32(pa[ks], vf, o[db]); }
    }
#endif
}
template <int DV>
DI void at_scale_o(f32x16* o, LAS float* scw, float val, int r32, int hi) {
    if (hi == 0) scw[r32] = val;
    __builtin_amdgcn_wave_barrier(); asm volatile("" ::: "memory");
#pragma unroll
    for (int g4 = 0; g4 < 4; ++g4) { const f32x4 a4 = *(const LAS f32x4*)(scw + 8 * g4 + 4 * hi);
#pragma unroll
        for (int db = 0; db < DV / 32; ++db) { o[db][4 * g4 + 0] *= a4[0]; o[db][4 * g4 + 1] *= a4[1]; o[db][4 * g4 + 2] *= a4[2]; o[db][4 * g4 + 3] *= a4[3]; } }
    __builtin_amdgcn_wave_barrier(); asm volatile("" ::: "memory");
}
template <int DQK, int DV, int OUTM, bool MASKED>
DI void attn_unit(LAS unsigned char* lds, const bf16_t* Qp, int ldq, const bf16_t* Kp, int ldk, const bf16_t* Vp, int ldv,
                  int nA, int rowB0, int nB, int posB0, int qpos0, float m0, float l0,
                  bf16_t* Og, int ldo, float* Of, int ldof) {
    constexpr int KSTR = DQK + 8, VSTR = DV + 32, KBUF = 64 * KSTR * 2, VBUF = 64 * VSTR * 2;
    constexpr int KCH = DQK / 8, VCH = DV / 8, NKC = 64 * KCH, NVC = 64 * VCH, KRN = (NKC + 511) / 512, VRN = (NVC + 511) / 512;
    static_assert(KBUF <= AT_KBUFMAX && VBUF <= AT_VBUFMAX, "attention LDS map");
    const int tid = tid_l(), lane = tid & 63, wid = __builtin_amdgcn_readfirstlane(tid >> 6), r32 = lane & 31, hi = lane >> 5;
#ifndef AT_QL
#define AT_QL 1
#endif
#ifndef AT_SB
#define AT_SB 0
#endif
    constexpr bool QL = AT_QL && (DQK > AT_QLMIN);
    bf16x8 qf[QL ? 1 : DQK / 16];
    const LAS unsigned char* qb = lds + AT_QOFF + wid * 6144 + lane * 16;
    { const bf16_t* qrow = Qp + (size_t)(32 * wid + r32) * ldq + 8 * hi;
#pragma unroll
      for (int ds = 0; ds < DQK / 16; ++ds) { const bf16x8 v = *(const bf16x8*)(qrow + 16 * ds); if (QL) *(LAS bf16x8*)(lds + AT_QOFF + wid * 6144 + lane * 16 + ds * 1024) = v; else qf[QL ? 0 : ds] = v; }
      if (QL) { __builtin_amdgcn_wave_barrier(); asm volatile("s_waitcnt lgkmcnt(0)" ::: "memory"); } }
    f32x16 o[DV / 32];
#pragma unroll
    for (int db = 0; db < DV / 32; ++db)
#pragma unroll
        for (int r = 0; r < 16; ++r) o[db][r] = 0.f;
    float mrun = m0, lrun = (hi == 0) ? l0 : 0.f;
    LAS float* scw = (LAS float*)(lds + AT_SOFF) + wid * 32;
    const int NT = nA + nB;
    const LAS unsigned char* kb0 = lds + AT_KOFF + r32 * (KSTR * 2) + hi * 16;
    const LAS unsigned char* vb0 = lds + AT_VOFF + (4 * hi + ((lane & 15) >> 2)) * (VSTR * 2) + (16 * ((lane >> 4) & 1) + 4 * (lane & 3)) * 2;
    const int dk0 = posB0 + 4 * hi - (qpos0 + 32 * wid + r32) - 64 * nA;
    u32x4 kreg[KRN], vreg[VRN];
    int kgo[KRN], klo[KRN], vgo[VRN], vlo_[VRN];
#pragma unroll
    for (int i_ = 0; i_ < KRN; ++i_) { int c_ = tid + 512 * i_; if (c_ >= NKC) c_ -= 512; const int r_ = c_ / KCH, cc_ = c_ % KCH; kgo[i_] = r_ * ldk + cc_ * 8; klo[i_] = AT_KOFF + r_ * (KSTR * 2) + cc_ * 16; }
#pragma unroll
    for (int i_ = 0; i_ < VRN; ++i_) { int c_ = tid + 512 * i_; if (c_ >= NVC) c_ -= 512; const int r_ = c_ / VCH, cc_ = c_ % VCH; vgo[i_] = r_ * ldv + cc_ * 8; vlo_[i_] = AT_VOFF + r_ * (VSTR * 2) + cc_ * 16; }
    const __amdgpu_buffer_rsrc_t rK = __builtin_amdgcn_make_buffer_rsrc((void*)Kp, 0, 0x7fffffff, 0x00020000), rV = __builtin_amdgcn_make_buffer_rsrc((void*)Vp, 0, 0x7fffffff, 0x00020000);
#define AT_GLOAD(t) do { const int row0_ = (t) < nA ? 64 * (t) : rowB0 + 64 * ((t) - nA); const int sk_ = row0_ * ldk * 2, sv_ = row0_ * ldv * 2; \
        _Pragma("unroll") for (int i_ = 0; i_ < KRN; ++i_) kreg[i_] = __builtin_amdgcn_raw_buffer_load_b128(rK, kgo[i_] * 2, sk_, 0); \
        _Pragma("unroll") for (int i_ = 0; i_ < VRN; ++i_) vreg[i_] = __builtin_amdgcn_raw_buffer_load_b128(rV, vgo[i_] * 2, sv_, 0); } while (0)
#define AT_SWRITE(buf) do { \
        _Pragma("unroll") for (int i_ = 0; i_ < KRN; ++i_) *(LAS u32x4*)(lds + (buf) * KBUF + klo[i_]) = kreg[i_]; \
        _Pragma("unroll") for (int i_ = 0; i_ < VRN; ++i_) *(LAS u32x4*)(lds + (buf) * VBUF + vlo_[i_]) = vreg[i_]; } while (0)
    unsigned pfv = 0u, pfacc = 0u;
    const int pft = tid & 255;
    const bf16_t* pfb = (pft < 128) ? Kp + (pft >> 1) * ldk + (pft & 1) * (DQK - 2) : Vp + ((pft - 128) >> 1) * ldv + (pft & 1) * (DV - 2);
    const int pfs = (pft < 128) ? ldk : ldv;
    constexpr int PFD = 4;
#if AT_NOPF
#define AT_PF(t) do {} while (0)
#else
#define AT_PF(t) do { pfacc ^= pfv; const int tt_ = (t) < NT ? (t) : NT - 1; const int row0_ = tt_ < nA ? 64 * tt_ : rowB0 + 64 * (tt_ - nA); \
        pfv = *(const unsigned*)(pfb + (size_t)row0_ * pfs); } while (0)
#endif
#define AT_MASK(P0, P1, t) do { if (MASKED && (t) >= nA) at_mask(P0, P1, dk0 + 64 * (t)); } while (0)
#define AT_RESC(al) do { if (__any((al) < 1.f)) at_scale_o<DV>(o, scw, (al), r32, hi); } while (0)
    constexpr int DRYP = (OUTM == 2) ? PROBE_MODE : 0;
    f32x16 pA0, pA1, pB0, pB1; float alA, alB; bf16x8 pa[4];
    AT_PF(1); AT_PF(2); AT_PF(3);
    AT_GLOAD(0); AT_SWRITE(0); __syncthreads();
    AT_GLOAD(1);
    at_qkt<DQK, QL>(pA0, pA1, kb0, qf, qb); AT_MASK(pA0, pA1, 0); at_psm(pA0, pA1, mrun, alA);
#if AT_LAZY
    lrun *= alA;
#endif
    AT_SWRITE(1); __syncthreads();
    int bp = 0, bc = 1, bn = 2;
    constexpr int NMF = 2 * (DQK / 16) + 4 * (DV / 32);
#if AT_IGLP >= 0
#define AT_SCHED() __builtin_amdgcn_iglp_opt(AT_IGLP)
#elif AT_SGB
#define AT_SCHED() do { _Pragma("unroll") for (int i_ = 0; i_ < NMF; ++i_) { __builtin_amdgcn_sched_group_barrier(0x008, 1, 0); __builtin_amdgcn_sched_group_barrier(0x100, 2, 0); __builtin_amdgcn_sched_group_barrier(0x002, AT_SGB, 0); } } while (0)
#else
#define AT_SCHED() do {} while (0)
#endif
#define AT_ROT() do { bp = bc; bc = bn; bn = (bn == 2) ? 0 : bn + 1; } while (0)
#if AT_LAZY
    for (int j = 1; j + 1 < NT; j += 2) {
        at_qkt<DQK, QL>(pB0, pB1, kb0 + bc * KBUF, qf, qb); AT_MASK(pB0, pB1, j);
        AT_GLOAD(j + 1);
        at_fsm_lazy(pA0, pA1, mrun, alA, lrun, pa);
        AT_RESC(alA);
        at_pv<DV>(o, vb0 + bp * VBUF, pa); at_psm_lazy(pB0, pB1, mrun);
        AT_SWRITE(bn);
        __syncthreads(); AT_ROT();
        at_qkt<DQK, QL>(pA0, pA1, kb0 + bc * KBUF, qf, qb); AT_MASK(pA0, pA1, j + 1);
        AT_GLOAD(j + 2);
        at_fsm_lazy(pB0, pB1, mrun, alB, lrun, pa);
        AT_RESC(alB);
        at_pv<DV>(o, vb0 + bp * VBUF, pa); at_psm_lazy(pA0, pA1, mrun);
        AT_SWRITE(bn);
        __syncthreads(); AT_ROT();
    }
    at_qkt<DQK, QL>(pB0, pB1, kb0 + bc * KBUF, qf, qb); AT_MASK(pB0, pB1, NT - 1);
    at_fsm_lazy(pA0, pA1, mrun, alA, lrun, pa);
    AT_RESC(alA);
    at_pv<DV>(o, vb0 + bp * VBUF, pa); at_psm_lazy(pB0, pB1, mrun);
    at_fsm_lazy(pB0, pB1, mrun, alB, lrun, pa);
    AT_RESC(alB);
    at_pv<DV>(o, vb0 + bc * VBUF, pa);
#else
    for (int j = 1; j + 1 < ((DRYP == 6) ? 2 : NT); j += 2) {
        SBAR(); if (DRYP != 5) at_qkt<DQK, QL>(pB0, pB1, kb0 + bc * KBUF, qf, qb); else { _Pragma("unroll") for (int r_ = 0; r_ < 16; ++r_) { pB0[r_] = o[0][r_] * 1e-3f; pB1[r_] = o[1][r_] * 1e-3f; } } AT_MASK(pB0, pB1, j);
        if (!(DRYP >= 1)) { AT_GLOAD(j + 1); AT_PF(j + PFD); }
        if (DRYP != 3) at_fsm(pA0, pA1, alA, lrun, pa); else at_fsm_fake(pA0, pA1, pa); SBAR();
        if (DRYP != 4) at_pv<DV>(o, vb0 + bp * VBUF, pa); else { o[0][0] += __builtin_bit_cast(float, (int)pa[0][0] + (int)pa[1][1] + (int)pa[2][2] + (int)pa[3][3]); } if (DRYP != 3) at_psm(pB0, pB1, mrun, alB); else alB = 1.f;
        AT_SCHED();
        if (!(DRYP >= 1)) AT_SWRITE(bn);
        AT_RESC(alB); if (DRYP != 2) __syncthreads(); AT_ROT();
        SBAR(); if (DRYP != 5) at_qkt<DQK, QL>(pA0, pA1, kb0 + bc * KBUF, qf, qb); else { _Pragma("unroll") for (int r_ = 0; r_ < 16; ++r_) { pA0[r_] = o[0][r_] * 1e-3f; pA1[r_] = o[1][r_] * 1e-3f; } } AT_MASK(pA0, pA1, j + 1);
        if (!(DRYP >= 1)) { AT_GLOAD(j + 2); AT_PF(j + 1 + PFD); }
        if (DRYP != 3) at_fsm(pB0, pB1, alB, lrun, pa); else at_fsm_fake(pB0, pB1, pa); SBAR();
        if (DRYP != 4) at_pv<DV>(o, vb0 + bp * VBUF, pa); else { o[0][0] += __builtin_bit_cast(float, (int)pa[0][0] + (int)pa[1][1] + (int)pa[2][2] + (int)pa[3][3]); } if (DRYP != 3) at_psm(pA0, pA1, mrun, alA); else alA = 1.f;
        AT_SCHED();
        if (!(DRYP >= 1)) AT_SWRITE(bn);
        AT_RESC(alA); if (DRYP != 2) __syncthreads(); AT_ROT();
    }
    SBAR(); at_qkt<DQK, QL>(pB0, pB1, kb0 + bc * KBUF, qf, qb); AT_MASK(pB0, pB1, NT - 1);
    at_fsm(pA0, pA1, alA, lrun, pa); SBAR();
    at_pv<DV>(o, vb0 + bp * VBUF, pa); at_psm(pB0, pB1, mrun, alB);
    AT_RESC(alB);
    at_fsm(pB0, pB1, alB, lrun, pa); SBAR();
    at_pv<DV>(o, vb0 + bc * VBUF, pa);
#endif
#undef AT_ROT
#undef AT_SCHED
    pfacc ^= pfv;
    if (__builtin_expect(pfacc == 0x9e3779b9u && lrun == 12345.678f, 0)) scw[0] = 1.f;
#undef AT_GLOAD
#undef AT_PF
#undef AT_SWRITE
#undef AT_MASK
#undef AT_RESC
    { const float lt = lrun + __shfl_xor(lrun, 32); at_scale_o<DV>(o, scw, 1.0f / lt, r32, hi); }
    if (OUTM == 0) {
#pragma unroll
        for (int db = 0; db < DV / 32; ++db) {
            bf16_t* pb = Og + (size_t)(32 * wid + 4 * hi) * ldo + 32 * db + r32;
            bf16_t zz[16];
#pragma unroll
            for (int r = 0; r < 16; ++r) zz[r] = pb[(size_t)((r & 3) + 8 * (r >> 2)) * ldo];
#pragma unroll
            for (int r = 0; r < 16; ++r) { const float z = __uint_as_float((unsigned)zz[r] << 16); pb[(size_t)((r & 3) + 8 * (r >> 2)) * ldo] = (bf16_t)(pk2(o[db][r] * silu_f(z), 0.f) & 0xffffu); }
        }
    } else {
#pragma unroll
        for (int db = 0; db < DV / 32; ++db)
#pragma unroll
            for (int r = 0; r < 16; ++r) {
                const int q = (r & 3) + 8 * (r >> 2) + 4 * hi;
                if (OUTM == 1) { Of[(size_t)(32 * wid + q) * ldof + 32 * db + r32] = o[db][r]; }
                else { if (lrun == 12345.678f) Of[(size_t)(32 * wid + q) * ldof + 32 * db + r32] = o[db][r]; }
            }
    }
    __syncthreads();
}

struct Args { const float* in[21]; float* out; unsigned char* ws; };
typedef const __attribute__((address_space(4))) Args* ArgsP;
DI ArgsP args_ptr() { ArgsP p = (ArgsP)__builtin_amdgcn_kernarg_segment_ptr(); asm volatile("" : "+s"(p)); return p; }
enum { I_X = 0, I_C, I_CTX, I_CCTX, I_WMOD, I_BMOD, I_NORMG, I_WIN, I_QNORM, I_WUQ, I_KVNORM, I_WUKV, I_LQ1, I_LK1, I_LQ2, I_LK2, I_SUBLN, I_SINK, I_WBR, I_WOUT, I_FNORM };

DI int colmap(int kind, int n) {
    if (kind == 1) {
        if (n < C_KR) return n;
        if (n < C_KR + 32) { const int e = n - C_KR; return C_KR + (e >> 1) + 16 * (e & 1); }
        if (n < C_DQ) return -1;
        if ((n >= C_DQ && n < C_DV) || (n >= C_SQ && n < C_SV)) { const int w = n & 63; return (n - w) - 96 + (w >> 1) + 32 * (w & 1); }
        return n - 96;
    }
    if (kind == 2) { const int h = n / 96, e = n % 96; if (e < 64) return n; const int e2 = e - 64; return h * 96 + 64 + (e2 >> 1) + 16 * (e2 & 1); }
    if (kind == 3) { if (n < 512) return (n >> 6) * 192 + (n & 63); const int n2 = n - 512; return (n2 >> 7) * 192 + 64 + (n2 & 127); }
    return n;
}
DI void transpose_item(const float* W, int ldw, int kind, const float* rowscale, bf16_t* WT, int ldd, int koff, LAS float* scr, int item, int nblk, int lane) {
    const int kb = item / nblk, nb = item % nblk, k0 = 64 * kb, n0 = 32 * nb;
    const int oc = colmap(kind, n0 + (lane & 31));
#pragma unroll 8
    for (int i = 0; i < 32; ++i) { const int kk = 2 * i + (lane >> 5); float v = 0.f; if (oc >= 0) v = W[(size_t)(k0 + kk) * ldw + oc]; if (rowscale) v *= rowscale[k0 + kk]; scr[kk * 33 + (lane & 31)] = v; }
    __builtin_amdgcn_wave_barrier(); asm volatile("s_waitcnt lgkmcnt(0)" ::: "memory");
    const int c = lane & 7;
#pragma unroll
    for (int j = 0; j < 4; ++j) { const int n = (lane >> 3) + 8 * j; const LAS float* s = scr + (8 * c) * 33 + n;
        u32x4 o; o.x = pk2(s[0 * 33], s[1 * 33]); o.y = pk2(s[2 * 33], s[3 * 33]); o.z = pk2(s[4 * 33], s[5 * 33]); o.w = pk2(s[6 * 33], s[7 * 33]);
        *(u32x4*)(WT + (size_t)(n0 + n) * ldd + koff + k0 + 8 * c) = o; }
    __builtin_amdgcn_wave_barrier(); asm volatile("s_waitcnt lgkmcnt(0)" ::: "memory");
}
DI void prologue(ArgsP ap, LAS unsigned char* lds) {
    const int tid = tid_l(), lane = tid & 63, wid = __builtin_amdgcn_readfirstlane(tid >> 6);
    unsigned char* ws = ap->ws;
    LAS float* scr = (LAS float*)(lds + wid * 8448);
    const int gw = bid_l() * 8 + wid, NGW = grd_l() * 8;
    constexpr int I_IN = 16 * (NP / 32), I_UQ = 6 * 24, I_UKV = 4 * 48, I_SQ = 16 * 32, PER_L = I_IN + I_UQ + I_UKV + 6 * I_SQ;
    for (int it = gw; it < 2 * PER_L; it += NGW) {
        const int l = it / PER_L; int r = it % PER_L;
        if (r < I_IN) { transpose_item(ap->in[I_WIN] + (size_t)l * 1024 * D_IN, D_IN, 1, nullptr, (bf16_t*)(ws + WS_WIN) + (size_t)l * NP * 1024, 1024, 0, scr, r, NP / 32, lane); continue; } r -= I_IN;
        if (r < I_UQ) { transpose_item(ap->in[I_WUQ] + (size_t)l * 384 * 768, 768, 2, ap->in[I_QNORM] + l * 384, (bf16_t*)(ws + WS_WUQ) + (size_t)l * 768 * 384, 384, 0, scr, r, 24, lane); continue; } r -= I_UQ;
        if (r < I_UKV) { transpose_item(ap->in[I_WUKV] + (size_t)l * 256 * 1536, 1536, 3, ap->in[I_KVNORM] + l * 256, (bf16_t*)(ws + WS_WUKV) + (size_t)l * 1536 * 256, 256, 0, scr, r, 48, lane); continue; } r -= I_UKV;
        if (r < 3 * I_SQ) { const int br = r / I_SQ; transpose_item(ap->in[I_WBR] + ((size_t)l * 3 + br) * 1024 * 1024, 1024, 0, nullptr, (bf16_t*)(ws + WS_WB) + ((size_t)l * 3 + br) * 1024 * 1024, 1024, 0, scr, r % I_SQ, 32, lane); continue; } r -= 3 * I_SQ;
        { const int rep = r / I_SQ; transpose_item(ap->in[I_WOUT] + (size_t)l * 1024 * 1024, 1024, 0, nullptr, (bf16_t*)(ws + WS_WO3) + (size_t)l * 1024 * 3072, 3072, rep * 1024, scr, r % I_SQ, 32, lane); }
    }
    const int gt = bid_l() * 512 + tid, NGT = grd_l() * 512;
    for (int i = gt; i < SEQ * 48; i += NGT) {
        const int pos = i / 48, p = i % 48; const float frow = (float)(pos >> 6), fcol = (float)(pos & 63);
        float ang; float* cd; float* sd;
        if (p < 32) { const int f = p & 15; const float inv = powf(10000.0f, -(float)f / 16.0f); ang = (p < 16 ? frow : fcol) * inv; cd = (float*)(ws + WS_COSH) + pos * 32 + p; sd = (float*)(ws + WS_SINH) + pos * 32 + p; }
        else { const int pp = p - 32, f = pp & 7; const float inv = powf(10000.0f, -(float)f / 8.0f); ang = (pp < 8 ? frow : fcol) * inv; cd = (float*)(ws + WS_COSM) + pos * 16 + pp; sd = (float*)(ws + WS_SINM) + pos * 16 + pp; }
        *cd = __cosf(ang); *sd = __sinf(ang);
    }
    for (int it = gw; it < 2 * 16 * 48; it += NGW) {
        const int l = it / 768, rem = it % 768, kc = rem / 48, nb = rem % 48; const int k = kc * 64 + lane;
        float sv[9];
#pragma unroll
        for (int v = 0; v < 8; ++v) sv[v] = silu_f(ap->in[I_C][v * 1024 + k]);
        sv[8] = silu_f(ap->in[I_CCTX][k]);
        float acc[9];
#pragma unroll
        for (int v = 0; v < 9; ++v) acc[v] = 0.f;
        const float* w = ap->in[I_WMOD] + ((size_t)l * 1024 + kc * 64) * 3072 + nb * 64 + lane;
#pragma unroll 8
        for (int kk = 0; kk < 64; ++kk) { const float wv = w[(size_t)kk * 3072];
#pragma unroll
            for (int v = 0; v < 9; ++v) acc[v] += __uint_as_float(__builtin_amdgcn_readlane(__float_as_uint(sv[v]), kk)) * wv; }
        float* mp = (float*)(ws + WS_MODP) + ((size_t)(l * 16 + kc) * 9) * 3072 + nb * 64 + lane;
#pragma unroll
        for (int v = 0; v < 9; ++v) mp[(size_t)v * 3072] = acc[v];
    }
}
DI void mod_finalize(ArgsP ap) {
    const int tid = tid_l();
    const int gt = bid_l() * 512 + tid, NGT = grd_l() * 512;
    const float* mp = (const float*)(ap->ws + WS_MODP); float* mod = (float*)(ap->ws + WS_MOD);
    for (int i = gt; i < 2 * 9 * 3072; i += NGT) {
        const int l = i / (9 * 3072), rem = i % (9 * 3072), n = rem % 3072;
        float s = ap->in[I_BMOD][l * 3072 + n];
#pragma unroll
        for (int kc = 0; kc < 16; ++kc) s += mp[(size_t)(l * 16 + kc) * 9 * 3072 + rem];
        mod[i] = s;
    }
}
DI void ph_norm_mod(ArgsP ap, int l, int g) {
    const int tid = tid_l(), lane = tid & 63, wid = __builtin_amdgcn_readfirstlane(tid >> 6);
    const int gw = bid_l() * 8 + wid, NGW = grd_l() * 8;
    const float* ng = ap->in[I_NORMG] + l * 1024; const float* mod = (const float*)(ap->ws + WS_MOD) + (size_t)l * 9 * 3072;
    const float* xs = (l == 0) ? ap->in[I_X] : ap->out; const float* cs = (l == 0) ? ap->in[I_CTX] : (const float*)(ap->ws + WS_CTX);
    bf16_t* H = (bf16_t*)(ap->ws + WS_H);
    for (int r = gw; r < R; r += NGW) {
        const int bl = r / RB, j = r % RB, b = g * GB + bl;
        const float* src; const float* md;
        if (j < CTX) { src = cs + ((size_t)b * CTX + j) * DM; md = mod + 8 * 3072; } else { src = xs + ((size_t)b * SEQ + (j - CTX)) * DM; md = mod + (size_t)b * 3072; }
        f32x4 v[4]; float ss = 0.f;
#pragma unroll
        for (int q = 0; q < 4; ++q) { v[q] = *(const f32x4*)(src + 4 * (lane + 64 * q)); ss += (v[q][0] * v[q][0] + v[q][1] * v[q][1]) + (v[q][2] * v[q][2] + v[q][3] * v[q][3]); }
        const float rstd = 1.0f / sqrtf(wave_sum(ss) * (1.0f / DM) + EPS);
#pragma unroll
        for (int q = 0; q < 4; ++q) { const int idx = 4 * (lane + 64 * q);
            const f32x4 gg = *(const f32x4*)(ng + idx), sh = *(const f32x4*)(md + idx), sc = *(const f32x4*)(md + 1024 + idx);
            const f32x4 y = (v[q] * rstd * gg) * (sc + 1.0f) + sh;
            u32x2 w; w.x = pk2(y[0], y[1]); w.y = pk2(y[2], y[3]); *(u32x2*)(H + (size_t)r * DM + idx) = w; }
    }
}
DI void ph_mla_norm(ArgsP ap) {
    const int tid = tid_l(), lane = tid & 63, wid = __builtin_amdgcn_readfirstlane(tid >> 6);
    const int gw = bid_l() * 8 + wid, NGW = grd_l() * 8;
    const bf16_t* P = (const bf16_t*)(ap->ws + WS_P); bf16_t* AQ = (bf16_t*)(ap->ws + WS_AQ); bf16_t* AKV = (bf16_t*)(ap->ws + WS_AKV); bf16_t* KM = (bf16_t*)(ap->ws + WS_KM);
    for (int r = gw; r < R; r += NGW) {
        const bf16_t* row = P + (size_t)r * NP;
        const u32x4 c0 = *(const u32x4*)(row + 8 * lane);
        u32x4 c1 = {0u, 0u, 0u, 0u}; if (lane < 20) c1 = *(const u32x4*)(row + 8 * (64 + lane));
        float f0[8] = {bflo(c0.x), bfhi(c0.x), bflo(c0.y), bfhi(c0.y), bflo(c0.z), bfhi(c0.z), bflo(c0.w), bfhi(c0.w)};
        float f1[8] = {bflo(c1.x), bfhi(c1.x), bflo(c1.y), bfhi(c1.y), bflo(c1.z), bfhi(c1.z), bflo(c1.w), bfhi(c1.w)};
        float s0 = 0.f, s1 = 0.f;
#pragma unroll
        for (int i = 0; i < 8; ++i) { s0 += f0[i] * f0[i]; s1 += f1[i] * f1[i]; }
        const float sq = wave_sum(lane < 48 ? s0 : 0.f);
        const float skv = wave_sum((lane >= 48 ? s0 : 0.f) + (lane < 16 ? s1 : 0.f));
        const float rq = 1.0f / sqrtf(sq * (1.0f / 384.0f) + EPS), rkv = 1.0f / sqrtf(skv * (1.0f / 256.0f) + EPS);
        { const float rr = lane < 48 ? rq : rkv; u32x4 w; w.x = pk2(f0[0] * rr, f0[1] * rr); w.y = pk2(f0[2] * rr, f0[3] * rr); w.z = pk2(f0[4] * rr, f0[5] * rr); w.w = pk2(f0[6] * rr, f0[7] * rr);
          if (lane < 48) *(u32x4*)(AQ + (size_t)r * 384 + 8 * lane) = w; else *(u32x4*)(AKV + (size_t)r * 256 + 8 * (lane - 48)) = w; }
        if (lane < 16) { u32x4 w; w.x = pk2(f1[0] * rkv, f1[1] * rkv); w.y = pk2(f1[2] * rkv, f1[3] * rkv); w.z = pk2(f1[4] * rkv, f1[5] * rkv); w.w = pk2(f1[6] * rkv, f1[7] * rkv);
            *(u32x4*)(AKV + (size_t)r * 256 + 8 * (16 + lane)) = w; }
        else if (lane < 20) {
#pragma unroll
            for (int h = 0; h < 8; ++h) *(u32x4*)(KM + (size_t)r * 768 + h * 96 + 64 + 8 * (lane - 16)) = c1; }
    }
}
template <bool DRYE>
DI void ph_diff_post(ArgsP ap, int l) {
    const int tid = tid_l(), lane = tid & 63, wid = __builtin_amdgcn_readfirstlane(tid >> 6);
    const int gw = bid_l() * 8 + wid, NGW = grd_l() * 8;
    const float lam_init = (l == 0) ? 0.2f : (0.8f - 0.6f * 0.7408182206817179f);
    const float d1 = wave_sum(ap->in[I_LQ1][l * 64 + lane] * ap->in[I_LK1][l * 64 + lane]), d2 = wave_sum(ap->in[I_LQ2][l * 64 + lane] * ap->in[I_LK2][l * 64 + lane]);
    const float lam = expf(d1) - expf(d2) + lam_init;
    const float sl0 = ap->in[I_SUBLN][l * 128 + 2 * lane] * (1.0f - lam_init), sl1 = ap->in[I_SUBLN][l * 128 + 2 * lane + 1] * (1.0f - lam_init);
    const float* OD = (const float*)(ap->ws + WS_OD); bf16_t* P = (bf16_t*)(ap->ws + WS_P);
    typedef float f32x2 __attribute__((ext_vector_type(2)));
    for (int r = gw; r < R; r += NGW) {
        if (l != 0 && (r % RB) < CTX) continue;
        const float* ob = OD + (size_t)r * 2048 + 2 * lane; unsigned* zb = (unsigned*)(P + (size_t)r * NP + C_Z + 1024 + 2 * lane);
        f32x2 o1[8], o2[8]; unsigned z[8];
#pragma unroll
        for (int h = 0; h < 8; ++h) { o1[h] = *(const f32x2*)(ob + (2 * h) * 128); o2[h] = *(const f32x2*)(ob + (2 * h + 1) * 128); z[h] = zb[h * 64]; }
#pragma unroll
        for (int h = 0; h < 8; ++h) {
            const float a0 = o1[h][0] - lam * o2[h][0], a1 = o1[h][1] - lam * o2[h][1];
            const float rstd = 1.0f / sqrtf(wave_sum(a0 * a0 + a1 * a1) * (1.0f / 128.0f) + EPS);
            if (!DRYE || rstd == 12345.678f) zb[h * 64] = pk2(a0 * rstd * sl0 * silu_f(bflo(z[h])), a1 * rstd * sl1 * silu_f(bfhi(z[h])));
        }
    }
}
template <bool DRYE>
DI void ph_final_norm(ArgsP ap) {
    const int tid = tid_l(), lane = tid & 63, wid = __builtin_amdgcn_readfirstlane(tid >> 6);
    const int gw = bid_l() * 8 + wid, NGW = grd_l() * 8; const float* fg = ap->in[I_FNORM];
    for (int r = gw; r < NBATCH * SEQ; r += NGW) {
        float* row = ap->out + (size_t)r * DM; f32x4 v[4]; float ss = 0.f;
#pragma unroll
        for (int q = 0; q < 4; ++q) { v[q] = *(const f32x4*)(row + 4 * (lane + 64 * q)); ss += (v[q][0] * v[q][0] + v[q][1] * v[q][1]) + (v[q][2] * v[q][2] + v[q][3] * v[q][3]); }
        const float rstd = 1.0f / sqrtf(wave_sum(ss) * (1.0f / DM) + EPS);
#pragma unroll
        for (int q = 0; q < 4; ++q) { const int idx = 4 * (lane + 64 * q); if (!DRYE || rstd == 12345.678f) *(f32x4*)(row + idx) = v[q] * rstd * *(const f32x4*)(fg + idx); }
    }
}
template <bool DRY>
DI void ph_attention(ArgsP ap, int l, LAS unsigned char* lds) {
    constexpr int OM0 = DRY ? 2 : 0;
    const int G = grd_l(), bx = bid_l(), vcu = (G % 8 == 0) ? (bx % 8) * (G / 8) + bx / 8 : bx;
    bf16_t* P = (bf16_t*)(ap->ws + WS_P); const bf16_t* QM = (const bf16_t*)(ap->ws + WS_QM); const bf16_t* KM = (const bf16_t*)(ap->ws + WS_KM); const bf16_t* VM = (const bf16_t*)(ap->ws + WS_VM);
    float* OD = (float*)(ap->ws + WS_OD); const float* sink = ap->in[I_SINK] + l * 16;
#if !defined(ATT_ONLY) || ATT_ONLY == 1
    if (!DRY || (DRY_SEL & 1))
    for (int u = vcu; u < GB * 8 * 32; u += G) { const int bh = u >> 5, qb = u & 31, bl = bh >> 3, h = bh & 7; const size_t rb = (size_t)bl * RB, q0 = rb + CTX + 256 * qb;
        attn_unit<96, 128, OM0, false>(lds, QM + q0 * 768 + h * 96, 768, KM + rb * 768 + h * 96, 768, VM + rb * 1024 + h * 128, 1024, RB / 64, 0, 0, 0, 0, NEGBIG, 0.f, P + q0 * NP + C_Z + h * 128, NP, OD, 0); }
#endif
#if !defined(ATT_ONLY) || ATT_ONLY == 2
    if (!DRY || (DRY_SEL & 2))
    for (int u = vcu; u < GB * 16 * 32; u += G) { const int bh = u >> 5, qb = u & 31, bl = bh >> 4, hm = bh & 15; const size_t rb = (size_t)bl * RB, q0 = rb + CTX + 256 * qb;
        attn_unit<64, 128, 1, false>(lds, P + q0 * NP + C_DQ + hm * 64, NP, P + rb * NP + C_DK + hm * 64, NP, P + rb * NP + C_DV + (hm >> 1) * 128, NP, RB / 64, 0, 0, 0, 0, NEGBIG, 0.f, nullptr, 0, OD + q0 * 2048 + hm * 128, 2048); }
#endif
#if !defined(ATT_ONLY) || ATT_ONLY == 3
    if (!DRY || (DRY_SEL & 4))
    for (int u = vcu; u < GB * 16 * 32; u += G) { const int bh = u >> 5, qb = u & 31, bl = bh >> 4, h = bh & 15; const size_t rb = (size_t)bl * RB, q0 = rb + CTX + 256 * qb;
        const int lo = (256 * qb - 128 < 0) ? 0 : 256 * qb - 128, hi = (256 * qb + 384 > SEQ) ? SEQ : 256 * qb + 384;
        attn_unit<64, 64, OM0, true>(lds, P + q0 * NP + C_SQ + h * 64, NP, P + rb * NP + C_SK + (h >> 2) * 64, NP, P + rb * NP + C_SV + (h >> 2) * 64, NP, CTX / 64, CTX + lo, (hi - lo) / 64, lo, 256 * qb, sink[h] * LOG2E, 1.0f,
                              P + q0 * NP + C_Z + 2048 + h * 64, NP, OD, 0); }
#endif
#if !defined(ATT_ONLY)
    if (l == 0) {
        for (int u = vcu; u < GB * 40; u += G) { const int bl = u / 40, k = u % 40; const size_t rb = (size_t)bl * RB;
            if (k < 8) { const int h = k;
                attn_unit<96, 128, OM0, false>(lds, QM + rb * 768 + h * 96, 768, KM + rb * 768 + h * 96, 768, VM + rb * 1024 + h * 128, 1024, CTX / 64, 0, 0, 0, 0, NEGBIG, 0.f, P + rb * NP + C_Z + h * 128, NP, OD, 0); }
            else if (k < 24) { const int hm = k - 8;
                attn_unit<64, 128, 1, false>(lds, P + rb * NP + C_DQ + hm * 64, NP, P + rb * NP + C_DK + hm * 64, NP, P + rb * NP + C_DV + (hm >> 1) * 128, NP, CTX / 64, 0, 0, 0, 0, NEGBIG, 0.f, nullptr, 0, OD + rb * 2048 + hm * 128, 2048); }
            else { const int h = k - 24;
                attn_unit<64, 64, OM0, false>(lds, P + rb * NP + C_SQ + h * 64, NP, P + rb * NP + C_SK + (h >> 2) * 64, NP, P + rb * NP + C_SV + (h >> 2) * 64, NP, CTX / 64, 0, 0, 0, 0, sink[h] * LOG2E, 1.0f, P + rb * NP + C_Z + 2048 + h * 64, NP, OD, 0); }
        }
    }
#endif
}

#define RLX_AGENT __ATOMIC_RELAXED, __HIP_MEMORY_SCOPE_AGENT
#define XB_TMO      128
#define XB_XCNT(j)  (256  + 64 * (j))
#define XB_XSUB(j)  (1280 + 64 * (j))
#define XB_XGEN(j)  (2304 + 64 * (j))
#define XB_TOP      3328
#define XB_TOPGEN   3392
#define XCD_BAR_WORDS 3456
#define XB_SPIN_CAP (1u << 18)

__device__ __forceinline__ unsigned xb_ld(unsigned* p)              { return __hip_atomic_load(p, __ATOMIC_RELAXED, __HIP_MEMORY_SCOPE_AGENT); }
__device__ __forceinline__ unsigned xb_add(unsigned* p, unsigned v) { return __hip_atomic_fetch_add(p, v, __ATOMIC_RELAXED, __HIP_MEMORY_SCOPE_AGENT); }
__device__ __forceinline__ unsigned xb_xcc_id() { return (unsigned)__builtin_amdgcn_s_getreg((3 << 11) | 20) & 0xFu; }
#define XB_SPIN(cond, bar) do { unsigned _sp = 0; while (cond) { __builtin_amdgcn_s_sleep(1); \
    if ((++_sp & 255u) == 0u) { if (xb_ld(&(bar)[XB_TMO])) break; if (_sp > XB_SPIN_CAP) { atomicAdd(&(bar)[XB_TMO], 1u); break; } } } } while (0)

struct XcdBarrier {
    unsigned* bar; unsigned x;
    volatile LAS unsigned* st;
};

__device__ __forceinline__ XcdBarrier xcd_barrier_post(unsigned* bar, volatile LAS unsigned* st) {
    XcdBarrier b; b.bar = bar; b.x = xb_xcc_id(); b.st = st;
    if (threadIdx.x == 0) (void)xb_add(&bar[XB_XCNT(b.x)], 1u);
    return b;
}
__device__ __forceinline__ void xcd_barrier_complete(unsigned* bar, unsigned x, unsigned& nloc, unsigned& nx) {
    const unsigned G = gridDim.x * gridDim.y * gridDim.z;
    unsigned sum, cnt, mine, sp = 0u;
    for (;;) {
        sum = 0u; cnt = 0u; mine = 0u;
#pragma unroll
        for (unsigned j = 0; j < 16; ++j) { const unsigned c = xb_ld(&bar[XB_XCNT(j)]); sum += c; cnt += (c > 0u) ? 1u : 0u; mine = (j == x) ? c : mine; }
        if (sum == G) break;
        __builtin_amdgcn_s_sleep(1);
        if ((++sp & 255u) == 0u) { if (xb_ld(&bar[XB_TMO])) break; if (sp > XB_SPIN_CAP) { atomicAdd(&bar[XB_TMO], 1u); break; } }
    }
    nloc = mine > 0u ? mine : 1u; nx = cnt > 0u ? cnt : 1u;
}

__device__ __forceinline__ void xcd_barrier(const XcdBarrier& b) {
    asm volatile("s_waitcnt vmcnt(0)" ::: "memory");
    __syncthreads();
    if (threadIdx.x == 0) {
        unsigned* bar = b.bar;
        __builtin_amdgcn_s_waitcnt(0);
        unsigned nloc = b.st[0], nx = b.st[1];
        if (nloc == 0u) { xcd_barrier_complete(bar, b.x, nloc, nx); b.st[0] = nloc; b.st[1] = nx; }
        const unsigned old = xb_add(&bar[XB_XSUB(b.x)], 1u);
        const unsigned gen = old / nloc;
        if (old + 1u == (gen + 1u) * nloc) {
            __builtin_amdgcn_fence(__ATOMIC_RELEASE, "agent");
            asm volatile("s_waitcnt vmcnt(0)" ::: "memory");
            const unsigned og = xb_add(&bar[XB_TOP], 1u);
            const unsigned tg = og / nx;
            if (og + 1u == (tg + 1u) * nx) xb_add(&bar[XB_TOPGEN], 1u);
            else XB_SPIN(xb_ld(&bar[XB_TOPGEN]) == tg, bar);
            __builtin_amdgcn_fence(__ATOMIC_ACQUIRE, "agent");
            xb_add(&bar[XB_XGEN(b.x)], 1u);
            asm volatile("s_waitcnt vmcnt(0)" ::: "memory");
        } else {
            XB_SPIN(xb_ld(&bar[XB_XGEN(b.x)]) == gen, bar);
            __builtin_amdgcn_fence(__ATOMIC_ACQUIRE, "agent");
            asm volatile("s_waitcnt vmcnt(0)" ::: "memory");
        }
    }
    __syncthreads();
}


__global__ void __launch_bounds__(512, 2) hybrid_fwd(Args a_unused) {
    extern __shared__ __attribute__((aligned(16))) unsigned char lds_raw[];
    LAS unsigned char* lds = (LAS unsigned char*)lds_raw;
    cg::grid_group grid = cg::this_grid();
    { volatile LAS unsigned* xst = (volatile LAS unsigned*)(lds + XB_LDS_OFF);
      if (threadIdx.x < 2) xst[threadIdx.x] = 0u;
      __syncthreads();
      (void)xcd_barrier_post((unsigned*)(args_ptr()->ws), xst); }
#define GSYNC() do { XcdBarrier b_; b_.bar = (unsigned*)(args_ptr()->ws); b_.x = xb_xcc_id(); b_.st = (volatile LAS unsigned*)(lds + XB_LDS_OFF); xcd_barrier(b_); } while (0)
#ifndef NO_PRO
    prologue(args_ptr(), lds);
#ifdef PROBE_PRO
    __syncthreads(); prologue(args_ptr(), lds);
#endif
#endif
    grid.sync();
    mod_finalize(args_ptr());
    GSYNC();
    for (int l = 0; l < 2; ++l) {
        for (int g = 0; g < NGRP; ++g) {
            ph_norm_mod(args_ptr(), lnd(l), lnd(g));
#ifdef PROBE_R1
            GSYNC(); ph_norm_mod(args_ptr(), lnd(l), lnd(g));
#endif
            GSYNC();
#ifndef NO_GEMM
            {
                unsigned char* ws = args_ptr()->ws; const int G = grd_l(), bx = bid_l();
                pg8::Gemm gm{1024, 1024, 1024}; pg8::Order S; S.init(R, NP, G, bx, ws + WS_H, 1024, (bf16_t*)(ws + WS_WIN) + (size_t)l * NP * 1024, 1024, 1 << 20, 0);
                EpiIn E{ws};
                pg8::gemm_phase<EpiIn, pg8::Order, true, true>(lds, gm, S, E);
#ifdef PROBE_G1
                __syncthreads(); pg8::gemm_phase<EpiIn, pg8::Order, true, true>(lds, gm, S, E);
#endif
            }
#endif
            GSYNC();
#ifndef NO_GEMM2
            {
                unsigned char* ws = args_ptr()->ws; const int G = grd_l(), bx = bid_l();
                pg8::Gemm gq{384, NP, 384}; pg8::Order Sq; Sq.init(R, 768, G, bx, (bf16_t*)(ws + WS_P) + C_QC, NP, (bf16_t*)(ws + WS_WUQ) + (size_t)l * 768 * 384, 384, 1 << 20, 0);
                EpiQ Eq{ws};
#ifndef NO_GQ
                pg8::gemm_phase<EpiQ, pg8::Order, true, true>(lds, gq, Sq, Eq);
#ifdef PROBE_G2
                __syncthreads(); pg8::gemm_phase<EpiQ, pg8::Order, true, true>(lds, gq, Sq, Eq);
#endif
#endif
            }
            {
                unsigned char* ws = args_ptr()->ws; const int G = grd_l(), bx = bid_l();
                pg8::Gemm gk{256, NP, 256}; pg8::Order Sk; Sk.init(R, 1536, G, bx, (bf16_t*)(ws + WS_P) + C_KVC, NP, (bf16_t*)(ws + WS_WUKV) + (size_t)l * 1536 * 256, 256, 1 << 20, 0);
                EpiKV Ek{ws};
#ifndef NO_GK
                pg8::gemm_phase<EpiKV, pg8::Order, true, true>(lds, gk, Sk, Ek);
#ifdef PROBE_G2
                __syncthreads(); pg8::gemm_phase<EpiKV, pg8::Order, true, true>(lds, gk, Sk, Ek);
#endif
#endif
            }
#endif
            GSYNC();
#ifndef NO_ATT
#ifdef PROBE_ATT
            ph_attention<true>(args_ptr(), lnd(l), lds);
            GSYNC();
#endif
            ph_attention<false>(args_ptr(), lnd(l), lds);
#endif
            GSYNC();
#ifdef PROBE_R2
            ph_diff_post<true>(args_ptr(), lnd(l)); GSYNC();
#endif
            ph_diff_post<false>(args_ptr(), lnd(l));
            GSYNC();
#ifndef NO_BR
            {
                unsigned char* ws = args_ptr()->ws; const int G = grd_l(), bx = bid_l();
                pg8::Gemm gb{1024, NP, 1024}; pg8::Order S; S.init(R, 3072, G, bx, (bf16_t*)(ws + WS_P) + C_Z, NP, (bf16_t*)(ws + WS_WB) + (size_t)l * 3 * 1024 * 1024, 1024, 4, 1024 * 2, l != 0);
#ifdef PROBE_BR
                { EpiBrT<true> Ed{ws}; pg8::gemm_phase<EpiBrT<true>, pg8::Order, true, true>(lds, gb, S, Ed); __syncthreads(); }
#endif
                EpiBrT<false> E{ws};
                pg8::gemm_phase<EpiBrT<false>, pg8::Order, true, true>(lds, gb, S, E);
            }
#endif
            GSYNC();
#ifndef NO_OUT
            {
                ArgsP ap = args_ptr(); unsigned char* ws = ap->ws; const int G = grd_l(), bx = bid_l();
                pg8::Gemm go{3072, NP, 3072}; pg8::Order S; S.init(R, 1024, G, bx, (bf16_t*)(ws + WS_P) + C_GM, NP, (bf16_t*)(ws + WS_WO3) + (size_t)l * 1024 * 3072, 3072, 1 << 20, 0, l != 0);
#ifdef PROBE_OUT
                { EpiOutT<true> Ed{l, g, (l == 0) ? ap->in[I_X] : (const float*)ap->out, ap->out, ap->in[I_CTX], ws}; pg8::gemm_phase<EpiOutT<true>, pg8::Order, true, true>(lds, go, S, Ed); __syncthreads(); }
#endif
                EpiOutT<false> E{l, g, (l == 0) ? ap->in[I_X] : (const float*)ap->out, ap->out, ap->in[I_CTX], ws};
                pg8::gemm_phase<EpiOutT<false>, pg8::Order, true, true>(lds, go, S, E);
            }
#endif
        }
        GSYNC();
    }
#ifdef PROBE_R2
    ph_final_norm<true>(args_ptr()); GSYNC();
#endif
    ph_final_norm<false>(args_ptr());
}

extern "C" void kernel_launch(void* const* d_in, const int* in_sizes, int n_in, void* d_out, int out_size, void* d_ws, size_t ws_size, hipStream_t stream) {
    static int grid = 0;
    if (grid == 0) {
        if (n_in != 21 || ws_size < WS_END) { fprintf(stderr, "kernel_launch: expected 21 inputs and >= %zu bytes of workspace (got %d, %zu)\n", (size_t)WS_END, n_in, ws_size); grid = -1; return; }
        int dev = 0, cus = 0, per_cu = 0;
        (void)hipGetDevice(&dev); (void)hipDeviceGetAttribute(&cus, hipDeviceAttributeMultiprocessorCount, dev);
        if (hipFuncSetAttribute((const void*)hybrid_fwd, hipFuncAttributeMaxDynamicSharedMemorySize, LDS_BYTES) != hipSuccess) fprintf(stderr, "kernel_launch: hipFuncSetAttribute failed\n");
        if (hipOccupancyMaxActiveBlocksPerMultiprocessor(&per_cu, (const void*)hybrid_fwd, 512, LDS_BYTES) != hipSuccess || per_cu < 1) { per_cu = 1; (void)hipGetLastError(); }
        if (cus <= 0) cus = 256;
        grid = cus * per_cu;
    }
    if (grid < 0) return;
    Args a{};
    for (int i = 0; i < 21; ++i) a.in[i] = (const float*)d_in[i];
    a.out = (float*)d_out; a.ws = (unsigned char*)d_ws;
    (void)hipMemsetAsync(d_ws, 0, 16384, stream);
    void* args[] = {&a};
    hipError_t e = hipLaunchCooperativeKernel((const void*)hybrid_fwd, dim3(grid), dim3(512), args, LDS_BYTES, stream);
    if (e != hipSuccess) fprintf(stderr, "kernel_launch: cooperative launch failed: %s (grid %d)\n", hipGetErrorString(e), grid);
}
```

```cpp
#include <hip/hip_runtime.h>
#include <hip/hip_cooperative_groups.h>
#include <cstdio>
#include <cstdint>
namespace cg = cooperative_groups;

#define DI __device__ __forceinline__
#define LAS __attribute__((address_space(3)))
__device__ __forceinline__ int tid_l() { int t = threadIdx.x; asm volatile("" : "+v"(t)); return t; }
__device__ __forceinline__ int bid_l() { int b = blockIdx.x; asm volatile("" : "+s"(b)); return b; }
__device__ __forceinline__ int lnd(int x) { asm volatile("" : "+s"(x)); return x; }
__device__ __forceinline__ int grd_l() { int g = gridDim.x; asm volatile("" : "+s"(g)); return g; }
typedef unsigned short bf16_t;
typedef short bf16x8 __attribute__((ext_vector_type(8)));
typedef short s16x4 __attribute__((ext_vector_type(4)));
typedef float f32x4 __attribute__((ext_vector_type(4)));
typedef float f32x16 __attribute__((ext_vector_type(16)));
typedef unsigned u32x4 __attribute__((ext_vector_type(4)));
typedef unsigned u32x2 __attribute__((ext_vector_type(2)));

constexpr int DM = 1024, NBATCH = 8, SEQ = 8192, CTX = 256, RB = CTX + SEQ;
constexpr int GB = 2, NGRP = NBATCH / GB, R = GB * RB;
constexpr int NP = 11520;
constexpr int C_QC = 0, C_KVC = 384, C_KR = 640, C_DQ = 768, C_DK = 1792, C_DV = 2816, C_SQ = 3840, C_SK = 4864, C_SV = 5120, C_Z = 5376, C_GM = 8448;
constexpr int D_IN = 11424;
constexpr float EPS = 1e-6f, LOG2E = 1.4426950408889634f;
constexpr float QS64 = 0.125f * LOG2E, QS96 = 0.10206207261596575f * LOG2E;
constexpr float NEGBIG = -1e30f, THR = 8.0f;

constexpr size_t al256(size_t x) { return (x + 255) & ~(size_t)255; }
constexpr size_t WS_WIN = 1u << 20;
constexpr size_t WS_WUQ = al256(WS_WIN + (size_t)2 * NP * 1024 * 2);
constexpr size_t WS_WUKV = al256(WS_WUQ + (size_t)2 * 768 * 384 * 2);
constexpr size_t WS_WB = al256(WS_WUKV + (size_t)2 * 1536 * 256 * 2);
constexpr size_t WS_WO3 = al256(WS_WB + (size_t)2 * 3 * 1024 * 1024 * 2);
constexpr size_t WS_COSH = al256(WS_WO3 + (size_t)2 * 1024 * 3072 * 2);
constexpr size_t WS_SINH = al256(WS_COSH + (size_t)SEQ * 32 * 4);
constexpr size_t WS_COSM = al256(WS_SINH + (size_t)SEQ * 32 * 4);
constexpr size_t WS_SINM = al256(WS_COSM + (size_t)SEQ * 16 * 4);
constexpr size_t WS_MODP = al256(WS_SINM + (size_t)SEQ * 16 * 4);
constexpr size_t WS_MOD = al256(WS_MODP + (size_t)16 * 2 * 9 * 3072 * 4);
constexpr size_t WS_CTX = al256(WS_MOD + (size_t)2 * 9 * 3072 * 4);
constexpr size_t WS_H = al256(WS_CTX + (size_t)NBATCH * CTX * DM * 4);
constexpr size_t WS_P = al256(WS_H + (size_t)R * DM * 2);
constexpr size_t WS_AQ = al256(WS_P + (size_t)R * NP * 2);
constexpr size_t WS_AKV = al256(WS_AQ + (size_t)R * 384 * 2);
constexpr size_t WS_QM = al256(WS_AKV + (size_t)R * 256 * 2);
constexpr size_t WS_KM = al256(WS_QM + (size_t)R * 768 * 2);
constexpr size_t WS_VM = al256(WS_KM + (size_t)R * 768 * 2);
constexpr size_t WS_OD = al256(WS_VM + (size_t)R * 1024 * 2);
constexpr size_t WS_END = al256(WS_OD + (size_t)R * 2048 * 4);
constexpr size_t WS_PART = WS_AQ;
static_assert(WS_END <= ((size_t)1 << 30), "workspace map exceeds 1 GiB");

constexpr int LDS_BYTES = 155648, XB_LDS_OFF = 155136;

DI unsigned pk2(float lo, float hi) { typedef float f2_t __attribute__((ext_vector_type(2))); typedef __bf16 b2_t __attribute__((ext_vector_type(2)));
    f2_t v = {lo, hi}; b2_t b = __builtin_convertvector(v, b2_t); return __builtin_bit_cast(unsigned, b); }
DI u32x4 pack8(f32x4 a, f32x4 b) { u32x4 w; w.x = pk2(a[0], a[1]); w.y = pk2(a[2], a[3]); w.z = pk2(b[0], b[1]); w.w = pk2(b[2], b[3]); return w; }
DI float bflo(unsigned w) { return __uint_as_float(w << 16); }
DI float bfhi(unsigned w) { return __uint_as_float(w & 0xffff0000u); }
DI float wave_sum(float v) {
#pragma unroll
    for (int o = 1; o < 64; o <<= 1) v += __shfl_xor(v, o);
    return v; }
DI float silu_f(float z) { return z * __builtin_amdgcn_rcpf(1.0f + __expf(-z)); }
DI float sigm_f(float z) { return __builtin_amdgcn_rcpf(1.0f + __expf(-z)); }
DI void rope8(f32x4& v0, f32x4& v1, const f32x4 cs, const f32x4 sn) {
    float a, b;
    a = v0[0]; b = v0[1]; v0[0] = a * cs[0] - b * sn[0]; v0[1] = b * cs[0] + a * sn[0];
    a = v0[2]; b = v0[3]; v0[2] = a * cs[1] - b * sn[1]; v0[3] = b * cs[1] + a * sn[1];
    a = v1[0]; b = v1[1]; v1[0] = a * cs[2] - b * sn[2]; v1[1] = b * cs[2] + a * sn[2];
    a = v1[2]; b = v1[3]; v1[2] = a * cs[3] - b * sn[3]; v1[3] = b * cs[3] + a * sn[3];
}
namespace pg8 {
#define PG8_LAS __attribute__((address_space(3)))
typedef unsigned short bf16_t;
typedef short bf16x8 __attribute__((ext_vector_type(8)));
typedef float f32x4 __attribute__((ext_vector_type(4)));
typedef unsigned u32x4 __attribute__((ext_vector_type(4)));
constexpr int BM = 256, BK = 64, HALF = 128, HTB = HALF * BK * 2  , STAGE_BYTES = 8 * HTB, NXCD = 8, WGM = 8;

__host__ __device__ __forceinline__ int lds_byte(int r, int c) { const int st = (r >> 4) * 2 + (c >> 5), rr = r & 15, cc = c & 31, ob = rr * 64 + cc * 2; return st * 1024 + (ob ^ (((ob >> 9) & 1) << 5)); }
__host__ __device__ __forceinline__ void stage_rc(int b, int& R, int& C) { const int st = b / 1024, sb = b % 1024, swz = sb ^ (((sb >> 9) & 1) << 5); R = (st >> 1) * 16 + swz / 64; C = (st & 1) * 32 + (swz % 64) / 2; }
__host__ __device__ __forceinline__ int perm32(int rho) { const int n = rho >> 4, i = rho & 15; return 8 * (i >> 2) + 4 * n + (i & 3); }

struct Unit { int pm, pn; };
struct Gemm { int K, lda, ldb; };
struct Order {
    int nM, nN, nwg, G, c; const char* A; const char* B; unsigned tA, tB; int pnblk; unsigned ablk; int skipctx;
    __device__ __forceinline__ void init(int M, int N, int G_, int c_, const void* A_, int lda, const void* B_, int ldb, int pnblk_, unsigned ablk_, int skipctx_ = 0) {
        skipctx = skipctx_; nM = M / BM; if (skipctx) nM -= nM / 33;
        nN = N / BM; nwg = nM * nN; G = G_; c = c_; A = (const char*)A_; B = (const char*)B_; tA = (unsigned)(BM * lda * 2); tB = (unsigned)(BM * ldb * 2); pnblk = pnblk_; ablk = ablk_; }
    __device__ __forceinline__ bool next(int i, Unit& u) const {
        const long L = (long)i * G + c; if (L >= nwg) return false;
        int wgid = (int)L; { const int q = nwg / NXCD, r = nwg % NXCD, xcd = wgid % NXCD, off = wgid / NXCD; wgid = (xcd < r ? xcd * (q + 1) : r * (q + 1) + (xcd - r) * q) + off; }
        const int nig = WGM * nN, gid = wgid / nig, fm = gid * WGM, gsz = (nM - fm) < WGM ? (nM - fm) : WGM;
        u.pm = fm + ((wgid % nig) % gsz); u.pn = (wgid % nig) / gsz; if (skipctx) u.pm += u.pm / 32 + 1; return true;
    }
    __device__ __forceinline__ const char* a_base(const Unit& u) const { return A + (size_t)u.pm * tA + (size_t)(u.pn / pnblk) * ablk; }
    __device__ __forceinline__ const char* b_base(const Unit& u) const { return B + (size_t)u.pn * tB; }
};

template <class Epi, class Sched, bool ALIGN_EPI = false, bool SP2 = false>
__device__ __forceinline__ void gemm_phase(PG8_LAS unsigned char* lds, const Gemm g, const Sched& S, const Epi& E) {
    const int tid = tid_l(), wid = __builtin_amdgcn_readfirstlane(tid >> 6), lane = tid & 63, wr = wid >> 2, wc = wid & 3, fr = lane & 15, fq = lane >> 4;
    const int K = g.K, nt = K / BK;
    unsigned voffA[2], voffB[2];
#pragma unroll
    for (int i = 0; i < 2; ++i) { int R, C; stage_rc(tid * 16 + i * 8192, R, C); const int Rb = Epi::PERM ? ((R & ~31) + perm32(R & 31)) : R;
        voffA[i] = (unsigned)(R * g.lda + C) * 2u; voffB[i] = (unsigned)(Rb * g.ldb + C) * 2u; }
    const size_t kstep = (size_t)(BK * 2);
    const size_t hstepA = (size_t)HALF * g.lda * 2, hstepB = (size_t)HALF * g.ldb * 2;
    const unsigned ldsw = (unsigned)wid * 1024u;
    const int aoff = lds_byte(wr * 64 + fr, fq * 8), boff = lds_byte(wc * 32 + fr, fq * 8);
#define PG8_SA(b, h) (((b) * 2 + (h)) * HTB)
#define PG8_SB(b, h) ((4 + (b) * 2 + (h)) * HTB)
#define PG8_STAGE(bufoff, gbase, voff) do { _Pragma("unroll") for (int _i = 0; _i < 2; ++_i) \
        __builtin_amdgcn_global_load_lds((const unsigned*)((const char*)(gbase) + (voff)[_i]), (PG8_LAS unsigned*)(lds + (bufoff) + ldsw + _i * 8192), 16, 0, 0); } while (0)
#define PG8_LDA(dst, b, h) do { _Pragma("unroll") for (int m = 0; m < 4; ++m) _Pragma("unroll") for (int k = 0; k < 2; ++k) dst[m][k] = *(const PG8_LAS bf16x8*)(lds + PG8_SA(b, h) + aoff + m * 2048 + k * 1024); } while (0)
#define PG8_LDB(dst, b, h) do { _Pragma("unroll") for (int n = 0; n < 2; ++n) _Pragma("unroll") for (int k = 0; k < 2; ++k) dst[n][k] = *(const PG8_LAS bf16x8*)(lds + PG8_SB(b, h) + boff + n * 2048 + k * 1024); } while (0)
#define PG8_MMA(ai, bj, At, Bt) do { __builtin_amdgcn_s_setprio(1); _Pragma("unroll") for (int m = 0; m < 4; ++m) _Pragma("unroll") for (int n = 0; n < 2; ++n) _Pragma("unroll") for (int k = 0; k < 2; ++k) \
        acc[ai][bj][m][n] = __builtin_amdgcn_mfma_f32_16x16x32_bf16(Bt[n][k], At[m][k], acc[ai][bj][m][n], 0, 0, 0); __builtin_amdgcn_s_setprio(0); } while (0)
#define PG8_WAIT_V(n) asm volatile("s_waitcnt vmcnt(" #n ")" ::: "memory")
#define PG8_WAIT_L(n) asm volatile("s_waitcnt lgkmcnt(" #n ")" ::: "memory")
#define PG8_BAR __builtin_amdgcn_s_barrier()
#define PG8_SCHED __builtin_amdgcn_sched_barrier(0)
    Unit cur, nxt; int ui = 0;
    if (!S.next(0, cur)) return;
    f32x4 acc[2][2][4][2];
#pragma unroll
    for (int a = 0; a < 2; ++a)
#pragma unroll
        for (int b = 0; b < 2; ++b)
#pragma unroll
            for (int m = 0; m < 4; ++m)
#pragma unroll
                for (int n = 0; n < 2; ++n) acc[a][b][m][n] = (f32x4){0.f, 0.f, 0.f, 0.f};
    bf16x8 At[4][2], B0[2][2], B1[2][2];
    const char* cA = S.a_base(cur); const char* cB = S.b_base(cur);

    if constexpr (SP2) {
        PG8_STAGE(PG8_SB(0, 0), cB, voffB); PG8_STAGE(PG8_SB(0, 1), cB + hstepB, voffB); PG8_STAGE(PG8_SA(0, 0), cA, voffA); PG8_STAGE(PG8_SA(0, 1), cA + hstepA, voffA);
        if (wr == 1) PG8_BAR;
        PG8_WAIT_V(2); PG8_BAR;
        PG8_STAGE(PG8_SB(1, 0), cB + kstep, voffB); PG8_STAGE(PG8_SA(1, 0), cA + kstep, voffA); PG8_STAGE(PG8_SB(1, 1), cB + hstepB + kstep, voffB);
        PG8_WAIT_V(6); PG8_BAR;
    } else {
        PG8_STAGE(PG8_SB(0, 0), cB, voffB); PG8_STAGE(PG8_SA(0, 0), cA, voffA); PG8_STAGE(PG8_SB(0, 1), cB + hstepB, voffB); PG8_STAGE(PG8_SA(0, 1), cA + hstepA, voffA);
        if (wr == 1) PG8_BAR;
        PG8_WAIT_V(4); PG8_BAR;
        PG8_STAGE(PG8_SB(1, 0), cB + kstep, voffB); PG8_STAGE(PG8_SA(1, 0), cA + kstep, voffA); PG8_STAGE(PG8_SB(1, 1), cB + hstepB + kstep, voffB);
        PG8_WAIT_V(6); PG8_BAR;
    }
    for (;;) {
        const bool has_next = S.next(ui + 1, nxt);
        const char* nA = has_next ? S.a_base(nxt) : cA; const char* nB = has_next ? S.b_base(nxt) : cB;
#pragma nounroll
        for (int t = 0; t < nt; t += 2) {
            const bool last = (t == nt - 2);
            const char* a1 = cA + (size_t)(t + 1) * kstep;
            const char* a2 = last ? nA : cA + (size_t)(t + 2) * kstep; const char* b2 = last ? nB : cB + (size_t)(t + 2) * kstep;
            const char* a3 = a2 + kstep; const char* b3 = b2 + kstep;

            if constexpr (SP2) {
            PG8_LDB(B0, 0, 0); PG8_LDB(B1, 0, 1); PG8_SCHED; PG8_LDA(At, 0, 0); PG8_STAGE(PG8_SA(1, 1), a1 + hstepA, voffA);
            PG8_WAIT_V(8); PG8_WAIT_L(0); PG8_BAR; PG8_MMA(0, 0, At, B0); PG8_MMA(0, 1, At, B1); PG8_BAR; PG8_SCHED;
            PG8_LDA(At, 0, 1); PG8_STAGE(PG8_SB(0, 0), b2, voffB); PG8_STAGE(PG8_SB(0, 1), b2 + hstepB, voffB); PG8_STAGE(PG8_SA(0, 0), a2, voffA);
            PG8_WAIT_V(8); PG8_WAIT_L(0); PG8_BAR; PG8_MMA(1, 0, At, B0); PG8_MMA(1, 1, At, B1); PG8_BAR; PG8_SCHED;
            PG8_LDB(B0, 1, 0); PG8_LDB(B1, 1, 1); PG8_SCHED; PG8_LDA(At, 1, 0); PG8_STAGE(PG8_SA(0, 1), a2 + hstepA, voffA);
            PG8_WAIT_V(8); PG8_WAIT_L(0); PG8_BAR; PG8_MMA(0, 0, At, B0); PG8_MMA(0, 1, At, B1); PG8_BAR; PG8_SCHED;
            PG8_LDA(At, 1, 1); PG8_STAGE(PG8_SB(1, 0), b3, voffB); PG8_STAGE(PG8_SB(1, 1), b3 + hstepB, voffB); PG8_STAGE(PG8_SA(1, 0), a3, voffA);
            PG8_WAIT_V(8); PG8_WAIT_L(0); PG8_BAR; PG8_MMA(1, 0, At, B0); PG8_MMA(1, 1, At, B1); PG8_BAR; PG8_SCHED;
            } else {
            PG8_LDB(B0, 0, 0); PG8_SCHED; PG8_LDA(At, 0, 0); PG8_STAGE(PG8_SA(1, 1), a1 + hstepA, voffA);
            PG8_WAIT_L(8); PG8_BAR; PG8_WAIT_L(0); PG8_MMA(0, 0, At, B0); PG8_BAR; PG8_SCHED;
            PG8_LDB(B1, 0, 1); PG8_STAGE(PG8_SB(0, 0), b2, voffB);
            PG8_BAR; PG8_WAIT_L(0); PG8_MMA(0, 1, At, B1); PG8_BAR;
            PG8_LDA(At, 0, 1); PG8_STAGE(PG8_SA(0, 0), a2, voffA);
            PG8_BAR; PG8_WAIT_L(0); PG8_MMA(1, 0, At, B0); PG8_BAR; PG8_SCHED;
            PG8_STAGE(PG8_SB(0, 1), b2 + hstepB, voffB);
            PG8_WAIT_V(6); PG8_BAR; PG8_MMA(1, 1, At, B1); PG8_BAR;
            PG8_LDB(B0, 1, 0); PG8_SCHED; PG8_LDA(At, 1, 0); PG8_STAGE(PG8_SA(0, 1), a2 + hstepA, voffA);
            PG8_WAIT_L(8); PG8_BAR; PG8_WAIT_L(0); PG8_MMA(0, 0, At, B0); PG8_BAR; PG8_SCHED;
            PG8_LDB(B1, 1, 1); PG8_STAGE(PG8_SB(1, 0), b3, voffB);
            PG8_BAR; PG8_WAIT_L(0); PG8_MMA(0, 1, At, B1); PG8_BAR;
            PG8_LDA(At, 1, 1); PG8_STAGE(PG8_SA(1, 0), a3, voffA);
            PG8_BAR; PG8_WAIT_L(0); PG8_MMA(1, 0, At, B0); PG8_BAR; PG8_SCHED;
            PG8_STAGE(PG8_SB(1, 1), b3 + hstepB, voffB);
            PG8_WAIT_V(6); PG8_BAR; PG8_MMA(1, 1, At, B1); PG8_BAR;
            }
        }
        if constexpr (ALIGN_EPI) { if (wr == 0) PG8_BAR; }
        if constexpr (!Epi::AFTER_DRAIN) { E(acc, cur, wr, wc, fr, fq); }
        if (!has_next) break;
#pragma unroll
        for (int a = 0; a < 2; ++a)
#pragma unroll
            for (int b = 0; b < 2; ++b)
#pragma unroll
                for (int m = 0; m < 4; ++m)
#pragma unroll
                    for (int n = 0; n < 2; ++n) acc[a][b][m][n] = (f32x4){0.f, 0.f, 0.f, 0.f};
        cur = nxt; cA = nA; cB = nB; ++ui;
        if constexpr (ALIGN_EPI) { if (wr == 1) PG8_BAR; }
    }
    PG8_WAIT_V(0);
    if constexpr (!ALIGN_EPI) { if (wr == 0) PG8_BAR; }
    PG8_BAR;
    if constexpr (Epi::AFTER_DRAIN) { E.fused(acc, cur, wr, wc, fr, fq, lds, wid, lane); }
#undef PG8_SA
#undef PG8_SB
#undef PG8_STAGE
#undef PG8_LDA
#undef PG8_LDB
#undef PG8_MMA
#undef PG8_WAIT_V
#undef PG8_WAIT_L
#undef PG8_BAR
#undef PG8_SCHED
}
}
struct EpiIn {
    static constexpr bool PERM = true, AFTER_DRAIN = false;
    unsigned char* ws;
    DI void operator()(const f32x4 (&acc)[2][2][4][2], const pg8::Unit& u, int wr, int wc, int fr, int fq) const {
        bf16_t* P = (bf16_t*)(ws + WS_P); const float* cosH = (const float*)(ws + WS_COSH); const float* sinH = (const float*)(ws + WS_SINH); const float* cosM = (const float*)(ws + WS_COSM); const float* sinM = (const float*)(ws + WS_SINM);
        const int pn = u.pn; const bool ctxt = (u.pm % 33) == 0;
        int mode = 0; float sc = 1.f;
        if ((pn >= 3 && pn <= 10) || (pn >= 15 && pn <= 19)) mode = 1;
        if (pn == 2) mode = 2;
        if ((pn >= 3 && pn <= 6) || (pn >= 15 && pn <= 18)) sc = QS64;
        if (ctxt) mode = 0;
        const int rowt = u.pm * 256 + wr * 64 + fr, colb = pn * 256 + wc * 32 + 8 * fq;
#pragma unroll
        for (int ai = 0; ai < 2; ++ai)
#pragma unroll
            for (int m = 0; m < 4; ++m) {
                const int row = rowt + ai * 128 + m * 16; const int pos = (row % RB) - CTX;
                bf16_t* rowp = P + (size_t)row * NP;
#pragma unroll
                for (int bj = 0; bj < 2; ++bj) {
                    const int col0 = colb + bj * 128;
                    f32x4 v0 = acc[ai][bj][m][0], v1 = acc[ai][bj][m][1];
                    if (pn <= 2) {
                        float s8 = (v0[0] * v0[0] + v0[1] * v0[1]) + (v0[2] * v0[2] + v0[3] * v0[3]) + (v1[0] * v1[0] + v1[1] * v1[1]) + (v1[2] * v1[2] + v1[3] * v1[3]);
                        s8 += __shfl_xor(s8, 16); s8 += __shfl_xor(s8, 32);
                        const int slice = pn * 8 + bj * 4 + wc;
                        if (fq == 0 && slice < 20) ((float*)(ws + WS_PART))[(size_t)row * 20 + slice] = s8;
                    }
                    if (mode == 1) { const int p0 = (col0 & 63) >> 1; const f32x4 cs = *(const f32x4*)(cosH + (size_t)pos * 32 + p0), sn = *(const f32x4*)(sinH + (size_t)pos * 32 + p0); rope8(v0, v1, cs, sn); }
                    else if (mode == 2 && col0 >= C_KR && col0 < C_KR + 32) { const int p0 = (col0 - C_KR) >> 1; const f32x4 cs = *(const f32x4*)(cosM + (size_t)pos * 16 + p0), sn = *(const f32x4*)(sinM + (size_t)pos * 16 + p0); rope8(v0, v1, cs, sn); }
                    v0 = v0 * sc; v1 = v1 * sc;
                    const u32x4 w8 = pack8(v0, v1);
                    *(u32x4*)(rowp + col0) = w8;
                    if (pn == 2 && col0 >= C_KR && col0 < C_KR + 32) {
                        bf16_t* km = (bf16_t*)(ws + WS_KM) + (size_t)row * 768 + 64 + (col0 - C_KR);
#pragma unroll
                        for (int h = 0; h < 8; ++h) *(u32x4*)(km + h * 96) = w8;
                    }
                }
            }
    }
};
struct EpiQ {
    static constexpr bool PERM = true, AFTER_DRAIN = false;
    unsigned char* ws;
    DI void operator()(const f32x4 (&acc)[2][2][4][2], const pg8::Unit& u, int wr, int wc, int fr, int fq) const {
        bf16_t* QM = (bf16_t*)(ws + WS_QM); const float* cosM = (const float*)(ws + WS_COSM); const float* sinM = (const float*)(ws + WS_SINM);
        const bool ctxt = (u.pm % 33) == 0;
        const int rowt = u.pm * 256 + wr * 64 + fr, colb = u.pn * 256 + wc * 32 + 8 * fq;
#pragma unroll
        for (int ai = 0; ai < 2; ++ai)
#pragma unroll
            for (int m = 0; m < 4; ++m) {
                const int row = rowt + ai * 128 + m * 16; const int pos = (row % RB) - CTX;
                const float* pr = (const float*)(ws + WS_PART) + (size_t)row * 20;
                const f32x4 q0 = *(const f32x4*)pr, q1 = *(const f32x4*)(pr + 4), q2 = *(const f32x4*)(pr + 8);
                const float rq = QS96 / sqrtf((((q0[0] + q0[1]) + (q0[2] + q0[3])) + ((q1[0] + q1[1]) + (q1[2] + q1[3])) + ((q2[0] + q2[1]) + (q2[2] + q2[3]))) * (1.0f / 384.0f) + EPS);
#pragma unroll
                for (int bj = 0; bj < 2; ++bj) {
                    const int col0 = colb + bj * 128, within = col0 % 96;
                    f32x4 v0 = acc[ai][bj][m][0], v1 = acc[ai][bj][m][1];
                    if (!ctxt && within >= 64) { const int p0 = (within - 64) >> 1; const f32x4 cs = *(const f32x4*)(cosM + (size_t)pos * 16 + p0), sn = *(const f32x4*)(sinM + (size_t)pos * 16 + p0); rope8(v0, v1, cs, sn); }
                    v0 = v0 * rq; v1 = v1 * rq;
                    *(u32x4*)(QM + (size_t)row * 768 + col0) = pack8(v0, v1);
                }
                asm volatile("" ::: "memory");
            }
    }
};
struct EpiKV {
    static constexpr bool PERM = true, AFTER_DRAIN = false;
    unsigned char* ws;
    DI void operator()(const f32x4 (&acc)[2][2][4][2], const pg8::Unit& u, int wr, int wc, int fr, int fq) const {
        bf16_t* KM = (bf16_t*)(ws + WS_KM); bf16_t* VM = (bf16_t*)(ws + WS_VM);
        const int rowt = u.pm * 256 + wr * 64 + fr, colb = u.pn * 256 + wc * 32 + 8 * fq;
#pragma unroll
        for (int ai = 0; ai < 2; ++ai)
#pragma unroll
            for (int m = 0; m < 4; ++m) {
                const int row = rowt + ai * 128 + m * 16;
                const float* pr = (const float*)(ws + WS_PART) + (size_t)row * 20 + 12;
                const f32x4 k0 = *(const f32x4*)pr, k1 = *(const f32x4*)(pr + 4);
                const float rkv = 1.0f / sqrtf((((k0[0] + k0[1]) + (k0[2] + k0[3])) + ((k1[0] + k1[1]) + (k1[2] + k1[3]))) * (1.0f / 256.0f) + EPS);
#pragma unroll
                for (int bj = 0; bj < 2; ++bj) {
                    const int col0 = colb + bj * 128;
                    bf16_t* dst = (col0 < 512) ? KM + (size_t)row * 768 + (col0 >> 6) * 96 + (col0 & 63) : VM + (size_t)row * 1024 + (col0 - 512);
                    *(u32x4*)dst = pack8(acc[ai][bj][m][0] * rkv, acc[ai][bj][m][1] * rkv);
                }
                asm volatile("" ::: "memory");
            }
    }
};
template <bool DRYE> struct EpiBrT {
    static constexpr bool PERM = true, AFTER_DRAIN = false;
    unsigned char* ws;
    DI void operator()(const f32x4 (&acc)[2][2][4][2], const pg8::Unit& u, int wr, int wc, int fr, int fq) const {
        bf16_t* P = (bf16_t*)(ws + WS_P);
        unsigned chk = 0u;
        const int rowt = u.pm * 256 + wr * 64 + fr, colb = u.pn * 256 + wc * 32 + 8 * fq;
#pragma unroll
        for (int ai = 0; ai < 2; ++ai)
#pragma unroll
            for (int m = 0; m < 4; ++m) {
                const int row = rowt + ai * 128 + m * 16;
#pragma unroll
                for (int bj = 0; bj < 2; ++bj) {
                    bf16_t* p = P + (size_t)row * NP + C_GM + colb + bj * 128;
                    const u32x4 g = *(const u32x4*)p;
                    f32x4 v0 = acc[ai][bj][m][0], v1 = acc[ai][bj][m][1];
                    v0[0] *= sigm_f(bflo(g.x)); v0[1] *= sigm_f(bfhi(g.x)); v0[2] *= sigm_f(bflo(g.y)); v0[3] *= sigm_f(bfhi(g.y));
                    v1[0] *= sigm_f(bflo(g.z)); v1[1] *= sigm_f(bfhi(g.z)); v1[2] *= sigm_f(bflo(g.w)); v1[3] *= sigm_f(bfhi(g.w));
                    { const u32x4 w_ = pack8(v0, v1); if (!DRYE) *(u32x4*)p = w_; else chk ^= w_.x ^ w_.y ^ w_.z ^ w_.w; }
                }
            }
        if (DRYE && chk == 0x12345678u) *(unsigned*)P = chk;
    }
};
template <bool DRYE> struct EpiOutT {
    static constexpr bool PERM = true, AFTER_DRAIN = false;
    int l, g; const float* xsrc; float* xdst; const float* ctxsrc; unsigned char* ws;
    DI void operator()(const f32x4 (&acc)[2][2][4][2], const pg8::Unit& u, int wr, int wc, int fr, int fq) const {
        float* ctxdst = (float*)(ws + WS_CTX); const float* mod = (const float*)(ws + WS_MOD) + (size_t)l * 9 * 3072;
        const int pmb = u.pm % 33, b = g * GB + u.pm / 33; const bool ctxt = pmb == 0;
        if (ctxt && l != 0) return;
        const float* gate = mod + (size_t)(ctxt ? 8 : b) * 3072 + 2048;
        const int colb = u.pn * 256 + wc * 32 + 8 * fq;
#pragma unroll
        for (int ai = 0; ai < 2; ++ai)
#pragma unroll
            for (int m = 0; m < 4; ++m) {
                const int j = pmb * 256 + ai * 128 + wr * 64 + m * 16 + fr;
                const size_t idx = ctxt ? ((size_t)b * CTX + j) * DM : ((size_t)b * SEQ + (j - CTX)) * DM;
                const float* s = (ctxt ? ctxsrc : xsrc) + idx; float* d = (ctxt ? ctxdst : xdst) + idx;
#pragma unroll
                for (int bj = 0; bj < 2; ++bj) {
                    const int col0 = colb + bj * 128;
                    const f32x4 g0 = *(const f32x4*)(gate + col0), g1 = *(const f32x4*)(gate + col0 + 4);
                    const f32x4 x0 = *(const f32x4*)(s + col0), x1 = *(const f32x4*)(s + col0 + 4);
                    if (!DRYE || x0[0] == 12345.678f) { *(f32x4*)(d + col0) = x0 + g0 * acc[ai][bj][m][0];
                    *(f32x4*)(d + col0 + 4) = x1 + g1 * acc[ai][bj][m][1]; }
                }
            }
    }
};

#define MFMA32(a, b, c) __builtin_amdgcn_mfma_f32_32x32x16_bf16((a), (b), (c), 0, 0, 0)
DI s16x4 tr16(const LAS unsigned char* p) { typedef short v4i16_t __attribute__((ext_vector_type(4))); return __builtin_bit_cast(s16x4, __builtin_amdgcn_ds_read_tr16_b64_v4i16((LAS v4i16_t*)p)); }
constexpr int AT_KOFF = 0, AT_KBUFMAX = 13312, AT_VOFF = 3 * AT_KBUFMAX, AT_VBUFMAX = 20480, AT_SOFF = AT_VOFF + 3 * AT_VBUFMAX, AT_QOFF = AT_SOFF + 1024;
static_assert(AT_QOFF + 8 * 6144 <= LDS_BYTES, "attention LDS map");
#ifndef AT_NEGM
#define AT_NEGM 0
#endif
#ifndef AT_LAZY_THR
#define AT_LAZY_THR 1048576.0f
#endif
#ifndef AT_LAZY
#define AT_LAZY 1
#endif
#ifndef AT_NOPF
#define AT_NOPF 1
#endif
#ifndef AT_IGLP
#define AT_IGLP -1
#endif
#ifndef AT_QLMIN
#define AT_QLMIN 64
#endif
#ifndef AT_PVKS
#define AT_PVKS 1
#endif
#ifndef AT_SGB
#define AT_SGB 0
#endif
#ifndef AT_PV8
#define AT_PV8 1
#endif
#ifndef AT_NOSBAR
#define AT_NOSBAR 1
#endif
#if AT_NOSBAR
#define SBAR() do {} while (0)
#else
#define SBAR() __builtin_amdgcn_sched_barrier(0)
#endif
#ifndef PROBE_MODE
#define PROBE_MODE 0
#endif
#ifndef DRY_SEL
#define DRY_SEL 7
#endif
#ifndef AT_QL
#define AT_QL 1
#endif
#ifndef AT_SB
#define AT_SB 0
#endif
template <int DQK, bool QL, bool NG = false>
DI void at_qkt(f32x16& p0, f32x16& p1, const LAS unsigned char* kb, const bf16x8* qf, const LAS unsigned char* qb, const f32x16* c0 = nullptr) {
    constexpr int KSTR = DQK + 8;
    if (!NG) {
#pragma unroll
        for (int r = 0; r < 16; ++r) { p0[r] = 0.f; p1[r] = 0.f; }
    }
#pragma unroll
    for (int ds = 0; ds < DQK / 16; ++ds) {
        const bf16x8 k0 = *(const LAS bf16x8*)(kb + ds * 32), k1 = *(const LAS bf16x8*)(kb + 32 * (KSTR * 2) + ds * 32);
        bf16x8 q; if (QL) q = *(const LAS bf16x8*)(qb + ds * 1024); else q = qf[ds];
        if (NG && ds == 0) { p0 = MFMA32(k0, q, *c0); p1 = MFMA32(k1, q, *c0); } else { p0 = MFMA32(k0, q, p0); p1 = MFMA32(k1, q, p1); }
        if (AT_SB && DQK > 64 && (ds & 1)) __builtin_amdgcn_sched_barrier(0x7f); }
}
DI void at_mask(f32x16& p0, f32x16& p1, int dk) {
#pragma unroll
    for (int r = 0; r < 16; ++r) { const int d = dk + (r & 3) + 8 * (r >> 2);
        if (d > 128 || d < -128) p0[r] = NEGBIG;
        if (d + 32 > 128 || d + 32 < -128) p1[r] = NEGBIG; }
}
DI void at_psm(f32x16& p0, f32x16& p1, float& mrun, float& alpha) {
    float ma = fmaxf(fmaxf(p0[0], p0[1]), p0[2]), mb = fmaxf(fmaxf(p1[0], p1[1]), p1[2]);
    ma = fmaxf(fmaxf(ma, p0[3]), p1[3]);
#pragma unroll
    for (int r = 4; r < 16; r += 2) { ma = fmaxf(fmaxf(ma, p0[r]), p0[r + 1]); mb = fmaxf(fmaxf(mb, p1[r]), p1[r + 1]); }
    float mx = fmaxf(ma, mb);
    { auto rr = __builtin_amdgcn_permlane32_swap(__float_as_uint(mx), __float_as_uint(mx), false, false); mx = fmaxf(__uint_as_float(rr[0]), __uint_as_float(rr[1])); }
    const bool keep = __all(mx - mrun <= THR);
    const float mn = keep ? mrun : fmaxf(mrun, mx); alpha = __builtin_amdgcn_exp2f(mrun - mn); mrun = mn;
#pragma unroll
    for (int r = 0; r < 16; ++r) { p0[r] -= mrun; p1[r] -= mrun; }
#pragma unroll
    for (int r = 0; r < 16; ++r) p0[r] = __builtin_amdgcn_exp2f(p0[r]);
}
template <bool NG>
DI void at_psm_lazy(f32x16& p0, f32x16& p1, float mrun) {
    if (!NG) {
#pragma unroll
        for (int r = 0; r < 16; ++r) { p0[r] -= mrun; p1[r] -= mrun; }
    }
#pragma unroll
    for (int r = 0; r < 16; ++r) p0[r] = __builtin_amdgcn_exp2f(p0[r]);
}
DI void at_fsm_lazy(f32x16& p0, f32x16& p1, float& mrun, float& alpha, float& lrun, bf16x8* pa) {
#pragma unroll
    for (int r = 0; r < 16; ++r) p1[r] = __builtin_amdgcn_exp2f(p1[r]);
    float ps = 0.f;
#pragma unroll
    for (int r = 0; r < 16; ++r) ps += p0[r] + p1[r];
    alpha = 1.f;
    if (__builtin_expect(__any(!(ps <= AT_LAZY_THR)), 0)) {
        float ma = fmaxf(fmaxf(p0[0], p0[1]), p0[2]), mb = fmaxf(fmaxf(p1[0], p1[1]), p1[2]);
        ma = fmaxf(fmaxf(ma, p0[3]), p1[3]);
#pragma unroll
        for (int r = 4; r < 16; r += 2) { ma = fmaxf(fmaxf(ma, p0[r]), p0[r + 1]); mb = fmaxf(fmaxf(mb, p1[r]), p1[r + 1]); }
        float mx = fmaxf(ma, mb);
        { auto rr = __builtin_amdgcn_permlane32_swap(__float_as_uint(mx), __float_as_uint(mx), false, false); mx = fmaxf(__uint_as_float(rr[0]), __uint_as_float(rr[1])); }
        const float d = fmaxf(__builtin_amdgcn_logf(mx), 0.f);
        alpha = __builtin_amdgcn_exp2f(-d); mrun += d; ps *= alpha;
#pragma unroll
        for (int r = 0; r < 16; ++r) { p0[r] *= alpha; p1[r] *= alpha; }
    }
    lrun = lrun * alpha + ps;
    u32x4 w;
    w.x = pk2(p0[0], p0[1]); w.y = pk2(p0[2], p0[3]); w.z = pk2(p0[4], p0[5]); w.w = pk2(p0[6], p0[7]); pa[0] = __builtin_bit_cast(bf16x8, w);
    w.x = pk2(p0[8], p0[9]); w.y = pk2(p0[10], p0[11]); w.z = pk2(p0[12], p0[13]); w.w = pk2(p0[14], p0[15]); pa[1] = __builtin_bit_cast(bf16x8, w);
    w.x = pk2(p1[0], p1[1]); w.y = pk2(p1[2], p1[3]); w.z = pk2(p1[4], p1[5]); w.w = pk2(p1[6], p1[7]); pa[2] = __builtin_bit_cast(bf16x8, w);
    w.x = pk2(p1[8], p1[9]); w.y = pk2(p1[10], p1[11]); w.z = pk2(p1[12], p1[13]); w.w = pk2(p1[14], p1[15]); pa[3] = __builtin_bit_cast(bf16x8, w);
}
DI void at_fsm(f32x16& p0, f32x16& p1, float alpha, float& lrun, bf16x8* pa) {
#pragma unroll
    for (int r = 0; r < 16; ++r) p1[r] = __builtin_amdgcn_exp2f(p1[r]);
    float ps = 0.f;
#pragma unroll
    for (int r = 0; r < 16; ++r) ps += p0[r] + p1[r];
    lrun = lrun * alpha + ps;
    u32x4 w;
    w.x = pk2(p0[0], p0[1]); w.y = pk2(p0[2], p0[3]); w.z = pk2(p0[4], p0[5]); w.w = pk2(p0[6], p0[7]); pa[0] = __builtin_bit_cast(bf16x8, w);
    w.x = pk2(p0[8], p0[9]); w.y = pk2(p0[10], p0[11]); w.z = pk2(p0[12], p0[13]); w.w = pk2(p0[14], p0[15]); pa[1] = __builtin_bit_cast(bf16x8, w);
    w.x = pk2(p1[0], p1[1]); w.y = pk2(p1[2], p1[3]); w.z = pk2(p1[4], p1[5]); w.w = pk2(p1[6], p1[7]); pa[2] = __builtin_bit_cast(bf16x8, w);
    w.x = pk2(p1[8], p1[9]); w.y = pk2(p1[10], p1[11]); w.z = pk2(p1[12], p1[13]); w.w = pk2(p1[14], p1[15]); pa[3] = __builtin_bit_cast(bf16x8, w);
}
DI void at_fsm_fake(f32x16& p0, f32x16& p1, bf16x8* pa) {
    u32x4 w;
    w.x = pk2(p0[0], p0[1]); w.y = pk2(p0[2], p0[3]); w.z = pk2(p0[4], p0[5]); w.w = pk2(p0[6], p0[7]); pa[0] = __builtin_bit_cast(bf16x8, w);
    w.x = pk2(p0[8], p0[9]); w.y = pk2(p0[10], p0[11]); w.z = pk2(p0[12], p0[13]); w.w = pk2(p0[14], p0[15]); pa[1] = __builtin_bit_cast(bf16x8, w);
    w.x = pk2(p1[0], p1[1]); w.y = pk2(p1[2], p1[3]); w.z = pk2(p1[4], p1[5]); w.w = pk2(p1[6], p1[7]); pa[2] = __builtin_bit_cast(bf16x8, w);
    w.x = pk2(p1[8], p1[9]); w.y = pk2(p1[10], p1[11]); w.z = pk2(p1[12], p1[13]); w.w = pk2(p1[14], p1[15]); pa[3] = __builtin_bit_cast(bf16x8, w);
}
template <int DV>
DI void at_pv(f32x16* o, const LAS unsigned char* vb, const bf16x8* pa) {
    constexpr int VSTR = DV + 32;
#if AT_PVKS
#pragma unroll
    for (int ks = 0; ks < 4; ++ks) {
        s16x4 vlo[DV / 32], vhi[DV / 32];
#pragma unroll
        for (int db = 0; db < DV / 32; ++db) { vlo[db] = tr16(vb + (16 * ks) * (VSTR * 2) + db * 64); vhi[db] = tr16(vb + (16 * ks + 8) * (VSTR * 2) + db * 64); }
#pragma unroll
        for (int db = 0; db < DV / 32; ++db) { const bf16x8 vf = __builtin_shufflevector(vlo[db], vhi[db], 0, 1, 2, 3, 4, 5, 6, 7); o[db] = MFMA32(pa[ks], vf, o[db]); }
    }
#else
#pragma unroll
    for (int db = 0; db < DV / 32; ++db) {
        s16x4 vlo[4], vhi[4];
#pragma unroll
        for (int ks = 0; ks < 4; ++ks) { vlo[ks] = tr16(vb + (16 * ks) * (VSTR * 2) + db * 64); vhi[ks] = tr16(vb + (16 * ks + 8) * (VSTR * 2) + db * 64); }
#pragma unroll
        for (int ks = 0; ks < 4; ++ks) { const bf16x8 vf = __builtin_shufflevector(vlo[ks], vhi[ks], 0, 1, 2, 3, 4, 5, 6, 7); o[db] = MFMA32(pa[ks], vf, o[db]); }
    }
#endif
}
template <int DV>
DI void at_scale_o(f32x16* o, LAS float* scw, float val, int r32, int hi) {
    if (hi == 0) scw[r32] = val;
    __builtin_amdgcn_wave_barrier(); asm volatile("" ::: "memory");
#pragma unroll
    for (int g4 = 0; g4 < 4; ++g4) { const f32x4 a4 = *(const LAS f32x4*)(scw + 8 * g4 + 4 * hi);
#pragma unroll
        for (int db = 0; db < DV / 32; ++db) { o[db][4 * g4 + 0] *= a4[0]; o[db][4 * g4 + 1] *= a4[1]; o[db][4 * g4 + 2] *= a4[2]; o[db][4 * g4 + 3] *= a4[3]; } }
    __builtin_amdgcn_wave_barrier(); asm volatile("" ::: "memory");
}
template <int DQK, int DV, int OUTM, bool MASKED>
DI void attn_unit(LAS unsigned char* lds, const bf16_t* Qp, int ldq, const bf16_t* Kp, int ldk, const bf16_t* Vp, int ldv,
                  int nA, int rowB0, int nB, int posB0, int qpos0, float m0, float l0,
                  bf16_t* Og, int ldo, float* Of, int ldof) {
    constexpr int KSTR = DQK + 8, VSTR = DV + 32, KBUF = 64 * KSTR * 2, VBUF = 64 * VSTR * 2;
    constexpr int KCH = DQK / 8, VCH = DV / 8, NKC = 64 * KCH, NVC = 64 * VCH, KRN = (NKC + 511) / 512, VRN = (NVC + 511) / 512;
    static_assert(KBUF <= AT_KBUFMAX && VBUF <= AT_VBUFMAX, "attention LDS map");
    const int tid = tid_l(), lane = tid & 63, wid = __builtin_amdgcn_readfirstlane(tid >> 6), r32 = lane & 31, hi = lane >> 5;
#ifndef AT_QL
#define AT_QL 1
#endif
#ifndef AT_SB
#define AT_SB 0
#endif
    constexpr bool NG = (AT_NEGM == 1 && DQK == 64) || (AT_NEGM == 2 && DQK == 64 && DV == 64);
    constexpr bool QL = AT_QL && (DQK > AT_QLMIN || (NG && DV == 128));
    bf16x8 qf[QL ? 1 : DQK / 16];
    const LAS unsigned char* qb = lds + AT_QOFF + wid * 6144 + lane * 16;
    { const bf16_t* qrow = Qp + (size_t)(32 * wid + r32) * ldq + 8 * hi;
#pragma unroll
      for (int ds = 0; ds < DQK / 16; ++ds) { const bf16x8 v = *(const bf16x8*)(qrow + 16 * ds); if (QL) *(LAS bf16x8*)(lds + AT_QOFF + wid * 6144 + lane * 16 + ds * 1024) = v; else qf[QL ? 0 : ds] = v; }
      if (QL) { __builtin_amdgcn_wave_barrier(); asm volatile("s_waitcnt lgkmcnt(0)" ::: "memory"); } }
    f32x16 o[DV / 32];
#pragma unroll
    for (int db = 0; db < DV / 32; ++db)
#pragma unroll
        for (int r = 0; r < 16; ++r) o[db][r] = 0.f;
    float mrun = m0, lrun = (hi == 0) ? l0 : 0.f;
    LAS float* scw = (LAS float*)(lds + AT_SOFF) + wid * 32;
    const int NT = nA + nB;
    const LAS unsigned char* kb0 = lds + AT_KOFF + r32 * (KSTR * 2) + hi * 16;
    const LAS unsigned char* vb0 = lds + AT_VOFF + (4 * hi + ((lane & 15) >> 2)) * (VSTR * 2) + (16 * ((lane >> 4) & 1) + 4 * (lane & 3)) * 2;
    const int dk0 = posB0 + 4 * hi - (qpos0 + 32 * wid + r32) - 64 * nA;
    u32x4 kreg[KRN], vreg[VRN];
    int kgo[KRN], klo[KRN], vgo[VRN], vlo_[VRN];
#pragma unroll
    for (int i_ = 0; i_ < KRN; ++i_) { int c_ = tid + 512 * i_; if (c_ >= NKC) c_ -= 512; const int r_ = c_ / KCH, cc_ = c_ % KCH; kgo[i_] = r_ * ldk + cc_ * 8; klo[i_] = AT_KOFF + r_ * (KSTR * 2) + cc_ * 16; }
#pragma unroll
    for (int i_ = 0; i_ < VRN; ++i_) { int c_ = tid + 512 * i_; if (c_ >= NVC) c_ -= 512; const int r_ = c_ / VCH, cc_ = c_ % VCH; vgo[i_] = r_ * ldv + cc_ * 8; vlo_[i_] = AT_VOFF + r_ * (VSTR * 2) + cc_ * 16; }
    const __amdgpu_buffer_rsrc_t rK = __builtin_amdgcn_make_buffer_rsrc((void*)Kp, 0, 0x7fffffff, 0x00020000), rV = __builtin_amdgcn_make_buffer_rsrc((void*)Vp, 0, 0x7fffffff, 0x00020000);
#define AT_GLOAD(t) do { const int row0_ = (t) < nA ? 64 * (t) : rowB0 + 64 * ((t) - nA); const int sk_ = row0_ * ldk * 2, sv_ = row0_ * ldv * 2; \
        _Pragma("unroll") for (int i_ = 0; i_ < KRN; ++i_) kreg[i_] = __builtin_amdgcn_raw_buffer_load_b128(rK, kgo[i_] * 2, sk_, 0); \
        _Pragma("unroll") for (int i_ = 0; i_ < VRN; ++i_) vreg[i_] = __builtin_amdgcn_raw_buffer_load_b128(rV, vgo[i_] * 2, sv_, 0); } while (0)
#define AT_SWRITE(buf) do { \
        _Pragma("unroll") for (int i_ = 0; i_ < KRN; ++i_) *(LAS u32x4*)(lds + (buf) * KBUF + klo[i_]) = kreg[i_]; \
        _Pragma("unroll") for (int i_ = 0; i_ < VRN; ++i_) *(LAS u32x4*)(lds + (buf) * VBUF + vlo_[i_]) = vreg[i_]; } while (0)
    unsigned pfv = 0u, pfacc = 0u;
    const int pft = tid & 255;
    const bf16_t* pfb = (pft < 128) ? Kp + (pft >> 1) * ldk + (pft & 1) * (DQK - 2) : Vp + ((pft - 128) >> 1) * ldv + (pft & 1) * (DV - 2);
    const int pfs = (pft < 128) ? ldk : ldv;
    constexpr int PFD = 4;
#if AT_NOPF
#define AT_PF(t) do {} while (0)
#else
#define AT_PF(t) do { pfacc ^= pfv; const int tt_ = (t) < NT ? (t) : NT - 1; const int row0_ = tt_ < nA ? 64 * tt_ : rowB0 + 64 * (tt_ - nA); \
        pfv = *(const unsigned*)(pfb + (size_t)row0_ * pfs); } while (0)
#endif
#define AT_MASK(P0, P1, t) do { if (MASKED && (t) >= nA) at_mask(P0, P1, dk0 + 64 * (t)); } while (0)
#define AT_RESC(al) do { if (__any((al) < 1.f)) at_scale_o<DV>(o, scw, (al), r32, hi); } while (0)
    constexpr int DRYP = (OUTM == 2) ? PROBE_MODE : 0;
    f32x16 pA0, pA1, pB0, pB1; float alA, alB; bf16x8 pa[4];
    AT_PF(1); AT_PF(2); AT_PF(3);
    AT_GLOAD(0); AT_SWRITE(0); __syncthreads();
    AT_GLOAD(1);
    at_qkt<DQK, QL>(pA0, pA1, kb0, qf, qb); AT_MASK(pA0, pA1, 0); at_psm(pA0, pA1, mrun, alA);
#if AT_LAZY
    lrun *= alA;
#endif
    AT_SWRITE(1); __syncthreads();
    int bp = 0, bc = 1, bn = 2;
    constexpr int NMF = 2 * (DQK / 16) + 4 * (DV / 32);
#if AT_IGLP >= 0
#define AT_SCHED() __builtin_amdgcn_iglp_opt(AT_IGLP)
#elif AT_SGB
#define AT_SCHED() do { _Pragma("unroll") for (int i_ = 0; i_ < NMF; ++i_) { __builtin_amdgcn_sched_group_barrier(0x008, 1, 0); __builtin_amdgcn_sched_group_barrier(0x100, 2, 0); __builtin_amdgcn_sched_group_barrier(0x002, AT_SGB, 0); } } while (0)
#else
#define AT_SCHED() do {} while (0)
#endif
#define AT_ROT() do { bp = bc; bc = bn; bn = (bn == 2) ? 0 : bn + 1; } while (0)
#if AT_LAZY
    f32x16 negm;
    if (NG) {
#pragma unroll
        for (int r = 0; r < 16; ++r) negm[r] = -mrun;
    }
#define AT_NEGUPD(al, P0, P1) do { if (NG && __any((al) < 1.f)) { const float d_ = -__builtin_amdgcn_logf(al); _Pragma("unroll") for (int r_ = 0; r_ < 16; ++r_) { negm[r_] = -mrun; P0[r_] -= d_; P1[r_] -= d_; } } } while (0)
    for (int j = 1; j + 1 < NT; j += 2) {
        at_qkt<DQK, QL, NG>(pB0, pB1, kb0 + bc * KBUF, qf, qb, &negm); AT_MASK(pB0, pB1, j);
        AT_GLOAD(j + 1);
        at_fsm_lazy(pA0, pA1, mrun, alA, lrun, pa);
        AT_RESC(alA); AT_NEGUPD(alA, pB0, pB1);
        at_pv<DV>(o, vb0 + bp * VBUF, pa); at_psm_lazy<NG>(pB0, pB1, mrun);
        AT_SWRITE(bn);
        __syncthreads(); AT_ROT();
        at_qkt<DQK, QL, NG>(pA0, pA1, kb0 + bc * KBUF, qf, qb, &negm); AT_MASK(pA0, pA1, j + 1);
        AT_GLOAD(j + 2);
        at_fsm_lazy(pB0, pB1, mrun, alB, lrun, pa);
        AT_RESC(alB); AT_NEGUPD(alB, pA0, pA1);
        at_pv<DV>(o, vb0 + bp * VBUF, pa); at_psm_lazy<NG>(pA0, pA1, mrun);
        AT_SWRITE(bn);
        __syncthreads(); AT_ROT();
    }
    at_qkt<DQK, QL, NG>(pB0, pB1, kb0 + bc * KBUF, qf, qb, &negm); AT_MASK(pB0, pB1, NT - 1);
    at_fsm_lazy(pA0, pA1, mrun, alA, lrun, pa);
    AT_RESC(alA); AT_NEGUPD(alA, pB0, pB1);
    at_pv<DV>(o, vb0 + bp * VBUF, pa); at_psm_lazy<NG>(pB0, pB1, mrun);
    at_fsm_lazy(pB0, pB1, mrun, alB, lrun, pa);
    AT_RESC(alB);
    at_pv<DV>(o, vb0 + bc * VBUF, pa);
#else
    for (int j = 1; j + 1 < ((DRYP == 6) ? 2 : NT); j += 2) {
        SBAR(); if (DRYP != 5) at_qkt<DQK, QL>(pB0, pB1, kb0 + bc * KBUF, qf, qb); else { _Pragma("unroll") for (int r_ = 0; r_ < 16; ++r_) { pB0[r_] = o[0][r_] * 1e-3f; pB1[r_] = o[1][r_] * 1e-3f; } } AT_MASK(pB0, pB1, j);
        if (!(DRYP >= 1)) { AT_GLOAD(j + 1); AT_PF(j + PFD); }
        if (DRYP != 3) at_fsm(pA0, pA1, alA, lrun, pa); else at_fsm_fake(pA0, pA1, pa); SBAR();
        if (DRYP != 4) at_pv<DV>(o, vb0 + bp * VBUF, pa); else { o[0][0] += __builtin_bit_cast(float, (int)pa[0][0] + (int)pa[1][1] + (int)pa[2][2] + (int)pa[3][3]); } if (DRYP != 3) at_psm(pB0, pB1, mrun, alB); else alB = 1.f;
        AT_SCHED();
        if (!(DRYP >= 1)) AT_SWRITE(bn);
        AT_RESC(alB); if (DRYP != 2) __syncthreads(); AT_ROT();
        SBAR(); if (DRYP != 5) at_qkt<DQK, QL>(pA0, pA1, kb0 + bc * KBUF, qf, qb); else { _Pragma("unroll") for (int r_ = 0; r_ < 16; ++r_) { pA0[r_] = o[0][r_] * 1e-3f; pA1[r_] = o[1][r_] * 1e-3f; } } AT_MASK(pA0, pA1, j + 1);
        if (!(DRYP >= 1)) { AT_GLOAD(j + 2); AT_PF(j + 1 + PFD); }
        if (DRYP != 3) at_fsm(pB0, pB1, alB, lrun, pa); else at_fsm_fake(pB0, pB1, pa); SBAR();
        if (DRYP != 4) at_pv<DV>(o, vb0 + bp * VBUF, pa); else { o[0][0] += __builtin_bit_cast(float, (int)pa[0][0] + (int)pa[1][1] + (int)pa[2][2] + (int)pa[3][3]); } if (DRYP != 3) at_psm(pA0, pA1, mrun, alA); else alA = 1.f;
        AT_SCHED();
        if (!(DRYP >= 1)) AT_SWRITE(bn);
        AT_RESC(alA); if (DRYP != 2) __syncthreads(); AT_ROT();
    }
    SBAR(); at_qkt<DQK, QL>(pB0, pB1, kb0 + bc * KBUF, qf, qb); AT_MASK(pB0, pB1, NT - 1);
    at_fsm(pA0, pA1, alA, lrun, pa); SBAR();
    at_pv<DV>(o, vb0 + bp * VBUF, pa); at_psm(pB0, pB1, mrun, alB);
    AT_RESC(alB);
    at_fsm(pB0, pB1, alB, lrun, pa); SBAR();
    at_pv<DV>(o, vb0 + bc * VBUF, pa);
#endif
#undef AT_ROT
#ifdef AT_NEGUPD
#undef AT_NEGUPD
#endif
#undef AT_SCHED
    pfacc ^= pfv;
    if (__builtin_expect(pfacc == 0x9e3779b9u && lrun == 12345.678f, 0)) scw[0] = 1.f;
#undef AT_GLOAD
#undef AT_PF
#undef AT_SWRITE
#undef AT_MASK
#undef AT_RESC
    { const float lt = lrun + __shfl_xor(lrun, 32); at_scale_o<DV>(o, scw, 1.0f / lt, r32, hi); }
    if (OUTM == 0) {
#pragma unroll
        for (int db = 0; db < DV / 32; ++db) {
            bf16_t* pb = Og + (size_t)(32 * wid + 4 * hi) * ldo + 32 * db + r32;
            bf16_t zz[16];
#pragma unroll
            for (int r = 0; r < 16; ++r) zz[r] = pb[(size_t)((r & 3) + 8 * (r >> 2)) * ldo];
#pragma unroll
            for (int r = 0; r < 16; ++r) { const float z = __uint_as_float((unsigned)zz[r] << 16); pb[(size_t)((r & 3) + 8 * (r >> 2)) * ldo] = (bf16_t)(pk2(o[db][r] * silu_f(z), 0.f) & 0xffffu); }
        }
    } else {
#pragma unroll
        for (int db = 0; db < DV / 32; ++db)
#pragma unroll
            for (int r = 0; r < 16; ++r) {
                const int q = (r & 3) + 8 * (r >> 2) + 4 * hi;
                if (OUTM == 1) { Of[(size_t)(32 * wid + q) * ldof + 32 * db + r32] = o[db][r]; }
                else { if (lrun == 12345.678f) Of[(size_t)(32 * wid + q) * ldof + 32 * db + r32] = o[db][r]; }
            }
    }
    __syncthreads();
}

struct Args { const float* in[21]; float* out; unsigned char* ws; };
typedef const __attribute__((address_space(4))) Args* ArgsP;
DI ArgsP args_ptr() { ArgsP p = (ArgsP)__builtin_amdgcn_kernarg_segment_ptr(); asm volatile("" : "+s"(p)); return p; }
enum { I_X = 0, I_C, I_CTX, I_CCTX, I_WMOD, I_BMOD, I_NORMG, I_WIN, I_QNORM, I_WUQ, I_KVNORM, I_WUKV, I_LQ1, I_LK1, I_LQ2, I_LK2, I_SUBLN, I_SINK, I_WBR, I_WOUT, I_FNORM };

DI int colmap(int kind, int n) {
    if (kind == 1) {
        if (n < C_KR) return n;
        if (n < C_KR + 32) { const int e = n - C_KR; return C_KR + (e >> 1) + 16 * (e & 1); }
        if (n < C_DQ) return -1;
        if ((n >= C_DQ && n < C_DV) || (n >= C_SQ && n < C_SV)) { const int w = n & 63; return (n - w) - 96 + (w >> 1) + 32 * (w & 1); }
        return n - 96;
    }
    if (kind == 2) { const int h = n / 96, e = n % 96; if (e < 64) return n; const int e2 = e - 64; return h * 96 + 64 + (e2 >> 1) + 16 * (e2 & 1); }
    if (kind == 3) { if (n < 512) return (n >> 6) * 192 + (n & 63); const int n2 = n - 512; return (n2 >> 7) * 192 + 64 + (n2 & 127); }
    return n;
}
DI void transpose_item(const float* W, int ldw, int kind, const float* rowscale, bf16_t* WT, int ldd, int koff, LAS float* scr, int item, int nblk, int lane) {
    const int kb = item / nblk, nb = item % nblk, k0 = 64 * kb, n0 = 32 * nb;
    const int oc = colmap(kind, n0 + (lane & 31));
#pragma unroll 8
    for (int i = 0; i < 32; ++i) { const int kk = 2 * i + (lane >> 5); float v = 0.f; if (oc >= 0) v = W[(size_t)(k0 + kk) * ldw + oc]; if (rowscale) v *= rowscale[k0 + kk]; scr[kk * 33 + (lane & 31)] = v; }
    __builtin_amdgcn_wave_barrier(); asm volatile("s_waitcnt lgkmcnt(0)" ::: "memory");
    const int c = lane & 7;
#pragma unroll
    for (int j = 0; j < 4; ++j) { const int n = (lane >> 3) + 8 * j; const LAS float* s = scr + (8 * c) * 33 + n;
        u32x4 o; o.x = pk2(s[0 * 33], s[1 * 33]); o.y = pk2(s[2 * 33], s[3 * 33]); o.z = pk2(s[4 * 33], s[5 * 33]); o.w = pk2(s[6 * 33], s[7 * 33]);
        *(u32x4*)(WT + (size_t)(n0 + n) * ldd + koff + k0 + 8 * c) = o; }
    __builtin_amdgcn_wave_barrier(); asm volatile("s_waitcnt lgkmcnt(0)" ::: "memory");
}
DI void prologue(ArgsP ap, LAS unsigned char* lds) {
    const int tid = tid_l(), lane = tid & 63, wid = __builtin_amdgcn_readfirstlane(tid >> 6);
    unsigned char* ws = ap->ws;
    LAS float* scr = (LAS float*)(lds + wid * 8448);
    const int gw = bid_l() * 8 + wid, NGW = grd_l() * 8;
    constexpr int I_IN = 16 * (NP / 32), I_UQ = 6 * 24, I_UKV = 4 * 48, I_SQ = 16 * 32, PER_L = I_IN + I_UQ + I_UKV + 6 * I_SQ;
    for (int it = gw; it < 2 * PER_L; it += NGW) {
        const int l = it / PER_L; int r = it % PER_L;
        if (r < I_IN) { transpose_item(ap->in[I_WIN] + (size_t)l * 1024 * D_IN, D_IN, 1, nullptr, (bf16_t*)(ws + WS_WIN) + (size_t)l * NP * 1024, 1024, 0, scr, r, NP / 32, lane); continue; } r -= I_IN;
        if (r < I_UQ) { transpose_item(ap->in[I_WUQ] + (size_t)l * 384 * 768, 768, 2, ap->in[I_QNORM] + l * 384, (bf16_t*)(ws + WS_WUQ) + (size_t)l * 768 * 384, 384, 0, scr, r, 24, lane); continue; } r -= I_UQ;
        if (r < I_UKV) { transpose_item(ap->in[I_WUKV] + (size_t)l * 256 * 1536, 1536, 3, ap->in[I_KVNORM] + l * 256, (bf16_t*)(ws + WS_WUKV) + (size_t)l * 1536 * 256, 256, 0, scr, r, 48, lane); continue; } r -= I_UKV;
        if (r < 3 * I_SQ) { const int br = r / I_SQ; transpose_item(ap->in[I_WBR] + ((size_t)l * 3 + br) * 1024 * 1024, 1024, 0, nullptr, (bf16_t*)(ws + WS_WB) + ((size_t)l * 3 + br) * 1024 * 1024, 1024, 0, scr, r % I_SQ, 32, lane); continue; } r -= 3 * I_SQ;
        { const int rep = r / I_SQ; transpose_item(ap->in[I_WOUT] + (size_t)l * 1024 * 1024, 1024, 0, nullptr, (bf16_t*)(ws + WS_WO3) + (size_t)l * 1024 * 3072, 3072, rep * 1024, scr, r % I_SQ, 32, lane); }
    }
    const int gt = bid_l() * 512 + tid, NGT = grd_l() * 512;
    for (int i = gt; i < SEQ * 48; i += NGT) {
        const int pos = i / 48, p = i % 48; const float frow = (float)(pos >> 6), fcol = (float)(pos & 63);
        float ang; float* cd; float* sd;
        if (p < 32) { const int f = p & 15; const float inv = powf(10000.0f, -(float)f / 16.0f); ang = (p < 16 ? frow : fcol) * inv; cd = (float*)(ws + WS_COSH) + pos * 32 + p; sd = (float*)(ws + WS_SINH) + pos * 32 + p; }
        else { const int pp = p - 32, f = pp & 7; const float inv = powf(10000.0f, -(float)f / 8.0f); ang = (pp < 8 ? frow : fcol) * inv; cd = (float*)(ws + WS_COSM) + pos * 16 + pp; sd = (float*)(ws + WS_SINM) + pos * 16 + pp; }
        *cd = __cosf(ang); *sd = __sinf(ang);
    }
    for (int it = gw; it < 2 * 16 * 48; it += NGW) {
        const int l = it / 768, rem = it % 768, kc = rem / 48, nb = rem % 48; const int k = kc * 64 + lane;
        float sv[9];
#pragma unroll
        for (int v = 0; v < 8; ++v) sv[v] = silu_f(ap->in[I_C][v * 1024 + k]);
        sv[8] = silu_f(ap->in[I_CCTX][k]);
        float acc[9];
#pragma unroll
        for (int v = 0; v < 9; ++v) acc[v] = 0.f;
        const float* w = ap->in[I_WMOD] + ((size_t)l * 1024 + kc * 64) * 3072 + nb * 64 + lane;
#pragma unroll 8
        for (int kk = 0; kk < 64; ++kk) { const float wv = w[(size_t)kk * 3072];
#pragma unroll
            for (int v = 0; v < 9; ++v) acc[v] += __uint_as_float(__builtin_amdgcn_readlane(__float_as_uint(sv[v]), kk)) * wv; }
        float* mp = (float*)(ws + WS_MODP) + ((size_t)(l * 16 + kc) * 9) * 3072 + nb * 64 + lane;
#pragma unroll
        for (int v = 0; v < 9; ++v) mp[(size_t)v * 3072] = acc[v];
    }
}
DI void mod_finalize(ArgsP ap) {
    const int tid = tid_l();
    const int gt = bid_l() * 512 + tid, NGT = grd_l() * 512;
    const float* mp = (const float*)(ap->ws + WS_MODP); float* mod = (float*)(ap->ws + WS_MOD);
    for (int i = gt; i < 2 * 9 * 3072; i += NGT) {
        const int l = i / (9 * 3072), rem = i % (9 * 3072), n = rem % 3072;
        float s = ap->in[I_BMOD][l * 3072 + n];
#pragma unroll
        for (int kc = 0; kc < 16; ++kc) s += mp[(size_t)(l * 16 + kc) * 9 * 3072 + rem];
        mod[i] = s;
    }
}
DI void ph_norm_mod(ArgsP ap, int l, int g) {
    const int tid = tid_l(), lane = tid & 63, wid = __builtin_amdgcn_readfirstlane(tid >> 6);
    const int gw = bid_l() * 8 + wid, NGW = grd_l() * 8;
    const float* ng = ap->in[I_NORMG] + l * 1024; const float* mod = (const float*)(ap->ws + WS_MOD) + (size_t)l * 9 * 3072;
    const float* xs = (l == 0) ? ap->in[I_X] : ap->out; const float* cs = (l == 0) ? ap->in[I_CTX] : (const float*)(ap->ws + WS_CTX);
    bf16_t* H = (bf16_t*)(ap->ws + WS_H);
    for (int r = gw; r < R; r += NGW) {
        const int bl = r / RB, j = r % RB, b = g * GB + bl;
        const float* src; const float* md;
        if (j < CTX) { src = cs + ((size_t)b * CTX + j) * DM; md = mod + 8 * 3072; } else { src = xs + ((size_t)b * SEQ + (j - CTX)) * DM; md = mod + (size_t)b * 3072; }
        f32x4 v[4]; float ss = 0.f;
#pragma unroll
        for (int q = 0; q < 4; ++q) { v[q] = *(const f32x4*)(src + 4 * (lane + 64 * q)); ss += (v[q][0] * v[q][0] + v[q][1] * v[q][1]) + (v[q][2] * v[q][2] + v[q][3] * v[q][3]); }
        const float rstd = 1.0f / sqrtf(wave_sum(ss) * (1.0f / DM) + EPS);
#pragma unroll
        for (int q = 0; q < 4; ++q) { const int idx = 4 * (lane + 64 * q);
            const f32x4 gg = *(const f32x4*)(ng + idx), sh = *(const f32x4*)(md + idx), sc = *(const f32x4*)(md + 1024 + idx);
            const f32x4 y = (v[q] * rstd * gg) * (sc + 1.0f) + sh;
            u32x2 w; w.x = pk2(y[0], y[1]); w.y = pk2(y[2], y[3]); *(u32x2*)(H + (size_t)r * DM + idx) = w; }
    }
}
DI void ph_mla_norm(ArgsP ap) {
    const int tid = tid_l(), lane = tid & 63, wid = __builtin_amdgcn_readfirstlane(tid >> 6);
    const int gw = bid_l() * 8 + wid, NGW = grd_l() * 8;
    const bf16_t* P = (const bf16_t*)(ap->ws + WS_P); bf16_t* AQ = (bf16_t*)(ap->ws + WS_AQ); bf16_t* AKV = (bf16_t*)(ap->ws + WS_AKV); bf16_t* KM = (bf16_t*)(ap->ws + WS_KM);
    for (int r = gw; r < R; r += NGW) {
        const bf16_t* row = P + (size_t)r * NP;
        const u32x4 c0 = *(const u32x4*)(row + 8 * lane);
        u32x4 c1 = {0u, 0u, 0u, 0u}; if (lane < 20) c1 = *(const u32x4*)(row + 8 * (64 + lane));
        float f0[8] = {bflo(c0.x), bfhi(c0.x), bflo(c0.y), bfhi(c0.y), bflo(c0.z), bfhi(c0.z), bflo(c0.w), bfhi(c0.w)};
        float f1[8] = {bflo(c1.x), bfhi(c1.x), bflo(c1.y), bfhi(c1.y), bflo(c1.z), bfhi(c1.z), bflo(c1.w), bfhi(c1.w)};
        float s0 = 0.f, s1 = 0.f;
#pragma unroll
        for (int i = 0; i < 8; ++i) { s0 += f0[i] * f0[i]; s1 += f1[i] * f1[i]; }
        const float sq = wave_sum(lane < 48 ? s0 : 0.f);
        const float skv = wave_sum((lane >= 48 ? s0 : 0.f) + (lane < 16 ? s1 : 0.f));
        const float rq = 1.0f / sqrtf(sq * (1.0f / 384.0f) + EPS), rkv = 1.0f / sqrtf(skv * (1.0f / 256.0f) + EPS);
        { const float rr = lane < 48 ? rq : rkv; u32x4 w; w.x = pk2(f0[0] * rr, f0[1] * rr); w.y = pk2(f0[2] * rr, f0[3] * rr); w.z = pk2(f0[4] * rr, f0[5] * rr); w.w = pk2(f0[6] * rr, f0[7] * rr);
          if (lane < 48) *(u32x4*)(AQ + (size_t)r * 384 + 8 * lane) = w; else *(u32x4*)(AKV + (size_t)r * 256 + 8 * (lane - 48)) = w; }
        if (lane < 16) { u32x4 w; w.x = pk2(f1[0] * rkv, f1[1] * rkv); w.y = pk2(f1[2] * rkv, f1[3] * rkv); w.z = pk2(f1[4] * rkv, f1[5] * rkv); w.w = pk2(f1[6] * rkv, f1[7] * rkv);
            *(u32x4*)(AKV + (size_t)r * 256 + 8 * (16 + lane)) = w; }
        else if (lane < 20) {
#pragma unroll
            for (int h = 0; h < 8; ++h) *(u32x4*)(KM + (size_t)r * 768 + h * 96 + 64 + 8 * (lane - 16)) = c1; }
    }
}
template <bool DRYE>
DI void ph_diff_post(ArgsP ap, int l) {
    const int tid = tid_l(), lane = tid & 63, wid = __builtin_amdgcn_readfirstlane(tid >> 6);
    const int gw = bid_l() * 8 + wid, NGW = grd_l() * 8;
    const float lam_init = (l == 0) ? 0.2f : (0.8f - 0.6f * 0.7408182206817179f);
    const float d1 = wave_sum(ap->in[I_LQ1][l * 64 + lane] * ap->in[I_LK1][l * 64 + lane]), d2 = wave_sum(ap->in[I_LQ2][l * 64 + lane] * ap->in[I_LK2][l * 64 + lane]);
    const float lam = expf(d1) - expf(d2) + lam_init;
    const float sl0 = ap->in[I_SUBLN][l * 128 + 2 * lane] * (1.0f - lam_init), sl1 = ap->in[I_SUBLN][l * 128 + 2 * lane + 1] * (1.0f - lam_init);
    const float* OD = (const float*)(ap->ws + WS_OD); bf16_t* P = (bf16_t*)(ap->ws + WS_P);
    typedef float f32x2 __attribute__((ext_vector_type(2)));
    for (int r = gw; r < R; r += NGW) {
        if (l != 0 && (r % RB) < CTX) continue;
        const float* ob = OD + (size_t)r * 2048 + 2 * lane; unsigned* zb = (unsigned*)(P + (size_t)r * NP + C_Z + 1024 + 2 * lane);
        f32x2 o1[8], o2[8]; unsigned z[8];
#pragma unroll
        for (int h = 0; h < 8; ++h) { o1[h] = *(const f32x2*)(ob + (2 * h) * 128); o2[h] = *(const f32x2*)(ob + (2 * h + 1) * 128); z[h] = zb[h * 64]; }
#pragma unroll
        for (int h = 0; h < 8; ++h) {
            const float a0 = o1[h][0] - lam * o2[h][0], a1 = o1[h][1] - lam * o2[h][1];
            const float rstd = 1.0f / sqrtf(wave_sum(a0 * a0 + a1 * a1) * (1.0f / 128.0f) + EPS);
            if (!DRYE || rstd == 12345.678f) zb[h * 64] = pk2(a0 * rstd * sl0 * silu_f(bflo(z[h])), a1 * rstd * sl1 * silu_f(bfhi(z[h])));
        }
    }
}
template <bool DRYE>
DI void ph_final_norm(ArgsP ap) {
    const int tid = tid_l(), lane = tid & 63, wid = __builtin_amdgcn_readfirstlane(tid >> 6);
    const int gw = bid_l() * 8 + wid, NGW = grd_l() * 8; const float* fg = ap->in[I_FNORM];
    for (int r = gw; r < NBATCH * SEQ; r += NGW) {
        float* row = ap->out + (size_t)r * DM; f32x4 v[4]; float ss = 0.f;
#pragma unroll
        for (int q = 0; q < 4; ++q) { v[q] = *(const f32x4*)(row + 4 * (lane + 64 * q)); ss += (v[q][0] * v[q][0] + v[q][1] * v[q][1]) + (v[q][2] * v[q][2] + v[q][3] * v[q][3]); }
        const float rstd = 1.0f / sqrtf(wave_sum(ss) * (1.0f / DM) + EPS);
#pragma unroll
        for (int q = 0; q < 4; ++q) { const int idx = 4 * (lane + 64 * q); if (!DRYE || rstd == 12345.678f) *(f32x4*)(row + idx) = v[q] * rstd * *(const f32x4*)(fg + idx); }
    }
}
template <bool DRY>
DI void ph_attention(ArgsP ap, int l, LAS unsigned char* lds) {
    constexpr int OM0 = DRY ? 2 : 0;
    const int G = grd_l(), bx = bid_l(), vcu = (G % 8 == 0) ? (bx % 8) * (G / 8) + bx / 8 : bx;
    bf16_t* P = (bf16_t*)(ap->ws + WS_P); const bf16_t* QM = (const bf16_t*)(ap->ws + WS_QM); const bf16_t* KM = (const bf16_t*)(ap->ws + WS_KM); const bf16_t* VM = (const bf16_t*)(ap->ws + WS_VM);
    float* OD = (float*)(ap->ws + WS_OD); const float* sink = ap->in[I_SINK] + l * 16;
#if !defined(ATT_ONLY) || ATT_ONLY == 1
    if (!DRY || (DRY_SEL & 1))
    for (int u = vcu; u < GB * 8 * 32; u += G) { const int bh = u >> 5, qb = u & 31, bl = bh >> 3, h = bh & 7; const size_t rb = (size_t)bl * RB, q0 = rb + CTX + 256 * qb;
        attn_unit<96, 128, OM0, false>(lds, QM + q0 * 768 + h * 96, 768, KM + rb * 768 + h * 96, 768, VM + rb * 1024 + h * 128, 1024, RB / 64, 0, 0, 0, 0, NEGBIG, 0.f, P + q0 * NP + C_Z + h * 128, NP, OD, 0); }
#endif
#if !defined(ATT_ONLY) || ATT_ONLY == 2
    if (!DRY || (DRY_SEL & 2))
    for (int u = vcu; u < GB * 16 * 32; u += G) { const int bh = u >> 5, qb = u & 31, bl = bh >> 4, hm = bh & 15; const size_t rb = (size_t)bl * RB, q0 = rb + CTX + 256 * qb;
        attn_unit<64, 128, 1, false>(lds, P + q0 * NP + C_DQ + hm * 64, NP, P + rb * NP + C_DK + hm * 64, NP, P + rb * NP + C_DV + (hm >> 1) * 128, NP, RB / 64, 0, 0, 0, 0, NEGBIG, 0.f, nullptr, 0, OD + q0 * 2048 + hm * 128, 2048); }
#endif
#if !defined(ATT_ONLY) || ATT_ONLY == 3
    if (!DRY || (DRY_SEL & 4))
    for (int u = vcu; u < GB * 16 * 32; u += G) { const int bh = u >> 5, qb = u & 31, bl = bh >> 4, h = bh & 15; const size_t rb = (size_t)bl * RB, q0 = rb + CTX + 256 * qb;
        const int lo = (256 * qb - 128 < 0) ? 0 : 256 * qb - 128, hi = (256 * qb + 384 > SEQ) ? SEQ : 256 * qb + 384;
        attn_unit<64, 64, OM0, true>(lds, P + q0 * NP + C_SQ + h * 64, NP, P + rb * NP + C_SK + (h >> 2) * 64, NP, P + rb * NP + C_SV + (h >> 2) * 64, NP, CTX / 64, CTX + lo, (hi - lo) / 64, lo, 256 * qb, sink[h] * LOG2E, 1.0f,
                              P + q0 * NP + C_Z + 2048 + h * 64, NP, OD, 0); }
#endif
#if !defined(ATT_ONLY)
    if (l == 0) {
        for (int u = vcu; u < GB * 40; u += G) { const int bl = u / 40, k = u % 40; const size_t rb = (size_t)bl * RB;
            if (k < 8) { const int h = k;
                attn_unit<96, 128, OM0, false>(lds, QM + rb * 768 + h * 96, 768, KM + rb * 768 + h * 96, 768, VM + rb * 1024 + h * 128, 1024, CTX / 64, 0, 0, 0, 0, NEGBIG, 0.f, P + rb * NP + C_Z + h * 128, NP, OD, 0); }
            else if (k < 24) { const int hm = k - 8;
                attn_unit<64, 128, 1, false>(lds, P + rb * NP + C_DQ + hm * 64, NP, P + rb * NP + C_DK + hm * 64, NP, P + rb * NP + C_DV + (hm >> 1) * 128, NP, CTX / 64, 0, 0, 0, 0, NEGBIG, 0.f, nullptr, 0, OD + rb * 2048 + hm * 128, 2048); }
            else { const int h = k - 24;
                attn_unit<64, 64, OM0, false>(lds, P + rb * NP + C_SQ + h * 64, NP, P + rb * NP + C_SK + (h >> 2) * 64, NP, P + rb * NP + C_SV + (h >> 2) * 64, NP, CTX / 64, 0, 0, 0, 0, sink[h] * LOG2E, 1.0f, P + rb * NP + C_Z + 2048 + h * 64, NP, OD, 0); }
        }
    }
#endif
}

#define RLX_AGENT __ATOMIC_RELAXED, __HIP_MEMORY_SCOPE_AGENT
#define XB_TMO      128
#define XB_XCNT(j)  (256  + 64 * (j))
#define XB_XSUB(j)  (1280 + 64 * (j))
#define XB_XGEN(j)  (2304 + 64 * (j))
#define XB_TOP      3328
#define XB_TOPGEN   3392
#define XCD_BAR_WORDS 3456
#define XB_SPIN_CAP (1u << 18)

__device__ __forceinline__ unsigned xb_ld(unsigned* p)              { return __hip_atomic_load(p, __ATOMIC_RELAXED, __HIP_MEMORY_SCOPE_AGENT); }
__device__ __forceinline__ unsigned xb_add(unsigned* p, unsigned v) { return __hip_atomic_fetch_add(p, v, __ATOMIC_RELAXED, __HIP_MEMORY_SCOPE_AGENT); }
__device__ __forceinline__ unsigned xb_xcc_id() { return (unsigned)__builtin_amdgcn_s_getreg((3 << 11) | 20) & 0xFu; }
#define XB_SPIN(cond, bar) do { unsigned _sp = 0; while (cond) { __builtin_amdgcn_s_sleep(1); \
    if ((++_sp & 255u) == 0u) { if (xb_ld(&(bar)[XB_TMO])) break; if (_sp > XB_SPIN_CAP) { atomicAdd(&(bar)[XB_TMO], 1u); break; } } } } while (0)

struct XcdBarrier {
    unsigned* bar; unsigned x;
    volatile LAS unsigned* st;
};

__device__ __forceinline__ XcdBarrier xcd_barrier_post(unsigned* bar, volatile LAS unsigned* st) {
    XcdBarrier b; b.bar = bar; b.x = xb_xcc_id(); b.st = st;
    if (threadIdx.x == 0) (void)xb_add(&bar[XB_XCNT(b.x)], 1u);
    return b;
}
__device__ __forceinline__ void xcd_barrier_complete(unsigned* bar, unsigned x, unsigned& nloc, unsigned& nx) {
    const unsigned G = gridDim.x * gridDim.y * gridDim.z;
    unsigned sum, cnt, mine, sp = 0u;
    for (;;) {
        sum = 0u; cnt = 0u; mine = 0u;
#pragma unroll
        for (unsigned j = 0; j < 16; ++j) { const unsigned c = xb_ld(&bar[XB_XCNT(j)]); sum += c; cnt += (c > 0u) ? 1u : 0u; mine = (j == x) ? c : mine; }
        if (sum == G) break;
        __builtin_amdgcn_s_sleep(1);
        if ((++sp & 255u) == 0u) { if (xb_ld(&bar[XB_TMO])) break; if (sp > XB_SPIN_CAP) { atomicAdd(&bar[XB_TMO], 1u); break; } }
    }
    nloc = mine > 0u ? mine : 1u; nx = cnt > 0u ? cnt : 1u;
}

__device__ __forceinline__ void xcd_barrier(const XcdBarrier& b) {
    asm volatile("s_waitcnt vmcnt(0)" ::: "memory");
    __syncthreads();
    if (threadIdx.x == 0) {
        unsigned* bar = b.bar;
        __builtin_amdgcn_s_waitcnt(0);
        unsigned nloc = b.st[0], nx = b.st[1];
        if (nloc == 0u) { xcd_barrier_complete(bar, b.x, nloc, nx); b.st[0] = nloc; b.st[1] = nx; }
        const unsigned old = xb_add(&bar[XB_XSUB(b.x)], 1u);
        const unsigned gen = old / nloc;
        if (old + 1u == (gen + 1u) * nloc) {
            __builtin_amdgcn_fence(__ATOMIC_RELEASE, "agent");
            asm volatile("s_waitcnt vmcnt(0)" ::: "memory");
            const unsigned og = xb_add(&bar[XB_TOP], 1u);
            const unsigned tg = og / nx;
            if (og + 1u == (tg + 1u) * nx) xb_add(&bar[XB_TOPGEN], 1u);
            else XB_SPIN(xb_ld(&bar[XB_TOPGEN]) == tg, bar);
            __builtin_amdgcn_fence(__ATOMIC_ACQUIRE, "agent");
            xb_add(&bar[XB_XGEN(b.x)], 1u);
            asm volatile("s_waitcnt vmcnt(0)" ::: "memory");
        } else {
            XB_SPIN(xb_ld(&bar[XB_XGEN(b.x)]) == gen, bar);
            __builtin_amdgcn_fence(__ATOMIC_ACQUIRE, "agent");
            asm volatile("s_waitcnt vmcnt(0)" ::: "memory");
        }
    }
    __syncthreads();
}


__global__ void __launch_bounds__(512, 2) hybrid_fwd(Args a_unused) {
    extern __shared__ __attribute__((aligned(16))) unsigned char lds_raw[];
    LAS unsigned char* lds = (LAS unsigned char*)lds_raw;
    cg::grid_group grid = cg::this_grid();
    { volatile LAS unsigned* xst = (volatile LAS unsigned*)(lds + XB_LDS_OFF);
      if (threadIdx.x < 2) xst[threadIdx.x] = 0u;
      __syncthreads();
      (void)xcd_barrier_post((unsigned*)(args_ptr()->ws), xst); }
#define GSYNC() do { XcdBarrier b_; b_.bar = (unsigned*)(args_ptr()->ws); b_.x = xb_xcc_id(); b_.st = (volatile LAS unsigned*)(lds + XB_LDS_OFF); xcd_barrier(b_); } while (0)
#ifndef NO_PRO
    prologue(args_ptr(), lds);
#ifdef PROBE_PRO
    __syncthreads(); prologue(args_ptr(), lds);
#endif
#endif
    grid.sync();
    mod_finalize(args_ptr());
    GSYNC();
    for (int l = 0; l < 2; ++l) {
        for (int g = 0; g < NGRP; ++g) {
            ph_norm_mod(args_ptr(), lnd(l), lnd(g));
#ifdef PROBE_R1
            GSYNC(); ph_norm_mod(args_ptr(), lnd(l), lnd(g));
#endif
            GSYNC();
#ifndef NO_GEMM
            {
                unsigned char* ws = args_ptr()->ws; const int G = grd_l(), bx = bid_l();
                pg8::Gemm gm{1024, 1024, 1024}; pg8::Order S; S.init(R, NP, G, bx, ws + WS_H, 1024, (bf16_t*)(ws + WS_WIN) + (size_t)l * NP * 1024, 1024, 1 << 20, 0);
                EpiIn E{ws};
                pg8::gemm_phase<EpiIn, pg8::Order, true, true>(lds, gm, S, E);
#ifdef PROBE_G1
                __syncthreads(); pg8::gemm_phase<EpiIn, pg8::Order, true, true>(lds, gm, S, E);
#endif
            }
#endif
            GSYNC();
#ifndef NO_GEMM2
            {
                unsigned char* ws = args_ptr()->ws; const int G = grd_l(), bx = bid_l();
                pg8::Gemm gq{384, NP, 384}; pg8::Order Sq; Sq.init(R, 768, G, bx, (bf16_t*)(ws + WS_P) + C_QC, NP, (bf16_t*)(ws + WS_WUQ) + (size_t)l * 768 * 384, 384, 1 << 20, 0);
                EpiQ Eq{ws};
#ifndef NO_GQ
                pg8::gemm_phase<EpiQ, pg8::Order, true, true>(lds, gq, Sq, Eq);
#ifdef PROBE_G2
                __syncthreads(); pg8::gemm_phase<EpiQ, pg8::Order, true, true>(lds, gq, Sq, Eq);
#endif
#endif
            }
            {
                unsigned char* ws = args_ptr()->ws; const int G = grd_l(), bx = bid_l();
                pg8::Gemm gk{256, NP, 256}; pg8::Order Sk; Sk.init(R, 1536, G, bx, (bf16_t*)(ws + WS_P) + C_KVC, NP, (bf16_t*)(ws + WS_WUKV) + (size_t)l * 1536 * 256, 256, 1 << 20, 0);
                EpiKV Ek{ws};
#ifndef NO_GK
                pg8::gemm_phase<EpiKV, pg8::Order, true, true>(lds, gk, Sk, Ek);
#ifdef PROBE_G2
                __syncthreads(); pg8::gemm_phase<EpiKV, pg8::Order, true, true>(lds, gk, Sk, Ek);
#endif
#endif
            }
#endif
            GSYNC();
#ifndef NO_ATT
#ifdef PROBE_ATT
            ph_attention<true>(args_ptr(), lnd(l), lds);
            GSYNC();
#endif
            ph_attention<false>(args_ptr(), lnd(l), lds);
#endif
            GSYNC();
#ifdef PROBE_R2
            ph_diff_post<true>(args_ptr(), lnd(l)); GSYNC();
#endif
            ph_diff_post<false>(args_ptr(), lnd(l));
            GSYNC();
#ifndef NO_BR
            {
                unsigned char* ws = args_ptr()->ws; const int G = grd_l(), bx = bid_l();
                pg8::Gemm gb{1024, NP, 1024}; pg8::Order S; S.init(R, 3072, G, bx, (bf16_t*)(ws + WS_P) + C_Z, NP, (bf16_t*)(ws + WS_WB) + (size_t)l * 3 * 1024 * 1024, 1024, 4, 1024 * 2, l != 0);
#ifdef PROBE_BR
                { EpiBrT<true> Ed{ws}; pg8::gemm_phase<EpiBrT<true>, pg8::Order, true, true>(lds, gb, S, Ed); __syncthreads(); }
#endif
                EpiBrT<false> E{ws};
                pg8::gemm_phase<EpiBrT<false>, pg8::Order, true, true>(lds, gb, S, E);
            }
#endif
            GSYNC();
#ifndef NO_OUT
            {
                ArgsP ap = args_ptr(); unsigned char* ws = ap->ws; const int G = grd_l(), bx = bid_l();
                pg8::Gemm go{3072, NP, 3072}; pg8::Order S; S.init(R, 1024, G, bx, (bf16_t*)(ws + WS_P) + C_GM, NP, (bf16_t*)(ws + WS_WO3) + (size_t)l * 1024 * 3072, 3072, 1 << 20, 0, l != 0);
#ifdef PROBE_OUT
                { EpiOutT<true> Ed{l, g, (l == 0) ? ap->in[I_X] : (const float*)ap->out, ap->out, ap->in[I_CTX], ws}; pg8::gemm_phase<EpiOutT<true>, pg8::Order, true, true>(lds, go, S, Ed); __syncthreads(); }
#endif
                EpiOutT<false> E{l, g, (l == 0) ? ap->in[I_X] : (const float*)ap->out, ap->out, ap->in[I_CTX], ws};
                pg8::gemm_phase<EpiOutT<false>, pg8::Order, true, true>(lds, go, S, E);
            }
#endif
        }
        GSYNC();
    }
#ifdef PROBE_R2
    ph_final_norm<true>(args_ptr()); GSYNC();
#endif
    ph_final_norm<false>(args_ptr());
}

extern "C" void kernel_launch(void* const* d_in, const int* in_sizes, int n_in, void* d_out, int out_size, void* d_ws, size_t ws_size, hipStream_t stream) {
    static int grid = 0;
    if (grid == 0) {
        if (n_in != 21 || ws_size < WS_END) { fprintf(stderr, "kernel_launch: expected 21 inputs and >= %zu bytes of workspace (got %d, %zu)\n", (size_t)WS_END, n_in, ws_size); grid = -1; return; }
        int dev = 0, cus = 0, per_cu = 0;
        (void)hipGetDevice(&dev); (void)hipDeviceGetAttribute(&cus, hipDeviceAttributeMultiprocessorCount, dev);
        if (hipFuncSetAttribute((const void*)hybrid_fwd, hipFuncAttributeMaxDynamicSharedMemorySize, LDS_BYTES) != hipSuccess) fprintf(stderr, "kernel_launch: hipFuncSetAttribute failed\n");
        if (hipOccupancyMaxActiveBlocksPerMultiprocessor(&per_cu, (const void*)hybrid_fwd, 512, LDS_BYTES) != hipSuccess || per_cu < 1) { per_cu = 1; (void)hipGetLastError(); }
        if (cus <= 0) cus = 256;
        grid = cus * per_cu;
    }
    if (grid < 0) return;
    Args a{};
    for (int i = 0; i < 21; ++i) a.in[i] = (const float*)d_in[i];
    a.out = (float*)d_out; a.ws = (unsigned char*)d_ws;
    (void)hipMemsetAsync(d_ws, 0, 16384, stream);
    void* args[] = {&a};
    hipError_t e = hipLaunchCooperativeKernel((const void*)hybrid_fwd, dim3(grid), dim3(512), args, LDS_BYTES, stream);
    if (e != hipSuccess) fprintf(stderr, "kernel_launch: cooperative launch failed: %s (grid %d)\n", hipGetErrorString(e), grid);
}
```

```cpp
#include <hip/hip_runtime.h>
#include <hip/hip_cooperative_groups.h>
#include <cstdio>
#include <cstdint>
namespace cg = cooperative_groups;

#define DI __device__ __forceinline__
#define LAS __attribute__((address_space(3)))
__device__ __forceinline__ int tid_l() { int t = threadIdx.x; asm volatile("" : "+v"(t)); return t; }
__device__ __forceinline__ int bid_l() { int b = blockIdx.x; asm volatile("" : "+s"(b)); return b; }
__device__ __forceinline__ int lnd(int x) { asm volatile("" : "+s"(x)); return x; }
__device__ __forceinline__ int grd_l() { int g = gridDim.x; asm volatile("" : "+s"(g)); return g; }
typedef unsigned short bf16_t;
typedef short bf16x8 __attribute__((ext_vector_type(8)));
typedef short s16x4 __attribute__((ext_vector_type(4)));
typedef float f32x4 __attribute__((ext_vector_type(4)));
typedef float f32x16 __attribute__((ext_vector_type(16)));
typedef unsigned u32x4 __attribute__((ext_vector_type(4)));
typedef unsigned u32x2 __attribute__((ext_vector_type(2)));

constexpr int DM = 1024, NBATCH = 8, SEQ = 8192, CTX = 256, RB = CTX + SEQ;
constexpr int GB = 2, NGRP = NBATCH / GB, R = GB * RB;
constexpr int NP = 11520;
constexpr int C_QC = 0, C_KVC = 384, C_KR = 640, C_DQ = 768, C_DK = 1792, C_DV = 2816, C_SQ = 3840, C_SK = 4864, C_SV = 5120, C_Z = 5376, C_GM = 8448;
constexpr int D_IN = 11424;
constexpr float EPS = 1e-6f, LOG2E = 1.4426950408889634f;
constexpr float QS64 = 0.125f * LOG2E, QS96 = 0.10206207261596575f * LOG2E;
constexpr float NEGBIG = -1e30f, THR = 8.0f;

constexpr size_t al256(size_t x) { return (x + 255) & ~(size_t)255; }
constexpr size_t WS_WIN = 1u << 20;
constexpr size_t WS_WUQ = al256(WS_WIN + (size_t)2 * NP * 1024 * 2);
constexpr size_t WS_WUKV = al256(WS_WUQ + (size_t)2 * 768 * 384 * 2);
constexpr size_t WS_WB = al256(WS_WUKV + (size_t)2 * 1536 * 256 * 2);
constexpr size_t WS_WO3 = al256(WS_WB + (size_t)2 * 3 * 1024 * 1024 * 2);
constexpr size_t WS_COSH = al256(WS_WO3 + (size_t)2 * 1024 * 3072 * 2);
constexpr size_t WS_SINH = al256(WS_COSH + (size_t)SEQ * 32 * 4);
constexpr size_t WS_COSM = al256(WS_SINH + (size_t)SEQ * 32 * 4);
constexpr size_t WS_SINM = al256(WS_COSM + (size_t)SEQ * 16 * 4);
constexpr size_t WS_MODP = al256(WS_SINM + (size_t)SEQ * 16 * 4);
constexpr size_t WS_MOD = al256(WS_MODP + (size_t)16 * 2 * 9 * 3072 * 4);
constexpr size_t WS_CTX = al256(WS_MOD + (size_t)2 * 9 * 3072 * 4);
constexpr size_t WS_H = al256(WS_CTX + (size_t)NBATCH * CTX * DM * 4);
constexpr size_t WS_P = al256(WS_H + (size_t)R * DM * 2);
constexpr size_t WS_AQ = al256(WS_P + (size_t)R * NP * 2);
constexpr size_t WS_AKV = al256(WS_AQ + (size_t)R * 384 * 2);
constexpr size_t WS_QM = al256(WS_AKV + (size_t)R * 256 * 2);
constexpr size_t WS_KM = al256(WS_QM + (size_t)R * 768 * 2);
constexpr size_t WS_VM = al256(WS_KM + (size_t)R * 768 * 2);
constexpr size_t WS_OD = al256(WS_VM + (size_t)R * 1024 * 2);
constexpr size_t WS_END = al256(WS_OD + (size_t)R * 2048 * 4);
constexpr size_t WS_PART = WS_AQ;
static_assert(WS_END <= ((size_t)1 << 30), "workspace map exceeds 1 GiB");

constexpr int LDS_BYTES = 155648, XB_LDS_OFF = 155136;

DI unsigned pk2(float lo, float hi) { typedef float f2_t __attribute__((ext_vector_type(2))); typedef __bf16 b2_t __attribute__((ext_vector_type(2)));
    f2_t v = {lo, hi}; b2_t b = __builtin_convertvector(v, b2_t); return __builtin_bit_cast(unsigned, b); }
DI u32x4 pack8(f32x4 a, f32x4 b) { u32x4 w; w.x = pk2(a[0], a[1]); w.y = pk2(a[2], a[3]); w.z = pk2(b[0], b[1]); w.w = pk2(b[2], b[3]); return w; }
DI float bflo(unsigned w) { return __uint_as_float(w << 16); }
DI float bfhi(unsigned w) { return __uint_as_float(w & 0xffff0000u); }
DI float wave_sum(float v) {
#pragma unroll
    for (int o = 1; o < 64; o <<= 1) v += __shfl_xor(v, o);
    return v; }
DI float opq(float a) { asm("" : "+v"(a)); return a; }
DI float silu_f(float z) { return z * __builtin_amdgcn_rcpf(1.0f + __expf(-z)); }
DI float sigm_f(float z) { return __builtin_amdgcn_rcpf(1.0f + __expf(-z)); }
DI void rope8(f32x4& v0, f32x4& v1, const f32x4 cs, const f32x4 sn) {
    float a, b;
    a = v0[0]; b = v0[1]; v0[0] = a * cs[0] - b * sn[0]; v0[1] = b * cs[0] + a * sn[0];
    a = v0[2]; b = v0[3]; v0[2] = a * cs[1] - b * sn[1]; v0[3] = b * cs[1] + a * sn[1];
    a = v1[0]; b = v1[1]; v1[0] = a * cs[2] - b * sn[2]; v1[1] = b * cs[2] + a * sn[2];
    a = v1[2]; b = v1[3]; v1[2] = a * cs[3] - b * sn[3]; v1[3] = b * cs[3] + a * sn[3];
}
namespace pg8 {
#define PG8_LAS __attribute__((address_space(3)))
typedef unsigned short bf16_t;
typedef short bf16x8 __attribute__((ext_vector_type(8)));
typedef float f32x4 __attribute__((ext_vector_type(4)));
typedef unsigned u32x4 __attribute__((ext_vector_type(4)));
constexpr int BM = 256, BK = 64, HALF = 128, HTB = HALF * BK * 2  , STAGE_BYTES = 8 * HTB, NXCD = 8, WGM = 8;

__host__ __device__ __forceinline__ int lds_byte(int r, int c) { const int st = (r >> 4) * 2 + (c >> 5), rr = r & 15, cc = c & 31, ob = rr * 64 + cc * 2; return st * 1024 + (ob ^ (((ob >> 9) & 1) << 5)); }
__host__ __device__ __forceinline__ void stage_rc(int b, int& R, int& C) { const int st = b / 1024, sb = b % 1024, swz = sb ^ (((sb >> 9) & 1) << 5); R = (st >> 1) * 16 + swz / 64; C = (st & 1) * 32 + (swz % 64) / 2; }
__host__ __device__ __forceinline__ int perm32(int rho) { const int n = rho >> 4, i = rho & 15; return 8 * (i >> 2) + 4 * n + (i & 3); }

struct Unit { int pm, pn; };
struct Gemm { int K, lda, ldb; };
struct Order {
    int nM, nN, nwg, G, c; const char* A; const char* B; unsigned tA, tB; int pnblk; unsigned ablk; int skipctx;
    __device__ __forceinline__ void init(int M, int N, int G_, int c_, const void* A_, int lda, const void* B_, int ldb, int pnblk_, unsigned ablk_, int skipctx_ = 0) {
        skipctx = skipctx_; nM = M / BM; if (skipctx) nM -= nM / 33;
        nN = N / BM; nwg = nM * nN; G = G_; c = c_; A = (const char*)A_; B = (const char*)B_; tA = (unsigned)(BM * lda * 2); tB = (unsigned)(BM * ldb * 2); pnblk = pnblk_; ablk = ablk_; }
    __device__ __forceinline__ bool next(int i, Unit& u) const {
        const long L = (long)i * G + c; if (L >= nwg) return false;
        int wgid = (int)L; { const int q = nwg / NXCD, r = nwg % NXCD, xcd = wgid % NXCD, off = wgid / NXCD; wgid = (xcd < r ? xcd * (q + 1) : r * (q + 1) + (xcd - r) * q) + off; }
        const int nig = WGM * nN, gid = wgid / nig, fm = gid * WGM, gsz = (nM - fm) < WGM ? (nM - fm) : WGM;
        u.pm = fm + ((wgid % nig) % gsz); u.pn = (wgid % nig) / gsz; if (skipctx) u.pm += u.pm / 32 + 1; return true;
    }
    __device__ __forceinline__ const char* a_base(const Unit& u) const { return A + (size_t)u.pm * tA + (size_t)(u.pn / pnblk) * ablk; }
    __device__ __forceinline__ const char* b_base(const Unit& u) const { return B + (size_t)u.pn * tB; }
};

template <class Epi, class Sched, bool ALIGN_EPI = false, bool SP2 = false>
__device__ __forceinline__ void gemm_phase(PG8_LAS unsigned char* lds, const Gemm g, const Sched& S, const Epi& E) {
    const int tid = tid_l(), wid = __builtin_amdgcn_readfirstlane(tid >> 6), lane = tid & 63, wr = wid >> 2, wc = wid & 3, fr = lane & 15, fq = lane >> 4;
    const int K = g.K, nt = K / BK;
    unsigned voffA[2], voffB[2];
#pragma unroll
    for (int i = 0; i < 2; ++i) { int R, C; stage_rc(tid * 16 + i * 8192, R, C); const int Rb = Epi::PERM ? ((R & ~31) + perm32(R & 31)) : R;
        voffA[i] = (unsigned)(R * g.lda + C) * 2u; voffB[i] = (unsigned)(Rb * g.ldb + C) * 2u; }
    const size_t kstep = (size_t)(BK * 2);
    const size_t hstepA = (size_t)HALF * g.lda * 2, hstepB = (size_t)HALF * g.ldb * 2;
    const unsigned ldsw = (unsigned)wid * 1024u;
    const int aoff = lds_byte(wr * 64 + fr, fq * 8), boff = lds_byte(wc * 32 + fr, fq * 8);
#define PG8_SA(b, h) (((b) * 2 + (h)) * HTB)
#define PG8_SB(b, h) ((4 + (b) * 2 + (h)) * HTB)
#define PG8_STAGE(bufoff, gbase, voff) do { _Pragma("unroll") for (int _i = 0; _i < 2; ++_i) \
        __builtin_amdgcn_global_load_lds((const unsigned*)((const char*)(gbase) + (voff)[_i]), (PG8_LAS unsigned*)(lds + (bufoff) + ldsw + _i * 8192), 16, 0, 0); } while (0)
#define PG8_LDA(dst, b, h) do { _Pragma("unroll") for (int m = 0; m < 4; ++m) _Pragma("unroll") for (int k = 0; k < 2; ++k) dst[m][k] = *(const PG8_LAS bf16x8*)(lds + PG8_SA(b, h) + aoff + m * 2048 + k * 1024); } while (0)
#define PG8_LDB(dst, b, h) do { _Pragma("unroll") for (int n = 0; n < 2; ++n) _Pragma("unroll") for (int k = 0; k < 2; ++k) dst[n][k] = *(const PG8_LAS bf16x8*)(lds + PG8_SB(b, h) + boff + n * 2048 + k * 1024); } while (0)
#define PG8_MMA(ai, bj, At, Bt) do { __builtin_amdgcn_s_setprio(1); _Pragma("unroll") for (int m = 0; m < 4; ++m) _Pragma("unroll") for (int n = 0; n < 2; ++n) _Pragma("unroll") for (int k = 0; k < 2; ++k) \
        acc[ai][bj][m][n] = __builtin_amdgcn_mfma_f32_16x16x32_bf16(Bt[n][k], At[m][k], acc[ai][bj][m][n], 0, 0, 0); __builtin_amdgcn_s_setprio(0); } while (0)
#define PG8_WAIT_V(n) asm volatile("s_waitcnt vmcnt(" #n ")" ::: "memory")
#define PG8_WAIT_L(n) asm volatile("s_waitcnt lgkmcnt(" #n ")" ::: "memory")
#define PG8_BAR __builtin_amdgcn_s_barrier()
#define PG8_SCHED __builtin_amdgcn_sched_barrier(0)
    Unit cur, nxt; int ui = 0;
    if (!S.next(0, cur)) return;
    f32x4 acc[2][2][4][2];
#pragma unroll
    for (int a = 0; a < 2; ++a)
#pragma unroll
        for (int b = 0; b < 2; ++b)
#pragma unroll
            for (int m = 0; m < 4; ++m)
#pragma unroll
                for (int n = 0; n < 2; ++n) acc[a][b][m][n] = (f32x4){0.f, 0.f, 0.f, 0.f};
    bf16x8 At[4][2], B0[2][2], B1[2][2];
    const char* cA = S.a_base(cur); const char* cB = S.b_base(cur);

    if constexpr (SP2) {
        PG8_STAGE(PG8_SB(0, 0), cB, voffB); PG8_STAGE(PG8_SB(0, 1), cB + hstepB, voffB); PG8_STAGE(PG8_SA(0, 0), cA, voffA); PG8_STAGE(PG8_SA(0, 1), cA + hstepA, voffA);
        if (wr == 1) PG8_BAR;
        PG8_WAIT_V(2); PG8_BAR;
        PG8_STAGE(PG8_SB(1, 0), cB + kstep, voffB); PG8_STAGE(PG8_SA(1, 0), cA + kstep, voffA); PG8_STAGE(PG8_SB(1, 1), cB + hstepB + kstep, voffB);
        PG8_WAIT_V(6); PG8_BAR;
    } else {
        PG8_STAGE(PG8_SB(0, 0), cB, voffB); PG8_STAGE(PG8_SA(0, 0), cA, voffA); PG8_STAGE(PG8_SB(0, 1), cB + hstepB, voffB); PG8_STAGE(PG8_SA(0, 1), cA + hstepA, voffA);
        if (wr == 1) PG8_BAR;
        PG8_WAIT_V(4); PG8_BAR;
        PG8_STAGE(PG8_SB(1, 0), cB + kstep, voffB); PG8_STAGE(PG8_SA(1, 0), cA + kstep, voffA); PG8_STAGE(PG8_SB(1, 1), cB + hstepB + kstep, voffB);
        PG8_WAIT_V(6); PG8_BAR;
    }
    for (;;) {
        const bool has_next = S.next(ui + 1, nxt);
        const char* nA = has_next ? S.a_base(nxt) : cA; const char* nB = has_next ? S.b_base(nxt) : cB;
#pragma nounroll
        for (int t = 0; t < nt; t += 2) {
            const bool last = (t == nt - 2);
            const char* a1 = cA + (size_t)(t + 1) * kstep;
            const char* a2 = last ? nA : cA + (size_t)(t + 2) * kstep; const char* b2 = last ? nB : cB + (size_t)(t + 2) * kstep;
            const char* a3 = a2 + kstep; const char* b3 = b2 + kstep;

            if constexpr (SP2) {
            PG8_LDB(B0, 0, 0); PG8_LDB(B1, 0, 1); PG8_SCHED; PG8_LDA(At, 0, 0); PG8_STAGE(PG8_SA(1, 1), a1 + hstepA, voffA);
            PG8_WAIT_V(8); PG8_WAIT_L(0); PG8_BAR; PG8_MMA(0, 0, At, B0); PG8_MMA(0, 1, At, B1); PG8_BAR; PG8_SCHED;
            PG8_LDA(At, 0, 1); PG8_STAGE(PG8_SB(0, 0), b2, voffB); PG8_STAGE(PG8_SB(0, 1), b2 + hstepB, voffB); PG8_STAGE(PG8_SA(0, 0), a2, voffA);
            PG8_WAIT_V(8); PG8_WAIT_L(0); PG8_BAR; PG8_MMA(1, 0, At, B0); PG8_MMA(1, 1, At, B1); PG8_BAR; PG8_SCHED;
            PG8_LDB(B0, 1, 0); PG8_LDB(B1, 1, 1); PG8_SCHED; PG8_LDA(At, 1, 0); PG8_STAGE(PG8_SA(0, 1), a2 + hstepA, voffA);
            PG8_WAIT_V(8); PG8_WAIT_L(0); PG8_BAR; PG8_MMA(0, 0, At, B0); PG8_MMA(0, 1, At, B1); PG8_BAR; PG8_SCHED;
            PG8_LDA(At, 1, 1); PG8_STAGE(PG8_SB(1, 0), b3, voffB); PG8_STAGE(PG8_SB(1, 1), b3 + hstepB, voffB); PG8_STAGE(PG8_SA(1, 0), a3, voffA);
            PG8_WAIT_V(8); PG8_WAIT_L(0); PG8_BAR; PG8_MMA(1, 0, At, B0); PG8_MMA(1, 1, At, B1); PG8_BAR; PG8_SCHED;
            } else {
            PG8_LDB(B0, 0, 0); PG8_SCHED; PG8_LDA(At, 0, 0); PG8_STAGE(PG8_SA(1, 1), a1 + hstepA, voffA);
            PG8_WAIT_L(8); PG8_BAR; PG8_WAIT_L(0); PG8_MMA(0, 0, At, B0); PG8_BAR; PG8_SCHED;
            PG8_LDB(B1, 0, 1); PG8_STAGE(PG8_SB(0, 0), b2, voffB);
            PG8_BAR; PG8_WAIT_L(0); PG8_MMA(0, 1, At, B1); PG8_BAR;
            PG8_LDA(At, 0, 1); PG8_STAGE(PG8_SA(0, 0), a2, voffA);
            PG8_BAR; PG8_WAIT_L(0); PG8_MMA(1, 0, At, B0); PG8_BAR; PG8_SCHED;
            PG8_STAGE(PG8_SB(0, 1), b2 + hstepB, voffB);
            PG8_WAIT_V(6); PG8_BAR; PG8_MMA(1, 1, At, B1); PG8_BAR;
            PG8_LDB(B0, 1, 0); PG8_SCHED; PG8_LDA(At, 1, 0); PG8_STAGE(PG8_SA(0, 1), a2 + hstepA, voffA);
            PG8_WAIT_L(8); PG8_BAR; PG8_WAIT_L(0); PG8_MMA(0, 0, At, B0); PG8_BAR; PG8_SCHED;
            PG8_LDB(B1, 1, 1); PG8_STAGE(PG8_SB(1, 0), b3, voffB);
            PG8_BAR; PG8_WAIT_L(0); PG8_MMA(0, 1, At, B1); PG8_BAR;
            PG8_LDA(At, 1, 1); PG8_STAGE(PG8_SA(1, 0), a3, voffA);
            PG8_BAR; PG8_WAIT_L(0); PG8_MMA(1, 0, At, B0); PG8_BAR; PG8_SCHED;
            PG8_STAGE(PG8_SB(1, 1), b3 + hstepB, voffB);
            PG8_WAIT_V(6); PG8_BAR; PG8_MMA(1, 1, At, B1); PG8_BAR;
            }
        }
        if constexpr (ALIGN_EPI) { if (wr == 0) PG8_BAR; }
        if constexpr (!Epi::AFTER_DRAIN) { E(acc, cur, wr, wc, fr, fq); }
        if (!has_next) break;
#pragma unroll
        for (int a = 0; a < 2; ++a)
#pragma unroll
            for (int b = 0; b < 2; ++b)
#pragma unroll
                for (int m = 0; m < 4; ++m)
#pragma unroll
                    for (int n = 0; n < 2; ++n) acc[a][b][m][n] = (f32x4){0.f, 0.f, 0.f, 0.f};
        cur = nxt; cA = nA; cB = nB; ++ui;
        if constexpr (ALIGN_EPI) { if (wr == 1) PG8_BAR; }
    }
    PG8_WAIT_V(0);
    if constexpr (!ALIGN_EPI) { if (wr == 0) PG8_BAR; }
    PG8_BAR;
    if constexpr (Epi::AFTER_DRAIN) { E.fused(acc, cur, wr, wc, fr, fq, lds, wid, lane); }
#undef PG8_SA
#undef PG8_SB
#undef PG8_STAGE
#undef PG8_LDA
#undef PG8_LDB
#undef PG8_MMA
#undef PG8_WAIT_V
#undef PG8_WAIT_L
#undef PG8_BAR
#undef PG8_SCHED
}
}
struct EpiIn {
    static constexpr bool PERM = true, AFTER_DRAIN = false;
    unsigned char* ws;
    DI void operator()(const f32x4 (&acc)[2][2][4][2], const pg8::Unit& u, int wr, int wc, int fr, int fq) const {
        bf16_t* P = (bf16_t*)(ws + WS_P); const float* cosH = (const float*)(ws + WS_COSH); const float* sinH = (const float*)(ws + WS_SINH); const float* cosM = (const float*)(ws + WS_COSM); const float* sinM = (const float*)(ws + WS_SINM);
        const int pn = u.pn; const bool ctxt = (u.pm % 33) == 0;
        int mode = 0; float sc = 1.f;
        if ((pn >= 3 && pn <= 10) || (pn >= 15 && pn <= 19)) mode = 1;
        if (pn == 2) mode = 2;
        if ((pn >= 3 && pn <= 6) || (pn >= 15 && pn <= 18)) sc = QS64;
        if (ctxt) mode = 0;
        const int rowt = u.pm * 256 + wr * 64 + fr, colb = pn * 256 + wc * 32 + 8 * fq;
#pragma unroll
        for (int ai = 0; ai < 2; ++ai)
#pragma unroll
            for (int m = 0; m < 4; ++m) {
                const int row = rowt + ai * 128 + m * 16; const int pos = (row % RB) - CTX;
                bf16_t* rowp = P + (size_t)row * NP;
#pragma unroll
                for (int bj = 0; bj < 2; ++bj) {
                    const int col0 = colb + bj * 128;
                    f32x4 v0 = acc[ai][bj][m][0], v1 = acc[ai][bj][m][1];
                    if (pn <= 2) {
                        float s8 = (v0[0] * v0[0] + v0[1] * v0[1]) + (v0[2] * v0[2] + v0[3] * v0[3]) + (v1[0] * v1[0] + v1[1] * v1[1]) + (v1[2] * v1[2] + v1[3] * v1[3]);
                        s8 += __shfl_xor(s8, 16); s8 += __shfl_xor(s8, 32);
                        const int slice = pn * 8 + bj * 4 + wc;
                        if (fq == 0 && slice < 20) ((float*)(ws + WS_PART))[(size_t)row * 20 + slice] = s8;
                    }
                    if (mode == 1) { const int p0 = (col0 & 63) >> 1; const f32x4 cs = *(const f32x4*)(cosH + (size_t)pos * 32 + p0), sn = *(const f32x4*)(sinH + (size_t)pos * 32 + p0); rope8(v0, v1, cs, sn); }
                    else if (mode == 2 && col0 >= C_KR && col0 < C_KR + 32) { const int p0 = (col0 - C_KR) >> 1; const f32x4 cs = *(const f32x4*)(cosM + (size_t)pos * 16 + p0), sn = *(const f32x4*)(sinM + (size_t)pos * 16 + p0); rope8(v0, v1, cs, sn); }
                    v0 = v0 * sc; v1 = v1 * sc;
                    const u32x4 w8 = pack8(v0, v1);
                    *(u32x4*)(rowp + col0) = w8;
                    if (pn == 2 && col0 >= C_KR && col0 < C_KR + 32) {
                        bf16_t* km = (bf16_t*)(ws + WS_KM) + (size_t)row * 768 + 64 + (col0 - C_KR);
#pragma unroll
                        for (int h = 0; h < 8; ++h) *(u32x4*)(km + h * 96) = w8;
                    }
                }
            }
    }
};
struct EpiQ {
    static constexpr bool PERM = true, AFTER_DRAIN = false;
    unsigned char* ws;
    DI void operator()(const f32x4 (&acc)[2][2][4][2], const pg8::Unit& u, int wr, int wc, int fr, int fq) const {
        bf16_t* QM = (bf16_t*)(ws + WS_QM); const float* cosM = (const float*)(ws + WS_COSM); const float* sinM = (const float*)(ws + WS_SINM);
        const bool ctxt = (u.pm % 33) == 0;
        const int rowt = u.pm * 256 + wr * 64 + fr, colb = u.pn * 256 + wc * 32 + 8 * fq;
#pragma unroll
        for (int ai = 0; ai < 2; ++ai)
#pragma unroll
            for (int m = 0; m < 4; ++m) {
                const int row = rowt + ai * 128 + m * 16; const int pos = (row % RB) - CTX;
                const float* pr = (const float*)(ws + WS_PART) + (size_t)row * 20;
                const f32x4 q0 = *(const f32x4*)pr, q1 = *(const f32x4*)(pr + 4), q2 = *(const f32x4*)(pr + 8);
                const float rq = QS96 / sqrtf((((q0[0] + q0[1]) + (q0[2] + q0[3])) + ((q1[0] + q1[1]) + (q1[2] + q1[3])) + ((q2[0] + q2[1]) + (q2[2] + q2[3]))) * (1.0f / 384.0f) + EPS);
#pragma unroll
                for (int bj = 0; bj < 2; ++bj) {
                    const int col0 = colb + bj * 128, within = col0 % 96;
                    f32x4 v0 = acc[ai][bj][m][0], v1 = acc[ai][bj][m][1];
                    if (!ctxt && within >= 64) { const int p0 = (within - 64) >> 1; const f32x4 cs = *(const f32x4*)(cosM + (size_t)pos * 16 + p0), sn = *(const f32x4*)(sinM + (size_t)pos * 16 + p0); rope8(v0, v1, cs, sn); }
                    v0 = v0 * rq; v1 = v1 * rq;
                    *(u32x4*)(QM + (size_t)row * 768 + col0) = pack8(v0, v1);
                }
                asm volatile("" ::: "memory");
            }
    }
};
struct EpiKV {
    static constexpr bool PERM = true, AFTER_DRAIN = false;
    unsigned char* ws;
    DI void operator()(const f32x4 (&acc)[2][2][4][2], const pg8::Unit& u, int wr, int wc, int fr, int fq) const {
        bf16_t* KM = (bf16_t*)(ws + WS_KM); bf16_t* VM = (bf16_t*)(ws + WS_VM);
        const int rowt = u.pm * 256 + wr * 64 + fr, colb = u.pn * 256 + wc * 32 + 8 * fq;
#pragma unroll
        for (int ai = 0; ai < 2; ++ai)
#pragma unroll
            for (int m = 0; m < 4; ++m) {
                const int row = rowt + ai * 128 + m * 16;
                const float* pr = (const float*)(ws + WS_PART) + (size_t)row * 20 + 12;
                const f32x4 k0 = *(const f32x4*)pr, k1 = *(const f32x4*)(pr + 4);
                const float rkv = 1.0f / sqrtf((((k0[0] + k0[1]) + (k0[2] + k0[3])) + ((k1[0] + k1[1]) + (k1[2] + k1[3]))) * (1.0f / 256.0f) + EPS);
#pragma unroll
                for (int bj = 0; bj < 2; ++bj) {
                    const int col0 = colb + bj * 128;
                    bf16_t* dst = (col0 < 512) ? KM + (size_t)row * 768 + (col0 >> 6) * 96 + (col0 & 63) : VM + (size_t)row * 1024 + (col0 - 512);
                    *(u32x4*)dst = pack8(acc[ai][bj][m][0] * rkv, acc[ai][bj][m][1] * rkv);
                }
                asm volatile("" ::: "memory");
            }
    }
};
template <bool DRYE> struct EpiBrT {
    static constexpr bool PERM = true, AFTER_DRAIN = false;
    unsigned char* ws;
    DI void operator()(const f32x4 (&acc)[2][2][4][2], const pg8::Unit& u, int wr, int wc, int fr, int fq) const {
        bf16_t* P = (bf16_t*)(ws + WS_P);
        unsigned chk = 0u;
        const int rowt = u.pm * 256 + wr * 64 + fr, colb = u.pn * 256 + wc * 32 + 8 * fq;
#pragma unroll
        for (int ai = 0; ai < 2; ++ai)
#pragma unroll
            for (int m = 0; m < 4; ++m) {
                const int row = rowt + ai * 128 + m * 16;
#pragma unroll
                for (int bj = 0; bj < 2; ++bj) {
                    bf16_t* p = P + (size_t)row * NP + C_GM + colb + bj * 128;
                    const u32x4 g = *(const u32x4*)p;
                    f32x4 v0 = acc[ai][bj][m][0], v1 = acc[ai][bj][m][1];
                    v0[0] *= sigm_f(bflo(g.x)); v0[1] *= sigm_f(bfhi(g.x)); v0[2] *= sigm_f(bflo(g.y)); v0[3] *= sigm_f(bfhi(g.y));
                    v1[0] *= sigm_f(bflo(g.z)); v1[1] *= sigm_f(bfhi(g.z)); v1[2] *= sigm_f(bflo(g.w)); v1[3] *= sigm_f(bfhi(g.w));
                    { const u32x4 w_ = pack8(v0, v1); if (!DRYE) *(u32x4*)p = w_; else chk ^= w_.x ^ w_.y ^ w_.z ^ w_.w; }
                }
            }
        if (DRYE && chk == 0x12345678u) *(unsigned*)P = chk;
    }
};
template <bool DRYE> struct EpiOutT {
    static constexpr bool PERM = true, AFTER_DRAIN = false;
    int l, g; const float* xsrc; float* xdst; const float* ctxsrc; unsigned char* ws;
    DI void operator()(const f32x4 (&acc)[2][2][4][2], const pg8::Unit& u, int wr, int wc, int fr, int fq) const {
        float* ctxdst = (float*)(ws + WS_CTX); const float* mod = (const float*)(ws + WS_MOD) + (size_t)l * 9 * 3072;
        const int pmb = u.pm % 33, b = g * GB + u.pm / 33; const bool ctxt = pmb == 0;
        if (ctxt && l != 0) return;
        const float* gate = mod + (size_t)(ctxt ? 8 : b) * 3072 + 2048;
        const int colb = u.pn * 256 + wc * 32 + 8 * fq;
#pragma unroll
        for (int ai = 0; ai < 2; ++ai)
#pragma unroll
            for (int m = 0; m < 4; ++m) {
                const int j = pmb * 256 + ai * 128 + wr * 64 + m * 16 + fr;
                const size_t idx = ctxt ? ((size_t)b * CTX + j) * DM : ((size_t)b * SEQ + (j - CTX)) * DM;
                const float* s = (ctxt ? ctxsrc : xsrc) + idx; float* d = (ctxt ? ctxdst : xdst) + idx;
#pragma unroll
                for (int bj = 0; bj < 2; ++bj) {
                    const int col0 = colb + bj * 128;
                    const f32x4 g0 = *(const f32x4*)(gate + col0), g1 = *(const f32x4*)(gate + col0 + 4);
                    const f32x4 x0 = *(const f32x4*)(s + col0), x1 = *(const f32x4*)(s + col0 + 4);
                    if (!DRYE || x0[0] == 12345.678f) { *(f32x4*)(d + col0) = x0 + g0 * acc[ai][bj][m][0];
                    *(f32x4*)(d + col0 + 4) = x1 + g1 * acc[ai][bj][m][1]; }
                }
            }
    }
};

#define MFMA32(a, b, c) __builtin_amdgcn_mfma_f32_32x32x16_bf16((a), (b), (c), 0, 0, 0)
DI s16x4 tr16(const LAS unsigned char* p) { typedef short v4i16_t __attribute__((ext_vector_type(4))); return __builtin_bit_cast(s16x4, __builtin_amdgcn_ds_read_tr16_b64_v4i16((LAS v4i16_t*)p)); }
constexpr int AT_KOFF = 0, AT_KBUFMAX = 13312, AT_VOFF = 3 * AT_KBUFMAX, AT_VBUFMAX = 20480, AT_SOFF = AT_VOFF + 3 * AT_VBUFMAX, AT_QOFF = AT_SOFF + 1024;
static_assert(AT_QOFF + 8 * 6144 <= LDS_BYTES, "attention LDS map");
#ifndef AT_NEGM
#define AT_NEGM 0
#endif
#ifndef AT_LAZY_THR
#define AT_LAZY_THR 1048576.0f
#endif
#ifndef AT_LAZY
#define AT_LAZY 1
#endif
#ifndef AT_NOPF
#define AT_NOPF 1
#endif
#ifndef AT_IGLP
#define AT_IGLP -1
#endif
#ifndef AT_QLMIN
#define AT_QLMIN 64
#endif
#ifndef AT_PVKS
#define AT_PVKS 1
#endif
#ifndef AT_SGB
#define AT_SGB 0
#endif
#ifndef AT_PV8
#define AT_PV8 1
#endif
#ifndef AT_NOSBAR
#define AT_NOSBAR 1
#endif
#if AT_NOSBAR
#define SBAR() do {} while (0)
#else
#define SBAR() __builtin_amdgcn_sched_barrier(0)
#endif
#ifndef PROBE_MODE
#define PROBE_MODE 0
#endif
#ifndef DRY_SEL
#define DRY_SEL 7
#endif
#ifndef AT_QL
#define AT_QL 1
#endif
#ifndef AT_SB
#define AT_SB 0
#endif
template <int DQK, bool QL, bool NG = false>
DI void at_qkt(f32x16& p0, f32x16& p1, const LAS unsigned char* kb, const bf16x8* qf, const LAS unsigned char* qb, const f32x16* c0 = nullptr) {
    constexpr int KSTR = DQK + 8;
    if (!NG) {
#pragma unroll
        for (int r = 0; r < 16; ++r) { p0[r] = 0.f; p1[r] = 0.f; }
    }
#pragma unroll
    for (int ds = 0; ds < DQK / 16; ++ds) {
        const bf16x8 k0 = *(const LAS bf16x8*)(kb + ds * 32), k1 = *(const LAS bf16x8*)(kb + 32 * (KSTR * 2) + ds * 32);
        bf16x8 q; if (QL) q = *(const LAS bf16x8*)(qb + ds * 1024); else q = qf[ds];
        if (NG && ds == 0) { p0 = MFMA32(k0, q, *c0); p1 = MFMA32(k1, q, *c0); } else { p0 = MFMA32(k0, q, p0); p1 = MFMA32(k1, q, p1); }
        if (AT_SB && DQK > 64 && (ds & 1)) __builtin_amdgcn_sched_barrier(0x7f); }
}
DI void at_mask(f32x16& p0, f32x16& p1, int dk) {
#pragma unroll
    for (int r = 0; r < 16; ++r) { const int d = dk + (r & 3) + 8 * (r >> 2);
        if (d > 128 || d < -128) p0[r] = NEGBIG;
        if (d + 32 > 128 || d + 32 < -128) p1[r] = NEGBIG; }
}
DI void at_psm(f32x16& p0, f32x16& p1, float& mrun, float& alpha) {
    float ma = fmaxf(fmaxf(p0[0], p0[1]), p0[2]), mb = fmaxf(fmaxf(p1[0], p1[1]), p1[2]);
    ma = fmaxf(fmaxf(ma, p0[3]), p1[3]);
#pragma unroll
    for (int r = 4; r < 16; r += 2) { ma = fmaxf(fmaxf(ma, p0[r]), p0[r + 1]); mb = fmaxf(fmaxf(mb, p1[r]), p1[r + 1]); }
    float mx = fmaxf(ma, mb);
    { auto rr = __builtin_amdgcn_permlane32_swap(__float_as_uint(mx), __float_as_uint(mx), false, false); mx = fmaxf(__uint_as_float(rr[0]), __uint_as_float(rr[1])); }
    const bool keep = __all(mx - mrun <= THR);
    const float mn = keep ? mrun : fmaxf(mrun, mx); alpha = __builtin_amdgcn_exp2f(mrun - mn); mrun = mn;
#pragma unroll
    for (int r = 0; r < 16; ++r) { p0[r] -= mrun; p1[r] -= mrun; }
#pragma unroll
    for (int r = 0; r < 16; ++r) p0[r] = __builtin_amdgcn_exp2f(p0[r]);
}
template <bool NG>
DI void at_psm_lazy(f32x16& p0, f32x16& p1, float mrun) {
    if (!NG) {
#pragma unroll
        for (int r = 0; r < 16; ++r) { p0[r] -= mrun; p1[r] -= mrun; }
    }
#pragma unroll
    for (int r = 0; r < 16; ++r) p0[r] = __builtin_amdgcn_exp2f(p0[r]);
}
DI void at_fsm_lazy(f32x16& p0, f32x16& p1, float& mrun, float& alpha, float& lrun, bf16x8* pa) {
#pragma unroll
    for (int r = 0; r < 16; ++r) p1[r] = __builtin_amdgcn_exp2f(p1[r]);
    float sa = p0[0] + p0[1], sb = p0[2] + p0[3], sc_ = p1[0] + p1[1], sd = p1[2] + p1[3];
#pragma unroll
    for (int r = 4; r < 16; r += 2) { sa = opq(sa) + p0[r]; sb = opq(sb) + p0[r + 1]; sc_ = opq(sc_) + p1[r]; sd = opq(sd) + p1[r + 1]; }
    float ps = (opq(sa) + sb) + (opq(sc_) + sd);
    alpha = 1.f;
    if (__builtin_expect(__any(!(ps <= AT_LAZY_THR)), 0)) {
        float ma = fmaxf(fmaxf(p0[0], p0[1]), p0[2]), mb = fmaxf(fmaxf(p1[0], p1[1]), p1[2]);
        ma = fmaxf(fmaxf(ma, p0[3]), p1[3]);
#pragma unroll
        for (int r = 4; r < 16; r += 2) { ma = fmaxf(fmaxf(ma, p0[r]), p0[r + 1]); mb = fmaxf(fmaxf(mb, p1[r]), p1[r + 1]); }
        float mx = fmaxf(ma, mb);
        { auto rr = __builtin_amdgcn_permlane32_swap(__float_as_uint(mx), __float_as_uint(mx), false, false); mx = fmaxf(__uint_as_float(rr[0]), __uint_as_float(rr[1])); }
        const float d = fmaxf(__builtin_amdgcn_logf(mx), 0.f);
        alpha = __builtin_amdgcn_exp2f(-d); mrun += d; ps *= alpha;
#pragma unroll
        for (int r = 0; r < 16; ++r) { p0[r] *= alpha; p1[r] *= alpha; }
    }
    lrun = lrun * alpha + ps;
    u32x4 w;
    w.x = pk2(p0[0], p0[1]); w.y = pk2(p0[2], p0[3]); w.z = pk2(p0[4], p0[5]); w.w = pk2(p0[6], p0[7]); pa[0] = __builtin_bit_cast(bf16x8, w);
    w.x = pk2(p0[8], p0[9]); w.y = pk2(p0[10], p0[11]); w.z = pk2(p0[12], p0[13]); w.w = pk2(p0[14], p0[15]); pa[1] = __builtin_bit_cast(bf16x8, w);
    w.x = pk2(p1[0], p1[1]); w.y = pk2(p1[2], p1[3]); w.z = pk2(p1[4], p1[5]); w.w = pk2(p1[6], p1[7]); pa[2] = __builtin_bit_cast(bf16x8, w);
    w.x = pk2(p1[8], p1[9]); w.y = pk2(p1[10], p1[11]); w.z = pk2(p1[12], p1[13]); w.w = pk2(p1[14], p1[15]); pa[3] = __builtin_bit_cast(bf16x8, w);
}
DI void at_fsm(f32x16& p0, f32x16& p1, float alpha, float& lrun, bf16x8* pa) {
#pragma unroll
    for (int r = 0; r < 16; ++r) p1[r] = __builtin_amdgcn_exp2f(p1[r]);
    float ps = 0.f;
#pragma unroll
    for (int r = 0; r < 16; ++r) ps += p0[r] + p1[r];
    lrun = lrun * alpha + ps;
    u32x4 w;
    w.x = pk2(p0[0], p0[1]); w.y = pk2(p0[2], p0[3]); w.z = pk2(p0[4], p0[5]); w.w = pk2(p0[6], p0[7]); pa[0] = __builtin_bit_cast(bf16x8, w);
    w.x = pk2(p0[8], p0[9]); w.y = pk2(p0[10], p0[11]); w.z = pk2(p0[12], p0[13]); w.w = pk2(p0[14], p0[15]); pa[1] = __builtin_bit_cast(bf16x8, w);
    w.x = pk2(p1[0], p1[1]); w.y = pk2(p1[2], p1[3]); w.z = pk2(p1[4], p1[5]); w.w = pk2(p1[6], p1[7]); pa[2] = __builtin_bit_cast(bf16x8, w);
    w.x = pk2(p1[8], p1[9]); w.y = pk2(p1[10], p1[11]); w.z = pk2(p1[12], p1[13]); w.w = pk2(p1[14], p1[15]); pa[3] = __builtin_bit_cast(bf16x8, w);
}
DI void at_fsm_fake(f32x16& p0, f32x16& p1, bf16x8* pa) {
    u32x4 w;
    w.x = pk2(p0[0], p0[1]); w.y = pk2(p0[2], p0[3]); w.z = pk2(p0[4], p0[5]); w.w = pk2(p0[6], p0[7]); pa[0] = __builtin_bit_cast(bf16x8, w);
    w.x = pk2(p0[8], p0[9]); w.y = pk2(p0[10], p0[11]); w.z = pk2(p0[12], p0[13]); w.w = pk2(p0[14], p0[15]); pa[1] = __builtin_bit_cast(bf16x8, w);
    w.x = pk2(p1[0], p1[1]); w.y = pk2(p1[2], p1[3]); w.z = pk2(p1[4], p1[5]); w.w = pk2(p1[6], p1[7]); pa[2] = __builtin_bit_cast(bf16x8, w);
    w.x = pk2(p1[8], p1[9]); w.y = pk2(p1[10], p1[11]); w.z = pk2(p1[12], p1[13]); w.w = pk2(p1[14], p1[15]); pa[3] = __builtin_bit_cast(bf16x8, w);
}
template <int DV>
DI void at_pv(f32x16* o, const LAS unsigned char* vb, const bf16x8* pa) {
    constexpr int VSTR = DV + 32;
#if AT_PVKS
#pragma unroll
    for (int ks = 0; ks < 4; ++ks) {
        s16x4 vlo[DV / 32], vhi[DV / 32];
#pragma unroll
        for (int db = 0; db < DV / 32; ++db) { vlo[db] = tr16(vb + (16 * ks) * (VSTR * 2) + db * 64); vhi[db] = tr16(vb + (16 * ks + 8) * (VSTR * 2) + db * 64); }
#pragma unroll
        for (int db = 0; db < DV / 32; ++db) { const bf16x8 vf = __builtin_shufflevector(vlo[db], vhi[db], 0, 1, 2, 3, 4, 5, 6, 7); o[db] = MFMA32(pa[ks], vf, o[db]); }
    }
#else
#pragma unroll
    for (int db = 0; db < DV / 32; ++db) {
        s16x4 vlo[4], vhi[4];
#pragma unroll
        for (int ks = 0; ks < 4; ++ks) { vlo[ks] = tr16(vb + (16 * ks) * (VSTR * 2) + db * 64); vhi[ks] = tr16(vb + (16 * ks + 8) * (VSTR * 2) + db * 64); }
#pragma unroll
        for (int ks = 0; ks < 4; ++ks) { const bf16x8 vf = __builtin_shufflevector(vlo[ks], vhi[ks], 0, 1, 2, 3, 4, 5, 6, 7); o[db] = MFMA32(pa[ks], vf, o[db]); }
    }
#endif
}
template <int DV>
DI void at_scale_o(f32x16* o, LAS float* scw, float val, int r32, int hi) {
    if (hi == 0) scw[r32] = val;
    __builtin_amdgcn_wave_barrier(); asm volatile("" ::: "memory");
#pragma unroll
    for (int g4 = 0; g4 < 4; ++g4) { const f32x4 a4 = *(const LAS f32x4*)(scw + 8 * g4 + 4 * hi);
#pragma unroll
        for (int db = 0; db < DV / 32; ++db) { o[db][4 * g4 + 0] *= a4[0]; o[db][4 * g4 + 1] *= a4[1]; o[db][4 * g4 + 2] *= a4[2]; o[db][4 * g4 + 3] *= a4[3]; } }
    __builtin_amdgcn_wave_barrier(); asm volatile("" ::: "memory");
}
template <int DQK, int DV, int OUTM, bool MASKED>
DI void attn_unit(LAS unsigned char* lds, const bf16_t* Qp, int ldq, const bf16_t* Kp, int ldk, const bf16_t* Vp, int ldv,
                  int nA, int rowB0, int nB, int posB0, int qpos0, float m0, float l0,
                  bf16_t* Og, int ldo, float* Of, int ldof) {
    constexpr int KSTR = DQK + 8, VSTR = DV + 32, KBUF = 64 * KSTR * 2, VBUF = 64 * VSTR * 2;
    constexpr int KCH = DQK / 8, VCH = DV / 8, NKC = 64 * KCH, NVC = 64 * VCH, KRN = (NKC + 511) / 512, VRN = (NVC + 511) / 512;
    static_assert(KBUF <= AT_KBUFMAX && VBUF <= AT_VBUFMAX, "attention LDS map");
    const int tid = tid_l(), lane = tid & 63, wid = __builtin_amdgcn_readfirstlane(tid >> 6), r32 = lane & 31, hi = lane >> 5;
#ifndef AT_QL
#define AT_QL 1
#endif
#ifndef AT_SB
#define AT_SB 0
#endif
    constexpr bool NG = (AT_NEGM == 1 && DQK == 64) || (AT_NEGM == 2 && DQK == 64 && DV == 64);
    constexpr bool QL = AT_QL && (DQK > AT_QLMIN || (NG && DV == 128));
    bf16x8 qf[QL ? 1 : DQK / 16];
    const LAS unsigned char* qb = lds + AT_QOFF + wid * 6144 + lane * 16;
    { const bf16_t* qrow = Qp + (size_t)(32 * wid + r32) * ldq + 8 * hi;
#pragma unroll
      for (int ds = 0; ds < DQK / 16; ++ds) { const bf16x8 v = *(const bf16x8*)(qrow + 16 * ds); if (QL) *(LAS bf16x8*)(lds + AT_QOFF + wid * 6144 + lane * 16 + ds * 1024) = v; else qf[QL ? 0 : ds] = v; }
      if (QL) { __builtin_amdgcn_wave_barrier(); asm volatile("s_waitcnt lgkmcnt(0)" ::: "memory"); } }
    f32x16 o[DV / 32];
#pragma unroll
    for (int db = 0; db < DV / 32; ++db)
#pragma unroll
        for (int r = 0; r < 16; ++r) o[db][r] = 0.f;
    float mrun = m0, lrun = (hi == 0) ? l0 : 0.f;
    LAS float* scw = (LAS float*)(lds + AT_SOFF) + wid * 32;
    const int NT = nA + nB;
    const LAS unsigned char* kb0 = lds + AT_KOFF + r32 * (KSTR * 2) + hi * 16;
    const LAS unsigned char* vb0 = lds + AT_VOFF + (4 * hi + ((lane & 15) >> 2)) * (VSTR * 2) + (16 * ((lane >> 4) & 1) + 4 * (lane & 3)) * 2;
    const int dk0 = posB0 + 4 * hi - (qpos0 + 32 * wid + r32) - 64 * nA;
    u32x4 kreg[KRN], vreg[VRN];
    int kgo[KRN], klo[KRN], vgo[VRN], vlo_[VRN];
#pragma unroll
    for (int i_ = 0; i_ < KRN; ++i_) { int c_ = tid + 512 * i_; if (c_ >= NKC) c_ -= 512; const int r_ = c_ / KCH, cc_ = c_ % KCH; kgo[i_] = r_ * ldk + cc_ * 8; klo[i_] = AT_KOFF + r_ * (KSTR * 2) + cc_ * 16; }
#pragma unroll
    for (int i_ = 0; i_ < VRN; ++i_) { int c_ = tid + 512 * i_; if (c_ >= NVC) c_ -= 512; const int r_ = c_ / VCH, cc_ = c_ % VCH; vgo[i_] = r_ * ldv + cc_ * 8; vlo_[i_] = AT_VOFF + r_ * (VSTR * 2) + cc_ * 16; }
    const __amdgpu_buffer_rsrc_t rK = __builtin_amdgcn_make_buffer_rsrc((void*)Kp, 0, 0x7fffffff, 0x00020000), rV = __builtin_amdgcn_make_buffer_rsrc((void*)Vp, 0, 0x7fffffff, 0x00020000);
#define AT_GLOAD(t) do { const int row0_ = (t) < nA ? 64 * (t) : rowB0 + 64 * ((t) - nA); const int sk_ = row0_ * ldk * 2, sv_ = row0_ * ldv * 2; \
        _Pragma("unroll") for (int i_ = 0; i_ < KRN; ++i_) kreg[i_] = __builtin_amdgcn_raw_buffer_load_b128(rK, kgo[i_] * 2, sk_, 0); \
        _Pragma("unroll") for (int i_ = 0; i_ < VRN; ++i_) vreg[i_] = __builtin_amdgcn_raw_buffer_load_b128(rV, vgo[i_] * 2, sv_, 0); } while (0)
#define AT_SWRITE(buf) do { \
        _Pragma("unroll") for (int i_ = 0; i_ < KRN; ++i_) *(LAS u32x4*)(lds + (buf) * KBUF + klo[i_]) = kreg[i_]; \
        _Pragma("unroll") for (int i_ = 0; i_ < VRN; ++i_) *(LAS u32x4*)(lds + (buf) * VBUF + vlo_[i_]) = vreg[i_]; } while (0)
    unsigned pfv = 0u, pfacc = 0u;
    const int pft = tid & 255;
    const bf16_t* pfb = (pft < 128) ? Kp + (pft >> 1) * ldk + (pft & 1) * (DQK - 2) : Vp + ((pft - 128) >> 1) * ldv + (pft & 1) * (DV - 2);
    const int pfs = (pft < 128) ? ldk : ldv;
    constexpr int PFD = 4;
#if AT_NOPF
#define AT_PF(t) do {} while (0)
#else
#define AT_PF(t) do { pfacc ^= pfv; const int tt_ = (t) < NT ? (t) : NT - 1; const int row0_ = tt_ < nA ? 64 * tt_ : rowB0 + 64 * (tt_ - nA); \
        pfv = *(const unsigned*)(pfb + (size_t)row0_ * pfs); } while (0)
#endif
#define AT_MASK(P0, P1, t) do { if (MASKED && (t) >= nA) at_mask(P0, P1, dk0 + 64 * (t)); } while (0)
#define AT_RESC(al) do { if (__any((al) < 1.f)) at_scale_o<DV>(o, scw, (al), r32, hi); } while (0)
    constexpr int DRYP = (OUTM == 2) ? PROBE_MODE : 0;
    f32x16 pA0, pA1, pB0, pB1; float alA, alB; bf16x8 pa[4];
    AT_PF(1); AT_PF(2); AT_PF(3);
    AT_GLOAD(0); AT_SWRITE(0); __syncthreads();
    AT_GLOAD(1);
    at_qkt<DQK, QL>(pA0, pA1, kb0, qf, qb); AT_MASK(pA0, pA1, 0); at_psm(pA0, pA1, mrun, alA);
#if AT_LAZY
    lrun *= alA;
#endif
    AT_SWRITE(1); __syncthreads();
    int bp = 0, bc = 1, bn = 2;
    constexpr int NMF = 2 * (DQK / 16) + 4 * (DV / 32);
#if AT_IGLP >= 0
#define AT_SCHED() __builtin_amdgcn_iglp_opt(AT_IGLP)
#elif AT_SGB
#define AT_SCHED() do { _Pragma("unroll") for (int i_ = 0; i_ < NMF; ++i_) { __builtin_amdgcn_sched_group_barrier(0x008, 1, 0); __builtin_amdgcn_sched_group_barrier(0x100, 2, 0); __builtin_amdgcn_sched_group_barrier(0x002, AT_SGB, 0); } } while (0)
#else
#define AT_SCHED() do {} while (0)
#endif
#define AT_ROT() do { bp = bc; bc = bn; bn = (bn == 2) ? 0 : bn + 1; } while (0)
#if AT_LAZY
    f32x16 negm;
    if (NG) {
#pragma unroll
        for (int r = 0; r < 16; ++r) negm[r] = -mrun;
    }
#define AT_NEGUPD(al, P0, P1) do { if (NG && __any((al) < 1.f)) { const float d_ = -__builtin_amdgcn_logf(al); _Pragma("unroll") for (int r_ = 0; r_ < 16; ++r_) { negm[r_] = -mrun; P0[r_] -= d_; P1[r_] -= d_; } } } while (0)
    for (int j = 1; j + 1 < NT; j += 2) {
        at_qkt<DQK, QL, NG>(pB0, pB1, kb0 + bc * KBUF, qf, qb, &negm); AT_MASK(pB0, pB1, j);
        AT_GLOAD(j + 1);
        at_fsm_lazy(pA0, pA1, mrun, alA, lrun, pa);
        AT_RESC(alA); AT_NEGUPD(alA, pB0, pB1);
        at_pv<DV>(o, vb0 + bp * VBUF, pa); at_psm_lazy<NG>(pB0, pB1, mrun);
        AT_SWRITE(bn);
        __syncthreads(); AT_ROT();
        at_qkt<DQK, QL, NG>(pA0, pA1, kb0 + bc * KBUF, qf, qb, &negm); AT_MASK(pA0, pA1, j + 1);
        AT_GLOAD(j + 2);
        at_fsm_lazy(pB0, pB1, mrun, alB, lrun, pa);
        AT_RESC(alB); AT_NEGUPD(alB, pA0, pA1);
        at_pv<DV>(o, vb0 + bp * VBUF, pa); at_psm_lazy<NG>(pA0, pA1, mrun);
        AT_SWRITE(bn);
        __syncthreads(); AT_ROT();
    }
    at_qkt<DQK, QL, NG>(pB0, pB1, kb0 + bc * KBUF, qf, qb, &negm); AT_MASK(pB0, pB1, NT - 1);
    at_fsm_lazy(pA0, pA1, mrun, alA, lrun, pa);
    AT_RESC(alA); AT_NEGUPD(alA, pB0, pB1);
    at_pv<DV>(o, vb0 + bp * VBUF, pa); at_psm_lazy<NG>(pB0, pB1, mrun);
    at_fsm_lazy(pB0, pB1, mrun, alB, lrun, pa);
    AT_RESC(alB);
    at_pv<DV>(o, vb0 + bc * VBUF, pa);
#else
    for (int j = 1; j + 1 < ((DRYP == 6) ? 2 : NT); j += 2) {
        SBAR(); if (DRYP != 5) at_qkt<DQK, QL>(pB0, pB1, kb0 + bc * KBUF, qf, qb); else { _Pragma("unroll") for (int r_ = 0; r_ < 16; ++r_) { pB0[r_] = o[0][r_] * 1e-3f; pB1[r_] = o[1][r_] * 1e-3f; } } AT_MASK(pB0, pB1, j);
        if (!(DRYP >= 1)) { AT_GLOAD(j + 1); AT_PF(j + PFD); }
        if (DRYP != 3) at_fsm(pA0, pA1, alA, lrun, pa); else at_fsm_fake(pA0, pA1, pa); SBAR();
        if (DRYP != 4) at_pv<DV>(o, vb0 + bp * VBUF, pa); else { o[0][0] += __builtin_bit_cast(float, (int)pa[0][0] + (int)pa[1][1] + (int)pa[2][2] + (int)pa[3][3]); } if (DRYP != 3) at_psm(pB0, pB1, mrun, alB); else alB = 1.f;
        AT_SCHED();
        if (!(DRYP >= 1)) AT_SWRITE(bn);
        AT_RESC(alB); if (DRYP != 2) __syncthreads(); AT_ROT();
        SBAR(); if (DRYP != 5) at_qkt<DQK, QL>(pA0, pA1, kb0 + bc * KBUF, qf, qb); else { _Pragma("unroll") for (int r_ = 0; r_ < 16; ++r_) { pA0[r_] = o[0][r_] * 1e-3f; pA1[r_] = o[1][r_] * 1e-3f; } } AT_MASK(pA0, pA1, j + 1);
        if (!(DRYP >= 1)) { AT_GLOAD(j + 2); AT_PF(j + 1 + PFD); }
        if (DRYP != 3) at_fsm(pB0, pB1, alB, lrun, pa); else at_fsm_fake(pB0, pB1, pa); SBAR();
        if (DRYP != 4) at_pv<DV>(o, vb0 + bp * VBUF, pa); else { o[0][0] += __builtin_bit_cast(float, (int)pa[0][0] + (int)pa[1][1] + (int)pa[2][2] + (int)pa[3][3]); } if (DRYP != 3) at_psm(pA0, pA1, mrun, alA); else alA = 1.f;
        AT_SCHED();
        if (!(DRYP >= 1)) AT_SWRITE(bn);
        AT_RESC(alA); if (DRYP != 2) __syncthreads(); AT_ROT();
    }
    SBAR(); at_qkt<DQK, QL>(pB0, pB1, kb0 + bc * KBUF, qf, qb); AT_MASK(pB0, pB1, NT - 1);
    at_fsm(pA0, pA1, alA, lrun, pa); SBAR();
    at_pv<DV>(o, vb0 + bp * VBUF, pa); at_psm(pB0, pB1, mrun, alB);
    AT_RESC(alB);
    at_fsm(pB0, pB1, alB, lrun, pa); SBAR();
    at_pv<DV>(o, vb0 + bc * VBUF, pa);
#endif
#undef AT_ROT
#ifdef AT_NEGUPD
#undef AT_NEGUPD
#endif
#undef AT_SCHED
    pfacc ^= pfv;
    if (__builtin_expect(pfacc == 0x9e3779b9u && lrun == 12345.678f, 0)) scw[0] = 1.f;
#undef AT_GLOAD
#undef AT_PF
#undef AT_SWRITE
#undef AT_MASK
#undef AT_RESC
    { const float lt = lrun + __shfl_xor(lrun, 32); at_scale_o<DV>(o, scw, 1.0f / lt, r32, hi); }
    if (OUTM == 0) {
#pragma unroll
        for (int db = 0; db < DV / 32; ++db) {
            bf16_t* pb = Og + (size_t)(32 * wid + 4 * hi) * ldo + 32 * db + r32;
            bf16_t zz[16];
#pragma unroll
            for (int r = 0; r < 16; ++r) zz[r] = pb[(size_t)((r & 3) + 8 * (r >> 2)) * ldo];
#pragma unroll
            for (int r = 0; r < 16; ++r) { const float z = __uint_as_float((unsigned)zz[r] << 16); pb[(size_t)((r & 3) + 8 * (r >> 2)) * ldo] = (bf16_t)(pk2(o[db][r] * silu_f(z), 0.f) & 0xffffu); }
        }
    } else {
#pragma unroll
        for (int db = 0; db < DV / 32; ++db)
#pragma unroll
            for (int r = 0; r < 16; ++r) {
                const int q = (r & 3) + 8 * (r >> 2) + 4 * hi;
                if (OUTM == 1) { Of[(size_t)(32 * wid + q) * ldof + 32 * db + r32] = o[db][r]; }
                else { if (lrun == 12345.678f) Of[(size_t)(32 * wid + q) * ldof + 32 * db + r32] = o[db][r]; }
            }
    }
    __syncthreads();
}

struct Args { const float* in[21]; float* out; unsigned char* ws; };
typedef const __attribute__((address_space(4))) Args* ArgsP;
DI ArgsP args_ptr() { ArgsP p = (ArgsP)__builtin_amdgcn_kernarg_segment_ptr(); asm volatile("" : "+s"(p)); return p; }
enum { I_X = 0, I_C, I_CTX, I_CCTX, I_WMOD, I_BMOD, I_NORMG, I_WIN, I_QNORM, I_WUQ, I_KVNORM, I_WUKV, I_LQ1, I_LK1, I_LQ2, I_LK2, I_SUBLN, I_SINK, I_WBR, I_WOUT, I_FNORM };

DI int colmap(int kind, int n) {
    if (kind == 1) {
        if (n < C_KR) return n;
        if (n < C_KR + 32) { const int e = n - C_KR; return C_KR + (e >> 1) + 16 * (e & 1); }
        if (n < C_DQ) return -1;
        if ((n >= C_DQ && n < C_DV) || (n >= C_SQ && n < C_SV)) { const int w = n & 63; return (n - w) - 96 + (w >> 1) + 32 * (w & 1); }
        return n - 96;
    }
    if (kind == 2) { const int h = n / 96, e = n % 96; if (e < 64) return n; const int e2 = e - 64; return h * 96 + 64 + (e2 >> 1) + 16 * (e2 & 1); }
    if (kind == 3) { if (n < 512) return (n >> 6) * 192 + (n & 63); const int n2 = n - 512; return (n2 >> 7) * 192 + 64 + (n2 & 127); }
    return n;
}
DI void transpose_item(const float* W, int ldw, int kind, const float* rowscale, bf16_t* WT, int ldd, int koff, LAS float* scr, int item, int nblk, int lane) {
    const int kb = item / nblk, nb = item % nblk, k0 = 64 * kb, n0 = 32 * nb;
    const int oc = colmap(kind, n0 + (lane & 31));
#pragma unroll 8
    for (int i = 0; i < 32; ++i) { const int kk = 2 * i + (lane >> 5); float v = 0.f; if (oc >= 0) v = W[(size_t)(k0 + kk) * ldw + oc]; if (rowscale) v *= rowscale[k0 + kk]; scr[kk * 33 + (lane & 31)] = v; }
    __builtin_amdgcn_wave_barrier(); asm volatile("s_waitcnt lgkmcnt(0)" ::: "memory");
    const int c = lane & 7;
#pragma unroll
    for (int j = 0; j < 4; ++j) { const int n = (lane >> 3) + 8 * j; const LAS float* s = scr + (8 * c) * 33 + n;
        u32x4 o; o.x = pk2(s[0 * 33], s[1 * 33]); o.y = pk2(s[2 * 33], s[3 * 33]); o.z = pk2(s[4 * 33], s[5 * 33]); o.w = pk2(s[6 * 33], s[7 * 33]);
        *(u32x4*)(WT + (size_t)(n0 + n) * ldd + koff + k0 + 8 * c) = o; }
    __builtin_amdgcn_wave_barrier(); asm volatile("s_waitcnt lgkmcnt(0)" ::: "memory");
}
DI void prologue(ArgsP ap, LAS unsigned char* lds) {
    const int tid = tid_l(), lane = tid & 63, wid = __builtin_amdgcn_readfirstlane(tid >> 6);
    unsigned char* ws = ap->ws;
    LAS float* scr = (LAS float*)(lds + wid * 8448);
    const int gw = bid_l() * 8 + wid, NGW = grd_l() * 8;
    constexpr int I_IN = 16 * (NP / 32), I_UQ = 6 * 24, I_UKV = 4 * 48, I_SQ = 16 * 32, PER_L = I_IN + I_UQ + I_UKV + 6 * I_SQ;
    for (int it = gw; it < 2 * PER_L; it += NGW) {
        const int l = it / PER_L; int r = it % PER_L;
        if (r < I_IN) { transpose_item(ap->in[I_WIN] + (size_t)l * 1024 * D_IN, D_IN, 1, nullptr, (bf16_t*)(ws + WS_WIN) + (size_t)l * NP * 1024, 1024, 0, scr, r, NP / 32, lane); continue; } r -= I_IN;
        if (r < I_UQ) { transpose_item(ap->in[I_WUQ] + (size_t)l * 384 * 768, 768, 2, ap->in[I_QNORM] + l * 384, (bf16_t*)(ws + WS_WUQ) + (size_t)l * 768 * 384, 384, 0, scr, r, 24, lane); continue; } r -= I_UQ;
        if (r < I_UKV) { transpose_item(ap->in[I_WUKV] + (size_t)l * 256 * 1536, 1536, 3, ap->in[I_KVNORM] + l * 256, (bf16_t*)(ws + WS_WUKV) + (size_t)l * 1536 * 256, 256, 0, scr, r, 48, lane); continue; } r -= I_UKV;
        if (r < 3 * I_SQ) { const int br = r / I_SQ; transpose_item(ap->in[I_WBR] + ((size_t)l * 3 + br) * 1024 * 1024, 1024, 0, nullptr, (bf16_t*)(ws + WS_WB) + ((size_t)l * 3 + br) * 1024 * 1024, 1024, 0, scr, r % I_SQ, 32, lane); continue; } r -= 3 * I_SQ;
        { const int rep = r / I_SQ; transpose_item(ap->in[I_WOUT] + (size_t)l * 1024 * 1024, 1024, 0, nullptr, (bf16_t*)(ws + WS_WO3) + (size_t)l * 1024 * 3072, 3072, rep * 1024, scr, r % I_SQ, 32, lane); }
    }
    const int gt = bid_l() * 512 + tid, NGT = grd_l() * 512;
    for (int i = gt; i < SEQ * 48; i += NGT) {
        const int pos = i / 48, p = i % 48; const float frow = (float)(pos >> 6), fcol = (float)(pos & 63);
        float ang; float* cd; float* sd;
        if (p < 32) { const int f = p & 15; const float inv = powf(10000.0f, -(float)f / 16.0f); ang = (p < 16 ? frow : fcol) * inv; cd = (float*)(ws + WS_COSH) + pos * 32 + p; sd = (float*)(ws + WS_SINH) + pos * 32 + p; }
        else { const int pp = p - 32, f = pp & 7; const float inv = powf(10000.0f, -(float)f / 8.0f); ang = (pp < 8 ? frow : fcol) * inv; cd = (float*)(ws + WS_COSM) + pos * 16 + pp; sd = (float*)(ws + WS_SINM) + pos * 16 + pp; }
        *cd = __cosf(ang); *sd = __sinf(ang);
    }
    for (int it = gw; it < 2 * 16 * 48; it += NGW) {
        const int l = it / 768, rem = it % 768, kc = rem / 48, nb = rem % 48; const int k = kc * 64 + lane;
        float sv[9];
#pragma unroll
        for (int v = 0; v < 8; ++v) sv[v] = silu_f(ap->in[I_C][v * 1024 + k]);
        sv[8] = silu_f(ap->in[I_CCTX][k]);
        float acc[9];
#pragma unroll
        for (int v = 0; v < 9; ++v) acc[v] = 0.f;
        const float* w = ap->in[I_WMOD] + ((size_t)l * 1024 + kc * 64) * 3072 + nb * 64 + lane;
#pragma unroll 8
        for (int kk = 0; kk < 64; ++kk) { const float wv = w[(size_t)kk * 3072];
#pragma unroll
            for (int v = 0; v < 9; ++v) acc[v] += __uint_as_float(__builtin_amdgcn_readlane(__float_as_uint(sv[v]), kk)) * wv; }
        float* mp = (float*)(ws + WS_MODP) + ((size_t)(l * 16 + kc) * 9) * 3072 + nb * 64 + lane;
#pragma unroll
        for (int v = 0; v < 9; ++v) mp[(size_t)v * 3072] = acc[v];
    }
}
DI void mod_finalize(ArgsP ap) {
    const int tid = tid_l();
    const int gt = bid_l() * 512 + tid, NGT = grd_l() * 512;
    const float* mp = (const float*)(ap->ws + WS_MODP); float* mod = (float*)(ap->ws + WS_MOD);
    for (int i = gt; i < 2 * 9 * 3072; i += NGT) {
        const int l = i / (9 * 3072), rem = i % (9 * 3072), n = rem % 3072;
        float s = ap->in[I_BMOD][l * 3072 + n];
#pragma unroll
        for (int kc = 0; kc < 16; ++kc) s += mp[(size_t)(l * 16 + kc) * 9 * 3072 + rem];
        mod[i] = s;
    }
}
DI void ph_norm_mod(ArgsP ap, int l, int g) {
    const int tid = tid_l(), lane = tid & 63, wid = __builtin_amdgcn_readfirstlane(tid >> 6);
    const int gw = bid_l() * 8 + wid, NGW = grd_l() * 8;
    const float* ng = ap->in[I_NORMG] + l * 1024; const float* mod = (const float*)(ap->ws + WS_MOD) + (size_t)l * 9 * 3072;
    const float* xs = (l == 0) ? ap->in[I_X] : ap->out; const float* cs = (l == 0) ? ap->in[I_CTX] : (const float*)(ap->ws + WS_CTX);
    bf16_t* H = (bf16_t*)(ap->ws + WS_H);
    for (int r = gw; r < R; r += NGW) {
        const int bl = r / RB, j = r % RB, b = g * GB + bl;
        const float* src; const float* md;
        if (j < CTX) { src = cs + ((size_t)b * CTX + j) * DM; md = mod + 8 * 3072; } else { src = xs + ((size_t)b * SEQ + (j - CTX)) * DM; md = mod + (size_t)b * 3072; }
        f32x4 v[4]; float ss = 0.f;
#pragma unroll
        for (int q = 0; q < 4; ++q) { v[q] = *(const f32x4*)(src + 4 * (lane + 64 * q)); ss += (v[q][0] * v[q][0] + v[q][1] * v[q][1]) + (v[q][2] * v[q][2] + v[q][3] * v[q][3]); }
        const float rstd = 1.0f / sqrtf(wave_sum(ss) * (1.0f / DM) + EPS);
#pragma unroll
        for (int q = 0; q < 4; ++q) { const int idx = 4 * (lane + 64 * q);
            const f32x4 gg = *(const f32x4*)(ng + idx), sh = *(const f32x4*)(md + idx), sc = *(const f32x4*)(md + 1024 + idx);
            const f32x4 y = (v[q] * rstd * gg) * (sc + 1.0f) + sh;
            u32x2 w; w.x = pk2(y[0], y[1]); w.y = pk2(y[2], y[3]); *(u32x2*)(H + (size_t)r * DM + idx) = w; }
    }
}
DI void ph_mla_norm(ArgsP ap) {
    const int tid = tid_l(), lane = tid & 63, wid = __builtin_amdgcn_readfirstlane(tid >> 6);
    const int gw = bid_l() * 8 + wid, NGW = grd_l() * 8;
    const bf16_t* P = (const bf16_t*)(ap->ws + WS_P); bf16_t* AQ = (bf16_t*)(ap->ws + WS_AQ); bf16_t* AKV = (bf16_t*)(ap->ws + WS_AKV); bf16_t* KM = (bf16_t*)(ap->ws + WS_KM);
    for (int r = gw; r < R; r += NGW) {
        const bf16_t* row = P + (size_t)r * NP;
        const u32x4 c0 = *(const u32x4*)(row + 8 * lane);
        u32x4 c1 = {0u, 0u, 0u, 0u}; if (lane < 20) c1 = *(const u32x4*)(row + 8 * (64 + lane));
        float f0[8] = {bflo(c0.x), bfhi(c0.x), bflo(c0.y), bfhi(c0.y), bflo(c0.z), bfhi(c0.z), bflo(c0.w), bfhi(c0.w)};
        float f1[8] = {bflo(c1.x), bfhi(c1.x), bflo(c1.y), bfhi(c1.y), bflo(c1.z), bfhi(c1.z), bflo(c1.w), bfhi(c1.w)};
        float s0 = 0.f, s1 = 0.f;
#pragma unroll
        for (int i = 0; i < 8; ++i) { s0 += f0[i] * f0[i]; s1 += f1[i] * f1[i]; }
        const float sq = wave_sum(lane < 48 ? s0 : 0.f);
        const float skv = wave_sum((lane >= 48 ? s0 : 0.f) + (lane < 16 ? s1 : 0.f));
        const float rq = 1.0f / sqrtf(sq * (1.0f / 384.0f) + EPS), rkv = 1.0f / sqrtf(skv * (1.0f / 256.0f) + EPS);
        { const float rr = lane < 48 ? rq : rkv; u32x4 w; w.x = pk2(f0[0] * rr, f0[1] * rr); w.y = pk2(f0[2] * rr, f0[3] * rr); w.z = pk2(f0[4] * rr, f0[5] * rr); w.w = pk2(f0[6] * rr, f0[7] * rr);
          if (lane < 48) *(u32x4*)(AQ + (size_t)r * 384 + 8 * lane) = w; else *(u32x4*)(AKV + (size_t)r * 256 + 8 * (lane - 48)) = w; }
        if (lane < 16) { u32x4 w; w.x = pk2(f1[0] * rkv, f1[1] * rkv); w.y = pk2(f1[2] * rkv, f1[3] * rkv); w.z = pk2(f1[4] * rkv, f1[5] * rkv); w.w = pk2(f1[6] * rkv, f1[7] * rkv);
            *(u32x4*)(AKV + (size_t)r * 256 + 8 * (16 + lane)) = w; }
        else if (lane < 20) {
#pragma unroll
            for (int h = 0; h < 8; ++h) *(u32x4*)(KM + (size_t)r * 768 + h * 96 + 64 + 8 * (lane - 16)) = c1; }
    }
}
template <bool DRYE>
DI void ph_diff_post(ArgsP ap, int l) {
    const int tid = tid_l(), lane = tid & 63, wid = __builtin_amdgcn_readfirstlane(tid >> 6);
    const int gw = bid_l() * 8 + wid, NGW = grd_l() * 8;
    const float lam_init = (l == 0) ? 0.2f : (0.8f - 0.6f * 0.7408182206817179f);
    const float d1 = wave_sum(ap->in[I_LQ1][l * 64 + lane] * ap->in[I_LK1][l * 64 + lane]), d2 = wave_sum(ap->in[I_LQ2][l * 64 + lane] * ap->in[I_LK2][l * 64 + lane]);
    const float lam = expf(d1) - expf(d2) + lam_init;
    const float sl0 = ap->in[I_SUBLN][l * 128 + 2 * lane] * (1.0f - lam_init), sl1 = ap->in[I_SUBLN][l * 128 + 2 * lane + 1] * (1.0f - lam_init);
    const float* OD = (const float*)(ap->ws + WS_OD); bf16_t* P = (bf16_t*)(ap->ws + WS_P);
    typedef float f32x2 __attribute__((ext_vector_type(2)));
    for (int r = gw; r < R; r += NGW) {
        if (l != 0 && (r % RB) < CTX) continue;
        const float* ob = OD + (size_t)r * 2048 + 2 * lane; unsigned* zb = (unsigned*)(P + (size_t)r * NP + C_Z + 1024 + 2 * lane);
        f32x2 o1[8], o2[8]; unsigned z[8];
#pragma unroll
        for (int h = 0; h < 8; ++h) { o1[h] = *(const f32x2*)(ob + (2 * h) * 128); o2[h] = *(const f32x2*)(ob + (2 * h + 1) * 128); z[h] = zb[h * 64]; }
#pragma unroll
        for (int h = 0; h < 8; ++h) {
            const float a0 = o1[h][0] - lam * o2[h][0], a1 = o1[h][1] - lam * o2[h][1];
            const float rstd = 1.0f / sqrtf(wave_sum(a0 * a0 + a1 * a1) * (1.0f / 128.0f) + EPS);
            if (!DRYE || rstd == 12345.678f) zb[h * 64] = pk2(a0 * rstd * sl0 * silu_f(bflo(z[h])), a1 * rstd * sl1 * silu_f(bfhi(z[h])));
        }
    }
}
template <bool DRYE>
DI void ph_final_norm(ArgsP ap) {
    const int tid = tid_l(), lane = tid & 63, wid = __builtin_amdgcn_readfirstlane(tid >> 6);
    const int gw = bid_l() * 8 + wid, NGW = grd_l() * 8; const float* fg = ap->in[I_FNORM];
    for (int r = gw; r < NBATCH * SEQ; r += NGW) {
        float* row = ap->out + (size_t)r * DM; f32x4 v[4]; float ss = 0.f;
#pragma unroll
        for (int q = 0; q < 4; ++q) { v[q] = *(const f32x4*)(row + 4 * (lane + 64 * q)); ss += (v[q][0] * v[q][0] + v[q][1] * v[q][1]) + (v[q][2] * v[q][2] + v[q][3] * v[q][3]); }
        const float rstd = 1.0f / sqrtf(wave_sum(ss) * (1.0f / DM) + EPS);
#pragma unroll
        for (int q = 0; q < 4; ++q) { const int idx = 4 * (lane + 64 * q); if (!DRYE || rstd == 12345.678f) *(f32x4*)(row + idx) = v[q] * rstd * *(const f32x4*)(fg + idx); }
    }
}
template <bool DRY>
DI void ph_attention(ArgsP ap, int l, LAS unsigned char* lds) {
    constexpr int OM0 = DRY ? 2 : 0;
    const int G = grd_l(), bx = bid_l(), vcu = (G % 8 == 0) ? (bx % 8) * (G / 8) + bx / 8 : bx;
    bf16_t* P = (bf16_t*)(ap->ws + WS_P); const bf16_t* QM = (const bf16_t*)(ap->ws + WS_QM); const bf16_t* KM = (const bf16_t*)(ap->ws + WS_KM); const bf16_t* VM = (const bf16_t*)(ap->ws + WS_VM);
    float* OD = (float*)(ap->ws + WS_OD); const float* sink = ap->in[I_SINK] + l * 16;
#if !defined(ATT_ONLY) || ATT_ONLY == 1
    if (!DRY || (DRY_SEL & 1))
    for (int u = vcu; u < GB * 8 * 32; u += G) { const int bh = u >> 5, qb = u & 31, bl = bh >> 3, h = bh & 7; const size_t rb = (size_t)bl * RB, q0 = rb + CTX + 256 * qb;
        attn_unit<96, 128, OM0, false>(lds, QM + q0 * 768 + h * 96, 768, KM + rb * 768 + h * 96, 768, VM + rb * 1024 + h * 128, 1024, RB / 64, 0, 0, 0, 0, NEGBIG, 0.f, P + q0 * NP + C_Z + h * 128, NP, OD, 0); }
#endif
#if !defined(ATT_ONLY) || ATT_ONLY == 2
    if (!DRY || (DRY_SEL & 2))
    for (int u = vcu; u < GB * 16 * 32; u += G) { const int bh = u >> 5, qb = u & 31, bl = bh >> 4, hm = bh & 15; const size_t rb = (size_t)bl * RB, q0 = rb + CTX + 256 * qb;
        attn_unit<64, 128, 1, false>(lds, P + q0 * NP + C_DQ + hm * 64, NP, P + rb * NP + C_DK + hm * 64, NP, P + rb * NP + C_DV + (hm >> 1) * 128, NP, RB / 64, 0, 0, 0, 0, NEGBIG, 0.f, nullptr, 0, OD + q0 * 2048 + hm * 128, 2048); }
#endif
#if !defined(ATT_ONLY) || ATT_ONLY == 3
    if (!DRY || (DRY_SEL & 4))
    for (int u = vcu; u < GB * 16 * 32; u += G) { const int bh = u >> 5, qb = u & 31, bl = bh >> 4, h = bh & 15; const size_t rb = (size_t)bl * RB, q0 = rb + CTX + 256 * qb;
        const int lo = (256 * qb - 128 < 0) ? 0 : 256 * qb - 128, hi = (256 * qb + 384 > SEQ) ? SEQ : 256 * qb + 384;
        attn_unit<64, 64, OM0, true>(lds, P + q0 * NP + C_SQ + h * 64, NP, P + rb * NP + C_SK + (h >> 2) * 64, NP, P + rb * NP + C_SV + (h >> 2) * 64, NP, CTX / 64, CTX + lo, (hi - lo) / 64, lo, 256 * qb, sink[h] * LOG2E, 1.0f,
                              P + q0 * NP + C_Z + 2048 + h * 64, NP, OD, 0); }
#endif
#if !defined(ATT_ONLY)
    if (l == 0) {
        for (int u = vcu; u < GB * 40; u += G) { const int bl = u / 40, k = u % 40; const size_t rb = (size_t)bl * RB;
            if (k < 8) { const int h = k;
                attn_unit<96, 128, OM0, false>(lds, QM + rb * 768 + h * 96, 768, KM + rb * 768 + h * 96, 768, VM + rb * 1024 + h * 128, 1024, CTX / 64, 0, 0, 0, 0, NEGBIG, 0.f, P + rb * NP + C_Z + h * 128, NP, OD, 0); }
            else if (k < 24) { const int hm = k - 8;
                attn_unit<64, 128, 1, false>(lds, P + rb * NP + C_DQ + hm * 64, NP, P + rb * NP + C_DK + hm * 64, NP, P + rb * NP + C_DV + (hm >> 1) * 128, NP, CTX / 64, 0, 0, 0, 0, NEGBIG, 0.f, nullptr, 0, OD + rb * 2048 + hm * 128, 2048); }
            else { const int h = k - 24;
                attn_unit<64, 64, OM0, false>(lds, P + rb * NP + C_SQ + h * 64, NP, P + rb * NP + C_SK + (h >> 2) * 64, NP, P + rb * NP + C_SV + (h >> 2) * 64, NP, CTX / 64, 0, 0, 0, 0, sink[h] * LOG2E, 1.0f, P + rb * NP + C_Z + 2048 + h * 64, NP, OD, 0); }
        }
    }
#endif
}

#define RLX_AGENT __ATOMIC_RELAXED, __HIP_MEMORY_SCOPE_AGENT
#define XB_TMO      128
#define XB_XCNT(j)  (256  + 64 * (j))
#define XB_XSUB(j)  (1280 + 64 * (j))
#define XB_XGEN(j)  (2304 + 64 * (j))
#define XB_TOP      3328
#define XB_TOPGEN   3392
#define XCD_BAR_WORDS 3456
#define XB_SPIN_CAP (1u << 18)

__device__ __forceinline__ unsigned xb_ld(unsigned* p)              { return __hip_atomic_load(p, __ATOMIC_RELAXED, __HIP_MEMORY_SCOPE_AGENT); }
__device__ __forceinline__ unsigned xb_add(unsigned* p, unsigned v) { return __hip_atomic_fetch_add(p, v, __ATOMIC_RELAXED, __HIP_MEMORY_SCOPE_AGENT); }
__device__ __forceinline__ unsigned xb_xcc_id() { return (unsigned)__builtin_amdgcn_s_getreg((3 << 11) | 20) & 0xFu; }
#define XB_SPIN(cond, bar) do { unsigned _sp = 0; while (cond) { __builtin_amdgcn_s_sleep(1); \
    if ((++_sp & 255u) == 0u) { if (xb_ld(&(bar)[XB_TMO])) break; if (_sp > XB_SPIN_CAP) { atomicAdd(&(bar)[XB_TMO], 1u); break; } } } } while (0)

struct XcdBarrier {
    unsigned* bar; unsigned x;
    volatile LAS unsigned* st;
};

__device__ __forceinline__ XcdBarrier xcd_barrier_post(unsigned* bar, volatile LAS unsigned* st) {
    XcdBarrier b; b.bar = bar; b.x = xb_xcc_id(); b.st = st;
    if (threadIdx.x == 0) (void)xb_add(&bar[XB_XCNT(b.x)], 1u);
    return b;
}
__device__ __forceinline__ void xcd_barrier_complete(unsigned* bar, unsigned x, unsigned& nloc, unsigned& nx) {
    const unsigned G = gridDim.x * gridDim.y * gridDim.z;
    unsigned sum, cnt, mine, sp = 0u;
    for (;;) {
        sum = 0u; cnt = 0u; mine = 0u;
#pragma unroll
        for (unsigned j = 0; j < 16; ++j) { const unsigned c = xb_ld(&bar[XB_XCNT(j)]); sum += c; cnt += (c > 0u) ? 1u : 0u; mine = (j == x) ? c : mine; }
        if (sum == G) break;
        __builtin_amdgcn_s_sleep(1);
        if ((++sp & 255u) == 0u) { if (xb_ld(&bar[XB_TMO])) break; if (sp > XB_SPIN_CAP) { atomicAdd(&bar[XB_TMO], 1u); break; } }
    }
    nloc = mine > 0u ? mine : 1u; nx = cnt > 0u ? cnt : 1u;
}

__device__ __forceinline__ void xcd_barrier(const XcdBarrier& b) {
    asm volatile("s_waitcnt vmcnt(0)" ::: "memory");
    __syncthreads();
    if (threadIdx.x == 0) {
        unsigned* bar = b.bar;
        __builtin_amdgcn_s_waitcnt(0);
        unsigned nloc = b.st[0], nx = b.st[1];
        if (nloc == 0u) { xcd_barrier_complete(bar, b.x, nloc, nx); b.st[0] = nloc; b.st[1] = nx; }
        const unsigned old = xb_add(&bar[XB_XSUB(b.x)], 1u);
        const unsigned gen = old / nloc;
        if (old + 1u == (gen + 1u) * nloc) {
            __builtin_amdgcn_fence(__ATOMIC_RELEASE, "agent");
            asm volatile("s_waitcnt vmcnt(0)" ::: "memory");
            const unsigned og = xb_add(&bar[XB_TOP], 1u);
            const unsigned tg = og / nx;
            if (og + 1u == (tg + 1u) * nx) xb_add(&bar[XB_TOPGEN], 1u);
            else XB_SPIN(xb_ld(&bar[XB_TOPGEN]) == tg, bar);
            __builtin_amdgcn_fence(__ATOMIC_ACQUIRE, "agent");
            xb_add(&bar[XB_XGEN(b.x)], 1u);
            asm volatile("s_waitcnt vmcnt(0)" ::: "memory");
        } else {
            XB_SPIN(xb_ld(&bar[XB_XGEN(b.x)]) == gen, bar);
            __builtin_amdgcn_fence(__ATOMIC_ACQUIRE, "agent");
            asm volatile("s_waitcnt vmcnt(0)" ::: "memory");
        }
    }
    __syncthreads();
}


__global__ void __launch_bounds__(512, 2) hybrid_fwd(Args a_unused) {
    extern __shared__ __attribute__((aligned(16))) unsigned char lds_raw[];
    LAS unsigned char* lds = (LAS unsigned char*)lds_raw;
    cg::grid_group grid = cg::this_grid();
    { volatile LAS unsigned* xst = (volatile LAS unsigned*)(lds + XB_LDS_OFF);
      if (threadIdx.x < 2) xst[threadIdx.x] = 0u;
      __syncthreads();
      (void)xcd_barrier_post((unsigned*)(args_ptr()->ws), xst); }
#define GSYNC() do { XcdBarrier b_; b_.bar = (unsigned*)(args_ptr()->ws); b_.x = xb_xcc_id(); b_.st = (volatile LAS unsigned*)(lds + XB_LDS_OFF); xcd_barrier(b_); } while (0)
#ifndef NO_PRO
    prologue(args_ptr(), lds);
#ifdef PROBE_PRO
    __syncthreads(); prologue(args_ptr(), lds);
#endif
#endif
    grid.sync();
    mod_finalize(args_ptr());
    GSYNC();
    for (int l = 0; l < 2; ++l) {
        for (int g = 0; g < NGRP; ++g) {
            ph_norm_mod(args_ptr(), lnd(l), lnd(g));
#ifdef PROBE_R1
            GSYNC(); ph_norm_mod(args_ptr(), lnd(l), lnd(g));
#endif
            GSYNC();
#ifndef NO_GEMM
            {
                unsigned char* ws = args_ptr()->ws; const int G = grd_l(), bx = bid_l();
                pg8::Gemm gm{1024, 1024, 1024}; pg8::Order S; S.init(R, NP, G, bx, ws + WS_H, 1024, (bf16_t*)(ws + WS_WIN) + (size_t)l * NP * 1024, 1024, 1 << 20, 0);
                EpiIn E{ws};
                pg8::gemm_phase<EpiIn, pg8::Order, true, true>(lds, gm, S, E);
#ifdef PROBE_G1
                __syncthreads(); pg8::gemm_phase<EpiIn, pg8::Order, true, true>(lds, gm, S, E);
#endif
            }
#endif
            GSYNC();
#ifndef NO_GEMM2
            {
                unsigned char* ws = args_ptr()->ws; const int G = grd_l(), bx = bid_l();
                pg8::Gemm gq{384, NP, 384}; pg8::Order Sq; Sq.init(R, 768, G, bx, (bf16_t*)(ws + WS_P) + C_QC, NP, (bf16_t*)(ws + WS_WUQ) + (size_t)l * 768 * 384, 384, 1 << 20, 0);
                EpiQ Eq{ws};
#ifndef NO_GQ
                pg8::gemm_phase<EpiQ, pg8::Order, true, true>(lds, gq, Sq, Eq);
#ifdef PROBE_G2
                __syncthreads(); pg8::gemm_phase<EpiQ, pg8::Order, true, true>(lds, gq, Sq, Eq);
#endif
#endif
            }
            {
                unsigned char* ws = args_ptr()->ws; const int G = grd_l(), bx = bid_l();
                pg8::Gemm gk{256, NP, 256}; pg8::Order Sk; Sk.init(R, 1536, G, bx, (bf16_t*)(ws + WS_P) + C_KVC, NP, (bf16_t*)(ws + WS_WUKV) + (size_t)l * 1536 * 256, 256, 1 << 20, 0);
                EpiKV Ek{ws};
#ifndef NO_GK
                pg8::gemm_phase<EpiKV, pg8::Order, true, true>(lds, gk, Sk, Ek);
#ifdef PROBE_G2
                __syncthreads(); pg8::gemm_phase<EpiKV, pg8::Order, true, true>(lds, gk, Sk, Ek);
#endif
#endif
            }
#endif
            GSYNC();
#ifndef NO_ATT
#ifdef PROBE_ATT
            ph_attention<true>(args_ptr(), lnd(l), lds);
            GSYNC();
#endif
            ph_attention<false>(args_ptr(), lnd(l), lds);
#endif
            GSYNC();
#ifdef PROBE_R2
            ph_diff_post<true>(args_ptr(), lnd(l)); GSYNC();
#endif
            ph_diff_post<false>(args_ptr(), lnd(l));
            GSYNC();
#ifndef NO_BR
            {
                unsigned char* ws = args_ptr()->ws; const int G = grd_l(), bx = bid_l();
                pg8::Gemm gb{1024, NP, 1024}; pg8::Order S; S.init(R, 3072, G, bx, (bf16_t*)(ws + WS_P) + C_Z, NP, (bf16_t*)(ws + WS_WB) + (size_t)l * 3 * 1024 * 1024, 1024, 4, 1024 * 2, l != 0);
#ifdef PROBE_BR
                { EpiBrT<true> Ed{ws}; pg8::gemm_phase<EpiBrT<true>, pg8::Order, true, true>(lds, gb, S, Ed); __syncthreads(); }
#endif
                EpiBrT<false> E{ws};
                pg8::gemm_phase<EpiBrT<false>, pg8::Order, true, true>(lds, gb, S, E);
            }
#endif
            GSYNC();
#ifndef NO_OUT
            {
                ArgsP ap = args_ptr(); unsigned char* ws = ap->ws; const int G = grd_l(), bx = bid_l();
                pg8::Gemm go{3072, NP, 3072}; pg8::Order S; S.init(R, 1024, G, bx, (bf16_t*)(ws + WS_P) + C_GM, NP, (bf16_t*)(ws + WS_WO3) + (size_t)l * 1024 * 3072, 3072, 1 << 20, 0, l != 0);
#ifdef PROBE_OUT
                { EpiOutT<true> Ed{l, g, (l == 0) ? ap->in[I_X] : (const float*)ap->out, ap->out, ap->in[I_CTX], ws}; pg8::gemm_phase<EpiOutT<true>, pg8::Order, true, true>(lds, go, S, Ed); __syncthreads(); }
#endif
                EpiOutT<false> E{l, g, (l == 0) ? ap->in[I_X] : (const float*)ap->out, ap->out, ap->in[I_CTX], ws};
                pg8::gemm_phase<EpiOutT<false>, pg8::Order, true, true>(lds, go, S, E);
            }
#endif
        }
        GSYNC();
    }
#ifdef PROBE_R2
    ph_final_norm<true>(args_ptr()); GSYNC();
#endif
    ph_final_norm<false>(args_ptr());
}

extern "C" void kernel_launch(void* const* d_in, const int* in_sizes, int n_in, void* d_out, int out_size, void* d_ws, size_t ws_size, hipStream_t stream) {
    static int grid = 0;
    if (grid == 0) {
        if (n_in != 21 || ws_size < WS_END) { fprintf(stderr, "kernel_launch: expected 21 inputs and >= %zu bytes of workspace (got %d, %zu)\n", (size_t)WS_END, n_in, ws_size); grid = -1; return; }
        int dev = 0, cus = 0, per_cu = 0;
        (void)hipGetDevice(&dev); (void)hipDeviceGetAttribute(&cus, hipDeviceAttributeMultiprocessorCount, dev);
        if (hipFuncSetAttribute((const void*)hybrid_fwd, hipFuncAttributeMaxDynamicSharedMemorySize, LDS_BYTES) != hipSuccess) fprintf(stderr, "kernel_launch: hipFuncSetAttribute failed\n");
        if (hipOccupancyMaxActiveBlocksPerMultiprocessor(&per_cu, (const void*)hybrid_fwd, 512, LDS_BYTES) != hipSuccess || per_cu < 1) { per_cu = 1; (void)hipGetLastError(); }
        if (cus <= 0) cus = 256;
        grid = cus * per_cu;
    }
    if (grid < 0) return;
    Args a{};
    for (int i = 0; i < 21; ++i) a.in[i] = (const float*)d_in[i];
    a.out = (float*)d_out; a.ws = (unsigned char*)d_ws;
    (void)hipMemsetAsync(d_ws, 0, 16384, stream);
    void* args[] = {&a};
    hipError_t e = hipLaunchCooperativeKernel((const void*)hybrid_fwd, dim3(grid), dim3(512), args, LDS_BYTES, stream);
    if (e != hipSuccess) fprintf(stderr, "kernel_launch: cooperative launch failed: %s (grid %d)\n", hipGetErrorString(e), grid);
}
```

```cpp
#include <hip/hip_runtime.h>
#include <hip/hip_cooperative_groups.h>
#include <cstdio>
#include <cstdint>
namespace cg = cooperative_groups;

#define DI __device__ __forceinline__
#define LAS __attribute__((address_space(3)))
__device__ __forceinline__ int tid_l() { int t = threadIdx.x; asm volatile("" : "+v"(t)); return t; }
__device__ __forceinline__ int bid_l() { int b = blockIdx.x; asm volatile("" : "+s"(b)); return b; }
__device__ __forceinline__ int lnd(int x) { asm volatile("" : "+s"(x)); return x; }
__device__ __forceinline__ int grd_l() { int g = gridDim.x; asm volatile("" : "+s"(g)); return g; }
typedef unsigned short bf16_t;
typedef short bf16x8 __attribute__((ext_vector_type(8)));
typedef short s16x4 __attribute__((ext_vector_type(4)));
typedef float f32x4 __attribute__((ext_vector_type(4)));
typedef float f32x16 __attribute__((ext_vector_type(16)));
typedef unsigned u32x4 __attribute__((ext_vector_type(4)));
typedef unsigned u32x2 __attribute__((ext_vector_type(2)));

constexpr int DM = 1024, NBATCH = 8, SEQ = 8192, CTX = 256, RB = CTX + SEQ;
constexpr int GB = 2, NGRP = NBATCH / GB, R = GB * RB;
constexpr int NP = 11520;
constexpr int C_QC = 0, C_KVC = 384, C_KR = 640, C_DQ = 768, C_DK = 1792, C_DV = 2816, C_SQ = 3840, C_SK = 4864, C_SV = 5120, C_Z = 5376, C_GM = 8448;
constexpr int D_IN = 11424;
constexpr float EPS = 1e-6f, LOG2E = 1.4426950408889634f;
constexpr float QS64 = 0.125f * LOG2E, QS96 = 0.10206207261596575f * LOG2E;
constexpr float NEGBIG = -1e30f, THR = 8.0f;

constexpr size_t al256(size_t x) { return (x + 255) & ~(size_t)255; }
constexpr size_t WS_WIN = 1u << 20;
constexpr size_t WS_WUQ = al256(WS_WIN + (size_t)2 * NP * 1024 * 2);
constexpr size_t WS_WUKV = al256(WS_WUQ + (size_t)2 * 768 * 384 * 2);
constexpr size_t WS_WB = al256(WS_WUKV + (size_t)2 * 1536 * 256 * 2);
constexpr size_t WS_WO3 = al256(WS_WB + (size_t)2 * 3 * 1024 * 1024 * 2);
constexpr size_t WS_COSH = al256(WS_WO3 + (size_t)2 * 1024 * 3072 * 2);
constexpr size_t WS_SINH = al256(WS_COSH + (size_t)SEQ * 32 * 4);
constexpr size_t WS_COSM = al256(WS_SINH + (size_t)SEQ * 32 * 4);
constexpr size_t WS_SINM = al256(WS_COSM + (size_t)SEQ * 16 * 4);
constexpr size_t WS_MODP = al256(WS_SINM + (size_t)SEQ * 16 * 4);
constexpr size_t WS_MOD = al256(WS_MODP + (size_t)16 * 2 * 9 * 3072 * 4);
constexpr size_t WS_CTX = al256(WS_MOD + (size_t)2 * 9 * 3072 * 4);
constexpr size_t WS_H = al256(WS_CTX + (size_t)NBATCH * CTX * DM * 4);
constexpr size_t WS_P = al256(WS_H + (size_t)R * DM * 2);
constexpr size_t WS_AQ = al256(WS_P + (size_t)R * NP * 2);
constexpr size_t WS_AKV = al256(WS_AQ + (size_t)R * 384 * 2);
constexpr size_t WS_QM = al256(WS_AKV + (size_t)R * 256 * 2);
constexpr size_t WS_KM = al256(WS_QM + (size_t)R * 768 * 2);
constexpr size_t WS_VM = al256(WS_KM + (size_t)R * 768 * 2);
constexpr size_t WS_OD = al256(WS_VM + (size_t)R * 1024 * 2);
constexpr size_t WS_END = al256(WS_OD + (size_t)R * 2048 * 4);
constexpr size_t WS_PART = WS_AQ;
static_assert(WS_END <= ((size_t)1 << 30), "workspace map exceeds 1 GiB");

constexpr int LDS_BYTES = 155648, XB_LDS_OFF = 155136;

DI unsigned pk2(float lo, float hi) { typedef float f2_t __attribute__((ext_vector_type(2))); typedef __bf16 b2_t __attribute__((ext_vector_type(2)));
    f2_t v = {lo, hi}; b2_t b = __builtin_convertvector(v, b2_t); return __builtin_bit_cast(unsigned, b); }
DI u32x4 pack8(f32x4 a, f32x4 b) { u32x4 w; w.x = pk2(a[0], a[1]); w.y = pk2(a[2], a[3]); w.z = pk2(b[0], b[1]); w.w = pk2(b[2], b[3]); return w; }
DI float bflo(unsigned w) { return __uint_as_float(w << 16); }
DI float bfhi(unsigned w) { return __uint_as_float(w & 0xffff0000u); }
DI float wave_sum(float v) {
#pragma unroll
    for (int o = 1; o < 64; o <<= 1) v += __shfl_xor(v, o);
    return v; }
DI float opq(float a) { asm("" : "+v"(a)); return a; }
DI float silu_f(float z) { return z * __builtin_amdgcn_rcpf(1.0f + __expf(-z)); }
DI float sigm_f(float z) { return __builtin_amdgcn_rcpf(1.0f + __expf(-z)); }
DI void rope8(f32x4& v0, f32x4& v1, const f32x4 cs, const f32x4 sn) {
    float a, b;
    a = v0[0]; b = v0[1]; v0[0] = a * cs[0] - b * sn[0]; v0[1] = b * cs[0] + a * sn[0];
    a = v0[2]; b = v0[3]; v0[2] = a * cs[1] - b * sn[1]; v0[3] = b * cs[1] + a * sn[1];
    a = v1[0]; b = v1[1]; v1[0] = a * cs[2] - b * sn[2]; v1[1] = b * cs[2] + a * sn[2];
    a = v1[2]; b = v1[3]; v1[2] = a * cs[3] - b * sn[3]; v1[3] = b * cs[3] + a * sn[3];
}
namespace pg8 {
#define PG8_LAS __attribute__((address_space(3)))
typedef unsigned short bf16_t;
typedef short bf16x8 __attribute__((ext_vector_type(8)));
typedef float f32x4 __attribute__((ext_vector_type(4)));
typedef unsigned u32x4 __attribute__((ext_vector_type(4)));
constexpr int BM = 256, BK = 64, HALF = 128, HTB = HALF * BK * 2  , STAGE_BYTES = 8 * HTB, NXCD = 8, WGM = 8;

__host__ __device__ __forceinline__ int lds_byte(int r, int c) { const int st = (r >> 4) * 2 + (c >> 5), rr = r & 15, cc = c & 31, ob = rr * 64 + cc * 2; return st * 1024 + (ob ^ (((ob >> 9) & 1) << 5)); }
__host__ __device__ __forceinline__ void stage_rc(int b, int& R, int& C) { const int st = b / 1024, sb = b % 1024, swz = sb ^ (((sb >> 9) & 1) << 5); R = (st >> 1) * 16 + swz / 64; C = (st & 1) * 32 + (swz % 64) / 2; }
__host__ __device__ __forceinline__ int perm32(int rho) { const int n = rho >> 4, i = rho & 15; return 8 * (i >> 2) + 4 * n + (i & 3); }

struct Unit { int pm, pn; };
struct Gemm { int K, lda, ldb; };
struct Order {
    int nM, nN, nwg, G, c; const char* A; const char* B; unsigned tA, tB; int pnblk; unsigned ablk; int skipctx;
    __device__ __forceinline__ void init(int M, int N, int G_, int c_, const void* A_, int lda, const void* B_, int ldb, int pnblk_, unsigned ablk_, int skipctx_ = 0) {
        skipctx = skipctx_; nM = M / BM; if (skipctx) nM -= nM / 33;
        nN = N / BM; nwg = nM * nN; G = G_; c = c_; A = (const char*)A_; B = (const char*)B_; tA = (unsigned)(BM * lda * 2); tB = (unsigned)(BM * ldb * 2); pnblk = pnblk_; ablk = ablk_; }
    __device__ __forceinline__ bool next(int i, Unit& u) const {
        const long L = (long)i * G + c; if (L >= nwg) return false;
        int wgid = (int)L; { const int q = nwg / NXCD, r = nwg % NXCD, xcd = wgid % NXCD, off = wgid / NXCD; wgid = (xcd < r ? xcd * (q + 1) : r * (q + 1) + (xcd - r) * q) + off; }
        const int nig = WGM * nN, gid = wgid / nig, fm = gid * WGM, gsz = (nM - fm) < WGM ? (nM - fm) : WGM;
        u.pm = fm + ((wgid % nig) % gsz); u.pn = (wgid % nig) / gsz; if (skipctx) u.pm += u.pm / 32 + 1; return true;
    }
    __device__ __forceinline__ const char* a_base(const Unit& u) const { return A + (size_t)u.pm * tA + (size_t)(u.pn / pnblk) * ablk; }
    __device__ __forceinline__ const char* b_base(const Unit& u) const { return B + (size_t)u.pn * tB; }
};

template <class Epi, class Sched, bool ALIGN_EPI = false, bool SP2 = false>
__device__ __forceinline__ void gemm_phase(PG8_LAS unsigned char* lds, const Gemm g, const Sched& S, const Epi& E) {
    const int tid = tid_l(), wid = __builtin_amdgcn_readfirstlane(tid >> 6), lane = tid & 63, wr = wid >> 2, wc = wid & 3, fr = lane & 15, fq = lane >> 4;
    const int K = g.K, nt = K / BK;
    unsigned voffA[2], voffB[2];
#pragma unroll
    for (int i = 0; i < 2; ++i) { int R, C; stage_rc(tid * 16 + i * 8192, R, C); const int Rb = Epi::PERM ? ((R & ~31) + perm32(R & 31)) : R;
        voffA[i] = (unsigned)(R * g.lda + C) * 2u; voffB[i] = (unsigned)(Rb * g.ldb + C) * 2u; }
    const size_t kstep = (size_t)(BK * 2);
    const size_t hstepA = (size_t)HALF * g.lda * 2, hstepB = (size_t)HALF * g.ldb * 2;
    const unsigned ldsw = (unsigned)wid * 1024u;
    const int aoff = lds_byte(wr * 64 + fr, fq * 8), boff = lds_byte(wc * 32 + fr, fq * 8);
#define PG8_SA(b, h) (((b) * 2 + (h)) * HTB)
#define PG8_SB(b, h) ((4 + (b) * 2 + (h)) * HTB)
#define PG8_STAGE(bufoff, gbase, voff) do { _Pragma("unroll") for (int _i = 0; _i < 2; ++_i) \
        __builtin_amdgcn_global_load_lds((const unsigned*)((const char*)(gbase) + (voff)[_i]), (PG8_LAS unsigned*)(lds + (bufoff) + ldsw + _i * 8192), 16, 0, 0); } while (0)
#define PG8_LDA(dst, b, h) do { _Pragma("unroll") for (int m = 0; m < 4; ++m) _Pragma("unroll") for (int k = 0; k < 2; ++k) dst[m][k] = *(const PG8_LAS bf16x8*)(lds + PG8_SA(b, h) + aoff + m * 2048 + k * 1024); } while (0)
#define PG8_LDB(dst, b, h) do { _Pragma("unroll") for (int n = 0; n < 2; ++n) _Pragma("unroll") for (int k = 0; k < 2; ++k) dst[n][k] = *(const PG8_LAS bf16x8*)(lds + PG8_SB(b, h) + boff + n * 2048 + k * 1024); } while (0)
#define PG8_MMA(ai, bj, At, Bt) do { __builtin_amdgcn_s_setprio(1); _Pragma("unroll") for (int m = 0; m < 4; ++m) _Pragma("unroll") for (int n = 0; n < 2; ++n) _Pragma("unroll") for (int k = 0; k < 2; ++k) \
        acc[ai][bj][m][n] = __builtin_amdgcn_mfma_f32_16x16x32_bf16(Bt[n][k], At[m][k], acc[ai][bj][m][n], 0, 0, 0); __builtin_amdgcn_s_setprio(0); } while (0)
#define PG8_WAIT_V(n) asm volatile("s_waitcnt vmcnt(" #n ")" ::: "memory")
#define PG8_WAIT_L(n) asm volatile("s_waitcnt lgkmcnt(" #n ")" ::: "memory")
#define PG8_BAR __builtin_amdgcn_s_barrier()
#define PG8_SCHED __builtin_amdgcn_sched_barrier(0)
    Unit cur, nxt; int ui = 0;
    if (!S.next(0, cur)) return;
    f32x4 acc[2][2][4][2];
#pragma unroll
    for (int a = 0; a < 2; ++a)
#pragma unroll
        for (int b = 0; b < 2; ++b)
#pragma unroll
            for (int m = 0; m < 4; ++m)
#pragma unroll
                for (int n = 0; n < 2; ++n) acc[a][b][m][n] = (f32x4){0.f, 0.f, 0.f, 0.f};
    bf16x8 At[4][2], B0[2][2], B1[2][2];
    const char* cA = S.a_base(cur); const char* cB = S.b_base(cur);

    if constexpr (SP2) {
        PG8_STAGE(PG8_SB(0, 0), cB, voffB); PG8_STAGE(PG8_SB(0, 1), cB + hstepB, voffB); PG8_STAGE(PG8_SA(0, 0), cA, voffA); PG8_STAGE(PG8_SA(0, 1), cA + hstepA, voffA);
        if (wr == 1) PG8_BAR;
        PG8_WAIT_V(2); PG8_BAR;
        PG8_STAGE(PG8_SB(1, 0), cB + kstep, voffB); PG8_STAGE(PG8_SA(1, 0), cA + kstep, voffA); PG8_STAGE(PG8_SB(1, 1), cB + hstepB + kstep, voffB);
        PG8_WAIT_V(6); PG8_BAR;
    } else {
        PG8_STAGE(PG8_SB(0, 0), cB, voffB); PG8_STAGE(PG8_SA(0, 0), cA, voffA); PG8_STAGE(PG8_SB(0, 1), cB + hstepB, voffB); PG8_STAGE(PG8_SA(0, 1), cA + hstepA, voffA);
        if (wr == 1) PG8_BAR;
        PG8_WAIT_V(4); PG8_BAR;
        PG8_STAGE(PG8_SB(1, 0), cB + kstep, voffB); PG8_STAGE(PG8_SA(1, 0), cA + kstep, voffA); PG8_STAGE(PG8_SB(1, 1), cB + hstepB + kstep, voffB);
        PG8_WAIT_V(6); PG8_BAR;
    }
    for (;;) {
        const bool has_next = S.next(ui + 1, nxt);
        const char* nA = has_next ? S.a_base(nxt) : cA; const char* nB = has_next ? S.b_base(nxt) : cB;
#pragma nounroll
        for (int t = 0; t < nt; t += 2) {
            const bool last = (t == nt - 2);
            const char* a1 = cA + (size_t)(t + 1) * kstep;
            const char* a2 = last ? nA : cA + (size_t)(t + 2) * kstep; const char* b2 = last ? nB : cB + (size_t)(t + 2) * kstep;
            const char* a3 = a2 + kstep; const char* b3 = b2 + kstep;

            if constexpr (SP2) {
            PG8_LDB(B0, 0, 0); PG8_LDB(B1, 0, 1); PG8_SCHED; PG8_LDA(At, 0, 0); PG8_STAGE(PG8_SA(1, 1), a1 + hstepA, voffA);
            PG8_WAIT_V(8); PG8_WAIT_L(0); PG8_BAR; PG8_MMA(0, 0, At, B0); PG8_MMA(0, 1, At, B1); PG8_BAR; PG8_SCHED;
            PG8_LDA(At, 0, 1); PG8_STAGE(PG8_SB(0, 0), b2, voffB); PG8_STAGE(PG8_SB(0, 1), b2 + hstepB, voffB); PG8_STAGE(PG8_SA(0, 0), a2, voffA);
            PG8_WAIT_V(8); PG8_WAIT_L(0); PG8_BAR; PG8_MMA(1, 0, At, B0); PG8_MMA(1, 1, At, B1); PG8_BAR; PG8_SCHED;
            PG8_LDB(B0, 1, 0); PG8_LDB(B1, 1, 1); PG8_SCHED; PG8_LDA(At, 1, 0); PG8_STAGE(PG8_SA(0, 1), a2 + hstepA, voffA);
            PG8_WAIT_V(8); PG8_WAIT_L(0); PG8_BAR; PG8_MMA(0, 0, At, B0); PG8_MMA(0, 1, At, B1); PG8_BAR; PG8_SCHED;
            PG8_LDA(At, 1, 1); PG8_STAGE(PG8_SB(1, 0), b3, voffB); PG8_STAGE(PG8_SB(1, 1), b3 + hstepB, voffB); PG8_STAGE(PG8_SA(1, 0), a3, voffA);
            PG8_WAIT_V(8); PG8_WAIT_L(0); PG8_BAR; PG8_MMA(1, 0, At, B0); PG8_MMA(1, 1, At, B1); PG8_BAR; PG8_SCHED;
            } else {
            PG8_LDB(B0, 0, 0); PG8_SCHED; PG8_LDA(At, 0, 0); PG8_STAGE(PG8_SA(1, 1), a1 + hstepA, voffA);
            PG8_WAIT_L(8); PG8_BAR; PG8_WAIT_L(0); PG8_MMA(0, 0, At, B0); PG8_BAR; PG8_SCHED;
            PG8_LDB(B1, 0, 1); PG8_STAGE(PG8_SB(0, 0), b2, voffB);
            PG8_BAR; PG8_WAIT_L(0); PG8_MMA(0, 1, At, B1); PG8_BAR;
            PG8_LDA(At, 0, 1); PG8_STAGE(PG8_SA(0, 0), a2, voffA);
            PG8_BAR; PG8_WAIT_L(0); PG8_MMA(1, 0, At, B0); PG8_BAR; PG8_SCHED;
            PG8_STAGE(PG8_SB(0, 1), b2 + hstepB, voffB);
            PG8_WAIT_V(6); PG8_BAR; PG8_MMA(1, 1, At, B1); PG8_BAR;
            PG8_LDB(B0, 1, 0); PG8_SCHED; PG8_LDA(At, 1, 0); PG8_STAGE(PG8_SA(0, 1), a2 + hstepA, voffA);
            PG8_WAIT_L(8); PG8_BAR; PG8_WAIT_L(0); PG8_MMA(0, 0, At, B0); PG8_BAR; PG8_SCHED;
            PG8_LDB(B1, 1, 1); PG8_STAGE(PG8_SB(1, 0), b3, voffB);
            PG8_BAR; PG8_WAIT_L(0); PG8_MMA(0, 1, At, B1); PG8_BAR;
            PG8_LDA(At, 1, 1); PG8_STAGE(PG8_SA(1, 0), a3, voffA);
            PG8_BAR; PG8_WAIT_L(0); PG8_MMA(1, 0, At, B0); PG8_BAR; PG8_SCHED;
            PG8_STAGE(PG8_SB(1, 1), b3 + hstepB, voffB);
            PG8_WAIT_V(6); PG8_BAR; PG8_MMA(1, 1, At, B1); PG8_BAR;
            }
        }
        if constexpr (ALIGN_EPI) { if (wr == 0) PG8_BAR; }
        if constexpr (!Epi::AFTER_DRAIN) { E(acc, cur, wr, wc, fr, fq); }
        if (!has_next) break;
#pragma unroll
        for (int a = 0; a < 2; ++a)
#pragma unroll
            for (int b = 0; b < 2; ++b)
#pragma unroll
                for (int m = 0; m < 4; ++m)
#pragma unroll
                    for (int n = 0; n < 2; ++n) acc[a][b][m][n] = (f32x4){0.f, 0.f, 0.f, 0.f};
        cur = nxt; cA = nA; cB = nB; ++ui;
        if constexpr (ALIGN_EPI) { if (wr == 1) PG8_BAR; }
    }
    PG8_WAIT_V(0);
    if constexpr (!ALIGN_EPI) { if (wr == 0) PG8_BAR; }
    PG8_BAR;
    if constexpr (Epi::AFTER_DRAIN) { E.fused(acc, cur, wr, wc, fr, fq, lds, wid, lane); }
#undef PG8_SA
#undef PG8_SB
#undef PG8_STAGE
#undef PG8_LDA
#undef PG8_LDB
#undef PG8_MMA
#undef PG8_WAIT_V
#undef PG8_WAIT_L
#undef PG8_BAR
#undef PG8_SCHED
}
}
struct EpiIn {
    static constexpr bool PERM = true, AFTER_DRAIN = false;
    unsigned char* ws;
    DI void operator()(const f32x4 (&acc)[2][2][4][2], const pg8::Unit& u, int wr, int wc, int fr, int fq) const {
        bf16_t* P = (bf16_t*)(ws + WS_P); const float* cosH = (const float*)(ws + WS_COSH); const float* sinH = (const float*)(ws + WS_SINH); const float* cosM = (const float*)(ws + WS_COSM); const float* sinM = (const float*)(ws + WS_SINM);
        const int pn = u.pn; const bool ctxt = (u.pm % 33) == 0;
        int mode = 0; float sc = 1.f;
        if ((pn >= 3 && pn <= 10) || (pn >= 15 && pn <= 19)) mode = 1;
        if (pn == 2) mode = 2;
        if ((pn >= 3 && pn <= 6) || (pn >= 15 && pn <= 18)) sc = QS64;
        if (ctxt) mode = 0;
        const int rowt = u.pm * 256 + wr * 64 + fr, colb = pn * 256 + wc * 32 + 8 * fq;
#pragma unroll
        for (int ai = 0; ai < 2; ++ai)
#pragma unroll
            for (int m = 0; m < 4; ++m) {
                const int row = rowt + ai * 128 + m * 16; const int pos = (row % RB) - CTX;
                bf16_t* rowp = P + (size_t)row * NP;
#pragma unroll
                for (int bj = 0; bj < 2; ++bj) {
                    const int col0 = colb + bj * 128;
                    f32x4 v0 = acc[ai][bj][m][0], v1 = acc[ai][bj][m][1];
                    if (pn <= 2) {
                        float s8 = (v0[0] * v0[0] + v0[1] * v0[1]) + (v0[2] * v0[2] + v0[3] * v0[3]) + (v1[0] * v1[0] + v1[1] * v1[1]) + (v1[2] * v1[2] + v1[3] * v1[3]);
                        s8 += __shfl_xor(s8, 16); s8 += __shfl_xor(s8, 32);
                        const int slice = pn * 8 + bj * 4 + wc;
                        if (fq == 0 && slice < 20) ((float*)(ws + WS_PART))[(size_t)row * 20 + slice] = s8;
                    }
                    if (mode == 1) { const int p0 = (col0 & 63) >> 1; const f32x4 cs = *(const f32x4*)(cosH + (size_t)pos * 32 + p0), sn = *(const f32x4*)(sinH + (size_t)pos * 32 + p0); rope8(v0, v1, cs, sn); }
                    else if (mode == 2 && col0 >= C_KR && col0 < C_KR + 32) { const int p0 = (col0 - C_KR) >> 1; const f32x4 cs = *(const f32x4*)(cosM + (size_t)pos * 16 + p0), sn = *(const f32x4*)(sinM + (size_t)pos * 16 + p0); rope8(v0, v1, cs, sn); }
                    v0 = v0 * sc; v1 = v1 * sc;
                    const u32x4 w8 = pack8(v0, v1);
                    *(u32x4*)(rowp + col0) = w8;
                    if (pn == 2 && col0 >= C_KR && col0 < C_KR + 32) {
                        bf16_t* km = (bf16_t*)(ws + WS_KM) + (size_t)row * 768 + 64 + (col0 - C_KR);
#pragma unroll
                        for (int h = 0; h < 8; ++h) *(u32x4*)(km + h * 96) = w8;
                    }
                }
            }
    }
};
struct EpiQ {
    static constexpr bool PERM = true, AFTER_DRAIN = false;
    unsigned char* ws;
    DI void operator()(const f32x4 (&acc)[2][2][4][2], const pg8::Unit& u, int wr, int wc, int fr, int fq) const {
        bf16_t* QM = (bf16_t*)(ws + WS_QM); const float* cosM = (const float*)(ws + WS_COSM); const float* sinM = (const float*)(ws + WS_SINM);
        const bool ctxt = (u.pm % 33) == 0;
        const int rowt = u.pm * 256 + wr * 64 + fr, colb = u.pn * 256 + wc * 32 + 8 * fq;
#pragma unroll
        for (int ai = 0; ai < 2; ++ai)
#pragma unroll
            for (int m = 0; m < 4; ++m) {
                const int row = rowt + ai * 128 + m * 16; const int pos = (row % RB) - CTX;
                const float* pr = (const float*)(ws + WS_PART) + (size_t)row * 20;
                const f32x4 q0 = *(const f32x4*)pr, q1 = *(const f32x4*)(pr + 4), q2 = *(const f32x4*)(pr + 8);
                const float rq = QS96 / sqrtf((((q0[0] + q0[1]) + (q0[2] + q0[3])) + ((q1[0] + q1[1]) + (q1[2] + q1[3])) + ((q2[0] + q2[1]) + (q2[2] + q2[3]))) * (1.0f / 384.0f) + EPS);
#pragma unroll
                for (int bj = 0; bj < 2; ++bj) {
                    const int col0 = colb + bj * 128, within = col0 % 96;
                    f32x4 v0 = acc[ai][bj][m][0], v1 = acc[ai][bj][m][1];
                    if (!ctxt && within >= 64) { const int p0 = (within - 64) >> 1; const f32x4 cs = *(const f32x4*)(cosM + (size_t)pos * 16 + p0), sn = *(const f32x4*)(sinM + (size_t)pos * 16 + p0); rope8(v0, v1, cs, sn); }
                    v0 = v0 * rq; v1 = v1 * rq;
                    *(u32x4*)(QM + (size_t)row * 768 + col0) = pack8(v0, v1);
                }
                asm volatile("" ::: "memory");
            }
    }
};
struct EpiKV {
    static constexpr bool PERM = true, AFTER_DRAIN = false;
    unsigned char* ws;
    DI void operator()(const f32x4 (&acc)[2][2][4][2], const pg8::Unit& u, int wr, int wc, int fr, int fq) const {
        bf16_t* KM = (bf16_t*)(ws + WS_KM); bf16_t* VM = (bf16_t*)(ws + WS_VM);
        const int rowt = u.pm * 256 + wr * 64 + fr, colb = u.pn * 256 + wc * 32 + 8 * fq;
#pragma unroll
        for (int ai = 0; ai < 2; ++ai)
#pragma unroll
            for (int m = 0; m < 4; ++m) {
                const int row = rowt + ai * 128 + m * 16;
                const float* pr = (const float*)(ws + WS_PART) + (size_t)row * 20 + 12;
                const f32x4 k0 = *(const f32x4*)pr, k1 = *(const f32x4*)(pr + 4);
                const float rkv = 1.0f / sqrtf((((k0[0] + k0[1]) + (k0[2] + k0[3])) + ((k1[0] + k1[1]) + (k1[2] + k1[3]))) * (1.0f / 256.0f) + EPS);
#pragma unroll
                for (int bj = 0; bj < 2; ++bj) {
                    const int col0 = colb + bj * 128;
                    bf16_t* dst = (col0 < 512) ? KM + (size_t)row * 768 + (col0 >> 6) * 96 + (col0 & 63) : VM + (size_t)row * 1024 + (col0 - 512);
                    *(u32x4*)dst = pack8(acc[ai][bj][m][0] * rkv, acc[ai][bj][m][1] * rkv);
                }
                asm volatile("" ::: "memory");
            }
    }
};
template <bool DRYE> struct EpiBrT {
    static constexpr bool PERM = true, AFTER_DRAIN = false;
    unsigned char* ws;
    DI void operator()(const f32x4 (&acc)[2][2][4][2], const pg8::Unit& u, int wr, int wc, int fr, int fq) const {
        bf16_t* P = (bf16_t*)(ws + WS_P);
        unsigned chk = 0u;
        const int rowt = u.pm * 256 + wr * 64 + fr, colb = u.pn * 256 + wc * 32 + 8 * fq;
#pragma unroll
        for (int ai = 0; ai < 2; ++ai)
#pragma unroll
            for (int m = 0; m < 4; ++m) {
                const int row = rowt + ai * 128 + m * 16;
#pragma unroll
                for (int bj = 0; bj < 2; ++bj) {
                    bf16_t* p = P + (size_t)row * NP + C_GM + colb + bj * 128;
                    const u32x4 g = *(const u32x4*)p;
                    f32x4 v0 = acc[ai][bj][m][0], v1 = acc[ai][bj][m][1];
                    v0[0] *= sigm_f(bflo(g.x)); v0[1] *= sigm_f(bfhi(g.x)); v0[2] *= sigm_f(bflo(g.y)); v0[3] *= sigm_f(bfhi(g.y));
                    v1[0] *= sigm_f(bflo(g.z)); v1[1] *= sigm_f(bfhi(g.z)); v1[2] *= sigm_f(bflo(g.w)); v1[3] *= sigm_f(bfhi(g.w));
                    { const u32x4 w_ = pack8(v0, v1); if (!DRYE) *(u32x4*)p = w_; else chk ^= w_.x ^ w_.y ^ w_.z ^ w_.w; }
                }
            }
        if (DRYE && chk == 0x12345678u) *(unsigned*)P = chk;
    }
};
template <bool DRYE> struct EpiOutT {
    static constexpr bool PERM = true, AFTER_DRAIN = false;
    int l, g; const float* xsrc; float* xdst; const float* ctxsrc; unsigned char* ws;
    DI void operator()(const f32x4 (&acc)[2][2][4][2], const pg8::Unit& u, int wr, int wc, int fr, int fq) const {
        float* ctxdst = (float*)(ws + WS_CTX); const float* mod = (const float*)(ws + WS_MOD) + (size_t)l * 9 * 3072;
        const int pmb = u.pm % 33, b = g * GB + u.pm / 33; const bool ctxt = pmb == 0;
        if (ctxt && l != 0) return;
        const float* gate = mod + (size_t)(ctxt ? 8 : b) * 3072 + 2048;
        const int colb = u.pn * 256 + wc * 32 + 8 * fq;
#pragma unroll
        for (int ai = 0; ai < 2; ++ai)
#pragma unroll
            for (int m = 0; m < 4; ++m) {
                const int j = pmb * 256 + ai * 128 + wr * 64 + m * 16 + fr;
                const size_t idx = ctxt ? ((size_t)b * CTX + j) * DM : ((size_t)b * SEQ + (j - CTX)) * DM;
                const float* s = (ctxt ? ctxsrc : xsrc) + idx; float* d = (ctxt ? ctxdst : xdst) + idx;
#pragma unroll
                for (int bj = 0; bj < 2; ++bj) {
                    const int col0 = colb + bj * 128;
                    const f32x4 g0 = *(const f32x4*)(gate + col0), g1 = *(const f32x4*)(gate + col0 + 4);
                    const f32x4 x0 = *(const f32x4*)(s + col0), x1 = *(const f32x4*)(s + col0 + 4);
                    if (!DRYE || x0[0] == 12345.678f) { *(f32x4*)(d + col0) = x0 + g0 * acc[ai][bj][m][0];
                    *(f32x4*)(d + col0 + 4) = x1 + g1 * acc[ai][bj][m][1]; }
                }
            }
    }
};

#define MFMA32(a, b, c) __builtin_amdgcn_mfma_f32_32x32x16_bf16((a), (b), (c), 0, 0, 0)
DI s16x4 tr16(const LAS unsigned char* p) { typedef short v4i16_t __attribute__((ext_vector_type(4))); return __builtin_bit_cast(s16x4, __builtin_amdgcn_ds_read_tr16_b64_v4i16((LAS v4i16_t*)p)); }
constexpr int AT_KOFF = 0, AT_KBUFMAX = 13312, AT_VOFF = 3 * AT_KBUFMAX, AT_VBUFMAX = 20480, AT_SOFF = AT_VOFF + 3 * AT_VBUFMAX, AT_QOFF = AT_SOFF + 1024;
static_assert(AT_QOFF + 8 * 6144 <= LDS_BYTES, "attention LDS map");
#ifndef AT_NEGM
#define AT_NEGM 0
#endif
#ifndef AT_LAZY_THR
#define AT_LAZY_THR 1048576.0f
#endif
#ifndef AT_LAZY
#define AT_LAZY 1
#endif
#ifndef AT_NOPF
#define AT_NOPF 1
#endif
#ifndef AT_IGLP
#define AT_IGLP -1
#endif
#ifndef AT_QLMIN
#define AT_QLMIN 64
#endif
#ifndef AT_PVKS
#define AT_PVKS 1
#endif
#ifndef AT_SGB
#define AT_SGB 0
#endif
#ifndef AT_PV8
#define AT_PV8 1
#endif
#ifndef AT_NOSBAR
#define AT_NOSBAR 1
#endif
#if AT_NOSBAR
#define SBAR() do {} while (0)
#else
#define SBAR() __builtin_amdgcn_sched_barrier(0)
#endif
#ifndef PROBE_MODE
#define PROBE_MODE 0
#endif
#ifndef DRY_SEL
#define DRY_SEL 7
#endif
#ifndef AT_QL
#define AT_QL 1
#endif
#ifndef AT_SB
#define AT_SB 0
#endif
template <int DQK, bool QL, bool NG = false>
DI void at_qkt(f32x16& p0, f32x16& p1, const LAS unsigned char* kb, const bf16x8* qf, const LAS unsigned char* qb, const f32x16* c0 = nullptr) {
    constexpr int KSTR = DQK + 8;
    if (!NG) {
#pragma unroll
        for (int r = 0; r < 16; ++r) { p0[r] = 0.f; p1[r] = 0.f; }
    }
#pragma unroll
    for (int ds = 0; ds < DQK / 16; ++ds) {
        const bf16x8 k0 = *(const LAS bf16x8*)(kb + ds * 32), k1 = *(const LAS bf16x8*)(kb + 32 * (KSTR * 2) + ds * 32);
        bf16x8 q; if (QL) q = *(const LAS bf16x8*)(qb + ds * 1024); else q = qf[ds];
        if (NG && ds == 0) { p0 = MFMA32(k0, q, *c0); p1 = MFMA32(k1, q, *c0); } else { p0 = MFMA32(k0, q, p0); p1 = MFMA32(k1, q, p1); }
        if (AT_SB && DQK > 64 && (ds & 1)) __builtin_amdgcn_sched_barrier(0x7f); }
}
DI void at_mask(f32x16& p0, f32x16& p1, int dk) {
#pragma unroll
    for (int r = 0; r < 16; ++r) { const int d = dk + (r & 3) + 8 * (r >> 2);
        if (d > 128 || d < -128) p0[r] = NEGBIG;
        if (d + 32 > 128 || d + 32 < -128) p1[r] = NEGBIG; }
}
DI void at_psm(f32x16& p0, f32x16& p1, float& mrun, float& alpha) {
    float ma = fmaxf(fmaxf(p0[0], p0[1]), p0[2]), mb = fmaxf(fmaxf(p1[0], p1[1]), p1[2]);
    ma = fmaxf(fmaxf(ma, p0[3]), p1[3]);
#pragma unroll
    for (int r = 4; r < 16; r += 2) { ma = fmaxf(fmaxf(ma, p0[r]), p0[r + 1]); mb = fmaxf(fmaxf(mb, p1[r]), p1[r + 1]); }
    float mx = fmaxf(ma, mb);
    { auto rr = __builtin_amdgcn_permlane32_swap(__float_as_uint(mx), __float_as_uint(mx), false, false); mx = fmaxf(__uint_as_float(rr[0]), __uint_as_float(rr[1])); }
    const bool keep = __all(mx - mrun <= THR);
    const float mn = keep ? mrun : fmaxf(mrun, mx); alpha = __builtin_amdgcn_exp2f(mrun - mn); mrun = mn;
#pragma unroll
    for (int r = 0; r < 16; ++r) { p0[r] -= mrun; p1[r] -= mrun; }
#pragma unroll
    for (int r = 0; r < 16; ++r) p0[r] = __builtin_amdgcn_exp2f(p0[r]);
}
template <int DV> DI void at_scale_o(f32x16* o, LAS float* scw, float val, int r32, int hi);
template <bool NG>
DI void at_psm_lazy(f32x16& p0, f32x16& p1, float mrun) {
    if (!NG) {
#pragma unroll
        for (int r = 0; r < 16; ++r) { p0[r] -= mrun; p1[r] -= mrun; }
    }
#pragma unroll
    for (int r = 0; r < 16; ++r) p0[r] = __builtin_amdgcn_exp2f(p0[r]);
}
template <int DV>
DI void at_fsm_lazy(f32x16& p0, f32x16& p1, float& mrun, float& alpha, float& lrun, bf16x8* pa, f32x16* o, LAS float* scw, int r32, int hi) {
#pragma unroll
    for (int r = 0; r < 16; ++r) p1[r] = __builtin_amdgcn_exp2f(p1[r]);
    float sa = p0[0] + p0[1], sb = p0[2] + p0[3], sc_ = p1[0] + p1[1], sd = p1[2] + p1[3];
#pragma unroll
    for (int r = 4; r < 16; r += 2) { sa = opq(sa) + p0[r]; sb = opq(sb) + p0[r + 1]; sc_ = opq(sc_) + p1[r]; sd = opq(sd) + p1[r + 1]; }
    float ps = (opq(sa) + sb) + (opq(sc_) + sd);
    alpha = 1.f;
    if (__builtin_expect(__any(!(ps <= AT_LAZY_THR)), 0)) {
        float ma = fmaxf(fmaxf(p0[0], p0[1]), p0[2]), mb = fmaxf(fmaxf(p1[0], p1[1]), p1[2]);
        ma = fmaxf(fmaxf(ma, p0[3]), p1[3]);
#pragma unroll
        for (int r = 4; r < 16; r += 2) { ma = fmaxf(fmaxf(ma, p0[r]), p0[r + 1]); mb = fmaxf(fmaxf(mb, p1[r]), p1[r + 1]); }
        float mx = fmaxf(ma, mb);
        { auto rr = __builtin_amdgcn_permlane32_swap(__float_as_uint(mx), __float_as_uint(mx), false, false); mx = fmaxf(__uint_as_float(rr[0]), __uint_as_float(rr[1])); }
        const float d = fmaxf(__builtin_amdgcn_logf(mx), 0.f);
        alpha = __builtin_amdgcn_exp2f(-d); mrun += d; ps *= alpha;
#pragma unroll
        for (int r = 0; r < 16; ++r) { p0[r] *= alpha; p1[r] *= alpha; }
        at_scale_o<DV>(o, scw, alpha, r32, hi);
    }
    lrun = lrun * alpha + ps;
    u32x4 w;
    w.x = pk2(p0[0], p0[1]); w.y = pk2(p0[2], p0[3]); w.z = pk2(p0[4], p0[5]); w.w = pk2(p0[6], p0[7]); pa[0] = __builtin_bit_cast(bf16x8, w);
    w.x = pk2(p0[8], p0[9]); w.y = pk2(p0[10], p0[11]); w.z = pk2(p0[12], p0[13]); w.w = pk2(p0[14], p0[15]); pa[1] = __builtin_bit_cast(bf16x8, w);
    w.x = pk2(p1[0], p1[1]); w.y = pk2(p1[2], p1[3]); w.z = pk2(p1[4], p1[5]); w.w = pk2(p1[6], p1[7]); pa[2] = __builtin_bit_cast(bf16x8, w);
    w.x = pk2(p1[8], p1[9]); w.y = pk2(p1[10], p1[11]); w.z = pk2(p1[12], p1[13]); w.w = pk2(p1[14], p1[15]); pa[3] = __builtin_bit_cast(bf16x8, w);
}
DI void at_fsm(f32x16& p0, f32x16& p1, float alpha, float& lrun, bf16x8* pa) {
#pragma unroll
    for (int r = 0; r < 16; ++r) p1[r] = __builtin_amdgcn_exp2f(p1[r]);
    float ps = 0.f;
#pragma unroll
    for (int r = 0; r < 16; ++r) ps += p0[r] + p1[r];
    lrun = lrun * alpha + ps;
    u32x4 w;
    w.x = pk2(p0[0], p0[1]); w.y = pk2(p0[2], p0[3]); w.z = pk2(p0[4], p0[5]); w.w = pk2(p0[6], p0[7]); pa[0] = __builtin_bit_cast(bf16x8, w);
    w.x = pk2(p0[8], p0[9]); w.y = pk2(p0[10], p0[11]); w.z = pk2(p0[12], p0[13]); w.w = pk2(p0[14], p0[15]); pa[1] = __builtin_bit_cast(bf16x8, w);
    w.x = pk2(p1[0], p1[1]); w.y = pk2(p1[2], p1[3]); w.z = pk2(p1[4], p1[5]); w.w = pk2(p1[6], p1[7]); pa[2] = __builtin_bit_cast(bf16x8, w);
    w.x = pk2(p1[8], p1[9]); w.y = pk2(p1[10], p1[11]); w.z = pk2(p1[12], p1[13]); w.w = pk2(p1[14], p1[15]); pa[3] = __builtin_bit_cast(bf16x8, w);
}
DI void at_fsm_fake(f32x16& p0, f32x16& p1, bf16x8* pa) {
    u32x4 w;
    w.x = pk2(p0[0], p0[1]); w.y = pk2(p0[2], p0[3]); w.z = pk2(p0[4], p0[5]); w.w = pk2(p0[6], p0[7]); pa[0] = __builtin_bit_cast(bf16x8, w);
    w.x = pk2(p0[8], p0[9]); w.y = pk2(p0[10], p0[11]); w.z = pk2(p0[12], p0[13]); w.w = pk2(p0[14], p0[15]); pa[1] = __builtin_bit_cast(bf16x8, w);
    w.x = pk2(p1[0], p1[1]); w.y = pk2(p1[2], p1[3]); w.z = pk2(p1[4], p1[5]); w.w = pk2(p1[6], p1[7]); pa[2] = __builtin_bit_cast(bf16x8, w);
    w.x = pk2(p1[8], p1[9]); w.y = pk2(p1[10], p1[11]); w.z = pk2(p1[12], p1[13]); w.w = pk2(p1[14], p1[15]); pa[3] = __builtin_bit_cast(bf16x8, w);
}
template <int DV>
DI void at_pv(f32x16* o, const LAS unsigned char* vb, const bf16x8* pa) {
    constexpr int VSTR = DV + 32;
#if AT_PVKS
#pragma unroll
    for (int ks = 0; ks < 4; ++ks) {
        s16x4 vlo[DV / 32], vhi[DV / 32];
#pragma unroll
        for (int db = 0; db < DV / 32; ++db) { vlo[db] = tr16(vb + (16 * ks) * (VSTR * 2) + db * 64); vhi[db] = tr16(vb + (16 * ks + 8) * (VSTR * 2) + db * 64); }
#pragma unroll
        for (int db = 0; db < DV / 32; ++db) { const bf16x8 vf = __builtin_shufflevector(vlo[db], vhi[db], 0, 1, 2, 3, 4, 5, 6, 7); o[db] = MFMA32(pa[ks], vf, o[db]); }
    }
#else
#pragma unroll
    for (int db = 0; db < DV / 32; ++db) {
        s16x4 vlo[4], vhi[4];
#pragma unroll
        for (int ks = 0; ks < 4; ++ks) { vlo[ks] = tr16(vb + (16 * ks) * (VSTR * 2) + db * 64); vhi[ks] = tr16(vb + (16 * ks + 8) * (VSTR * 2) + db * 64); }
#pragma unroll
        for (int ks = 0; ks < 4; ++ks) { const bf16x8 vf = __builtin_shufflevector(vlo[ks], vhi[ks], 0, 1, 2, 3, 4, 5, 6, 7); o[db] = MFMA32(pa[ks], vf, o[db]); }
    }
#endif
}
template <int DV>
DI void at_scale_o(f32x16* o, LAS float* scw, float val, int r32, int hi) {
    if (hi == 0) scw[r32] = val;
    __builtin_amdgcn_wave_barrier(); asm volatile("" ::: "memory");
#pragma unroll
    for (int g4 = 0; g4 < 4; ++g4) { const f32x4 a4 = *(const LAS f32x4*)(scw + 8 * g4 + 4 * hi);
#pragma unroll
        for (int db = 0; db < DV / 32; ++db) { o[db][4 * g4 + 0] *= a4[0]; o[db][4 * g4 + 1] *= a4[1]; o[db][4 * g4 + 2] *= a4[2]; o[db][4 * g4 + 3] *= a4[3]; } }
    __builtin_amdgcn_wave_barrier(); asm volatile("" ::: "memory");
}
template <int DQK, int DV, int OUTM, bool MASKED>
DI void attn_unit(LAS unsigned char* lds, const bf16_t* Qp, int ldq, const bf16_t* Kp, int ldk, const bf16_t* Vp, int ldv,
                  int nA, int rowB0, int nB, int posB0, int qpos0, float m0, float l0,
                  bf16_t* Og, int ldo, float* Of, int ldof) {
    constexpr int KSTR = DQK + 8, VSTR = DV + 32, KBUF = 64 * KSTR * 2, VBUF = 64 * VSTR * 2;
    constexpr int KCH = DQK / 8, VCH = DV / 8, NKC = 64 * KCH, NVC = 64 * VCH, KRN = (NKC + 511) / 512, VRN = (NVC + 511) / 512;
    static_assert(KBUF <= AT_KBUFMAX && VBUF <= AT_VBUFMAX, "attention LDS map");
    const int tid = tid_l(), lane = tid & 63, wid = __builtin_amdgcn_readfirstlane(tid >> 6), r32 = lane & 31, hi = lane >> 5;
#ifndef AT_QL
#define AT_QL 1
#endif
#ifndef AT_SB
#define AT_SB 0
#endif
    constexpr bool NG = (AT_NEGM == 1 && DQK == 64) || (AT_NEGM == 2 && DQK == 64 && DV == 64);
    constexpr bool QL = AT_QL && (DQK > AT_QLMIN || (NG && DV == 128));
    bf16x8 qf[QL ? 1 : DQK / 16];
    const LAS unsigned char* qb = lds + AT_QOFF + wid * 6144 + lane * 16;
    { const bf16_t* qrow = Qp + (size_t)(32 * wid + r32) * ldq + 8 * hi;
#pragma unroll
      for (int ds = 0; ds < DQK / 16; ++ds) { const bf16x8 v = *(const bf16x8*)(qrow + 16 * ds); if (QL) *(LAS bf16x8*)(lds + AT_QOFF + wid * 6144 + lane * 16 + ds * 1024) = v; else qf[QL ? 0 : ds] = v; }
      if (QL) { __builtin_amdgcn_wave_barrier(); asm volatile("s_waitcnt lgkmcnt(0)" ::: "memory"); } }
    f32x16 o[DV / 32];
#pragma unroll
    for (int db = 0; db < DV / 32; ++db)
#pragma unroll
        for (int r = 0; r < 16; ++r) o[db][r] = 0.f;
    float mrun = m0, lrun = (hi == 0) ? l0 : 0.f;
    LAS float* scw = (LAS float*)(lds + AT_SOFF) + wid * 32;
    const int NT = nA + nB;
    const LAS unsigned char* kb0 = lds + AT_KOFF + r32 * (KSTR * 2) + hi * 16;
    const LAS unsigned char* vb0 = lds + AT_VOFF + (4 * hi + ((lane & 15) >> 2)) * (VSTR * 2) + (16 * ((lane >> 4) & 1) + 4 * (lane & 3)) * 2;
    const int dk0 = posB0 + 4 * hi - (qpos0 + 32 * wid + r32) - 64 * nA;
    u32x4 kreg[KRN], vreg[VRN];
    int kgo[KRN], klo[KRN], vgo[VRN], vlo_[VRN];
#pragma unroll
    for (int i_ = 0; i_ < KRN; ++i_) { int c_ = tid + 512 * i_; if (c_ >= NKC) c_ -= 512; const int r_ = c_ / KCH, cc_ = c_ % KCH; kgo[i_] = r_ * ldk + cc_ * 8; klo[i_] = AT_KOFF + r_ * (KSTR * 2) + cc_ * 16; }
#pragma unroll
    for (int i_ = 0; i_ < VRN; ++i_) { int c_ = tid + 512 * i_; if (c_ >= NVC) c_ -= 512; const int r_ = c_ / VCH, cc_ = c_ % VCH; vgo[i_] = r_ * ldv + cc_ * 8; vlo_[i_] = AT_VOFF + r_ * (VSTR * 2) + cc_ * 16; }
    const __amdgpu_buffer_rsrc_t rK = __builtin_amdgcn_make_buffer_rsrc((void*)Kp, 0, 0x7fffffff, 0x00020000), rV = __builtin_amdgcn_make_buffer_rsrc((void*)Vp, 0, 0x7fffffff, 0x00020000);
#define AT_GLOAD(t) do { const int row0_ = (t) < nA ? 64 * (t) : rowB0 + 64 * ((t) - nA); const int sk_ = row0_ * ldk * 2, sv_ = row0_ * ldv * 2; \
        _Pragma("unroll") for (int i_ = 0; i_ < KRN; ++i_) kreg[i_] = __builtin_amdgcn_raw_buffer_load_b128(rK, kgo[i_] * 2, sk_, 0); \
        _Pragma("unroll") for (int i_ = 0; i_ < VRN; ++i_) vreg[i_] = __builtin_amdgcn_raw_buffer_load_b128(rV, vgo[i_] * 2, sv_, 0); } while (0)
#define AT_SWRITE(buf) do { \
        _Pragma("unroll") for (int i_ = 0; i_ < KRN; ++i_) *(LAS u32x4*)(lds + (buf) * KBUF + klo[i_]) = kreg[i_]; \
        _Pragma("unroll") for (int i_ = 0; i_ < VRN; ++i_) *(LAS u32x4*)(lds + (buf) * VBUF + vlo_[i_]) = vreg[i_]; } while (0)
    unsigned pfv = 0u, pfacc = 0u;
    const int pft = tid & 255;
    const bf16_t* pfb = (pft < 128) ? Kp + (pft >> 1) * ldk + (pft & 1) * (DQK - 2) : Vp + ((pft - 128) >> 1) * ldv + (pft & 1) * (DV - 2);
    const int pfs = (pft < 128) ? ldk : ldv;
    constexpr int PFD = 4;
#if AT_NOPF
#define AT_PF(t) do {} while (0)
#else
#define AT_PF(t) do { pfacc ^= pfv; const int tt_ = (t) < NT ? (t) : NT - 1; const int row0_ = tt_ < nA ? 64 * tt_ : rowB0 + 64 * (tt_ - nA); \
        pfv = *(const unsigned*)(pfb + (size_t)row0_ * pfs); } while (0)
#endif
#define AT_MASK(P0, P1, t) do { if (MASKED && (t) >= nA) at_mask(P0, P1, dk0 + 64 * (t)); } while (0)
#define AT_RESC(al) do { if (__any((al) < 1.f)) at_scale_o<DV>(o, scw, (al), r32, hi); } while (0)
    constexpr int DRYP = (OUTM == 2) ? PROBE_MODE : 0;
    f32x16 pA0, pA1, pB0, pB1; float alA, alB; bf16x8 pa[4];
    AT_PF(1); AT_PF(2); AT_PF(3);
    AT_GLOAD(0); AT_SWRITE(0); __syncthreads();
    AT_GLOAD(1);
    at_qkt<DQK, QL>(pA0, pA1, kb0, qf, qb); AT_MASK(pA0, pA1, 0); at_psm(pA0, pA1, mrun, alA);
#if AT_LAZY
    lrun *= alA;
#endif
    AT_SWRITE(1); __syncthreads();
    int bp = 0, bc = 1, bn = 2;
    constexpr int NMF = 2 * (DQK / 16) + 4 * (DV / 32);
#if AT_IGLP >= 0
#define AT_SCHED() __builtin_amdgcn_iglp_opt(AT_IGLP)
#elif AT_SGB
#define AT_SCHED() do { _Pragma("unroll") for (int i_ = 0; i_ < NMF; ++i_) { __builtin_amdgcn_sched_group_barrier(0x008, 1, 0); __builtin_amdgcn_sched_group_barrier(0x100, 2, 0); __builtin_amdgcn_sched_group_barrier(0x002, AT_SGB, 0); } } while (0)
#else
#define AT_SCHED() do {} while (0)
#endif
#define AT_ROT() do { bp = bc; bc = bn; bn = (bn == 2) ? 0 : bn + 1; } while (0)
#if AT_LAZY
    f32x16 negm;
    if (NG) {
#pragma unroll
        for (int r = 0; r < 16; ++r) negm[r] = -mrun;
    }
#define AT_NEGUPD(al, P0, P1) do { if (NG && __any((al) < 1.f)) { const float d_ = -__builtin_amdgcn_logf(al); _Pragma("unroll") for (int r_ = 0; r_ < 16; ++r_) { negm[r_] = -mrun; P0[r_] -= d_; P1[r_] -= d_; } } } while (0)
    for (int j = 1; j + 1 < NT; j += 2) {
        at_qkt<DQK, QL, NG>(pB0, pB1, kb0 + bc * KBUF, qf, qb, &negm); AT_MASK(pB0, pB1, j);
        AT_GLOAD(j + 1);
        at_fsm_lazy<DV>(pA0, pA1, mrun, alA, lrun, pa, o, scw, r32, hi);
        AT_NEGUPD(alA, pB0, pB1);
        at_pv<DV>(o, vb0 + bp * VBUF, pa); at_psm_lazy<NG>(pB0, pB1, mrun);
        AT_SWRITE(bn);
        __syncthreads(); AT_ROT();
        at_qkt<DQK, QL, NG>(pA0, pA1, kb0 + bc * KBUF, qf, qb, &negm); AT_MASK(pA0, pA1, j + 1);
        AT_GLOAD(j + 2);
        at_fsm_lazy<DV>(pB0, pB1, mrun, alB, lrun, pa, o, scw, r32, hi);
        AT_NEGUPD(alB, pA0, pA1);
        at_pv<DV>(o, vb0 + bp * VBUF, pa); at_psm_lazy<NG>(pA0, pA1, mrun);
        AT_SWRITE(bn);
        __syncthreads(); AT_ROT();
    }
    at_qkt<DQK, QL, NG>(pB0, pB1, kb0 + bc * KBUF, qf, qb, &negm); AT_MASK(pB0, pB1, NT - 1);
    at_fsm_lazy<DV>(pA0, pA1, mrun, alA, lrun, pa, o, scw, r32, hi);
    AT_NEGUPD(alA, pB0, pB1);
    at_pv<DV>(o, vb0 + bp * VBUF, pa); at_psm_lazy<NG>(pB0, pB1, mrun);
    at_fsm_lazy<DV>(pB0, pB1, mrun, alB, lrun, pa, o, scw, r32, hi);
    at_pv<DV>(o, vb0 + bc * VBUF, pa);
#else
    for (int j = 1; j + 1 < ((DRYP == 6) ? 2 : NT); j += 2) {
        SBAR(); if (DRYP != 5) at_qkt<DQK, QL>(pB0, pB1, kb0 + bc * KBUF, qf, qb); else { _Pragma("unroll") for (int r_ = 0; r_ < 16; ++r_) { pB0[r_] = o[0][r_] * 1e-3f; pB1[r_] = o[1][r_] * 1e-3f; } } AT_MASK(pB0, pB1, j);
        if (!(DRYP >= 1)) { AT_GLOAD(j + 1); AT_PF(j + PFD); }
        if (DRYP != 3) at_fsm(pA0, pA1, alA, lrun, pa); else at_fsm_fake(pA0, pA1, pa); SBAR();
        if (DRYP != 4) at_pv<DV>(o, vb0 + bp * VBUF, pa); else { o[0][0] += __builtin_bit_cast(float, (int)pa[0][0] + (int)pa[1][1] + (int)pa[2][2] + (int)pa[3][3]); } if (DRYP != 3) at_psm(pB0, pB1, mrun, alB); else alB = 1.f;
        AT_SCHED();
        if (!(DRYP >= 1)) AT_SWRITE(bn);
        AT_RESC(alB); if (DRYP != 2) __syncthreads(); AT_ROT();
        SBAR(); if (DRYP != 5) at_qkt<DQK, QL>(pA0, pA1, kb0 + bc * KBUF, qf, qb); else { _Pragma("unroll") for (int r_ = 0; r_ < 16; ++r_) { pA0[r_] = o[0][r_] * 1e-3f; pA1[r_] = o[1][r_] * 1e-3f; } } AT_MASK(pA0, pA1, j + 1);
        if (!(DRYP >= 1)) { AT_GLOAD(j + 2); AT_PF(j + 1 + PFD); }
        if (DRYP != 3) at_fsm(pB0, pB1, alB, lrun, pa); else at_fsm_fake(pB0, pB1, pa); SBAR();
        if (DRYP != 4) at_pv<DV>(o, vb0 + bp * VBUF, pa); else { o[0][0] += __builtin_bit_cast(float, (int)pa[0][0] + (int)pa[1][1] + (int)pa[2][2] + (int)pa[3][3]); } if (DRYP != 3) at_psm(pA0, pA1, mrun, alA); else alA = 1.f;
        AT_SCHED();
        if (!(DRYP >= 1)) AT_SWRITE(bn);
        AT_RESC(alA); if (DRYP != 2) __syncthreads(); AT_ROT();
    }
    SBAR(); at_qkt<DQK, QL>(pB0, pB1, kb0 + bc * KBUF, qf, qb); AT_MASK(pB0, pB1, NT - 1);
    at_fsm(pA0, pA1, alA, lrun, pa); SBAR();
    at_pv<DV>(o, vb0 + bp * VBUF, pa); at_psm(pB0, pB1, mrun, alB);
    AT_RESC(alB);
    at_fsm(pB0, pB1, alB, lrun, pa); SBAR();
    at_pv<DV>(o, vb0 + bc * VBUF, pa);
#endif
#undef AT_ROT
#ifdef AT_NEGUPD
#undef AT_NEGUPD
#endif
#undef AT_SCHED
    pfacc ^= pfv;
    if (__builtin_expect(pfacc == 0x9e3779b9u && lrun == 12345.678f, 0)) scw[0] = 1.f;
#undef AT_GLOAD
#undef AT_PF
#undef AT_SWRITE
#undef AT_MASK
#undef AT_RESC
    { const float lt = lrun + __shfl_xor(lrun, 32); at_scale_o<DV>(o, scw, 1.0f / lt, r32, hi); }
    if (OUTM == 0) {
#pragma unroll
        for (int db = 0; db < DV / 32; ++db) {
            bf16_t* pb = Og + (size_t)(32 * wid + 4 * hi) * ldo + 32 * db + r32;
            bf16_t zz[16];
#pragma unroll
            for (int r = 0; r < 16; ++r) zz[r] = pb[(size_t)((r & 3) + 8 * (r >> 2)) * ldo];
#pragma unroll
            for (int r = 0; r < 16; ++r) { const float z = __uint_as_float((unsigned)zz[r] << 16); pb[(size_t)((r & 3) + 8 * (r >> 2)) * ldo] = (bf16_t)(pk2(o[db][r] * silu_f(z), 0.f) & 0xffffu); }
        }
    } else {
#pragma unroll
        for (int db = 0; db < DV / 32; ++db)
#pragma unroll
            for (int r = 0; r < 16; ++r) {
                const int q = (r & 3) + 8 * (r >> 2) + 4 * hi;
                if (OUTM == 1) { Of[(size_t)(32 * wid + q) * ldof + 32 * db + r32] = o[db][r]; }
                else { if (lrun == 12345.678f) Of[(size_t)(32 * wid + q) * ldof + 32 * db + r32] = o[db][r]; }
            }
    }
    __syncthreads();
}

struct Args { const float* in[21]; float* out; unsigned char* ws; };
typedef const __attribute__((address_space(4))) Args* ArgsP;
DI ArgsP args_ptr() { ArgsP p = (ArgsP)__builtin_amdgcn_kernarg_segment_ptr(); asm volatile("" : "+s"(p)); return p; }
enum { I_X = 0, I_C, I_CTX, I_CCTX, I_WMOD, I_BMOD, I_NORMG, I_WIN, I_QNORM, I_WUQ, I_KVNORM, I_WUKV, I_LQ1, I_LK1, I_LQ2, I_LK2, I_SUBLN, I_SINK, I_WBR, I_WOUT, I_FNORM };

DI int colmap(int kind, int n) {
    if (kind == 1) {
        if (n < C_KR) return n;
        if (n < C_KR + 32) { const int e = n - C_KR; return C_KR + (e >> 1) + 16 * (e & 1); }
        if (n < C_DQ) return -1;
        if ((n >= C_DQ && n < C_DV) || (n >= C_SQ && n < C_SV)) { const int w = n & 63; return (n - w) - 96 + (w >> 1) + 32 * (w & 1); }
        return n - 96;
    }
    if (kind == 2) { const int h = n / 96, e = n % 96; if (e < 64) return n; const int e2 = e - 64; return h * 96 + 64 + (e2 >> 1) + 16 * (e2 & 1); }
    if (kind == 3) { if (n < 512) return (n >> 6) * 192 + (n & 63); const int n2 = n - 512; return (n2 >> 7) * 192 + 64 + (n2 & 127); }
    return n;
}
DI void transpose_item(const float* W, int ldw, int kind, const float* rowscale, bf16_t* WT, int ldd, int koff, LAS float* scr, int item, int nblk, int lane) {
    const int kb = item / nblk, nb = item % nblk, k0 = 64 * kb, n0 = 32 * nb;
    const int oc = colmap(kind, n0 + (lane & 31));
#pragma unroll 8
    for (int i = 0; i < 32; ++i) { const int kk = 2 * i + (lane >> 5); float v = 0.f; if (oc >= 0) v = W[(size_t)(k0 + kk) * ldw + oc]; if (rowscale) v *= rowscale[k0 + kk]; scr[kk * 33 + (lane & 31)] = v; }
    __builtin_amdgcn_wave_barrier(); asm volatile("s_waitcnt lgkmcnt(0)" ::: "memory");
    const int c = lane & 7;
#pragma unroll
    for (int j = 0; j < 4; ++j) { const int n = (lane >> 3) + 8 * j; const LAS float* s = scr + (8 * c) * 33 + n;
        u32x4 o; o.x = pk2(s[0 * 33], s[1 * 33]); o.y = pk2(s[2 * 33], s[3 * 33]); o.z = pk2(s[4 * 33], s[5 * 33]); o.w = pk2(s[6 * 33], s[7 * 33]);
        *(u32x4*)(WT + (size_t)(n0 + n) * ldd + koff + k0 + 8 * c) = o; }
    __builtin_amdgcn_wave_barrier(); asm volatile("s_waitcnt lgkmcnt(0)" ::: "memory");
}
DI void prologue(ArgsP ap, LAS unsigned char* lds) {
    const int tid = tid_l(), lane = tid & 63, wid = __builtin_amdgcn_readfirstlane(tid >> 6);
    unsigned char* ws = ap->ws;
    LAS float* scr = (LAS float*)(lds + wid * 8448);
    const int gw = bid_l() * 8 + wid, NGW = grd_l() * 8;
    constexpr int I_IN = 16 * (NP / 32), I_UQ = 6 * 24, I_UKV = 4 * 48, I_SQ = 16 * 32, PER_L = I_IN + I_UQ + I_UKV + 6 * I_SQ;
    for (int it = gw; it < 2 * PER_L; it += NGW) {
        const int l = it / PER_L; int r = it % PER_L;
        if (r < I_IN) { transpose_item(ap->in[I_WIN] + (size_t)l * 1024 * D_IN, D_IN, 1, nullptr, (bf16_t*)(ws + WS_WIN) + (size_t)l * NP * 1024, 1024, 0, scr, r, NP / 32, lane); continue; } r -= I_IN;
        if (r < I_UQ) { transpose_item(ap->in[I_WUQ] + (size_t)l * 384 * 768, 768, 2, ap->in[I_QNORM] + l * 384, (bf16_t*)(ws + WS_WUQ) + (size_t)l * 768 * 384, 384, 0, scr, r, 24, lane); continue; } r -= I_UQ;
        if (r < I_UKV) { transpose_item(ap->in[I_WUKV] + (size_t)l * 256 * 1536, 1536, 3, ap->in[I_KVNORM] + l * 256, (bf16_t*)(ws + WS_WUKV) + (size_t)l * 1536 * 256, 256, 0, scr, r, 48, lane); continue; } r -= I_UKV;
        if (r < 3 * I_SQ) { const int br = r / I_SQ; transpose_item(ap->in[I_WBR] + ((size_t)l * 3 + br) * 1024 * 1024, 1024, 0, nullptr, (bf16_t*)(ws + WS_WB) + ((size_t)l * 3 + br) * 1024 * 1024, 1024, 0, scr, r % I_SQ, 32, lane); continue; } r -= 3 * I_SQ;
        { const int rep = r / I_SQ; transpose_item(ap->in[I_WOUT] + (size_t)l * 1024 * 1024, 1024, 0, nullptr, (bf16_t*)(ws + WS_WO3) + (size_t)l * 1024 * 3072, 3072, rep * 1024, scr, r % I_SQ, 32, lane); }
    }
    const int gt = bid_l() * 512 + tid, NGT = grd_l() * 512;
    for (int i = gt; i < SEQ * 48; i += NGT) {
        const int pos = i / 48, p = i % 48; const float frow = (float)(pos >> 6), fcol = (float)(pos & 63);
        float ang; float* cd; float* sd;
        if (p < 32) { const int f = p & 15; const float inv = powf(10000.0f, -(float)f / 16.0f); ang = (p < 16 ? frow : fcol) * inv; cd = (float*)(ws + WS_COSH) + pos * 32 + p; sd = (float*)(ws + WS_SINH) + pos * 32 + p; }
        else { const int pp = p - 32, f = pp & 7; const float inv = powf(10000.0f, -(float)f / 8.0f); ang = (pp < 8 ? frow : fcol) * inv; cd = (float*)(ws + WS_COSM) + pos * 16 + pp; sd = (float*)(ws + WS_SINM) + pos * 16 + pp; }
        *cd = __cosf(ang); *sd = __sinf(ang);
    }
    for (int it = gw; it < 2 * 16 * 48; it += NGW) {
        const int l = it / 768, rem = it % 768, kc = rem / 48, nb = rem % 48; const int k = kc * 64 + lane;
        float sv[9];
#pragma unroll
        for (int v = 0; v < 8; ++v) sv[v] = silu_f(ap->in[I_C][v * 1024 + k]);
        sv[8] = silu_f(ap->in[I_CCTX][k]);
        float acc[9];
#pragma unroll
        for (int v = 0; v < 9; ++v) acc[v] = 0.f;
        const float* w = ap->in[I_WMOD] + ((size_t)l * 1024 + kc * 64) * 3072 + nb * 64 + lane;
#pragma unroll 8
        for (int kk = 0; kk < 64; ++kk) { const float wv = w[(size_t)kk * 3072];
#pragma unroll
            for (int v = 0; v < 9; ++v) acc[v] += __uint_as_float(__builtin_amdgcn_readlane(__float_as_uint(sv[v]), kk)) * wv; }
        float* mp = (float*)(ws + WS_MODP) + ((size_t)(l * 16 + kc) * 9) * 3072 + nb * 64 + lane;
#pragma unroll
        for (int v = 0; v < 9; ++v) mp[(size_t)v * 3072] = acc[v];
    }
}
DI void mod_finalize(ArgsP ap) {
    const int tid = tid_l();
    const int gt = bid_l() * 512 + tid, NGT = grd_l() * 512;
    const float* mp = (const float*)(ap->ws + WS_MODP); float* mod = (float*)(ap->ws + WS_MOD);
    for (int i = gt; i < 2 * 9 * 3072; i += NGT) {
        const int l = i / (9 * 3072), rem = i % (9 * 3072), n = rem % 3072;
        float s = ap->in[I_BMOD][l * 3072 + n];
#pragma unroll
        for (int kc = 0; kc < 16; ++kc) s += mp[(size_t)(l * 16 + kc) * 9 * 3072 + rem];
        mod[i] = s;
    }
}
DI void ph_norm_mod(ArgsP ap, int l, int g) {
    const int tid = tid_l(), lane = tid & 63, wid = __builtin_amdgcn_readfirstlane(tid >> 6);
    const int gw = bid_l() * 8 + wid, NGW = grd_l() * 8;
    const float* ng = ap->in[I_NORMG] + l * 1024; const float* mod = (const float*)(ap->ws + WS_MOD) + (size_t)l * 9 * 3072;
    const float* xs = (l == 0) ? ap->in[I_X] : ap->out; const float* cs = (l == 0) ? ap->in[I_CTX] : (const float*)(ap->ws + WS_CTX);
    bf16_t* H = (bf16_t*)(ap->ws + WS_H);
    for (int r = gw; r < R; r += NGW) {
        const int bl = r / RB, j = r % RB, b = g * GB + bl;
        const float* src; const float* md;
        if (j < CTX) { src = cs + ((size_t)b * CTX + j) * DM; md = mod + 8 * 3072; } else { src = xs + ((size_t)b * SEQ + (j - CTX)) * DM; md = mod + (size_t)b * 3072; }
        f32x4 v[4]; float ss = 0.f;
#pragma unroll
        for (int q = 0; q < 4; ++q) { v[q] = *(const f32x4*)(src + 4 * (lane + 64 * q)); ss += (v[q][0] * v[q][0] + v[q][1] * v[q][1]) + (v[q][2] * v[q][2] + v[q][3] * v[q][3]); }
        const float rstd = 1.0f / sqrtf(wave_sum(ss) * (1.0f / DM) + EPS);
#pragma unroll
        for (int q = 0; q < 4; ++q) { const int idx = 4 * (lane + 64 * q);
            const f32x4 gg = *(const f32x4*)(ng + idx), sh = *(const f32x4*)(md + idx), sc = *(const f32x4*)(md + 1024 + idx);
            const f32x4 y = (v[q] * rstd * gg) * (sc + 1.0f) + sh;
            u32x2 w; w.x = pk2(y[0], y[1]); w.y = pk2(y[2], y[3]); *(u32x2*)(H + (size_t)r * DM + idx) = w; }
    }
}
DI void ph_mla_norm(ArgsP ap) {
    const int tid = tid_l(), lane = tid & 63, wid = __builtin_amdgcn_readfirstlane(tid >> 6);
    const int gw = bid_l() * 8 + wid, NGW = grd_l() * 8;
    const bf16_t* P = (const bf16_t*)(ap->ws + WS_P); bf16_t* AQ = (bf16_t*)(ap->ws + WS_AQ); bf16_t* AKV = (bf16_t*)(ap->ws + WS_AKV); bf16_t* KM = (bf16_t*)(ap->ws + WS_KM);
    for (int r = gw; r < R; r += NGW) {
        const bf16_t* row = P + (size_t)r * NP;
        const u32x4 c0 = *(const u32x4*)(row + 8 * lane);
        u32x4 c1 = {0u, 0u, 0u, 0u}; if (lane < 20) c1 = *(const u32x4*)(row + 8 * (64 + lane));
        float f0[8] = {bflo(c0.x), bfhi(c0.x), bflo(c0.y), bfhi(c0.y), bflo(c0.z), bfhi(c0.z), bflo(c0.w), bfhi(c0.w)};
        float f1[8] = {bflo(c1.x), bfhi(c1.x), bflo(c1.y), bfhi(c1.y), bflo(c1.z), bfhi(c1.z), bflo(c1.w), bfhi(c1.w)};
        float s0 = 0.f, s1 = 0.f;
#pragma unroll
        for (int i = 0; i < 8; ++i) { s0 += f0[i] * f0[i]; s1 += f1[i] * f1[i]; }
        const float sq = wave_sum(lane < 48 ? s0 : 0.f);
        const float skv = wave_sum((lane >= 48 ? s0 : 0.f) + (lane < 16 ? s1 : 0.f));
        const float rq = 1.0f / sqrtf(sq * (1.0f / 384.0f) + EPS), rkv = 1.0f / sqrtf(skv * (1.0f / 256.0f) + EPS);
        { const float rr = lane < 48 ? rq : rkv; u32x4 w; w.x = pk2(f0[0] * rr, f0[1] * rr); w.y = pk2(f0[2] * rr, f0[3] * rr); w.z = pk2(f0[4] * rr, f0[5] * rr); w.w = pk2(f0[6] * rr, f0[7] * rr);
          if (lane < 48) *(u32x4*)(AQ + (size_t)r * 384 + 8 * lane) = w; else *(u32x4*)(AKV + (size_t)r * 256 + 8 * (lane - 48)) = w; }
        if (lane < 16) { u32x4 w; w.x = pk2(f1[0] * rkv, f1[1] * rkv); w.y = pk2(f1[2] * rkv, f1[3] * rkv); w.z = pk2(f1[4] * rkv, f1[5] * rkv); w.w = pk2(f1[6] * rkv, f1[7] * rkv);
            *(u32x4*)(AKV + (size_t)r * 256 + 8 * (16 + lane)) = w; }
        else if (lane < 20) {
#pragma unroll
            for (int h = 0; h < 8; ++h) *(u32x4*)(KM + (size_t)r * 768 + h * 96 + 64 + 8 * (lane - 16)) = c1; }
    }
}
template <bool DRYE>
DI void ph_diff_post(ArgsP ap, int l) {
    const int tid = tid_l(), lane = tid & 63, wid = __builtin_amdgcn_readfirstlane(tid >> 6);
    const int gw = bid_l() * 8 + wid, NGW = grd_l() * 8;
    const float lam_init = (l == 0) ? 0.2f : (0.8f - 0.6f * 0.7408182206817179f);
    const float d1 = wave_sum(ap->in[I_LQ1][l * 64 + lane] * ap->in[I_LK1][l * 64 + lane]), d2 = wave_sum(ap->in[I_LQ2][l * 64 + lane] * ap->in[I_LK2][l * 64 + lane]);
    const float lam = expf(d1) - expf(d2) + lam_init;
    const float sl0 = ap->in[I_SUBLN][l * 128 + 2 * lane] * (1.0f - lam_init), sl1 = ap->in[I_SUBLN][l * 128 + 2 * lane + 1] * (1.0f - lam_init);
    const float* OD = (const float*)(ap->ws + WS_OD); bf16_t* P = (bf16_t*)(ap->ws + WS_P);
    typedef float f32x2 __attribute__((ext_vector_type(2)));
    for (int r = gw; r < R; r += NGW) {
        if (l != 0 && (r % RB) < CTX) continue;
        const float* ob = OD + (size_t)r * 2048 + 2 * lane; unsigned* zb = (unsigned*)(P + (size_t)r * NP + C_Z + 1024 + 2 * lane);
        f32x2 o1[8], o2[8]; unsigned z[8];
#pragma unroll
        for (int h = 0; h < 8; ++h) { o1[h] = *(const f32x2*)(ob + (2 * h) * 128); o2[h] = *(const f32x2*)(ob + (2 * h + 1) * 128); z[h] = zb[h * 64]; }
#pragma unroll
        for (int h = 0; h < 8; ++h) {
            const float a0 = o1[h][0] - lam * o2[h][0], a1 = o1[h][1] - lam * o2[h][1];
            const float rstd = 1.0f / sqrtf(wave_sum(a0 * a0 + a1 * a1) * (1.0f / 128.0f) + EPS);
            if (!DRYE || rstd == 12345.678f) zb[h * 64] = pk2(a0 * rstd * sl0 * silu_f(bflo(z[h])), a1 * rstd * sl1 * silu_f(bfhi(z[h])));
        }
    }
}
template <bool DRYE>
DI void ph_final_norm(ArgsP ap) {
    const int tid = tid_l(), lane = tid & 63, wid = __builtin_amdgcn_readfirstlane(tid >> 6);
    const int gw = bid_l() * 8 + wid, NGW = grd_l() * 8; const float* fg = ap->in[I_FNORM];
    for (int r = gw; r < NBATCH * SEQ; r += NGW) {
        float* row = ap->out + (size_t)r * DM; f32x4 v[4]; float ss = 0.f;
#pragma unroll
        for (int q = 0; q < 4; ++q) { v[q] = *(const f32x4*)(row + 4 * (lane + 64 * q)); ss += (v[q][0] * v[q][0] + v[q][1] * v[q][1]) + (v[q][2] * v[q][2] + v[q][3] * v[q][3]); }
        const float rstd = 1.0f / sqrtf(wave_sum(ss) * (1.0f / DM) + EPS);
#pragma unroll
        for (int q = 0; q < 4; ++q) { const int idx = 4 * (lane + 64 * q); if (!DRYE || rstd == 12345.678f) *(f32x4*)(row + idx) = v[q] * rstd * *(const f32x4*)(fg + idx); }
    }
}
template <bool DRY>
DI void ph_attention(ArgsP ap, int l, LAS unsigned char* lds) {
    constexpr int OM0 = DRY ? 2 : 0;
    const int G = grd_l(), bx = bid_l(), vcu = (G % 8 == 0) ? (bx % 8) * (G / 8) + bx / 8 : bx;
    bf16_t* P = (bf16_t*)(ap->ws + WS_P); const bf16_t* QM = (const bf16_t*)(ap->ws + WS_QM); const bf16_t* KM = (const bf16_t*)(ap->ws + WS_KM); const bf16_t* VM = (const bf16_t*)(ap->ws + WS_VM);
    float* OD = (float*)(ap->ws + WS_OD); const float* sink = ap->in[I_SINK] + l * 16;
#if !defined(ATT_ONLY) || ATT_ONLY == 1
    if (!DRY || (DRY_SEL & 1))
    for (int u = vcu; u < GB * 8 * 32; u += G) { const int bh = u >> 5, qb = u & 31, bl = bh >> 3, h = bh & 7; const size_t rb = (size_t)bl * RB, q0 = rb + CTX + 256 * qb;
        attn_unit<96, 128, OM0, false>(lds, QM + q0 * 768 + h * 96, 768, KM + rb * 768 + h * 96, 768, VM + rb * 1024 + h * 128, 1024, RB / 64, 0, 0, 0, 0, NEGBIG, 0.f, P + q0 * NP + C_Z + h * 128, NP, OD, 0); }
#endif
#if !defined(ATT_ONLY) || ATT_ONLY == 2
    if (!DRY || (DRY_SEL & 2))
    for (int u = vcu; u < GB * 16 * 32; u += G) { const int bh = u >> 5, qb = u & 31, bl = bh >> 4, hm = bh & 15; const size_t rb = (size_t)bl * RB, q0 = rb + CTX + 256 * qb;
        attn_unit<64, 128, 1, false>(lds, P + q0 * NP + C_DQ + hm * 64, NP, P + rb * NP + C_DK + hm * 64, NP, P + rb * NP + C_DV + (hm >> 1) * 128, NP, RB / 64, 0, 0, 0, 0, NEGBIG, 0.f, nullptr, 0, OD + q0 * 2048 + hm * 128, 2048); }
#endif
#if !defined(ATT_ONLY) || ATT_ONLY == 3
    if (!DRY || (DRY_SEL & 4))
    for (int u = vcu; u < GB * 16 * 32; u += G) { const int bh = u >> 5, qb = u & 31, bl = bh >> 4, h = bh & 15; const size_t rb = (size_t)bl * RB, q0 = rb + CTX + 256 * qb;
        const int lo = (256 * qb - 128 < 0) ? 0 : 256 * qb - 128, hi = (256 * qb + 384 > SEQ) ? SEQ : 256 * qb + 384;
        attn_unit<64, 64, OM0, true>(lds, P + q0 * NP + C_SQ + h * 64, NP, P + rb * NP + C_SK + (h >> 2) * 64, NP, P + rb * NP + C_SV + (h >> 2) * 64, NP, CTX / 64, CTX + lo, (hi - lo) / 64, lo, 256 * qb, sink[h] * LOG2E, 1.0f,
                              P + q0 * NP + C_Z + 2048 + h * 64, NP, OD, 0); }
#endif
#if !defined(ATT_ONLY)
    if (l == 0) {
        for (int u = vcu; u < GB * 40; u += G) { const int bl = u / 40, k = u % 40; const size_t rb = (size_t)bl * RB;
            if (k < 8) { const int h = k;
                attn_unit<96, 128, OM0, false>(lds, QM + rb * 768 + h * 96, 768, KM + rb * 768 + h * 96, 768, VM + rb * 1024 + h * 128, 1024, CTX / 64, 0, 0, 0, 0, NEGBIG, 0.f, P + rb * NP + C_Z + h * 128, NP, OD, 0); }
            else if (k < 24) { const int hm = k - 8;
                attn_unit<64, 128, 1, false>(lds, P + rb * NP + C_DQ + hm * 64, NP, P + rb * NP + C_DK + hm * 64, NP, P + rb * NP + C_DV + (hm >> 1) * 128, NP, CTX / 64, 0, 0, 0, 0, NEGBIG, 0.f, nullptr, 0, OD + rb * 2048 + hm * 128, 2048); }
            else { const int h = k - 24;
                attn_unit<64, 64, OM0, false>(lds, P + rb * NP + C_SQ + h * 64, NP, P + rb * NP + C_SK + (h >> 2) * 64, NP, P + rb * NP + C_SV + (h >> 2) * 64, NP, CTX / 64, 0, 0, 0, 0, sink[h] * LOG2E, 1.0f, P + rb * NP + C_Z + 2048 + h * 64, NP, OD, 0); }
        }
    }
#endif
}

#define RLX_AGENT __ATOMIC_RELAXED, __HIP_MEMORY_SCOPE_AGENT
#define XB_TMO      128
#define XB_XCNT(j)  (256  + 64 * (j))
#define XB_XSUB(j)  (1280 + 64 * (j))
#define XB_XGEN(j)  (2304 + 64 * (j))
#define XB_TOP      3328
#define XB_TOPGEN   3392
#define XCD_BAR_WORDS 3456
#define XB_SPIN_CAP (1u << 18)

__device__ __forceinline__ unsigned xb_ld(unsigned* p)              { return __hip_atomic_load(p, __ATOMIC_RELAXED, __HIP_MEMORY_SCOPE_AGENT); }
__device__ __forceinline__ unsigned xb_add(unsigned* p, unsigned v) { return __hip_atomic_fetch_add(p, v, __ATOMIC_RELAXED, __HIP_MEMORY_SCOPE_AGENT); }
__device__ __forceinline__ unsigned xb_xcc_id() { return (unsigned)__builtin_amdgcn_s_getreg((3 << 11) | 20) & 0xFu; }
#define XB_SPIN(cond, bar) do { unsigned _sp = 0; while (cond) { __builtin_amdgcn_s_sleep(1); \
    if ((++_sp & 255u) == 0u) { if (xb_ld(&(bar)[XB_TMO])) break; if (_sp > XB_SPIN_CAP) { atomicAdd(&(bar)[XB_TMO], 1u); break; } } } } while (0)

struct XcdBarrier {
    unsigned* bar; unsigned x;
    volatile LAS unsigned* st;
};

__device__ __forceinline__ XcdBarrier xcd_barrier_post(unsigned* bar, volatile LAS unsigned* st) {
    XcdBarrier b; b.bar = bar; b.x = xb_xcc_id(); b.st = st;
    if (threadIdx.x == 0) (void)xb_add(&bar[XB_XCNT(b.x)], 1u);
    return b;
}
__device__ __forceinline__ void xcd_barrier_complete(unsigned* bar, unsigned x, unsigned& nloc, unsigned& nx) {
    const unsigned G = gridDim.x * gridDim.y * gridDim.z;
    unsigned sum, cnt, mine, sp = 0u;
    for (;;) {
        sum = 0u; cnt = 0u; mine = 0u;
#pragma unroll
        for (unsigned j = 0; j < 16; ++j) { const unsigned c = xb_ld(&bar[XB_XCNT(j)]); sum += c; cnt += (c > 0u) ? 1u : 0u; mine = (j == x) ? c : mine; }
        if (sum == G) break;
        __builtin_amdgcn_s_sleep(1);
        if ((++sp & 255u) == 0u) { if (xb_ld(&bar[XB_TMO])) break; if (sp > XB_SPIN_CAP) { atomicAdd(&bar[XB_TMO], 1u); break; } }
    }
    nloc = mine > 0u ? mine : 1u; nx = cnt > 0u ? cnt : 1u;
}

__device__ __forceinline__ void xcd_barrier(const XcdBarrier& b) {
    asm volatile("s_waitcnt vmcnt(0)" ::: "memory");
    __syncthreads();
    if (threadIdx.x == 0) {
        unsigned* bar = b.bar;
        __builtin_amdgcn_s_waitcnt(0);
        unsigned nloc = b.st[0], nx = b.st[1];
        if (nloc == 0u) { xcd_barrier_complete(bar, b.x, nloc, nx); b.st[0] = nloc; b.st[1] = nx; }
        const unsigned old = xb_add(&bar[XB_XSUB(b.x)], 1u);
        const unsigned gen = old / nloc;
        if (old + 1u == (gen + 1u) * nloc) {
            __builtin_amdgcn_fence(__ATOMIC_RELEASE, "agent");
            asm volatile("s_waitcnt vmcnt(0)" ::: "memory");
            const unsigned og = xb_add(&bar[XB_TOP], 1u);
            const unsigned tg = og / nx;
            if (og + 1u == (tg + 1u) * nx) xb_add(&bar[XB_TOPGEN], 1u);
            else XB_SPIN(xb_ld(&bar[XB_TOPGEN]) == tg, bar);
            __builtin_amdgcn_fence(__ATOMIC_ACQUIRE, "agent");
            xb_add(&bar[XB_XGEN(b.x)], 1u);
            asm volatile("s_waitcnt vmcnt(0)" ::: "memory");
        } else {
            XB_SPIN(xb_ld(&bar[XB_XGEN(b.x)]) == gen, bar);
            __builtin_amdgcn_fence(__ATOMIC_ACQUIRE, "agent");
            asm volatile("s_waitcnt vmcnt(0)" ::: "memory");
        }
    }
    __syncthreads();
}


__global__ void __launch_bounds__(512, 2) hybrid_fwd(Args a_unused) {
    extern __shared__ __attribute__((aligned(16))) unsigned char lds_raw[];
    LAS unsigned char* lds = (LAS unsigned char*)lds_raw;
    cg::grid_group grid = cg::this_grid();
    { volatile LAS unsigned* xst = (volatile LAS unsigned*)(lds + XB_LDS_OFF);
      if (threadIdx.x < 2) xst[threadIdx.x] = 0u;
      __syncthreads();
      (void)xcd_barrier_post((unsigned*)(args_ptr()->ws), xst); }
#define GSYNC() do { XcdBarrier b_; b_.bar = (unsigned*)(args_ptr()->ws); b_.x = xb_xcc_id(); b_.st = (volatile LAS unsigned*)(lds + XB_LDS_OFF); xcd_barrier(b_); } while (0)
#ifndef NO_PRO
    prologue(args_ptr(), lds);
#ifdef PROBE_PRO
    __syncthreads(); prologue(args_ptr(), lds);
#endif
#endif
    grid.sync();
    mod_finalize(args_ptr());
    GSYNC();
    for (int l = 0; l < 2; ++l) {
        for (int g = 0; g < NGRP; ++g) {
            ph_norm_mod(args_ptr(), lnd(l), lnd(g));
#ifdef PROBE_R1
            GSYNC(); ph_norm_mod(args_ptr(), lnd(l), lnd(g));
#endif
            GSYNC();
#ifndef NO_GEMM
            {
                unsigned char* ws = args_ptr()->ws; const int G = grd_l(), bx = bid_l();
                pg8::Gemm gm{1024, 1024, 1024}; pg8::Order S; S.init(R, NP, G, bx, ws + WS_H, 1024, (bf16_t*)(ws + WS_WIN) + (size_t)l * NP * 1024, 1024, 1 << 20, 0);
                EpiIn E{ws};
                pg8::gemm_phase<EpiIn, pg8::Order, true, true>(lds, gm, S, E);
#ifdef PROBE_G1
                __syncthreads(); pg8::gemm_phase<EpiIn, pg8::Order, true, true>(lds, gm, S, E);
#endif
            }
#endif
            GSYNC();
#ifndef NO_GEMM2
            {
                unsigned char* ws = args_ptr()->ws; const int G = grd_l(), bx = bid_l();
                pg8::Gemm gq{384, NP, 384}; pg8::Order Sq; Sq.init(R, 768, G, bx, (bf16_t*)(ws + WS_P) + C_QC, NP, (bf16_t*)(ws + WS_WUQ) + (size_t)l * 768 * 384, 384, 1 << 20, 0);
                EpiQ Eq{ws};
#ifndef NO_GQ
                pg8::gemm_phase<EpiQ, pg8::Order, true, true>(lds, gq, Sq, Eq);
#ifdef PROBE_G2
                __syncthreads(); pg8::gemm_phase<EpiQ, pg8::Order, true, true>(lds, gq, Sq, Eq);
#endif
#endif
            }
            {
                unsigned char* ws = args_ptr()->ws; const int G = grd_l(), bx = bid_l();
                pg8::Gemm gk{256, NP, 256}; pg8::Order Sk; Sk.init(R, 1536, G, bx, (bf16_t*)(ws + WS_P) + C_KVC, NP, (bf16_t*)(ws + WS_WUKV) + (size_t)l * 1536 * 256, 256, 1 << 20, 0);
                EpiKV Ek{ws};
#ifndef NO_GK
                pg8::gemm_phase<EpiKV, pg8::Order, true, true>(lds, gk, Sk, Ek);
#ifdef PROBE_G2
                __syncthreads(); pg8::gemm_phase<EpiKV, pg8::Order, true, true>(lds, gk, Sk, Ek);
#endif
#endif
            }
#endif
            GSYNC();
#ifndef NO_ATT
#ifdef PROBE_ATT
            ph_attention<true>(args_ptr(), lnd(l), lds);
            GSYNC();
#endif
            ph_attention<false>(args_ptr(), lnd(l), lds);
#endif
            GSYNC();
#ifdef PROBE_R2
            ph_diff_post<true>(args_ptr(), lnd(l)); GSYNC();
#endif
            ph_diff_post<false>(args_ptr(), lnd(l));
            GSYNC();
#ifndef NO_BR
            {
                unsigned char* ws = args_ptr()->ws; const int G = grd_l(), bx = bid_l();
                pg8::Gemm gb{1024, NP, 1024}; pg8::Order S; S.init(R, 3072, G, bx, (bf16_t*)(ws + WS_P) + C_Z, NP, (bf16_t*)(ws + WS_WB) + (size_t)l * 3 * 1024 * 1024, 1024, 4, 1024 * 2, l != 0);
#ifdef PROBE_BR
                { EpiBrT<true> Ed{ws}; pg8::gemm_phase<EpiBrT<true>, pg8::Order, true, true>(lds, gb, S, Ed); __syncthreads(); }
#endif
                EpiBrT<false> E{ws};
                pg8::gemm_phase<EpiBrT<false>, pg8::Order, true, true>(lds, gb, S, E);
            }
#endif
            GSYNC();
#ifndef NO_OUT
            {
                ArgsP ap = args_ptr(); unsigned char* ws = ap->ws; const int G = grd_l(), bx = bid_l();
                pg8::Gemm go{3072, NP, 3072}; pg8::Order S; S.init(R, 1024, G, bx, (bf16_t*)(ws + WS_P) + C_GM, NP, (bf16_t*)(ws + WS_WO3) + (size_t)l * 1024 * 3072, 3072, 1 << 20, 0, l != 0);
#ifdef PROBE_OUT
                { EpiOutT<true> Ed{l, g, (l == 0) ? ap->in[I_X] : (const float*)ap->out, ap->out, ap->in[I_CTX], ws}; pg8::gemm_phase<EpiOutT<true>, pg8::Order, true, true>(lds, go, S, Ed); __syncthreads(); }
#endif
                EpiOutT<false> E{l, g, (l == 0) ? ap->in[I_X] : (const float*)ap->out, ap->out, ap->in[I_CTX], ws};
                pg8::gemm_phase<EpiOutT<false>, pg8::Order, true, true>(lds, go, S, E);
            }
#endif
        }
        GSYNC();
    }
#ifdef PROBE_R2
    ph_final_norm<true>(args_ptr()); GSYNC();
#endif
    ph_final_norm<false>(args_ptr());
}

extern "C" void kernel_launch(void* const* d_in, const int* in_sizes, int n_in, void* d_out, int out_size, void* d_ws, size_t ws_size, hipStream_t stream) {
    static int grid = 0;
    if (grid == 0) {
        if (n_in != 21 || ws_size < WS_END) { fprintf(stderr, "kernel_launch: expected 21 inputs and >= %zu bytes of workspace (got %d, %zu)\n", (size_t)WS_END, n_in, ws_size); grid = -1; return; }
        int dev = 0, cus = 0, per_cu = 0;
        (void)hipGetDevice(&dev); (void)hipDeviceGetAttribute(&cus, hipDeviceAttributeMultiprocessorCount, dev);
        if (hipFuncSetAttribute((const void*)hybrid_fwd, hipFuncAttributeMaxDynamicSharedMemorySize, LDS_BYTES) != hipSuccess) fprintf(stderr, "kernel_launch: hipFuncSetAttribute failed\n");
        if (hipOccupancyMaxActiveBlocksPerMultiprocessor(&per_cu, (const void*)hybrid_fwd, 512, LDS_BYTES) != hipSuccess || per_cu < 1) { per_cu = 1; (void)hipGetLastError(); }
        if (cus <= 0) cus = 256;
        grid = cus * per_cu;
    }
    if (grid < 0) return;
    Args a{};
    for (int i = 0; i < 21; ++i) a.in[i] = (const float*)d_in[i];
    a.out = (float*)d_out; a.ws = (unsigned char*)d_ws;
    (void)hipMemsetAsync(d_ws, 0, 16384, stream);
    void* args[] = {&a};
    hipError_t e = hipLaunchCooperativeKernel((const void*)hybrid_fwd, dim3(grid), dim3(512), args, LDS_BYTES, stream);
    if (e != hipSuccess) fprintf(stderr, "kernel_launch: cooperative launch failed: %s (grid %d)\n", hipGetErrorString(e), grid);
}
```

```cpp
#include <hip/hip_runtime.h>
#include <hip/hip_cooperative_groups.h>
#include <cstdio>
#include <cstdint>
namespace cg = cooperative_groups;

#define DI __device__ __forceinline__
#define LAS __attribute__((address_space(3)))
__device__ __forceinline__ int tid_l() { int t = threadIdx.x; asm volatile("" : "+v"(t)); return t; }
__device__ __forceinline__ int bid_l() { int b = blockIdx.x; asm volatile("" : "+s"(b)); return b; }
__device__ __forceinline__ int lnd(int x) { asm volatile("" : "+s"(x)); return x; }
__device__ __forceinline__ int grd_l() { int g = gridDim.x; asm volatile("" : "+s"(g)); return g; }
typedef unsigned short bf16_t;
typedef short bf16x8 __attribute__((ext_vector_type(8)));
typedef short s16x4 __attribute__((ext_vector_type(4)));
typedef float f32x4 __attribute__((ext_vector_type(4)));
typedef float f32x16 __attribute__((ext_vector_type(16)));
typedef unsigned u32x4 __attribute__((ext_vector_type(4)));
typedef unsigned u32x2 __attribute__((ext_vector_type(2)));

constexpr int DM = 1024, NBATCH = 8, SEQ = 8192, CTX = 256, RB = CTX + SEQ;
constexpr int GB = 2, NGRP = NBATCH / GB, R = GB * RB;
constexpr int NP = 11520;
constexpr int C_QC = 0, C_KVC = 384, C_KR = 640, C_DQ = 768, C_DK = 1792, C_DV = 2816, C_SQ = 3840, C_SK = 4864, C_SV = 5120, C_Z = 5376, C_GM = 8448;
constexpr int D_IN = 11424;
constexpr float EPS = 1e-6f, LOG2E = 1.4426950408889634f;
constexpr float QS64 = 0.125f * LOG2E, QS96 = 0.10206207261596575f * LOG2E;
constexpr float NEGBIG = -1e30f, THR = 8.0f;

constexpr size_t al256(size_t x) { return (x + 255) & ~(size_t)255; }
constexpr size_t WS_WIN = 1u << 20;
constexpr size_t WS_WUQ = al256(WS_WIN + (size_t)2 * NP * 1024 * 2);
constexpr size_t WS_WUKV = al256(WS_WUQ + (size_t)2 * 768 * 384 * 2);
constexpr size_t WS_WB = al256(WS_WUKV + (size_t)2 * 1536 * 256 * 2);
constexpr size_t WS_WO3 = al256(WS_WB + (size_t)2 * 3 * 1024 * 1024 * 2);
constexpr size_t WS_COSH = al256(WS_WO3 + (size_t)2 * 1024 * 3072 * 2);
constexpr size_t WS_SINH = al256(WS_COSH + (size_t)SEQ * 32 * 4);
constexpr size_t WS_COSM = al256(WS_SINH + (size_t)SEQ * 32 * 4);
constexpr size_t WS_SINM = al256(WS_COSM + (size_t)SEQ * 16 * 4);
constexpr size_t WS_MODP = al256(WS_SINM + (size_t)SEQ * 16 * 4);
constexpr size_t WS_MOD = al256(WS_MODP + (size_t)16 * 2 * 9 * 3072 * 4);
constexpr size_t WS_CTX = al256(WS_MOD + (size_t)2 * 9 * 3072 * 4);
constexpr size_t WS_H = al256(WS_CTX + (size_t)NBATCH * CTX * DM * 4);
constexpr size_t WS_P = al256(WS_H + (size_t)R * DM * 2);
constexpr size_t WS_AQ = al256(WS_P + (size_t)R * NP * 2);
constexpr size_t WS_AKV = al256(WS_AQ + (size_t)R * 384 * 2);
constexpr size_t WS_QM = al256(WS_AKV + (size_t)R * 256 * 2);
constexpr size_t WS_KM = al256(WS_QM + (size_t)R * 768 * 2);
constexpr size_t WS_VM = al256(WS_KM + (size_t)R * 768 * 2);
constexpr size_t WS_OD = al256(WS_VM + (size_t)R * 1024 * 2);
constexpr size_t WS_END = al256(WS_OD + (size_t)R * 2048 * 4);
constexpr size_t WS_PART = WS_AQ;
static_assert(WS_END <= ((size_t)1 << 30), "workspace map exceeds 1 GiB");

constexpr int LDS_BYTES = 155648, XB_LDS_OFF = 155136;

DI unsigned pk2(float lo, float hi) { typedef float f2_t __attribute__((ext_vector_type(2))); typedef __bf16 b2_t __attribute__((ext_vector_type(2)));
    f2_t v = {lo, hi}; b2_t b = __builtin_convertvector(v, b2_t); return __builtin_bit_cast(unsigned, b); }
DI u32x4 pack8(f32x4 a, f32x4 b) { u32x4 w; w.x = pk2(a[0], a[1]); w.y = pk2(a[2], a[3]); w.z = pk2(b[0], b[1]); w.w = pk2(b[2], b[3]); return w; }
DI float bflo(unsigned w) { return __uint_as_float(w << 16); }
DI float bfhi(unsigned w) { return __uint_as_float(w & 0xffff0000u); }
DI float wave_sum(float v) {
#pragma unroll
    for (int o = 1; o < 64; o <<= 1) v += __shfl_xor(v, o);
    return v; }
DI float opq(float a) { asm("" : "+v"(a)); return a; }
DI float silu_f(float z) { return z * __builtin_amdgcn_rcpf(1.0f + __expf(-z)); }
DI float sigm_f(float z) { return __builtin_amdgcn_rcpf(1.0f + __expf(-z)); }
DI void rope8(f32x4& v0, f32x4& v1, const f32x4 cs, const f32x4 sn) {
    float a, b;
    a = v0[0]; b = v0[1]; v0[0] = a * cs[0] - b * sn[0]; v0[1] = b * cs[0] + a * sn[0];
    a = v0[2]; b = v0[3]; v0[2] = a * cs[1] - b * sn[1]; v0[3] = b * cs[1] + a * sn[1];
    a = v1[0]; b = v1[1]; v1[0] = a * cs[2] - b * sn[2]; v1[1] = b * cs[2] + a * sn[2];
    a = v1[2]; b = v1[3]; v1[2] = a * cs[3] - b * sn[3]; v1[3] = b * cs[3] + a * sn[3];
}
namespace pg8 {
#define PG8_LAS __attribute__((address_space(3)))
typedef unsigned short bf16_t;
typedef short bf16x8 __attribute__((ext_vector_type(8)));
typedef float f32x4 __attribute__((ext_vector_type(4)));
typedef unsigned u32x4 __attribute__((ext_vector_type(4)));
constexpr int BM = 256, BK = 64, HALF = 128, HTB = HALF * BK * 2  , STAGE_BYTES = 8 * HTB, NXCD = 8, WGM = 8;

__host__ __device__ __forceinline__ int lds_byte(int r, int c) { const int st = (r >> 4) * 2 + (c >> 5), rr = r & 15, cc = c & 31, ob = rr * 64 + cc * 2; return st * 1024 + (ob ^ (((ob >> 9) & 1) << 5)); }
__host__ __device__ __forceinline__ void stage_rc(int b, int& R, int& C) { const int st = b / 1024, sb = b % 1024, swz = sb ^ (((sb >> 9) & 1) << 5); R = (st >> 1) * 16 + swz / 64; C = (st & 1) * 32 + (swz % 64) / 2; }
__host__ __device__ __forceinline__ int perm32(int rho) { const int n = rho >> 4, i = rho & 15; return 8 * (i >> 2) + 4 * n + (i & 3); }

struct Unit { int pm, pn; };
struct Gemm { int K, lda, ldb; };
struct Order {
    int nM, nN, nwg, G, c; const char* A; const char* B; unsigned tA, tB; int pnblk; unsigned ablk; int skipctx;
    __device__ __forceinline__ void init(int M, int N, int G_, int c_, const void* A_, int lda, const void* B_, int ldb, int pnblk_, unsigned ablk_, int skipctx_ = 0) {
        skipctx = skipctx_; nM = M / BM; if (skipctx) nM -= nM / 33;
        nN = N / BM; nwg = nM * nN; G = G_; c = c_; A = (const char*)A_; B = (const char*)B_; tA = (unsigned)(BM * lda * 2); tB = (unsigned)(BM * ldb * 2); pnblk = pnblk_; ablk = ablk_; }
    __device__ __forceinline__ bool next(int i, Unit& u) const {
        const long L = (long)i * G + c; if (L >= nwg) return false;
        int wgid = (int)L; { const int q = nwg / NXCD, r = nwg % NXCD, xcd = wgid % NXCD, off = wgid / NXCD; wgid = (xcd < r ? xcd * (q + 1) : r * (q + 1) + (xcd - r) * q) + off; }
        const int nig = WGM * nN, gid = wgid / nig, fm = gid * WGM, gsz = (nM - fm) < WGM ? (nM - fm) : WGM;
        u.pm = fm + ((wgid % nig) % gsz); u.pn = (wgid % nig) / gsz; if (skipctx) u.pm += u.pm / 32 + 1; return true;
    }
    __device__ __forceinline__ const char* a_base(const Unit& u) const { return A + (size_t)u.pm * tA + (size_t)(u.pn / pnblk) * ablk; }
    __device__ __forceinline__ const char* b_base(const Unit& u) const { return B + (size_t)u.pn * tB; }
};

template <class Epi, class Sched, bool ALIGN_EPI = false, bool SP2 = false>
__device__ __forceinline__ void gemm_phase(PG8_LAS unsigned char* lds, const Gemm g, const Sched& S, const Epi& E) {
    const int tid = tid_l(), wid = __builtin_amdgcn_readfirstlane(tid >> 6), lane = tid & 63, wr = wid >> 2, wc = wid & 3, fr = lane & 15, fq = lane >> 4;
    const int K = g.K, nt = K / BK;
    unsigned voffA[2], voffB[2];
#pragma unroll
    for (int i = 0; i < 2; ++i) { int R, C; stage_rc(tid * 16 + i * 8192, R, C); const int Rb = Epi::PERM ? ((R & ~31) + perm32(R & 31)) : R;
        voffA[i] = (unsigned)(R * g.lda + C) * 2u; voffB[i] = (unsigned)(Rb * g.ldb + C) * 2u; }
    const size_t kstep = (size_t)(BK * 2);
    const size_t hstepA = (size_t)HALF * g.lda * 2, hstepB = (size_t)HALF * g.ldb * 2;
    const unsigned ldsw = (unsigned)wid * 1024u;
    const int aoff = lds_byte(wr * 64 + fr, fq * 8), boff = lds_byte(wc * 32 + fr, fq * 8);
#define PG8_SA(b, h) (((b) * 2 + (h)) * HTB)
#define PG8_SB(b, h) ((4 + (b) * 2 + (h)) * HTB)
#define PG8_STAGE(bufoff, gbase, voff) do { _Pragma("unroll") for (int _i = 0; _i < 2; ++_i) \
        __builtin_amdgcn_global_load_lds((const unsigned*)((const char*)(gbase) + (voff)[_i]), (PG8_LAS unsigned*)(lds + (bufoff) + ldsw + _i * 8192), 16, 0, 0); } while (0)
#define PG8_LDA(dst, b, h) do { _Pragma("unroll") for (int m = 0; m < 4; ++m) _Pragma("unroll") for (int k = 0; k < 2; ++k) dst[m][k] = *(const PG8_LAS bf16x8*)(lds + PG8_SA(b, h) + aoff + m * 2048 + k * 1024); } while (0)
#define PG8_LDB(dst, b, h) do { _Pragma("unroll") for (int n = 0; n < 2; ++n) _Pragma("unroll") for (int k = 0; k < 2; ++k) dst[n][k] = *(const PG8_LAS bf16x8*)(lds + PG8_SB(b, h) + boff + n * 2048 + k * 1024); } while (0)
#define PG8_MMA(ai, bj, At, Bt) do { __builtin_amdgcn_s_setprio(1); _Pragma("unroll") for (int m = 0; m < 4; ++m) _Pragma("unroll") for (int n = 0; n < 2; ++n) _Pragma("unroll") for (int k = 0; k < 2; ++k) \
        acc[ai][bj][m][n] = __builtin_amdgcn_mfma_f32_16x16x32_bf16(Bt[n][k], At[m][k], acc[ai][bj][m][n], 0, 0, 0); __builtin_amdgcn_s_setprio(0); } while (0)
#define PG8_WAIT_V(n) asm volatile("s_waitcnt vmcnt(" #n ")" ::: "memory")
#define PG8_WAIT_L(n) asm volatile("s_waitcnt lgkmcnt(" #n ")" ::: "memory")
#define PG8_BAR __builtin_amdgcn_s_barrier()
#define PG8_SCHED __builtin_amdgcn_sched_barrier(0)
    Unit cur, nxt; int ui = 0;
    if (!S.next(0, cur)) return;
    f32x4 acc[2][2][4][2];
#pragma unroll
    for (int a = 0; a < 2; ++a)
#pragma unroll
        for (int b = 0; b < 2; ++b)
#pragma unroll
            for (int m = 0; m < 4; ++m)
#pragma unroll
                for (int n = 0; n < 2; ++n) acc[a][b][m][n] = (f32x4){0.f, 0.f, 0.f, 0.f};
    bf16x8 At[4][2], B0[2][2], B1[2][2];
    const char* cA = S.a_base(cur); const char* cB = S.b_base(cur);

    if constexpr (SP2) {
        PG8_STAGE(PG8_SB(0, 0), cB, voffB); PG8_STAGE(PG8_SB(0, 1), cB + hstepB, voffB); PG8_STAGE(PG8_SA(0, 0), cA, voffA); PG8_STAGE(PG8_SA(0, 1), cA + hstepA, voffA);
        if (wr == 1) PG8_BAR;
        PG8_WAIT_V(2); PG8_BAR;
        PG8_STAGE(PG8_SB(1, 0), cB + kstep, voffB); PG8_STAGE(PG8_SA(1, 0), cA + kstep, voffA); PG8_STAGE(PG8_SB(1, 1), cB + hstepB + kstep, voffB);
        PG8_WAIT_V(6); PG8_BAR;
    } else {
        PG8_STAGE(PG8_SB(0, 0), cB, voffB); PG8_STAGE(PG8_SA(0, 0), cA, voffA); PG8_STAGE(PG8_SB(0, 1), cB + hstepB, voffB); PG8_STAGE(PG8_SA(0, 1), cA + hstepA, voffA);
        if (wr == 1) PG8_BAR;
        PG8_WAIT_V(4); PG8_BAR;
        PG8_STAGE(PG8_SB(1, 0), cB + kstep, voffB); PG8_STAGE(PG8_SA(1, 0), cA + kstep, voffA); PG8_STAGE(PG8_SB(1, 1), cB + hstepB + kstep, voffB);
        PG8_WAIT_V(6); PG8_BAR;
    }
    for (;;) {
        const bool has_next = S.next(ui + 1, nxt);
        const char* nA = has_next ? S.a_base(nxt) : cA; const char* nB = has_next ? S.b_base(nxt) : cB;
#pragma nounroll
        for (int t = 0; t < nt; t += 2) {
            const bool last = (t == nt - 2);
            const char* a1 = cA + (size_t)(t + 1) * kstep;
            const char* a2 = last ? nA : cA + (size_t)(t + 2) * kstep; const char* b2 = last ? nB : cB + (size_t)(t + 2) * kstep;
            const char* a3 = a2 + kstep; const char* b3 = b2 + kstep;

            if constexpr (SP2) {
            PG8_LDB(B0, 0, 0); PG8_LDB(B1, 0, 1); PG8_SCHED; PG8_LDA(At, 0, 0); PG8_STAGE(PG8_SA(1, 1), a1 + hstepA, voffA);
            PG8_WAIT_V(8); PG8_WAIT_L(0); PG8_BAR; PG8_MMA(0, 0, At, B0); PG8_MMA(0, 1, At, B1); PG8_BAR; PG8_SCHED;
            PG8_LDA(At, 0, 1); PG8_STAGE(PG8_SB(0, 0), b2, voffB); PG8_STAGE(PG8_SB(0, 1), b2 + hstepB, voffB); PG8_STAGE(PG8_SA(0, 0), a2, voffA);
            PG8_WAIT_V(8); PG8_WAIT_L(0); PG8_BAR; PG8_MMA(1, 0, At, B0); PG8_MMA(1, 1, At, B1); PG8_BAR; PG8_SCHED;
            PG8_LDB(B0, 1, 0); PG8_LDB(B1, 1, 1); PG8_SCHED; PG8_LDA(At, 1, 0); PG8_STAGE(PG8_SA(0, 1), a2 + hstepA, voffA);
            PG8_WAIT_V(8); PG8_WAIT_L(0); PG8_BAR; PG8_MMA(0, 0, At, B0); PG8_MMA(0, 1, At, B1); PG8_BAR; PG8_SCHED;
            PG8_LDA(At, 1, 1); PG8_STAGE(PG8_SB(1, 0), b3, voffB); PG8_STAGE(PG8_SB(1, 1), b3 + hstepB, voffB); PG8_STAGE(PG8_SA(1, 0), a3, voffA);
            PG8_WAIT_V(8); PG8_WAIT_L(0); PG8_BAR; PG8_MMA(1, 0, At, B0); PG8_MMA(1, 1, At, B1); PG8_BAR; PG8_SCHED;
            } else {
            PG8_LDB(B0, 0, 0); PG8_SCHED; PG8_LDA(At, 0, 0); PG8_STAGE(PG8_SA(1, 1), a1 + hstepA, voffA);
            PG8_WAIT_L(8); PG8_BAR; PG8_WAIT_L(0); PG8_MMA(0, 0, At, B0); PG8_BAR; PG8_SCHED;
            PG8_LDB(B1, 0, 1); PG8_STAGE(PG8_SB(0, 0), b2, voffB);
            PG8_BAR; PG8_WAIT_L(0); PG8_MMA(0, 1, At, B1); PG8_BAR;
            PG8_LDA(At, 0, 1); PG8_STAGE(PG8_SA(0, 0), a2, voffA);
            PG8_BAR; PG8_WAIT_L(0); PG8_MMA(1, 0, At, B0); PG8_BAR; PG8_SCHED;
            PG8_STAGE(PG8_SB(0, 1), b2 + hstepB, voffB);
            PG8_WAIT_V(6); PG8_BAR; PG8_MMA(1, 1, At, B1); PG8_BAR;
            PG8_LDB(B0, 1, 0); PG8_SCHED; PG8_LDA(At, 1, 0); PG8_STAGE(PG8_SA(0, 1), a2 + hstepA, voffA);
            PG8_WAIT_L(8); PG8_BAR; PG8_WAIT_L(0); PG8_MMA(0, 0, At, B0); PG8_BAR; PG8_SCHED;
            PG8_LDB(B1, 1, 1); PG8_STAGE(PG8_SB(1, 0), b3, voffB);
            PG8_BAR; PG8_WAIT_L(0); PG8_MMA(0, 1, At, B1); PG8_BAR;
            PG8_LDA(At, 1, 1); PG8_STAGE(PG8_SA(1, 0), a3, voffA);
            PG8_BAR; PG8_WAIT_L(0); PG8_MMA(1, 0, At, B0); PG8_BAR; PG8_SCHED;
            PG8_STAGE(PG8_SB(1, 1), b3 + hstepB, voffB);
            PG8_WAIT_V(6); PG8_BAR; PG8_MMA(1, 1, At, B1); PG8_BAR;
            }
        }
        if constexpr (ALIGN_EPI) { if (wr == 0) PG8_BAR; }
        if constexpr (!Epi::AFTER_DRAIN) { E(acc, cur, wr, wc, fr, fq); }
        if (!has_next) break;
#pragma unroll
        for (int a = 0; a < 2; ++a)
#pragma unroll
            for (int b = 0; b < 2; ++b)
#pragma unroll
                for (int m = 0; m < 4; ++m)
#pragma unroll
                    for (int n = 0; n < 2; ++n) acc[a][b][m][n] = (f32x4){0.f, 0.f, 0.f, 0.f};
        cur = nxt; cA = nA; cB = nB; ++ui;
        if constexpr (ALIGN_EPI) { if (wr == 1) PG8_BAR; }
    }
    PG8_WAIT_V(0);
    if constexpr (!ALIGN_EPI) { if (wr == 0) PG8_BAR; }
    PG8_BAR;
    if constexpr (Epi::AFTER_DRAIN) { E.fused(acc, cur, wr, wc, fr, fq, lds, wid, lane); }
#undef PG8_SA
#undef PG8_SB
#undef PG8_STAGE
#undef PG8_LDA
#undef PG8_LDB
#undef PG8_MMA
#undef PG8_WAIT_V
#undef PG8_WAIT_L
#undef PG8_BAR
#undef PG8_SCHED
}
}
struct EpiIn {
    static constexpr bool PERM = true, AFTER_DRAIN = false;
    unsigned char* ws;
    DI void operator()(const f32x4 (&acc)[2][2][4][2], const pg8::Unit& u, int wr, int wc, int fr, int fq) const {
        bf16_t* P = (bf16_t*)(ws + WS_P); const float* cosH = (const float*)(ws + WS_COSH); const float* sinH = (const float*)(ws + WS_SINH); const float* cosM = (const float*)(ws + WS_COSM); const float* sinM = (const float*)(ws + WS_SINM);
        const int pn = u.pn; const bool ctxt = (u.pm % 33) == 0;
        int mode = 0; float sc = 1.f;
        if ((pn >= 3 && pn <= 10) || (pn >= 15 && pn <= 19)) mode = 1;
        if (pn == 2) mode = 2;
        if ((pn >= 3 && pn <= 6) || (pn >= 15 && pn <= 18)) sc = QS64;
        if (ctxt) mode = 0;
        const int rowt = u.pm * 256 + wr * 64 + fr, colb = pn * 256 + wc * 32 + 8 * fq;
#pragma unroll
        for (int ai = 0; ai < 2; ++ai)
#pragma unroll
            for (int m = 0; m < 4; ++m) {
                const int row = rowt + ai * 128 + m * 16; const int pos = (row % RB) - CTX;
                bf16_t* rowp = P + (size_t)row * NP;
#pragma unroll
                for (int bj = 0; bj < 2; ++bj) {
                    const int col0 = colb + bj * 128;
                    f32x4 v0 = acc[ai][bj][m][0], v1 = acc[ai][bj][m][1];
                    if (pn <= 2) {
                        float s8 = (v0[0] * v0[0] + v0[1] * v0[1]) + (v0[2] * v0[2] + v0[3] * v0[3]) + (v1[0] * v1[0] + v1[1] * v1[1]) + (v1[2] * v1[2] + v1[3] * v1[3]);
                        s8 += __shfl_xor(s8, 16); s8 += __shfl_xor(s8, 32);
                        const int slice = pn * 8 + bj * 4 + wc;
                        if (fq == 0 && slice < 20) ((float*)(ws + WS_PART))[(size_t)row * 20 + slice] = s8;
                    }
                    if (mode == 1) { const int p0 = (col0 & 63) >> 1; const f32x4 cs = *(const f32x4*)(cosH + (size_t)pos * 32 + p0), sn = *(const f32x4*)(sinH + (size_t)pos * 32 + p0); rope8(v0, v1, cs, sn); }
                    else if (mode == 2 && col0 >= C_KR && col0 < C_KR + 32) { const int p0 = (col0 - C_KR) >> 1; const f32x4 cs = *(const f32x4*)(cosM + (size_t)pos * 16 + p0), sn = *(const f32x4*)(sinM + (size_t)pos * 16 + p0); rope8(v0, v1, cs, sn); }
                    v0 = v0 * sc; v1 = v1 * sc;
                    const u32x4 w8 = pack8(v0, v1);
                    *(u32x4*)(rowp + col0) = w8;
                    if (pn == 2 && col0 >= C_KR && col0 < C_KR + 32) {
                        bf16_t* km = (bf16_t*)(ws + WS_KM) + (size_t)row * 768 + 64 + (col0 - C_KR);
#pragma unroll
                        for (int h = 0; h < 8; ++h) *(u32x4*)(km + h * 96) = w8;
                    }
                }
            }
    }
};
struct EpiQ {
    static constexpr bool PERM = true, AFTER_DRAIN = false;
    unsigned char* ws;
    DI void operator()(const f32x4 (&acc)[2][2][4][2], const pg8::Unit& u, int wr, int wc, int fr, int fq) const {
        bf16_t* QM = (bf16_t*)(ws + WS_QM); const float* cosM = (const float*)(ws + WS_COSM); const float* sinM = (const float*)(ws + WS_SINM);
        const bool ctxt = (u.pm % 33) == 0;
        const int rowt = u.pm * 256 + wr * 64 + fr, colb = u.pn * 256 + wc * 32 + 8 * fq;
#pragma unroll
        for (int ai = 0; ai < 2; ++ai)
#pragma unroll
            for (int m = 0; m < 4; ++m) {
                const int row = rowt + ai * 128 + m * 16; const int pos = (row % RB) - CTX;
                const float* pr = (const float*)(ws + WS_PART) + (size_t)row * 20;
                const f32x4 q0 = *(const f32x4*)pr, q1 = *(const f32x4*)(pr + 4), q2 = *(const f32x4*)(pr + 8);
                const float rq = QS96 / sqrtf((((q0[0] + q0[1]) + (q0[2] + q0[3])) + ((q1[0] + q1[1]) + (q1[2] + q1[3])) + ((q2[0] + q2[1]) + (q2[2] + q2[3]))) * (1.0f / 384.0f) + EPS);
#pragma unroll
                for (int bj = 0; bj < 2; ++bj) {
                    const int col0 = colb + bj * 128, within = col0 % 96;
                    f32x4 v0 = acc[ai][bj][m][0], v1 = acc[ai][bj][m][1];
                    if (!ctxt && within >= 64) { const int p0 = (within - 64) >> 1; const f32x4 cs = *(const f32x4*)(cosM + (size_t)pos * 16 + p0), sn = *(const f32x4*)(sinM + (size_t)pos * 16 + p0); rope8(v0, v1, cs, sn); }
                    v0 = v0 * rq; v1 = v1 * rq;
                    *(u32x4*)(QM + (size_t)row * 768 + col0) = pack8(v0, v1);
                }
                asm volatile("" ::: "memory");
            }
    }
};
struct EpiKV {
    static constexpr bool PERM = true, AFTER_DRAIN = false;
    unsigned char* ws;
    DI void operator()(const f32x4 (&acc)[2][2][4][2], const pg8::Unit& u, int wr, int wc, int fr, int fq) const {
        bf16_t* KM = (bf16_t*)(ws + WS_KM); bf16_t* VM = (bf16_t*)(ws + WS_VM);
        const int rowt = u.pm * 256 + wr * 64 + fr, colb = u.pn * 256 + wc * 32 + 8 * fq;
#pragma unroll
        for (int ai = 0; ai < 2; ++ai)
#pragma unroll
            for (int m = 0; m < 4; ++m) {
                const int row = rowt + ai * 128 + m * 16;
                const float* pr = (const float*)(ws + WS_PART) + (size_t)row * 20 + 12;
                const f32x4 k0 = *(const f32x4*)pr, k1 = *(const f32x4*)(pr + 4);
                const float rkv = 1.0f / sqrtf((((k0[0] + k0[1]) + (k0[2] + k0[3])) + ((k1[0] + k1[1]) + (k1[2] + k1[3]))) * (1.0f / 256.0f) + EPS);
#pragma unroll
                for (int bj = 0; bj < 2; ++bj) {
                    const int col0 = colb + bj * 128;
                    bf16_t* dst = (col0 < 512) ? KM + (size_t)row * 768 + (col0 >> 6) * 96 + (col0 & 63) : VM + (size_t)row * 1024 + (col0 - 512);
                    *(u32x4*)dst = pack8(acc[ai][bj][m][0] * rkv, acc[ai][bj][m][1] * rkv);
                }
                asm volatile("" ::: "memory");
            }
    }
};
template <bool DRYE> struct EpiBrT {
    static constexpr bool PERM = true, AFTER_DRAIN = false;
    unsigned char* ws;
    DI void operator()(const f32x4 (&acc)[2][2][4][2], const pg8::Unit& u, int wr, int wc, int fr, int fq) const {
        bf16_t* P = (bf16_t*)(ws + WS_P);
        unsigned chk = 0u;
        const int rowt = u.pm * 256 + wr * 64 + fr, colb = u.pn * 256 + wc * 32 + 8 * fq;
#pragma unroll
        for (int ai = 0; ai < 2; ++ai)
#pragma unroll
            for (int m = 0; m < 4; ++m) {
                const int row = rowt + ai * 128 + m * 16;
#pragma unroll
                for (int bj = 0; bj < 2; ++bj) {
                    bf16_t* p = P + (size_t)row * NP + C_GM + colb + bj * 128;
                    const u32x4 g = *(const u32x4*)p;
                    f32x4 v0 = acc[ai][bj][m][0], v1 = acc[ai][bj][m][1];
                    v0[0] *= sigm_f(bflo(g.x)); v0[1] *= sigm_f(bfhi(g.x)); v0[2] *= sigm_f(bflo(g.y)); v0[3] *= sigm_f(bfhi(g.y));
                    v1[0] *= sigm_f(bflo(g.z)); v1[1] *= sigm_f(bfhi(g.z)); v1[2] *= sigm_f(bflo(g.w)); v1[3] *= sigm_f(bfhi(g.w));
                    { const u32x4 w_ = pack8(v0, v1); if (!DRYE) *(u32x4*)p = w_; else chk ^= w_.x ^ w_.y ^ w_.z ^ w_.w; }
                }
            }
        if (DRYE && chk == 0x12345678u) *(unsigned*)P = chk;
    }
};
template <bool DRYE> struct EpiOutT {
    static constexpr bool PERM = true, AFTER_DRAIN = false;
    int l, g; const float* xsrc; float* xdst; const float* ctxsrc; unsigned char* ws;
    DI void operator()(const f32x4 (&acc)[2][2][4][2], const pg8::Unit& u, int wr, int wc, int fr, int fq) const {
        float* ctxdst = (float*)(ws + WS_CTX); const float* mod = (const float*)(ws + WS_MOD) + (size_t)l * 9 * 3072;
        const int pmb = u.pm % 33, b = g * GB + u.pm / 33; const bool ctxt = pmb == 0;
        if (ctxt && l != 0) return;
        const float* gate = mod + (size_t)(ctxt ? 8 : b) * 3072 + 2048;
        const int colb = u.pn * 256 + wc * 32 + 8 * fq;
#pragma unroll
        for (int ai = 0; ai < 2; ++ai)
#pragma unroll
            for (int m = 0; m < 4; ++m) {
                const int j = pmb * 256 + ai * 128 + wr * 64 + m * 16 + fr;
                const size_t idx = ctxt ? ((size_t)b * CTX + j) * DM : ((size_t)b * SEQ + (j - CTX)) * DM;
                const float* s = (ctxt ? ctxsrc : xsrc) + idx; float* d = (ctxt ? ctxdst : xdst) + idx;
#pragma unroll
                for (int bj = 0; bj < 2; ++bj) {
                    const int col0 = colb + bj * 128;
                    const f32x4 g0 = *(const f32x4*)(gate + col0), g1 = *(const f32x4*)(gate + col0 + 4);
                    const f32x4 x0 = *(const f32x4*)(s + col0), x1 = *(const f32x4*)(s + col0 + 4);
                    if (!DRYE || x0[0] == 12345.678f) { *(f32x4*)(d + col0) = x0 + g0 * acc[ai][bj][m][0];
                    *(f32x4*)(d + col0 + 4) = x1 + g1 * acc[ai][bj][m][1]; }
                }
            }
    }
};

#define MFMA32(a, b, c) __builtin_amdgcn_mfma_f32_32x32x16_bf16((a), (b), (c), 0, 0, 0)
DI s16x4 tr16(const LAS unsigned char* p) { typedef short v4i16_t __attribute__((ext_vector_type(4))); return __builtin_bit_cast(s16x4, __builtin_amdgcn_ds_read_tr16_b64_v4i16((LAS v4i16_t*)p)); }
constexpr int AT_KOFF = 0, AT_KBUFMAX = 13312, AT_VOFF = 3 * AT_KBUFMAX, AT_VBUFMAX = 20480, AT_SOFF = AT_VOFF + 3 * AT_VBUFMAX, AT_QOFF = AT_SOFF + 1024;
static_assert(AT_QOFF + 8 * 6144 <= LDS_BYTES, "attention LDS map");
#ifndef AT_NEGM
#define AT_NEGM 0
#endif
#ifndef AT_LAZY_THR
#define AT_LAZY_THR 1048576.0f
#endif
#ifndef AT_LAZY
#define AT_LAZY 1
#endif
#ifndef AT_NOPF
#define AT_NOPF 1
#endif
#ifndef AT_IGLP
#define AT_IGLP -1
#endif
#ifndef AT_QLMIN
#define AT_QLMIN 64
#endif
#ifndef AT_PVKS
#define AT_PVKS 1
#endif
#ifndef AT_SGB
#define AT_SGB 0
#endif
#ifndef AT_PV8
#define AT_PV8 1
#endif
#ifndef AT_NOSBAR
#define AT_NOSBAR 1
#endif
#if AT_NOSBAR
#define SBAR() do {} while (0)
#else
#define SBAR() __builtin_amdgcn_sched_barrier(0)
#endif
#ifndef PROBE_MODE
#define PROBE_MODE 0
#endif
#ifndef DRY_SEL
#define DRY_SEL 7
#endif
#ifndef AT_QL
#define AT_QL 0
#endif
#ifndef AT_SB
#define AT_SB 0
#endif
template <int DQK, bool QL, bool NG = false>
DI void at_qkt(f32x16& p0, f32x16& p1, const LAS unsigned char* kb, const bf16x8* qf, const LAS unsigned char* qb, const f32x16* c0 = nullptr) {
    constexpr int KSTR = DQK + 8;
    if (!NG) {
#pragma unroll
        for (int r = 0; r < 16; ++r) { p0[r] = 0.f; p1[r] = 0.f; }
    }
#pragma unroll
    for (int ds = 0; ds < DQK / 16; ++ds) {
        const bf16x8 k0 = *(const LAS bf16x8*)(kb + ds * 32), k1 = *(const LAS bf16x8*)(kb + 32 * (KSTR * 2) + ds * 32);
        bf16x8 q; if (QL) q = *(const LAS bf16x8*)(qb + ds * 1024); else q = qf[ds];
        if (NG && ds == 0) { p0 = MFMA32(k0, q, *c0); p1 = MFMA32(k1, q, *c0); } else { p0 = MFMA32(k0, q, p0); p1 = MFMA32(k1, q, p1); }
        if (AT_SB && DQK > 64 && (ds & 1)) __builtin_amdgcn_sched_barrier(0x7f); }
}
DI void at_mask(f32x16& p0, f32x16& p1, int dk) {
#pragma unroll
    for (int r = 0; r < 16; ++r) { const int d = dk + (r & 3) + 8 * (r >> 2);
        if (d > 128 || d < -128) p0[r] = NEGBIG;
        if (d + 32 > 128 || d + 32 < -128) p1[r] = NEGBIG; }
}
DI void at_psm(f32x16& p0, f32x16& p1, float& mrun, float& alpha) {
    float ma = fmaxf(fmaxf(p0[0], p0[1]), p0[2]), mb = fmaxf(fmaxf(p1[0], p1[1]), p1[2]);
    ma = fmaxf(fmaxf(ma, p0[3]), p1[3]);
#pragma unroll
    for (int r = 4; r < 16; r += 2) { ma = fmaxf(fmaxf(ma, p0[r]), p0[r + 1]); mb = fmaxf(fmaxf(mb, p1[r]), p1[r + 1]); }
    float mx = fmaxf(ma, mb);
    { auto rr = __builtin_amdgcn_permlane32_swap(__float_as_uint(mx), __float_as_uint(mx), false, false); mx = fmaxf(__uint_as_float(rr[0]), __uint_as_float(rr[1])); }
    const bool keep = __all(mx - mrun <= THR);
    const float mn = keep ? mrun : fmaxf(mrun, mx); alpha = __builtin_amdgcn_exp2f(mrun - mn); mrun = mn;
#pragma unroll
    for (int r = 0; r < 16; ++r) { p0[r] -= mrun; p1[r] -= mrun; }
#pragma unroll
    for (int r = 0; r < 16; ++r) p0[r] = __builtin_amdgcn_exp2f(p0[r]);
}
template <int DV> DI void at_scale_o(f32x16* o, LAS float* scw, float val, int r32, int hi);
template <bool NG>
DI void at_psm_lazy(f32x16& p0, f32x16& p1, float mrun) {
    if (!NG) {
#pragma unroll
        for (int r = 0; r < 16; ++r) { p0[r] -= mrun; p1[r] -= mrun; }
    }
#pragma unroll
    for (int r = 0; r < 16; ++r) p0[r] = __builtin_amdgcn_exp2f(p0[r]);
}
template <int DV>
DI void at_fsm_lazy(f32x16& p0, f32x16& p1, float& mrun, float& alpha, float& lrun, bf16x8* pa, f32x16* o, LAS float* scw, int r32, int hi) {
#pragma unroll
    for (int r = 0; r < 16; ++r) p1[r] = __builtin_amdgcn_exp2f(p1[r]);
    float sa = p0[0] + p0[1], sb = p0[2] + p0[3], sc_ = p1[0] + p1[1], sd = p1[2] + p1[3];
#pragma unroll
    for (int r = 4; r < 16; r += 2) { sa = opq(sa) + p0[r]; sb = opq(sb) + p0[r + 1]; sc_ = opq(sc_) + p1[r]; sd = opq(sd) + p1[r + 1]; }
    float ps = (opq(sa) + sb) + (opq(sc_) + sd);
    alpha = 1.f;
    if (__builtin_expect(__any(!(ps <= AT_LAZY_THR)), 0)) {
        float ma = fmaxf(fmaxf(p0[0], p0[1]), p0[2]), mb = fmaxf(fmaxf(p1[0], p1[1]), p1[2]);
        ma = fmaxf(fmaxf(ma, p0[3]), p1[3]);
#pragma unroll
        for (int r = 4; r < 16; r += 2) { ma = fmaxf(fmaxf(ma, p0[r]), p0[r + 1]); mb = fmaxf(fmaxf(mb, p1[r]), p1[r + 1]); }
        float mx = fmaxf(ma, mb);
        { auto rr = __builtin_amdgcn_permlane32_swap(__float_as_uint(mx), __float_as_uint(mx), false, false); mx = fmaxf(__uint_as_float(rr[0]), __uint_as_float(rr[1])); }
        const float d = fmaxf(__builtin_amdgcn_logf(mx), 0.f);
        alpha = __builtin_amdgcn_exp2f(-d); mrun += d; ps *= alpha;
#pragma unroll
        for (int r = 0; r < 16; ++r) { p0[r] *= alpha; p1[r] *= alpha; }
        at_scale_o<DV>(o, scw, alpha, r32, hi);
    }
    lrun = lrun * alpha + ps;
    u32x4 w;
    w.x = pk2(p0[0], p0[1]); w.y = pk2(p0[2], p0[3]); w.z = pk2(p0[4], p0[5]); w.w = pk2(p0[6], p0[7]); pa[0] = __builtin_bit_cast(bf16x8, w);
    w.x = pk2(p0[8], p0[9]); w.y = pk2(p0[10], p0[11]); w.z = pk2(p0[12], p0[13]); w.w = pk2(p0[14], p0[15]); pa[1] = __builtin_bit_cast(bf16x8, w);
    w.x = pk2(p1[0], p1[1]); w.y = pk2(p1[2], p1[3]); w.z = pk2(p1[4], p1[5]); w.w = pk2(p1[6], p1[7]); pa[2] = __builtin_bit_cast(bf16x8, w);
    w.x = pk2(p1[8], p1[9]); w.y = pk2(p1[10], p1[11]); w.z = pk2(p1[12], p1[13]); w.w = pk2(p1[14], p1[15]); pa[3] = __builtin_bit_cast(bf16x8, w);
}
DI void at_fsm(f32x16& p0, f32x16& p1, float alpha, float& lrun, bf16x8* pa) {
#pragma unroll
    for (int r = 0; r < 16; ++r) p1[r] = __builtin_amdgcn_exp2f(p1[r]);
    float ps = 0.f;
#pragma unroll
    for (int r = 0; r < 16; ++r) ps += p0[r] + p1[r];
    lrun = lrun * alpha + ps;
    u32x4 w;
    w.x = pk2(p0[0], p0[1]); w.y = pk2(p0[2], p0[3]); w.z = pk2(p0[4], p0[5]); w.w = pk2(p0[6], p0[7]); pa[0] = __builtin_bit_cast(bf16x8, w);
    w.x = pk2(p0[8], p0[9]); w.y = pk2(p0[10], p0[11]); w.z = pk2(p0[12], p0[13]); w.w = pk2(p0[14], p0[15]); pa[1] = __builtin_bit_cast(bf16x8, w);
    w.x = pk2(p1[0], p1[1]); w.y = pk2(p1[2], p1[3]); w.z = pk2(p1[4], p1[5]); w.w = pk2(p1[6], p1[7]); pa[2] = __builtin_bit_cast(bf16x8, w);
    w.x = pk2(p1[8], p1[9]); w.y = pk2(p1[10], p1[11]); w.z = pk2(p1[12], p1[13]); w.w = pk2(p1[14], p1[15]); pa[3] = __builtin_bit_cast(bf16x8, w);
}
DI void at_fsm_fake(f32x16& p0, f32x16& p1, bf16x8* pa) {
    u32x4 w;
    w.x = pk2(p0[0], p0[1]); w.y = pk2(p0[2], p0[3]); w.z = pk2(p0[4], p0[5]); w.w = pk2(p0[6], p0[7]); pa[0] = __builtin_bit_cast(bf16x8, w);
    w.x = pk2(p0[8], p0[9]); w.y = pk2(p0[10], p0[11]); w.z = pk2(p0[12], p0[13]); w.w = pk2(p0[14], p0[15]); pa[1] = __builtin_bit_cast(bf16x8, w);
    w.x = pk2(p1[0], p1[1]); w.y = pk2(p1[2], p1[3]); w.z = pk2(p1[4], p1[5]); w.w = pk2(p1[6], p1[7]); pa[2] = __builtin_bit_cast(bf16x8, w);
    w.x = pk2(p1[8], p1[9]); w.y = pk2(p1[10], p1[11]); w.z = pk2(p1[12], p1[13]); w.w = pk2(p1[14], p1[15]); pa[3] = __builtin_bit_cast(bf16x8, w);
}
template <int DV>
DI void at_pv(f32x16* o, const LAS unsigned char* vb, const bf16x8* pa) {
    constexpr int VSTR = DV + 32;
#if AT_PVKS
#pragma unroll
    for (int ks = 0; ks < 4; ++ks) {
        s16x4 vlo[DV / 32], vhi[DV / 32];
#pragma unroll
        for (int db = 0; db < DV / 32; ++db) { vlo[db] = tr16(vb + (16 * ks) * (VSTR * 2) + db * 64); vhi[db] = tr16(vb + (16 * ks + 8) * (VSTR * 2) + db * 64); }
#pragma unroll
        for (int db = 0; db < DV / 32; ++db) { const bf16x8 vf = __builtin_shufflevector(vlo[db], vhi[db], 0, 1, 2, 3, 4, 5, 6, 7); o[db] = MFMA32(pa[ks], vf, o[db]); }
    }
#else
#pragma unroll
    for (int db = 0; db < DV / 32; ++db) {
        s16x4 vlo[4], vhi[4];
#pragma unroll
        for (int ks = 0; ks < 4; ++ks) { vlo[ks] = tr16(vb + (16 * ks) * (VSTR * 2) + db * 64); vhi[ks] = tr16(vb + (16 * ks + 8) * (VSTR * 2) + db * 64); }
#pragma unroll
        for (int ks = 0; ks < 4; ++ks) { const bf16x8 vf = __builtin_shufflevector(vlo[ks], vhi[ks], 0, 1, 2, 3, 4, 5, 6, 7); o[db] = MFMA32(pa[ks], vf, o[db]); }
    }
#endif
}
template <int DV>
DI void at_scale_o(f32x16* o, LAS float* scw, float val, int r32, int hi) {
    if (hi == 0) scw[r32] = val;
    __builtin_amdgcn_wave_barrier(); asm volatile("" ::: "memory");
#pragma unroll
    for (int g4 = 0; g4 < 4; ++g4) { const f32x4 a4 = *(const LAS f32x4*)(scw + 8 * g4 + 4 * hi);
#pragma unroll
        for (int db = 0; db < DV / 32; ++db) { o[db][4 * g4 + 0] *= a4[0]; o[db][4 * g4 + 1] *= a4[1]; o[db][4 * g4 + 2] *= a4[2]; o[db][4 * g4 + 3] *= a4[3]; } }
    __builtin_amdgcn_wave_barrier(); asm volatile("" ::: "memory");
}
template <int DQK, int DV, int OUTM, bool MASKED>
DI void attn_unit(LAS unsigned char* lds, const bf16_t* Qp, int ldq, const bf16_t* Kp, int ldk, const bf16_t* Vp, int ldv,
                  int nA, int rowB0, int nB, int posB0, int qpos0, float m0, float l0,
                  bf16_t* Og, int ldo, float* Of, int ldof) {
    constexpr int KSTR = DQK + 8, VSTR = DV + 32, KBUF = 64 * KSTR * 2, VBUF = 64 * VSTR * 2;
    constexpr int KCH = DQK / 8, VCH = DV / 8, NKC = 64 * KCH, NVC = 64 * VCH, KRN = (NKC + 511) / 512, VRN = (NVC + 511) / 512;
    static_assert(KBUF <= AT_KBUFMAX && VBUF <= AT_VBUFMAX, "attention LDS map");
    const int tid = tid_l(), lane = tid & 63, wid = __builtin_amdgcn_readfirstlane(tid >> 6), r32 = lane & 31, hi = lane >> 5;
#ifndef AT_QL
#define AT_QL 0
#endif
#ifndef AT_SB
#define AT_SB 0
#endif
    constexpr bool NG = (AT_NEGM == 1 && DQK == 64) || (AT_NEGM == 2 && DQK == 64 && DV == 64);
    constexpr bool QL = AT_QL && (DQK > AT_QLMIN || (NG && DV == 128));
    bf16x8 qf[QL ? 1 : DQK / 16];
    const LAS unsigned char* qb = lds + AT_QOFF + wid * 6144 + lane * 16;
    { const bf16_t* qrow = Qp + (size_t)(32 * wid + r32) * ldq + 8 * hi;
#pragma unroll
      for (int ds = 0; ds < DQK / 16; ++ds) { const bf16x8 v = *(const bf16x8*)(qrow + 16 * ds); if (QL) *(LAS bf16x8*)(lds + AT_QOFF + wid * 6144 + lane * 16 + ds * 1024) = v; else qf[QL ? 0 : ds] = v; }
      if (QL) { __builtin_amdgcn_wave_barrier(); asm volatile("s_waitcnt lgkmcnt(0)" ::: "memory"); } }
    f32x16 o[DV / 32];
#pragma unroll
    for (int db = 0; db < DV / 32; ++db)
#pragma unroll
        for (int r = 0; r < 16; ++r) o[db][r] = 0.f;
    float mrun = m0, lrun = (hi == 0) ? l0 : 0.f;
    LAS float* scw = (LAS float*)(lds + AT_SOFF) + wid * 32;
    const int NT = nA + nB;
    const LAS unsigned char* kb0 = lds + AT_KOFF + r32 * (KSTR * 2) + hi * 16;
    const LAS unsigned char* vb0 = lds + AT_VOFF + (4 * hi + ((lane & 15) >> 2)) * (VSTR * 2) + (16 * ((lane >> 4) & 1) + 4 * (lane & 3)) * 2;
    const int dk0 = posB0 + 4 * hi - (qpos0 + 32 * wid + r32) - 64 * nA;
    u32x4 kreg[KRN], vreg[VRN];
    int kgo[KRN], klo[KRN], vgo[VRN], vlo_[VRN];
#pragma unroll
    for (int i_ = 0; i_ < KRN; ++i_) { int c_ = tid + 512 * i_; if (c_ >= NKC) c_ -= 512; const int r_ = c_ / KCH, cc_ = c_ % KCH; kgo[i_] = r_ * ldk + cc_ * 8; klo[i_] = AT_KOFF + r_ * (KSTR * 2) + cc_ * 16; }
#pragma unroll
    for (int i_ = 0; i_ < VRN; ++i_) { int c_ = tid + 512 * i_; if (c_ >= NVC) c_ -= 512; const int r_ = c_ / VCH, cc_ = c_ % VCH; vgo[i_] = r_ * ldv + cc_ * 8; vlo_[i_] = AT_VOFF + r_ * (VSTR * 2) + cc_ * 16; }
    const __amdgpu_buffer_rsrc_t rK = __builtin_amdgcn_make_buffer_rsrc((void*)Kp, 0, 0x7fffffff, 0x00020000), rV = __builtin_amdgcn_make_buffer_rsrc((void*)Vp, 0, 0x7fffffff, 0x00020000);
#define AT_GLOAD(t) do { const int row0_ = (t) < nA ? 64 * (t) : rowB0 + 64 * ((t) - nA); const int sk_ = row0_ * ldk * 2, sv_ = row0_ * ldv * 2; \
        _Pragma("unroll") for (int i_ = 0; i_ < KRN; ++i_) kreg[i_] = __builtin_amdgcn_raw_buffer_load_b128(rK, kgo[i_] * 2, sk_, 0); \
        _Pragma("unroll") for (int i_ = 0; i_ < VRN; ++i_) vreg[i_] = __builtin_amdgcn_raw_buffer_load_b128(rV, vgo[i_] * 2, sv_, 0); } while (0)
#define AT_SWRITE(buf) do { \
        _Pragma("unroll") for (int i_ = 0; i_ < KRN; ++i_) *(LAS u32x4*)(lds + (buf) * KBUF + klo[i_]) = kreg[i_]; \
        _Pragma("unroll") for (int i_ = 0; i_ < VRN; ++i_) *(LAS u32x4*)(lds + (buf) * VBUF + vlo_[i_]) = vreg[i_]; } while (0)
    unsigned pfv = 0u, pfacc = 0u;
    const int pft = tid & 255;
    const bf16_t* pfb = (pft < 128) ? Kp + (pft >> 1) * ldk + (pft & 1) * (DQK - 2) : Vp + ((pft - 128) >> 1) * ldv + (pft & 1) * (DV - 2);
    const int pfs = (pft < 128) ? ldk : ldv;
    constexpr int PFD = 4;
#if AT_NOPF
#define AT_PF(t) do {} while (0)
#else
#define AT_PF(t) do { pfacc ^= pfv; const int tt_ = (t) < NT ? (t) : NT - 1; const int row0_ = tt_ < nA ? 64 * tt_ : rowB0 + 64 * (tt_ - nA); \
        pfv = *(const unsigned*)(pfb + (size_t)row0_ * pfs); } while (0)
#endif
#define AT_MASK(P0, P1, t) do { if (MASKED && (t) >= nA) at_mask(P0, P1, dk0 + 64 * (t)); } while (0)
#define AT_RESC(al) do { if (__any((al) < 1.f)) at_scale_o<DV>(o, scw, (al), r32, hi); } while (0)
    constexpr int DRYP = (OUTM == 2) ? PROBE_MODE : 0;
    f32x16 pA0, pA1, pB0, pB1; float alA, alB; bf16x8 pa[4];
    AT_PF(1); AT_PF(2); AT_PF(3);
    AT_GLOAD(0); AT_SWRITE(0); __syncthreads();
    AT_GLOAD(1);
    at_qkt<DQK, QL>(pA0, pA1, kb0, qf, qb); AT_MASK(pA0, pA1, 0); at_psm(pA0, pA1, mrun, alA);
#if AT_LAZY
    lrun *= alA;
#endif
    AT_SWRITE(1); __syncthreads();
    int bp = 0, bc = 1, bn = 2;
    constexpr int NMF = 2 * (DQK / 16) + 4 * (DV / 32);
#if AT_IGLP >= 0
#define AT_SCHED() __builtin_amdgcn_iglp_opt(AT_IGLP)
#elif AT_SGB
#define AT_SCHED() do { _Pragma("unroll") for (int i_ = 0; i_ < NMF; ++i_) { __builtin_amdgcn_sched_group_barrier(0x008, 1, 0); __builtin_amdgcn_sched_group_barrier(0x100, 2, 0); __builtin_amdgcn_sched_group_barrier(0x002, AT_SGB, 0); } } while (0)
#else
#define AT_SCHED() do {} while (0)
#endif
#define AT_ROT() do { bp = bc; bc = bn; bn = (bn == 2) ? 0 : bn + 1; } while (0)
#if AT_LAZY
    f32x16 negm;
    if (NG) {
#pragma unroll
        for (int r = 0; r < 16; ++r) negm[r] = -mrun;
    }
#define AT_NEGUPD(al, P0, P1) do { if (NG && __any((al) < 1.f)) { const float d_ = -__builtin_amdgcn_logf(al); _Pragma("unroll") for (int r_ = 0; r_ < 16; ++r_) { negm[r_] = -mrun; P0[r_] -= d_; P1[r_] -= d_; } } } while (0)
    for (int j = 1; j + 1 < NT; j += 2) {
        at_qkt<DQK, QL, NG>(pB0, pB1, kb0 + bc * KBUF, qf, qb, &negm); AT_MASK(pB0, pB1, j);
        AT_GLOAD(j + 1);
        at_fsm_lazy<DV>(pA0, pA1, mrun, alA, lrun, pa, o, scw, r32, hi);
        AT_NEGUPD(alA, pB0, pB1);
        at_pv<DV>(o, vb0 + bp * VBUF, pa); at_psm_lazy<NG>(pB0, pB1, mrun);
        AT_SWRITE(bn);
        __syncthreads(); AT_ROT();
        at_qkt<DQK, QL, NG>(pA0, pA1, kb0 + bc * KBUF, qf, qb, &negm); AT_MASK(pA0, pA1, j + 1);
        AT_GLOAD(j + 2);
        at_fsm_lazy<DV>(pB0, pB1, mrun, alB, lrun, pa, o, scw, r32, hi);
        AT_NEGUPD(alB, pA0, pA1);
        at_pv<DV>(o, vb0 + bp * VBUF, pa); at_psm_lazy<NG>(pA0, pA1, mrun);
        AT_SWRITE(bn);
        __syncthreads(); AT_ROT();
    }
    at_qkt<DQK, QL, NG>(pB0, pB1, kb0 + bc * KBUF, qf, qb, &negm); AT_MASK(pB0, pB1, NT - 1);
    at_fsm_lazy<DV>(pA0, pA1, mrun, alA, lrun, pa, o, scw, r32, hi);
    AT_NEGUPD(alA, pB0, pB1);
    at_pv<DV>(o, vb0 + bp * VBUF, pa); at_psm_lazy<NG>(pB0, pB1, mrun);
    at_fsm_lazy<DV>(pB0, pB1, mrun, alB, lrun, pa, o, scw, r32, hi);
    at_pv<DV>(o, vb0 + bc * VBUF, pa);
#else
    for (int j = 1; j + 1 < ((DRYP == 6) ? 2 : NT); j += 2) {
        SBAR(); if (DRYP != 5) at_qkt<DQK, QL>(pB0, pB1, kb0 + bc * KBUF, qf, qb); else { _Pragma("unroll") for (int r_ = 0; r_ < 16; ++r_) { pB0[r_] = o[0][r_] * 1e-3f; pB1[r_] = o[1][r_] * 1e-3f; } } AT_MASK(pB0, pB1, j);
        if (!(DRYP >= 1)) { AT_GLOAD(j + 1); AT_PF(j + PFD); }
        if (DRYP != 3) at_fsm(pA0, pA1, alA, lrun, pa); else at_fsm_fake(pA0, pA1, pa); SBAR();
        if (DRYP != 4) at_pv<DV>(o, vb0 + bp * VBUF, pa); else { o[0][0] += __builtin_bit_cast(float, (int)pa[0][0] + (int)pa[1][1] + (int)pa[2][2] + (int)pa[3][3]); } if (DRYP != 3) at_psm(pB0, pB1, mrun, alB); else alB = 1.f;
        AT_SCHED();
        if (!(DRYP >= 1)) AT_SWRITE(bn);
        AT_RESC(alB); if (DRYP != 2) __syncthreads(); AT_ROT();
        SBAR(); if (DRYP != 5) at_qkt<DQK, QL>(pA0, pA1, kb0 + bc * KBUF, qf, qb); else { _Pragma("unroll") for (int r_ = 0; r_ < 16; ++r_) { pA0[r_] = o[0][r_] * 1e-3f; pA1[r_] = o[1][r_] * 1e-3f; } } AT_MASK(pA0, pA1, j + 1);
        if (!(DRYP >= 1)) { AT_GLOAD(j + 2); AT_PF(j + 1 + PFD); }
        if (DRYP != 3) at_fsm(pB0, pB1, alB, lrun, pa); else at_fsm_fake(pB0, pB1, pa); SBAR();
        if (DRYP != 4) at_pv<DV>(o, vb0 + bp * VBUF, pa); else { o[0][0] += __builtin_bit_cast(float, (int)pa[0][0] + (int)pa[1][1] + (int)pa[2][2] + (int)pa[3][3]); } if (DRYP != 3) at_psm(pA0, pA1, mrun, alA); else alA = 1.f;
        AT_SCHED();
        if (!(DRYP >= 1)) AT_SWRITE(bn);
        AT_RESC(alA); if (DRYP != 2) __syncthreads(); AT_ROT();
    }
    SBAR(); at_qkt<DQK, QL>(pB0, pB1, kb0 + bc * KBUF, qf, qb); AT_MASK(pB0, pB1, NT - 1);
    at_fsm(pA0, pA1, alA, lrun, pa); SBAR();
    at_pv<DV>(o, vb0 + bp * VBUF, pa); at_psm(pB0, pB1, mrun, alB);
    AT_RESC(alB);
    at_fsm(pB0, pB1, alB, lrun, pa); SBAR();
    at_pv<DV>(o, vb0 + bc * VBUF, pa);
#endif
#undef AT_ROT
#ifdef AT_NEGUPD
#undef AT_NEGUPD
#endif
#undef AT_SCHED
    pfacc ^= pfv;
    if (__builtin_expect(pfacc == 0x9e3779b9u && lrun == 12345.678f, 0)) scw[0] = 1.f;
#undef AT_GLOAD
#undef AT_PF
#undef AT_SWRITE
#undef AT_MASK
#undef AT_RESC
    { const float lt = lrun + __shfl_xor(lrun, 32); at_scale_o<DV>(o, scw, 1.0f / lt, r32, hi); }
    if (OUTM == 0) {
#pragma unroll
        for (int db = 0; db < DV / 32; ++db) {
            bf16_t* pb = Og + (size_t)(32 * wid + 4 * hi) * ldo + 32 * db + r32;
            bf16_t zz[16];
#pragma unroll
            for (int r = 0; r < 16; ++r) zz[r] = pb[(size_t)((r & 3) + 8 * (r >> 2)) * ldo];
#pragma unroll
            for (int r = 0; r < 16; ++r) { const float z = __uint_as_float((unsigned)zz[r] << 16); pb[(size_t)((r & 3) + 8 * (r >> 2)) * ldo] = (bf16_t)(pk2(o[db][r] * silu_f(z), 0.f) & 0xffffu); }
        }
    } else {
#pragma unroll
        for (int db = 0; db < DV / 32; ++db)
#pragma unroll
            for (int r = 0; r < 16; ++r) {
                const int q = (r & 3) + 8 * (r >> 2) + 4 * hi;
                if (OUTM == 1) { Of[(size_t)(32 * wid + q) * ldof + 32 * db + r32] = o[db][r]; }
                else { if (lrun == 12345.678f) Of[(size_t)(32 * wid + q) * ldof + 32 * db + r32] = o[db][r]; }
            }
    }
    __syncthreads();
}

struct Args { const float* in[21]; float* out; unsigned char* ws; };
typedef const __attribute__((address_space(4))) Args* ArgsP;
DI ArgsP args_ptr() { ArgsP p = (ArgsP)__builtin_amdgcn_kernarg_segment_ptr(); asm volatile("" : "+s"(p)); return p; }
enum { I_X = 0, I_C, I_CTX, I_CCTX, I_WMOD, I_BMOD, I_NORMG, I_WIN, I_QNORM, I_WUQ, I_KVNORM, I_WUKV, I_LQ1, I_LK1, I_LQ2, I_LK2, I_SUBLN, I_SINK, I_WBR, I_WOUT, I_FNORM };

DI int colmap(int kind, int n) {
    if (kind == 1) {
        if (n < C_KR) return n;
        if (n < C_KR + 32) { const int e = n - C_KR; return C_KR + (e >> 1) + 16 * (e & 1); }
        if (n < C_DQ) return -1;
        if ((n >= C_DQ && n < C_DV) || (n >= C_SQ && n < C_SV)) { const int w = n & 63; return (n - w) - 96 + (w >> 1) + 32 * (w & 1); }
        return n - 96;
    }
    if (kind == 2) { const int h = n / 96, e = n % 96; if (e < 64) return n; const int e2 = e - 64; return h * 96 + 64 + (e2 >> 1) + 16 * (e2 & 1); }
    if (kind == 3) { if (n < 512) return (n >> 6) * 192 + (n & 63); const int n2 = n - 512; return (n2 >> 7) * 192 + 64 + (n2 & 127); }
    return n;
}
DI void transpose_item(const float* W, int ldw, int kind, const float* rowscale, bf16_t* WT, int ldd, int koff, LAS float* scr, int item, int nblk, int lane) {
    const int kb = item / nblk, nb = item % nblk, k0 = 64 * kb, n0 = 32 * nb;
    const int oc = colmap(kind, n0 + (lane & 31));
#pragma unroll 8
    for (int i = 0; i < 32; ++i) { const int kk = 2 * i + (lane >> 5); float v = 0.f; if (oc >= 0) v = W[(size_t)(k0 + kk) * ldw + oc]; if (rowscale) v *= rowscale[k0 + kk]; scr[kk * 33 + (lane & 31)] = v; }
    __builtin_amdgcn_wave_barrier(); asm volatile("s_waitcnt lgkmcnt(0)" ::: "memory");
    const int c = lane & 7;
#pragma unroll
    for (int j = 0; j < 4; ++j) { const int n = (lane >> 3) + 8 * j; const LAS float* s = scr + (8 * c) * 33 + n;
        u32x4 o; o.x = pk2(s[0 * 33], s[1 * 33]); o.y = pk2(s[2 * 33], s[3 * 33]); o.z = pk2(s[4 * 33], s[5 * 33]); o.w = pk2(s[6 * 33], s[7 * 33]);
        *(u32x4*)(WT + (size_t)(n0 + n) * ldd + koff + k0 + 8 * c) = o; }
    __builtin_amdgcn_wave_barrier(); asm volatile("s_waitcnt lgkmcnt(0)" ::: "memory");
}
DI void prologue(ArgsP ap, LAS unsigned char* lds) {
    const int tid = tid_l(), lane = tid & 63, wid = __builtin_amdgcn_readfirstlane(tid >> 6);
    unsigned char* ws = ap->ws;
    LAS float* scr = (LAS float*)(lds + wid * 8448);
    const int gw = bid_l() * 8 + wid, NGW = grd_l() * 8;
    constexpr int I_IN = 16 * (NP / 32), I_UQ = 6 * 24, I_UKV = 4 * 48, I_SQ = 16 * 32, PER_L = I_IN + I_UQ + I_UKV + 6 * I_SQ;
    for (int it = gw; it < 2 * PER_L; it += NGW) {
        const int l = it / PER_L; int r = it % PER_L;
        if (r < I_IN) { transpose_item(ap->in[I_WIN] + (size_t)l * 1024 * D_IN, D_IN, 1, nullptr, (bf16_t*)(ws + WS_WIN) + (size_t)l * NP * 1024, 1024, 0, scr, r, NP / 32, lane); continue; } r -= I_IN;
        if (r < I_UQ) { transpose_item(ap->in[I_WUQ] + (size_t)l * 384 * 768, 768, 2, ap->in[I_QNORM] + l * 384, (bf16_t*)(ws + WS_WUQ) + (size_t)l * 768 * 384, 384, 0, scr, r, 24, lane); continue; } r -= I_UQ;
        if (r < I_UKV) { transpose_item(ap->in[I_WUKV] + (size_t)l * 256 * 1536, 1536, 3, ap->in[I_KVNORM] + l * 256, (bf16_t*)(ws + WS_WUKV) + (size_t)l * 1536 * 256, 256, 0, scr, r, 48, lane); continue; } r -= I_UKV;
        if (r < 3 * I_SQ) { const int br = r / I_SQ; transpose_item(ap->in[I_WBR] + ((size_t)l * 3 + br) * 1024 * 1024, 1024, 0, nullptr, (bf16_t*)(ws + WS_WB) + ((size_t)l * 3 + br) * 1024 * 1024, 1024, 0, scr, r % I_SQ, 32, lane); continue; } r -= 3 * I_SQ;
        { const int rep = r / I_SQ; transpose_item(ap->in[I_WOUT] + (size_t)l * 1024 * 1024, 1024, 0, nullptr, (bf16_t*)(ws + WS_WO3) + (size_t)l * 1024 * 3072, 3072, rep * 1024, scr, r % I_SQ, 32, lane); }
    }
    const int gt = bid_l() * 512 + tid, NGT = grd_l() * 512;
    for (int i = gt; i < SEQ * 48; i += NGT) {
        const int pos = i / 48, p = i % 48; const float frow = (float)(pos >> 6), fcol = (float)(pos & 63);
        float ang; float* cd; float* sd;
        if (p < 32) { const int f = p & 15; const float inv = powf(10000.0f, -(float)f / 16.0f); ang = (p < 16 ? frow : fcol) * inv; cd = (float*)(ws + WS_COSH) + pos * 32 + p; sd = (float*)(ws + WS_SINH) + pos * 32 + p; }
        else { const int pp = p - 32, f = pp & 7; const float inv = powf(10000.0f, -(float)f / 8.0f); ang = (pp < 8 ? frow : fcol) * inv; cd = (float*)(ws + WS_COSM) + pos * 16 + pp; sd = (float*)(ws + WS_SINM) + pos * 16 + pp; }
        *cd = __cosf(ang); *sd = __sinf(ang);
    }
    for (int it = gw; it < 2 * 16 * 48; it += NGW) {
        const int l = it / 768, rem = it % 768, kc = rem / 48, nb = rem % 48; const int k = kc * 64 + lane;
        float sv[9];
#pragma unroll
        for (int v = 0; v < 8; ++v) sv[v] = silu_f(ap->in[I_C][v * 1024 + k]);
        sv[8] = silu_f(ap->in[I_CCTX][k]);
        float acc[9];
#pragma unroll
        for (int v = 0; v < 9; ++v) acc[v] = 0.f;
        const float* w = ap->in[I_WMOD] + ((size_t)l * 1024 + kc * 64) * 3072 + nb * 64 + lane;
#pragma unroll 8
        for (int kk = 0; kk < 64; ++kk) { const float wv = w[(size_t)kk * 3072];
#pragma unroll
            for (int v = 0; v < 9; ++v) acc[v] += __uint_as_float(__builtin_amdgcn_readlane(__float_as_uint(sv[v]), kk)) * wv; }
        float* mp = (float*)(ws + WS_MODP) + ((size_t)(l * 16 + kc) * 9) * 3072 + nb * 64 + lane;
#pragma unroll
        for (int v = 0; v < 9; ++v) mp[(size_t)v * 3072] = acc[v];
    }
}
DI void mod_finalize(ArgsP ap) {
    const int tid = tid_l();
    const int gt = bid_l() * 512 + tid, NGT = grd_l() * 512;
    const float* mp = (const float*)(ap->ws + WS_MODP); float* mod = (float*)(ap->ws + WS_MOD);
    for (int i = gt; i < 2 * 9 * 3072; i += NGT) {
        const int l = i / (9 * 3072), rem = i % (9 * 3072), n = rem % 3072;
        float s = ap->in[I_BMOD][l * 3072 + n];
#pragma unroll
        for (int kc = 0; kc < 16; ++kc) s += mp[(size_t)(l * 16 + kc) * 9 * 3072 + rem];
        mod[i] = s;
    }
}
DI void ph_norm_mod(ArgsP ap, int l, int g) {
    const int tid = tid_l(), lane = tid & 63, wid = __builtin_amdgcn_readfirstlane(tid >> 6);
    const int gw = bid_l() * 8 + wid, NGW = grd_l() * 8;
    const float* ng = ap->in[I_NORMG] + l * 1024; const float* mod = (const float*)(ap->ws + WS_MOD) + (size_t)l * 9 * 3072;
    const float* xs = (l == 0) ? ap->in[I_X] : ap->out; const float* cs = (l == 0) ? ap->in[I_CTX] : (const float*)(ap->ws + WS_CTX);
    bf16_t* H = (bf16_t*)(ap->ws + WS_H);
    for (int r = gw; r < R; r += NGW) {
        const int bl = r / RB, j = r % RB, b = g * GB + bl;
        const float* src; const float* md;
        if (j < CTX) { src = cs + ((size_t)b * CTX + j) * DM; md = mod + 8 * 3072; } else { src = xs + ((size_t)b * SEQ + (j - CTX)) * DM; md = mod + (size_t)b * 3072; }
        f32x4 v[4]; float ss = 0.f;
#pragma unroll
        for (int q = 0; q < 4; ++q) { v[q] = *(const f32x4*)(src + 4 * (lane + 64 * q)); ss += (v[q][0] * v[q][0] + v[q][1] * v[q][1]) + (v[q][2] * v[q][2] + v[q][3] * v[q][3]); }
        const float rstd = 1.0f / sqrtf(wave_sum(ss) * (1.0f / DM) + EPS);
#pragma unroll
        for (int q = 0; q < 4; ++q) { const int idx = 4 * (lane + 64 * q);
            const f32x4 gg = *(const f32x4*)(ng + idx), sh = *(const f32x4*)(md + idx), sc = *(const f32x4*)(md + 1024 + idx);
            const f32x4 y = (v[q] * rstd * gg) * (sc + 1.0f) + sh;
            u32x2 w; w.x = pk2(y[0], y[1]); w.y = pk2(y[2], y[3]); *(u32x2*)(H + (size_t)r * DM + idx) = w; }
    }
}
DI void ph_mla_norm(ArgsP ap) {
    const int tid = tid_l(), lane = tid & 63, wid = __builtin_amdgcn_readfirstlane(tid >> 6);
    const int gw = bid_l() * 8 + wid, NGW = grd_l() * 8;
    const bf16_t* P = (const bf16_t*)(ap->ws + WS_P); bf16_t* AQ = (bf16_t*)(ap->ws + WS_AQ); bf16_t* AKV = (bf16_t*)(ap->ws + WS_AKV); bf16_t* KM = (bf16_t*)(ap->ws + WS_KM);
    for (int r = gw; r < R; r += NGW) {
        const bf16_t* row = P + (size_t)r * NP;
        const u32x4 c0 = *(const u32x4*)(row + 8 * lane);
        u32x4 c1 = {0u, 0u, 0u, 0u}; if (lane < 20) c1 = *(const u32x4*)(row + 8 * (64 + lane));
        float f0[8] = {bflo(c0.x), bfhi(c0.x), bflo(c0.y), bfhi(c0.y), bflo(c0.z), bfhi(c0.z), bflo(c0.w), bfhi(c0.w)};
        float f1[8] = {bflo(c1.x), bfhi(c1.x), bflo(c1.y), bfhi(c1.y), bflo(c1.z), bfhi(c1.z), bflo(c1.w), bfhi(c1.w)};
        float s0 = 0.f, s1 = 0.f;
#pragma unroll
        for (int i = 0; i < 8; ++i) { s0 += f0[i] * f0[i]; s1 += f1[i] * f1[i]; }
        const float sq = wave_sum(lane < 48 ? s0 : 0.f);
        const float skv = wave_sum((lane >= 48 ? s0 : 0.f) + (lane < 16 ? s1 : 0.f));
        const float rq = 1.0f / sqrtf(sq * (1.0f / 384.0f) + EPS), rkv = 1.0f / sqrtf(skv * (1.0f / 256.0f) + EPS);
        { const float rr = lane < 48 ? rq : rkv; u32x4 w; w.x = pk2(f0[0] * rr, f0[1] * rr); w.y = pk2(f0[2] * rr, f0[3] * rr); w.z = pk2(f0[4] * rr, f0[5] * rr); w.w = pk2(f0[6] * rr, f0[7] * rr);
          if (lane < 48) *(u32x4*)(AQ + (size_t)r * 384 + 8 * lane) = w; else *(u32x4*)(AKV + (size_t)r * 256 + 8 * (lane - 48)) = w; }
        if (lane < 16) { u32x4 w; w.x = pk2(f1[0] * rkv, f1[1] * rkv); w.y = pk2(f1[2] * rkv, f1[3] * rkv); w.z = pk2(f1[4] * rkv, f1[5] * rkv); w.w = pk2(f1[6] * rkv, f1[7] * rkv);
            *(u32x4*)(AKV + (size_t)r * 256 + 8 * (16 + lane)) = w; }
        else if (lane < 20) {
#pragma unroll
            for (int h = 0; h < 8; ++h) *(u32x4*)(KM + (size_t)r * 768 + h * 96 + 64 + 8 * (lane - 16)) = c1; }
    }
}
template <bool DRYE>
DI void ph_diff_post(ArgsP ap, int l) {
    const int tid = tid_l(), lane = tid & 63, wid = __builtin_amdgcn_readfirstlane(tid >> 6);
    const int gw = bid_l() * 8 + wid, NGW = grd_l() * 8;
    const float lam_init = (l == 0) ? 0.2f : (0.8f - 0.6f * 0.7408182206817179f);
    const float d1 = wave_sum(ap->in[I_LQ1][l * 64 + lane] * ap->in[I_LK1][l * 64 + lane]), d2 = wave_sum(ap->in[I_LQ2][l * 64 + lane] * ap->in[I_LK2][l * 64 + lane]);
    const float lam = expf(d1) - expf(d2) + lam_init;
    const float sl0 = ap->in[I_SUBLN][l * 128 + 2 * lane] * (1.0f - lam_init), sl1 = ap->in[I_SUBLN][l * 128 + 2 * lane + 1] * (1.0f - lam_init);
    const float* OD = (const float*)(ap->ws + WS_OD); bf16_t* P = (bf16_t*)(ap->ws + WS_P);
    typedef float f32x2 __attribute__((ext_vector_type(2)));
    for (int r = gw; r < R; r += NGW) {
        if (l != 0 && (r % RB) < CTX) continue;
        const float* ob = OD + (size_t)r * 2048 + 2 * lane; unsigned* zb = (unsigned*)(P + (size_t)r * NP + C_Z + 1024 + 2 * lane);
        f32x2 o1[8], o2[8]; unsigned z[8];
#pragma unroll
        for (int h = 0; h < 8; ++h) { o1[h] = *(const f32x2*)(ob + (2 * h) * 128); o2[h] = *(const f32x2*)(ob + (2 * h + 1) * 128); z[h] = zb[h * 64]; }
#pragma unroll
        for (int h = 0; h < 8; ++h) {
            const float a0 = o1[h][0] - lam * o2[h][0], a1 = o1[h][1] - lam * o2[h][1];
            const float rstd = 1.0f / sqrtf(wave_sum(a0 * a0 + a1 * a1) * (1.0f / 128.0f) + EPS);
            if (!DRYE || rstd == 12345.678f) zb[h * 64] = pk2(a0 * rstd * sl0 * silu_f(bflo(z[h])), a1 * rstd * sl1 * silu_f(bfhi(z[h])));
        }
    }
}
template <bool DRYE>
DI void ph_final_norm(ArgsP ap) {
    const int tid = tid_l(), lane = tid & 63, wid = __builtin_amdgcn_readfirstlane(tid >> 6);
    const int gw = bid_l() * 8 + wid, NGW = grd_l() * 8; const float* fg = ap->in[I_FNORM];
    for (int r = gw; r < NBATCH * SEQ; r += NGW) {
        float* row = ap->out + (size_t)r * DM; f32x4 v[4]; float ss = 0.f;
#pragma unroll
        for (int q = 0; q < 4; ++q) { v[q] = *(const f32x4*)(row + 4 * (lane + 64 * q)); ss += (v[q][0] * v[q][0] + v[q][1] * v[q][1]) + (v[q][2] * v[q][2] + v[q][3] * v[q][3]); }
        const float rstd = 1.0f / sqrtf(wave_sum(ss) * (1.0f / DM) + EPS);
#pragma unroll
        for (int q = 0; q < 4; ++q) { const int idx = 4 * (lane + 64 * q); if (!DRYE || rstd == 12345.678f) *(f32x4*)(row + idx) = v[q] * rstd * *(const f32x4*)(fg + idx); }
    }
}
template <bool DRY>
DI void ph_attention(ArgsP ap, int l, LAS unsigned char* lds) {
    constexpr int OM0 = DRY ? 2 : 0;
    const int G = grd_l(), bx = bid_l(), vcu = (G % 8 == 0) ? (bx % 8) * (G / 8) + bx / 8 : bx;
    bf16_t* P = (bf16_t*)(ap->ws + WS_P); const bf16_t* QM = (const bf16_t*)(ap->ws + WS_QM); const bf16_t* KM = (const bf16_t*)(ap->ws + WS_KM); const bf16_t* VM = (const bf16_t*)(ap->ws + WS_VM);
    float* OD = (float*)(ap->ws + WS_OD); const float* sink = ap->in[I_SINK] + l * 16;
#if !defined(ATT_ONLY) || ATT_ONLY == 1
    if (!DRY || (DRY_SEL & 1))
    for (int u = vcu; u < GB * 8 * 32; u += G) { const int bh = u >> 5, qb = u & 31, bl = bh >> 3, h = bh & 7; const size_t rb = (size_t)bl * RB, q0 = rb + CTX + 256 * qb;
        attn_unit<96, 128, OM0, false>(lds, QM + q0 * 768 + h * 96, 768, KM + rb * 768 + h * 96, 768, VM + rb * 1024 + h * 128, 1024, RB / 64, 0, 0, 0, 0, NEGBIG, 0.f, P + q0 * NP + C_Z + h * 128, NP, OD, 0); }
#endif
#if !defined(ATT_ONLY) || ATT_ONLY == 2
    if (!DRY || (DRY_SEL & 2))
    for (int u = vcu; u < GB * 16 * 32; u += G) { const int bh = u >> 5, qb = u & 31, bl = bh >> 4, hm = bh & 15; const size_t rb = (size_t)bl * RB, q0 = rb + CTX + 256 * qb;
        attn_unit<64, 128, 1, false>(lds, P + q0 * NP + C_DQ + hm * 64, NP, P + rb * NP + C_DK + hm * 64, NP, P + rb * NP + C_DV + (hm >> 1) * 128, NP, RB / 64, 0, 0, 0, 0, NEGBIG, 0.f, nullptr, 0, OD + q0 * 2048 + hm * 128, 2048); }
#endif
#if !defined(ATT_ONLY) || ATT_ONLY == 3
    if (!DRY || (DRY_SEL & 4))
    for (int u = vcu; u < GB * 16 * 32; u += G) { const int bh = u >> 5, qb = u & 31, bl = bh >> 4, h = bh & 15; const size_t rb = (size_t)bl * RB, q0 = rb + CTX + 256 * qb;
        const int lo = (256 * qb - 128 < 0) ? 0 : 256 * qb - 128, hi = (256 * qb + 384 > SEQ) ? SEQ : 256 * qb + 384;
        attn_unit<64, 64, OM0, true>(lds, P + q0 * NP + C_SQ + h * 64, NP, P + rb * NP + C_SK + (h >> 2) * 64, NP, P + rb * NP + C_SV + (h >> 2) * 64, NP, CTX / 64, CTX + lo, (hi - lo) / 64, lo, 256 * qb, sink[h] * LOG2E, 1.0f,
                              P + q0 * NP + C_Z + 2048 + h * 64, NP, OD, 0); }
#endif
#if !defined(ATT_ONLY)
    if (l == 0) {
        for (int u = vcu; u < GB * 40; u += G) { const int bl = u / 40, k = u % 40; const size_t rb = (size_t)bl * RB;
            if (k < 8) { const int h = k;
                attn_unit<96, 128, OM0, false>(lds, QM + rb * 768 + h * 96, 768, KM + rb * 768 + h * 96, 768, VM + rb * 1024 + h * 128, 1024, CTX / 64, 0, 0, 0, 0, NEGBIG, 0.f, P + rb * NP + C_Z + h * 128, NP, OD, 0); }
            else if (k < 24) { const int hm = k - 8;
                attn_unit<64, 128, 1, false>(lds, P + rb * NP + C_DQ + hm * 64, NP, P + rb * NP + C_DK + hm * 64, NP, P + rb * NP + C_DV + (hm >> 1) * 128, NP, CTX / 64, 0, 0, 0, 0, NEGBIG, 0.f, nullptr, 0, OD + rb * 2048 + hm * 128, 2048); }
            else { const int h = k - 24;
                attn_unit<64, 64, OM0, false>(lds, P + rb * NP + C_SQ + h * 64, NP, P + rb * NP + C_SK + (h >> 2) * 64, NP, P + rb * NP + C_SV + (h >> 2) * 64, NP, CTX / 64, 0, 0, 0, 0, sink[h] * LOG2E, 1.0f, P + rb * NP + C_Z + 2048 + h * 64, NP, OD, 0); }
        }
    }
#endif
}

#define RLX_AGENT __ATOMIC_RELAXED, __HIP_MEMORY_SCOPE_AGENT
#define XB_TMO      128
#define XB_XCNT(j)  (256  + 64 * (j))
#define XB_XSUB(j)  (1280 + 64 * (j))
#define XB_XGEN(j)  (2304 + 64 * (j))
#define XB_TOP      3328
#define XB_TOPGEN   3392
#define XCD_BAR_WORDS 3456
#define XB_SPIN_CAP (1u << 18)

__device__ __forceinline__ unsigned xb_ld(unsigned* p)              { return __hip_atomic_load(p, __ATOMIC_RELAXED, __HIP_MEMORY_SCOPE_AGENT); }
__device__ __forceinline__ unsigned xb_add(unsigned* p, unsigned v) { return __hip_atomic_fetch_add(p, v, __ATOMIC_RELAXED, __HIP_MEMORY_SCOPE_AGENT); }
__device__ __forceinline__ unsigned xb_xcc_id() { return (unsigned)__builtin_amdgcn_s_getreg((3 << 11) | 20) & 0xFu; }
#define XB_SPIN(cond, bar) do { unsigned _sp = 0; while (cond) { __builtin_amdgcn_s_sleep(1); \
    if ((++_sp & 255u) == 0u) { if (xb_ld(&(bar)[XB_TMO])) break; if (_sp > XB_SPIN_CAP) { atomicAdd(&(bar)[XB_TMO], 1u); break; } } } } while (0)

struct XcdBarrier {
    unsigned* bar; unsigned x;
    volatile LAS unsigned* st;
};

__device__ __forceinline__ XcdBarrier xcd_barrier_post(unsigned* bar, volatile LAS unsigned* st) {
    XcdBarrier b; b.bar = bar; b.x = xb_xcc_id(); b.st = st;
    if (threadIdx.x == 0) (void)xb_add(&bar[XB_XCNT(b.x)], 1u);
    return b;
}
__device__ __forceinline__ void xcd_barrier_complete(unsigned* bar, unsigned x, unsigned& nloc, unsigned& nx) {
    const unsigned G = gridDim.x * gridDim.y * gridDim.z;
    unsigned sum, cnt, mine, sp = 0u;
    for (;;) {
        sum = 0u; cnt = 0u; mine = 0u;
#pragma unroll
        for (unsigned j = 0; j < 16; ++j) { const unsigned c = xb_ld(&bar[XB_XCNT(j)]); sum += c; cnt += (c > 0u) ? 1u : 0u; mine = (j == x) ? c : mine; }
        if (sum == G) break;
        __builtin_amdgcn_s_sleep(1);
        if ((++sp & 255u) == 0u) { if (xb_ld(&bar[XB_TMO])) break; if (sp > XB_SPIN_CAP) { atomicAdd(&bar[XB_TMO], 1u); break; } }
    }
    nloc = mine > 0u ? mine : 1u; nx = cnt > 0u ? cnt : 1u;
}

__device__ __forceinline__ void xcd_barrier(const XcdBarrier& b) {
    asm volatile("s_waitcnt vmcnt(0)" ::: "memory");
    __syncthreads();
    if (threadIdx.x == 0) {
        unsigned* bar = b.bar;
        __builtin_amdgcn_s_waitcnt(0);
        unsigned nloc = b.st[0], nx = b.st[1];
        if (nloc == 0u) { xcd_barrier_complete(bar, b.x, nloc, nx); b.st[0] = nloc; b.st[1] = nx; }
        const unsigned old = xb_add(&bar[XB_XSUB(b.x)], 1u);
        const unsigned gen = old / nloc;
        if (old + 1u == (gen + 1u) * nloc) {
            __builtin_amdgcn_fence(__ATOMIC_RELEASE, "agent");
            asm volatile("s_waitcnt vmcnt(0)" ::: "memory");
            const unsigned og = xb_add(&bar[XB_TOP], 1u);
            const unsigned tg = og / nx;
            if (og + 1u == (tg + 1u) * nx) xb_add(&bar[XB_TOPGEN], 1u);
            else XB_SPIN(xb_ld(&bar[XB_TOPGEN]) == tg, bar);
            __builtin_amdgcn_fence(__ATOMIC_ACQUIRE, "agent");
            xb_add(&bar[XB_XGEN(b.x)], 1u);
            asm volatile("s_waitcnt vmcnt(0)" ::: "memory");
        } else {
            XB_SPIN(xb_ld(&bar[XB_XGEN(b.x)]) == gen, bar);
            __builtin_amdgcn_fence(__ATOMIC_ACQUIRE, "agent");
            asm volatile("s_waitcnt vmcnt(0)" ::: "memory");
        }
    }
    __syncthreads();
}


__global__ void __launch_bounds__(512, 2) hybrid_fwd(Args a_unused) {
    extern __shared__ __attribute__((aligned(16))) unsigned char lds_raw[];
    LAS unsigned char* lds = (LAS unsigned char*)lds_raw;
    cg::grid_group grid = cg::this_grid();
    { volatile LAS unsigned* xst = (volatile LAS unsigned*)(lds + XB_LDS_OFF);
      if (threadIdx.x < 2) xst[threadIdx.x] = 0u;
      __syncthreads();
      (void)xcd_barrier_post((unsigned*)(args_ptr()->ws), xst); }
#define GSYNC() do { XcdBarrier b_; b_.bar = (unsigned*)(args_ptr()->ws); b_.x = xb_xcc_id(); b_.st = (volatile LAS unsigned*)(lds + XB_LDS_OFF); xcd_barrier(b_); } while (0)
#ifndef NO_PRO
    prologue(args_ptr(), lds);
#ifdef PROBE_PRO
    __syncthreads(); prologue(args_ptr(), lds);
#endif
#endif
    grid.sync();
    mod_finalize(args_ptr());
    GSYNC();
    for (int l = 0; l < 2; ++l) {
        for (int g = 0; g < NGRP; ++g) {
            ph_norm_mod(args_ptr(), lnd(l), lnd(g));
#ifdef PROBE_R1
            GSYNC(); ph_norm_mod(args_ptr(), lnd(l), lnd(g));
#endif
            GSYNC();
#ifndef NO_GEMM
            {
                unsigned char* ws = args_ptr()->ws; const int G = grd_l(), bx = bid_l();
                pg8::Gemm gm{1024, 1024, 1024}; pg8::Order S; S.init(R, NP, G, bx, ws + WS_H, 1024, (bf16_t*)(ws + WS_WIN) + (size_t)l * NP * 1024, 1024, 1 << 20, 0);
                EpiIn E{ws};
                pg8::gemm_phase<EpiIn, pg8::Order, true, true>(lds, gm, S, E);
#ifdef PROBE_G1
                __syncthreads(); pg8::gemm_phase<EpiIn, pg8::Order, true, true>(lds, gm, S, E);
#endif
            }
#endif
            GSYNC();
#ifndef NO_GEMM2
            {
                unsigned char* ws = args_ptr()->ws; const int G = grd_l(), bx = bid_l();
                pg8::Gemm gq{384, NP, 384}; pg8::Order Sq; Sq.init(R, 768, G, bx, (bf16_t*)(ws + WS_P) + C_QC, NP, (bf16_t*)(ws + WS_WUQ) + (size_t)l * 768 * 384, 384, 1 << 20, 0);
                EpiQ Eq{ws};
#ifndef NO_GQ
                pg8::gemm_phase<EpiQ, pg8::Order, true, true>(lds, gq, Sq, Eq);
#ifdef PROBE_G2
                __syncthreads(); pg8::gemm_phase<EpiQ, pg8::Order, true, true>(lds, gq, Sq, Eq);
#endif
#endif
            }
            {
                unsigned char* ws = args_ptr()->ws; const int G = grd_l(), bx = bid_l();
                pg8::Gemm gk{256, NP, 256}; pg8::Order Sk; Sk.init(R, 1536, G, bx, (bf16_t*)(ws + WS_P) + C_KVC, NP, (bf16_t*)(ws + WS_WUKV) + (size_t)l * 1536 * 256, 256, 1 << 20, 0);
                EpiKV Ek{ws};
#ifndef NO_GK
                pg8::gemm_phase<EpiKV, pg8::Order, true, true>(lds, gk, Sk, Ek);
#ifdef PROBE_G2
                __syncthreads(); pg8::gemm_phase<EpiKV, pg8::Order, true, true>(lds, gk, Sk, Ek);
#endif
#endif
            }
#endif
            GSYNC();
#ifndef NO_ATT
#ifdef PROBE_ATT
            ph_attention<true>(args_ptr(), lnd(l), lds);
            GSYNC();
#endif
            ph_attention<false>(args_ptr(), lnd(l), lds);
#endif
            GSYNC();
#ifdef PROBE_R2
            ph_diff_post<true>(args_ptr(), lnd(l)); GSYNC();
#endif
            ph_diff_post<false>(args_ptr(), lnd(l));
            GSYNC();
#ifndef NO_BR
            {
                unsigned char* ws = args_ptr()->ws; const int G = grd_l(), bx = bid_l();
                pg8::Gemm gb{1024, NP, 1024}; pg8::Order S; S.init(R, 3072, G, bx, (bf16_t*)(ws + WS_P) + C_Z, NP, (bf16_t*)(ws + WS_WB) + (size_t)l * 3 * 1024 * 1024, 1024, 4, 1024 * 2, l != 0);
#ifdef PROBE_BR
                { EpiBrT<true> Ed{ws}; pg8::gemm_phase<EpiBrT<true>, pg8::Order, true, true>(lds, gb, S, Ed); __syncthreads(); }
#endif
                EpiBrT<false> E{ws};
                pg8::gemm_phase<EpiBrT<false>, pg8::Order, true, true>(lds, gb, S, E);
            }
#endif
            GSYNC();
#ifndef NO_OUT
            {
                ArgsP ap = args_ptr(); unsigned char* ws = ap->ws; const int G = grd_l(), bx = bid_l();
                pg8::Gemm go{3072, NP, 3072}; pg8::Order S; S.init(R, 1024, G, bx, (bf16_t*)(ws + WS_P) + C_GM, NP, (bf16_t*)(ws + WS_WO3) + (size_t)l * 1024 * 3072, 3072, 1 << 20, 0, l != 0);
#ifdef PROBE_OUT
                { EpiOutT<true> Ed{l, g, (l == 0) ? ap->in[I_X] : (const float*)ap->out, ap->out, ap->in[I_CTX], ws}; pg8::gemm_phase<EpiOutT<true>, pg8::Order, true, true>(lds, go, S, Ed); __syncthreads(); }
#endif
                EpiOutT<false> E{l, g, (l == 0) ? ap->in[I_X] : (const float*)ap->out, ap->out, ap->in[I_CTX], ws};
                pg8::gemm_phase<EpiOutT<false>, pg8::Order, true, true>(lds, go, S, E);
            }
#endif
        }
        GSYNC();
    }
#ifdef PROBE_R2
    ph_final_norm<true>(args_ptr()); GSYNC();
#endif
    ph_final_norm<false>(args_ptr());
}

extern "C" void kernel_launch(void* const* d_in, const int* in_sizes, int n_in, void* d_out, int out_size, void* d_ws, size_t ws_size, hipStream_t stream) {
    static int grid = 0;
    if (grid == 0) {
        if (n_in != 21 || ws_size < WS_END) { fprintf(stderr, "kernel_launch: expected 21 inputs and >= %zu bytes of workspace (got %d, %zu)\n", (size_t)WS_END, n_in, ws_size); grid = -1; return; }
        int dev = 0, cus = 0, per_cu = 0;
        (void)hipGetDevice(&dev); (void)hipDeviceGetAttribute(&cus, hipDeviceAttributeMultiprocessorCount, dev);
        if (hipFuncSetAttribute((const void*)hybrid_fwd, hipFuncAttributeMaxDynamicSharedMemorySize, LDS_BYTES) != hipSuccess) fprintf(stderr, "kernel_launch: hipFuncSetAttribute failed\n");
        if (hipOccupancyMaxActiveBlocksPerMultiprocessor(&per_cu, (const void*)hybrid_fwd, 512, LDS_BYTES) != hipSuccess || per_cu < 1) { per_cu = 1; (void)hipGetLastError(); }
        if (cus <= 0) cus = 256;
        grid = cus * per_cu;
    }
    if (grid < 0) return;
    Args a{};
    for (int i = 0; i < 21; ++i) a.in[i] = (const float*)d_in[i];
    a.out = (float*)d_out; a.ws = (unsigned char*)d_ws;
    (void)hipMemsetAsync(d_ws, 0, 16384, stream);
    void* args[] = {&a};
    hipError_t e = hipLaunchCooperativeKernel((const void*)hybrid_fwd, dim3(grid), dim3(512), args, LDS_BYTES, stream);
    if (e != hipSuccess) fprintf(stderr, "kernel_launch: cooperative launch failed: %s (grid %d)\n", hipGetErrorString(e), grid);
}
```

```cpp
#include <hip/hip_runtime.h>
#include <hip/hip_cooperative_groups.h>
#include <cstdio>
#include <cstdint>
namespace cg = cooperative_groups;

#define DI __device__ __forceinline__
#define LAS __attribute__((address_space(3)))
__device__ __forceinline__ int tid_l() { int t = threadIdx.x; asm volatile("" : "+v"(t)); return t; }
__device__ __forceinline__ int bid_l() { int b = blockIdx.x; asm volatile("" : "+s"(b)); return b; }
__device__ __forceinline__ int lnd(int x) { asm volatile("" : "+s"(x)); return x; }
__device__ __forceinline__ int grd_l() { int g = gridDim.x; asm volatile("" : "+s"(g)); return g; }
typedef unsigned short bf16_t;
typedef short bf16x8 __attribute__((ext_vector_type(8)));
typedef short s16x4 __attribute__((ext_vector_type(4)));
typedef float f32x4 __attribute__((ext_vector_type(4)));
typedef float f32x16 __attribute__((ext_vector_type(16)));
typedef unsigned u32x4 __attribute__((ext_vector_type(4)));
typedef unsigned u32x2 __attribute__((ext_vector_type(2)));

constexpr int DM = 1024, NBATCH = 8, SEQ = 8192, CTX = 256, RB = CTX + SEQ;
constexpr int GB = 2, NGRP = NBATCH / GB, R = GB * RB;
constexpr int NP = 11520;
constexpr int C_QC = 0, C_KVC = 384, C_KR = 640, C_DQ = 768, C_DK = 1792, C_DV = 2816, C_SQ = 3840, C_SK = 4864, C_SV = 5120, C_Z = 5376, C_GM = 8448;
constexpr int D_IN = 11424;
constexpr float EPS = 1e-6f, LOG2E = 1.4426950408889634f;
constexpr float QS64 = 0.125f * LOG2E, QS96 = 0.10206207261596575f * LOG2E;
constexpr float NEGBIG = -1e30f, THR = 8.0f;

constexpr size_t al256(size_t x) { return (x + 255) & ~(size_t)255; }
constexpr size_t WS_WIN = 1u << 20;
constexpr size_t WS_WUQ = al256(WS_WIN + (size_t)2 * NP * 1024 * 2);
constexpr size_t WS_WUKV = al256(WS_WUQ + (size_t)2 * 768 * 384 * 2);
constexpr size_t WS_WB = al256(WS_WUKV + (size_t)2 * 1536 * 256 * 2);
constexpr size_t WS_WO3 = al256(WS_WB + (size_t)2 * 3 * 1024 * 1024 * 2);
constexpr size_t WS_COSH = al256(WS_WO3 + (size_t)2 * 1024 * 3072 * 2);
constexpr size_t WS_SINH = al256(WS_COSH + (size_t)SEQ * 32 * 4);
constexpr size_t WS_COSM = al256(WS_SINH + (size_t)SEQ * 32 * 4);
constexpr size_t WS_SINM = al256(WS_COSM + (size_t)SEQ * 16 * 4);
constexpr size_t WS_MODP = al256(WS_SINM + (size_t)SEQ * 16 * 4);
constexpr size_t WS_MOD = al256(WS_MODP + (size_t)16 * 2 * 9 * 3072 * 4);
constexpr size_t WS_CTX = al256(WS_MOD + (size_t)2 * 9 * 3072 * 4);
constexpr size_t WS_H = al256(WS_CTX + (size_t)NBATCH * CTX * DM * 4);
constexpr size_t WS_P = al256(WS_H + (size_t)R * DM * 2);
constexpr size_t WS_AQ = al256(WS_P + (size_t)R * NP * 2);
constexpr size_t WS_AKV = al256(WS_AQ + (size_t)R * 384 * 2);
constexpr size_t WS_QM = al256(WS_AKV + (size_t)R * 256 * 2);
constexpr size_t WS_KM = al256(WS_QM + (size_t)R * 768 * 2);
constexpr size_t WS_VM = al256(WS_KM + (size_t)R * 768 * 2);
constexpr size_t WS_OD = al256(WS_VM + (size_t)R * 1024 * 2);
constexpr size_t WS_END = al256(WS_OD + (size_t)R * 2048 * 4);
constexpr size_t WS_PART = WS_AQ;
static_assert(WS_END <= ((size_t)1 << 30), "workspace map exceeds 1 GiB");

constexpr int LDS_BYTES = 155648, XB_LDS_OFF = 155136;

DI unsigned pk2(float lo, float hi) { typedef float f2_t __attribute__((ext_vector_type(2))); typedef __bf16 b2_t __attribute__((ext_vector_type(2)));
    f2_t v = {lo, hi}; b2_t b = __builtin_convertvector(v, b2_t); return __builtin_bit_cast(unsigned, b); }
DI u32x4 pack8(f32x4 a, f32x4 b) { u32x4 w; w.x = pk2(a[0], a[1]); w.y = pk2(a[2], a[3]); w.z = pk2(b[0], b[1]); w.w = pk2(b[2], b[3]); return w; }
DI float bflo(unsigned w) { return __uint_as_float(w << 16); }
DI float bfhi(unsigned w) { return __uint_as_float(w & 0xffff0000u); }
DI float wave_sum(float v) {
#pragma unroll
    for (int o = 1; o < 64; o <<= 1) v += __shfl_xor(v, o);
    return v; }
DI float opq(float a) { asm("" : "+v"(a)); return a; }
DI float silu_f(float z) { return z * __builtin_amdgcn_rcpf(1.0f + __expf(-z)); }
DI float sigm_f(float z) { return __builtin_amdgcn_rcpf(1.0f + __expf(-z)); }
DI void rope8(f32x4& v0, f32x4& v1, const f32x4 cs, const f32x4 sn) {
    float a, b;
    a = v0[0]; b = v0[1]; v0[0] = a * cs[0] - b * sn[0]; v0[1] = b * cs[0] + a * sn[0];
    a = v0[2]; b = v0[3]; v0[2] = a * cs[1] - b * sn[1]; v0[3] = b * cs[1] + a * sn[1];
    a = v1[0]; b = v1[1]; v1[0] = a * cs[2] - b * sn[2]; v1[1] = b * cs[2] + a * sn[2];
    a = v1[2]; b = v1[3]; v1[2] = a * cs[3] - b * sn[3]; v1[3] = b * cs[3] + a * sn[3];
}
namespace pg8 {
#define PG8_LAS __attribute__((address_space(3)))
typedef unsigned short bf16_t;
typedef short bf16x8 __attribute__((ext_vector_type(8)));
typedef float f32x4 __attribute__((ext_vector_type(4)));
typedef unsigned u32x4 __attribute__((ext_vector_type(4)));
constexpr int BM = 256, BK = 64, HALF = 128, HTB = HALF * BK * 2  , STAGE_BYTES = 8 * HTB, NXCD = 8, WGM = 8;

__host__ __device__ __forceinline__ int lds_byte(int r, int c) { const int st = (r >> 4) * 2 + (c >> 5), rr = r & 15, cc = c & 31, ob = rr * 64 + cc * 2; return st * 1024 + (ob ^ (((ob >> 9) & 1) << 5)); }
__host__ __device__ __forceinline__ void stage_rc(int b, int& R, int& C) { const int st = b / 1024, sb = b % 1024, swz = sb ^ (((sb >> 9) & 1) << 5); R = (st >> 1) * 16 + swz / 64; C = (st & 1) * 32 + (swz % 64) / 2; }
__host__ __device__ __forceinline__ int perm32(int rho) { const int n = rho >> 4, i = rho & 15; return 8 * (i >> 2) + 4 * n + (i & 3); }

struct Unit { int pm, pn; };
struct Gemm { int K, lda, ldb; };
struct Order {
    int nM, nN, nwg, G, c; const char* A; const char* B; unsigned tA, tB; int pnblk; unsigned ablk; int skipctx;
    __device__ __forceinline__ void init(int M, int N, int G_, int c_, const void* A_, int lda, const void* B_, int ldb, int pnblk_, unsigned ablk_, int skipctx_ = 0) {
        skipctx = skipctx_; nM = M / BM; if (skipctx) nM -= nM / 33;
        nN = N / BM; nwg = nM * nN; G = G_; c = c_; A = (const char*)A_; B = (const char*)B_; tA = (unsigned)(BM * lda * 2); tB = (unsigned)(BM * ldb * 2); pnblk = pnblk_; ablk = ablk_; }
    __device__ __forceinline__ bool next(int i, Unit& u) const {
        const long L = (long)i * G + c; if (L >= nwg) return false;
        int wgid = (int)L; { const int q = nwg / NXCD, r = nwg % NXCD, xcd = wgid % NXCD, off = wgid / NXCD; wgid = (xcd < r ? xcd * (q + 1) : r * (q + 1) + (xcd - r) * q) + off; }
        const int nig = WGM * nN, gid = wgid / nig, fm = gid * WGM, gsz = (nM - fm) < WGM ? (nM - fm) : WGM;
        u.pm = fm + ((wgid % nig) % gsz); u.pn = (wgid % nig) / gsz; if (skipctx) u.pm += u.pm / 32 + 1; return true;
    }
    __device__ __forceinline__ const char* a_base(const Unit& u) const { return A + (size_t)u.pm * tA + (size_t)(u.pn / pnblk) * ablk; }
    __device__ __forceinline__ const char* b_base(const Unit& u) const { return B + (size_t)u.pn * tB; }
};

template <class Epi, class Sched, bool ALIGN_EPI = false, bool SP2 = false>
__device__ __forceinline__ void gemm_phase(PG8_LAS unsigned char* lds, const Gemm g, const Sched& S, const Epi& E) {
    const int tid = tid_l(), wid = __builtin_amdgcn_readfirstlane(tid >> 6), lane = tid & 63, wr = wid >> 2, wc = wid & 3, fr = lane & 15, fq = lane >> 4;
    const int K = g.K, nt = K / BK;
    unsigned voffA[2], voffB[2];
#pragma unroll
    for (int i = 0; i < 2; ++i) { int R, C; stage_rc(tid * 16 + i * 8192, R, C); const int Rb = Epi::PERM ? ((R & ~31) + perm32(R & 31)) : R;
        voffA[i] = (unsigned)(R * g.lda + C) * 2u; voffB[i] = (unsigned)(Rb * g.ldb + C) * 2u; }
    const size_t kstep = (size_t)(BK * 2);
    const size_t hstepA = (size_t)HALF * g.lda * 2, hstepB = (size_t)HALF * g.ldb * 2;
    const unsigned ldsw = (unsigned)wid * 1024u;
    const int aoff = lds_byte(wr * 64 + fr, fq * 8), boff = lds_byte(wc * 32 + fr, fq * 8);
#define PG8_SA(b, h) (((b) * 2 + (h)) * HTB)
#define PG8_SB(b, h) ((4 + (b) * 2 + (h)) * HTB)
#define PG8_STAGE(bufoff, gbase, voff) do { _Pragma("unroll") for (int _i = 0; _i < 2; ++_i) \
        __builtin_amdgcn_global_load_lds((const unsigned*)((const char*)(gbase) + (voff)[_i]), (PG8_LAS unsigned*)(lds + (bufoff) + ldsw + _i * 8192), 16, 0, 0); } while (0)
#define PG8_LDA(dst, b, h) do { _Pragma("unroll") for (int m = 0; m < 4; ++m) _Pragma("unroll") for (int k = 0; k < 2; ++k) dst[m][k] = *(const PG8_LAS bf16x8*)(lds + PG8_SA(b, h) + aoff + m * 2048 + k * 1024); } while (0)
#define PG8_LDB(dst, b, h) do { _Pragma("unroll") for (int n = 0; n < 2; ++n) _Pragma("unroll") for (int k = 0; k < 2; ++k) dst[n][k] = *(const PG8_LAS bf16x8*)(lds + PG8_SB(b, h) + boff + n * 2048 + k * 1024); } while (0)
#define PG8_MMA(ai, bj, At, Bt) do { __builtin_amdgcn_s_setprio(1); _Pragma("unroll") for (int m = 0; m < 4; ++m) _Pragma("unroll") for (int n = 0; n < 2; ++n) _Pragma("unroll") for (int k = 0; k < 2; ++k) \
        acc[ai][bj][m][n] = __builtin_amdgcn_mfma_f32_16x16x32_bf16(Bt[n][k], At[m][k], acc[ai][bj][m][n], 0, 0, 0); __builtin_amdgcn_s_setprio(0); } while (0)
#define PG8_WAIT_V(n) asm volatile("s_waitcnt vmcnt(" #n ")" ::: "memory")
#define PG8_WAIT_L(n) asm volatile("s_waitcnt lgkmcnt(" #n ")" ::: "memory")
#define PG8_BAR __builtin_amdgcn_s_barrier()
#define PG8_SCHED __builtin_amdgcn_sched_barrier(0)
    Unit cur, nxt; int ui = 0;
    if (!S.next(0, cur)) return;
    f32x4 acc[2][2][4][2];
#pragma unroll
    for (int a = 0; a < 2; ++a)
#pragma unroll
        for (int b = 0; b < 2; ++b)
#pragma unroll
            for (int m = 0; m < 4; ++m)
#pragma unroll
                for (int n = 0; n < 2; ++n) acc[a][b][m][n] = (f32x4){0.f, 0.f, 0.f, 0.f};
    bf16x8 At[4][2], B0[2][2], B1[2][2];
    const char* cA = S.a_base(cur); const char* cB = S.b_base(cur);

    if constexpr (SP2) {
        PG8_STAGE(PG8_SB(0, 0), cB, voffB); PG8_STAGE(PG8_SB(0, 1), cB + hstepB, voffB); PG8_STAGE(PG8_SA(0, 0), cA, voffA); PG8_STAGE(PG8_SA(0, 1), cA + hstepA, voffA);
        if (wr == 1) PG8_BAR;
        PG8_WAIT_V(2); PG8_BAR;
        PG8_STAGE(PG8_SB(1, 0), cB + kstep, voffB); PG8_STAGE(PG8_SA(1, 0), cA + kstep, voffA); PG8_STAGE(PG8_SB(1, 1), cB + hstepB + kstep, voffB);
        PG8_WAIT_V(6); PG8_BAR;
    } else {
        PG8_STAGE(PG8_SB(0, 0), cB, voffB); PG8_STAGE(PG8_SA(0, 0), cA, voffA); PG8_STAGE(PG8_SB(0, 1), cB + hstepB, voffB); PG8_STAGE(PG8_SA(0, 1), cA + hstepA, voffA);
        if (wr == 1) PG8_BAR;
        PG8_WAIT_V(4); PG8_BAR;
        PG8_STAGE(PG8_SB(1, 0), cB + kstep, voffB); PG8_STAGE(PG8_SA(1, 0), cA + kstep, voffA); PG8_STAGE(PG8_SB(1, 1), cB + hstepB + kstep, voffB);
        PG8_WAIT_V(6); PG8_BAR;
    }
    for (;;) {
        const bool has_next = S.next(ui + 1, nxt);
        const char* nA = has_next ? S.a_base(nxt) : cA; const char* nB = has_next ? S.b_base(nxt) : cB;
#pragma nounroll
        for (int t = 0; t < nt; t += 2) {
            const bool last = (t == nt - 2);
            const char* a1 = cA + (size_t)(t + 1) * kstep;
            const char* a2 = last ? nA : cA + (size_t)(t + 2) * kstep; const char* b2 = last ? nB : cB + (size_t)(t + 2) * kstep;
            const char* a3 = a2 + kstep; const char* b3 = b2 + kstep;

            if constexpr (SP2) {
            PG8_LDB(B0, 0, 0); PG8_LDB(B1, 0, 1); PG8_SCHED; PG8_LDA(At, 0, 0); PG8_STAGE(PG8_SA(1, 1), a1 + hstepA, voffA);
            PG8_WAIT_V(8); PG8_WAIT_L(0); PG8_BAR; PG8_MMA(0, 0, At, B0); PG8_MMA(0, 1, At, B1); PG8_BAR; PG8_SCHED;
            PG8_LDA(At, 0, 1); PG8_STAGE(PG8_SB(0, 0), b2, voffB); PG8_STAGE(PG8_SB(0, 1), b2 + hstepB, voffB); PG8_STAGE(PG8_SA(0, 0), a2, voffA);
            PG8_WAIT_V(8); PG8_WAIT_L(0); PG8_BAR; PG8_MMA(1, 0, At, B0); PG8_MMA(1, 1, At, B1); PG8_BAR; PG8_SCHED;
            PG8_LDB(B0, 1, 0); PG8_LDB(B1, 1, 1); PG8_SCHED; PG8_LDA(At, 1, 0); PG8_STAGE(PG8_SA(0, 1), a2 + hstepA, voffA);
            PG8_WAIT_V(8); PG8_WAIT_L(0); PG8_BAR; PG8_MMA(0, 0, At, B0); PG8_MMA(0, 1, At, B1); PG8_BAR; PG8_SCHED;
            PG8_LDA(At, 1, 1); PG8_STAGE(PG8_SB(1, 0), b3, voffB); PG8_STAGE(PG8_SB(1, 1), b3 + hstepB, voffB); PG8_STAGE(PG8_SA(1, 0), a3, voffA);
            PG8_WAIT_V(8); PG8_WAIT_L(0); PG8_BAR; PG8_MMA(1, 0, At, B0); PG8_MMA(1, 1, At, B1); PG8_BAR; PG8_SCHED;
            } else {
            PG8_LDB(B0, 0, 0); PG8_SCHED; PG8_LDA(At, 0, 0); PG8_STAGE(PG8_SA(1, 1), a1 + hstepA, voffA);
            PG8_WAIT_L(8); PG8_BAR; PG8_WAIT_L(0); PG8_MMA(0, 0, At, B0); PG8_BAR; PG8_SCHED;
            PG8_LDB(B1, 0, 1); PG8_STAGE(PG8_SB(0, 0), b2, voffB);
            PG8_BAR; PG8_WAIT_L(0); PG8_MMA(0, 1, At, B1); PG8_BAR;
            PG8_LDA(At, 0, 1); PG8_STAGE(PG8_SA(0, 0), a2, voffA);
            PG8_BAR; PG8_WAIT_L(0); PG8_MMA(1, 0, At, B0); PG8_BAR; PG8_SCHED;
            PG8_STAGE(PG8_SB(0, 1), b2 + hstepB, voffB);
            PG8_WAIT_V(6); PG8_BAR; PG8_MMA(1, 1, At, B1); PG8_BAR;
            PG8_LDB(B0, 1, 0); PG8_SCHED; PG8_LDA(At, 1, 0); PG8_STAGE(PG8_SA(0, 1), a2 + hstepA, voffA);
            PG8_WAIT_L(8); PG8_BAR; PG8_WAIT_L(0); PG8_MMA(0, 0, At, B0); PG8_BAR; PG8_SCHED;
            PG8_LDB(B1, 1, 1); PG8_STAGE(PG8_SB(1, 0), b3, voffB);
            PG8_BAR; PG8_WAIT_L(0); PG8_MMA(0, 1, At, B1); PG8_BAR;
            PG8_LDA(At, 1, 1); PG8_STAGE(PG8_SA(1, 0), a3, voffA);
            PG8_BAR; PG8_WAIT_L(0); PG8_MMA(1, 0, At, B0); PG8_BAR; PG8_SCHED;
            PG8_STAGE(PG8_SB(1, 1), b3 + hstepB, voffB);
            PG8_WAIT_V(6); PG8_BAR; PG8_MMA(1, 1, At, B1); PG8_BAR;
            }
        }
        if constexpr (ALIGN_EPI) { if (wr == 0) PG8_BAR; }
        if constexpr (!Epi::AFTER_DRAIN) { E(acc, cur, wr, wc, fr, fq); }
        if (!has_next) break;
#pragma unroll
        for (int a = 0; a < 2; ++a)
#pragma unroll
            for (int b = 0; b < 2; ++b)
#pragma unroll
                for (int m = 0; m < 4; ++m)
#pragma unroll
                    for (int n = 0; n < 2; ++n) acc[a][b][m][n] = (f32x4){0.f, 0.f, 0.f, 0.f};
        cur = nxt; cA = nA; cB = nB; ++ui;
        if constexpr (ALIGN_EPI) { if (wr == 1) PG8_BAR; }
    }
    PG8_WAIT_V(0);
    if constexpr (!ALIGN_EPI) { if (wr == 0) PG8_BAR; }
    PG8_BAR;
    if constexpr (Epi::AFTER_DRAIN) { E.fused(acc, cur, wr, wc, fr, fq, lds, wid, lane); }
#undef PG8_SA
#undef PG8_SB
#undef PG8_STAGE
#undef PG8_LDA
#undef PG8_LDB
#undef PG8_MMA
#undef PG8_WAIT_V
#undef PG8_WAIT_L
#undef PG8_BAR
#undef PG8_SCHED
}
}
struct EpiIn {
    static constexpr bool PERM = true, AFTER_DRAIN = false;
    unsigned char* ws;
    DI void operator()(const f32x4 (&acc)[2][2][4][2], const pg8::Unit& u, int wr, int wc, int fr, int fq) const {
        bf16_t* P = (bf16_t*)(ws + WS_P); const float* cosH = (const float*)(ws + WS_COSH); const float* sinH = (const float*)(ws + WS_SINH); const float* cosM = (const float*)(ws + WS_COSM); const float* sinM = (const float*)(ws + WS_SINM);
        const int pn = u.pn; const bool ctxt = (u.pm % 33) == 0;
        int mode = 0; float sc = 1.f;
        if ((pn >= 3 && pn <= 10) || (pn >= 15 && pn <= 19)) mode = 1;
        if (pn == 2) mode = 2;
        if ((pn >= 3 && pn <= 6) || (pn >= 15 && pn <= 18)) sc = QS64;
        if (ctxt) mode = 0;
        const int rowt = u.pm * 256 + wr * 64 + fr, colb = pn * 256 + wc * 32 + 8 * fq;
#pragma unroll
        for (int ai = 0; ai < 2; ++ai)
#pragma unroll
            for (int m = 0; m < 4; ++m) {
                const int row = rowt + ai * 128 + m * 16; const int pos = (row % RB) - CTX;
                bf16_t* rowp = P + (size_t)row * NP;
#pragma unroll
                for (int bj = 0; bj < 2; ++bj) {
                    const int col0 = colb + bj * 128;
                    f32x4 v0 = acc[ai][bj][m][0], v1 = acc[ai][bj][m][1];
                    if (pn <= 2) {
                        float s8 = (v0[0] * v0[0] + v0[1] * v0[1]) + (v0[2] * v0[2] + v0[3] * v0[3]) + (v1[0] * v1[0] + v1[1] * v1[1]) + (v1[2] * v1[2] + v1[3] * v1[3]);
                        s8 += __shfl_xor(s8, 16); s8 += __shfl_xor(s8, 32);
                        const int slice = pn * 8 + bj * 4 + wc;
                        if (fq == 0 && slice < 20) ((float*)(ws + WS_PART))[(size_t)row * 20 + slice] = s8;
                    }
                    if (mode == 1) { const int p0 = (col0 & 63) >> 1; const f32x4 cs = *(const f32x4*)(cosH + (size_t)pos * 32 + p0), sn = *(const f32x4*)(sinH + (size_t)pos * 32 + p0); rope8(v0, v1, cs, sn); }
                    else if (mode == 2 && col0 >= C_KR && col0 < C_KR + 32) { const int p0 = (col0 - C_KR) >> 1; const f32x4 cs = *(const f32x4*)(cosM + (size_t)pos * 16 + p0), sn = *(const f32x4*)(sinM + (size_t)pos * 16 + p0); rope8(v0, v1, cs, sn); }
                    v0 = v0 * sc; v1 = v1 * sc;
                    const u32x4 w8 = pack8(v0, v1);
                    *(u32x4*)(rowp + col0) = w8;
                    if (pn == 2 && col0 >= C_KR && col0 < C_KR + 32) {
                        bf16_t* km = (bf16_t*)(ws + WS_KM) + (size_t)row * 768 + 64 + (col0 - C_KR);
#pragma unroll
                        for (int h = 0; h < 8; ++h) *(u32x4*)(km + h * 96) = w8;
                    }
                }
            }
    }
};
struct EpiQ {
    static constexpr bool PERM = true, AFTER_DRAIN = false;
    unsigned char* ws;
    DI void operator()(const f32x4 (&acc)[2][2][4][2], const pg8::Unit& u, int wr, int wc, int fr, int fq) const {
        bf16_t* QM = (bf16_t*)(ws + WS_QM); const float* cosM = (const float*)(ws + WS_COSM); const float* sinM = (const float*)(ws + WS_SINM);
        const bool ctxt = (u.pm % 33) == 0;
        const int rowt = u.pm * 256 + wr * 64 + fr, colb = u.pn * 256 + wc * 32 + 8 * fq;
#pragma unroll
        for (int ai = 0; ai < 2; ++ai)
#pragma unroll
            for (int m = 0; m < 4; ++m) {
                const int row = rowt + ai * 128 + m * 16; const int pos = (row % RB) - CTX;
                const float* pr = (const float*)(ws + WS_PART) + (size_t)row * 20;
                const f32x4 q0 = *(const f32x4*)pr, q1 = *(const f32x4*)(pr + 4), q2 = *(const f32x4*)(pr + 8);
                const float rq = QS96 / sqrtf((((q0[0] + q0[1]) + (q0[2] + q0[3])) + ((q1[0] + q1[1]) + (q1[2] + q1[3])) + ((q2[0] + q2[1]) + (q2[2] + q2[3]))) * (1.0f / 384.0f) + EPS);
#pragma unroll
                for (int bj = 0; bj < 2; ++bj) {
                    const int col0 = colb + bj * 128, within = col0 % 96;
                    f32x4 v0 = acc[ai][bj][m][0], v1 = acc[ai][bj][m][1];
                    if (!ctxt && within >= 64) { const int p0 = (within - 64) >> 1; const f32x4 cs = *(const f32x4*)(cosM + (size_t)pos * 16 + p0), sn = *(const f32x4*)(sinM + (size_t)pos * 16 + p0); rope8(v0, v1, cs, sn); }
                    v0 = v0 * rq; v1 = v1 * rq;
                    *(u32x4*)(QM + (size_t)row * 768 + col0) = pack8(v0, v1);
                }
                asm volatile("" ::: "memory");
            }
    }
};
struct EpiKV {
    static constexpr bool PERM = true, AFTER_DRAIN = false;
    unsigned char* ws;
    DI void operator()(const f32x4 (&acc)[2][2][4][2], const pg8::Unit& u, int wr, int wc, int fr, int fq) const {
        bf16_t* KM = (bf16_t*)(ws + WS_KM); bf16_t* VM = (bf16_t*)(ws + WS_VM);
        const int rowt = u.pm * 256 + wr * 64 + fr, colb = u.pn * 256 + wc * 32 + 8 * fq;
#pragma unroll
        for (int ai = 0; ai < 2; ++ai)
#pragma unroll
            for (int m = 0; m < 4; ++m) {
                const int row = rowt + ai * 128 + m * 16;
                const float* pr = (const float*)(ws + WS_PART) + (size_t)row * 20 + 12;
                const f32x4 k0 = *(const f32x4*)pr, k1 = *(const f32x4*)(pr + 4);
                const float rkv = 1.0f / sqrtf((((k0[0] + k0[1]) + (k0[2] + k0[3])) + ((k1[0] + k1[1]) + (k1[2] + k1[3]))) * (1.0f / 256.0f) + EPS);
#pragma unroll
                for (int bj = 0; bj < 2; ++bj) {
                    const int col0 = colb + bj * 128;
                    bf16_t* dst = (col0 < 512) ? KM + (size_t)row * 768 + (col0 >> 6) * 96 + (col0 & 63) : VM + (size_t)row * 1024 + (col0 - 512);
                    *(u32x4*)dst = pack8(acc[ai][bj][m][0] * rkv, acc[ai][bj][m][1] * rkv);
                }
                asm volatile("" ::: "memory");
            }
    }
};
template <bool DRYE> struct EpiBrT {
    static constexpr bool PERM = true, AFTER_DRAIN = false;
    unsigned char* ws;
    DI void operator()(const f32x4 (&acc)[2][2][4][2], const pg8::Unit& u, int wr, int wc, int fr, int fq) const {
        bf16_t* P = (bf16_t*)(ws + WS_P);
        unsigned chk = 0u;
        const int rowt = u.pm * 256 + wr * 64 + fr, colb = u.pn * 256 + wc * 32 + 8 * fq;
#pragma unroll
        for (int ai = 0; ai < 2; ++ai)
#pragma unroll
            for (int m = 0; m < 4; ++m) {
                const int row = rowt + ai * 128 + m * 16;
#pragma unroll
                for (int bj = 0; bj < 2; ++bj) {
                    bf16_t* p = P + (size_t)row * NP + C_GM + colb + bj * 128;
                    const u32x4 g = *(const u32x4*)p;
                    f32x4 v0 = acc[ai][bj][m][0], v1 = acc[ai][bj][m][1];
                    v0[0] *= sigm_f(bflo(g.x)); v0[1] *= sigm_f(bfhi(g.x)); v0[2] *= sigm_f(bflo(g.y)); v0[3] *= sigm_f(bfhi(g.y));
                    v1[0] *= sigm_f(bflo(g.z)); v1[1] *= sigm_f(bfhi(g.z)); v1[2] *= sigm_f(bflo(g.w)); v1[3] *= sigm_f(bfhi(g.w));
                    { const u32x4 w_ = pack8(v0, v1); if (!DRYE) *(u32x4*)p = w_; else chk ^= w_.x ^ w_.y ^ w_.z ^ w_.w; }
                }
            }
        if (DRYE && chk == 0x12345678u) *(unsigned*)P = chk;
    }
};
template <bool DRYE> struct EpiOutT {
    static constexpr bool PERM = true, AFTER_DRAIN = false;
    int l, g; const float* xsrc; float* xdst; const float* ctxsrc; unsigned char* ws;
    DI void operator()(const f32x4 (&acc)[2][2][4][2], const pg8::Unit& u, int wr, int wc, int fr, int fq) const {
        float* ctxdst = (float*)(ws + WS_CTX); const float* mod = (const float*)(ws + WS_MOD) + (size_t)l * 9 * 3072;
        const int pmb = u.pm % 33, b = g * GB + u.pm / 33; const bool ctxt = pmb == 0;
        if (ctxt && l != 0) return;
        const float* gate = mod + (size_t)(ctxt ? 8 : b) * 3072 + 2048;
        const int colb = u.pn * 256 + wc * 32 + 8 * fq;
#pragma unroll
        for (int ai = 0; ai < 2; ++ai)
#pragma unroll
            for (int m = 0; m < 4; ++m) {
                const int j = pmb * 256 + ai * 128 + wr * 64 + m * 16 + fr;
                const size_t idx = ctxt ? ((size_t)b * CTX + j) * DM : ((size_t)b * SEQ + (j - CTX)) * DM;
                const float* s = (ctxt ? ctxsrc : xsrc) + idx; float* d = (ctxt ? ctxdst : xdst) + idx;
#pragma unroll
                for (int bj = 0; bj < 2; ++bj) {
                    const int col0 = colb + bj * 128;
                    const f32x4 g0 = *(const f32x4*)(gate + col0), g1 = *(const f32x4*)(gate + col0 + 4);
                    const f32x4 x0 = *(const f32x4*)(s + col0), x1 = *(const f32x4*)(s + col0 + 4);
                    if (!DRYE || x0[0] == 12345.678f) { *(f32x4*)(d + col0) = x0 + g0 * acc[ai][bj][m][0];
                    *(f32x4*)(d + col0 + 4) = x1 + g1 * acc[ai][bj][m][1]; }
                }
            }
    }
};

#define MFMA32(a, b, c) __builtin_amdgcn_mfma_f32_32x32x16_bf16((a), (b), (c), 0, 0, 0)
DI s16x4 tr16(const LAS unsigned char* p) { typedef short v4i16_t __attribute__((ext_vector_type(4))); return __builtin_bit_cast(s16x4, __builtin_amdgcn_ds_read_tr16_b64_v4i16((LAS v4i16_t*)p)); }
constexpr int AT_KOFF = 0, AT_KBUFMAX = 13312, AT_VOFF = 3 * AT_KBUFMAX, AT_VBUFMAX = 20480, AT_SOFF = AT_VOFF + 3 * AT_VBUFMAX, AT_QOFF = AT_SOFF + 1024;
static_assert(AT_QOFF + 8 * 6144 <= LDS_BYTES, "attention LDS map");
#ifndef AT_NEGM
#define AT_NEGM 0
#endif
#ifndef AT_LAZY_THR
#define AT_LAZY_THR 1048576.0f
#endif
#ifndef AT_LAZY
#define AT_LAZY 1
#endif
#ifndef AT_NOPF
#define AT_NOPF 1
#endif
#ifndef AT_IGLP
#define AT_IGLP -1
#endif
#ifndef AT_QLMIN
#define AT_QLMIN 64
#endif
#ifndef AT_PVKS
#define AT_PVKS 2
#endif
#ifndef AT_SGB
#define AT_SGB 0
#endif
#ifndef AT_PV8
#define AT_PV8 1
#endif
#ifndef AT_NOSBAR
#define AT_NOSBAR 1
#endif
#if AT_NOSBAR
#define SBAR() do {} while (0)
#else
#define SBAR() __builtin_amdgcn_sched_barrier(0)
#endif
#ifndef PROBE_MODE
#define PROBE_MODE 0
#endif
#ifndef DRY_SEL
#define DRY_SEL 7
#endif
#ifndef AT_QL
#define AT_QL 0
#endif
#ifndef AT_SB
#define AT_SB 0
#endif
template <int DQK, bool QL, bool NG = false>
DI void at_qkt(f32x16& p0, f32x16& p1, const LAS unsigned char* kb, const bf16x8* qf, const LAS unsigned char* qb, const f32x16* c0 = nullptr) {
    constexpr int KSTR = DQK + 8;
    if (!NG) {
#pragma unroll
        for (int r = 0; r < 16; ++r) { p0[r] = 0.f; p1[r] = 0.f; }
    }
#pragma unroll
    for (int ds = 0; ds < DQK / 16; ++ds) {
        const bf16x8 k0 = *(const LAS bf16x8*)(kb + ds * 32), k1 = *(const LAS bf16x8*)(kb + 32 * (KSTR * 2) + ds * 32);
        bf16x8 q; if (QL) q = *(const LAS bf16x8*)(qb + ds * 1024); else q = qf[ds];
        if (NG && ds == 0) { p0 = MFMA32(k0, q, *c0); p1 = MFMA32(k1, q, *c0); } else { p0 = MFMA32(k0, q, p0); p1 = MFMA32(k1, q, p1); }
        if (AT_SB && DQK > 64 && (ds & 1)) __builtin_amdgcn_sched_barrier(0x7f); }
}
DI void at_mask(f32x16& p0, f32x16& p1, int dk) {
#pragma unroll
    for (int r = 0; r < 16; ++r) { const int d = dk + (r & 3) + 8 * (r >> 2);
        if (d > 128 || d < -128) p0[r] = NEGBIG;
        if (d + 32 > 128 || d + 32 < -128) p1[r] = NEGBIG; }
}
DI void at_psm(f32x16& p0, f32x16& p1, float& mrun, float& alpha) {
    float ma = fmaxf(fmaxf(p0[0], p0[1]), p0[2]), mb = fmaxf(fmaxf(p1[0], p1[1]), p1[2]);
    ma = fmaxf(fmaxf(ma, p0[3]), p1[3]);
#pragma unroll
    for (int r = 4; r < 16; r += 2) { ma = fmaxf(fmaxf(ma, p0[r]), p0[r + 1]); mb = fmaxf(fmaxf(mb, p1[r]), p1[r + 1]); }
    float mx = fmaxf(ma, mb);
    { auto rr = __builtin_amdgcn_permlane32_swap(__float_as_uint(mx), __float_as_uint(mx), false, false); mx = fmaxf(__uint_as_float(rr[0]), __uint_as_float(rr[1])); }
    const bool keep = __all(mx - mrun <= THR);
    const float mn = keep ? mrun : fmaxf(mrun, mx); alpha = __builtin_amdgcn_exp2f(mrun - mn); mrun = mn;
#pragma unroll
    for (int r = 0; r < 16; ++r) { p0[r] -= mrun; p1[r] -= mrun; }
#pragma unroll
    for (int r = 0; r < 16; ++r) p0[r] = __builtin_amdgcn_exp2f(p0[r]);
}
template <int DV> DI void at_scale_o(f32x16* o, LAS float* scw, float val, int r32, int hi);
template <bool NG>
DI void at_psm_lazy(f32x16& p0, f32x16& p1, float mrun) {
    if (!NG) {
#pragma unroll
        for (int r = 0; r < 16; ++r) { p0[r] -= mrun; p1[r] -= mrun; }
    }
#pragma unroll
    for (int r = 0; r < 16; ++r) p0[r] = __builtin_amdgcn_exp2f(p0[r]);
}
template <int DV>
DI void at_fsm_lazy(f32x16& p0, f32x16& p1, float& mrun, float& alpha, float& lrun, bf16x8* pa, f32x16* o, LAS float* scw, int r32, int hi) {
#pragma unroll
    for (int r = 0; r < 16; ++r) p1[r] = __builtin_amdgcn_exp2f(p1[r]);
    float sa = p0[0] + p0[1], sb = p0[2] + p0[3], sc_ = p1[0] + p1[1], sd = p1[2] + p1[3];
#pragma unroll
    for (int r = 4; r < 16; r += 2) { sa = opq(sa) + p0[r]; sb = opq(sb) + p0[r + 1]; sc_ = opq(sc_) + p1[r]; sd = opq(sd) + p1[r + 1]; }
    float ps = (opq(sa) + sb) + (opq(sc_) + sd);
    alpha = 1.f;
    if (__builtin_expect(__any(!(ps <= AT_LAZY_THR)), 0)) {
        float ma = fmaxf(fmaxf(p0[0], p0[1]), p0[2]), mb = fmaxf(fmaxf(p1[0], p1[1]), p1[2]);
        ma = fmaxf(fmaxf(ma, p0[3]), p1[3]);
#pragma unroll
        for (int r = 4; r < 16; r += 2) { ma = fmaxf(fmaxf(ma, p0[r]), p0[r + 1]); mb = fmaxf(fmaxf(mb, p1[r]), p1[r + 1]); }
        float mx = fmaxf(ma, mb);
        { auto rr = __builtin_amdgcn_permlane32_swap(__float_as_uint(mx), __float_as_uint(mx), false, false); mx = fmaxf(__uint_as_float(rr[0]), __uint_as_float(rr[1])); }
        const float d = fmaxf(__builtin_amdgcn_logf(mx), 0.f);
        alpha = __builtin_amdgcn_exp2f(-d); mrun += d; ps *= alpha;
#pragma unroll
        for (int r = 0; r < 16; ++r) { p0[r] *= alpha; p1[r] *= alpha; }
        at_scale_o<DV>(o, scw, alpha, r32, hi);
    }
    lrun = lrun * alpha + ps;
    u32x4 w;
    w.x = pk2(p0[0], p0[1]); w.y = pk2(p0[2], p0[3]); w.z = pk2(p0[4], p0[5]); w.w = pk2(p0[6], p0[7]); pa[0] = __builtin_bit_cast(bf16x8, w);
    w.x = pk2(p0[8], p0[9]); w.y = pk2(p0[10], p0[11]); w.z = pk2(p0[12], p0[13]); w.w = pk2(p0[14], p0[15]); pa[1] = __builtin_bit_cast(bf16x8, w);
    w.x = pk2(p1[0], p1[1]); w.y = pk2(p1[2], p1[3]); w.z = pk2(p1[4], p1[5]); w.w = pk2(p1[6], p1[7]); pa[2] = __builtin_bit_cast(bf16x8, w);
    w.x = pk2(p1[8], p1[9]); w.y = pk2(p1[10], p1[11]); w.z = pk2(p1[12], p1[13]); w.w = pk2(p1[14], p1[15]); pa[3] = __builtin_bit_cast(bf16x8, w);
}
DI void at_fsm(f32x16& p0, f32x16& p1, float alpha, float& lrun, bf16x8* pa) {
#pragma unroll
    for (int r = 0; r < 16; ++r) p1[r] = __builtin_amdgcn_exp2f(p1[r]);
    float ps = 0.f;
#pragma unroll
    for (int r = 0; r < 16; ++r) ps += p0[r] + p1[r];
    lrun = lrun * alpha + ps;
    u32x4 w;
    w.x = pk2(p0[0], p0[1]); w.y = pk2(p0[2], p0[3]); w.z = pk2(p0[4], p0[5]); w.w = pk2(p0[6], p0[7]); pa[0] = __builtin_bit_cast(bf16x8, w);
    w.x = pk2(p0[8], p0[9]); w.y = pk2(p0[10], p0[11]); w.z = pk2(p0[12], p0[13]); w.w = pk2(p0[14], p0[15]); pa[1] = __builtin_bit_cast(bf16x8, w);
    w.x = pk2(p1[0], p1[1]); w.y = pk2(p1[2], p1[3]); w.z = pk2(p1[4], p1[5]); w.w = pk2(p1[6], p1[7]); pa[2] = __builtin_bit_cast(bf16x8, w);
    w.x = pk2(p1[8], p1[9]); w.y = pk2(p1[10], p1[11]); w.z = pk2(p1[12], p1[13]); w.w = pk2(p1[14], p1[15]); pa[3] = __builtin_bit_cast(bf16x8, w);
}
DI void at_fsm_fake(f32x16& p0, f32x16& p1, bf16x8* pa) {
    u32x4 w;
    w.x = pk2(p0[0], p0[1]); w.y = pk2(p0[2], p0[3]); w.z = pk2(p0[4], p0[5]); w.w = pk2(p0[6], p0[7]); pa[0] = __builtin_bit_cast(bf16x8, w);
    w.x = pk2(p0[8], p0[9]); w.y = pk2(p0[10], p0[11]); w.z = pk2(p0[12], p0[13]); w.w = pk2(p0[14], p0[15]); pa[1] = __builtin_bit_cast(bf16x8, w);
    w.x = pk2(p1[0], p1[1]); w.y = pk2(p1[2], p1[3]); w.z = pk2(p1[4], p1[5]); w.w = pk2(p1[6], p1[7]); pa[2] = __builtin_bit_cast(bf16x8, w);
    w.x = pk2(p1[8], p1[9]); w.y = pk2(p1[10], p1[11]); w.z = pk2(p1[12], p1[13]); w.w = pk2(p1[14], p1[15]); pa[3] = __builtin_bit_cast(bf16x8, w);
}
template <int DV>
DI void at_pv(f32x16* o, const LAS unsigned char* vb, const bf16x8* pa) {
    constexpr int VSTR = DV + 32;
#if AT_PVKS == 2
    s16x4 vlo[2][DV / 32], vhi[2][DV / 32];
#pragma unroll
    for (int db = 0; db < DV / 32; ++db) { vlo[0][db] = tr16(vb + db * 64); vhi[0][db] = tr16(vb + 8 * (VSTR * 2) + db * 64); }
#pragma unroll
    for (int ks = 0; ks < 4; ++ks) {
        if (ks < 3) {
#pragma unroll
            for (int db = 0; db < DV / 32; ++db) { vlo[(ks + 1) & 1][db] = tr16(vb + (16 * (ks + 1)) * (VSTR * 2) + db * 64); vhi[(ks + 1) & 1][db] = tr16(vb + (16 * (ks + 1) + 8) * (VSTR * 2) + db * 64); }
        }
#pragma unroll
        for (int db = 0; db < DV / 32; ++db) { const bf16x8 vf = __builtin_shufflevector(vlo[ks & 1][db], vhi[ks & 1][db], 0, 1, 2, 3, 4, 5, 6, 7); o[db] = MFMA32(pa[ks], vf, o[db]); }
    }
#elif AT_PVKS
#else
#pragma unroll
    for (int db = 0; db < DV / 32; ++db) {
        s16x4 vlo[4], vhi[4];
#pragma unroll
        for (int ks = 0; ks < 4; ++ks) { vlo[ks] = tr16(vb + (16 * ks) * (VSTR * 2) + db * 64); vhi[ks] = tr16(vb + (16 * ks + 8) * (VSTR * 2) + db * 64); }
#pragma unroll
        for (int ks = 0; ks < 4; ++ks) { const bf16x8 vf = __builtin_shufflevector(vlo[ks], vhi[ks], 0, 1, 2, 3, 4, 5, 6, 7); o[db] = MFMA32(pa[ks], vf, o[db]); }
    }
#endif
}
template <int DV>
DI void at_scale_o(f32x16* o, LAS float* scw, float val, int r32, int hi) {
    if (hi == 0) scw[r32] = val;
    __builtin_amdgcn_wave_barrier(); asm volatile("" ::: "memory");
#pragma unroll
    for (int g4 = 0; g4 < 4; ++g4) { const f32x4 a4 = *(const LAS f32x4*)(scw + 8 * g4 + 4 * hi);
#pragma unroll
        for (int db = 0; db < DV / 32; ++db) { o[db][4 * g4 + 0] *= a4[0]; o[db][4 * g4 + 1] *= a4[1]; o[db][4 * g4 + 2] *= a4[2]; o[db][4 * g4 + 3] *= a4[3]; } }
    __builtin_amdgcn_wave_barrier(); asm volatile("" ::: "memory");
}
template <int DQK, int DV, int OUTM, bool MASKED>
DI void attn_unit(LAS unsigned char* lds, const bf16_t* Qp, int ldq, const bf16_t* Kp, int ldk, const bf16_t* Vp, int ldv,
                  int nA, int rowB0, int nB, int posB0, int qpos0, float m0, float l0,
                  bf16_t* Og, int ldo, float* Of, int ldof) {
    constexpr int KSTR = DQK + 8, VSTR = DV + 32, KBUF = 64 * KSTR * 2, VBUF = 64 * VSTR * 2;
    constexpr int KCH = DQK / 8, VCH = DV / 8, NKC = 64 * KCH, NVC = 64 * VCH, KRN = (NKC + 511) / 512, VRN = (NVC + 511) / 512;
    static_assert(KBUF <= AT_KBUFMAX && VBUF <= AT_VBUFMAX, "attention LDS map");
    const int tid = tid_l(), lane = tid & 63, wid = __builtin_amdgcn_readfirstlane(tid >> 6), r32 = lane & 31, hi = lane >> 5;
#ifndef AT_QL
#define AT_QL 0
#endif
#ifndef AT_SB
#define AT_SB 0
#endif
    constexpr bool NG = (AT_NEGM == 1 && DQK == 64) || (AT_NEGM == 2 && DQK == 64 && DV == 64);
    constexpr bool QL = AT_QL && (DQK > AT_QLMIN || (NG && DV == 128));
    bf16x8 qf[QL ? 1 : DQK / 16];
    const LAS unsigned char* qb = lds + AT_QOFF + wid * 6144 + lane * 16;
    { const bf16_t* qrow = Qp + (size_t)(32 * wid + r32) * ldq + 8 * hi;
#pragma unroll
      for (int ds = 0; ds < DQK / 16; ++ds) { const bf16x8 v = *(const bf16x8*)(qrow + 16 * ds); if (QL) *(LAS bf16x8*)(lds + AT_QOFF + wid * 6144 + lane * 16 + ds * 1024) = v; else qf[QL ? 0 : ds] = v; }
      if (QL) { __builtin_amdgcn_wave_barrier(); asm volatile("s_waitcnt lgkmcnt(0)" ::: "memory"); } }
    f32x16 o[DV / 32];
#pragma unroll
    for (int db = 0; db < DV / 32; ++db)
#pragma unroll
        for (int r = 0; r < 16; ++r) o[db][r] = 0.f;
    float mrun = m0, lrun = (hi == 0) ? l0 : 0.f;
    LAS float* scw = (LAS float*)(lds + AT_SOFF) + wid * 32;
    const int NT = nA + nB;
    const LAS unsigned char* kb0 = lds + AT_KOFF + r32 * (KSTR * 2) + hi * 16;
    const LAS unsigned char* vb0 = lds + AT_VOFF + (4 * hi + ((lane & 15) >> 2)) * (VSTR * 2) + (16 * ((lane >> 4) & 1) + 4 * (lane & 3)) * 2;
    const int dk0 = posB0 + 4 * hi - (qpos0 + 32 * wid + r32) - 64 * nA;
    u32x4 kreg[KRN], vreg[VRN];
    int kgo[KRN], klo[KRN], vgo[VRN], vlo_[VRN];
#pragma unroll
    for (int i_ = 0; i_ < KRN; ++i_) { int c_ = tid + 512 * i_; if (c_ >= NKC) c_ -= 512; const int r_ = c_ / KCH, cc_ = c_ % KCH; kgo[i_] = r_ * ldk + cc_ * 8; klo[i_] = AT_KOFF + r_ * (KSTR * 2) + cc_ * 16; }
#pragma unroll
    for (int i_ = 0; i_ < VRN; ++i_) { int c_ = tid + 512 * i_; if (c_ >= NVC) c_ -= 512; const int r_ = c_ / VCH, cc_ = c_ % VCH; vgo[i_] = r_ * ldv + cc_ * 8; vlo_[i_] = AT_VOFF + r_ * (VSTR * 2) + cc_ * 16; }
    const __amdgpu_buffer_rsrc_t rK = __builtin_amdgcn_make_buffer_rsrc((void*)Kp, 0, 0x7fffffff, 0x00020000), rV = __builtin_amdgcn_make_buffer_rsrc((void*)Vp, 0, 0x7fffffff, 0x00020000);
#define AT_GLOAD(t) do { const int row0_ = (t) < nA ? 64 * (t) : rowB0 + 64 * ((t) - nA); const int sk_ = row0_ * ldk * 2, sv_ = row0_ * ldv * 2; \
        _Pragma("unroll") for (int i_ = 0; i_ < KRN; ++i_) kreg[i_] = __builtin_amdgcn_raw_buffer_load_b128(rK, kgo[i_] * 2, sk_, 0); \
        _Pragma("unroll") for (int i_ = 0; i_ < VRN; ++i_) vreg[i_] = __builtin_amdgcn_raw_buffer_load_b128(rV, vgo[i_] * 2, sv_, 0); } while (0)
#define AT_SWRITE(buf) do { \
        _Pragma("unroll") for (int i_ = 0; i_ < KRN; ++i_) *(LAS u32x4*)(lds + (buf) * KBUF + klo[i_]) = kreg[i_]; \
        _Pragma("unroll") for (int i_ = 0; i_ < VRN; ++i_) *(LAS u32x4*)(lds + (buf) * VBUF + vlo_[i_]) = vreg[i_]; } while (0)
    unsigned pfv = 0u, pfacc = 0u;
    const int pft = tid & 255;
    const bf16_t* pfb = (pft < 128) ? Kp + (pft >> 1) * ldk + (pft & 1) * (DQK - 2) : Vp + ((pft - 128) >> 1) * ldv + (pft & 1) * (DV - 2);
    const int pfs = (pft < 128) ? ldk : ldv;
    constexpr int PFD = 4;
#if AT_NOPF
#define AT_PF(t) do {} while (0)
#else
#define AT_PF(t) do { pfacc ^= pfv; const int tt_ = (t) < NT ? (t) : NT - 1; const int row0_ = tt_ < nA ? 64 * tt_ : rowB0 + 64 * (tt_ - nA); \
        pfv = *(const unsigned*)(pfb + (size_t)row0_ * pfs); } while (0)
#endif
#define AT_MASK(P0, P1, t) do { if (MASKED && (t) >= nA) at_mask(P0, P1, dk0 + 64 * (t)); } while (0)
#define AT_RESC(al) do { if (__any((al) < 1.f)) at_scale_o<DV>(o, scw, (al), r32, hi); } while (0)
    constexpr int DRYP = (OUTM == 2) ? PROBE_MODE : 0;
    f32x16 pA0, pA1, pB0, pB1; float alA, alB; bf16x8 pa[4];
    AT_PF(1); AT_PF(2); AT_PF(3);
    AT_GLOAD(0); AT_SWRITE(0); __syncthreads();
    AT_GLOAD(1);
    at_qkt<DQK, QL>(pA0, pA1, kb0, qf, qb); AT_MASK(pA0, pA1, 0); at_psm(pA0, pA1, mrun, alA);
#if AT_LAZY
    lrun *= alA;
#endif
    AT_SWRITE(1); __syncthreads();
    int bp = 0, bc = 1, bn = 2;
    constexpr int NMF = 2 * (DQK / 16) + 4 * (DV / 32);
#if AT_IGLP >= 0
#define AT_SCHED() __builtin_amdgcn_iglp_opt(AT_IGLP)
#elif AT_SGB
#define AT_SCHED() do { _Pragma("unroll") for (int i_ = 0; i_ < NMF; ++i_) { __builtin_amdgcn_sched_group_barrier(0x008, 1, 0); __builtin_amdgcn_sched_group_barrier(0x100, 2, 0); __builtin_amdgcn_sched_group_barrier(0x002, AT_SGB, 0); } } while (0)
#else
#define AT_SCHED() do {} while (0)
#endif
#define AT_ROT() do { bp = bc; bc = bn; bn = (bn == 2) ? 0 : bn + 1; } while (0)
#if AT_LAZY
    f32x16 negm;
    if (NG) {
#pragma unroll
        for (int r = 0; r < 16; ++r) negm[r] = -mrun;
    }
#define AT_NEGUPD(al, P0, P1) do { if (NG && __any((al) < 1.f)) { const float d_ = -__builtin_amdgcn_logf(al); _Pragma("unroll") for (int r_ = 0; r_ < 16; ++r_) { negm[r_] = -mrun; P0[r_] -= d_; P1[r_] -= d_; } } } while (0)
    for (int j = 1; j + 1 < NT; j += 2) {
        at_qkt<DQK, QL, NG>(pB0, pB1, kb0 + bc * KBUF, qf, qb, &negm); AT_MASK(pB0, pB1, j);
        AT_GLOAD(j + 1);
        at_fsm_lazy<DV>(pA0, pA1, mrun, alA, lrun, pa, o, scw, r32, hi);
        AT_NEGUPD(alA, pB0, pB1);
        at_pv<DV>(o, vb0 + bp * VBUF, pa); at_psm_lazy<NG>(pB0, pB1, mrun);
        AT_SWRITE(bn);
        __syncthreads(); AT_ROT();
        at_qkt<DQK, QL, NG>(pA0, pA1, kb0 + bc * KBUF, qf, qb, &negm); AT_MASK(pA0, pA1, j + 1);
        AT_GLOAD(j + 2);
        at_fsm_lazy<DV>(pB0, pB1, mrun, alB, lrun, pa, o, scw, r32, hi);
        AT_NEGUPD(alB, pA0, pA1);
        at_pv<DV>(o, vb0 + bp * VBUF, pa); at_psm_lazy<NG>(pA0, pA1, mrun);
        AT_SWRITE(bn);
        __syncthreads(); AT_ROT();
    }
    at_qkt<DQK, QL, NG>(pB0, pB1, kb0 + bc * KBUF, qf, qb, &negm); AT_MASK(pB0, pB1, NT - 1);
    at_fsm_lazy<DV>(pA0, pA1, mrun, alA, lrun, pa, o, scw, r32, hi);
    AT_NEGUPD(alA, pB0, pB1);
    at_pv<DV>(o, vb0 + bp * VBUF, pa); at_psm_lazy<NG>(pB0, pB1, mrun);
    at_fsm_lazy<DV>(pB0, pB1, mrun, alB, lrun, pa, o, scw, r32, hi);
    at_pv<DV>(o, vb0 + bc * VBUF, pa);
#else
    for (int j = 1; j + 1 < ((DRYP == 6) ? 2 : NT); j += 2) {
        SBAR(); if (DRYP != 5) at_qkt<DQK, QL>(pB0, pB1, kb0 + bc * KBUF, qf, qb); else { _Pragma("unroll") for (int r_ = 0; r_ < 16; ++r_) { pB0[r_] = o[0][r_] * 1e-3f; pB1[r_] = o[1][r_] * 1e-3f; } } AT_MASK(pB0, pB1, j);
        if (!(DRYP >= 1)) { AT_GLOAD(j + 1); AT_PF(j + PFD); }
        if (DRYP != 3) at_fsm(pA0, pA1, alA, lrun, pa); else at_fsm_fake(pA0, pA1, pa); SBAR();
        if (DRYP != 4) at_pv<DV>(o, vb0 + bp * VBUF, pa); else { o[0][0] += __builtin_bit_cast(float, (int)pa[0][0] + (int)pa[1][1] + (int)pa[2][2] + (int)pa[3][3]); } if (DRYP != 3) at_psm(pB0, pB1, mrun, alB); else alB = 1.f;
        AT_SCHED();
        if (!(DRYP >= 1)) AT_SWRITE(bn);
        AT_RESC(alB); if (DRYP != 2) __syncthreads(); AT_ROT();
        SBAR(); if (DRYP != 5) at_qkt<DQK, QL>(pA0, pA1, kb0 + bc * KBUF, qf, qb); else { _Pragma("unroll") for (int r_ = 0; r_ < 16; ++r_) { pA0[r_] = o[0][r_] * 1e-3f; pA1[r_] = o[1][r_] * 1e-3f; } } AT_MASK(pA0, pA1, j + 1);
        if (!(DRYP >= 1)) { AT_GLOAD(j + 2); AT_PF(j + 1 + PFD); }
        if (DRYP != 3) at_fsm(pB0, pB1, alB, lrun, pa); else at_fsm_fake(pB0, pB1, pa); SBAR();
        if (DRYP != 4) at_pv<DV>(o, vb0 + bp * VBUF, pa); else { o[0][0] += __builtin_bit_cast(float, (int)pa[0][0] + (int)pa[1][1] + (int)pa[2][2] + (int)pa[3][3]); } if (DRYP != 3) at_psm(pA0, pA1, mrun, alA); else alA = 1.f;
        AT_SCHED();
        if (!(DRYP >= 1)) AT_SWRITE(bn);
        AT_RESC(alA); if (DRYP != 2) __syncthreads(); AT_ROT();
    }
    SBAR(); at_qkt<DQK, QL>(pB0, pB1, kb0 + bc * KBUF, qf, qb); AT_MASK(pB0, pB1, NT - 1);
    at_fsm(pA0, pA1, alA, lrun, pa); SBAR();
    at_pv<DV>(o, vb0 + bp * VBUF, pa); at_psm(pB0, pB1, mrun, alB);
    AT_RESC(alB);
    at_fsm(pB0, pB1, alB, lrun, pa); SBAR();
    at_pv<DV>(o, vb0 + bc * VBUF, pa);
#endif
#undef AT_ROT
#ifdef AT_NEGUPD
#undef AT_NEGUPD
#endif
#undef AT_SCHED
    pfacc ^= pfv;
    if (__builtin_expect(pfacc == 0x9e3779b9u && lrun == 12345.678f, 0)) scw[0] = 1.f;
#undef AT_GLOAD
#undef AT_PF
#undef AT_SWRITE
#undef AT_MASK
#undef AT_RESC
    { const float lt = lrun + __shfl_xor(lrun, 32); at_scale_o<DV>(o, scw, 1.0f / lt, r32, hi); }
    if (OUTM == 0) {
#pragma unroll
        for (int db = 0; db < DV / 32; ++db) {
            bf16_t* pb = Og + (size_t)(32 * wid + 4 * hi) * ldo + 32 * db + r32;
            bf16_t zz[16];
#pragma unroll
            for (int r = 0; r < 16; ++r) zz[r] = pb[(size_t)((r & 3) + 8 * (r >> 2)) * ldo];
#pragma unroll
            for (int r = 0; r < 16; ++r) { const float z = __uint_as_float((unsigned)zz[r] << 16); pb[(size_t)((r & 3) + 8 * (r >> 2)) * ldo] = (bf16_t)(pk2(o[db][r] * silu_f(z), 0.f) & 0xffffu); }
        }
    } else {
#pragma unroll
        for (int db = 0; db < DV / 32; ++db)
#pragma unroll
            for (int r = 0; r < 16; ++r) {
                const int q = (r & 3) + 8 * (r >> 2) + 4 * hi;
                if (OUTM == 1) { Of[(size_t)(32 * wid + q) * ldof + 32 * db + r32] = o[db][r]; }
                else { if (lrun == 12345.678f) Of[(size_t)(32 * wid + q) * ldof + 32 * db + r32] = o[db][r]; }
            }
    }
    __syncthreads();
}

struct Args { const float* in[21]; float* out; unsigned char* ws; };
typedef const __attribute__((address_space(4))) Args* ArgsP;
DI ArgsP args_ptr() { ArgsP p = (ArgsP)__builtin_amdgcn_kernarg_segment_ptr(); asm volatile("" : "+s"(p)); return p; }
enum { I_X = 0, I_C, I_CTX, I_CCTX, I_WMOD, I_BMOD, I_NORMG, I_WIN, I_QNORM, I_WUQ, I_KVNORM, I_WUKV, I_LQ1, I_LK1, I_LQ2, I_LK2, I_SUBLN, I_SINK, I_WBR, I_WOUT, I_FNORM };

DI int colmap(int kind, int n) {
    if (kind == 1) {
        if (n < C_KR) return n;
        if (n < C_KR + 32) { const int e = n - C_KR; return C_KR + (e >> 1) + 16 * (e & 1); }
        if (n < C_DQ) return -1;
        if ((n >= C_DQ && n < C_DV) || (n >= C_SQ && n < C_SV)) { const int w = n & 63; return (n - w) - 96 + (w >> 1) + 32 * (w & 1); }
        return n - 96;
    }
    if (kind == 2) { const int h = n / 96, e = n % 96; if (e < 64) return n; const int e2 = e - 64; return h * 96 + 64 + (e2 >> 1) + 16 * (e2 & 1); }
    if (kind == 3) { if (n < 512) return (n >> 6) * 192 + (n & 63); const int n2 = n - 512; return (n2 >> 7) * 192 + 64 + (n2 & 127); }
    return n;
}
DI void transpose_item(const float* W, int ldw, int kind, const float* rowscale, bf16_t* WT, int ldd, int koff, LAS float* scr, int item, int nblk, int lane) {
    const int kb = item / nblk, nb = item % nblk, k0 = 64 * kb, n0 = 32 * nb;
    const int oc = colmap(kind, n0 + (lane & 31));
#pragma unroll 8
    for (int i = 0; i < 32; ++i) { const int kk = 2 * i + (lane >> 5); float v = 0.f; if (oc >= 0) v = W[(size_t)(k0 + kk) * ldw + oc]; if (rowscale) v *= rowscale[k0 + kk]; scr[kk * 33 + (lane & 31)] = v; }
    __builtin_amdgcn_wave_barrier(); asm volatile("s_waitcnt lgkmcnt(0)" ::: "memory");
    const int c = lane & 7;
#pragma unroll
    for (int j = 0; j < 4; ++j) { const int n = (lane >> 3) + 8 * j; const LAS float* s = scr + (8 * c) * 33 + n;
        u32x4 o; o.x = pk2(s[0 * 33], s[1 * 33]); o.y = pk2(s[2 * 33], s[3 * 33]); o.z = pk2(s[4 * 33], s[5 * 33]); o.w = pk2(s[6 * 33], s[7 * 33]);
        *(u32x4*)(WT + (size_t)(n0 + n) * ldd + koff + k0 + 8 * c) = o; }
    __builtin_amdgcn_wave_barrier(); asm volatile("s_waitcnt lgkmcnt(0)" ::: "memory");
}
DI void prologue(ArgsP ap, LAS unsigned char* lds) {
    const int tid = tid_l(), lane = tid & 63, wid = __builtin_amdgcn_readfirstlane(tid >> 6);
    unsigned char* ws = ap->ws;
    LAS float* scr = (LAS float*)(lds + wid * 8448);
    const int gw = bid_l() * 8 + wid, NGW = grd_l() * 8;
    constexpr int I_IN = 16 * (NP / 32), I_UQ = 6 * 24, I_UKV = 4 * 48, I_SQ = 16 * 32, PER_L = I_IN + I_UQ + I_UKV + 6 * I_SQ;
    for (int it = gw; it < 2 * PER_L; it += NGW) {
        const int l = it / PER_L; int r = it % PER_L;
        if (r < I_IN) { transpose_item(ap->in[I_WIN] + (size_t)l * 1024 * D_IN, D_IN, 1, nullptr, (bf16_t*)(ws + WS_WIN) + (size_t)l * NP * 1024, 1024, 0, scr, r, NP / 32, lane); continue; } r -= I_IN;
        if (r < I_UQ) { transpose_item(ap->in[I_WUQ] + (size_t)l * 384 * 768, 768, 2, ap->in[I_QNORM] + l * 384, (bf16_t*)(ws + WS_WUQ) + (size_t)l * 768 * 384, 384, 0, scr, r, 24, lane); continue; } r -= I_UQ;
        if (r < I_UKV) { transpose_item(ap->in[I_WUKV] + (size_t)l * 256 * 1536, 1536, 3, ap->in[I_KVNORM] + l * 256, (bf16_t*)(ws + WS_WUKV) + (size_t)l * 1536 * 256, 256, 0, scr, r, 48, lane); continue; } r -= I_UKV;
        if (r < 3 * I_SQ) { const int br = r / I_SQ; transpose_item(ap->in[I_WBR] + ((size_t)l * 3 + br) * 1024 * 1024, 1024, 0, nullptr, (bf16_t*)(ws + WS_WB) + ((size_t)l * 3 + br) * 1024 * 1024, 1024, 0, scr, r % I_SQ, 32, lane); continue; } r -= 3 * I_SQ;
        { const int rep = r / I_SQ; transpose_item(ap->in[I_WOUT] + (size_t)l * 1024 * 1024, 1024, 0, nullptr, (bf16_t*)(ws + WS_WO3) + (size_t)l * 1024 * 3072, 3072, rep * 1024, scr, r % I_SQ, 32, lane); }
    }
    const int gt = bid_l() * 512 + tid, NGT = grd_l() * 512;
    for (int i = gt; i < SEQ * 48; i += NGT) {
        const int pos = i / 48, p = i % 48; const float frow = (float)(pos >> 6), fcol = (float)(pos & 63);
        float ang; float* cd; float* sd;
        if (p < 32) { const int f = p & 15; const float inv = powf(10000.0f, -(float)f / 16.0f); ang = (p < 16 ? frow : fcol) * inv; cd = (float*)(ws + WS_COSH) + pos * 32 + p; sd = (float*)(ws + WS_SINH) + pos * 32 + p; }
        else { const int pp = p - 32, f = pp & 7; const float inv = powf(10000.0f, -(float)f / 8.0f); ang = (pp < 8 ? frow : fcol) * inv; cd = (float*)(ws + WS_COSM) + pos * 16 + pp; sd = (float*)(ws + WS_SINM) + pos * 16 + pp; }
        *cd = __cosf(ang); *sd = __sinf(ang);
    }
    for (int it = gw; it < 2 * 16 * 48; it += NGW) {
        const int l = it / 768, rem = it % 768, kc = rem / 48, nb = rem % 48; const int k = kc * 64 + lane;
        float sv[9];
#pragma unroll
        for (int v = 0; v < 8; ++v) sv[v] = silu_f(ap->in[I_C][v * 1024 + k]);
        sv[8] = silu_f(ap->in[I_CCTX][k]);
        float acc[9];
#pragma unroll
        for (int v = 0; v < 9; ++v) acc[v] = 0.f;
        const float* w = ap->in[I_WMOD] + ((size_t)l * 1024 + kc * 64) * 3072 + nb * 64 + lane;
#pragma unroll 8
        for (int kk = 0; kk < 64; ++kk) { const float wv = w[(size_t)kk * 3072];
#pragma unroll
            for (int v = 0; v < 9; ++v) acc[v] += __uint_as_float(__builtin_amdgcn_readlane(__float_as_uint(sv[v]), kk)) * wv; }
        float* mp = (float*)(ws + WS_MODP) + ((size_t)(l * 16 + kc) * 9) * 3072 + nb * 64 + lane;
#pragma unroll
        for (int v = 0; v < 9; ++v) mp[(size_t)v * 3072] = acc[v];
    }
}
DI void mod_finalize(ArgsP ap) {
    const int tid = tid_l();
    const int gt = bid_l() * 512 + tid, NGT = grd_l() * 512;
    const float* mp = (const float*)(ap->ws + WS_MODP); float* mod = (float*)(ap->ws + WS_MOD);
    for (int i = gt; i < 2 * 9 * 3072; i += NGT) {
        const int l = i / (9 * 3072), rem = i % (9 * 3072), n = rem % 3072;
        float s = ap->in[I_BMOD][l * 3072 + n];
#pragma unroll
        for (int kc = 0; kc < 16; ++kc) s += mp[(size_t)(l * 16 + kc) * 9 * 3072 + rem];
        mod[i] = s;
    }
}
DI void ph_norm_mod(ArgsP ap, int l, int g) {
    const int tid = tid_l(), lane = tid & 63, wid = __builtin_amdgcn_readfirstlane(tid >> 6);
    const int gw = bid_l() * 8 + wid, NGW = grd_l() * 8;
    const float* ng = ap->in[I_NORMG] + l * 1024; const float* mod = (const float*)(ap->ws + WS_MOD) + (size_t)l * 9 * 3072;
    const float* xs = (l == 0) ? ap->in[I_X] : ap->out; const float* cs = (l == 0) ? ap->in[I_CTX] : (const float*)(ap->ws + WS_CTX);
    bf16_t* H = (bf16_t*)(ap->ws + WS_H);
    for (int r = gw; r < R; r += NGW) {
        const int bl = r / RB, j = r % RB, b = g * GB + bl;
        const float* src; const float* md;
        if (j < CTX) { src = cs + ((size_t)b * CTX + j) * DM; md = mod + 8 * 3072; } else { src = xs + ((size_t)b * SEQ + (j - CTX)) * DM; md = mod + (size_t)b * 3072; }
        f32x4 v[4]; float ss = 0.f;
#pragma unroll
        for (int q = 0; q < 4; ++q) { v[q] = *(const f32x4*)(src + 4 * (lane + 64 * q)); ss += (v[q][0] * v[q][0] + v[q][1] * v[q][1]) + (v[q][2] * v[q][2] + v[q][3] * v[q][3]); }
        const float rstd = 1.0f / sqrtf(wave_sum(ss) * (1.0f / DM) + EPS);
#pragma unroll
        for (int q = 0; q < 4; ++q) { const int idx = 4 * (lane + 64 * q);
            const f32x4 gg = *(const f32x4*)(ng + idx), sh = *(const f32x4*)(md + idx), sc = *(const f32x4*)(md + 1024 + idx);
            const f32x4 y = (v[q] * rstd * gg) * (sc + 1.0f) + sh;
            u32x2 w; w.x = pk2(y[0], y[1]); w.y = pk2(y[2], y[3]); *(u32x2*)(H + (size_t)r * DM + idx) = w; }
    }
}
DI void ph_mla_norm(ArgsP ap) {
    const int tid = tid_l(), lane = tid & 63, wid = __builtin_amdgcn_readfirstlane(tid >> 6);
    const int gw = bid_l() * 8 + wid, NGW = grd_l() * 8;
    const bf16_t* P = (const bf16_t*)(ap->ws + WS_P); bf16_t* AQ = (bf16_t*)(ap->ws + WS_AQ); bf16_t* AKV = (bf16_t*)(ap->ws + WS_AKV); bf16_t* KM = (bf16_t*)(ap->ws + WS_KM);
    for (int r = gw; r < R; r += NGW) {
        const bf16_t* row = P + (size_t)r * NP;
        const u32x4 c0 = *(const u32x4*)(row + 8 * lane);
        u32x4 c1 = {0u, 0u, 0u, 0u}; if (lane < 20) c1 = *(const u32x4*)(row + 8 * (64 + lane));
        float f0[8] = {bflo(c0.x), bfhi(c0.x), bflo(c0.y), bfhi(c0.y), bflo(c0.z), bfhi(c0.z), bflo(c0.w), bfhi(c0.w)};
        float f1[8] = {bflo(c1.x), bfhi(c1.x), bflo(c1.y), bfhi(c1.y), bflo(c1.z), bfhi(c1.z), bflo(c1.w), bfhi(c1.w)};
        float s0 = 0.f, s1 = 0.f;
#pragma unroll
        for (int i = 0; i < 8; ++i) { s0 += f0[i] * f0[i]; s1 += f1[i] * f1[i]; }
        const float sq = wave_sum(lane < 48 ? s0 : 0.f);
        const float skv = wave_sum((lane >= 48 ? s0 : 0.f) + (lane < 16 ? s1 : 0.f));
        const float rq = 1.0f / sqrtf(sq * (1.0f / 384.0f) + EPS), rkv = 1.0f / sqrtf(skv * (1.0f / 256.0f) + EPS);
        { const float rr = lane < 48 ? rq : rkv; u32x4 w; w.x = pk2(f0[0] * rr, f0[1] * rr); w.y = pk2(f0[2] * rr, f0[3] * rr); w.z = pk2(f0[4] * rr, f0[5] * rr); w.w = pk2(f0[6] * rr, f0[7] * rr);
          if (lane < 48) *(u32x4*)(AQ + (size_t)r * 384 + 8 * lane) = w; else *(u32x4*)(AKV + (size_t)r * 256 + 8 * (lane - 48)) = w; }
        if (lane < 16) { u32x4 w; w.x = pk2(f1[0] * rkv, f1[1] * rkv); w.y = pk2(f1[2] * rkv, f1[3] * rkv); w.z = pk2(f1[4] * rkv, f1[5] * rkv); w.w = pk2(f1[6] * rkv, f1[7] * rkv);
            *(u32x4*)(AKV + (size_t)r * 256 + 8 * (16 + lane)) = w; }
        else if (lane < 20) {
#pragma unroll
            for (int h = 0; h < 8; ++h) *(u32x4*)(KM + (size_t)r * 768 + h * 96 + 64 + 8 * (lane - 16)) = c1; }
    }
}
template <bool DRYE>
DI void ph_diff_post(ArgsP ap, int l) {
    const int tid = tid_l(), lane = tid & 63, wid = __builtin_amdgcn_readfirstlane(tid >> 6);
    const int gw = bid_l() * 8 + wid, NGW = grd_l() * 8;
    const float lam_init = (l == 0) ? 0.2f : (0.8f - 0.6f * 0.7408182206817179f);
    const float d1 = wave_sum(ap->in[I_LQ1][l * 64 + lane] * ap->in[I_LK1][l * 64 + lane]), d2 = wave_sum(ap->in[I_LQ2][l * 64 + lane] * ap->in[I_LK2][l * 64 + lane]);
    const float lam = expf(d1) - expf(d2) + lam_init;
    const float sl0 = ap->in[I_SUBLN][l * 128 + 2 * lane] * (1.0f - lam_init), sl1 = ap->in[I_SUBLN][l * 128 + 2 * lane + 1] * (1.0f - lam_init);
    const float* OD = (const float*)(ap->ws + WS_OD); bf16_t* P = (bf16_t*)(ap->ws + WS_P);
    typedef float f32x2 __attribute__((ext_vector_type(2)));
    for (int r = gw; r < R; r += NGW) {
        if (l != 0 && (r % RB) < CTX) continue;
        const float* ob = OD + (size_t)r * 2048 + 2 * lane; unsigned* zb = (unsigned*)(P + (size_t)r * NP + C_Z + 1024 + 2 * lane);
        f32x2 o1[8], o2[8]; unsigned z[8];
#pragma unroll
        for (int h = 0; h < 8; ++h) { o1[h] = *(const f32x2*)(ob + (2 * h) * 128); o2[h] = *(const f32x2*)(ob + (2 * h + 1) * 128); z[h] = zb[h * 64]; }
#pragma unroll
        for (int h = 0; h < 8; ++h) {
            const float a0 = o1[h][0] - lam * o2[h][0], a1 = o1[h][1] - lam * o2[h][1];
            const float rstd = 1.0f / sqrtf(wave_sum(a0 * a0 + a1 * a1) * (1.0f / 128.0f) + EPS);
            if (!DRYE || rstd == 12345.678f) zb[h * 64] = pk2(a0 * rstd * sl0 * silu_f(bflo(z[h])), a1 * rstd * sl1 * silu_f(bfhi(z[h])));
        }
    }
}
template <bool DRYE>
DI void ph_final_norm(ArgsP ap) {
    const int tid = tid_l(), lane = tid & 63, wid = __builtin_amdgcn_readfirstlane(tid >> 6);
    const int gw = bid_l() * 8 + wid, NGW = grd_l() * 8; const float* fg = ap->in[I_FNORM];
    for (int r = gw; r < NBATCH * SEQ; r += NGW) {
        float* row = ap->out + (size_t)r * DM; f32x4 v[4]; float ss = 0.f;
#pragma unroll
        for (int q = 0; q < 4; ++q) { v[q] = *(const f32x4*)(row + 4 * (lane + 64 * q)); ss += (v[q][0] * v[q][0] + v[q][1] * v[q][1]) + (v[q][2] * v[q][2] + v[q][3] * v[q][3]); }
        const float rstd = 1.0f / sqrtf(wave_sum(ss) * (1.0f / DM) + EPS);
#pragma unroll
        for (int q = 0; q < 4; ++q) { const int idx = 4 * (lane + 64 * q); if (!DRYE || rstd == 12345.678f) *(f32x4*)(row + idx) = v[q] * rstd * *(const f32x4*)(fg + idx); }
    }
}
template <bool DRY>
DI void ph_attention(ArgsP ap, int l, LAS unsigned char* lds) {
    constexpr int OM0 = DRY ? 2 : 0;
    const int G = grd_l(), bx = bid_l(), vcu = (G % 8 == 0) ? (bx % 8) * (G / 8) + bx / 8 : bx;
    bf16_t* P = (bf16_t*)(ap->ws + WS_P); const bf16_t* QM = (const bf16_t*)(ap->ws + WS_QM); const bf16_t* KM = (const bf16_t*)(ap->ws + WS_KM); const bf16_t* VM = (const bf16_t*)(ap->ws + WS_VM);
    float* OD = (float*)(ap->ws + WS_OD); const float* sink = ap->in[I_SINK] + l * 16;
#if !defined(ATT_ONLY) || ATT_ONLY == 1
    if (!DRY || (DRY_SEL & 1))
    for (int u = vcu; u < GB * 8 * 32; u += G) { const int bh = u >> 5, qb = u & 31, bl = bh >> 3, h = bh & 7; const size_t rb = (size_t)bl * RB, q0 = rb + CTX + 256 * qb;
        attn_unit<96, 128, OM0, false>(lds, QM + q0 * 768 + h * 96, 768, KM + rb * 768 + h * 96, 768, VM + rb * 1024 + h * 128, 1024, RB / 64, 0, 0, 0, 0, NEGBIG, 0.f, P + q0 * NP + C_Z + h * 128, NP, OD, 0); }
#endif
#if !defined(ATT_ONLY) || ATT_ONLY == 2
    if (!DRY || (DRY_SEL & 2))
    for (int u = vcu; u < GB * 16 * 32; u += G) { const int bh = u >> 5, qb = u & 31, bl = bh >> 4, hm = bh & 15; const size_t rb = (size_t)bl * RB, q0 = rb + CTX + 256 * qb;
        attn_unit<64, 128, 1, false>(lds, P + q0 * NP + C_DQ + hm * 64, NP, P + rb * NP + C_DK + hm * 64, NP, P + rb * NP + C_DV + (hm >> 1) * 128, NP, RB / 64, 0, 0, 0, 0, NEGBIG, 0.f, nullptr, 0, OD + q0 * 2048 + hm * 128, 2048); }
#endif
#if !defined(ATT_ONLY) || ATT_ONLY == 3
    if (!DRY || (DRY_SEL & 4))
    for (int u = vcu; u < GB * 16 * 32; u += G) { const int bh = u >> 5, qb = u & 31, bl = bh >> 4, h = bh & 15; const size_t rb = (size_t)bl * RB, q0 = rb + CTX + 256 * qb;
        const int lo = (256 * qb - 128 < 0) ? 0 : 256 * qb - 128, hi = (256 * qb + 384 > SEQ) ? SEQ : 256 * qb + 384;
        attn_unit<64, 64, OM0, true>(lds, P + q0 * NP + C_SQ + h * 64, NP, P + rb * NP + C_SK + (h >> 2) * 64, NP, P + rb * NP + C_SV + (h >> 2) * 64, NP, CTX / 64, CTX + lo, (hi - lo) / 64, lo, 256 * qb, sink[h] * LOG2E, 1.0f,
                              P + q0 * NP + C_Z + 2048 + h * 64, NP, OD, 0); }
#endif
#if !defined(ATT_ONLY)
    if (l == 0) {
        for (int u = vcu; u < GB * 40; u += G) { const int bl = u / 40, k = u % 40; const size_t rb = (size_t)bl * RB;
            if (k < 8) { const int h = k;
                attn_unit<96, 128, OM0, false>(lds, QM + rb * 768 + h * 96, 768, KM + rb * 768 + h * 96, 768, VM + rb * 1024 + h * 128, 1024, CTX / 64, 0, 0, 0, 0, NEGBIG, 0.f, P + rb * NP + C_Z + h * 128, NP, OD, 0); }
            else if (k < 24) { const int hm = k - 8;
                attn_unit<64, 128, 1, false>(lds, P + rb * NP + C_DQ + hm * 64, NP, P + rb * NP + C_DK + hm * 64, NP, P + rb * NP + C_DV + (hm >> 1) * 128, NP, CTX / 64, 0, 0, 0, 0, NEGBIG, 0.f, nullptr, 0, OD + rb * 2048 + hm * 128, 2048); }
            else { const int h = k - 24;
                attn_unit<64, 64, OM0, false>(lds, P + rb * NP + C_SQ + h * 64, NP, P + rb * NP + C_SK + (h >> 2) * 64, NP, P + rb * NP + C_SV + (h >> 2) * 64, NP, CTX / 64, 0, 0, 0, 0, sink[h] * LOG2E, 1.0f, P + rb * NP + C_Z + 2048 + h * 64, NP, OD, 0); }
        }
    }
#endif
}

#define RLX_AGENT __ATOMIC_RELAXED, __HIP_MEMORY_SCOPE_AGENT
#define XB_TMO      128
#define XB_XCNT(j)  (256  + 64 * (j))
#define XB_XSUB(j)  (1280 + 64 * (j))
#define XB_XGEN(j)  (2304 + 64 * (j))
#define XB_TOP      3328
#define XB_TOPGEN   3392
#define XCD_BAR_WORDS 3456
#define XB_SPIN_CAP (1u << 18)

__device__ __forceinline__ unsigned xb_ld(unsigned* p)              { return __hip_atomic_load(p, __ATOMIC_RELAXED, __HIP_MEMORY_SCOPE_AGENT); }
__device__ __forceinline__ unsigned xb_add(unsigned* p, unsigned v) { return __hip_atomic_fetch_add(p, v, __ATOMIC_RELAXED, __HIP_MEMORY_SCOPE_AGENT); }
__device__ __forceinline__ unsigned xb_xcc_id() { return (unsigned)__builtin_amdgcn_s_getreg((3 << 11) | 20) & 0xFu; }
#define XB_SPIN(cond, bar) do { unsigned _sp = 0; while (cond) { __builtin_amdgcn_s_sleep(1); \
    if ((++_sp & 255u) == 0u) { if (xb_ld(&(bar)[XB_TMO])) break; if (_sp > XB_SPIN_CAP) { atomicAdd(&(bar)[XB_TMO], 1u); break; } } } } while (0)

struct XcdBarrier {
    unsigned* bar; unsigned x;
    volatile LAS unsigned* st;
};

__device__ __forceinline__ XcdBarrier xcd_barrier_post(unsigned* bar, volatile LAS unsigned* st) {
    XcdBarrier b; b.bar = bar; b.x = xb_xcc_id(); b.st = st;
    if (threadIdx.x == 0) (void)xb_add(&bar[XB_XCNT(b.x)], 1u);
    return b;
}
__device__ __forceinline__ void xcd_barrier_complete(unsigned* bar, unsigned x, unsigned& nloc, unsigned& nx) {
    const unsigned G = gridDim.x * gridDim.y * gridDim.z;
    unsigned sum, cnt, mine, sp = 0u;
    for (;;) {
        sum = 0u; cnt = 0u; mine = 0u;
#pragma unroll
        for (unsigned j = 0; j < 16; ++j) { const unsigned c = xb_ld(&bar[XB_XCNT(j)]); sum += c; cnt += (c > 0u) ? 1u : 0u; mine = (j == x) ? c : mine; }
        if (sum == G) break;
        __builtin_amdgcn_s_sleep(1);
        if ((++sp & 255u) == 0u) { if (xb_ld(&bar[XB_TMO])) break; if (sp > XB_SPIN_CAP) { atomicAdd(&bar[XB_TMO], 1u); break; } }
    }
    nloc = mine > 0u ? mine : 1u; nx = cnt > 0u ? cnt : 1u;
}

__device__ __forceinline__ void xcd_barrier(const XcdBarrier& b) {
    asm volatile("s_waitcnt vmcnt(0)" ::: "memory");
    __syncthreads();
    if (threadIdx.x == 0) {
        unsigned* bar = b.bar;
        __builtin_amdgcn_s_waitcnt(0);
        unsigned nloc = b.st[0], nx = b.st[1];
        if (nloc == 0u) { xcd_barrier_complete(bar, b.x, nloc, nx); b.st[0] = nloc; b.st[1] = nx; }
        const unsigned old = xb_add(&bar[XB_XSUB(b.x)], 1u);
        const unsigned gen = old / nloc;
        if (old + 1u == (gen + 1u) * nloc) {
            __builtin_amdgcn_fence(__ATOMIC_RELEASE, "agent");
            asm volatile("s_waitcnt vmcnt(0)" ::: "memory");
            const unsigned og = xb_add(&bar[XB_TOP], 1u);
            const unsigned tg = og / nx;
            if (og + 1u == (tg + 1u) * nx) xb_add(&bar[XB_TOPGEN], 1u);
            else XB_SPIN(xb_ld(&bar[XB_TOPGEN]) == tg, bar);
            __builtin_amdgcn_fence(__ATOMIC_ACQUIRE, "agent");
            xb_add(&bar[XB_XGEN(b.x)], 1u);
            asm volatile("s_waitcnt vmcnt(0)" ::: "memory");
        } else {
            XB_SPIN(xb_ld(&bar[XB_XGEN(b.x)]) == gen, bar);
            __builtin_amdgcn_fence(__ATOMIC_ACQUIRE, "agent");
            asm volatile("s_waitcnt vmcnt(0)" ::: "memory");
        }
    }
    __syncthreads();
}


__global__ void __launch_bounds__(512, 2) hybrid_fwd(Args a_unused) {
    extern __shared__ __attribute__((aligned(16))) unsigned char lds_raw[];
    LAS unsigned char* lds = (LAS unsigned char*)lds_raw;
    cg::grid_group grid = cg::this_grid();
    { volatile LAS unsigned* xst = (volatile LAS unsigned*)(lds + XB_LDS_OFF);
      if (threadIdx.x < 2) xst[threadIdx.x] = 0u;
      __syncthreads();
      (void)xcd_barrier_post((unsigned*)(args_ptr()->ws), xst); }
#define GSYNC() do { XcdBarrier b_; b_.bar = (unsigned*)(args_ptr()->ws); b_.x = xb_xcc_id(); b_.st = (volatile LAS unsigned*)(lds + XB_LDS_OFF); xcd_barrier(b_); } while (0)
#ifndef NO_PRO
    prologue(args_ptr(), lds);
#ifdef PROBE_PRO
    __syncthreads(); prologue(args_ptr(), lds);
#endif
#endif
    grid.sync();
    mod_finalize(args_ptr());
    GSYNC();
    for (int l = 0; l < 2; ++l) {
        for (int g = 0; g < NGRP; ++g) {
            ph_norm_mod(args_ptr(), lnd(l), lnd(g));
#ifdef PROBE_R1
            GSYNC(); ph_norm_mod(args_ptr(), lnd(l), lnd(g));
#endif
            GSYNC();
#ifndef NO_GEMM
            {
                unsigned char* ws = args_ptr()->ws; const int G = grd_l(), bx = bid_l();
                pg8::Gemm gm{1024, 1024, 1024}; pg8::Order S; S.init(R, NP, G, bx, ws + WS_H, 1024, (bf16_t*)(ws + WS_WIN) + (size_t)l * NP * 1024, 1024, 1 << 20, 0);
                EpiIn E{ws};
                pg8::gemm_phase<EpiIn, pg8::Order, true, true>(lds, gm, S, E);
#ifdef PROBE_G1
                __syncthreads(); pg8::gemm_phase<EpiIn, pg8::Order, true, true>(lds, gm, S, E);
#endif
            }
#endif
            GSYNC();
#ifndef NO_GEMM2
            {
                unsigned char* ws = args_ptr()->ws; const int G = grd_l(), bx = bid_l();
                pg8::Gemm gq{384, NP, 384}; pg8::Order Sq; Sq.init(R, 768, G, bx, (bf16_t*)(ws + WS_P) + C_QC, NP, (bf16_t*)(ws + WS_WUQ) + (size_t)l * 768 * 384, 384, 1 << 20, 0);
                EpiQ Eq{ws};
#ifndef NO_GQ
                pg8::gemm_phase<EpiQ, pg8::Order, true, true>(lds, gq, Sq, Eq);
#ifdef PROBE_G2
                __syncthreads(); pg8::gemm_phase<EpiQ, pg8::Order, true, true>(lds, gq, Sq, Eq);
#endif
#endif
            }
            {
                unsigned char* ws = args_ptr()->ws; const int G = grd_l(), bx = bid_l();
                pg8::Gemm gk{256, NP, 256}; pg8::Order Sk; Sk.init(R, 1536, G, bx, (bf16_t*)(ws + WS_P) + C_KVC, NP, (bf16_t*)(ws + WS_WUKV) + (size_t)l * 1536 * 256, 256, 1 << 20, 0);
                EpiKV Ek{ws};
#ifndef NO_GK
                pg8::gemm_phase<EpiKV, pg8::Order, true, true>(lds, gk, Sk, Ek);
#ifdef PROBE_G2
                __syncthreads(); pg8::gemm_phase<EpiKV, pg8::Order, true, true>(lds, gk, Sk, Ek);
#endif
#endif
            }
#endif
            GSYNC();
#ifndef NO_ATT
#ifdef PROBE_ATT
            ph_attention<true>(args_ptr(), lnd(l), lds);
            GSYNC();
#endif
            ph_attention<false>(args_ptr(), lnd(l), lds);
#endif
            GSYNC();
#ifdef PROBE_R2
            ph_diff_post<true>(args_ptr(), lnd(l)); GSYNC();
#endif
            ph_diff_post<false>(args_ptr(), lnd(l));
            GSYNC();
#ifndef NO_BR
            {
                unsigned char* ws = args_ptr()->ws; const int G = grd_l(), bx = bid_l();
                pg8::Gemm gb{1024, NP, 1024}; pg8::Order S; S.init(R, 3072, G, bx, (bf16_t*)(ws + WS_P) + C_Z, NP, (bf16_t*)(ws + WS_WB) + (size_t)l * 3 * 1024 * 1024, 1024, 4, 1024 * 2, l != 0);
#ifdef PROBE_BR
                { EpiBrT<true> Ed{ws}; pg8::gemm_phase<EpiBrT<true>, pg8::Order, true, true>(lds, gb, S, Ed); __syncthreads(); }
#endif
                EpiBrT<false> E{ws};
                pg8::gemm_phase<EpiBrT<false>, pg8::Order, true, true>(lds, gb, S, E);
            }
#endif
            GSYNC();
#ifndef NO_OUT
            {
                ArgsP ap = args_ptr(); unsigned char* ws = ap->ws; const int G = grd_l(), bx = bid_l();
                pg8::Gemm go{3072, NP, 3072}; pg8::Order S; S.init(R, 1024, G, bx, (bf16_t*)(ws + WS_P) + C_GM, NP, (bf16_t*)(ws + WS_WO3) + (size_t)l * 1024 * 3072, 3072, 1 << 20, 0, l != 0);
#ifdef PROBE_OUT
                { EpiOutT<true> Ed{l, g, (l == 0) ? ap->in[I_X] : (const float*)ap->out, ap->out, ap->in[I_CTX], ws}; pg8::gemm_phase<EpiOutT<true>, pg8::Order, true, true>(lds, go, S, Ed); __syncthreads(); }
#endif
                EpiOutT<false> E{l, g, (l == 0) ? ap->in[I_X] : (const float*)ap->out, ap->out, ap->in[I_CTX], ws};
                pg8::gemm_phase<EpiOutT<false>, pg8::Order, true, true>(lds, go, S, E);
            }
#endif
        }
        GSYNC();
    }
#ifdef PROBE_R2
    ph_final_norm<true>(args_ptr()); GSYNC();
#endif
    ph_final_norm<false>(args_ptr());
}

extern "C" void kernel_launch(void* const* d_in, const int* in_sizes, int n_in, void* d_out, int out_size, void* d_ws, size_t ws_size, hipStream_t stream) {
    static int grid = 0;
    if (grid == 0) {
        if (n_in != 21 || ws_size < WS_END) { fprintf(stderr, "kernel_launch: expected 21 inputs and >= %zu bytes of workspace (got %d, %zu)\n", (size_t)WS_END, n_in, ws_size); grid = -1; return; }
        int dev = 0, cus = 0, per_cu = 0;
        (void)hipGetDevice(&dev); (void)hipDeviceGetAttribute(&cus, hipDeviceAttributeMultiprocessorCount, dev);
        if (hipFuncSetAttribute((const void*)hybrid_fwd, hipFuncAttributeMaxDynamicSharedMemorySize, LDS_BYTES) != hipSuccess) fprintf(stderr, "kernel_launch: hipFuncSetAttribute failed\n");
        if (hipOccupancyMaxActiveBlocksPerMultiprocessor(&per_cu, (const void*)hybrid_fwd, 512, LDS_BYTES) != hipSuccess || per_cu < 1) { per_cu = 1; (void)hipGetLastError(); }
        if (cus <= 0) cus = 256;
        grid = cus * per_cu;
    }
    if (grid < 0) return;
    Args a{};
    for (int i = 0; i < 21; ++i) a.in[i] = (const float*)d_in[i];
    a.out = (float*)d_out; a.ws = (unsigned char*)d_ws;
    (void)hipMemsetAsync(d_ws, 0, 16384, stream);
    void* args[] = {&a};
    hipError_t e = hipLaunchCooperativeKernel((const void*)hybrid_fwd, dim3(grid), dim3(512), args, LDS_BYTES, stream);
    if (e != hipSuccess) fprintf(stderr, "kernel_launch: cooperative launch failed: %s (grid %d)\n", hipGetErrorString(e), grid);
}
```

```cpp
#include <hip/hip_runtime.h>
#include <hip/hip_cooperative_groups.h>
#include <cstdio>
#include <cstdint>
namespace cg = cooperative_groups;

#define DI __device__ __forceinline__
#define LAS __attribute__((address_space(3)))
__device__ __forceinline__ int tid_l() { int t = threadIdx.x; asm volatile("" : "+v"(t)); return t; }
__device__ __forceinline__ int bid_l() { int b = blockIdx.x; asm volatile("" : "+s"(b)); return b; }
__device__ __forceinline__ int lnd(int x) { asm volatile("" : "+s"(x)); return x; }
__device__ __forceinline__ int grd_l() { int g = gridDim.x; asm volatile("" : "+s"(g)); return g; }
typedef unsigned short bf16_t;
typedef short bf16x8 __attribute__((ext_vector_type(8)));
typedef short s16x4 __attribute__((ext_vector_type(4)));
typedef float f32x4 __attribute__((ext_vector_type(4)));
typedef float f32x16 __attribute__((ext_vector_type(16)));
typedef unsigned u32x4 __attribute__((ext_vector_type(4)));
typedef unsigned u32x2 __attribute__((ext_vector_type(2)));

constexpr int DM = 1024, NBATCH = 8, SEQ = 8192, CTX = 256, RB = CTX + SEQ;
constexpr int GB = 2, NGRP = NBATCH / GB, R = GB * RB;
constexpr int NP = 11520;
constexpr int C_QC = 0, C_KVC = 384, C_KR = 640, C_DQ = 768, C_DK = 1792, C_DV = 2816, C_SQ = 3840, C_SK = 4864, C_SV = 5120, C_Z = 5376, C_GM = 8448;
constexpr int D_IN = 11424;
constexpr float EPS = 1e-6f, LOG2E = 1.4426950408889634f;
constexpr float QS64 = 0.125f * LOG2E, QS96 = 0.10206207261596575f * LOG2E;
constexpr float NEGBIG = -1e30f, THR = 8.0f;

constexpr size_t al256(size_t x) { return (x + 255) & ~(size_t)255; }
constexpr size_t WS_WIN = 1u << 20;
constexpr size_t WS_WUQ = al256(WS_WIN + (size_t)2 * NP * 1024 * 2);
constexpr size_t WS_WUKV = al256(WS_WUQ + (size_t)2 * 768 * 384 * 2);
constexpr size_t WS_WB = al256(WS_WUKV + (size_t)2 * 1536 * 256 * 2);
constexpr size_t WS_WO3 = al256(WS_WB + (size_t)2 * 3 * 1024 * 1024 * 2);
constexpr size_t WS_COSH = al256(WS_WO3 + (size_t)2 * 1024 * 3072 * 2);
constexpr size_t WS_SINH = al256(WS_COSH + (size_t)SEQ * 32 * 4);
constexpr size_t WS_COSM = al256(WS_SINH + (size_t)SEQ * 32 * 4);
constexpr size_t WS_SINM = al256(WS_COSM + (size_t)SEQ * 16 * 4);
constexpr size_t WS_MODP = al256(WS_SINM + (size_t)SEQ * 16 * 4);
constexpr size_t WS_MOD = al256(WS_MODP + (size_t)16 * 2 * 9 * 3072 * 4);
constexpr size_t WS_CTX = al256(WS_MOD + (size_t)2 * 9 * 3072 * 4);
constexpr size_t WS_H = al256(WS_CTX + (size_t)NBATCH * CTX * DM * 4);
constexpr size_t WS_P = al256(WS_H + (size_t)R * DM * 2);
constexpr size_t WS_AQ = al256(WS_P + (size_t)R * NP * 2);
constexpr size_t WS_AKV = al256(WS_AQ + (size_t)R * 384 * 2);
constexpr size_t WS_QM = al256(WS_AKV + (size_t)R * 256 * 2);
constexpr size_t WS_KM = al256(WS_QM + (size_t)R * 768 * 2);
constexpr size_t WS_VM = al256(WS_KM + (size_t)R * 768 * 2);
constexpr size_t WS_OD = al256(WS_VM + (size_t)R * 1024 * 2);
constexpr size_t WS_END = al256(WS_OD + (size_t)R * 2048 * 4);
constexpr size_t WS_PART = WS_AQ;
static_assert(WS_END <= ((size_t)1 << 30), "workspace map exceeds 1 GiB");

constexpr int LDS_BYTES = 155648, XB_LDS_OFF = 155136;

DI unsigned pk2(float lo, float hi) { typedef float f2_t __attribute__((ext_vector_type(2))); typedef __bf16 b2_t __attribute__((ext_vector_type(2)));
    f2_t v = {lo, hi}; b2_t b = __builtin_convertvector(v, b2_t); return __builtin_bit_cast(unsigned, b); }
DI u32x4 pack8(f32x4 a, f32x4 b) { u32x4 w; w.x = pk2(a[0], a[1]); w.y = pk2(a[2], a[3]); w.z = pk2(b[0], b[1]); w.w = pk2(b[2], b[3]); return w; }
DI float bflo(unsigned w) { return __uint_as_float(w << 16); }
DI float bfhi(unsigned w) { return __uint_as_float(w & 0xffff0000u); }
DI float wave_sum(float v) {
#pragma unroll
    for (int o = 1; o < 64; o <<= 1) v += __shfl_xor(v, o);
    return v; }
DI float opq(float a) { asm("" : "+v"(a)); return a; }
DI float silu_f(float z) { return z * __builtin_amdgcn_rcpf(1.0f + __expf(-z)); }
DI float sigm_f(float z) { return __builtin_amdgcn_rcpf(1.0f + __expf(-z)); }
DI void rope8(f32x4& v0, f32x4& v1, const f32x4 cs, const f32x4 sn) {
    float a, b;
    a = v0[0]; b = v0[1]; v0[0] = a * cs[0] - b * sn[0]; v0[1] = b * cs[0] + a * sn[0];
    a = v0[2]; b = v0[3]; v0[2] = a * cs[1] - b * sn[1]; v0[3] = b * cs[1] + a * sn[1];
    a = v1[0]; b = v1[1]; v1[0] = a * cs[2] - b * sn[2]; v1[1] = b * cs[2] + a * sn[2];
    a = v1[2]; b = v1[3]; v1[2] = a * cs[3] - b * sn[3]; v1[3] = b * cs[3] + a * sn[3];
}
namespace pg8 {
#define PG8_LAS __attribute__((address_space(3)))
typedef unsigned short bf16_t;
typedef short bf16x8 __attribute__((ext_vector_type(8)));
typedef float f32x4 __attribute__((ext_vector_type(4)));
typedef unsigned u32x4 __attribute__((ext_vector_type(4)));
constexpr int BM = 256, BK = 64, HALF = 128, HTB = HALF * BK * 2  , STAGE_BYTES = 8 * HTB, NXCD = 8, WGM = 8;

__host__ __device__ __forceinline__ int lds_byte(int r, int c) { const int st = (r >> 4) * 2 + (c >> 5), rr = r & 15, cc = c & 31, ob = rr * 64 + cc * 2; return st * 1024 + (ob ^ (((ob >> 9) & 1) << 5)); }
__host__ __device__ __forceinline__ void stage_rc(int b, int& R, int& C) { const int st = b / 1024, sb = b % 1024, swz = sb ^ (((sb >> 9) & 1) << 5); R = (st >> 1) * 16 + swz / 64; C = (st & 1) * 32 + (swz % 64) / 2; }
__host__ __device__ __forceinline__ int perm32(int rho) { const int n = rho >> 4, i = rho & 15; return 8 * (i >> 2) + 4 * n + (i & 3); }

struct Unit { int pm, pn; };
struct Gemm { int K, lda, ldb; };
struct Order {
    int nM, nN, nwg, G, c; const char* A; const char* B; unsigned tA, tB; int pnblk; unsigned ablk; int skipctx;
    __device__ __forceinline__ void init(int M, int N, int G_, int c_, const void* A_, int lda, const void* B_, int ldb, int pnblk_, unsigned ablk_, int skipctx_ = 0) {
        skipctx = skipctx_; nM = M / BM; if (skipctx) nM -= nM / 33;
        nN = N / BM; nwg = nM * nN; G = G_; c = c_; A = (const char*)A_; B = (const char*)B_; tA = (unsigned)(BM * lda * 2); tB = (unsigned)(BM * ldb * 2); pnblk = pnblk_; ablk = ablk_; }
    __device__ __forceinline__ bool next(int i, Unit& u) const {
        const long L = (long)i * G + c; if (L >= nwg) return false;
        int wgid = (int)L; { const int q = nwg / NXCD, r = nwg % NXCD, xcd = wgid % NXCD, off = wgid / NXCD; wgid = (xcd < r ? xcd * (q + 1) : r * (q + 1) + (xcd - r) * q) + off; }
        const int nig = WGM * nN, gid = wgid / nig, fm = gid * WGM, gsz = (nM - fm) < WGM ? (nM - fm) : WGM;
        u.pm = fm + ((wgid % nig) % gsz); u.pn = (wgid % nig) / gsz; if (skipctx) u.pm += u.pm / 32 + 1; return true;
    }
    __device__ __forceinline__ const char* a_base(const Unit& u) const { return A + (size_t)u.pm * tA + (size_t)(u.pn / pnblk) * ablk; }
    __device__ __forceinline__ const char* b_base(const Unit& u) const { return B + (size_t)u.pn * tB; }
};

template <class Epi, class Sched, bool ALIGN_EPI = false, bool SP2 = false>
__device__ __forceinline__ void gemm_phase(PG8_LAS unsigned char* lds, const Gemm g, const Sched& S, const Epi& E) {
    const int tid = tid_l(), wid = __builtin_amdgcn_readfirstlane(tid >> 6), lane = tid & 63, wr = wid >> 2, wc = wid & 3, fr = lane & 15, fq = lane >> 4;
    const int K = g.K, nt = K / BK;
    unsigned voffA[2], voffB[2];
#pragma unroll
    for (int i = 0; i < 2; ++i) { int R, C; stage_rc(tid * 16 + i * 8192, R, C); const int Rb = Epi::PERM ? ((R & ~31) + perm32(R & 31)) : R;
        voffA[i] = (unsigned)(R * g.lda + C) * 2u; voffB[i] = (unsigned)(Rb * g.ldb + C) * 2u; }
    const size_t kstep = (size_t)(BK * 2);
    const size_t hstepA = (size_t)HALF * g.lda * 2, hstepB = (size_t)HALF * g.ldb * 2;
    const unsigned ldsw = (unsigned)wid * 1024u;
    const int aoff = lds_byte(wr * 64 + fr, fq * 8), boff = lds_byte(wc * 32 + fr, fq * 8);
#define PG8_SA(b, h) (((b) * 2 + (h)) * HTB)
#define PG8_SB(b, h) ((4 + (b) * 2 + (h)) * HTB)
#define PG8_STAGE(bufoff, gbase, voff) do { _Pragma("unroll") for (int _i = 0; _i < 2; ++_i) \
        __builtin_amdgcn_global_load_lds((const unsigned*)((const char*)(gbase) + (voff)[_i]), (PG8_LAS unsigned*)(lds + (bufoff) + ldsw + _i * 8192), 16, 0, 0); } while (0)
#define PG8_LDA(dst, b, h) do { _Pragma("unroll") for (int m = 0; m < 4; ++m) _Pragma("unroll") for (int k = 0; k < 2; ++k) dst[m][k] = *(const PG8_LAS bf16x8*)(lds + PG8_SA(b, h) + aoff + m * 2048 + k * 1024); } while (0)
#define PG8_LDB(dst, b, h) do { _Pragma("unroll") for (int n = 0; n < 2; ++n) _Pragma("unroll") for (int k = 0; k < 2; ++k) dst[n][k] = *(const PG8_LAS bf16x8*)(lds + PG8_SB(b, h) + boff + n * 2048 + k * 1024); } while (0)
#define PG8_MMA(ai, bj, At, Bt) do { __builtin_amdgcn_s_setprio(1); _Pragma("unroll") for (int m = 0; m < 4; ++m) _Pragma("unroll") for (int n = 0; n < 2; ++n) _Pragma("unroll") for (int k = 0; k < 2; ++k) \
        acc[ai][bj][m][n] = __builtin_amdgcn_mfma_f32_16x16x32_bf16(Bt[n][k], At[m][k], acc[ai][bj][m][n], 0, 0, 0); __builtin_amdgcn_s_setprio(0); } while (0)
#define PG8_WAIT_V(n) asm volatile("s_waitcnt vmcnt(" #n ")" ::: "memory")
#define PG8_WAIT_L(n) asm volatile("s_waitcnt lgkmcnt(" #n ")" ::: "memory")
#define PG8_BAR __builtin_amdgcn_s_barrier()
#define PG8_SCHED __builtin_amdgcn_sched_barrier(0)
    Unit cur, nxt; int ui = 0;
    if (!S.next(0, cur)) return;
    f32x4 acc[2][2][4][2];
#pragma unroll
    for (int a = 0; a < 2; ++a)
#pragma unroll
        for (int b = 0; b < 2; ++b)
#pragma unroll
            for (int m = 0; m < 4; ++m)
#pragma unroll
                for (int n = 0; n < 2; ++n) acc[a][b][m][n] = (f32x4){0.f, 0.f, 0.f, 0.f};
    bf16x8 At[4][2], B0[2][2], B1[2][2];
    const char* cA = S.a_base(cur); const char* cB = S.b_base(cur);

    if constexpr (SP2) {
        PG8_STAGE(PG8_SB(0, 0), cB, voffB); PG8_STAGE(PG8_SB(0, 1), cB + hstepB, voffB); PG8_STAGE(PG8_SA(0, 0), cA, voffA); PG8_STAGE(PG8_SA(0, 1), cA + hstepA, voffA);
        if (wr == 1) PG8_BAR;
        PG8_WAIT_V(2); PG8_BAR;
        PG8_STAGE(PG8_SB(1, 0), cB + kstep, voffB); PG8_STAGE(PG8_SA(1, 0), cA + kstep, voffA); PG8_STAGE(PG8_SB(1, 1), cB + hstepB + kstep, voffB);
        PG8_WAIT_V(6); PG8_BAR;
    } else {
        PG8_STAGE(PG8_SB(0, 0), cB, voffB); PG8_STAGE(PG8_SA(0, 0), cA, voffA); PG8_STAGE(PG8_SB(0, 1), cB + hstepB, voffB); PG8_STAGE(PG8_SA(0, 1), cA + hstepA, voffA);
        if (wr == 1) PG8_BAR;
        PG8_WAIT_V(4); PG8_BAR;
        PG8_STAGE(PG8_SB(1, 0), cB + kstep, voffB); PG8_STAGE(PG8_SA(1, 0), cA + kstep, voffA); PG8_STAGE(PG8_SB(1, 1), cB + hstepB + kstep, voffB);
        PG8_WAIT_V(6); PG8_BAR;
    }
    for (;;) {
        const bool has_next = S.next(ui + 1, nxt);
        const char* nA = has_next ? S.a_base(nxt) : cA; const char* nB = has_next ? S.b_base(nxt) : cB;
#pragma nounroll
        for (int t = 0; t < nt; t += 2) {
            const bool last = (t == nt - 2);
            const char* a1 = cA + (size_t)(t + 1) * kstep;
            const char* a2 = last ? nA : cA + (size_t)(t + 2) * kstep; const char* b2 = last ? nB : cB + (size_t)(t + 2) * kstep;
            const char* a3 = a2 + kstep; const char* b3 = b2 + kstep;

            if constexpr (SP2) {
            PG8_LDB(B0, 0, 0); PG8_LDB(B1, 0, 1); PG8_SCHED; PG8_LDA(At, 0, 0); PG8_STAGE(PG8_SA(1, 1), a1 + hstepA, voffA);
            PG8_WAIT_V(8); PG8_WAIT_L(0); PG8_BAR; PG8_MMA(0, 0, At, B0); PG8_MMA(0, 1, At, B1); PG8_BAR; PG8_SCHED;
            PG8_LDA(At, 0, 1); PG8_STAGE(PG8_SB(0, 0), b2, voffB); PG8_STAGE(PG8_SB(0, 1), b2 + hstepB, voffB); PG8_STAGE(PG8_SA(0, 0), a2, voffA);
            PG8_WAIT_V(8); PG8_WAIT_L(0); PG8_BAR; PG8_MMA(1, 0, At, B0); PG8_MMA(1, 1, At, B1); PG8_BAR; PG8_SCHED;
            PG8_LDB(B0, 1, 0); PG8_LDB(B1, 1, 1); PG8_SCHED; PG8_LDA(At, 1, 0); PG8_STAGE(PG8_SA(0, 1), a2 + hstepA, voffA);
            PG8_WAIT_V(8); PG8_WAIT_L(0); PG8_BAR; PG8_MMA(0, 0, At, B0); PG8_MMA(0, 1, At, B1); PG8_BAR; PG8_SCHED;
            PG8_LDA(At, 1, 1); PG8_STAGE(PG8_SB(1, 0), b3, voffB); PG8_STAGE(PG8_SB(1, 1), b3 + hstepB, voffB); PG8_STAGE(PG8_SA(1, 0), a3, voffA);
            PG8_WAIT_V(8); PG8_WAIT_L(0); PG8_BAR; PG8_MMA(1, 0, At, B0); PG8_MMA(1, 1, At, B1); PG8_BAR; PG8_SCHED;
            } else {
            PG8_LDB(B0, 0, 0); PG8_SCHED; PG8_LDA(At, 0, 0); PG8_STAGE(PG8_SA(1, 1), a1 + hstepA, voffA);
            PG8_WAIT_L(8); PG8_BAR; PG8_WAIT_L(0); PG8_MMA(0, 0, At, B0); PG8_BAR; PG8_SCHED;
            PG8_LDB(B1, 0, 1); PG8_STAGE(PG8_SB(0, 0), b2, voffB);
            PG8_BAR; PG8_WAIT_L(0); PG8_MMA(0, 1, At, B1); PG8_BAR;
            PG8_LDA(At, 0, 1); PG8_STAGE(PG8_SA(0, 0), a2, voffA);
            PG8_BAR; PG8_WAIT_L(0); PG8_MMA(1, 0, At, B0); PG8_BAR; PG8_SCHED;
            PG8_STAGE(PG8_SB(0, 1), b2 + hstepB, voffB);
            PG8_WAIT_V(6); PG8_BAR; PG8_MMA(1, 1, At, B1); PG8_BAR;
            PG8_LDB(B0, 1, 0); PG8_SCHED; PG8_LDA(At, 1, 0); PG8_STAGE(PG8_SA(0, 1), a2 + hstepA, voffA);
            PG8_WAIT_L(8); PG8_BAR; PG8_WAIT_L(0); PG8_MMA(0, 0, At, B0); PG8_BAR; PG8_SCHED;
            PG8_LDB(B1, 1, 1); PG8_STAGE(PG8_SB(1, 0), b3, voffB);
            PG8_BAR; PG8_WAIT_L(0); PG8_MMA(0, 1, At, B1); PG8_BAR;
            PG8_LDA(At, 1, 1); PG8_STAGE(PG8_SA(1, 0), a3, voffA);
            PG8_BAR; PG8_WAIT_L(0); PG8_MMA(1, 0, At, B0); PG8_BAR; PG8_SCHED;
            PG8_STAGE(PG8_SB(1, 1), b3 + hstepB, voffB);
            PG8_WAIT_V(6); PG8_BAR; PG8_MMA(1, 1, At, B1); PG8_BAR;
            }
        }
        if constexpr (ALIGN_EPI) { if (wr == 0) PG8_BAR; }
        if constexpr (!Epi::AFTER_DRAIN) { E(acc, cur, wr, wc, fr, fq); }
        if (!has_next) break;
#pragma unroll
        for (int a = 0; a < 2; ++a)
#pragma unroll
            for (int b = 0; b < 2; ++b)
#pragma unroll
                for (int m = 0; m < 4; ++m)
#pragma unroll
                    for (int n = 0; n < 2; ++n) acc[a][b][m][n] = (f32x4){0.f, 0.f, 0.f, 0.f};
        cur = nxt; cA = nA; cB = nB; ++ui;
        if constexpr (ALIGN_EPI) { if (wr == 1) PG8_BAR; }
    }
    PG8_WAIT_V(0);
    if constexpr (!ALIGN_EPI) { if (wr == 0) PG8_BAR; }
    PG8_BAR;
    if constexpr (Epi::AFTER_DRAIN) { E.fused(acc, cur, wr, wc, fr, fq, lds, wid, lane); }
#undef PG8_SA
#undef PG8_SB
#undef PG8_STAGE
#undef PG8_LDA
#undef PG8_LDB
#undef PG8_MMA
#undef PG8_WAIT_V
#undef PG8_WAIT_L
#undef PG8_BAR
#undef PG8_SCHED
}
}
struct EpiIn {
    static constexpr bool PERM = true, AFTER_DRAIN = false;
    unsigned char* ws;
    DI void operator()(const f32x4 (&acc)[2][2][4][2], const pg8::Unit& u, int wr, int wc, int fr, int fq) const {
        bf16_t* P = (bf16_t*)(ws + WS_P); const float* cosH = (const float*)(ws + WS_COSH); const float* sinH = (const float*)(ws + WS_SINH); const float* cosM = (const float*)(ws + WS_COSM); const float* sinM = (const float*)(ws + WS_SINM);
        const int pn = u.pn; const bool ctxt = (u.pm % 33) == 0;
        int mode = 0; float sc = 1.f;
        if ((pn >= 3 && pn <= 10) || (pn >= 15 && pn <= 19)) mode = 1;
        if (pn == 2) mode = 2;
        if ((pn >= 3 && pn <= 6) || (pn >= 15 && pn <= 18)) sc = QS64;
        if (ctxt) mode = 0;
        const int rowt = u.pm * 256 + wr * 64 + fr, colb = pn * 256 + wc * 32 + 8 * fq;
#pragma unroll
        for (int ai = 0; ai < 2; ++ai)
#pragma unroll
            for (int m = 0; m < 4; ++m) {
                const int row = rowt + ai * 128 + m * 16; const int pos = (row % RB) - CTX;
                bf16_t* rowp = P + (size_t)row * NP;
#pragma unroll
                for (int bj = 0; bj < 2; ++bj) {
                    const int col0 = colb + bj * 128;
                    f32x4 v0 = acc[ai][bj][m][0], v1 = acc[ai][bj][m][1];
                    if (pn <= 2) {
                        float s8 = (v0[0] * v0[0] + v0[1] * v0[1]) + (v0[2] * v0[2] + v0[3] * v0[3]) + (v1[0] * v1[0] + v1[1] * v1[1]) + (v1[2] * v1[2] + v1[3] * v1[3]);
                        s8 += __shfl_xor(s8, 16); s8 += __shfl_xor(s8, 32);
                        const int slice = pn * 8 + bj * 4 + wc;
                        if (fq == 0 && slice < 20) ((float*)(ws + WS_PART))[(size_t)row * 20 + slice] = s8;
                    }
                    if (mode == 1) { const int p0 = (col0 & 63) >> 1; const f32x4 cs = *(const f32x4*)(cosH + (size_t)pos * 32 + p0), sn = *(const f32x4*)(sinH + (size_t)pos * 32 + p0); rope8(v0, v1, cs, sn); }
                    else if (mode == 2 && col0 >= C_KR && col0 < C_KR + 32) { const int p0 = (col0 - C_KR) >> 1; const f32x4 cs = *(const f32x4*)(cosM + (size_t)pos * 16 + p0), sn = *(const f32x4*)(sinM + (size_t)pos * 16 + p0); rope8(v0, v1, cs, sn); }
                    v0 = v0 * sc; v1 = v1 * sc;
                    const u32x4 w8 = pack8(v0, v1);
                    *(u32x4*)(rowp + col0) = w8;
                    if (pn == 2 && col0 >= C_KR && col0 < C_KR + 32) {
                        bf16_t* km = (bf16_t*)(ws + WS_KM) + (size_t)row * 768 + 64 + (col0 - C_KR);
#pragma unroll
                        for (int h = 0; h < 8; ++h) *(u32x4*)(km + h * 96) = w8;
                    }
                }
            }
    }
};
struct EpiQ {
    static constexpr bool PERM = true, AFTER_DRAIN = false;
    unsigned char* ws;
    DI void operator()(const f32x4 (&acc)[2][2][4][2], const pg8::Unit& u, int wr, int wc, int fr, int fq) const {
        bf16_t* QM = (bf16_t*)(ws + WS_QM); const float* cosM = (const float*)(ws + WS_COSM); const float* sinM = (const float*)(ws + WS_SINM);
        const bool ctxt = (u.pm % 33) == 0;
        const int rowt = u.pm * 256 + wr * 64 + fr, colb = u.pn * 256 + wc * 32 + 8 * fq;
#pragma unroll
        for (int ai = 0; ai < 2; ++ai)
#pragma unroll
            for (int m = 0; m < 4; ++m) {
                const int row = rowt + ai * 128 + m * 16; const int pos = (row % RB) - CTX;
                const float* pr = (const float*)(ws + WS_PART) + (size_t)row * 20;
                const f32x4 q0 = *(const f32x4*)pr, q1 = *(const f32x4*)(pr + 4), q2 = *(const f32x4*)(pr + 8);
                const float rq = QS96 / sqrtf((((q0[0] + q0[1]) + (q0[2] + q0[3])) + ((q1[0] + q1[1]) + (q1[2] + q1[3])) + ((q2[0] + q2[1]) + (q2[2] + q2[3]))) * (1.0f / 384.0f) + EPS);
#pragma unroll
                for (int bj = 0; bj < 2; ++bj) {
                    const int col0 = colb + bj * 128, within = col0 % 96;
                    f32x4 v0 = acc[ai][bj][m][0], v1 = acc[ai][bj][m][1];
                    if (!ctxt && within >= 64) { const int p0 = (within - 64) >> 1; const f32x4 cs = *(const f32x4*)(cosM + (size_t)pos * 16 + p0), sn = *(const f32x4*)(sinM + (size_t)pos * 16 + p0); rope8(v0, v1, cs, sn); }
                    v0 = v0 * rq; v1 = v1 * rq;
                    *(u32x4*)(QM + (size_t)row * 768 + col0) = pack8(v0, v1);
                }
                asm volatile("" ::: "memory");
            }
    }
};
struct EpiKV {
    static constexpr bool PERM = true, AFTER_DRAIN = false;
    unsigned char* ws;
    DI void operator()(const f32x4 (&acc)[2][2][4][2], const pg8::Unit& u, int wr, int wc, int fr, int fq) const {
        bf16_t* KM = (bf16_t*)(ws + WS_KM); bf16_t* VM = (bf16_t*)(ws + WS_VM);
        const int rowt = u.pm * 256 + wr * 64 + fr, colb = u.pn * 256 + wc * 32 + 8 * fq;
#pragma unroll
        for (int ai = 0; ai < 2; ++ai)
#pragma unroll
            for (int m = 0; m < 4; ++m) {
                const int row = rowt + ai * 128 + m * 16;
                const float* pr = (const float*)(ws + WS_PART) + (size_t)row * 20 + 12;
                const f32x4 k0 = *(const f32x4*)pr, k1 = *(const f32x4*)(pr + 4);
                const float rkv = 1.0f / sqrtf((((k0[0] + k0[1]) + (k0[2] + k0[3])) + ((k1[0] + k1[1]) + (k1[2] + k1[3]))) * (1.0f / 256.0f) + EPS);
#pragma unroll
                for (int bj = 0; bj < 2; ++bj) {
                    const int col0 = colb + bj * 128;
                    bf16_t* dst = (col0 < 512) ? KM + (size_t)row * 768 + (col0 >> 6) * 96 + (col0 & 63) : VM + (size_t)row * 1024 + (col0 - 512);
                    *(u32x4*)dst = pack8(acc[ai][bj][m][0] * rkv, acc[ai][bj][m][1] * rkv);
                }
                asm volatile("" ::: "memory");
            }
    }
};
template <bool DRYE> struct EpiBrT {
    static constexpr bool PERM = true, AFTER_DRAIN = false;
    unsigned char* ws;
    DI void operator()(const f32x4 (&acc)[2][2][4][2], const pg8::Unit& u, int wr, int wc, int fr, int fq) const {
        bf16_t* P = (bf16_t*)(ws + WS_P);
        unsigned chk = 0u;
        const int rowt = u.pm * 256 + wr * 64 + fr, colb = u.pn * 256 + wc * 32 + 8 * fq;
#pragma unroll
        for (int ai = 0; ai < 2; ++ai)
#pragma unroll
            for (int m = 0; m < 4; ++m) {
                const int row = rowt + ai * 128 + m * 16;
#pragma unroll
                for (int bj = 0; bj < 2; ++bj) {
                    bf16_t* p = P + (size_t)row * NP + C_GM + colb + bj * 128;
                    const u32x4 g = *(const u32x4*)p;
                    f32x4 v0 = acc[ai][bj][m][0], v1 = acc[ai][bj][m][1];
                    v0[0] *= sigm_f(bflo(g.x)); v0[1] *= sigm_f(bfhi(g.x)); v0[2] *= sigm_f(bflo(g.y)); v0[3] *= sigm_f(bfhi(g.y));
                    v1[0] *= sigm_f(bflo(g.z)); v1[1] *= sigm_f(bfhi(g.z)); v1[2] *= sigm_f(bflo(g.w)); v1[3] *= sigm_f(bfhi(g.w));
                    { const u32x4 w_ = pack8(v0, v1); if (!DRYE) *(u32x4*)p = w_; else chk ^= w_.x ^ w_.y ^ w_.z ^ w_.w; }
                }
            }
        if (DRYE && chk == 0x12345678u) *(unsigned*)P = chk;
    }
};
template <bool DRYE> struct EpiOutT {
    static constexpr bool PERM = true, AFTER_DRAIN = false;
    int l, g; const float* xsrc; float* xdst; const float* ctxsrc; unsigned char* ws;
    DI void operator()(const f32x4 (&acc)[2][2][4][2], const pg8::Unit& u, int wr, int wc, int fr, int fq) const {
        float* ctxdst = (float*)(ws + WS_CTX); const float* mod = (const float*)(ws + WS_MOD) + (size_t)l * 9 * 3072;
        const int pmb = u.pm % 33, b = g * GB + u.pm / 33; const bool ctxt = pmb == 0;
        if (ctxt && l != 0) return;
        const float* gate = mod + (size_t)(ctxt ? 8 : b) * 3072 + 2048;
        const int colb = u.pn * 256 + wc * 32 + 8 * fq;
#pragma unroll
        for (int ai = 0; ai < 2; ++ai)
#pragma unroll
            for (int m = 0; m < 4; ++m) {
                const int j = pmb * 256 + ai * 128 + wr * 64 + m * 16 + fr;
                const size_t idx = ctxt ? ((size_t)b * CTX + j) * DM : ((size_t)b * SEQ + (j - CTX)) * DM;
                const float* s = (ctxt ? ctxsrc : xsrc) + idx; float* d = (ctxt ? ctxdst : xdst) + idx;
#pragma unroll
                for (int bj = 0; bj < 2; ++bj) {
                    const int col0 = colb + bj * 128;
                    const f32x4 g0 = *(const f32x4*)(gate + col0), g1 = *(const f32x4*)(gate + col0 + 4);
                    const f32x4 x0 = *(const f32x4*)(s + col0), x1 = *(const f32x4*)(s + col0 + 4);
                    if (!DRYE || x0[0] == 12345.678f) { *(f32x4*)(d + col0) = x0 + g0 * acc[ai][bj][m][0];
                    *(f32x4*)(d + col0 + 4) = x1 + g1 * acc[ai][bj][m][1]; }
                }
            }
    }
};

#define MFMA32(a, b, c) __builtin_amdgcn_mfma_f32_32x32x16_bf16((a), (b), (c), 0, 0, 0)
DI s16x4 tr16(const LAS unsigned char* p) { typedef short v4i16_t __attribute__((ext_vector_type(4))); return __builtin_bit_cast(s16x4, __builtin_amdgcn_ds_read_tr16_b64_v4i16((LAS v4i16_t*)p)); }
constexpr int AT_KOFF = 0, AT_KBUFMAX = 13312, AT_VOFF = 3 * AT_KBUFMAX, AT_VBUFMAX = 20480, AT_SOFF = AT_VOFF + 3 * AT_VBUFMAX, AT_QOFF = AT_SOFF + 1024;
static_assert(AT_QOFF + 8 * 6144 <= LDS_BYTES, "attention LDS map");
#ifndef AT_NEGM
#define AT_NEGM 0
#endif
#ifndef AT_LAZY_THR
#define AT_LAZY_THR 1048576.0f
#endif
#ifndef AT_LAZY
#define AT_LAZY 1
#endif
#ifndef AT_NOPF
#define AT_NOPF 1
#endif
#ifndef AT_IGLP
#define AT_IGLP -1
#endif
#ifndef AT_QLMIN
#define AT_QLMIN 64
#endif
#ifndef AT_PVKS
#define AT_PVKS 2
#endif
#ifndef AT_SGB
#define AT_SGB 0
#endif
#ifndef AT_PV8
#define AT_PV8 1
#endif
#ifndef AT_NOSBAR
#define AT_NOSBAR 1
#endif
#if AT_NOSBAR
#define SBAR() do {} while (0)
#else
#define SBAR() __builtin_amdgcn_sched_barrier(0)
#endif
#ifndef PROBE_MODE
#define PROBE_MODE 0
#endif
#ifndef DRY_SEL
#define DRY_SEL 7
#endif
#ifndef AT_QL
#define AT_QL 0
#endif
#ifndef AT_SB
#define AT_SB 0
#endif
template <int DQK, bool QL, bool NG = false>
DI void at_qkt(f32x16& p0, f32x16& p1, const LAS unsigned char* kb, const bf16x8* qf, const LAS unsigned char* qb, const f32x16* c0 = nullptr) {
    constexpr int KSTR = DQK + 8;
    if (!NG) {
#pragma unroll
        for (int r = 0; r < 16; ++r) { p0[r] = 0.f; p1[r] = 0.f; }
    }
#pragma unroll
    for (int ds = 0; ds < DQK / 16; ++ds) {
        const bf16x8 k0 = *(const LAS bf16x8*)(kb + ds * 32), k1 = *(const LAS bf16x8*)(kb + 32 * (KSTR * 2) + ds * 32);
        bf16x8 q; if (QL) q = *(const LAS bf16x8*)(qb + ds * 1024); else q = qf[ds];
        if (NG && ds == 0) { p0 = MFMA32(k0, q, *c0); p1 = MFMA32(k1, q, *c0); } else { p0 = MFMA32(k0, q, p0); p1 = MFMA32(k1, q, p1); }
        if (AT_SB && DQK > 64 && (ds & 1)) __builtin_amdgcn_sched_barrier(0x7f); }
}
DI void at_mask(f32x16& p0, f32x16& p1, int dk) {
#pragma unroll
    for (int r = 0; r < 16; ++r) { const int d = dk + (r & 3) + 8 * (r >> 2);
        if (d > 128 || d < -128) p0[r] = NEGBIG;
        if (d + 32 > 128 || d + 32 < -128) p1[r] = NEGBIG; }
}
DI void at_psm(f32x16& p0, f32x16& p1, float& mrun, float& alpha) {
    float ma = fmaxf(fmaxf(p0[0], p0[1]), p0[2]), mb = fmaxf(fmaxf(p1[0], p1[1]), p1[2]);
    ma = fmaxf(fmaxf(ma, p0[3]), p1[3]);
#pragma unroll
    for (int r = 4; r < 16; r += 2) { ma = fmaxf(fmaxf(ma, p0[r]), p0[r + 1]); mb = fmaxf(fmaxf(mb, p1[r]), p1[r + 1]); }
    float mx = fmaxf(ma, mb);
    { auto rr = __builtin_amdgcn_permlane32_swap(__float_as_uint(mx), __float_as_uint(mx), false, false); mx = fmaxf(__uint_as_float(rr[0]), __uint_as_float(rr[1])); }
    const bool keep = __all(mx - mrun <= THR);
    const float mn = keep ? mrun : fmaxf(mrun, mx); alpha = __builtin_amdgcn_exp2f(mrun - mn); mrun = mn;
#pragma unroll
    for (int r = 0; r < 16; ++r) { p0[r] -= mrun; p1[r] -= mrun; }
#pragma unroll
    for (int r = 0; r < 16; ++r) p0[r] = __builtin_amdgcn_exp2f(p0[r]);
}
template <int DV> DI void at_scale_o(f32x16* o, LAS float* scw, float val, int r32, int hi);
template <bool NG>
DI void at_psm_lazy(f32x16& p0, f32x16& p1, float mrun) {
    if (!NG) {
#pragma unroll
        for (int r = 0; r < 16; ++r) { p0[r] -= mrun; p1[r] -= mrun; }
    }
#pragma unroll
    for (int r = 0; r < 16; ++r) p0[r] = __builtin_amdgcn_exp2f(p0[r]);
}
template <int DV>
DI void at_fsm_lazy(f32x16& p0, f32x16& p1, float& mrun, float& alpha, float& lrun, bf16x8* pa, f32x16* o, LAS float* scw, int r32, int hi) {
#pragma unroll
    for (int r = 0; r < 16; ++r) p1[r] = __builtin_amdgcn_exp2f(p1[r]);
    float sa = p0[0] + p0[1], sb = p0[2] + p0[3], sc_ = p1[0] + p1[1], sd = p1[2] + p1[3];
#pragma unroll
    for (int r = 4; r < 16; r += 2) { sa = opq(sa) + p0[r]; sb = opq(sb) + p0[r + 1]; sc_ = opq(sc_) + p1[r]; sd = opq(sd) + p1[r + 1]; }
    float ps = (opq(sa) + sb) + (opq(sc_) + sd);
    alpha = 1.f;
    if (__builtin_expect(__any(!(ps <= AT_LAZY_THR)), 0)) {
        float ma = fmaxf(fmaxf(p0[0], p0[1]), p0[2]), mb = fmaxf(fmaxf(p1[0], p1[1]), p1[2]);
        ma = fmaxf(fmaxf(ma, p0[3]), p1[3]);
#pragma unroll
        for (int r = 4; r < 16; r += 2) { ma = fmaxf(fmaxf(ma, p0[r]), p0[r + 1]); mb = fmaxf(fmaxf(mb, p1[r]), p1[r + 1]); }
        float mx = fmaxf(ma, mb);
        { auto rr = __builtin_amdgcn_permlane32_swap(__float_as_uint(mx), __float_as_uint(mx), false, false); mx = fmaxf(__uint_as_float(rr[0]), __uint_as_float(rr[1])); }
        const float d = fmaxf(__builtin_amdgcn_logf(mx), 0.f);
        alpha = __builtin_amdgcn_exp2f(-d); mrun += d; ps *= alpha;
#pragma unroll
        for (int r = 0; r < 16; ++r) { p0[r] *= alpha; p1[r] *= alpha; }
        at_scale_o<DV>(o, scw, alpha, r32, hi);
    }
    lrun = lrun * alpha + ps;
    u32x4 w;
    w.x = pk2(p0[0], p0[1]); w.y = pk2(p0[2], p0[3]); w.z = pk2(p0[4], p0[5]); w.w = pk2(p0[6], p0[7]); pa[0] = __builtin_bit_cast(bf16x8, w);
    w.x = pk2(p0[8], p0[9]); w.y = pk2(p0[10], p0[11]); w.z = pk2(p0[12], p0[13]); w.w = pk2(p0[14], p0[15]); pa[1] = __builtin_bit_cast(bf16x8, w);
    w.x = pk2(p1[0], p1[1]); w.y = pk2(p1[2], p1[3]); w.z = pk2(p1[4], p1[5]); w.w = pk2(p1[6], p1[7]); pa[2] = __builtin_bit_cast(bf16x8, w);
    w.x = pk2(p1[8], p1[9]); w.y = pk2(p1[10], p1[11]); w.z = pk2(p1[12], p1[13]); w.w = pk2(p1[14], p1[15]); pa[3] = __builtin_bit_cast(bf16x8, w);
}
DI void at_fsm(f32x16& p0, f32x16& p1, float alpha, float& lrun, bf16x8* pa) {
#pragma unroll
    for (int r = 0; r < 16; ++r) p1[r] = __builtin_amdgcn_exp2f(p1[r]);
    float ps = 0.f;
#pragma unroll
    for (int r = 0; r < 16; ++r) ps += p0[r] + p1[r];
    lrun = lrun * alpha + ps;
    u32x4 w;
    w.x = pk2(p0[0], p0[1]); w.y = pk2(p0[2], p0[3]); w.z = pk2(p0[4], p0[5]); w.w = pk2(p0[6], p0[7]); pa[0] = __builtin_bit_cast(bf16x8, w);
    w.x = pk2(p0[8], p0[9]); w.y = pk2(p0[10], p0[11]); w.z = pk2(p0[12], p0[13]); w.w = pk2(p0[14], p0[15]); pa[1] = __builtin_bit_cast(bf16x8, w);
    w.x = pk2(p1[0], p1[1]); w.y = pk2(p1[2], p1[3]); w.z = pk2(p1[4], p1[5]); w.w = pk2(p1[6], p1[7]); pa[2] = __builtin_bit_cast(bf16x8, w);
    w.x = pk2(p1[8], p1[9]); w.y = pk2(p1[10], p1[11]); w.z = pk2(p1[12], p1[13]); w.w = pk2(p1[14], p1[15]); pa[3] = __builtin_bit_cast(bf16x8, w);
}
DI void at_fsm_fake(f32x16& p0, f32x16& p1, bf16x8* pa) {
    u32x4 w;
    w.x = pk2(p0[0], p0[1]); w.y = pk2(p0[2], p0[3]); w.z = pk2(p0[4], p0[5]); w.w = pk2(p0[6], p0[7]); pa[0] = __builtin_bit_cast(bf16x8, w);
    w.x = pk2(p0[8], p0[9]); w.y = pk2(p0[10], p0[11]); w.z = pk2(p0[12], p0[13]); w.w = pk2(p0[14], p0[15]); pa[1] = __builtin_bit_cast(bf16x8, w);
    w.x = pk2(p1[0], p1[1]); w.y = pk2(p1[2], p1[3]); w.z = pk2(p1[4], p1[5]); w.w = pk2(p1[6], p1[7]); pa[2] = __builtin_bit_cast(bf16x8, w);
    w.x = pk2(p1[8], p1[9]); w.y = pk2(p1[10], p1[11]); w.z = pk2(p1[12], p1[13]); w.w = pk2(p1[14], p1[15]); pa[3] = __builtin_bit_cast(bf16x8, w);
}
template <int DV>
DI void at_pv(f32x16* o, const LAS unsigned char* vb, const bf16x8* pa) {
    constexpr int VSTR = DV + 32;
#if AT_PVKS == 2
    s16x4 vlo[2][DV / 32], vhi[2][DV / 32];
#pragma unroll
    for (int db = 0; db < DV / 32; ++db) { vlo[0][db] = tr16(vb + db * 64); vhi[0][db] = tr16(vb + 8 * (VSTR * 2) + db * 64); }
#pragma unroll
    for (int ks = 0; ks < 4; ++ks) {
        if (ks < 3) {
#pragma unroll
            for (int db = 0; db < DV / 32; ++db) { vlo[(ks + 1) & 1][db] = tr16(vb + (16 * (ks + 1)) * (VSTR * 2) + db * 64); vhi[(ks + 1) & 1][db] = tr16(vb + (16 * (ks + 1) + 8) * (VSTR * 2) + db * 64); }
        }
#pragma unroll
        for (int db = 0; db < DV / 32; ++db) { const bf16x8 vf = __builtin_shufflevector(vlo[ks & 1][db], vhi[ks & 1][db], 0, 1, 2, 3, 4, 5, 6, 7); o[db] = MFMA32(pa[ks], vf, o[db]); }
    }
#elif AT_PVKS
#else
#pragma unroll
    for (int db = 0; db < DV / 32; ++db) {
        s16x4 vlo[4], vhi[4];
#pragma unroll
        for (int ks = 0; ks < 4; ++ks) { vlo[ks] = tr16(vb + (16 * ks) * (VSTR * 2) + db * 64); vhi[ks] = tr16(vb + (16 * ks + 8) * (VSTR * 2) + db * 64); }
#pragma unroll
        for (int ks = 0; ks < 4; ++ks) { const bf16x8 vf = __builtin_shufflevector(vlo[ks], vhi[ks], 0, 1, 2, 3, 4, 5, 6, 7); o[db] = MFMA32(pa[ks], vf, o[db]); }
    }
#endif
}
template <int DV>
DI void at_scale_o(f32x16* o, LAS float* scw, float val, int r32, int hi) {
    if (hi == 0) scw[r32] = val;
    __builtin_amdgcn_wave_barrier(); asm volatile("" ::: "memory");
#pragma unroll
    for (int g4 = 0; g4 < 4; ++g4) { const f32x4 a4 = *(const LAS f32x4*)(scw + 8 * g4 + 4 * hi);
#pragma unroll
        for (int db = 0; db < DV / 32; ++db) { o[db][4 * g4 + 0] *= a4[0]; o[db][4 * g4 + 1] *= a4[1]; o[db][4 * g4 + 2] *= a4[2]; o[db][4 * g4 + 3] *= a4[3]; } }
    __builtin_amdgcn_wave_barrier(); asm volatile("" ::: "memory");
}
template <int DQK, int DV, int OUTM, bool MASKED>
DI void attn_unit(LAS unsigned char* lds, const bf16_t* Qp, int ldq, const bf16_t* Kp, int ldk, const bf16_t* Vp, int ldv,
                  int nA, int rowB0, int nB, int posB0, int qpos0, float m0, float l0,
                  bf16_t* Og, int ldo, float* Of, int ldof) {
    constexpr int KSTR = DQK + 8, VSTR = DV + 32, KBUF = 64 * KSTR * 2, VBUF = 64 * VSTR * 2;
    constexpr int KCH = DQK / 8, VCH = DV / 8, NKC = 64 * KCH, NVC = 64 * VCH, KRN = (NKC + 511) / 512, VRN = (NVC + 511) / 512;
    static_assert(KBUF <= AT_KBUFMAX && VBUF <= AT_VBUFMAX, "attention LDS map");
    const int tid = tid_l(), lane = tid & 63, wid = __builtin_amdgcn_readfirstlane(tid >> 6), r32 = lane & 31, hi = lane >> 5;
#ifndef AT_QL
#define AT_QL 0
#endif
#ifndef AT_SB
#define AT_SB 0
#endif
    constexpr bool NG = (AT_NEGM == 1 && DQK == 64) || (AT_NEGM == 2 && DQK == 64 && DV == 64);
    constexpr bool QL = AT_QL && (DQK > AT_QLMIN || (NG && DV == 128));
    bf16x8 qf[QL ? 1 : DQK / 16];
    const LAS unsigned char* qb = lds + AT_QOFF + wid * 6144 + lane * 16;
    { const bf16_t* qrow = Qp + (size_t)(32 * wid + r32) * ldq + 8 * hi;
#pragma unroll
      for (int ds = 0; ds < DQK / 16; ++ds) { const bf16x8 v = *(const bf16x8*)(qrow + 16 * ds); if (QL) *(LAS bf16x8*)(lds + AT_QOFF + wid * 6144 + lane * 16 + ds * 1024) = v; else qf[QL ? 0 : ds] = v; }
      if (QL) { __builtin_amdgcn_wave_barrier(); asm volatile("s_waitcnt lgkmcnt(0)" ::: "memory"); } }
    f32x16 o[DV / 32];
#pragma unroll
    for (int db = 0; db < DV / 32; ++db)
#pragma unroll
        for (int r = 0; r < 16; ++r) o[db][r] = 0.f;
    float mrun = m0, lrun = (hi == 0) ? l0 : 0.f;
    LAS float* scw = (LAS float*)(lds + AT_SOFF) + wid * 32;
    const int NT = nA + nB;
    const LAS unsigned char* kb0 = lds + AT_KOFF + r32 * (KSTR * 2) + hi * 16;
    const LAS unsigned char* vb0 = lds + AT_VOFF + (4 * hi + ((lane & 15) >> 2)) * (VSTR * 2) + (16 * ((lane >> 4) & 1) + 4 * (lane & 3)) * 2;
    const int dk0 = posB0 + 4 * hi - (qpos0 + 32 * wid + r32) - 64 * nA;
    u32x4 kreg[KRN], vreg[VRN];
    int kgo[KRN], klo[KRN], vgo[VRN], vlo_[VRN];
#pragma unroll
    for (int i_ = 0; i_ < KRN; ++i_) { int c_ = tid + 512 * i_; if (c_ >= NKC) c_ -= 512; const int r_ = c_ / KCH, cc_ = c_ % KCH; kgo[i_] = r_ * ldk + cc_ * 8; klo[i_] = AT_KOFF + r_ * (KSTR * 2) + cc_ * 16; }
#pragma unroll
    for (int i_ = 0; i_ < VRN; ++i_) { int c_ = tid + 512 * i_; if (c_ >= NVC) c_ -= 512; const int r_ = c_ / VCH, cc_ = c_ % VCH; vgo[i_] = r_ * ldv + cc_ * 8; vlo_[i_] = AT_VOFF + r_ * (VSTR * 2) + cc_ * 16; }
    const __amdgpu_buffer_rsrc_t rK = __builtin_amdgcn_make_buffer_rsrc((void*)Kp, 0, 0x7fffffff, 0x00020000), rV = __builtin_amdgcn_make_buffer_rsrc((void*)Vp, 0, 0x7fffffff, 0x00020000);
#define AT_GLOAD(t) do { const int row0_ = (t) < nA ? 64 * (t) : rowB0 + 64 * ((t) - nA); const int sk_ = row0_ * ldk * 2, sv_ = row0_ * ldv * 2; \
        _Pragma("unroll") for (int i_ = 0; i_ < KRN; ++i_) kreg[i_] = __builtin_amdgcn_raw_buffer_load_b128(rK, kgo[i_] * 2, sk_, 0); \
        _Pragma("unroll") for (int i_ = 0; i_ < VRN; ++i_) vreg[i_] = __builtin_amdgcn_raw_buffer_load_b128(rV, vgo[i_] * 2, sv_, 0); } while (0)
#define AT_SWRITE(buf) do { \
        _Pragma("unroll") for (int i_ = 0; i_ < KRN; ++i_) *(LAS u32x4*)(lds + (buf) * KBUF + klo[i_]) = kreg[i_]; \
        _Pragma("unroll") for (int i_ = 0; i_ < VRN; ++i_) *(LAS u32x4*)(lds + (buf) * VBUF + vlo_[i_]) = vreg[i_]; } while (0)
    unsigned pfv = 0u, pfacc = 0u;
    const int pft = tid & 255;
    const bf16_t* pfb = (pft < 128) ? Kp + (pft >> 1) * ldk + (pft & 1) * (DQK - 2) : Vp + ((pft - 128) >> 1) * ldv + (pft & 1) * (DV - 2);
    const int pfs = (pft < 128) ? ldk : ldv;
    constexpr int PFD = 4;
#if AT_NOPF
#define AT_PF(t) do {} while (0)
#else
#define AT_PF(t) do { pfacc ^= pfv; const int tt_ = (t) < NT ? (t) : NT - 1; const int row0_ = tt_ < nA ? 64 * tt_ : rowB0 + 64 * (tt_ - nA); \
        pfv = *(const unsigned*)(pfb + (size_t)row0_ * pfs); } while (0)
#endif
#define AT_MASK(P0, P1, t) do { if (MASKED && (t) >= nA) at_mask(P0, P1, dk0 + 64 * (t)); } while (0)
#define AT_RESC(al) do { if (__any((al) < 1.f)) at_scale_o<DV>(o, scw, (al), r32, hi); } while (0)
    constexpr int DRYP = (OUTM == 2) ? PROBE_MODE : 0;
    f32x16 pA0, pA1, pB0, pB1; float alA, alB; bf16x8 pa[4];
    AT_PF(1); AT_PF(2); AT_PF(3);
    AT_GLOAD(0); AT_SWRITE(0); __syncthreads();
    AT_GLOAD(1);
    at_qkt<DQK, QL>(pA0, pA1, kb0, qf, qb); AT_MASK(pA0, pA1, 0); at_psm(pA0, pA1, mrun, alA);
#if AT_LAZY
    lrun *= alA;
#endif
    AT_SWRITE(1); __syncthreads();
    int bp = 0, bc = 1, bn = 2;
    constexpr int NMF = 2 * (DQK / 16) + 4 * (DV / 32);
#if AT_IGLP >= 0
#define AT_SCHED() __builtin_amdgcn_iglp_opt(AT_IGLP)
#elif AT_SGB
#define AT_SCHED() do { _Pragma("unroll") for (int i_ = 0; i_ < NMF; ++i_) { __builtin_amdgcn_sched_group_barrier(0x008, 1, 0); __builtin_amdgcn_sched_group_barrier(0x100, 2, 0); __builtin_amdgcn_sched_group_barrier(0x002, AT_SGB, 0); } } while (0)
#else
#define AT_SCHED() do {} while (0)
#endif
#define AT_ROT() do { bp = bc; bc = bn; bn = (bn == 2) ? 0 : bn + 1; } while (0)
#if AT_LAZY
    f32x16 negm;
    if (NG) {
#pragma unroll
        for (int r = 0; r < 16; ++r) negm[r] = -mrun;
    }
#define AT_NEGUPD(al, P0, P1) do { if (NG && __any((al) < 1.f)) { const float d_ = -__builtin_amdgcn_logf(al); _Pragma("unroll") for (int r_ = 0; r_ < 16; ++r_) { negm[r_] = -mrun; P0[r_] -= d_; P1[r_] -= d_; } } } while (0)
    for (int j = 1; j + 1 < NT; j += 2) {
        at_qkt<DQK, QL, NG>(pB0, pB1, kb0 + bc * KBUF, qf, qb, &negm); AT_MASK(pB0, pB1, j);
        AT_GLOAD(j + 1);
        at_fsm_lazy<DV>(pA0, pA1, mrun, alA, lrun, pa, o, scw, r32, hi);
        AT_NEGUPD(alA, pB0, pB1);
        at_pv<DV>(o, vb0 + bp * VBUF, pa); at_psm_lazy<NG>(pB0, pB1, mrun);
        AT_SWRITE(bn);
        __syncthreads(); AT_ROT();
        at_qkt<DQK, QL, NG>(pA0, pA1, kb0 + bc * KBUF, qf, qb, &negm); AT_MASK(pA0, pA1, j + 1);
        AT_GLOAD(j + 2);
        at_fsm_lazy<DV>(pB0, pB1, mrun, alB, lrun, pa, o, scw, r32, hi);
        AT_NEGUPD(alB, pA0, pA1);
        at_pv<DV>(o, vb0 + bp * VBUF, pa); at_psm_lazy<NG>(pA0, pA1, mrun);
        AT_SWRITE(bn);
        __syncthreads(); AT_ROT();
    }
    at_qkt<DQK, QL, NG>(pB0, pB1, kb0 + bc * KBUF, qf, qb, &negm); AT_MASK(pB0, pB1, NT - 1);
    at_fsm_lazy<DV>(pA0, pA1, mrun, alA, lrun, pa, o, scw, r32, hi);
    AT_NEGUPD(alA, pB0, pB1);
    at_pv<DV>(o, vb0 + bp * VBUF, pa); at_psm_lazy<NG>(pB0, pB1, mrun);
    at_fsm_lazy<DV>(pB0, pB1, mrun, alB, lrun, pa, o, scw, r32, hi);
    at_pv<DV>(o, vb0 + bc * VBUF, pa);
#else
    for (int j = 1; j + 1 < ((DRYP == 6) ? 2 : NT); j += 2) {
        SBAR(); if (DRYP != 5) at_qkt<DQK, QL>(pB0, pB1, kb0 + bc * KBUF, qf, qb); else { _Pragma("unroll") for (int r_ = 0; r_ < 16; ++r_) { pB0[r_] = o[0][r_] * 1e-3f; pB1[r_] = o[1][r_] * 1e-3f; } } AT_MASK(pB0, pB1, j);
        if (!(DRYP >= 1)) { AT_GLOAD(j + 1); AT_PF(j + PFD); }
        if (DRYP != 3) at_fsm(pA0, pA1, alA, lrun, pa); else at_fsm_fake(pA0, pA1, pa); SBAR();
        if (DRYP != 4) at_pv<DV>(o, vb0 + bp * VBUF, pa); else { o[0][0] += __builtin_bit_cast(float, (int)pa[0][0] + (int)pa[1][1] + (int)pa[2][2] + (int)pa[3][3]); } if (DRYP != 3) at_psm(pB0, pB1, mrun, alB); else alB = 1.f;
        AT_SCHED();
        if (!(DRYP >= 1)) AT_SWRITE(bn);
        AT_RESC(alB); if (DRYP != 2) __syncthreads(); AT_ROT();
        SBAR(); if (DRYP != 5) at_qkt<DQK, QL>(pA0, pA1, kb0 + bc * KBUF, qf, qb); else { _Pragma("unroll") for (int r_ = 0; r_ < 16; ++r_) { pA0[r_] = o[0][r_] * 1e-3f; pA1[r_] = o[1][r_] * 1e-3f; } } AT_MASK(pA0, pA1, j + 1);
        if (!(DRYP >= 1)) { AT_GLOAD(j + 2); AT_PF(j + 1 + PFD); }
        if (DRYP != 3) at_fsm(pB0, pB1, alB, lrun, pa); else at_fsm_fake(pB0, pB1, pa); SBAR();
        if (DRYP != 4) at_pv<DV>(o, vb0 + bp * VBUF, pa); else { o[0][0] += __builtin_bit_cast(float, (int)pa[0][0] + (int)pa[1][1] + (int)pa[2][2] + (int)pa[3][3]); } if (DRYP != 3) at_psm(pA0, pA1, mrun, alA); else alA = 1.f;
        AT_SCHED();
        if (!(DRYP >= 1)) AT_SWRITE(bn);
        AT_RESC(alA); if (DRYP != 2) __syncthreads(); AT_ROT();
    }
    SBAR(); at_qkt<DQK, QL>(pB0, pB1, kb0 + bc * KBUF, qf, qb); AT_MASK(pB0, pB1, NT - 1);
    at_fsm(pA0, pA1, alA, lrun, pa); SBAR();
    at_pv<DV>(o, vb0 + bp * VBUF, pa); at_psm(pB0, pB1, mrun, alB);
    AT_RESC(alB);
    at_fsm(pB0, pB1, alB, lrun, pa); SBAR();
    at_pv<DV>(o, vb0 + bc * VBUF, pa);
#endif
#undef AT_ROT
#ifdef AT_NEGUPD
#undef AT_NEGUPD
#endif
#undef AT_SCHED
    pfacc ^= pfv;
    if (__builtin_expect(pfacc == 0x9e3779b9u && lrun == 12345.678f, 0)) scw[0] = 1.f;
#undef AT_GLOAD
#undef AT_PF
#undef AT_SWRITE
#undef AT_MASK
#undef AT_RESC
    { const float lt = lrun + __shfl_xor(lrun, 32); at_scale_o<DV>(o, scw, 1.0f / lt, r32, hi); }
    if (OUTM == 0) {
        static_assert(!(AT_QL), "the output staging tile re-uses the Q park area");
        LAS float* st = (LAS float*)(lds + AT_QOFF + wid * 6144);
#pragma unroll
        for (int db = 0; db < DV / 32; ++db) {
#pragma unroll
            for (int r = 0; r < 16; ++r) st[((r & 3) + 8 * (r >> 2) + 4 * hi) * 36 + r32] = o[db][r];
            __builtin_amdgcn_wave_barrier(); asm volatile("s_waitcnt lgkmcnt(0)" ::: "memory");
#pragma unroll
            for (int i = 0; i < 2; ++i) {
                const int c = lane + 64 * i, row = c >> 2, cc = c & 3;
                f32x4 a = *(const LAS f32x4*)(st + row * 36 + cc * 8), b = *(const LAS f32x4*)(st + row * 36 + cc * 8 + 4);
                bf16_t* gp = Og + (size_t)(32 * wid + row) * ldo + 32 * db + cc * 8;
                const u32x4 z = *(const u32x4*)gp;
                a[0] *= silu_f(bflo(z.x)); a[1] *= silu_f(bfhi(z.x)); a[2] *= silu_f(bflo(z.y)); a[3] *= silu_f(bfhi(z.y));
                b[0] *= silu_f(bflo(z.z)); b[1] *= silu_f(bfhi(z.z)); b[2] *= silu_f(bflo(z.w)); b[3] *= silu_f(bfhi(z.w));
                *(u32x4*)gp = pack8(a, b);
            }
            __builtin_amdgcn_wave_barrier(); asm volatile("s_waitcnt lgkmcnt(0)" ::: "memory");
        }
    } else {
#pragma unroll
        for (int db = 0; db < DV / 32; ++db)
#pragma unroll
            for (int r = 0; r < 16; ++r) {
                const int q = (r & 3) + 8 * (r >> 2) + 4 * hi;
                if (OUTM == 1) { Of[(size_t)(32 * wid + q) * ldof + 32 * db + r32] = o[db][r]; }
                else { if (lrun == 12345.678f) Of[(size_t)(32 * wid + q) * ldof + 32 * db + r32] = o[db][r]; }
            }
    }
    __syncthreads();
}

struct Args { const float* in[21]; float* out; unsigned char* ws; };
typedef const __attribute__((address_space(4))) Args* ArgsP;
DI ArgsP args_ptr() { ArgsP p = (ArgsP)__builtin_amdgcn_kernarg_segment_ptr(); asm volatile("" : "+s"(p)); return p; }
enum { I_X = 0, I_C, I_CTX, I_CCTX, I_WMOD, I_BMOD, I_NORMG, I_WIN, I_QNORM, I_WUQ, I_KVNORM, I_WUKV, I_LQ1, I_LK1, I_LQ2, I_LK2, I_SUBLN, I_SINK, I_WBR, I_WOUT, I_FNORM };

DI int colmap(int kind, int n) {
    if (kind == 1) {
        if (n < C_KR) return n;
        if (n < C_KR + 32) { const int e = n - C_KR; return C_KR + (e >> 1) + 16 * (e & 1); }
        if (n < C_DQ) return -1;
        if ((n >= C_DQ && n < C_DV) || (n >= C_SQ && n < C_SV)) { const int w = n & 63; return (n - w) - 96 + (w >> 1) + 32 * (w & 1); }
        return n - 96;
    }
    if (kind == 2) { const int h = n / 96, e = n % 96; if (e < 64) return n; const int e2 = e - 64; return h * 96 + 64 + (e2 >> 1) + 16 * (e2 & 1); }
    if (kind == 3) { if (n < 512) return (n >> 6) * 192 + (n & 63); const int n2 = n - 512; return (n2 >> 7) * 192 + 64 + (n2 & 127); }
    return n;
}
DI void transpose_item(const float* W, int ldw, int kind, const float* rowscale, bf16_t* WT, int ldd, int koff, LAS float* scr, int item, int nblk, int lane) {
    const int kb = item / nblk, nb = item % nblk, k0 = 64 * kb, n0 = 32 * nb;
    const int oc = colmap(kind, n0 + (lane & 31));
#pragma unroll 8
    for (int i = 0; i < 32; ++i) { const int kk = 2 * i + (lane >> 5); float v = 0.f; if (oc >= 0) v = W[(size_t)(k0 + kk) * ldw + oc]; if (rowscale) v *= rowscale[k0 + kk]; scr[kk * 33 + (lane & 31)] = v; }
    __builtin_amdgcn_wave_barrier(); asm volatile("s_waitcnt lgkmcnt(0)" ::: "memory");
    const int c = lane & 7;
#pragma unroll
    for (int j = 0; j < 4; ++j) { const int n = (lane >> 3) + 8 * j; const LAS float* s = scr + (8 * c) * 33 + n;
        u32x4 o; o.x = pk2(s[0 * 33], s[1 * 33]); o.y = pk2(s[2 * 33], s[3 * 33]); o.z = pk2(s[4 * 33], s[5 * 33]); o.w = pk2(s[6 * 33], s[7 * 33]);
        *(u32x4*)(WT + (size_t)(n0 + n) * ldd + koff + k0 + 8 * c) = o; }
    __builtin_amdgcn_wave_barrier(); asm volatile("s_waitcnt lgkmcnt(0)" ::: "memory");
}
DI void prologue(ArgsP ap, LAS unsigned char* lds) {
    const int tid = tid_l(), lane = tid & 63, wid = __builtin_amdgcn_readfirstlane(tid >> 6);
    unsigned char* ws = ap->ws;
    LAS float* scr = (LAS float*)(lds + wid * 8448);
    const int gw = bid_l() * 8 + wid, NGW = grd_l() * 8;
    constexpr int I_IN = 16 * (NP / 32), I_UQ = 6 * 24, I_UKV = 4 * 48, I_SQ = 16 * 32, PER_L = I_IN + I_UQ + I_UKV + 6 * I_SQ;
    for (int it = gw; it < 2 * PER_L; it += NGW) {
        const int l = it / PER_L; int r = it % PER_L;
        if (r < I_IN) { transpose_item(ap->in[I_WIN] + (size_t)l * 1024 * D_IN, D_IN, 1, nullptr, (bf16_t*)(ws + WS_WIN) + (size_t)l * NP * 1024, 1024, 0, scr, r, NP / 32, lane); continue; } r -= I_IN;
        if (r < I_UQ) { transpose_item(ap->in[I_WUQ] + (size_t)l * 384 * 768, 768, 2, ap->in[I_QNORM] + l * 384, (bf16_t*)(ws + WS_WUQ) + (size_t)l * 768 * 384, 384, 0, scr, r, 24, lane); continue; } r -= I_UQ;
        if (r < I_UKV) { transpose_item(ap->in[I_WUKV] + (size_t)l * 256 * 1536, 1536, 3, ap->in[I_KVNORM] + l * 256, (bf16_t*)(ws + WS_WUKV) + (size_t)l * 1536 * 256, 256, 0, scr, r, 48, lane); continue; } r -= I_UKV;
        if (r < 3 * I_SQ) { const int br = r / I_SQ; transpose_item(ap->in[I_WBR] + ((size_t)l * 3 + br) * 1024 * 1024, 1024, 0, nullptr, (bf16_t*)(ws + WS_WB) + ((size_t)l * 3 + br) * 1024 * 1024, 1024, 0, scr, r % I_SQ, 32, lane); continue; } r -= 3 * I_SQ;
        { const int rep = r / I_SQ; transpose_item(ap->in[I_WOUT] + (size_t)l * 1024 * 1024, 1024, 0, nullptr, (bf16_t*)(ws + WS_WO3) + (size_t)l * 1024 * 3072, 3072, rep * 1024, scr, r % I_SQ, 32, lane); }
    }
    const int gt = bid_l() * 512 + tid, NGT = grd_l() * 512;
    for (int i = gt; i < SEQ * 48; i += NGT) {
        const int pos = i / 48, p = i % 48; const float frow = (float)(pos >> 6), fcol = (float)(pos & 63);
        float ang; float* cd; float* sd;
        if (p < 32) { const int f = p & 15; const float inv = powf(10000.0f, -(float)f / 16.0f); ang = (p < 16 ? frow : fcol) * inv; cd = (float*)(ws + WS_COSH) + pos * 32 + p; sd = (float*)(ws + WS_SINH) + pos * 32 + p; }
        else { const int pp = p - 32, f = pp & 7; const float inv = powf(10000.0f, -(float)f / 8.0f); ang = (pp < 8 ? frow : fcol) * inv; cd = (float*)(ws + WS_COSM) + pos * 16 + pp; sd = (float*)(ws + WS_SINM) + pos * 16 + pp; }
        *cd = __cosf(ang); *sd = __sinf(ang);
    }
    for (int it = gw; it < 2 * 16 * 48; it += NGW) {
        const int l = it / 768, rem = it % 768, kc = rem / 48, nb = rem % 48; const int k = kc * 64 + lane;
        float sv[9];
#pragma unroll
        for (int v = 0; v < 8; ++v) sv[v] = silu_f(ap->in[I_C][v * 1024 + k]);
        sv[8] = silu_f(ap->in[I_CCTX][k]);
        float acc[9];
#pragma unroll
        for (int v = 0; v < 9; ++v) acc[v] = 0.f;
        const float* w = ap->in[I_WMOD] + ((size_t)l * 1024 + kc * 64) * 3072 + nb * 64 + lane;
#pragma unroll 8
        for (int kk = 0; kk < 64; ++kk) { const float wv = w[(size_t)kk * 3072];
#pragma unroll
            for (int v = 0; v < 9; ++v) acc[v] += __uint_as_float(__builtin_amdgcn_readlane(__float_as_uint(sv[v]), kk)) * wv; }
        float* mp = (float*)(ws + WS_MODP) + ((size_t)(l * 16 + kc) * 9) * 3072 + nb * 64 + lane;
#pragma unroll
        for (int v = 0; v < 9; ++v) mp[(size_t)v * 3072] = acc[v];
    }
}
DI void mod_finalize(ArgsP ap) {
    const int tid = tid_l();
    const int gt = bid_l() * 512 + tid, NGT = grd_l() * 512;
    const float* mp = (const float*)(ap->ws + WS_MODP); float* mod = (float*)(ap->ws + WS_MOD);
    for (int i = gt; i < 2 * 9 * 3072; i += NGT) {
        const int l = i / (9 * 3072), rem = i % (9 * 3072), n = rem % 3072;
        float s = ap->in[I_BMOD][l * 3072 + n];
#pragma unroll
        for (int kc = 0; kc < 16; ++kc) s += mp[(size_t)(l * 16 + kc) * 9 * 3072 + rem];
        mod[i] = s;
    }
}
DI void ph_norm_mod(ArgsP ap, int l, int g) {
    const int tid = tid_l(), lane = tid & 63, wid = __builtin_amdgcn_readfirstlane(tid >> 6);
    const int gw = bid_l() * 8 + wid, NGW = grd_l() * 8;
    const float* ng = ap->in[I_NORMG] + l * 1024; const float* mod = (const float*)(ap->ws + WS_MOD) + (size_t)l * 9 * 3072;
    const float* xs = (l == 0) ? ap->in[I_X] : ap->out; const float* cs = (l == 0) ? ap->in[I_CTX] : (const float*)(ap->ws + WS_CTX);
    bf16_t* H = (bf16_t*)(ap->ws + WS_H);
    for (int r = gw; r < R; r += NGW) {
        const int bl = r / RB, j = r % RB, b = g * GB + bl;
        const float* src; const float* md;
        if (j < CTX) { src = cs + ((size_t)b * CTX + j) * DM; md = mod + 8 * 3072; } else { src = xs + ((size_t)b * SEQ + (j - CTX)) * DM; md = mod + (size_t)b * 3072; }
        f32x4 v[4]; float ss = 0.f;
#pragma unroll
        for (int q = 0; q < 4; ++q) { v[q] = *(const f32x4*)(src + 4 * (lane + 64 * q)); ss += (v[q][0] * v[q][0] + v[q][1] * v[q][1]) + (v[q][2] * v[q][2] + v[q][3] * v[q][3]); }
        const float rstd = 1.0f / sqrtf(wave_sum(ss) * (1.0f / DM) + EPS);
#pragma unroll
        for (int q = 0; q < 4; ++q) { const int idx = 4 * (lane + 64 * q);
            const f32x4 gg = *(const f32x4*)(ng + idx), sh = *(const f32x4*)(md + idx), sc = *(const f32x4*)(md + 1024 + idx);
            const f32x4 y = (v[q] * rstd * gg) * (sc + 1.0f) + sh;
            u32x2 w; w.x = pk2(y[0], y[1]); w.y = pk2(y[2], y[3]); *(u32x2*)(H + (size_t)r * DM + idx) = w; }
    }
}
DI void ph_mla_norm(ArgsP ap) {
    const int tid = tid_l(), lane = tid & 63, wid = __builtin_amdgcn_readfirstlane(tid >> 6);
    const int gw = bid_l() * 8 + wid, NGW = grd_l() * 8;
    const bf16_t* P = (const bf16_t*)(ap->ws + WS_P); bf16_t* AQ = (bf16_t*)(ap->ws + WS_AQ); bf16_t* AKV = (bf16_t*)(ap->ws + WS_AKV); bf16_t* KM = (bf16_t*)(ap->ws + WS_KM);
    for (int r = gw; r < R; r += NGW) {
        const bf16_t* row = P + (size_t)r * NP;
        const u32x4 c0 = *(const u32x4*)(row + 8 * lane);
        u32x4 c1 = {0u, 0u, 0u, 0u}; if (lane < 20) c1 = *(const u32x4*)(row + 8 * (64 + lane));
        float f0[8] = {bflo(c0.x), bfhi(c0.x), bflo(c0.y), bfhi(c0.y), bflo(c0.z), bfhi(c0.z), bflo(c0.w), bfhi(c0.w)};
        float f1[8] = {bflo(c1.x), bfhi(c1.x), bflo(c1.y), bfhi(c1.y), bflo(c1.z), bfhi(c1.z), bflo(c1.w), bfhi(c1.w)};
        float s0 = 0.f, s1 = 0.f;
#pragma unroll
        for (int i = 0; i < 8; ++i) { s0 += f0[i] * f0[i]; s1 += f1[i] * f1[i]; }
        const float sq = wave_sum(lane < 48 ? s0 : 0.f);
        const float skv = wave_sum((lane >= 48 ? s0 : 0.f) + (lane < 16 ? s1 : 0.f));
        const float rq = 1.0f / sqrtf(sq * (1.0f / 384.0f) + EPS), rkv = 1.0f / sqrtf(skv * (1.0f / 256.0f) + EPS);
        { const float rr = lane < 48 ? rq : rkv; u32x4 w; w.x = pk2(f0[0] * rr, f0[1] * rr); w.y = pk2(f0[2] * rr, f0[3] * rr); w.z = pk2(f0[4] * rr, f0[5] * rr); w.w = pk2(f0[6] * rr, f0[7] * rr);
          if (lane < 48) *(u32x4*)(AQ + (size_t)r * 384 + 8 * lane) = w; else *(u32x4*)(AKV + (size_t)r * 256 + 8 * (lane - 48)) = w; }
        if (lane < 16) { u32x4 w; w.x = pk2(f1[0] * rkv, f1[1] * rkv); w.y = pk2(f1[2] * rkv, f1[3] * rkv); w.z = pk2(f1[4] * rkv, f1[5] * rkv); w.w = pk2(f1[6] * rkv, f1[7] * rkv);
            *(u32x4*)(AKV + (size_t)r * 256 + 8 * (16 + lane)) = w; }
        else if (lane < 20) {
#pragma unroll
            for (int h = 0; h < 8; ++h) *(u32x4*)(KM + (size_t)r * 768 + h * 96 + 64 + 8 * (lane - 16)) = c1; }
    }
}
template <bool DRYE>
DI void ph_diff_post(ArgsP ap, int l) {
    const int tid = tid_l(), lane = tid & 63, wid = __builtin_amdgcn_readfirstlane(tid >> 6);
    const int gw = bid_l() * 8 + wid, NGW = grd_l() * 8;
    const float lam_init = (l == 0) ? 0.2f : (0.8f - 0.6f * 0.7408182206817179f);
    const float d1 = wave_sum(ap->in[I_LQ1][l * 64 + lane] * ap->in[I_LK1][l * 64 + lane]), d2 = wave_sum(ap->in[I_LQ2][l * 64 + lane] * ap->in[I_LK2][l * 64 + lane]);
    const float lam = expf(d1) - expf(d2) + lam_init;
    const float sl0 = ap->in[I_SUBLN][l * 128 + 2 * lane] * (1.0f - lam_init), sl1 = ap->in[I_SUBLN][l * 128 + 2 * lane + 1] * (1.0f - lam_init);
    const float* OD = (const float*)(ap->ws + WS_OD); bf16_t* P = (bf16_t*)(ap->ws + WS_P);
    typedef float f32x2 __attribute__((ext_vector_type(2)));
    for (int r = gw; r < R; r += NGW) {
        if (l != 0 && (r % RB) < CTX) continue;
        const float* ob = OD + (size_t)r * 2048 + 2 * lane; unsigned* zb = (unsigned*)(P + (size_t)r * NP + C_Z + 1024 + 2 * lane);
        f32x2 o1[8], o2[8]; unsigned z[8];
#pragma unroll
        for (int h = 0; h < 8; ++h) { o1[h] = *(const f32x2*)(ob + (2 * h) * 128); o2[h] = *(const f32x2*)(ob + (2 * h + 1) * 128); z[h] = zb[h * 64]; }
#pragma unroll
        for (int h = 0; h < 8; ++h) {
            const float a0 = o1[h][0] - lam * o2[h][0], a1 = o1[h][1] - lam * o2[h][1];
            const float rstd = 1.0f / sqrtf(wave_sum(a0 * a0 + a1 * a1) * (1.0f / 128.0f) + EPS);
            if (!DRYE || rstd == 12345.678f) zb[h * 64] = pk2(a0 * rstd * sl0 * silu_f(bflo(z[h])), a1 * rstd * sl1 * silu_f(bfhi(z[h])));
        }
    }
}
template <bool DRYE>
DI void ph_final_norm(ArgsP ap) {
    const int tid = tid_l(), lane = tid & 63, wid = __builtin_amdgcn_readfirstlane(tid >> 6);
    const int gw = bid_l() * 8 + wid, NGW = grd_l() * 8; const float* fg = ap->in[I_FNORM];
    for (int r = gw; r < NBATCH * SEQ; r += NGW) {
        float* row = ap->out + (size_t)r * DM; f32x4 v[4]; float ss = 0.f;
#pragma unroll
        for (int q = 0; q < 4; ++q) { v[q] = *(const f32x4*)(row + 4 * (lane + 64 * q)); ss += (v[q][0] * v[q][0] + v[q][1] * v[q][1]) + (v[q][2] * v[q][2] + v[q][3] * v[q][3]); }
        const float rstd = 1.0f / sqrtf(wave_sum(ss) * (1.0f / DM) + EPS);
#pragma unroll
        for (int q = 0; q < 4; ++q) { const int idx = 4 * (lane + 64 * q); if (!DRYE || rstd == 12345.678f) *(f32x4*)(row + idx) = v[q] * rstd * *(const f32x4*)(fg + idx); }
    }
}
template <bool DRY>
DI void ph_attention(ArgsP ap, int l, LAS unsigned char* lds) {
    constexpr int OM0 = DRY ? 2 : 0;
    const int G = grd_l(), bx = bid_l(), vcu = (G % 8 == 0) ? (bx % 8) * (G / 8) + bx / 8 : bx;
    bf16_t* P = (bf16_t*)(ap->ws + WS_P); const bf16_t* QM = (const bf16_t*)(ap->ws + WS_QM); const bf16_t* KM = (const bf16_t*)(ap->ws + WS_KM); const bf16_t* VM = (const bf16_t*)(ap->ws + WS_VM);
    float* OD = (float*)(ap->ws + WS_OD); const float* sink = ap->in[I_SINK] + l * 16;
#if !defined(ATT_ONLY) || ATT_ONLY == 1
    if (!DRY || (DRY_SEL & 1))
    for (int u = vcu; u < GB * 8 * 32; u += G) { const int bh = u >> 5, qb = u & 31, bl = bh >> 3, h = bh & 7; const size_t rb = (size_t)bl * RB, q0 = rb + CTX + 256 * qb;
        attn_unit<96, 128, OM0, false>(lds, QM + q0 * 768 + h * 96, 768, KM + rb * 768 + h * 96, 768, VM + rb * 1024 + h * 128, 1024, RB / 64, 0, 0, 0, 0, NEGBIG, 0.f, P + q0 * NP + C_Z + h * 128, NP, OD, 0); }
#endif
#if !defined(ATT_ONLY) || ATT_ONLY == 2
    if (!DRY || (DRY_SEL & 2))
    for (int u = vcu; u < GB * 16 * 32; u += G) { const int bh = u >> 5, qb = u & 31, bl = bh >> 4, hm = bh & 15; const size_t rb = (size_t)bl * RB, q0 = rb + CTX + 256 * qb;
        attn_unit<64, 128, 1, false>(lds, P + q0 * NP + C_DQ + hm * 64, NP, P + rb * NP + C_DK + hm * 64, NP, P + rb * NP + C_DV + (hm >> 1) * 128, NP, RB / 64, 0, 0, 0, 0, NEGBIG, 0.f, nullptr, 0, OD + q0 * 2048 + hm * 128, 2048); }
#endif
#if !defined(ATT_ONLY) || ATT_ONLY == 3
    if (!DRY || (DRY_SEL & 4))
    for (int u = vcu; u < GB * 16 * 32; u += G) { const int bh = u >> 5, qb = u & 31, bl = bh >> 4, h = bh & 15; const size_t rb = (size_t)bl * RB, q0 = rb + CTX + 256 * qb;
        const int lo = (256 * qb - 128 < 0) ? 0 : 256 * qb - 128, hi = (256 * qb + 384 > SEQ) ? SEQ : 256 * qb + 384;
        attn_unit<64, 64, OM0, true>(lds, P + q0 * NP + C_SQ + h * 64, NP, P + rb * NP + C_SK + (h >> 2) * 64, NP, P + rb * NP + C_SV + (h >> 2) * 64, NP, CTX / 64, CTX + lo, (hi - lo) / 64, lo, 256 * qb, sink[h] * LOG2E, 1.0f,
                              P + q0 * NP + C_Z + 2048 + h * 64, NP, OD, 0); }
#endif
#if !defined(ATT_ONLY)
    if (l == 0) {
        for (int u = vcu; u < GB * 40; u += G) { const int bl = u / 40, k = u % 40; const size_t rb = (size_t)bl * RB;
            if (k < 8) { const int h = k;
                attn_unit<96, 128, OM0, false>(lds, QM + rb * 768 + h * 96, 768, KM + rb * 768 + h * 96, 768, VM + rb * 1024 + h * 128, 1024, CTX / 64, 0, 0, 0, 0, NEGBIG, 0.f, P + rb * NP + C_Z + h * 128, NP, OD, 0); }
            else if (k < 24) { const int hm = k - 8;
                attn_unit<64, 128, 1, false>(lds, P + rb * NP + C_DQ + hm * 64, NP, P + rb * NP + C_DK + hm * 64, NP, P + rb * NP + C_DV + (hm >> 1) * 128, NP, CTX / 64, 0, 0, 0, 0, NEGBIG, 0.f, nullptr, 0, OD + rb * 2048 + hm * 128, 2048); }
            else { const int h = k - 24;
                attn_unit<64, 64, OM0, false>(lds, P + rb * NP + C_SQ + h * 64, NP, P + rb * NP + C_SK + (h >> 2) * 64, NP, P + rb * NP + C_SV + (h >> 2) * 64, NP, CTX / 64, 0, 0, 0, 0, sink[h] * LOG2E, 1.0f, P + rb * NP + C_Z + 2048 + h * 64, NP, OD, 0); }
        }
    }
#endif
}

#define RLX_AGENT __ATOMIC_RELAXED, __HIP_MEMORY_SCOPE_AGENT
#define XB_TMO      128
#define XB_XCNT(j)  (256  + 64 * (j))
#define XB_XSUB(j)  (1280 + 64 * (j))
#define XB_XGEN(j)  (2304 + 64 * (j))
#define XB_TOP      3328
#define XB_TOPGEN   3392
#define XCD_BAR_WORDS 3456
#define XB_SPIN_CAP (1u << 18)

__device__ __forceinline__ unsigned xb_ld(unsigned* p)              { return __hip_atomic_load(p, __ATOMIC_RELAXED, __HIP_MEMORY_SCOPE_AGENT); }
__device__ __forceinline__ unsigned xb_add(unsigned* p, unsigned v) { return __hip_atomic_fetch_add(p, v, __ATOMIC_RELAXED, __HIP_MEMORY_SCOPE_AGENT); }
__device__ __forceinline__ unsigned xb_xcc_id() { return (unsigned)__builtin_amdgcn_s_getreg((3 << 11) | 20) & 0xFu; }
#define XB_SPIN(cond, bar) do { unsigned _sp = 0; while (cond) { __builtin_amdgcn_s_sleep(1); \
    if ((++_sp & 255u) == 0u) { if (xb_ld(&(bar)[XB_TMO])) break; if (_sp > XB_SPIN_CAP) { atomicAdd(&(bar)[XB_TMO], 1u); break; } } } } while (0)

struct XcdBarrier {
    unsigned* bar; unsigned x;
    volatile LAS unsigned* st;
};

__device__ __forceinline__ XcdBarrier xcd_barrier_post(unsigned* bar, volatile LAS unsigned* st) {
    XcdBarrier b; b.bar = bar; b.x = xb_xcc_id(); b.st = st;
    if (threadIdx.x == 0) (void)xb_add(&bar[XB_XCNT(b.x)], 1u);
    return b;
}
__device__ __forceinline__ void xcd_barrier_complete(unsigned* bar, unsigned x, unsigned& nloc, unsigned& nx) {
    const unsigned G = gridDim.x * gridDim.y * gridDim.z;
    unsigned sum, cnt, mine, sp = 0u;
    for (;;) {
        sum = 0u; cnt = 0u; mine = 0u;
#pragma unroll
        for (unsigned j = 0; j < 16; ++j) { const unsigned c = xb_ld(&bar[XB_XCNT(j)]); sum += c; cnt += (c > 0u) ? 1u : 0u; mine = (j == x) ? c : mine; }
        if (sum == G) break;
        __builtin_amdgcn_s_sleep(1);
        if ((++sp & 255u) == 0u) { if (xb_ld(&bar[XB_TMO])) break; if (sp > XB_SPIN_CAP) { atomicAdd(&bar[XB_TMO], 1u); break; } }
    }
    nloc = mine > 0u ? mine : 1u; nx = cnt > 0u ? cnt : 1u;
}

__device__ __forceinline__ void xcd_barrier(const XcdBarrier& b) {
    asm volatile("s_waitcnt vmcnt(0)" ::: "memory");
    __syncthreads();
    if (threadIdx.x == 0) {
        unsigned* bar = b.bar;
        __builtin_amdgcn_s_waitcnt(0);
        unsigned nloc = b.st[0], nx = b.st[1];
        if (nloc == 0u) { xcd_barrier_complete(bar, b.x, nloc, nx); b.st[0] = nloc; b.st[1] = nx; }
        const unsigned old = xb_add(&bar[XB_XSUB(b.x)], 1u);
        const unsigned gen = old / nloc;
        if (old + 1u == (gen + 1u) * nloc) {
            __builtin_amdgcn_fence(__ATOMIC_RELEASE, "agent");
            asm volatile("s_waitcnt vmcnt(0)" ::: "memory");
            const unsigned og = xb_add(&bar[XB_TOP], 1u);
            const unsigned tg = og / nx;
            if (og + 1u == (tg + 1u) * nx) xb_add(&bar[XB_TOPGEN], 1u);
            else XB_SPIN(xb_ld(&bar[XB_TOPGEN]) == tg, bar);
            __builtin_amdgcn_fence(__ATOMIC_ACQUIRE, "agent");
            xb_add(&bar[XB_XGEN(b.x)], 1u);
            asm volatile("s_waitcnt vmcnt(0)" ::: "memory");
        } else {
            XB_SPIN(xb_ld(&bar[XB_XGEN(b.x)]) == gen, bar);
            __builtin_amdgcn_fence(__ATOMIC_ACQUIRE, "agent");
            asm volatile("s_waitcnt vmcnt(0)" ::: "memory");
        }
    }
    __syncthreads();
}


__global__ void __launch_bounds__(512, 2) hybrid_fwd(Args a_unused) {
    extern __shared__ __attribute__((aligned(16))) unsigned char lds_raw[];
    LAS unsigned char* lds = (LAS unsigned char*)lds_raw;
    cg::grid_group grid = cg::this_grid();
    { volatile LAS unsigned* xst = (volatile LAS unsigned*)(lds + XB_LDS_OFF);
      if (threadIdx.x < 2) xst[threadIdx.x] = 0u;
      __syncthreads();
      (void)xcd_barrier_post((unsigned*)(args_ptr()->ws), xst); }
#define GSYNC() do { XcdBarrier b_; b_.bar = (unsigned*)(args_ptr()->ws); b_.x = xb_xcc_id(); b_.st = (volatile LAS unsigned*)(lds + XB_LDS_OFF); xcd_barrier(b_); } while (0)
#ifndef NO_PRO
    prologue(args_ptr(), lds);
#ifdef PROBE_PRO
    __syncthreads(); prologue(args_ptr(), lds);
#endif
#endif
    grid.sync();
    mod_finalize(args_ptr());
    GSYNC();
    for (int l = 0; l < 2; ++l) {
        for (int g = 0; g < NGRP; ++g) {
            ph_norm_mod(args_ptr(), lnd(l), lnd(g));
#ifdef PROBE_R1
            GSYNC(); ph_norm_mod(args_ptr(), lnd(l), lnd(g));
#endif
            GSYNC();
#ifndef NO_GEMM
            {
                unsigned char* ws = args_ptr()->ws; const int G = grd_l(), bx = bid_l();
                pg8::Gemm gm{1024, 1024, 1024}; pg8::Order S; S.init(R, NP, G, bx, ws + WS_H, 1024, (bf16_t*)(ws + WS_WIN) + (size_t)l * NP * 1024, 1024, 1 << 20, 0);
                EpiIn E{ws};
                pg8::gemm_phase<EpiIn, pg8::Order, true, true>(lds, gm, S, E);
#ifdef PROBE_G1
                __syncthreads(); pg8::gemm_phase<EpiIn, pg8::Order, true, true>(lds, gm, S, E);
#endif
            }
#endif
            GSYNC();
#ifndef NO_GEMM2
            {
                unsigned char* ws = args_ptr()->ws; const int G = grd_l(), bx = bid_l();
                pg8::Gemm gq{384, NP, 384}; pg8::Order Sq; Sq.init(R, 768, G, bx, (bf16_t*)(ws + WS_P) + C_QC, NP, (bf16_t*)(ws + WS_WUQ) + (size_t)l * 768 * 384, 384, 1 << 20, 0);
                EpiQ Eq{ws};
#ifndef NO_GQ
                pg8::gemm_phase<EpiQ, pg8::Order, true, true>(lds, gq, Sq, Eq);
#ifdef PROBE_G2
                __syncthreads(); pg8::gemm_phase<EpiQ, pg8::Order, true, true>(lds, gq, Sq, Eq);
#endif
#endif
            }
            {
                unsigned char* ws = args_ptr()->ws; const int G = grd_l(), bx = bid_l();
                pg8::Gemm gk{256, NP, 256}; pg8::Order Sk; Sk.init(R, 1536, G, bx, (bf16_t*)(ws + WS_P) + C_KVC, NP, (bf16_t*)(ws + WS_WUKV) + (size_t)l * 1536 * 256, 256, 1 << 20, 0);
                EpiKV Ek{ws};
#ifndef NO_GK
                pg8::gemm_phase<EpiKV, pg8::Order, true, true>(lds, gk, Sk, Ek);
#ifdef PROBE_G2
                __syncthreads(); pg8::gemm_phase<EpiKV, pg8::Order, true, true>(lds, gk, Sk, Ek);
#endif
#endif
            }
#endif
            GSYNC();
#ifndef NO_ATT
#ifdef PROBE_ATT
            ph_attention<true>(args_ptr(), lnd(l), lds);
            GSYNC();
#endif
            ph_attention<false>(args_ptr(), lnd(l), lds);
#endif
            GSYNC();
#ifdef PROBE_R2
            ph_diff_post<true>(args_ptr(), lnd(l)); GSYNC();
#endif
            ph_diff_post<false>(args_ptr(), lnd(l));
            GSYNC();
#ifndef NO_BR
            {
                unsigned char* ws = args_ptr()->ws; const int G = grd_l(), bx = bid_l();
                pg8::Gemm gb{1024, NP, 1024}; pg8::Order S; S.init(R, 3072, G, bx, (bf16_t*)(ws + WS_P) + C_Z, NP, (bf16_t*)(ws + WS_WB) + (size_t)l * 3 * 1024 * 1024, 1024, 4, 1024 * 2, l != 0);
#ifdef PROBE_BR
                { EpiBrT<true> Ed{ws}; pg8::gemm_phase<EpiBrT<true>, pg8::Order, true, true>(lds, gb, S, Ed); __syncthreads(); }
#endif
                EpiBrT<false> E{ws};
                pg8::gemm_phase<EpiBrT<false>, pg8::Order, true, true>(lds, gb, S, E);
            }
#endif
            GSYNC();
#ifndef NO_OUT
            {
                ArgsP ap = args_ptr(); unsigned char* ws = ap->ws; const int G = grd_l(), bx = bid_l();
                pg8::Gemm go{3072, NP, 3072}; pg8::Order S; S.init(R, 1024, G, bx, (bf16_t*)(ws + WS_P) + C_GM, NP, (bf16_t*)(ws + WS_WO3) + (size_t)l * 1024 * 3072, 3072, 1 << 20, 0, l != 0);
#ifdef PROBE_OUT
                { EpiOutT<true> Ed{l, g, (l == 0) ? ap->in[I_X] : (const float*)ap->out, ap->out, ap->in[I_CTX], ws}; pg8::gemm_phase<EpiOutT<true>, pg8::Order, true, true>(lds, go, S, Ed); __syncthreads(); }
#endif
                EpiOutT<false> E{l, g, (l == 0) ? ap->in[I_X] : (const float*)ap->out, ap->out, ap->in[I_CTX], ws};
                pg8::gemm_phase<EpiOutT<false>, pg8::Order, true, true>(lds, go, S, E);
            }
#endif
        }
        GSYNC();
    }
#ifdef PROBE_R2
    ph_final_norm<true>(args_ptr()); GSYNC();
#endif
    ph_final_norm<false>(args_ptr());
}

extern "C" void kernel_launch(void* const* d_in, const int* in_sizes, int n_in, void* d_out, int out_size, void* d_ws, size_t ws_size, hipStream_t stream) {
    static int grid = 0;
    if (grid == 0) {
        if (n_in != 21 || ws_size < WS_END) { fprintf(stderr, "kernel_launch: expected 21 inputs and >= %zu bytes of workspace (got %d, %zu)\n", (size_t)WS_END, n_in, ws_size); grid = -1; return; }
        int dev = 0, cus = 0, per_cu = 0;
        (void)hipGetDevice(&dev); (void)hipDeviceGetAttribute(&cus, hipDeviceAttributeMultiprocessorCount, dev);
        if (hipFuncSetAttribute((const void*)hybrid_fwd, hipFuncAttributeMaxDynamicSharedMemorySize, LDS_BYTES) != hipSuccess) fprintf(stderr, "kernel_launch: hipFuncSetAttribute failed\n");
        if (hipOccupancyMaxActiveBlocksPerMultiprocessor(&per_cu, (const void*)hybrid_fwd, 512, LDS_BYTES) != hipSuccess || per_cu < 1) { per_cu = 1; (void)hipGetLastError(); }
        if (cus <= 0) cus = 256;
        grid = cus * per_cu;
    }
    if (grid < 0) return;
    Args a{};
    for (int i = 0; i < 21; ++i) a.in[i] = (const float*)d_in[i];
    a.out = (float*)d_out; a.ws = (unsigned char*)d_ws;
    (void)hipMemsetAsync(d_ws, 0, 16384, stream);
    void* args[] = {&a};
    hipError_t e = hipLaunchCooperativeKernel((const void*)hybrid_fwd, dim3(grid), dim3(512), args, LDS_BYTES, stream);
    if (e != hipSuccess) fprintf(stderr, "kernel_launch: cooperative launch failed: %s (grid %d)\n", hipGetErrorString(e), grid);
}
```

```cpp
#include <hip/hip_runtime.h>
#include <hip/hip_cooperative_groups.h>
#include <cstdio>
#include <cstdint>
namespace cg = cooperative_groups;

#define DI __device__ __forceinline__
#define LAS __attribute__((address_space(3)))
__device__ __forceinline__ int tid_l() { int t = threadIdx.x; asm volatile("" : "+v"(t)); return t; }
__device__ __forceinline__ int bid_l() { int b = blockIdx.x; asm volatile("" : "+s"(b)); return b; }
__device__ __forceinline__ int lnd(int x) { asm volatile("" : "+s"(x)); return x; }
__device__ __forceinline__ int grd_l() { int g = gridDim.x; asm volatile("" : "+s"(g)); return g; }
typedef unsigned short bf16_t;
typedef short bf16x8 __attribute__((ext_vector_type(8)));
typedef short s16x4 __attribute__((ext_vector_type(4)));
typedef float f32x4 __attribute__((ext_vector_type(4)));
typedef float f32x16 __attribute__((ext_vector_type(16)));
typedef unsigned u32x4 __attribute__((ext_vector_type(4)));
typedef unsigned u32x2 __attribute__((ext_vector_type(2)));

constexpr int DM = 1024, NBATCH = 8, SEQ = 8192, CTX = 256, RB = CTX + SEQ;
constexpr int GB = 2, NGRP = NBATCH / GB, R = GB * RB;
constexpr int NP = 11520;
constexpr int C_QC = 0, C_KVC = 384, C_KR = 640, C_DQ = 768, C_DK = 1792, C_DV = 2816, C_SQ = 3840, C_SK = 4864, C_SV = 5120, C_Z = 5376, C_GM = 8448;
constexpr int D_IN = 11424;
constexpr float EPS = 1e-6f, LOG2E = 1.4426950408889634f;
constexpr float QS64 = 0.125f * LOG2E, QS96 = 0.10206207261596575f * LOG2E;
constexpr float NEGBIG = -1e30f, THR = 8.0f;

constexpr size_t al256(size_t x) { return (x + 255) & ~(size_t)255; }
constexpr size_t WS_WIN = 1u << 20;
constexpr size_t WS_WUQ = al256(WS_WIN + (size_t)2 * NP * 1024 * 2);
constexpr size_t WS_WUKV = al256(WS_WUQ + (size_t)2 * 768 * 384 * 2);
constexpr size_t WS_WB = al256(WS_WUKV + (size_t)2 * 1536 * 256 * 2);
constexpr size_t WS_WO3 = al256(WS_WB + (size_t)2 * 3 * 1024 * 1024 * 2);
constexpr size_t WS_COSH = al256(WS_WO3 + (size_t)2 * 1024 * 3072 * 2);
constexpr size_t WS_SINH = al256(WS_COSH + (size_t)SEQ * 32 * 4);
constexpr size_t WS_COSM = al256(WS_SINH + (size_t)SEQ * 32 * 4);
constexpr size_t WS_SINM = al256(WS_COSM + (size_t)SEQ * 16 * 4);
constexpr size_t WS_MODP = al256(WS_SINM + (size_t)SEQ * 16 * 4);
constexpr size_t WS_MOD = al256(WS_MODP + (size_t)16 * 2 * 9 * 3072 * 4);
constexpr size_t WS_CTX = al256(WS_MOD + (size_t)2 * 9 * 3072 * 4);
constexpr size_t WS_H = al256(WS_CTX + (size_t)NBATCH * CTX * DM * 4);
constexpr size_t WS_P = al256(WS_H + (size_t)R * DM * 2);
constexpr size_t WS_AQ = al256(WS_P + (size_t)R * NP * 2);
constexpr size_t WS_AKV = al256(WS_AQ + (size_t)R * 384 * 2);
constexpr size_t WS_QM = al256(WS_AKV + (size_t)R * 256 * 2);
constexpr size_t WS_KM = al256(WS_QM + (size_t)R * 768 * 2);
constexpr size_t WS_VM = al256(WS_KM + (size_t)R * 768 * 2);
constexpr size_t WS_OD = al256(WS_VM + (size_t)R * 1024 * 2);
constexpr size_t WS_END = al256(WS_OD + (size_t)R * 2048 * 4);
constexpr size_t WS_PART = WS_AQ;
static_assert(WS_END <= ((size_t)1 << 30), "workspace map exceeds 1 GiB");

constexpr int LDS_BYTES = 155648, XB_LDS_OFF = 155136;

DI unsigned pk2(float lo, float hi) { typedef float f2_t __attribute__((ext_vector_type(2))); typedef __bf16 b2_t __attribute__((ext_vector_type(2)));
    f2_t v = {lo, hi}; b2_t b = __builtin_convertvector(v, b2_t); return __builtin_bit_cast(unsigned, b); }
DI u32x4 pack8(f32x4 a, f32x4 b) { u32x4 w; w.x = pk2(a[0], a[1]); w.y = pk2(a[2], a[3]); w.z = pk2(b[0], b[1]); w.w = pk2(b[2], b[3]); return w; }
DI float bflo(unsigned w) { return __uint_as_float(w << 16); }
DI float bfhi(unsigned w) { return __uint_as_float(w & 0xffff0000u); }
DI float wave_sum(float v) {
#pragma unroll
    for (int o = 1; o < 64; o <<= 1) v += __shfl_xor(v, o);
    return v; }
DI float opq(float a) { asm("" : "+v"(a)); return a; }
DI float silu_f(float z) { return z * __builtin_amdgcn_rcpf(1.0f + __expf(-z)); }
DI float sigm_f(float z) { return __builtin_amdgcn_rcpf(1.0f + __expf(-z)); }
DI void rope8(f32x4& v0, f32x4& v1, const f32x4 cs, const f32x4 sn) {
    float a, b;
    a = v0[0]; b = v0[1]; v0[0] = a * cs[0] - b * sn[0]; v0[1] = b * cs[0] + a * sn[0];
    a = v0[2]; b = v0[3]; v0[2] = a * cs[1] - b * sn[1]; v0[3] = b * cs[1] + a * sn[1];
    a = v1[0]; b = v1[1]; v1[0] = a * cs[2] - b * sn[2]; v1[1] = b * cs[2] + a * sn[2];
    a = v1[2]; b = v1[3]; v1[2] = a * cs[3] - b * sn[3]; v1[3] = b * cs[3] + a * sn[3];
}
namespace pg8 {
#define PG8_LAS __attribute__((address_space(3)))
typedef unsigned short bf16_t;
typedef short bf16x8 __attribute__((ext_vector_type(8)));
typedef float f32x4 __attribute__((ext_vector_type(4)));
typedef unsigned u32x4 __attribute__((ext_vector_type(4)));
constexpr int BM = 256, BK = 64, HALF = 128, HTB = HALF * BK * 2  , STAGE_BYTES = 8 * HTB, NXCD = 8, WGM = 8;

__host__ __device__ __forceinline__ int lds_byte(int r, int c) { const int st = (r >> 4) * 2 + (c >> 5), rr = r & 15, cc = c & 31, ob = rr * 64 + cc * 2; return st * 1024 + (ob ^ (((ob >> 9) & 1) << 5)); }
__host__ __device__ __forceinline__ void stage_rc(int b, int& R, int& C) { const int st = b / 1024, sb = b % 1024, swz = sb ^ (((sb >> 9) & 1) << 5); R = (st >> 1) * 16 + swz / 64; C = (st & 1) * 32 + (swz % 64) / 2; }
__host__ __device__ __forceinline__ int perm32(int rho) { const int n = rho >> 4, i = rho & 15; return 8 * (i >> 2) + 4 * n + (i & 3); }

struct Unit { int pm, pn; };
struct Gemm { int K, lda, ldb; };
struct Order {
    int nM, nN, nwg, G, c; const char* A; const char* B; unsigned tA, tB; int pnblk; unsigned ablk; int skipctx;
    __device__ __forceinline__ void init(int M, int N, int G_, int c_, const void* A_, int lda, const void* B_, int ldb, int pnblk_, unsigned ablk_, int skipctx_ = 0) {
        skipctx = skipctx_; nM = M / BM; if (skipctx) nM -= nM / 33;
        nN = N / BM; nwg = nM * nN; G = G_; c = c_; A = (const char*)A_; B = (const char*)B_; tA = (unsigned)(BM * lda * 2); tB = (unsigned)(BM * ldb * 2); pnblk = pnblk_; ablk = ablk_; }
    __device__ __forceinline__ bool next(int i, Unit& u) const {
        const long L = (long)i * G + c; if (L >= nwg) return false;
        int wgid = (int)L; { const int q = nwg / NXCD, r = nwg % NXCD, xcd = wgid % NXCD, off = wgid / NXCD; wgid = (xcd < r ? xcd * (q + 1) : r * (q + 1) + (xcd - r) * q) + off; }
        const int nig = WGM * nN, gid = wgid / nig, fm = gid * WGM, gsz = (nM - fm) < WGM ? (nM - fm) : WGM;
        u.pm = fm + ((wgid % nig) % gsz); u.pn = (wgid % nig) / gsz; if (skipctx) u.pm += u.pm / 32 + 1; return true;
    }
    __device__ __forceinline__ const char* a_base(const Unit& u) const { return A + (size_t)u.pm * tA + (size_t)(u.pn / pnblk) * ablk; }
    __device__ __forceinline__ const char* b_base(const Unit& u) const { return B + (size_t)u.pn * tB; }
};

template <class Epi, class Sched, bool ALIGN_EPI = false, bool SP2 = false>
__device__ __forceinline__ void gemm_phase(PG8_LAS unsigned char* lds, const Gemm g, const Sched& S, const Epi& E) {
    const int tid = tid_l(), wid = __builtin_amdgcn_readfirstlane(tid >> 6), lane = tid & 63, wr = wid >> 2, wc = wid & 3, fr = lane & 15, fq = lane >> 4;
    const int K = g.K, nt = K / BK;
    unsigned voffA[2], voffB[2];
#pragma unroll
    for (int i = 0; i < 2; ++i) { int R, C; stage_rc(tid * 16 + i * 8192, R, C); const int Rb = Epi::PERM ? ((R & ~31) + perm32(R & 31)) : R;
        voffA[i] = (unsigned)(R * g.lda + C) * 2u; voffB[i] = (unsigned)(Rb * g.ldb + C) * 2u; }
    const size_t kstep = (size_t)(BK * 2);
    const size_t hstepA = (size_t)HALF * g.lda * 2, hstepB = (size_t)HALF * g.ldb * 2;
    const unsigned ldsw = (unsigned)wid * 1024u;
    const int aoff = lds_byte(wr * 64 + fr, fq * 8), boff = lds_byte(wc * 32 + fr, fq * 8);
#define PG8_SA(b, h) (((b) * 2 + (h)) * HTB)
#define PG8_SB(b, h) ((4 + (b) * 2 + (h)) * HTB)
#define PG8_STAGE(bufoff, gbase, voff) do { _Pragma("unroll") for (int _i = 0; _i < 2; ++_i) \
        __builtin_amdgcn_global_load_lds((const unsigned*)((const char*)(gbase) + (voff)[_i]), (PG8_LAS unsigned*)(lds + (bufoff) + ldsw + _i * 8192), 16, 0, 0); } while (0)
#define PG8_LDA(dst, b, h) do { _Pragma("unroll") for (int m = 0; m < 4; ++m) _Pragma("unroll") for (int k = 0; k < 2; ++k) dst[m][k] = *(const PG8_LAS bf16x8*)(lds + PG8_SA(b, h) + aoff + m * 2048 + k * 1024); } while (0)
#define PG8_LDB(dst, b, h) do { _Pragma("unroll") for (int n = 0; n < 2; ++n) _Pragma("unroll") for (int k = 0; k < 2; ++k) dst[n][k] = *(const PG8_LAS bf16x8*)(lds + PG8_SB(b, h) + boff + n * 2048 + k * 1024); } while (0)
#define PG8_MMA(ai, bj, At, Bt) do { __builtin_amdgcn_s_setprio(1); _Pragma("unroll") for (int m = 0; m < 4; ++m) _Pragma("unroll") for (int n = 0; n < 2; ++n) _Pragma("unroll") for (int k = 0; k < 2; ++k) \
        acc[ai][bj][m][n] = __builtin_amdgcn_mfma_f32_16x16x32_bf16(Bt[n][k], At[m][k], acc[ai][bj][m][n], 0, 0, 0); __builtin_amdgcn_s_setprio(0); } while (0)
#define PG8_WAIT_V(n) asm volatile("s_waitcnt vmcnt(" #n ")" ::: "memory")
#define PG8_WAIT_L(n) asm volatile("s_waitcnt lgkmcnt(" #n ")" ::: "memory")
#define PG8_BAR __builtin_amdgcn_s_barrier()
#define PG8_SCHED __builtin_amdgcn_sched_barrier(0)
    Unit cur, nxt; int ui = 0;
    if (!S.next(0, cur)) return;
    f32x4 acc[2][2][4][2];
#pragma unroll
    for (int a = 0; a < 2; ++a)
#pragma unroll
        for (int b = 0; b < 2; ++b)
#pragma unroll
            for (int m = 0; m < 4; ++m)
#pragma unroll
                for (int n = 0; n < 2; ++n) acc[a][b][m][n] = (f32x4){0.f, 0.f, 0.f, 0.f};
    bf16x8 At[4][2], B0[2][2], B1[2][2];
    const char* cA = S.a_base(cur); const char* cB = S.b_base(cur);

    if constexpr (SP2) {
        PG8_STAGE(PG8_SB(0, 0), cB, voffB); PG8_STAGE(PG8_SB(0, 1), cB + hstepB, voffB); PG8_STAGE(PG8_SA(0, 0), cA, voffA); PG8_STAGE(PG8_SA(0, 1), cA + hstepA, voffA);
        if (wr == 1) PG8_BAR;
        PG8_WAIT_V(2); PG8_BAR;
        PG8_STAGE(PG8_SB(1, 0), cB + kstep, voffB); PG8_STAGE(PG8_SA(1, 0), cA + kstep, voffA); PG8_STAGE(PG8_SB(1, 1), cB + hstepB + kstep, voffB);
        PG8_WAIT_V(6); PG8_BAR;
    } else {
        PG8_STAGE(PG8_SB(0, 0), cB, voffB); PG8_STAGE(PG8_SA(0, 0), cA, voffA); PG8_STAGE(PG8_SB(0, 1), cB + hstepB, voffB); PG8_STAGE(PG8_SA(0, 1), cA + hstepA, voffA);
        if (wr == 1) PG8_BAR;
        PG8_WAIT_V(4); PG8_BAR;
        PG8_STAGE(PG8_SB(1, 0), cB + kstep, voffB); PG8_STAGE(PG8_SA(1, 0), cA + kstep, voffA); PG8_STAGE(PG8_SB(1, 1), cB + hstepB + kstep, voffB);
        PG8_WAIT_V(6); PG8_BAR;
    }
    for (;;) {
        const bool has_next = S.next(ui + 1, nxt);
        const char* nA = has_next ? S.a_base(nxt) : cA; const char* nB = has_next ? S.b_base(nxt) : cB;
#pragma nounroll
        for (int t = 0; t < nt; t += 2) {
            const bool last = (t == nt - 2);
            const char* a1 = cA + (size_t)(t + 1) * kstep;
            const char* a2 = last ? nA : cA + (size_t)(t + 2) * kstep; const char* b2 = last ? nB : cB + (size_t)(t + 2) * kstep;
            const char* a3 = a2 + kstep; const char* b3 = b2 + kstep;

            if constexpr (SP2) {
            PG8_LDB(B0, 0, 0); PG8_LDB(B1, 0, 1); PG8_SCHED; PG8_LDA(At, 0, 0); PG8_STAGE(PG8_SA(1, 1), a1 + hstepA, voffA);
            PG8_WAIT_V(8); PG8_WAIT_L(0); PG8_BAR; PG8_MMA(0, 0, At, B0); PG8_MMA(0, 1, At, B1); PG8_BAR; PG8_SCHED;
            PG8_LDA(At, 0, 1); PG8_STAGE(PG8_SB(0, 0), b2, voffB); PG8_STAGE(PG8_SB(0, 1), b2 + hstepB, voffB); PG8_STAGE(PG8_SA(0, 0), a2, voffA);
            PG8_WAIT_V(8); PG8_WAIT_L(0); PG8_BAR; PG8_MMA(1, 0, At, B0); PG8_MMA(1, 1, At, B1); PG8_BAR; PG8_SCHED;
            PG8_LDB(B0, 1, 0); PG8_LDB(B1, 1, 1); PG8_SCHED; PG8_LDA(At, 1, 0); PG8_STAGE(PG8_SA(0, 1), a2 + hstepA, voffA);
            PG8_WAIT_V(8); PG8_WAIT_L(0); PG8_BAR; PG8_MMA(0, 0, At, B0); PG8_MMA(0, 1, At, B1); PG8_BAR; PG8_SCHED;
            PG8_LDA(At, 1, 1); PG8_STAGE(PG8_SB(1, 0), b3, voffB); PG8_STAGE(PG8_SB(1, 1), b3 + hstepB, voffB); PG8_STAGE(PG8_SA(1, 0), a3, voffA);
            PG8_WAIT_V(8); PG8_WAIT_L(0); PG8_BAR; PG8_MMA(1, 0, At, B0); PG8_MMA(1, 1, At, B1); PG8_BAR; PG8_SCHED;
            } else {
            PG8_LDB(B0, 0, 0); PG8_SCHED; PG8_LDA(At, 0, 0); PG8_STAGE(PG8_SA(1, 1), a1 + hstepA, voffA);
            PG8_WAIT_L(8); PG8_BAR; PG8_WAIT_L(0); PG8_MMA(0, 0, At, B0); PG8_BAR; PG8_SCHED;
            PG8_LDB(B1, 0, 1); PG8_STAGE(PG8_SB(0, 0), b2, voffB);
            PG8_BAR; PG8_WAIT_L(0); PG8_MMA(0, 1, At, B1); PG8_BAR;
            PG8_LDA(At, 0, 1); PG8_STAGE(PG8_SA(0, 0), a2, voffA);
            PG8_BAR; PG8_WAIT_L(0); PG8_MMA(1, 0, At, B0); PG8_BAR; PG8_SCHED;
            PG8_STAGE(PG8_SB(0, 1), b2 + hstepB, voffB);
            PG8_WAIT_V(6); PG8_BAR; PG8_MMA(1, 1, At, B1); PG8_BAR;
            PG8_LDB(B0, 1, 0); PG8_SCHED; PG8_LDA(At, 1, 0); PG8_STAGE(PG8_SA(0, 1), a2 + hstepA, voffA);
            PG8_WAIT_L(8); PG8_BAR; PG8_WAIT_L(0); PG8_MMA(0, 0, At, B0); PG8_BAR; PG8_SCHED;
            PG8_LDB(B1, 1, 1); PG8_STAGE(PG8_SB(1, 0), b3, voffB);
            PG8_BAR; PG8_WAIT_L(0); PG8_MMA(0, 1, At, B1); PG8_BAR;
            PG8_LDA(At, 1, 1); PG8_STAGE(PG8_SA(1, 0), a3, voffA);
            PG8_BAR; PG8_WAIT_L(0); PG8_MMA(1, 0, At, B0); PG8_BAR; PG8_SCHED;
            PG8_STAGE(PG8_SB(1, 1), b3 + hstepB, voffB);
            PG8_WAIT_V(6); PG8_BAR; PG8_MMA(1, 1, At, B1); PG8_BAR;
            }
        }
        if constexpr (ALIGN_EPI) { if (wr == 0) PG8_BAR; }
        if constexpr (!Epi::AFTER_DRAIN) { E(acc, cur, wr, wc, fr, fq); }
        if (!has_next) break;
#pragma unroll
        for (int a = 0; a < 2; ++a)
#pragma unroll
            for (int b = 0; b < 2; ++b)
#pragma unroll
                for (int m = 0; m < 4; ++m)
#pragma unroll
                    for (int n = 0; n < 2; ++n) acc[a][b][m][n] = (f32x4){0.f, 0.f, 0.f, 0.f};
        cur = nxt; cA = nA; cB = nB; ++ui;
        if constexpr (ALIGN_EPI) { if (wr == 1) PG8_BAR; }
    }
    PG8_WAIT_V(0);
    if constexpr (!ALIGN_EPI) { if (wr == 0) PG8_BAR; }
    PG8_BAR;
    if constexpr (Epi::AFTER_DRAIN) { E.fused(acc, cur, wr, wc, fr, fq, lds, wid, lane); }
#undef PG8_SA
#undef PG8_SB
#undef PG8_STAGE
#undef PG8_LDA
#undef PG8_LDB
#undef PG8_MMA
#undef PG8_WAIT_V
#undef PG8_WAIT_L
#undef PG8_BAR
#undef PG8_SCHED
}
}
struct EpiIn {
    static constexpr bool PERM = true, AFTER_DRAIN = false;
    unsigned char* ws;
    DI void operator()(const f32x4 (&acc)[2][2][4][2], const pg8::Unit& u, int wr, int wc, int fr, int fq) const {
        bf16_t* P = (bf16_t*)(ws + WS_P); const float* cosH = (const float*)(ws + WS_COSH); const float* sinH = (const float*)(ws + WS_SINH); const float* cosM = (const float*)(ws + WS_COSM); const float* sinM = (const float*)(ws + WS_SINM);
        const int pn = u.pn; const bool ctxt = (u.pm % 33) == 0;
        int mode = 0; float sc = 1.f;
        if ((pn >= 3 && pn <= 10) || (pn >= 15 && pn <= 19)) mode = 1;
        if (pn == 2) mode = 2;
        if ((pn >= 3 && pn <= 6) || (pn >= 15 && pn <= 18)) sc = QS64;
        if (ctxt) mode = 0;
        const int rowt = u.pm * 256 + wr * 64 + fr, colb = pn * 256 + wc * 32 + 8 * fq, posb = (u.pm / 33) * RB + CTX;
#pragma unroll
        for (int ai = 0; ai < 2; ++ai)
#pragma unroll
            for (int m = 0; m < 4; ++m) {
                const int row = rowt + ai * 128 + m * 16; const int pos = row - posb;
                bf16_t* rowp = P + (size_t)row * NP;
#pragma unroll
                for (int bj = 0; bj < 2; ++bj) {
                    const int col0 = colb + bj * 128;
                    f32x4 v0 = acc[ai][bj][m][0], v1 = acc[ai][bj][m][1];
                    if (pn <= 2) {
                        float s8 = (v0[0] * v0[0] + v0[1] * v0[1]) + (v0[2] * v0[2] + v0[3] * v0[3]) + (v1[0] * v1[0] + v1[1] * v1[1]) + (v1[2] * v1[2] + v1[3] * v1[3]);
                        s8 += __shfl_xor(s8, 16); s8 += __shfl_xor(s8, 32);
                        const int slice = pn * 8 + bj * 4 + wc;
                        if (fq == 0 && slice < 20) ((float*)(ws + WS_PART))[(size_t)row * 20 + slice] = s8;
                    }
                    if (mode == 1) { const int p0 = (col0 & 63) >> 1; const f32x4 cs = *(const f32x4*)(cosH + (size_t)pos * 32 + p0), sn = *(const f32x4*)(sinH + (size_t)pos * 32 + p0); rope8(v0, v1, cs, sn); }
                    else if (mode == 2 && col0 >= C_KR && col0 < C_KR + 32) { const int p0 = (col0 - C_KR) >> 1; const f32x4 cs = *(const f32x4*)(cosM + (size_t)pos * 16 + p0), sn = *(const f32x4*)(sinM + (size_t)pos * 16 + p0); rope8(v0, v1, cs, sn); }
                    v0 = v0 * sc; v1 = v1 * sc;
                    const u32x4 w8 = pack8(v0, v1);
                    *(u32x4*)(rowp + col0) = w8;
                    if (pn == 2 && col0 >= C_KR && col0 < C_KR + 32) {
                        bf16_t* km = (bf16_t*)(ws + WS_KM) + (size_t)row * 768 + 64 + (col0 - C_KR);
#pragma unroll
                        for (int h = 0; h < 8; ++h) *(u32x4*)(km + h * 96) = w8;
                    }
                }
            }
    }
};
struct EpiQ {
    static constexpr bool PERM = true, AFTER_DRAIN = false;
    unsigned char* ws;
    DI void operator()(const f32x4 (&acc)[2][2][4][2], const pg8::Unit& u, int wr, int wc, int fr, int fq) const {
        bf16_t* QM = (bf16_t*)(ws + WS_QM); const float* cosM = (const float*)(ws + WS_COSM); const float* sinM = (const float*)(ws + WS_SINM);
        const bool ctxt = (u.pm % 33) == 0;
        const int rowt = u.pm * 256 + wr * 64 + fr, colb = u.pn * 256 + wc * 32 + 8 * fq, posb = (u.pm / 33) * RB + CTX;
#pragma unroll
        for (int ai = 0; ai < 2; ++ai)
#pragma unroll
            for (int m = 0; m < 4; ++m) {
                const int row = rowt + ai * 128 + m * 16; const int pos = row - posb;
                const float* pr = (const float*)(ws + WS_PART) + (size_t)row * 20;
                const f32x4 q0 = *(const f32x4*)pr, q1 = *(const f32x4*)(pr + 4), q2 = *(const f32x4*)(pr + 8);
                const float rq = QS96 / sqrtf((((q0[0] + q0[1]) + (q0[2] + q0[3])) + ((q1[0] + q1[1]) + (q1[2] + q1[3])) + ((q2[0] + q2[1]) + (q2[2] + q2[3]))) * (1.0f / 384.0f) + EPS);
#pragma unroll
                for (int bj = 0; bj < 2; ++bj) {
                    const int col0 = colb + bj * 128, within = col0 % 96;
                    f32x4 v0 = acc[ai][bj][m][0], v1 = acc[ai][bj][m][1];
                    if (!ctxt && within >= 64) { const int p0 = (within - 64) >> 1; const f32x4 cs = *(const f32x4*)(cosM + (size_t)pos * 16 + p0), sn = *(const f32x4*)(sinM + (size_t)pos * 16 + p0); rope8(v0, v1, cs, sn); }
                    v0 = v0 * rq; v1 = v1 * rq;
                    *(u32x4*)(QM + (size_t)row * 768 + col0) = pack8(v0, v1);
                }
                asm volatile("" ::: "memory");
            }
    }
};
struct EpiKV {
    static constexpr bool PERM = true, AFTER_DRAIN = false;
    unsigned char* ws;
    DI void operator()(const f32x4 (&acc)[2][2][4][2], const pg8::Unit& u, int wr, int wc, int fr, int fq) const {
        bf16_t* KM = (bf16_t*)(ws + WS_KM); bf16_t* VM = (bf16_t*)(ws + WS_VM);
        const int rowt = u.pm * 256 + wr * 64 + fr, colb = u.pn * 256 + wc * 32 + 8 * fq;
#pragma unroll
        for (int ai = 0; ai < 2; ++ai)
#pragma unroll
            for (int m = 0; m < 4; ++m) {
                const int row = rowt + ai * 128 + m * 16;
                const float* pr = (const float*)(ws + WS_PART) + (size_t)row * 20 + 12;
                const f32x4 k0 = *(const f32x4*)pr, k1 = *(const f32x4*)(pr + 4);
                const float rkv = 1.0f / sqrtf((((k0[0] + k0[1]) + (k0[2] + k0[3])) + ((k1[0] + k1[1]) + (k1[2] + k1[3]))) * (1.0f / 256.0f) + EPS);
#pragma unroll
                for (int bj = 0; bj < 2; ++bj) {
                    const int col0 = colb + bj * 128;
                    bf16_t* dst = (col0 < 512) ? KM + (size_t)row * 768 + (col0 >> 6) * 96 + (col0 & 63) : VM + (size_t)row * 1024 + (col0 - 512);
                    *(u32x4*)dst = pack8(acc[ai][bj][m][0] * rkv, acc[ai][bj][m][1] * rkv);
                }
                asm volatile("" ::: "memory");
            }
    }
};
template <bool DRYE> struct EpiBrT {
    static constexpr bool PERM = true, AFTER_DRAIN = false;
    unsigned char* ws;
    DI void operator()(const f32x4 (&acc)[2][2][4][2], const pg8::Unit& u, int wr, int wc, int fr, int fq) const {
        bf16_t* P = (bf16_t*)(ws + WS_P);
        unsigned chk = 0u;
        const int rowt = u.pm * 256 + wr * 64 + fr, colb = u.pn * 256 + wc * 32 + 8 * fq;
#pragma unroll
        for (int ai = 0; ai < 2; ++ai)
#pragma unroll
            for (int m = 0; m < 4; ++m) {
                const int row = rowt + ai * 128 + m * 16;
#pragma unroll
                for (int bj = 0; bj < 2; ++bj) {
                    bf16_t* p = P + (size_t)row * NP + C_GM + colb + bj * 128;
                    const u32x4 g = *(const u32x4*)p;
                    f32x4 v0 = acc[ai][bj][m][0], v1 = acc[ai][bj][m][1];
                    v0[0] *= sigm_f(bflo(g.x)); v0[1] *= sigm_f(bfhi(g.x)); v0[2] *= sigm_f(bflo(g.y)); v0[3] *= sigm_f(bfhi(g.y));
                    v1[0] *= sigm_f(bflo(g.z)); v1[1] *= sigm_f(bfhi(g.z)); v1[2] *= sigm_f(bflo(g.w)); v1[3] *= sigm_f(bfhi(g.w));
                    { const u32x4 w_ = pack8(v0, v1); if (!DRYE) *(u32x4*)p = w_; else chk ^= w_.x ^ w_.y ^ w_.z ^ w_.w; }
                }
            }
        if (DRYE && chk == 0x12345678u) *(unsigned*)P = chk;
    }
};
template <bool DRYE> struct EpiOutT {
    static constexpr bool PERM = true, AFTER_DRAIN = false;
    int l, g; const float* xsrc; float* xdst; const float* ctxsrc; unsigned char* ws;
    DI void operator()(const f32x4 (&acc)[2][2][4][2], const pg8::Unit& u, int wr, int wc, int fr, int fq) const {
        float* ctxdst = (float*)(ws + WS_CTX); const float* mod = (const float*)(ws + WS_MOD) + (size_t)l * 9 * 3072;
        const int pmb = u.pm % 33, b = g * GB + u.pm / 33; const bool ctxt = pmb == 0;
        if (ctxt && l != 0) return;
        const float* gate = mod + (size_t)(ctxt ? 8 : b) * 3072 + 2048;
        const int colb = u.pn * 256 + wc * 32 + 8 * fq;
#pragma unroll
        for (int ai = 0; ai < 2; ++ai)
#pragma unroll
            for (int m = 0; m < 4; ++m) {
                const int j = pmb * 256 + ai * 128 + wr * 64 + m * 16 + fr;
                const size_t idx = ctxt ? ((size_t)b * CTX + j) * DM : ((size_t)b * SEQ + (j - CTX)) * DM;
                const float* s = (ctxt ? ctxsrc : xsrc) + idx; float* d = (ctxt ? ctxdst : xdst) + idx;
#pragma unroll
                for (int bj = 0; bj < 2; ++bj) {
                    const int col0 = colb + bj * 128;
                    const f32x4 g0 = *(const f32x4*)(gate + col0), g1 = *(const f32x4*)(gate + col0 + 4);
                    const f32x4 x0 = *(const f32x4*)(s + col0), x1 = *(const f32x4*)(s + col0 + 4);
                    if (!DRYE || x0[0] == 12345.678f) { *(f32x4*)(d + col0) = x0 + g0 * acc[ai][bj][m][0];
                    *(f32x4*)(d + col0 + 4) = x1 + g1 * acc[ai][bj][m][1]; }
                }
            }
    }
};

#define MFMA32(a, b, c) __builtin_amdgcn_mfma_f32_32x32x16_bf16((a), (b), (c), 0, 0, 0)
DI s16x4 tr16(const LAS unsigned char* p) { typedef short v4i16_t __attribute__((ext_vector_type(4))); return __builtin_bit_cast(s16x4, __builtin_amdgcn_ds_read_tr16_b64_v4i16((LAS v4i16_t*)p)); }
constexpr int AT_KOFF = 0, AT_KBUFMAX = 13312, AT_VOFF = 3 * AT_KBUFMAX, AT_VBUFMAX = 20480, AT_SOFF = AT_VOFF + 3 * AT_VBUFMAX, AT_QOFF = AT_SOFF + 1024;
static_assert(AT_QOFF + 8 * 6144 <= LDS_BYTES, "attention LDS map");
#ifndef AT_NEGM
#define AT_NEGM 0
#endif
#ifndef AT_LAZY_THR
#define AT_LAZY_THR 1048576.0f
#endif
#ifndef AT_LAZY
#define AT_LAZY 1
#endif
#ifndef AT_NOPF
#define AT_NOPF 1
#endif
#ifndef AT_IGLP
#define AT_IGLP -1
#endif
#ifndef AT_QLMIN
#define AT_QLMIN 64
#endif
#ifndef AT_PVKS
#define AT_PVKS 2
#endif
#ifndef AT_SGB
#define AT_SGB 0
#endif
#ifndef AT_PV8
#define AT_PV8 1
#endif
#ifndef AT_NOSBAR
#define AT_NOSBAR 1
#endif
#if AT_NOSBAR
#define SBAR() do {} while (0)
#else
#define SBAR() __builtin_amdgcn_sched_barrier(0)
#endif
#ifndef PROBE_MODE
#define PROBE_MODE 0
#endif
#ifndef DRY_SEL
#define DRY_SEL 7
#endif
#ifndef AT_QL
#define AT_QL 0
#endif
#ifndef AT_SB
#define AT_SB 0
#endif
template <int DQK, bool QL, bool NG = false>
DI void at_qkt(f32x16& p0, f32x16& p1, const LAS unsigned char* kb, const bf16x8* qf, const LAS unsigned char* qb, const f32x16* c0 = nullptr) {
    constexpr int KSTR = DQK + 8;
    if (!NG) {
#pragma unroll
        for (int r = 0; r < 16; ++r) { p0[r] = 0.f; p1[r] = 0.f; }
    }
#pragma unroll
    for (int ds = 0; ds < DQK / 16; ++ds) {
        const bf16x8 k0 = *(const LAS bf16x8*)(kb + ds * 32), k1 = *(const LAS bf16x8*)(kb + 32 * (KSTR * 2) + ds * 32);
        bf16x8 q; if (QL) q = *(const LAS bf16x8*)(qb + ds * 1024); else q = qf[ds];
        if (NG && ds == 0) { p0 = MFMA32(k0, q, *c0); p1 = MFMA32(k1, q, *c0); } else { p0 = MFMA32(k0, q, p0); p1 = MFMA32(k1, q, p1); }
        if (AT_SB && DQK > 64 && (ds & 1)) __builtin_amdgcn_sched_barrier(0x7f); }
}
DI void at_mask(f32x16& p0, f32x16& p1, int dk) {
#pragma unroll
    for (int r = 0; r < 16; ++r) { const int d = dk + (r & 3) + 8 * (r >> 2);
        if (d > 128 || d < -128) p0[r] = NEGBIG;
        if (d + 32 > 128 || d + 32 < -128) p1[r] = NEGBIG; }
}
DI void at_psm(f32x16& p0, f32x16& p1, float& mrun, float& alpha) {
    float ma = fmaxf(fmaxf(p0[0], p0[1]), p0[2]), mb = fmaxf(fmaxf(p1[0], p1[1]), p1[2]);
    ma = fmaxf(fmaxf(ma, p0[3]), p1[3]);
#pragma unroll
    for (int r = 4; r < 16; r += 2) { ma = fmaxf(fmaxf(ma, p0[r]), p0[r + 1]); mb = fmaxf(fmaxf(mb, p1[r]), p1[r + 1]); }
    float mx = fmaxf(ma, mb);
    { auto rr = __builtin_amdgcn_permlane32_swap(__float_as_uint(mx), __float_as_uint(mx), false, false); mx = fmaxf(__uint_as_float(rr[0]), __uint_as_float(rr[1])); }
    const bool keep = __all(mx - mrun <= THR);
    const float mn = keep ? mrun : fmaxf(mrun, mx); alpha = __builtin_amdgcn_exp2f(mrun - mn); mrun = mn;
#pragma unroll
    for (int r = 0; r < 16; ++r) { p0[r] -= mrun; p1[r] -= mrun; }
#pragma unroll
    for (int r = 0; r < 16; ++r) p0[r] = __builtin_amdgcn_exp2f(p0[r]);
}
template <int DV> DI void at_scale_o(f32x16* o, LAS float* scw, float val, int r32, int hi);
template <bool NG>
DI void at_psm_lazy(f32x16& p0, f32x16& p1, float mrun) {
    if (!NG) {
#pragma unroll
        for (int r = 0; r < 16; ++r) { p0[r] -= mrun; p1[r] -= mrun; }
    }
#pragma unroll
    for (int r = 0; r < 16; ++r) p0[r] = __builtin_amdgcn_exp2f(p0[r]);
}
template <int DV>
DI void at_fsm_lazy(f32x16& p0, f32x16& p1, float& mrun, float& alpha, float& lrun, bf16x8* pa, f32x16* o, LAS float* scw, int r32, int hi) {
#pragma unroll
    for (int r = 0; r < 16; ++r) p1[r] = __builtin_amdgcn_exp2f(p1[r]);
    float sa = p0[0] + p0[1], sb = p0[2] + p0[3], sc_ = p1[0] + p1[1], sd = p1[2] + p1[3];
#pragma unroll
    for (int r = 4; r < 16; r += 2) { sa = opq(sa) + p0[r]; sb = opq(sb) + p0[r + 1]; sc_ = opq(sc_) + p1[r]; sd = opq(sd) + p1[r + 1]; }
    float ps = (opq(sa) + sb) + (opq(sc_) + sd);
    alpha = 1.f;
    if (__builtin_expect(__any(!(ps <= AT_LAZY_THR)), 0)) {
        float ma = fmaxf(fmaxf(p0[0], p0[1]), p0[2]), mb = fmaxf(fmaxf(p1[0], p1[1]), p1[2]);
        ma = fmaxf(fmaxf(ma, p0[3]), p1[3]);
#pragma unroll
        for (int r = 4; r < 16; r += 2) { ma = fmaxf(fmaxf(ma, p0[r]), p0[r + 1]); mb = fmaxf(fmaxf(mb, p1[r]), p1[r + 1]); }
        float mx = fmaxf(ma, mb);
        { auto rr = __builtin_amdgcn_permlane32_swap(__float_as_uint(mx), __float_as_uint(mx), false, false); mx = fmaxf(__uint_as_float(rr[0]), __uint_as_float(rr[1])); }
        const float d = fmaxf(__builtin_amdgcn_logf(mx), 0.f);
        alpha = __builtin_amdgcn_exp2f(-d); mrun += d; ps *= alpha;
#pragma unroll
        for (int r = 0; r < 16; ++r) { p0[r] *= alpha; p1[r] *= alpha; }
        at_scale_o<DV>(o, scw, alpha, r32, hi);
    }
    lrun = lrun * alpha + ps;
    u32x4 w;
    w.x = pk2(p0[0], p0[1]); w.y = pk2(p0[2], p0[3]); w.z = pk2(p0[4], p0[5]); w.w = pk2(p0[6], p0[7]); pa[0] = __builtin_bit_cast(bf16x8, w);
    w.x = pk2(p0[8], p0[9]); w.y = pk2(p0[10], p0[11]); w.z = pk2(p0[12], p0[13]); w.w = pk2(p0[14], p0[15]); pa[1] = __builtin_bit_cast(bf16x8, w);
    w.x = pk2(p1[0], p1[1]); w.y = pk2(p1[2], p1[3]); w.z = pk2(p1[4], p1[5]); w.w = pk2(p1[6], p1[7]); pa[2] = __builtin_bit_cast(bf16x8, w);
    w.x = pk2(p1[8], p1[9]); w.y = pk2(p1[10], p1[11]); w.z = pk2(p1[12], p1[13]); w.w = pk2(p1[14], p1[15]); pa[3] = __builtin_bit_cast(bf16x8, w);
}
DI void at_fsm(f32x16& p0, f32x16& p1, float alpha, float& lrun, bf16x8* pa) {
#pragma unroll
    for (int r = 0; r < 16; ++r) p1[r] = __builtin_amdgcn_exp2f(p1[r]);
    float ps = 0.f;
#pragma unroll
    for (int r = 0; r < 16; ++r) ps += p0[r] + p1[r];
    lrun = lrun * alpha + ps;
    u32x4 w;
    w.x = pk2(p0[0], p0[1]); w.y = pk2(p0[2], p0[3]); w.z = pk2(p0[4], p0[5]); w.w = pk2(p0[6], p0[7]); pa[0] = __builtin_bit_cast(bf16x8, w);
    w.x = pk2(p0[8], p0[9]); w.y = pk2(p0[10], p0[11]); w.z = pk2(p0[12], p0[13]); w.w = pk2(p0[14], p0[15]); pa[1] = __builtin_bit_cast(bf16x8, w);
    w.x = pk2(p1[0], p1[1]); w.y = pk2(p1[2], p1[3]); w.z = pk2(p1[4], p1[5]); w.w = pk2(p1[6], p1[7]); pa[2] = __builtin_bit_cast(bf16x8, w);
    w.x = pk2(p1[8], p1[9]); w.y = pk2(p1[10], p1[11]); w.z = pk2(p1[12], p1[13]); w.w = pk2(p1[14], p1[15]); pa[3] = __builtin_bit_cast(bf16x8, w);
}
DI void at_fsm_fake(f32x16& p0, f32x16& p1, bf16x8* pa) {
    u32x4 w;
    w.x = pk2(p0[0], p0[1]); w.y = pk2(p0[2], p0[3]); w.z = pk2(p0[4], p0[5]); w.w = pk2(p0[6], p0[7]); pa[0] = __builtin_bit_cast(bf16x8, w);
    w.x = pk2(p0[8], p0[9]); w.y = pk2(p0[10], p0[11]); w.z = pk2(p0[12], p0[13]); w.w = pk2(p0[14], p0[15]); pa[1] = __builtin_bit_cast(bf16x8, w);
    w.x = pk2(p1[0], p1[1]); w.y = pk2(p1[2], p1[3]); w.z = pk2(p1[4], p1[5]); w.w = pk2(p1[6], p1[7]); pa[2] = __builtin_bit_cast(bf16x8, w);
    w.x = pk2(p1[8], p1[9]); w.y = pk2(p1[10], p1[11]); w.z = pk2(p1[12], p1[13]); w.w = pk2(p1[14], p1[15]); pa[3] = __builtin_bit_cast(bf16x8, w);
}
template <int DV>
DI void at_pv(f32x16* o, const LAS unsigned char* vb, const bf16x8* pa) {
    constexpr int VSTR = DV + 32;
#if AT_PVKS == 2
    s16x4 vlo[2][DV / 32], vhi[2][DV / 32];
#pragma unroll
    for (int db = 0; db < DV / 32; ++db) { vlo[0][db] = tr16(vb + db * 64); vhi[0][db] = tr16(vb + 8 * (VSTR * 2) + db * 64); }
#pragma unroll
    for (int ks = 0; ks < 4; ++ks) {
        if (ks < 3) {
#pragma unroll
            for (int db = 0; db < DV / 32; ++db) { vlo[(ks + 1) & 1][db] = tr16(vb + (16 * (ks + 1)) * (VSTR * 2) + db * 64); vhi[(ks + 1) & 1][db] = tr16(vb + (16 * (ks + 1) + 8) * (VSTR * 2) + db * 64); }
        }
#pragma unroll
        for (int db = 0; db < DV / 32; ++db) { const bf16x8 vf = __builtin_shufflevector(vlo[ks & 1][db], vhi[ks & 1][db], 0, 1, 2, 3, 4, 5, 6, 7); o[db] = MFMA32(pa[ks], vf, o[db]); }
    }
#elif AT_PVKS
#else
#pragma unroll
    for (int db = 0; db < DV / 32; ++db) {
        s16x4 vlo[4], vhi[4];
#pragma unroll
        for (int ks = 0; ks < 4; ++ks) { vlo[ks] = tr16(vb + (16 * ks) * (VSTR * 2) + db * 64); vhi[ks] = tr16(vb + (16 * ks + 8) * (VSTR * 2) + db * 64); }
#pragma unroll
        for (int ks = 0; ks < 4; ++ks) { const bf16x8 vf = __builtin_shufflevector(vlo[ks], vhi[ks], 0, 1, 2, 3, 4, 5, 6, 7); o[db] = MFMA32(pa[ks], vf, o[db]); }
    }
#endif
}
template <int DV>
DI void at_scale_o(f32x16* o, LAS float* scw, float val, int r32, int hi) {
    if (hi == 0) scw[r32] = val;
    __builtin_amdgcn_wave_barrier(); asm volatile("" ::: "memory");
#pragma unroll
    for (int g4 = 0; g4 < 4; ++g4) { const f32x4 a4 = *(const LAS f32x4*)(scw + 8 * g4 + 4 * hi);
#pragma unroll
        for (int db = 0; db < DV / 32; ++db) { o[db][4 * g4 + 0] *= a4[0]; o[db][4 * g4 + 1] *= a4[1]; o[db][4 * g4 + 2] *= a4[2]; o[db][4 * g4 + 3] *= a4[3]; } }
    __builtin_amdgcn_wave_barrier(); asm volatile("" ::: "memory");
}
template <int DQK, int DV, int OUTM, bool MASKED>
DI void attn_unit(LAS unsigned char* lds, const bf16_t* Qp, int ldq, const bf16_t* Kp, int ldk, const bf16_t* Vp, int ldv,
                  int nA, int rowB0, int nB, int posB0, int qpos0, float m0, float l0,
                  bf16_t* Og, int ldo, float* Of, int ldof) {
    constexpr int KSTR = DQK + 8, VSTR = DV + 32, KBUF = 64 * KSTR * 2, VBUF = 64 * VSTR * 2;
    constexpr int KCH = DQK / 8, VCH = DV / 8, NKC = 64 * KCH, NVC = 64 * VCH, KRN = (NKC + 511) / 512, VRN = (NVC + 511) / 512;
    static_assert(KBUF <= AT_KBUFMAX && VBUF <= AT_VBUFMAX, "attention LDS map");
    const int tid = tid_l(), lane = tid & 63, wid = __builtin_amdgcn_readfirstlane(tid >> 6), r32 = lane & 31, hi = lane >> 5;
#ifndef AT_QL
#define AT_QL 0
#endif
#ifndef AT_SB
#define AT_SB 0
#endif
    constexpr bool NG = (AT_NEGM == 1 && DQK == 64) || (AT_NEGM == 2 && DQK == 64 && DV == 64);
    constexpr bool QL = AT_QL && (DQK > AT_QLMIN || (NG && DV == 128));
    bf16x8 qf[QL ? 1 : DQK / 16];
    const LAS unsigned char* qb = lds + AT_QOFF + wid * 6144 + lane * 16;
    { const bf16_t* qrow = Qp + (size_t)(32 * wid + r32) * ldq + 8 * hi;
#pragma unroll
      for (int ds = 0; ds < DQK / 16; ++ds) { const bf16x8 v = *(const bf16x8*)(qrow + 16 * ds); if (QL) *(LAS bf16x8*)(lds + AT_QOFF + wid * 6144 + lane * 16 + ds * 1024) = v; else qf[QL ? 0 : ds] = v; }
      if (QL) { __builtin_amdgcn_wave_barrier(); asm volatile("s_waitcnt lgkmcnt(0)" ::: "memory"); } }
    f32x16 o[DV / 32];
#pragma unroll
    for (int db = 0; db < DV / 32; ++db)
#pragma unroll
        for (int r = 0; r < 16; ++r) o[db][r] = 0.f;
    float mrun = m0, lrun = (hi == 0) ? l0 : 0.f;
    LAS float* scw = (LAS float*)(lds + AT_SOFF) + wid * 32;
    const int NT = nA + nB;
    const LAS unsigned char* kb0 = lds + AT_KOFF + r32 * (KSTR * 2) + hi * 16;
    const LAS unsigned char* vb0 = lds + AT_VOFF + (4 * hi + ((lane & 15) >> 2)) * (VSTR * 2) + (16 * ((lane >> 4) & 1) + 4 * (lane & 3)) * 2;
    const int dk0 = posB0 + 4 * hi - (qpos0 + 32 * wid + r32) - 64 * nA;
    u32x4 kreg[KRN], vreg[VRN];
    int kgo[KRN], klo[KRN], vgo[VRN], vlo_[VRN];
#pragma unroll
    for (int i_ = 0; i_ < KRN; ++i_) { int c_ = tid + 512 * i_; if (c_ >= NKC) c_ -= 512; const int r_ = c_ / KCH, cc_ = c_ % KCH; kgo[i_] = r_ * ldk + cc_ * 8; klo[i_] = AT_KOFF + r_ * (KSTR * 2) + cc_ * 16; }
#pragma unroll
    for (int i_ = 0; i_ < VRN; ++i_) { int c_ = tid + 512 * i_; if (c_ >= NVC) c_ -= 512; const int r_ = c_ / VCH, cc_ = c_ % VCH; vgo[i_] = r_ * ldv + cc_ * 8; vlo_[i_] = AT_VOFF + r_ * (VSTR * 2) + cc_ * 16; }
    const __amdgpu_buffer_rsrc_t rK = __builtin_amdgcn_make_buffer_rsrc((void*)Kp, 0, 0x7fffffff, 0x00020000), rV = __builtin_amdgcn_make_buffer_rsrc((void*)Vp, 0, 0x7fffffff, 0x00020000);
#define AT_GLOAD(t) do { const int row0_ = (t) < nA ? 64 * (t) : rowB0 + 64 * ((t) - nA); const int sk_ = row0_ * ldk * 2, sv_ = row0_ * ldv * 2; \
        _Pragma("unroll") for (int i_ = 0; i_ < KRN; ++i_) kreg[i_] = __builtin_amdgcn_raw_buffer_load_b128(rK, kgo[i_] * 2, sk_, 0); \
        _Pragma("unroll") for (int i_ = 0; i_ < VRN; ++i_) vreg[i_] = __builtin_amdgcn_raw_buffer_load_b128(rV, vgo[i_] * 2, sv_, 0); } while (0)
#define AT_SWRITE(buf) do { \
        _Pragma("unroll") for (int i_ = 0; i_ < KRN; ++i_) *(LAS u32x4*)(lds + (buf) * KBUF + klo[i_]) = kreg[i_]; \
        _Pragma("unroll") for (int i_ = 0; i_ < VRN; ++i_) *(LAS u32x4*)(lds + (buf) * VBUF + vlo_[i_]) = vreg[i_]; } while (0)
    unsigned pfv = 0u, pfacc = 0u;
    const int pft = tid & 255;
    const bf16_t* pfb = (pft < 128) ? Kp + (pft >> 1) * ldk + (pft & 1) * (DQK - 2) : Vp + ((pft - 128) >> 1) * ldv + (pft & 1) * (DV - 2);
    const int pfs = (pft < 128) ? ldk : ldv;
    constexpr int PFD = 4;
#if AT_NOPF
#define AT_PF(t) do {} while (0)
#else
#define AT_PF(t) do { pfacc ^= pfv; const int tt_ = (t) < NT ? (t) : NT - 1; const int row0_ = tt_ < nA ? 64 * tt_ : rowB0 + 64 * (tt_ - nA); \
        pfv = *(const unsigned*)(pfb + (size_t)row0_ * pfs); } while (0)
#endif
#define AT_MASK(P0, P1, t) do { if (MASKED && (t) >= nA) at_mask(P0, P1, dk0 + 64 * (t)); } while (0)
#define AT_RESC(al) do { if (__any((al) < 1.f)) at_scale_o<DV>(o, scw, (al), r32, hi); } while (0)
    constexpr int DRYP = (OUTM == 2) ? PROBE_MODE : 0;
    f32x16 pA0, pA1, pB0, pB1; float alA, alB; bf16x8 pa[4];
    AT_PF(1); AT_PF(2); AT_PF(3);
    AT_GLOAD(0); AT_SWRITE(0); __syncthreads();
    AT_GLOAD(1);
    at_qkt<DQK, QL>(pA0, pA1, kb0, qf, qb); AT_MASK(pA0, pA1, 0); at_psm(pA0, pA1, mrun, alA);
#if AT_LAZY
    lrun *= alA;
#endif
    AT_SWRITE(1); __syncthreads();
    int bp = 0, bc = 1, bn = 2;
    constexpr int NMF = 2 * (DQK / 16) + 4 * (DV / 32);
#if AT_IGLP >= 0
#define AT_SCHED() __builtin_amdgcn_iglp_opt(AT_IGLP)
#elif AT_SGB
#define AT_SCHED() do { _Pragma("unroll") for (int i_ = 0; i_ < NMF; ++i_) { __builtin_amdgcn_sched_group_barrier(0x008, 1, 0); __builtin_amdgcn_sched_group_barrier(0x100, 2, 0); __builtin_amdgcn_sched_group_barrier(0x002, AT_SGB, 0); } } while (0)
#else
#define AT_SCHED() do {} while (0)
#endif
#define AT_ROT() do { bp = bc; bc = bn; bn = (bn == 2) ? 0 : bn + 1; } while (0)
#if AT_LAZY
    f32x16 negm;
    if (NG) {
#pragma unroll
        for (int r = 0; r < 16; ++r) negm[r] = -mrun;
    }
#define AT_NEGUPD(al, P0, P1) do { if (NG && __any((al) < 1.f)) { const float d_ = -__builtin_amdgcn_logf(al); _Pragma("unroll") for (int r_ = 0; r_ < 16; ++r_) { negm[r_] = -mrun; P0[r_] -= d_; P1[r_] -= d_; } } } while (0)
    for (int j = 1; j + 1 < NT; j += 2) {
        at_qkt<DQK, QL, NG>(pB0, pB1, kb0 + bc * KBUF, qf, qb, &negm); AT_MASK(pB0, pB1, j);
        AT_GLOAD(j + 1);
        at_fsm_lazy<DV>(pA0, pA1, mrun, alA, lrun, pa, o, scw, r32, hi);
        AT_NEGUPD(alA, pB0, pB1);
        at_pv<DV>(o, vb0 + bp * VBUF, pa); at_psm_lazy<NG>(pB0, pB1, mrun);
        AT_SWRITE(bn);
        __syncthreads(); AT_ROT();
        at_qkt<DQK, QL, NG>(pA0, pA1, kb0 + bc * KBUF, qf, qb, &negm); AT_MASK(pA0, pA1, j + 1);
        AT_GLOAD(j + 2);
        at_fsm_lazy<DV>(pB0, pB1, mrun, alB, lrun, pa, o, scw, r32, hi);
        AT_NEGUPD(alB, pA0, pA1);
        at_pv<DV>(o, vb0 + bp * VBUF, pa); at_psm_lazy<NG>(pA0, pA1, mrun);
        AT_SWRITE(bn);
        __syncthreads(); AT_ROT();
    }
    at_qkt<DQK, QL, NG>(pB0, pB1, kb0 + bc * KBUF, qf, qb, &negm); AT_MASK(pB0, pB1, NT - 1);
    at_fsm_lazy<DV>(pA0, pA1, mrun, alA, lrun, pa, o, scw, r32, hi);
    AT_NEGUPD(alA, pB0, pB1);
    at_pv<DV>(o, vb0 + bp * VBUF, pa); at_psm_lazy<NG>(pB0, pB1, mrun);
    at_fsm_lazy<DV>(pB0, pB1, mrun, alB, lrun, pa, o, scw, r32, hi);
    at_pv<DV>(o, vb0 + bc * VBUF, pa);
#else
    for (int j = 1; j + 1 < ((DRYP == 6) ? 2 : NT); j += 2) {
        SBAR(); if (DRYP != 5) at_qkt<DQK, QL>(pB0, pB1, kb0 + bc * KBUF, qf, qb); else { _Pragma("unroll") for (int r_ = 0; r_ < 16; ++r_) { pB0[r_] = o[0][r_] * 1e-3f; pB1[r_] = o[1][r_] * 1e-3f; } } AT_MASK(pB0, pB1, j);
        if (!(DRYP >= 1)) { AT_GLOAD(j + 1); AT_PF(j + PFD); }
        if (DRYP != 3) at_fsm(pA0, pA1, alA, lrun, pa); else at_fsm_fake(pA0, pA1, pa); SBAR();
        if (DRYP != 4) at_pv<DV>(o, vb0 + bp * VBUF, pa); else { o[0][0] += __builtin_bit_cast(float, (int)pa[0][0] + (int)pa[1][1] + (int)pa[2][2] + (int)pa[3][3]); } if (DRYP != 3) at_psm(pB0, pB1, mrun, alB); else alB = 1.f;
        AT_SCHED();
        if (!(DRYP >= 1)) AT_SWRITE(bn);
        AT_RESC(alB); if (DRYP != 2) __syncthreads(); AT_ROT();
        SBAR(); if (DRYP != 5) at_qkt<DQK, QL>(pA0, pA1, kb0 + bc * KBUF, qf, qb); else { _Pragma("unroll") for (int r_ = 0; r_ < 16; ++r_) { pA0[r_] = o[0][r_] * 1e-3f; pA1[r_] = o[1][r_] * 1e-3f; } } AT_MASK(pA0, pA1, j + 1);
        if (!(DRYP >= 1)) { AT_GLOAD(j + 2); AT_PF(j + 1 + PFD); }
        if (DRYP != 3) at_fsm(pB0, pB1, alB, lrun, pa); else at_fsm_fake(pB0, pB1, pa); SBAR();
        if (DRYP != 4) at_pv<DV>(o, vb0 + bp * VBUF, pa); else { o[0][0] += __builtin_bit_cast(float, (int)pa[0][0] + (int)pa[1][1] + (int)pa[2][2] + (int)pa[3][3]); } if (DRYP != 3) at_psm(pA0, pA1, mrun, alA); else alA = 1.f;
        AT_SCHED();
        if (!(DRYP >= 1)) AT_SWRITE(bn);
        AT_RESC(alA); if (DRYP != 2) __syncthreads(); AT_ROT();
    }
    SBAR(); at_qkt<DQK, QL>(pB0, pB1, kb0 + bc * KBUF, qf, qb); AT_MASK(pB0, pB1, NT - 1);
    at_fsm(pA0, pA1, alA, lrun, pa); SBAR();
    at_pv<DV>(o, vb0 + bp * VBUF, pa); at_psm(pB0, pB1, mrun, alB);
    AT_RESC(alB);
    at_fsm(pB0, pB1, alB, lrun, pa); SBAR();
    at_pv<DV>(o, vb0 + bc * VBUF, pa);
#endif
#undef AT_ROT
#ifdef AT_NEGUPD
#undef AT_NEGUPD
#endif
#undef AT_SCHED
    pfacc ^= pfv;
    if (__builtin_expect(pfacc == 0x9e3779b9u && lrun == 12345.678f, 0)) scw[0] = 1.f;
#undef AT_GLOAD
#undef AT_PF
#undef AT_SWRITE
#undef AT_MASK
#undef AT_RESC
    { const float lt = lrun + __shfl_xor(lrun, 32); at_scale_o<DV>(o, scw, 1.0f / lt, r32, hi); }
    if (OUTM == 0) {
        static_assert(!(AT_QL), "the output staging tile re-uses the Q park area");
        LAS float* st = (LAS float*)(lds + AT_QOFF + wid * 6144);
#pragma unroll
        for (int db = 0; db < DV / 32; ++db) {
#pragma unroll
            for (int r = 0; r < 16; ++r) st[((r & 3) + 8 * (r >> 2) + 4 * hi) * 36 + r32] = o[db][r];
            __builtin_amdgcn_wave_barrier(); asm volatile("s_waitcnt lgkmcnt(0)" ::: "memory");
#pragma unroll
            for (int i = 0; i < 2; ++i) {
                const int c = lane + 64 * i, row = c >> 2, cc = c & 3;
                f32x4 a = *(const LAS f32x4*)(st + row * 36 + cc * 8), b = *(const LAS f32x4*)(st + row * 36 + cc * 8 + 4);
                bf16_t* gp = Og + (size_t)(32 * wid + row) * ldo + 32 * db + cc * 8;
                const u32x4 z = *(const u32x4*)gp;
                a[0] *= silu_f(bflo(z.x)); a[1] *= silu_f(bfhi(z.x)); a[2] *= silu_f(bflo(z.y)); a[3] *= silu_f(bfhi(z.y));
                b[0] *= silu_f(bflo(z.z)); b[1] *= silu_f(bfhi(z.z)); b[2] *= silu_f(bflo(z.w)); b[3] *= silu_f(bfhi(z.w));
                *(u32x4*)gp = pack8(a, b);
            }
            __builtin_amdgcn_wave_barrier(); asm volatile("s_waitcnt lgkmcnt(0)" ::: "memory");
        }
    } else {
#pragma unroll
        for (int db = 0; db < DV / 32; ++db)
#pragma unroll
            for (int r = 0; r < 16; ++r) {
                const int q = (r & 3) + 8 * (r >> 2) + 4 * hi;
                if (OUTM == 1) { Of[(size_t)(32 * wid + q) * ldof + 32 * db + r32] = o[db][r]; }
                else { if (lrun == 12345.678f) Of[(size_t)(32 * wid + q) * ldof + 32 * db + r32] = o[db][r]; }
            }
    }
    __syncthreads();
}

struct Args { const float* in[21]; float* out; unsigned char* ws; };
typedef const __attribute__((address_space(4))) Args* ArgsP;
DI ArgsP args_ptr() { ArgsP p = (ArgsP)__builtin_amdgcn_kernarg_segment_ptr(); asm volatile("" : "+s"(p)); return p; }
enum { I_X = 0, I_C, I_CTX, I_CCTX, I_WMOD, I_BMOD, I_NORMG, I_WIN, I_QNORM, I_WUQ, I_KVNORM, I_WUKV, I_LQ1, I_LK1, I_LQ2, I_LK2, I_SUBLN, I_SINK, I_WBR, I_WOUT, I_FNORM };

DI int colmap(int kind, int n) {
    if (kind == 1) {
        if (n < C_KR) return n;
        if (n < C_KR + 32) { const int e = n - C_KR; return C_KR + (e >> 1) + 16 * (e & 1); }
        if (n < C_DQ) return -1;
        if ((n >= C_DQ && n < C_DV) || (n >= C_SQ && n < C_SV)) { const int w = n & 63; return (n - w) - 96 + (w >> 1) + 32 * (w & 1); }
        return n - 96;
    }
    if (kind == 2) { const int h = n / 96, e = n % 96; if (e < 64) return n; const int e2 = e - 64; return h * 96 + 64 + (e2 >> 1) + 16 * (e2 & 1); }
    if (kind == 3) { if (n < 512) return (n >> 6) * 192 + (n & 63); const int n2 = n - 512; return (n2 >> 7) * 192 + 64 + (n2 & 127); }
    return n;
}
DI void transpose_item(const float* W, int ldw, int kind, const float* rowscale, bf16_t* WT, int ldd, int koff, LAS float* scr, int item, int nblk, int lane) {
    const int kb = item / nblk, nb = item % nblk, k0 = 64 * kb, n0 = 32 * nb;
    const int oc = colmap(kind, n0 + (lane & 31));
#pragma unroll 8
    for (int i = 0; i < 32; ++i) { const int kk = 2 * i + (lane >> 5); float v = 0.f; if (oc >= 0) v = W[(size_t)(k0 + kk) * ldw + oc]; if (rowscale) v *= rowscale[k0 + kk]; scr[kk * 33 + (lane & 31)] = v; }
    __builtin_amdgcn_wave_barrier(); asm volatile("s_waitcnt lgkmcnt(0)" ::: "memory");
    const int c = lane & 7;
#pragma unroll
    for (int j = 0; j < 4; ++j) { const int n = (lane >> 3) + 8 * j; const LAS float* s = scr + (8 * c) * 33 + n;
        u32x4 o; o.x = pk2(s[0 * 33], s[1 * 33]); o.y = pk2(s[2 * 33], s[3 * 33]); o.z = pk2(s[4 * 33], s[5 * 33]); o.w = pk2(s[6 * 33], s[7 * 33]);
        *(u32x4*)(WT + (size_t)(n0 + n) * ldd + koff + k0 + 8 * c) = o; }
    __builtin_amdgcn_wave_barrier(); asm volatile("s_waitcnt lgkmcnt(0)" ::: "memory");
}
DI void prologue(ArgsP ap, LAS unsigned char* lds) {
    const int tid = tid_l(), lane = tid & 63, wid = __builtin_amdgcn_readfirstlane(tid >> 6);
    unsigned char* ws = ap->ws;
    LAS float* scr = (LAS float*)(lds + wid * 8448);
    const int gw = bid_l() * 8 + wid, NGW = grd_l() * 8;
    constexpr int I_IN = 16 * (NP / 32), I_UQ = 6 * 24, I_UKV = 4 * 48, I_SQ = 16 * 32, PER_L = I_IN + I_UQ + I_UKV + 6 * I_SQ;
    for (int it = gw; it < 2 * PER_L; it += NGW) {
        const int l = it / PER_L; int r = it % PER_L;
        if (r < I_IN) { transpose_item(ap->in[I_WIN] + (size_t)l * 1024 * D_IN, D_IN, 1, nullptr, (bf16_t*)(ws + WS_WIN) + (size_t)l * NP * 1024, 1024, 0, scr, r, NP / 32, lane); continue; } r -= I_IN;
        if (r < I_UQ) { transpose_item(ap->in[I_WUQ] + (size_t)l * 384 * 768, 768, 2, ap->in[I_QNORM] + l * 384, (bf16_t*)(ws + WS_WUQ) + (size_t)l * 768 * 384, 384, 0, scr, r, 24, lane); continue; } r -= I_UQ;
        if (r < I_UKV) { transpose_item(ap->in[I_WUKV] + (size_t)l * 256 * 1536, 1536, 3, ap->in[I_KVNORM] + l * 256, (bf16_t*)(ws + WS_WUKV) + (size_t)l * 1536 * 256, 256, 0, scr, r, 48, lane); continue; } r -= I_UKV;
        if (r < 3 * I_SQ) { const int br = r / I_SQ; transpose_item(ap->in[I_WBR] + ((size_t)l * 3 + br) * 1024 * 1024, 1024, 0, nullptr, (bf16_t*)(ws + WS_WB) + ((size_t)l * 3 + br) * 1024 * 1024, 1024, 0, scr, r % I_SQ, 32, lane); continue; } r -= 3 * I_SQ;
        { const int rep = r / I_SQ; transpose_item(ap->in[I_WOUT] + (size_t)l * 1024 * 1024, 1024, 0, nullptr, (bf16_t*)(ws + WS_WO3) + (size_t)l * 1024 * 3072, 3072, rep * 1024, scr, r % I_SQ, 32, lane); }
    }
    const int gt = bid_l() * 512 + tid, NGT = grd_l() * 512;
    for (int i = gt; i < SEQ * 48; i += NGT) {
        const int pos = i / 48, p = i % 48; const float frow = (float)(pos >> 6), fcol = (float)(pos & 63);
        float ang; float* cd; float* sd;
        if (p < 32) { const int f = p & 15; const float inv = powf(10000.0f, -(float)f / 16.0f); ang = (p < 16 ? frow : fcol) * inv; cd = (float*)(ws + WS_COSH) + pos * 32 + p; sd = (float*)(ws + WS_SINH) + pos * 32 + p; }
        else { const int pp = p - 32, f = pp & 7; const float inv = powf(10000.0f, -(float)f / 8.0f); ang = (pp < 8 ? frow : fcol) * inv; cd = (float*)(ws + WS_COSM) + pos * 16 + pp; sd = (float*)(ws + WS_SINM) + pos * 16 + pp; }
        *cd = __cosf(ang); *sd = __sinf(ang);
    }
    for (int it = gw; it < 2 * 16 * 48; it += NGW) {
        const int l = it / 768, rem = it % 768, kc = rem / 48, nb = rem % 48; const int k = kc * 64 + lane;
        float sv[9];
#pragma unroll
        for (int v = 0; v < 8; ++v) sv[v] = silu_f(ap->in[I_C][v * 1024 + k]);
        sv[8] = silu_f(ap->in[I_CCTX][k]);
        float acc[9];
#pragma unroll
        for (int v = 0; v < 9; ++v) acc[v] = 0.f;
        const float* w = ap->in[I_WMOD] + ((size_t)l * 1024 + kc * 64) * 3072 + nb * 64 + lane;
#pragma unroll 8
        for (int kk = 0; kk < 64; ++kk) { const float wv = w[(size_t)kk * 3072];
#pragma unroll
            for (int v = 0; v < 9; ++v) acc[v] += __uint_as_float(__builtin_amdgcn_readlane(__float_as_uint(sv[v]), kk)) * wv; }
        float* mp = (float*)(ws + WS_MODP) + ((size_t)(l * 16 + kc) * 9) * 3072 + nb * 64 + lane;
#pragma unroll
        for (int v = 0; v < 9; ++v) mp[(size_t)v * 3072] = acc[v];
    }
}
DI void mod_finalize(ArgsP ap) {
    const int tid = tid_l();
    const int gt = bid_l() * 512 + tid, NGT = grd_l() * 512;
    const float* mp = (const float*)(ap->ws + WS_MODP); float* mod = (float*)(ap->ws + WS_MOD);
    for (int i = gt; i < 2 * 9 * 3072; i += NGT) {
        const int l = i / (9 * 3072), rem = i % (9 * 3072), n = rem % 3072;
        float s = ap->in[I_BMOD][l * 3072 + n];
#pragma unroll
        for (int kc = 0; kc < 16; ++kc) s += mp[(size_t)(l * 16 + kc) * 9 * 3072 + rem];
        mod[i] = s;
    }
}
DI void ph_norm_mod(ArgsP ap, int l, int g) {
    const int tid = tid_l(), lane = tid & 63, wid = __builtin_amdgcn_readfirstlane(tid >> 6);
    const int gw = bid_l() * 8 + wid, NGW = grd_l() * 8;
    const float* ng = ap->in[I_NORMG] + l * 1024; const float* mod = (const float*)(ap->ws + WS_MOD) + (size_t)l * 9 * 3072;
    const float* xs = (l == 0) ? ap->in[I_X] : ap->out; const float* cs = (l == 0) ? ap->in[I_CTX] : (const float*)(ap->ws + WS_CTX);
    bf16_t* H = (bf16_t*)(ap->ws + WS_H);
    for (int r = gw; r < R; r += NGW) {
        const int bl = r / RB, j = r % RB, b = g * GB + bl;
        const float* src; const float* md;
        if (j < CTX) { src = cs + ((size_t)b * CTX + j) * DM; md = mod + 8 * 3072; } else { src = xs + ((size_t)b * SEQ + (j - CTX)) * DM; md = mod + (size_t)b * 3072; }
        f32x4 v[4]; float ss = 0.f;
#pragma unroll
        for (int q = 0; q < 4; ++q) { v[q] = *(const f32x4*)(src + 4 * (lane + 64 * q)); ss += (v[q][0] * v[q][0] + v[q][1] * v[q][1]) + (v[q][2] * v[q][2] + v[q][3] * v[q][3]); }
        const float rstd = 1.0f / sqrtf(wave_sum(ss) * (1.0f / DM) + EPS);
#pragma unroll
        for (int q = 0; q < 4; ++q) { const int idx = 4 * (lane + 64 * q);
            const f32x4 gg = *(const f32x4*)(ng + idx), sh = *(const f32x4*)(md + idx), sc = *(const f32x4*)(md + 1024 + idx);
            const f32x4 y = (v[q] * rstd * gg) * (sc + 1.0f) + sh;
            u32x2 w; w.x = pk2(y[0], y[1]); w.y = pk2(y[2], y[3]); *(u32x2*)(H + (size_t)r * DM + idx) = w; }
    }
}
DI void ph_mla_norm(ArgsP ap) {
    const int tid = tid_l(), lane = tid & 63, wid = __builtin_amdgcn_readfirstlane(tid >> 6);
    const int gw = bid_l() * 8 + wid, NGW = grd_l() * 8;
    const bf16_t* P = (const bf16_t*)(ap->ws + WS_P); bf16_t* AQ = (bf16_t*)(ap->ws + WS_AQ); bf16_t* AKV = (bf16_t*)(ap->ws + WS_AKV); bf16_t* KM = (bf16_t*)(ap->ws + WS_KM);
    for (int r = gw; r < R; r += NGW) {
        const bf16_t* row = P + (size_t)r * NP;
        const u32x4 c0 = *(const u32x4*)(row + 8 * lane);
        u32x4 c1 = {0u, 0u, 0u, 0u}; if (lane < 20) c1 = *(const u32x4*)(row + 8 * (64 + lane));
        float f0[8] = {bflo(c0.x), bfhi(c0.x), bflo(c0.y), bfhi(c0.y), bflo(c0.z), bfhi(c0.z), bflo(c0.w), bfhi(c0.w)};
        float f1[8] = {bflo(c1.x), bfhi(c1.x), bflo(c1.y), bfhi(c1.y), bflo(c1.z), bfhi(c1.z), bflo(c1.w), bfhi(c1.w)};
        float s0 = 0.f, s1 = 0.f;
#pragma unroll
        for (int i = 0; i < 8; ++i) { s0 += f0[i] * f0[i]; s1 += f1[i] * f1[i]; }
        const float sq = wave_sum(lane < 48 ? s0 : 0.f);
        const float skv = wave_sum((lane >= 48 ? s0 : 0.f) + (lane < 16 ? s1 : 0.f));
        const float rq = 1.0f / sqrtf(sq * (1.0f / 384.0f) + EPS), rkv = 1.0f / sqrtf(skv * (1.0f / 256.0f) + EPS);
        { const float rr = lane < 48 ? rq : rkv; u32x4 w; w.x = pk2(f0[0] * rr, f0[1] * rr); w.y = pk2(f0[2] * rr, f0[3] * rr); w.z = pk2(f0[4] * rr, f0[5] * rr); w.w = pk2(f0[6] * rr, f0[7] * rr);
          if (lane < 48) *(u32x4*)(AQ + (size_t)r * 384 + 8 * lane) = w; else *(u32x4*)(AKV + (size_t)r * 256 + 8 * (lane - 48)) = w; }
        if (lane < 16) { u32x4 w; w.x = pk2(f1[0] * rkv, f1[1] * rkv); w.y = pk2(f1[2] * rkv, f1[3] * rkv); w.z = pk2(f1[4] * rkv, f1[5] * rkv); w.w = pk2(f1[6] * rkv, f1[7] * rkv);
            *(u32x4*)(AKV + (size_t)r * 256 + 8 * (16 + lane)) = w; }
        else if (lane < 20) {
#pragma unroll
            for (int h = 0; h < 8; ++h) *(u32x4*)(KM + (size_t)r * 768 + h * 96 + 64 + 8 * (lane - 16)) = c1; }
    }
}
template <bool DRYE>
DI void ph_diff_post(ArgsP ap, int l) {
    const int tid = tid_l(), lane = tid & 63, wid = __builtin_amdgcn_readfirstlane(tid >> 6);
    const int gw = bid_l() * 8 + wid, NGW = grd_l() * 8;
    const float lam_init = (l == 0) ? 0.2f : (0.8f - 0.6f * 0.7408182206817179f);
    const float d1 = wave_sum(ap->in[I_LQ1][l * 64 + lane] * ap->in[I_LK1][l * 64 + lane]), d2 = wave_sum(ap->in[I_LQ2][l * 64 + lane] * ap->in[I_LK2][l * 64 + lane]);
    const float lam = expf(d1) - expf(d2) + lam_init;
    const float sl0 = ap->in[I_SUBLN][l * 128 + 2 * lane] * (1.0f - lam_init), sl1 = ap->in[I_SUBLN][l * 128 + 2 * lane + 1] * (1.0f - lam_init);
    const float* OD = (const float*)(ap->ws + WS_OD); bf16_t* P = (bf16_t*)(ap->ws + WS_P);
    typedef float f32x2 __attribute__((ext_vector_type(2)));
    for (int r = gw; r < R; r += NGW) {
        if (l != 0 && (r % RB) < CTX) continue;
        const float* ob = OD + (size_t)r * 2048 + 2 * lane; unsigned* zb = (unsigned*)(P + (size_t)r * NP + C_Z + 1024 + 2 * lane);
        f32x2 o1[8], o2[8]; unsigned z[8];
#pragma unroll
        for (int h = 0; h < 8; ++h) { o1[h] = *(const f32x2*)(ob + (2 * h) * 128); o2[h] = *(const f32x2*)(ob + (2 * h + 1) * 128); z[h] = zb[h * 64]; }
#pragma unroll
        for (int h = 0; h < 8; ++h) {
            const float a0 = o1[h][0] - lam * o2[h][0], a1 = o1[h][1] - lam * o2[h][1];
            const float rstd = 1.0f / sqrtf(wave_sum(a0 * a0 + a1 * a1) * (1.0f / 128.0f) + EPS);
            if (!DRYE || rstd == 12345.678f) zb[h * 64] = pk2(a0 * rstd * sl0 * silu_f(bflo(z[h])), a1 * rstd * sl1 * silu_f(bfhi(z[h])));
        }
    }
}
template <bool DRYE>
DI void ph_final_norm(ArgsP ap) {
    const int tid = tid_l(), lane = tid & 63, wid = __builtin_amdgcn_readfirstlane(tid >> 6);
    const int gw = bid_l() * 8 + wid, NGW = grd_l() * 8; const float* fg = ap->in[I_FNORM];
    for (int r = gw; r < NBATCH * SEQ; r += NGW) {
        float* row = ap->out + (size_t)r * DM; f32x4 v[4]; float ss = 0.f;
#pragma unroll
        for (int q = 0; q < 4; ++q) { v[q] = *(const f32x4*)(row + 4 * (lane + 64 * q)); ss += (v[q][0] * v[q][0] + v[q][1] * v[q][1]) + (v[q][2] * v[q][2] + v[q][3] * v[q][3]); }
        const float rstd = 1.0f / sqrtf(wave_sum(ss) * (1.0f / DM) + EPS);
#pragma unroll
        for (int q = 0; q < 4; ++q) { const int idx = 4 * (lane + 64 * q); if (!DRYE || rstd == 12345.678f) *(f32x4*)(row + idx) = v[q] * rstd * *(const f32x4*)(fg + idx); }
    }
}
template <bool DRY>
DI void ph_attention(ArgsP ap, int l, LAS unsigned char* lds) {
    constexpr int OM0 = DRY ? 2 : 0;
    const int G = grd_l(), bx = bid_l(), vcu = (G % 8 == 0) ? (bx % 8) * (G / 8) + bx / 8 : bx;
    bf16_t* P = (bf16_t*)(ap->ws + WS_P); const bf16_t* QM = (const bf16_t*)(ap->ws + WS_QM); const bf16_t* KM = (const bf16_t*)(ap->ws + WS_KM); const bf16_t* VM = (const bf16_t*)(ap->ws + WS_VM);
    float* OD = (float*)(ap->ws + WS_OD); const float* sink = ap->in[I_SINK] + l * 16;
#if !defined(ATT_ONLY) || ATT_ONLY == 1
    if (!DRY || (DRY_SEL & 1))
    for (int u = vcu; u < GB * 8 * 32; u += G) { const int bh = u >> 5, qb = u & 31, bl = bh >> 3, h = bh & 7; const size_t rb = (size_t)bl * RB, q0 = rb + CTX + 256 * qb;
        attn_unit<96, 128, OM0, false>(lds, QM + q0 * 768 + h * 96, 768, KM + rb * 768 + h * 96, 768, VM + rb * 1024 + h * 128, 1024, RB / 64, 0, 0, 0, 0, NEGBIG, 0.f, P + q0 * NP + C_Z + h * 128, NP, OD, 0); }
#endif
#if !defined(ATT_ONLY) || ATT_ONLY == 2
    if (!DRY || (DRY_SEL & 2))
    for (int u = vcu; u < GB * 16 * 32; u += G) { const int bh = u >> 5, qb = u & 31, bl = bh >> 4, hm = bh & 15; const size_t rb = (size_t)bl * RB, q0 = rb + CTX + 256 * qb;
        attn_unit<64, 128, 1, false>(lds, P + q0 * NP + C_DQ + hm * 64, NP, P + rb * NP + C_DK + hm * 64, NP, P + rb * NP + C_DV + (hm >> 1) * 128, NP, RB / 64, 0, 0, 0, 0, NEGBIG, 0.f, nullptr, 0, OD + q0 * 2048 + hm * 128, 2048); }
#endif
#if !defined(ATT_ONLY) || ATT_ONLY == 3
    if (!DRY || (DRY_SEL & 4))
    for (int u = vcu; u < GB * 16 * 32; u += G) { const int bh = u >> 5, qb = u & 31, bl = bh >> 4, h = bh & 15; const size_t rb = (size_t)bl * RB, q0 = rb + CTX + 256 * qb;
        const int lo = (256 * qb - 128 < 0) ? 0 : 256 * qb - 128, hi = (256 * qb + 384 > SEQ) ? SEQ : 256 * qb + 384;
        attn_unit<64, 64, OM0, true>(lds, P + q0 * NP + C_SQ + h * 64, NP, P + rb * NP + C_SK + (h >> 2) * 64, NP, P + rb * NP + C_SV + (h >> 2) * 64, NP, CTX / 64, CTX + lo, (hi - lo) / 64, lo, 256 * qb, sink[h] * LOG2E, 1.0f,
                              P + q0 * NP + C_Z + 2048 + h * 64, NP, OD, 0); }
#endif
#if !defined(ATT_ONLY)
    if (l == 0) {
        for (int u = vcu; u < GB * 40; u += G) { const int bl = u / 40, k = u % 40; const size_t rb = (size_t)bl * RB;
            if (k < 8) { const int h = k;
                attn_unit<96, 128, OM0, false>(lds, QM + rb * 768 + h * 96, 768, KM + rb * 768 + h * 96, 768, VM + rb * 1024 + h * 128, 1024, CTX / 64, 0, 0, 0, 0, NEGBIG, 0.f, P + rb * NP + C_Z + h * 128, NP, OD, 0); }
            else if (k < 24) { const int hm = k - 8;
                attn_unit<64, 128, 1, false>(lds, P + rb * NP + C_DQ + hm * 64, NP, P + rb * NP + C_DK + hm * 64, NP, P + rb * NP + C_DV + (hm >> 1) * 128, NP, CTX / 64, 0, 0, 0, 0, NEGBIG, 0.f, nullptr, 0, OD + rb * 2048 + hm * 128, 2048); }
            else { const int h = k - 24;
                attn_unit<64, 64, OM0, false>(lds, P + rb * NP + C_SQ + h * 64, NP, P + rb * NP + C_SK + (h >> 2) * 64, NP, P + rb * NP + C_SV + (h >> 2) * 64, NP, CTX / 64, 0, 0, 0, 0, sink[h] * LOG2E, 1.0f, P + rb * NP + C_Z + 2048 + h * 64, NP, OD, 0); }
        }
    }
#endif
}

#define RLX_AGENT __ATOMIC_RELAXED, __HIP_MEMORY_SCOPE_AGENT
#define XB_TMO      128
#define XB_XCNT(j)  (256  + 64 * (j))
#define XB_XSUB(j)  (1280 + 64 * (j))
#define XB_XGEN(j)  (2304 + 64 * (j))
#define XB_TOP      3328
#define XB_TOPGEN   3392
#define XCD_BAR_WORDS 3456
#define XB_SPIN_CAP (1u << 18)

__device__ __forceinline__ unsigned xb_ld(unsigned* p)              { return __hip_atomic_load(p, __ATOMIC_RELAXED, __HIP_MEMORY_SCOPE_AGENT); }
__device__ __forceinline__ unsigned xb_add(unsigned* p, unsigned v) { return __hip_atomic_fetch_add(p, v, __ATOMIC_RELAXED, __HIP_MEMORY_SCOPE_AGENT); }
__device__ __forceinline__ unsigned xb_xcc_id() { return (unsigned)__builtin_amdgcn_s_getreg((3 << 11) | 20) & 0xFu; }
#define XB_SPIN(cond, bar) do { unsigned _sp = 0; while (cond) { __builtin_amdgcn_s_sleep(1); \
    if ((++_sp & 255u) == 0u) { if (xb_ld(&(bar)[XB_TMO])) break; if (_sp > XB_SPIN_CAP) { atomicAdd(&(bar)[XB_TMO], 1u); break; } } } } while (0)

struct XcdBarrier {
    unsigned* bar; unsigned x;
    volatile LAS unsigned* st;
};

__device__ __forceinline__ XcdBarrier xcd_barrier_post(unsigned* bar, volatile LAS unsigned* st) {
    XcdBarrier b; b.bar = bar; b.x = xb_xcc_id(); b.st = st;
    if (threadIdx.x == 0) (void)xb_add(&bar[XB_XCNT(b.x)], 1u);
    return b;
}
__device__ __forceinline__ void xcd_barrier_complete(unsigned* bar, unsigned x, unsigned& nloc, unsigned& nx) {
    const unsigned G = gridDim.x * gridDim.y * gridDim.z;
    unsigned sum, cnt, mine, sp = 0u;
    for (;;) {
        sum = 0u; cnt = 0u; mine = 0u;
#pragma unroll
        for (unsigned j = 0; j < 16; ++j) { const unsigned c = xb_ld(&bar[XB_XCNT(j)]); sum += c; cnt += (c > 0u) ? 1u : 0u; mine = (j == x) ? c : mine; }
        if (sum == G) break;
        __builtin_amdgcn_s_sleep(1);
        if ((++sp & 255u) == 0u) { if (xb_ld(&bar[XB_TMO])) break; if (sp > XB_SPIN_CAP) { atomicAdd(&bar[XB_TMO], 1u); break; } }
    }
    nloc = mine > 0u ? mine : 1u; nx = cnt > 0u ? cnt : 1u;
}

__device__ __forceinline__ void xcd_barrier(const XcdBarrier& b) {
    asm volatile("s_waitcnt vmcnt(0)" ::: "memory");
    __syncthreads();
    if (threadIdx.x == 0) {
        unsigned* bar = b.bar;
        __builtin_amdgcn_s_waitcnt(0);
        unsigned nloc = b.st[0], nx = b.st[1];
        if (nloc == 0u) { xcd_barrier_complete(bar, b.x, nloc, nx); b.st[0] = nloc; b.st[1] = nx; }
        const unsigned old = xb_add(&bar[XB_XSUB(b.x)], 1u);
        const unsigned gen = old / nloc;
        if (old + 1u == (gen + 1u) * nloc) {
            __builtin_amdgcn_fence(__ATOMIC_RELEASE, "agent");
            asm volatile("s_waitcnt vmcnt(0)" ::: "memory");
            const unsigned og = xb_add(&bar[XB_TOP], 1u);
            const unsigned tg = og / nx;
            if (og + 1u == (tg + 1u) * nx) xb_add(&bar[XB_TOPGEN], 1u);
            else XB_SPIN(xb_ld(&bar[XB_TOPGEN]) == tg, bar);
            __builtin_amdgcn_fence(__ATOMIC_ACQUIRE, "agent");
            xb_add(&bar[XB_XGEN(b.x)], 1u);
            asm volatile("s_waitcnt vmcnt(0)" ::: "memory");
        } else {
            XB_SPIN(xb_ld(&bar[XB_XGEN(b.x)]) == gen, bar);
            __builtin_amdgcn_fence(__ATOMIC_ACQUIRE, "agent");
            asm volatile("s_waitcnt vmcnt(0)" ::: "memory");
        }
    }
    __syncthreads();
}


__global__ void __launch_bounds__(512, 2) hybrid_fwd(Args a_unused) {
    extern __shared__ __attribute__((aligned(16))) unsigned char lds_raw[];
    LAS unsigned char* lds = (LAS unsigned char*)lds_raw;
    cg::grid_group grid = cg::this_grid();
    { volatile LAS unsigned* xst = (volatile LAS unsigned*)(lds + XB_LDS_OFF);
      if (threadIdx.x < 2) xst[threadIdx.x] = 0u;
      __syncthreads();
      (void)xcd_barrier_post((unsigned*)(args_ptr()->ws), xst); }
#define GSYNC() do { XcdBarrier b_; b_.bar = (unsigned*)(args_ptr()->ws); b_.x = xb_xcc_id(); b_.st = (volatile LAS unsigned*)(lds + XB_LDS_OFF); xcd_barrier(b_); } while (0)
#ifndef NO_PRO
    prologue(args_ptr(), lds);
#ifdef PROBE_PRO
    __syncthreads(); prologue(args_ptr(), lds);
#endif
#endif
    grid.sync();
    mod_finalize(args_ptr());
    GSYNC();
    for (int l = 0; l < 2; ++l) {
        for (int g = 0; g < NGRP; ++g) {
            ph_norm_mod(args_ptr(), lnd(l), lnd(g));
#ifdef PROBE_R1
            GSYNC(); ph_norm_mod(args_ptr(), lnd(l), lnd(g));
#endif
            GSYNC();
#ifndef NO_GEMM
            {
                unsigned char* ws = args_ptr()->ws; const int G = grd_l(), bx = bid_l();
                pg8::Gemm gm{1024, 1024, 1024}; pg8::Order S; S.init(R, NP, G, bx, ws + WS_H, 1024, (bf16_t*)(ws + WS_WIN) + (size_t)l * NP * 1024, 1024, 1 << 20, 0);
                EpiIn E{ws};
                pg8::gemm_phase<EpiIn, pg8::Order, true, true>(lds, gm, S, E);
#ifdef PROBE_G1
                __syncthreads(); pg8::gemm_phase<EpiIn, pg8::Order, true, true>(lds, gm, S, E);
#endif
            }
#endif
            GSYNC();
#ifndef NO_GEMM2
            {
                unsigned char* ws = args_ptr()->ws; const int G = grd_l(), bx = bid_l();
                pg8::Gemm gq{384, NP, 384}; pg8::Order Sq; Sq.init(R, 768, G, bx, (bf16_t*)(ws + WS_P) + C_QC, NP, (bf16_t*)(ws + WS_WUQ) + (size_t)l * 768 * 384, 384, 1 << 20, 0);
                EpiQ Eq{ws};
#ifndef NO_GQ
                pg8::gemm_phase<EpiQ, pg8::Order, true, true>(lds, gq, Sq, Eq);
#ifdef PROBE_G2
                __syncthreads(); pg8::gemm_phase<EpiQ, pg8::Order, true, true>(lds, gq, Sq, Eq);
#endif
#endif
            }
            {
                unsigned char* ws = args_ptr()->ws; const int G = grd_l(), bx = bid_l();
                pg8::Gemm gk{256, NP, 256}; pg8::Order Sk; Sk.init(R, 1536, G, bx, (bf16_t*)(ws + WS_P) + C_KVC, NP, (bf16_t*)(ws + WS_WUKV) + (size_t)l * 1536 * 256, 256, 1 << 20, 0);
                EpiKV Ek{ws};
#ifndef NO_GK
                pg8::gemm_phase<EpiKV, pg8::Order, true, true>(lds, gk, Sk, Ek);
#ifdef PROBE_G2
                __syncthreads(); pg8::gemm_phase<EpiKV, pg8::Order, true, true>(lds, gk, Sk, Ek);
#endif
#endif
            }
#endif
            GSYNC();
#ifndef NO_ATT
#ifdef PROBE_ATT
            ph_attention<true>(args_ptr(), lnd(l), lds);
            GSYNC();
#endif
            ph_attention<false>(args_ptr(), lnd(l), lds);
#endif
            GSYNC();
#ifdef PROBE_R2
            ph_diff_post<true>(args_ptr(), lnd(l)); GSYNC();
#endif
            ph_diff_post<false>(args_ptr(), lnd(l));
            GSYNC();
#ifndef NO_BR
            {
                unsigned char* ws = args_ptr()->ws; const int G = grd_l(), bx = bid_l();
                pg8::Gemm gb{1024, NP, 1024}; pg8::Order S; S.init(R, 3072, G, bx, (bf16_t*)(ws + WS_P) + C_Z, NP, (bf16_t*)(ws + WS_WB) + (size_t)l * 3 * 1024 * 1024, 1024, 4, 1024 * 2, l != 0);
#ifdef PROBE_BR
                { EpiBrT<true> Ed{ws}; pg8::gemm_phase<EpiBrT<true>, pg8::Order, true, true>(lds, gb, S, Ed); __syncthreads(); }
#endif
                EpiBrT<false> E{ws};
                pg8::gemm_phase<EpiBrT<false>, pg8::Order, true, true>(lds, gb, S, E);
            }
#endif
            GSYNC();
#ifndef NO_OUT
            {
                ArgsP ap = args_ptr(); unsigned char* ws = ap->ws; const int G = grd_l(), bx = bid_l();
                pg8::Gemm go{3072, NP, 3072}; pg8::Order S; S.init(R, 1024, G, bx, (bf16_t*)(ws + WS_P) + C_GM, NP, (bf16_t*)(ws + WS_WO3) + (size_t)l * 1024 * 3072, 3072, 1 << 20, 0, l != 0);
#ifdef PROBE_OUT
                { EpiOutT<true> Ed{l, g, (l == 0) ? ap->in[I_X] : (const float*)ap->out, ap->out, ap->in[I_CTX], ws}; pg8::gemm_phase<EpiOutT<true>, pg8::Order, true, true>(lds, go, S, Ed); __syncthreads(); }
#endif
                EpiOutT<false> E{l, g, (l == 0) ? ap->in[I_X] : (const float*)ap->out, ap->out, ap->in[I_CTX], ws};
                pg8::gemm_phase<EpiOutT<false>, pg8::Order, true, true>(lds, go, S, E);
            }
#endif
        }
        GSYNC();
    }
#ifdef PROBE_R2
    ph_final_norm<true>(args_ptr()); GSYNC();
#endif
    ph_final_norm<false>(args_ptr());
}

extern "C" void kernel_launch(void* const* d_in, const int* in_sizes, int n_in, void* d_out, int out_size, void* d_ws, size_t ws_size, hipStream_t stream) {
    static int grid = 0;
    if (grid == 0) {
        if (n_in != 21 || ws_size < WS_END) { fprintf(stderr, "kernel_launch: expected 21 inputs and >= %zu bytes of workspace (got %d, %zu)\n", (size_t)WS_END, n_in, ws_size); grid = -1; return; }
        int dev = 0, cus = 0, per_cu = 0;
        (void)hipGetDevice(&dev); (void)hipDeviceGetAttribute(&cus, hipDeviceAttributeMultiprocessorCount, dev);
        if (hipFuncSetAttribute((const void*)hybrid_fwd, hipFuncAttributeMaxDynamicSharedMemorySize, LDS_BYTES) != hipSuccess) fprintf(stderr, "kernel_launch: hipFuncSetAttribute failed\n");
        if (hipOccupancyMaxActiveBlocksPerMultiprocessor(&per_cu, (const void*)hybrid_fwd, 512, LDS_BYTES) != hipSuccess || per_cu < 1) { per_cu = 1; (void)hipGetLastError(); }
        if (cus <= 0) cus = 256;
        grid = cus * per_cu;
    }
    if (grid < 0) return;
    Args a{};
    for (int i = 0; i < 21; ++i) a.in[i] = (const float*)d_in[i];
    a.out = (float*)d_out; a.ws = (unsigned char*)d_ws;
    (void)hipMemsetAsync(d_ws, 0, 16384, stream);
    void* args[] = {&a};
    hipError_t e = hipLaunchCooperativeKernel((const void*)hybrid_fwd, dim3(grid), dim3(512), args, LDS_BYTES, stream);
    if (e != hipSuccess) fprintf(stderr, "kernel_launch: cooperative launch failed: %s (grid %d)\n", hipGetErrorString(e), grid);
}
```

```cpp
#include <hip/hip_runtime.h>
#include <hip/hip_cooperative_groups.h>
#include <cstdio>
#include <cstdint>
namespace cg = cooperative_groups;

#define DI __device__ __forceinline__
#define LAS __attribute__((address_space(3)))
__device__ __forceinline__ int tid_l() { int t = threadIdx.x; asm volatile("" : "+v"(t)); return t; }
__device__ __forceinline__ int bid_l() { int b = blockIdx.x; asm volatile("" : "+s"(b)); return b; }
__device__ __forceinline__ int lnd(int x) { asm volatile("" : "+s"(x)); return x; }
__device__ __forceinline__ int grd_l() { int g = gridDim.x; asm volatile("" : "+s"(g)); return g; }
typedef unsigned short bf16_t;
typedef short bf16x8 __attribute__((ext_vector_type(8)));
typedef short s16x4 __attribute__((ext_vector_type(4)));
typedef float f32x4 __attribute__((ext_vector_type(4)));
typedef float f32x16 __attribute__((ext_vector_type(16)));
typedef unsigned u32x4 __attribute__((ext_vector_type(4)));
typedef unsigned u32x2 __attribute__((ext_vector_type(2)));

constexpr int DM = 1024, NBATCH = 8, SEQ = 8192, CTX = 256, RB = CTX + SEQ;
constexpr int GB = 2, NGRP = NBATCH / GB, R = GB * RB;
constexpr int NP = 11520;
constexpr int C_QC = 0, C_KVC = 384, C_KR = 640, C_DQ = 768, C_DK = 1792, C_DV = 2816, C_SQ = 3840, C_SK = 4864, C_SV = 5120, C_Z = 5376, C_GM = 8448;
constexpr int D_IN = 11424;
constexpr float EPS = 1e-6f, LOG2E = 1.4426950408889634f;
constexpr float QS64 = 0.125f * LOG2E, QS96 = 0.10206207261596575f * LOG2E;
constexpr float NEGBIG = -1e30f, THR = 8.0f;

constexpr size_t al256(size_t x) { return (x + 255) & ~(size_t)255; }
constexpr size_t WS_WIN = 1u << 20;
constexpr size_t WS_WUQ = al256(WS_WIN + (size_t)2 * NP * 1024 * 2);
constexpr size_t WS_WUKV = al256(WS_WUQ + (size_t)2 * 768 * 384 * 2);
constexpr size_t WS_WB = al256(WS_WUKV + (size_t)2 * 1536 * 256 * 2);
constexpr size_t WS_WO3 = al256(WS_WB + (size_t)2 * 3 * 1024 * 1024 * 2);
constexpr size_t WS_COSH = al256(WS_WO3 + (size_t)2 * 1024 * 3072 * 2);
constexpr size_t WS_SINH = al256(WS_COSH + (size_t)SEQ * 32 * 4);
constexpr size_t WS_COSM = al256(WS_SINH + (size_t)SEQ * 32 * 4);
constexpr size_t WS_SINM = al256(WS_COSM + (size_t)SEQ * 16 * 4);
constexpr size_t WS_MODP = al256(WS_SINM + (size_t)SEQ * 16 * 4);
constexpr size_t WS_MOD = al256(WS_MODP + (size_t)16 * 2 * 9 * 3072 * 4);
constexpr size_t WS_CTX = al256(WS_MOD + (size_t)2 * 9 * 3072 * 4);
constexpr size_t WS_H = al256(WS_CTX + (size_t)NBATCH * CTX * DM * 4);
constexpr size_t WS_P = al256(WS_H + (size_t)R * DM * 2);
constexpr size_t WS_AQ = al256(WS_P + (size_t)R * NP * 2);
constexpr size_t WS_AKV = al256(WS_AQ + (size_t)R * 384 * 2);
constexpr size_t WS_QM = al256(WS_AKV + (size_t)R * 256 * 2);
constexpr size_t WS_KM = al256(WS_QM + (size_t)R * 768 * 2);
constexpr size_t WS_VM = al256(WS_KM + (size_t)R * 768 * 2);
constexpr size_t WS_OD = al256(WS_VM + (size_t)R * 1024 * 2);
constexpr size_t WS_END = al256(WS_OD + (size_t)R * 2048 * 4);
constexpr size_t WS_PART = WS_AQ;
static_assert(WS_END <= ((size_t)1 << 30), "workspace map exceeds 1 GiB");

constexpr int LDS_BYTES = 155648, XB_LDS_OFF = 155136;

DI unsigned pk2(float lo, float hi) { typedef float f2_t __attribute__((ext_vector_type(2))); typedef __bf16 b2_t __attribute__((ext_vector_type(2)));
    f2_t v = {lo, hi}; b2_t b = __builtin_convertvector(v, b2_t); return __builtin_bit_cast(unsigned, b); }
DI u32x4 pack8(f32x4 a, f32x4 b) { u32x4 w; w.x = pk2(a[0], a[1]); w.y = pk2(a[2], a[3]); w.z = pk2(b[0], b[1]); w.w = pk2(b[2], b[3]); return w; }
DI float bflo(unsigned w) { return __uint_as_float(w << 16); }
DI float bfhi(unsigned w) { return __uint_as_float(w & 0xffff0000u); }
DI float wave_sum(float v) {
#pragma unroll
    for (int o = 1; o < 64; o <<= 1) v += __shfl_xor(v, o);
    return v; }
DI float opq(float a) { asm("" : "+v"(a)); return a; }
DI float silu_f(float z) { return z * __builtin_amdgcn_rcpf(1.0f + __expf(-z)); }
DI float sigm_f(float z) { return __builtin_amdgcn_rcpf(1.0f + __expf(-z)); }
DI void rope8(f32x4& v0, f32x4& v1, const f32x4 cs, const f32x4 sn) {
    float a, b;
    a = v0[0]; b = v0[1]; v0[0] = a * cs[0] - b * sn[0]; v0[1] = b * cs[0] + a * sn[0];
    a = v0[2]; b = v0[3]; v0[2] = a * cs[1] - b * sn[1]; v0[3] = b * cs[1] + a * sn[1];
    a = v1[0]; b = v1[1]; v1[0] = a * cs[2] - b * sn[2]; v1[1] = b * cs[2] + a * sn[2];
    a = v1[2]; b = v1[3]; v1[2] = a * cs[3] - b * sn[3]; v1[3] = b * cs[3] + a * sn[3];
}
namespace pg8 {
#define PG8_LAS __attribute__((address_space(3)))
typedef unsigned short bf16_t;
typedef short bf16x8 __attribute__((ext_vector_type(8)));
typedef float f32x4 __attribute__((ext_vector_type(4)));
typedef unsigned u32x4 __attribute__((ext_vector_type(4)));
constexpr int BM = 256, BK = 64, HALF = 128, HTB = HALF * BK * 2  , STAGE_BYTES = 8 * HTB, NXCD = 8, WGM = 8;

__host__ __device__ __forceinline__ int lds_byte(int r, int c) { const int st = (r >> 4) * 2 + (c >> 5), rr = r & 15, cc = c & 31, ob = rr * 64 + cc * 2; return st * 1024 + (ob ^ (((ob >> 9) & 1) << 5)); }
__host__ __device__ __forceinline__ void stage_rc(int b, int& R, int& C) { const int st = b / 1024, sb = b % 1024, swz = sb ^ (((sb >> 9) & 1) << 5); R = (st >> 1) * 16 + swz / 64; C = (st & 1) * 32 + (swz % 64) / 2; }
__host__ __device__ __forceinline__ int perm32(int rho) { const int n = rho >> 4, i = rho & 15; return 8 * (i >> 2) + 4 * n + (i & 3); }

struct Unit { int pm, pn; };
struct Gemm { int K, lda, ldb; };
struct Order {
    int nM, nN, nwg, G, c; const char* A; const char* B; unsigned tA, tB; int pnblk; unsigned ablk; int skipctx;
    __device__ __forceinline__ void init(int M, int N, int G_, int c_, const void* A_, int lda, const void* B_, int ldb, int pnblk_, unsigned ablk_, int skipctx_ = 0) {
        skipctx = skipctx_; nM = M / BM; if (skipctx) nM -= nM / 33;
        nN = N / BM; nwg = nM * nN; G = G_; c = c_; A = (const char*)A_; B = (const char*)B_; tA = (unsigned)(BM * lda * 2); tB = (unsigned)(BM * ldb * 2); pnblk = pnblk_; ablk = ablk_; }
    __device__ __forceinline__ bool next(int i, Unit& u) const {
        const long L = (long)i * G + c; if (L >= nwg) return false;
        int wgid = (int)L; { const int q = nwg / NXCD, r = nwg % NXCD, xcd = wgid % NXCD, off = wgid / NXCD; wgid = (xcd < r ? xcd * (q + 1) : r * (q + 1) + (xcd - r) * q) + off; }
        const int nig = WGM * nN, gid = wgid / nig, fm = gid * WGM, gsz = (nM - fm) < WGM ? (nM - fm) : WGM;
        u.pm = fm + ((wgid % nig) % gsz); u.pn = (wgid % nig) / gsz; if (skipctx) u.pm += u.pm / 32 + 1; return true;
    }
    __device__ __forceinline__ const char* a_base(const Unit& u) const { return A + (size_t)u.pm * tA + (size_t)(u.pn / pnblk) * ablk; }
    __device__ __forceinline__ const char* b_base(const Unit& u) const { return B + (size_t)u.pn * tB; }
};

template <class Epi, class Sched, bool ALIGN_EPI = false, bool SP2 = false>
__device__ __forceinline__ void gemm_phase(PG8_LAS unsigned char* lds, const Gemm g, const Sched& S, const Epi& E) {
    const int tid = tid_l(), wid = __builtin_amdgcn_readfirstlane(tid >> 6), lane = tid & 63, wr = wid >> 2, wc = wid & 3, fr = lane & 15, fq = lane >> 4;
    const int K = g.K, nt = K / BK;
    unsigned voffA[2], voffB[2];
#pragma unroll
    for (int i = 0; i < 2; ++i) { int R, C; stage_rc(tid * 16 + i * 8192, R, C); const int Rb = Epi::PERM ? ((R & ~31) + perm32(R & 31)) : R;
        voffA[i] = (unsigned)(R * g.lda + C) * 2u; voffB[i] = (unsigned)(Rb * g.ldb + C) * 2u; }
    const size_t kstep = (size_t)(BK * 2);
    const size_t hstepA = (size_t)HALF * g.lda * 2, hstepB = (size_t)HALF * g.ldb * 2;
    const unsigned ldsw = (unsigned)wid * 1024u;
    const int aoff = lds_byte(wr * 64 + fr, fq * 8), boff = lds_byte(wc * 32 + fr, fq * 8);
#define PG8_SA(b, h) (((b) * 2 + (h)) * HTB)
#define PG8_SB(b, h) ((4 + (b) * 2 + (h)) * HTB)
#define PG8_STAGE(bufoff, gbase, voff) do { _Pragma("unroll") for (int _i = 0; _i < 2; ++_i) \
        __builtin_amdgcn_global_load_lds((const unsigned*)((const char*)(gbase) + (voff)[_i]), (PG8_LAS unsigned*)(lds + (bufoff) + ldsw + _i * 8192), 16, 0, 0); } while (0)
#define PG8_LDA(dst, b, h) do { _Pragma("unroll") for (int m = 0; m < 4; ++m) _Pragma("unroll") for (int k = 0; k < 2; ++k) dst[m][k] = *(const PG8_LAS bf16x8*)(lds + PG8_SA(b, h) + aoff + m * 2048 + k * 1024); } while (0)
#define PG8_LDB(dst, b, h) do { _Pragma("unroll") for (int n = 0; n < 2; ++n) _Pragma("unroll") for (int k = 0; k < 2; ++k) dst[n][k] = *(const PG8_LAS bf16x8*)(lds + PG8_SB(b, h) + boff + n * 2048 + k * 1024); } while (0)
#define PG8_MMA(ai, bj, At, Bt) do { __builtin_amdgcn_s_setprio(1); _Pragma("unroll") for (int m = 0; m < 4; ++m) _Pragma("unroll") for (int n = 0; n < 2; ++n) _Pragma("unroll") for (int k = 0; k < 2; ++k) \
        acc[ai][bj][m][n] = __builtin_amdgcn_mfma_f32_16x16x32_bf16(Bt[n][k], At[m][k], acc[ai][bj][m][n], 0, 0, 0); __builtin_amdgcn_s_setprio(0); } while (0)
#define PG8_WAIT_V(n) asm volatile("s_waitcnt vmcnt(" #n ")" ::: "memory")
#define PG8_WAIT_L(n) asm volatile("s_waitcnt lgkmcnt(" #n ")" ::: "memory")
#define PG8_BAR __builtin_amdgcn_s_barrier()
#define PG8_SCHED __builtin_amdgcn_sched_barrier(0)
    Unit cur, nxt; int ui = 0;
    if (!S.next(0, cur)) return;
    f32x4 acc[2][2][4][2];
#pragma unroll
    for (int a = 0; a < 2; ++a)
#pragma unroll
        for (int b = 0; b < 2; ++b)
#pragma unroll
            for (int m = 0; m < 4; ++m)
#pragma unroll
                for (int n = 0; n < 2; ++n) acc[a][b][m][n] = (f32x4){0.f, 0.f, 0.f, 0.f};
    bf16x8 At[4][2], B0[2][2], B1[2][2];
    const char* cA = S.a_base(cur); const char* cB = S.b_base(cur);

    if constexpr (SP2) {
        PG8_STAGE(PG8_SB(0, 0), cB, voffB); PG8_STAGE(PG8_SB(0, 1), cB + hstepB, voffB); PG8_STAGE(PG8_SA(0, 0), cA, voffA); PG8_STAGE(PG8_SA(0, 1), cA + hstepA, voffA);
        if (wr == 1) PG8_BAR;
        PG8_WAIT_V(2); PG8_BAR;
        PG8_STAGE(PG8_SB(1, 0), cB + kstep, voffB); PG8_STAGE(PG8_SA(1, 0), cA + kstep, voffA); PG8_STAGE(PG8_SB(1, 1), cB + hstepB + kstep, voffB);
        PG8_WAIT_V(6); PG8_BAR;
    } else {
        PG8_STAGE(PG8_SB(0, 0), cB, voffB); PG8_STAGE(PG8_SA(0, 0), cA, voffA); PG8_STAGE(PG8_SB(0, 1), cB + hstepB, voffB); PG8_STAGE(PG8_SA(0, 1), cA + hstepA, voffA);
        if (wr == 1) PG8_BAR;
        PG8_WAIT_V(4); PG8_BAR;
        PG8_STAGE(PG8_SB(1, 0), cB + kstep, voffB); PG8_STAGE(PG8_SA(1, 0), cA + kstep, voffA); PG8_STAGE(PG8_SB(1, 1), cB + hstepB + kstep, voffB);
        PG8_WAIT_V(6); PG8_BAR;
    }
    for (;;) {
        const bool has_next = S.next(ui + 1, nxt);
        const char* nA = has_next ? S.a_base(nxt) : cA; const char* nB = has_next ? S.b_base(nxt) : cB;
#pragma nounroll
        for (int t = 0; t < nt; t += 2) {
            const bool last = (t == nt - 2);
            const char* a1 = cA + (size_t)(t + 1) * kstep;
            const char* a2 = last ? nA : cA + (size_t)(t + 2) * kstep; const char* b2 = last ? nB : cB + (size_t)(t + 2) * kstep;
            const char* a3 = a2 + kstep; const char* b3 = b2 + kstep;

            if constexpr (SP2) {
            PG8_LDB(B0, 0, 0); PG8_LDB(B1, 0, 1); PG8_SCHED; PG8_LDA(At, 0, 0); PG8_STAGE(PG8_SA(1, 1), a1 + hstepA, voffA);
            PG8_WAIT_V(8); PG8_WAIT_L(0); PG8_BAR; PG8_MMA(0, 0, At, B0); PG8_MMA(0, 1, At, B1); PG8_BAR; PG8_SCHED;
            PG8_LDA(At, 0, 1); PG8_STAGE(PG8_SB(0, 0), b2, voffB); PG8_STAGE(PG8_SB(0, 1), b2 + hstepB, voffB); PG8_STAGE(PG8_SA(0, 0), a2, voffA);
            PG8_WAIT_V(8); PG8_WAIT_L(0); PG8_BAR; PG8_MMA(1, 0, At, B0); PG8_MMA(1, 1, At, B1); PG8_BAR; PG8_SCHED;
            PG8_LDB(B0, 1, 0); PG8_LDB(B1, 1, 1); PG8_SCHED; PG8_LDA(At, 1, 0); PG8_STAGE(PG8_SA(0, 1), a2 + hstepA, voffA);
            PG8_WAIT_V(8); PG8_WAIT_L(0); PG8_BAR; PG8_MMA(0, 0, At, B0); PG8_MMA(0, 1, At, B1); PG8_BAR; PG8_SCHED;
            PG8_LDA(At, 1, 1); PG8_STAGE(PG8_SB(1, 0), b3, voffB); PG8_STAGE(PG8_SB(1, 1), b3 + hstepB, voffB); PG8_STAGE(PG8_SA(1, 0), a3, voffA);
            PG8_WAIT_V(8); PG8_WAIT_L(0); PG8_BAR; PG8_MMA(1, 0, At, B0); PG8_MMA(1, 1, At, B1); PG8_BAR; PG8_SCHED;
            } else {
            PG8_LDB(B0, 0, 0); PG8_SCHED; PG8_LDA(At, 0, 0); PG8_STAGE(PG8_SA(1, 1), a1 + hstepA, voffA);
            PG8_WAIT_L(8); PG8_BAR; PG8_WAIT_L(0); PG8_MMA(0, 0, At, B0); PG8_BAR; PG8_SCHED;
            PG8_LDB(B1, 0, 1); PG8_STAGE(PG8_SB(0, 0), b2, voffB);
            PG8_BAR; PG8_WAIT_L(0); PG8_MMA(0, 1, At, B1); PG8_BAR;
            PG8_LDA(At, 0, 1); PG8_STAGE(PG8_SA(0, 0), a2, voffA);
            PG8_BAR; PG8_WAIT_L(0); PG8_MMA(1, 0, At, B0); PG8_BAR; PG8_SCHED;
            PG8_STAGE(PG8_SB(0, 1), b2 + hstepB, voffB);
            PG8_WAIT_V(6); PG8_BAR; PG8_MMA(1, 1, At, B1); PG8_BAR;
            PG8_LDB(B0, 1, 0); PG8_SCHED; PG8_LDA(At, 1, 0); PG8_STAGE(PG8_SA(0, 1), a2 + hstepA, voffA);
            PG8_WAIT_L(8); PG8_BAR; PG8_WAIT_L(0); PG8_MMA(0, 0, At, B0); PG8_BAR; PG8_SCHED;
            PG8_LDB(B1, 1, 1); PG8_STAGE(PG8_SB(1, 0), b3, voffB);
            PG8_BAR; PG8_WAIT_L(0); PG8_MMA(0, 1, At, B1); PG8_BAR;
            PG8_LDA(At, 1, 1); PG8_STAGE(PG8_SA(1, 0), a3, voffA);
            PG8_BAR; PG8_WAIT_L(0); PG8_MMA(1, 0, At, B0); PG8_BAR; PG8_SCHED;
            PG8_STAGE(PG8_SB(1, 1), b3 + hstepB, voffB);
            PG8_WAIT_V(6); PG8_BAR; PG8_MMA(1, 1, At, B1); PG8_BAR;
            }
        }
        if constexpr (ALIGN_EPI) { if (wr == 0) PG8_BAR; }
        if constexpr (!Epi::AFTER_DRAIN) { E(acc, cur, wr, wc, fr, fq); }
        if (!has_next) break;
#pragma unroll
        for (int a = 0; a < 2; ++a)
#pragma unroll
            for (int b = 0; b < 2; ++b)
#pragma unroll
                for (int m = 0; m < 4; ++m)
#pragma unroll
                    for (int n = 0; n < 2; ++n) acc[a][b][m][n] = (f32x4){0.f, 0.f, 0.f, 0.f};
        cur = nxt; cA = nA; cB = nB; ++ui;
        if constexpr (ALIGN_EPI) { if (wr == 1) PG8_BAR; }
    }
    PG8_WAIT_V(0);
    if constexpr (!ALIGN_EPI) { if (wr == 0) PG8_BAR; }
    PG8_BAR;
    if constexpr (Epi::AFTER_DRAIN) { E.fused(acc, cur, wr, wc, fr, fq, lds, wid, lane); }
#undef PG8_SA
#undef PG8_SB
#undef PG8_STAGE
#undef PG8_LDA
#undef PG8_LDB
#undef PG8_MMA
#undef PG8_WAIT_V
#undef PG8_WAIT_L
#undef PG8_BAR
#undef PG8_SCHED
}
}
struct EpiIn {
    static constexpr bool PERM = true, AFTER_DRAIN = false;
    unsigned char* ws;
    DI void operator()(const f32x4 (&acc)[2][2][4][2], const pg8::Unit& u, int wr, int wc, int fr, int fq) const {
        bf16_t* P = (bf16_t*)(ws + WS_P); const float* cosH = (const float*)(ws + WS_COSH); const float* sinH = (const float*)(ws + WS_SINH); const float* cosM = (const float*)(ws + WS_COSM); const float* sinM = (const float*)(ws + WS_SINM);
        const int pn = u.pn; const bool ctxt = (u.pm % 33) == 0;
        int mode = 0; float sc = 1.f;
        if ((pn >= 3 && pn <= 10) || (pn >= 15 && pn <= 19)) mode = 1;
        if (pn == 2) mode = 2;
        if ((pn >= 3 && pn <= 6) || (pn >= 15 && pn <= 18)) sc = QS64;
        if (ctxt) mode = 0;
        const int rowt = u.pm * 256 + wr * 64 + fr, colb = pn * 256 + wc * 32 + 8 * fq, posb = (u.pm / 33) * RB + CTX;
#pragma unroll
        for (int ai = 0; ai < 2; ++ai)
#pragma unroll
            for (int m = 0; m < 4; ++m) {
                const int row = rowt + ai * 128 + m * 16; const int pos = row - posb;
                bf16_t* rowp = P + (size_t)row * NP;
#pragma unroll
                for (int bj = 0; bj < 2; ++bj) {
                    const int col0 = colb + bj * 128;
                    f32x4 v0 = acc[ai][bj][m][0], v1 = acc[ai][bj][m][1];
                    if (pn <= 2) {
                        float s8 = (v0[0] * v0[0] + v0[1] * v0[1]) + (v0[2] * v0[2] + v0[3] * v0[3]) + (v1[0] * v1[0] + v1[1] * v1[1]) + (v1[2] * v1[2] + v1[3] * v1[3]);
                        s8 += __shfl_xor(s8, 16); s8 += __shfl_xor(s8, 32);
                        const int slice = pn * 8 + bj * 4 + wc;
                        if (fq == 0 && slice < 20) ((float*)(ws + WS_PART))[(size_t)row * 20 + slice] = s8;
                    }
                    if (mode == 1) { const int p0 = (col0 & 63) >> 1; const f32x4 cs = *(const f32x4*)(cosH + (size_t)pos * 32 + p0), sn = *(const f32x4*)(sinH + (size_t)pos * 32 + p0); rope8(v0, v1, cs, sn); }
                    else if (mode == 2 && col0 >= C_KR && col0 < C_KR + 32) { const int p0 = (col0 - C_KR) >> 1; const f32x4 cs = *(const f32x4*)(cosM + (size_t)pos * 16 + p0), sn = *(const f32x4*)(sinM + (size_t)pos * 16 + p0); rope8(v0, v1, cs, sn); }
                    v0 = v0 * sc; v1 = v1 * sc;
                    const u32x4 w8 = pack8(v0, v1);
                    *(u32x4*)(rowp + col0) = w8;
                    if (pn == 2 && col0 >= C_KR && col0 < C_KR + 32) {
                        bf16_t* km = (bf16_t*)(ws + WS_KM) + (size_t)row * 768 + 64 + (col0 - C_KR);
#pragma unroll
                        for (int h = 0; h < 8; ++h) *(u32x4*)(km + h * 96) = w8;
                    }
                }
            }
    }
};
struct EpiQ {
    static constexpr bool PERM = true, AFTER_DRAIN = false;
    unsigned char* ws;
    DI void operator()(const f32x4 (&acc)[2][2][4][2], const pg8::Unit& u, int wr, int wc, int fr, int fq) const {
        bf16_t* QM = (bf16_t*)(ws + WS_QM); const float* cosM = (const float*)(ws + WS_COSM); const float* sinM = (const float*)(ws + WS_SINM);
        const bool ctxt = (u.pm % 33) == 0;
        const int rowt = u.pm * 256 + wr * 64 + fr, colb = u.pn * 256 + wc * 32 + 8 * fq, posb = (u.pm / 33) * RB + CTX;
#pragma unroll
        for (int ai = 0; ai < 2; ++ai)
#pragma unroll
            for (int m = 0; m < 4; ++m) {
                const int row = rowt + ai * 128 + m * 16; const int pos = row - posb;
                const float* pr = (const float*)(ws + WS_PART) + (size_t)row * 20;
                const f32x4 q0 = *(const f32x4*)pr, q1 = *(const f32x4*)(pr + 4), q2 = *(const f32x4*)(pr + 8);
                const float rq = QS96 / sqrtf((((q0[0] + q0[1]) + (q0[2] + q0[3])) + ((q1[0] + q1[1]) + (q1[2] + q1[3])) + ((q2[0] + q2[1]) + (q2[2] + q2[3]))) * (1.0f / 384.0f) + EPS);
#pragma unroll
                for (int bj = 0; bj < 2; ++bj) {
                    const int col0 = colb + bj * 128, within = col0 % 96;
                    f32x4 v0 = acc[ai][bj][m][0], v1 = acc[ai][bj][m][1];
                    if (!ctxt && within >= 64) { const int p0 = (within - 64) >> 1; const f32x4 cs = *(const f32x4*)(cosM + (size_t)pos * 16 + p0), sn = *(const f32x4*)(sinM + (size_t)pos * 16 + p0); rope8(v0, v1, cs, sn); }
                    v0 = v0 * rq; v1 = v1 * rq;
                    *(u32x4*)(QM + (size_t)row * 768 + col0) = pack8(v0, v1);
                }
                asm volatile("" ::: "memory");
            }
    }
};
struct EpiKV {
    static constexpr bool PERM = true, AFTER_DRAIN = false;
    unsigned char* ws;
    DI void operator()(const f32x4 (&acc)[2][2][4][2], const pg8::Unit& u, int wr, int wc, int fr, int fq) const {
        bf16_t* KM = (bf16_t*)(ws + WS_KM); bf16_t* VM = (bf16_t*)(ws + WS_VM);
        const int rowt = u.pm * 256 + wr * 64 + fr, colb = u.pn * 256 + wc * 32 + 8 * fq;
#pragma unroll
        for (int ai = 0; ai < 2; ++ai)
#pragma unroll
            for (int m = 0; m < 4; ++m) {
                const int row = rowt + ai * 128 + m * 16;
                const float* pr = (const float*)(ws + WS_PART) + (size_t)row * 20 + 12;
                const f32x4 k0 = *(const f32x4*)pr, k1 = *(const f32x4*)(pr + 4);
                const float rkv = 1.0f / sqrtf((((k0[0] + k0[1]) + (k0[2] + k0[3])) + ((k1[0] + k1[1]) + (k1[2] + k1[3]))) * (1.0f / 256.0f) + EPS);
#pragma unroll
                for (int bj = 0; bj < 2; ++bj) {
                    const int col0 = colb + bj * 128;
                    bf16_t* dst = (col0 < 512) ? KM + (size_t)row * 768 + (col0 >> 6) * 96 + (col0 & 63) : VM + (size_t)row * 1024 + (col0 - 512);
                    *(u32x4*)dst = pack8(acc[ai][bj][m][0] * rkv, acc[ai][bj][m][1] * rkv);
                }
                asm volatile("" ::: "memory");
            }
    }
};
template <bool DRYE> struct EpiBrT {
    static constexpr bool PERM = true, AFTER_DRAIN = false;
    unsigned char* ws;
    DI void operator()(const f32x4 (&acc)[2][2][4][2], const pg8::Unit& u, int wr, int wc, int fr, int fq) const {
        bf16_t* P = (bf16_t*)(ws + WS_P);
        unsigned chk = 0u;
        const int rowt = u.pm * 256 + wr * 64 + fr, colb = u.pn * 256 + wc * 32 + 8 * fq;
#pragma unroll
        for (int ai = 0; ai < 2; ++ai)
#pragma unroll
            for (int m = 0; m < 4; ++m) {
                const int row = rowt + ai * 128 + m * 16;
#pragma unroll
                for (int bj = 0; bj < 2; ++bj) {
                    bf16_t* p = P + (size_t)row * NP + C_GM + colb + bj * 128;
                    const u32x4 g = *(const u32x4*)p;
                    f32x4 v0 = acc[ai][bj][m][0], v1 = acc[ai][bj][m][1];
                    v0[0] *= sigm_f(bflo(g.x)); v0[1] *= sigm_f(bfhi(g.x)); v0[2] *= sigm_f(bflo(g.y)); v0[3] *= sigm_f(bfhi(g.y));
                    v1[0] *= sigm_f(bflo(g.z)); v1[1] *= sigm_f(bfhi(g.z)); v1[2] *= sigm_f(bflo(g.w)); v1[3] *= sigm_f(bfhi(g.w));
                    { const u32x4 w_ = pack8(v0, v1); if (!DRYE) *(u32x4*)p = w_; else chk ^= w_.x ^ w_.y ^ w_.z ^ w_.w; }
                }
            }
        if (DRYE && chk == 0x12345678u) *(unsigned*)P = chk;
    }
};
template <bool DRYE> struct EpiOutT {
    static constexpr bool PERM = true, AFTER_DRAIN = false;
    int l, g; const float* xsrc; float* xdst; const float* ctxsrc; unsigned char* ws;
    DI void operator()(const f32x4 (&acc)[2][2][4][2], const pg8::Unit& u, int wr, int wc, int fr, int fq) const {
        float* ctxdst = (float*)(ws + WS_CTX); const float* mod = (const float*)(ws + WS_MOD) + (size_t)l * 9 * 3072;
        const int pmb = u.pm % 33, b = g * GB + u.pm / 33; const bool ctxt = pmb == 0;
        if (ctxt && l != 0) return;
        const float* gate = mod + (size_t)(ctxt ? 8 : b) * 3072 + 2048;
        const int colb = u.pn * 256 + wc * 32 + 8 * fq;
#pragma unroll
        for (int ai = 0; ai < 2; ++ai)
#pragma unroll
            for (int m = 0; m < 4; ++m) {
                const int j = pmb * 256 + ai * 128 + wr * 64 + m * 16 + fr;
                const size_t idx = ctxt ? ((size_t)b * CTX + j) * DM : ((size_t)b * SEQ + (j - CTX)) * DM;
                const float* s = (ctxt ? ctxsrc : xsrc) + idx; float* d = (ctxt ? ctxdst : xdst) + idx;
#pragma unroll
                for (int bj = 0; bj < 2; ++bj) {
                    const int col0 = colb + bj * 128;
                    const f32x4 g0 = *(const f32x4*)(gate + col0), g1 = *(const f32x4*)(gate + col0 + 4);
                    const f32x4 x0 = *(const f32x4*)(s + col0), x1 = *(const f32x4*)(s + col0 + 4);
                    if (!DRYE || x0[0] == 12345.678f) { *(f32x4*)(d + col0) = x0 + g0 * acc[ai][bj][m][0];
                    *(f32x4*)(d + col0 + 4) = x1 + g1 * acc[ai][bj][m][1]; }
                }
            }
    }
};

#define MFMA32(a, b, c) __builtin_amdgcn_mfma_f32_32x32x16_bf16((a), (b), (c), 0, 0, 0)
DI s16x4 tr16(const LAS unsigned char* p) { typedef short v4i16_t __attribute__((ext_vector_type(4))); return __builtin_bit_cast(s16x4, __builtin_amdgcn_ds_read_tr16_b64_v4i16((LAS v4i16_t*)p)); }
constexpr int AT_KOFF = 0, AT_KBUFMAX = 13312, AT_VOFF = 3 * AT_KBUFMAX, AT_VBUFMAX = 20480, AT_SOFF = AT_VOFF + 3 * AT_VBUFMAX, AT_QOFF = AT_SOFF + 1024;
static_assert(AT_QOFF + 8 * 6144 <= LDS_BYTES, "attention LDS map");
#ifndef AT_NEGM
#define AT_NEGM 0
#endif
#ifndef AT_LAZY_THR
#define AT_LAZY_THR 1048576.0f
#endif
#ifndef AT_LAZY
#define AT_LAZY 1
#endif
#ifndef AT_NOPF
#define AT_NOPF 1
#endif
#ifndef AT_IGLP
#define AT_IGLP -1
#endif
#ifndef AT_QLMIN
#define AT_QLMIN 64
#endif
#ifndef AT_PVKS
#define AT_PVKS 2
#endif
#ifndef AT_SGB
#define AT_SGB 0
#endif
#ifndef AT_PV8
#define AT_PV8 1
#endif
#ifndef AT_NOSBAR
#define AT_NOSBAR 1
#endif
#if AT_NOSBAR
#define SBAR() do {} while (0)
#else
#define SBAR() __builtin_amdgcn_sched_barrier(0)
#endif
#ifndef PROBE_MODE
#define PROBE_MODE 0
#endif
#ifndef DRY_SEL
#define DRY_SEL 7
#endif
#ifndef AT_QL
#define AT_QL 0
#endif
#ifndef AT_SB
#define AT_SB 0
#endif
template <int DQK, bool QL, bool NG = false>
DI void at_qkt(f32x16& p0, f32x16& p1, const LAS unsigned char* kb, const bf16x8* qf, const LAS unsigned char* qb, const f32x16* c0 = nullptr) {
    constexpr int KSTR = DQK + 8;
    if (!NG) {
#pragma unroll
        for (int r = 0; r < 16; ++r) { p0[r] = 0.f; p1[r] = 0.f; }
    }
#pragma unroll
    for (int ds = 0; ds < DQK / 16; ++ds) {
        const bf16x8 k0 = *(const LAS bf16x8*)(kb + ds * 32), k1 = *(const LAS bf16x8*)(kb + 32 * (KSTR * 2) + ds * 32);
        bf16x8 q; if (QL) q = *(const LAS bf16x8*)(qb + ds * 1024); else q = qf[ds];
        if (NG && ds == 0) { p0 = MFMA32(k0, q, *c0); p1 = MFMA32(k1, q, *c0); } else { p0 = MFMA32(k0, q, p0); p1 = MFMA32(k1, q, p1); }
        if (AT_SB && DQK > 64 && (ds & 1)) __builtin_amdgcn_sched_barrier(0x7f); }
}
DI void at_mask(f32x16& p0, f32x16& p1, int dk) {
#pragma unroll
    for (int r = 0; r < 16; ++r) { const int d = dk + (r & 3) + 8 * (r >> 2);
        if (d > 128 || d < -128) p0[r] = NEGBIG;
        if (d + 32 > 128 || d + 32 < -128) p1[r] = NEGBIG; }
}
DI void at_psm(f32x16& p0, f32x16& p1, float& mrun, float& alpha) {
    float ma = fmaxf(fmaxf(p0[0], p0[1]), p0[2]), mb = fmaxf(fmaxf(p1[0], p1[1]), p1[2]);
    ma = fmaxf(fmaxf(ma, p0[3]), p1[3]);
#pragma unroll
    for (int r = 4; r < 16; r += 2) { ma = fmaxf(fmaxf(ma, p0[r]), p0[r + 1]); mb = fmaxf(fmaxf(mb, p1[r]), p1[r + 1]); }
    float mx = fmaxf(ma, mb);
    { auto rr = __builtin_amdgcn_permlane32_swap(__float_as_uint(mx), __float_as_uint(mx), false, false); mx = fmaxf(__uint_as_float(rr[0]), __uint_as_float(rr[1])); }
    const bool keep = __all(mx - mrun <= THR);
    const float mn = keep ? mrun : fmaxf(mrun, mx); alpha = __builtin_amdgcn_exp2f(mrun - mn); mrun = mn;
#pragma unroll
    for (int r = 0; r < 16; ++r) { p0[r] -= mrun; p1[r] -= mrun; }
#pragma unroll
    for (int r = 0; r < 16; ++r) p0[r] = __builtin_amdgcn_exp2f(p0[r]);
}
template <int DV> DI void at_scale_o(f32x16* o, LAS float* scw, float val, int r32, int hi);
template <bool NG>
DI void at_psm_lazy(f32x16& p0, f32x16& p1, float mrun) {
    if (!NG) {
#pragma unroll
        for (int r = 0; r < 16; ++r) { p0[r] -= mrun; p1[r] -= mrun; }
    }
#pragma unroll
    for (int r = 0; r < 16; ++r) p0[r] = __builtin_amdgcn_exp2f(p0[r]);
}
template <int DV>
DI void at_fsm_lazy(f32x16& p0, f32x16& p1, float& mrun, float& alpha, float& lrun, bf16x8* pa, f32x16* o, LAS float* scw, int r32, int hi) {
#pragma unroll
    for (int r = 0; r < 16; ++r) p1[r] = __builtin_amdgcn_exp2f(p1[r]);
    float sa = p0[0] + p0[1], sb = p0[2] + p0[3], sc_ = p1[0] + p1[1], sd = p1[2] + p1[3];
#pragma unroll
    for (int r = 4; r < 16; r += 2) { sa = opq(sa) + p0[r]; sb = opq(sb) + p0[r + 1]; sc_ = opq(sc_) + p1[r]; sd = opq(sd) + p1[r + 1]; }
    float ps = (opq(sa) + sb) + (opq(sc_) + sd);
    alpha = 1.f;
    if (__builtin_expect(__any(!(ps <= AT_LAZY_THR)), 0)) {
        float ma = fmaxf(fmaxf(p0[0], p0[1]), p0[2]), mb = fmaxf(fmaxf(p1[0], p1[1]), p1[2]);
        ma = fmaxf(fmaxf(ma, p0[3]), p1[3]);
#pragma unroll
        for (int r = 4; r < 16; r += 2) { ma = fmaxf(fmaxf(ma, p0[r]), p0[r + 1]); mb = fmaxf(fmaxf(mb, p1[r]), p1[r + 1]); }
        float mx = fmaxf(ma, mb);
        { auto rr = __builtin_amdgcn_permlane32_swap(__float_as_uint(mx), __float_as_uint(mx), false, false); mx = fmaxf(__uint_as_float(rr[0]), __uint_as_float(rr[1])); }
        const float d = fmaxf(__builtin_amdgcn_logf(mx), 0.f);
        alpha = __builtin_amdgcn_exp2f(-d); mrun += d; ps *= alpha;
#pragma unroll
        for (int r = 0; r < 16; ++r) { p0[r] *= alpha; p1[r] *= alpha; }
        at_scale_o<DV>(o, scw, alpha, r32, hi);
    }
    lrun = lrun * alpha + ps;
    u32x4 w;
    w.x = pk2(p0[0], p0[1]); w.y = pk2(p0[2], p0[3]); w.z = pk2(p0[4], p0[5]); w.w = pk2(p0[6], p0[7]); pa[0] = __builtin_bit_cast(bf16x8, w);
    w.x = pk2(p0[8], p0[9]); w.y = pk2(p0[10], p0[11]); w.z = pk2(p0[12], p0[13]); w.w = pk2(p0[14], p0[15]); pa[1] = __builtin_bit_cast(bf16x8, w);
    w.x = pk2(p1[0], p1[1]); w.y = pk2(p1[2], p1[3]); w.z = pk2(p1[4], p1[5]); w.w = pk2(p1[6], p1[7]); pa[2] = __builtin_bit_cast(bf16x8, w);
    w.x = pk2(p1[8], p1[9]); w.y = pk2(p1[10], p1[11]); w.z = pk2(p1[12], p1[13]); w.w = pk2(p1[14], p1[15]); pa[3] = __builtin_bit_cast(bf16x8, w);
}
DI void at_fsm(f32x16& p0, f32x16& p1, float alpha, float& lrun, bf16x8* pa) {
#pragma unroll
    for (int r = 0; r < 16; ++r) p1[r] = __builtin_amdgcn_exp2f(p1[r]);
    float ps = 0.f;
#pragma unroll
    for (int r = 0; r < 16; ++r) ps += p0[r] + p1[r];
    lrun = lrun * alpha + ps;
    u32x4 w;
    w.x = pk2(p0[0], p0[1]); w.y = pk2(p0[2], p0[3]); w.z = pk2(p0[4], p0[5]); w.w = pk2(p0[6], p0[7]); pa[0] = __builtin_bit_cast(bf16x8, w);
    w.x = pk2(p0[8], p0[9]); w.y = pk2(p0[10], p0[11]); w.z = pk2(p0[12], p0[13]); w.w = pk2(p0[14], p0[15]); pa[1] = __builtin_bit_cast(bf16x8, w);
    w.x = pk2(p1[0], p1[1]); w.y = pk2(p1[2], p1[3]); w.z = pk2(p1[4], p1[5]); w.w = pk2(p1[6], p1[7]); pa[2] = __builtin_bit_cast(bf16x8, w);
    w.x = pk2(p1[8], p1[9]); w.y = pk2(p1[10], p1[11]); w.z = pk2(p1[12], p1[13]); w.w = pk2(p1[14], p1[15]); pa[3] = __builtin_bit_cast(bf16x8, w);
}
DI void at_fsm_fake(f32x16& p0, f32x16& p1, bf16x8* pa) {
    u32x4 w;
    w.x = pk2(p0[0], p0[1]); w.y = pk2(p0[2], p0[3]); w.z = pk2(p0[4], p0[5]); w.w = pk2(p0[6], p0[7]); pa[0] = __builtin_bit_cast(bf16x8, w);
    w.x = pk2(p0[8], p0[9]); w.y = pk2(p0[10], p0[11]); w.z = pk2(p0[12], p0[13]); w.w = pk2(p0[14], p0[15]); pa[1] = __builtin_bit_cast(bf16x8, w);
    w.x = pk2(p1[0], p1[1]); w.y = pk2(p1[2], p1[3]); w.z = pk2(p1[4], p1[5]); w.w = pk2(p1[6], p1[7]); pa[2] = __builtin_bit_cast(bf16x8, w);
    w.x = pk2(p1[8], p1[9]); w.y = pk2(p1[10], p1[11]); w.z = pk2(p1[12], p1[13]); w.w = pk2(p1[14], p1[15]); pa[3] = __builtin_bit_cast(bf16x8, w);
}
template <int DV>
DI void at_pv(f32x16* o, const LAS unsigned char* vb, const bf16x8* pa) {
    constexpr int VSTR = DV + 32;
#if AT_PVKS == 2
    s16x4 vlo[2][DV / 32], vhi[2][DV / 32];
#pragma unroll
    for (int db = 0; db < DV / 32; ++db) { vlo[0][db] = tr16(vb + db * 64); vhi[0][db] = tr16(vb + 8 * (VSTR * 2) + db * 64); }
#pragma unroll
    for (int ks = 0; ks < 4; ++ks) {
        if (ks < 3) {
#pragma unroll
            for (int db = 0; db < DV / 32; ++db) { vlo[(ks + 1) & 1][db] = tr16(vb + (16 * (ks + 1)) * (VSTR * 2) + db * 64); vhi[(ks + 1) & 1][db] = tr16(vb + (16 * (ks + 1) + 8) * (VSTR * 2) + db * 64); }
        }
#pragma unroll
        for (int db = 0; db < DV / 32; ++db) { const bf16x8 vf = __builtin_shufflevector(vlo[ks & 1][db], vhi[ks & 1][db], 0, 1, 2, 3, 4, 5, 6, 7); o[db] = MFMA32(pa[ks], vf, o[db]); }
    }
#elif AT_PVKS
#else
#pragma unroll
    for (int db = 0; db < DV / 32; ++db) {
        s16x4 vlo[4], vhi[4];
#pragma unroll
        for (int ks = 0; ks < 4; ++ks) { vlo[ks] = tr16(vb + (16 * ks) * (VSTR * 2) + db * 64); vhi[ks] = tr16(vb + (16 * ks + 8) * (VSTR * 2) + db * 64); }
#pragma unroll
        for (int ks = 0; ks < 4; ++ks) { const bf16x8 vf = __builtin_shufflevector(vlo[ks], vhi[ks], 0, 1, 2, 3, 4, 5, 6, 7); o[db] = MFMA32(pa[ks], vf, o[db]); }
    }
#endif
}
template <int DV>
DI void at_scale_o(f32x16* o, LAS float* scw, float val, int r32, int hi) {
    if (hi == 0) scw[r32] = val;
    __builtin_amdgcn_wave_barrier(); asm volatile("" ::: "memory");
#pragma unroll
    for (int g4 = 0; g4 < 4; ++g4) { const f32x4 a4 = *(const LAS f32x4*)(scw + 8 * g4 + 4 * hi);
#pragma unroll
        for (int db = 0; db < DV / 32; ++db) { o[db][4 * g4 + 0] *= a4[0]; o[db][4 * g4 + 1] *= a4[1]; o[db][4 * g4 + 2] *= a4[2]; o[db][4 * g4 + 3] *= a4[3]; } }
    __builtin_amdgcn_wave_barrier(); asm volatile("" ::: "memory");
}
template <int DQK, int DV, int OUTM, bool MASKED>
DI void attn_unit(LAS unsigned char* lds, const bf16_t* Qp, int ldq, const bf16_t* Kp, int ldk, const bf16_t* Vp, int ldv,
                  int nA, int rowB0, int nB, int posB0, int qpos0, float m0, float l0,
                  bf16_t* Og, int ldo, float* Of, int ldof) {
    constexpr int KSTR = DQK + 8, VSTR = DV + 32, KBUF = 64 * KSTR * 2, VBUF = 64 * VSTR * 2;
    constexpr int KCH = DQK / 8, VCH = DV / 8, NKC = 64 * KCH, NVC = 64 * VCH, KRN = (NKC + 511) / 512, VRN = (NVC + 511) / 512;
    static_assert(KBUF <= AT_KBUFMAX && VBUF <= AT_VBUFMAX, "attention LDS map");
    const int tid = tid_l(), lane = tid & 63, wid = __builtin_amdgcn_readfirstlane(tid >> 6), r32 = lane & 31, hi = lane >> 5;
#ifndef AT_QL
#define AT_QL 0
#endif
#ifndef AT_SB
#define AT_SB 0
#endif
    constexpr bool NG = (AT_NEGM == 1 && DQK == 64) || (AT_NEGM == 2 && DQK == 64 && DV == 64);
    constexpr bool QL = AT_QL && (DQK > AT_QLMIN || (NG && DV == 128));
    bf16x8 qf[QL ? 1 : DQK / 16];
    const LAS unsigned char* qb = lds + AT_QOFF + wid * 6144 + lane * 16;
    { const bf16_t* qrow = Qp + (size_t)(32 * wid + r32) * ldq + 8 * hi;
#pragma unroll
      for (int ds = 0; ds < DQK / 16; ++ds) { const bf16x8 v = *(const bf16x8*)(qrow + 16 * ds); if (QL) *(LAS bf16x8*)(lds + AT_QOFF + wid * 6144 + lane * 16 + ds * 1024) = v; else qf[QL ? 0 : ds] = v; }
      if (QL) { __builtin_amdgcn_wave_barrier(); asm volatile("s_waitcnt lgkmcnt(0)" ::: "memory"); } }
    f32x16 o[DV / 32];
#pragma unroll
    for (int db = 0; db < DV / 32; ++db)
#pragma unroll
        for (int r = 0; r < 16; ++r) o[db][r] = 0.f;
    float mrun = m0, lrun = (hi == 0) ? l0 : 0.f;
    LAS float* scw = (LAS float*)(lds + AT_SOFF) + wid * 32;
    const int NT = nA + nB;
    const LAS unsigned char* kb0 = lds + AT_KOFF + r32 * (KSTR * 2) + hi * 16;
    const LAS unsigned char* vb0 = lds + AT_VOFF + (4 * hi + ((lane & 15) >> 2)) * (VSTR * 2) + (16 * ((lane >> 4) & 1) + 4 * (lane & 3)) * 2;
    const int dk0 = posB0 + 4 * hi - (qpos0 + 32 * wid + r32) - 64 * nA;
    u32x4 kreg[KRN], vreg[VRN];
    int kgo[KRN], klo[KRN], vgo[VRN], vlo_[VRN];
#pragma unroll
    for (int i_ = 0; i_ < KRN; ++i_) { int c_ = tid + 512 * i_; if (c_ >= NKC) c_ -= 512; const int r_ = c_ / KCH, cc_ = c_ % KCH; kgo[i_] = r_ * ldk + cc_ * 8; klo[i_] = AT_KOFF + r_ * (KSTR * 2) + cc_ * 16; }
#pragma unroll
    for (int i_ = 0; i_ < VRN; ++i_) { int c_ = tid + 512 * i_; if (c_ >= NVC) c_ -= 512; const int r_ = c_ / VCH, cc_ = c_ % VCH; vgo[i_] = r_ * ldv + cc_ * 8; vlo_[i_] = AT_VOFF + r_ * (VSTR * 2) + cc_ * 16; }
    const __amdgpu_buffer_rsrc_t rK = __builtin_amdgcn_make_buffer_rsrc((void*)Kp, 0, 0x7fffffff, 0x00020000), rV = __builtin_amdgcn_make_buffer_rsrc((void*)Vp, 0, 0x7fffffff, 0x00020000);
#define AT_GLOAD(t) do { const int row0_ = (t) < nA ? 64 * (t) : rowB0 + 64 * ((t) - nA); const int sk_ = row0_ * ldk * 2, sv_ = row0_ * ldv * 2; \
        _Pragma("unroll") for (int i_ = 0; i_ < KRN; ++i_) kreg[i_] = __builtin_amdgcn_raw_buffer_load_b128(rK, kgo[i_] * 2, sk_, 0); \
        _Pragma("unroll") for (int i_ = 0; i_ < VRN; ++i_) vreg[i_] = __builtin_amdgcn_raw_buffer_load_b128(rV, vgo[i_] * 2, sv_, 0); } while (0)
#define AT_SWRITE(buf) do { \
        _Pragma("unroll") for (int i_ = 0; i_ < KRN; ++i_) *(LAS u32x4*)(lds + (buf) * KBUF + klo[i_]) = kreg[i_]; \
        _Pragma("unroll") for (int i_ = 0; i_ < VRN; ++i_) *(LAS u32x4*)(lds + (buf) * VBUF + vlo_[i_]) = vreg[i_]; } while (0)
    unsigned pfv = 0u, pfacc = 0u;
    const int pft = tid & 255;
    const bf16_t* pfb = (pft < 128) ? Kp + (pft >> 1) * ldk + (pft & 1) * (DQK - 2) : Vp + ((pft - 128) >> 1) * ldv + (pft & 1) * (DV - 2);
    const int pfs = (pft < 128) ? ldk : ldv;
    constexpr int PFD = 4;
#if AT_NOPF
#define AT_PF(t) do {} while (0)
#else
#define AT_PF(t) do { pfacc ^= pfv; const int tt_ = (t) < NT ? (t) : NT - 1; const int row0_ = tt_ < nA ? 64 * tt_ : rowB0 + 64 * (tt_ - nA); \
        pfv = *(const unsigned*)(pfb + (size_t)row0_ * pfs); } while (0)
#endif
#define AT_MASK(P0, P1, t) do { if (MASKED && (t) >= nA) { const int kq_ = posB0 + 64 * ((t) - nA) - (qpos0 + 32 * wid); if (kq_ + 63 > 128 || kq_ - 31 < -128) at_mask(P0, P1, dk0 + 64 * (t)); } } while (0)
#define AT_RESC(al) do { if (__any((al) < 1.f)) at_scale_o<DV>(o, scw, (al), r32, hi); } while (0)
    constexpr int DRYP = (OUTM == 2) ? PROBE_MODE : 0;
    f32x16 pA0, pA1, pB0, pB1; float alA, alB; bf16x8 pa[4];
    AT_PF(1); AT_PF(2); AT_PF(3);
    AT_GLOAD(0); AT_SWRITE(0); __syncthreads();
    AT_GLOAD(1);
    at_qkt<DQK, QL>(pA0, pA1, kb0, qf, qb); AT_MASK(pA0, pA1, 0); at_psm(pA0, pA1, mrun, alA);
#if AT_LAZY
    lrun *= alA;
#endif
    AT_SWRITE(1); __syncthreads();
    int bp = 0, bc = 1, bn = 2;
    constexpr int NMF = 2 * (DQK / 16) + 4 * (DV / 32);
#if AT_IGLP >= 0
#define AT_SCHED() __builtin_amdgcn_iglp_opt(AT_IGLP)
#elif AT_SGB
#define AT_SCHED() do { _Pragma("unroll") for (int i_ = 0; i_ < NMF; ++i_) { __builtin_amdgcn_sched_group_barrier(0x008, 1, 0); __builtin_amdgcn_sched_group_barrier(0x100, 2, 0); __builtin_amdgcn_sched_group_barrier(0x002, AT_SGB, 0); } } while (0)
#else
#define AT_SCHED() do {} while (0)
#endif
#define AT_ROT() do { bp = bc; bc = bn; bn = (bn == 2) ? 0 : bn + 1; } while (0)
#if AT_LAZY
    f32x16 negm;
    if (NG) {
#pragma unroll
        for (int r = 0; r < 16; ++r) negm[r] = -mrun;
    }
#define AT_NEGUPD(al, P0, P1) do { if (NG && __any((al) < 1.f)) { const float d_ = -__builtin_amdgcn_logf(al); _Pragma("unroll") for (int r_ = 0; r_ < 16; ++r_) { negm[r_] = -mrun; P0[r_] -= d_; P1[r_] -= d_; } } } while (0)
    for (int j = 1; j + 1 < NT; j += 2) {
        at_qkt<DQK, QL, NG>(pB0, pB1, kb0 + bc * KBUF, qf, qb, &negm); AT_MASK(pB0, pB1, j);
        AT_GLOAD(j + 1);
        at_fsm_lazy<DV>(pA0, pA1, mrun, alA, lrun, pa, o, scw, r32, hi);
        AT_NEGUPD(alA, pB0, pB1);
        at_pv<DV>(o, vb0 + bp * VBUF, pa); at_psm_lazy<NG>(pB0, pB1, mrun);
        AT_SWRITE(bn);
        __syncthreads(); AT_ROT();
        at_qkt<DQK, QL, NG>(pA0, pA1, kb0 + bc * KBUF, qf, qb, &negm); AT_MASK(pA0, pA1, j + 1);
        AT_GLOAD(j + 2);
        at_fsm_lazy<DV>(pB0, pB1, mrun, alB, lrun, pa, o, scw, r32, hi);
        AT_NEGUPD(alB, pA0, pA1);
        at_pv<DV>(o, vb0 + bp * VBUF, pa); at_psm_lazy<NG>(pA0, pA1, mrun);
        AT_SWRITE(bn);
        __syncthreads(); AT_ROT();
    }
    at_qkt<DQK, QL, NG>(pB0, pB1, kb0 + bc * KBUF, qf, qb, &negm); AT_MASK(pB0, pB1, NT - 1);
    at_fsm_lazy<DV>(pA0, pA1, mrun, alA, lrun, pa, o, scw, r32, hi);
    AT_NEGUPD(alA, pB0, pB1);
    at_pv<DV>(o, vb0 + bp * VBUF, pa); at_psm_lazy<NG>(pB0, pB1, mrun);
    at_fsm_lazy<DV>(pB0, pB1, mrun, alB, lrun, pa, o, scw, r32, hi);
    at_pv<DV>(o, vb0 + bc * VBUF, pa);
#else
    for (int j = 1; j + 1 < ((DRYP == 6) ? 2 : NT); j += 2) {
        SBAR(); if (DRYP != 5) at_qkt<DQK, QL>(pB0, pB1, kb0 + bc * KBUF, qf, qb); else { _Pragma("unroll") for (int r_ = 0; r_ < 16; ++r_) { pB0[r_] = o[0][r_] * 1e-3f; pB1[r_] = o[1][r_] * 1e-3f; } } AT_MASK(pB0, pB1, j);
        if (!(DRYP >= 1)) { AT_GLOAD(j + 1); AT_PF(j + PFD); }
        if (DRYP != 3) at_fsm(pA0, pA1, alA, lrun, pa); else at_fsm_fake(pA0, pA1, pa); SBAR();
        if (DRYP != 4) at_pv<DV>(o, vb0 + bp * VBUF, pa); else { o[0][0] += __builtin_bit_cast(float, (int)pa[0][0] + (int)pa[1][1] + (int)pa[2][2] + (int)pa[3][3]); } if (DRYP != 3) at_psm(pB0, pB1, mrun, alB); else alB = 1.f;
        AT_SCHED();
        if (!(DRYP >= 1)) AT_SWRITE(bn);
        AT_RESC(alB); if (DRYP != 2) __syncthreads(); AT_ROT();
        SBAR(); if (DRYP != 5) at_qkt<DQK, QL>(pA0, pA1, kb0 + bc * KBUF, qf, qb); else { _Pragma("unroll") for (int r_ = 0; r_ < 16; ++r_) { pA0[r_] = o[0][r_] * 1e-3f; pA1[r_] = o[1][r_] * 1e-3f; } } AT_MASK(pA0, pA1, j + 1);
        if (!(DRYP >= 1)) { AT_GLOAD(j + 2); AT_PF(j + 1 + PFD); }
        if (DRYP != 3) at_fsm(pB0, pB1, alB, lrun, pa); else at_fsm_fake(pB0, pB1, pa); SBAR();
        if (DRYP != 4) at_pv<DV>(o, vb0 + bp * VBUF, pa); else { o[0][0] += __builtin_bit_cast(float, (int)pa[0][0] + (int)pa[1][1] + (int)pa[2][2] + (int)pa[3][3]); } if (DRYP != 3) at_psm(pA0, pA1, mrun, alA); else alA = 1.f;
        AT_SCHED();
        if (!(DRYP >= 1)) AT_SWRITE(bn);
        AT_RESC(alA); if (DRYP != 2) __syncthreads(); AT_ROT();
    }
    SBAR(); at_qkt<DQK, QL>(pB0, pB1, kb0 + bc * KBUF, qf, qb); AT_MASK(pB0, pB1, NT - 1);
    at_fsm(pA0, pA1, alA, lrun, pa); SBAR();
    at_pv<DV>(o, vb0 + bp * VBUF, pa); at_psm(pB0, pB1, mrun, alB);
    AT_RESC(alB);
    at_fsm(pB0, pB1, alB, lrun, pa); SBAR();
    at_pv<DV>(o, vb0 + bc * VBUF, pa);
#endif
#undef AT_ROT
#ifdef AT_NEGUPD
#undef AT_NEGUPD
#endif
#undef AT_SCHED
    pfacc ^= pfv;
    if (__builtin_expect(pfacc == 0x9e3779b9u && lrun == 12345.678f, 0)) scw[0] = 1.f;
#undef AT_GLOAD
#undef AT_PF
#undef AT_SWRITE
#undef AT_MASK
#undef AT_RESC
    { const float lt = lrun + __shfl_xor(lrun, 32); at_scale_o<DV>(o, scw, 1.0f / lt, r32, hi); }
    if (OUTM == 0) {
        static_assert(!(AT_QL), "the output staging tile re-uses the Q park area");
        LAS float* st = (LAS float*)(lds + AT_QOFF + wid * 6144);
#pragma unroll
        for (int db = 0; db < DV / 32; ++db) {
#pragma unroll
            for (int r = 0; r < 16; ++r) st[((r & 3) + 8 * (r >> 2) + 4 * hi) * 36 + r32] = o[db][r];
            __builtin_amdgcn_wave_barrier(); asm volatile("s_waitcnt lgkmcnt(0)" ::: "memory");
#pragma unroll
            for (int i = 0; i < 2; ++i) {
                const int c = lane + 64 * i, row = c >> 2, cc = c & 3;
                f32x4 a = *(const LAS f32x4*)(st + row * 36 + cc * 8), b = *(const LAS f32x4*)(st + row * 36 + cc * 8 + 4);
                bf16_t* gp = Og + (size_t)(32 * wid + row) * ldo + 32 * db + cc * 8;
                const u32x4 z = *(const u32x4*)gp;
                a[0] *= silu_f(bflo(z.x)); a[1] *= silu_f(bfhi(z.x)); a[2] *= silu_f(bflo(z.y)); a[3] *= silu_f(bfhi(z.y));
                b[0] *= silu_f(bflo(z.z)); b[1] *= silu_f(bfhi(z.z)); b[2] *= silu_f(bflo(z.w)); b[3] *= silu_f(bfhi(z.w));
                *(u32x4*)gp = pack8(a, b);
            }
            __builtin_amdgcn_wave_barrier(); asm volatile("s_waitcnt lgkmcnt(0)" ::: "memory");
        }
    } else {
#pragma unroll
        for (int db = 0; db < DV / 32; ++db)
#pragma unroll
            for (int r = 0; r < 16; ++r) {
                const int q = (r & 3) + 8 * (r >> 2) + 4 * hi;
                if (OUTM == 1) { Of[(size_t)(32 * wid + q) * ldof + 32 * db + r32] = o[db][r]; }
                else { if (lrun == 12345.678f) Of[(size_t)(32 * wid + q) * ldof + 32 * db + r32] = o[db][r]; }
            }
    }
    __syncthreads();
}

struct Args { const float* in[21]; float* out; unsigned char* ws; };
typedef const __attribute__((address_space(4))) Args* ArgsP;
DI ArgsP args_ptr() { ArgsP p = (ArgsP)__builtin_amdgcn_kernarg_segment_ptr(); asm volatile("" : "+s"(p)); return p; }
enum { I_X = 0, I_C, I_CTX, I_CCTX, I_WMOD, I_BMOD, I_NORMG, I_WIN, I_QNORM, I_WUQ, I_KVNORM, I_WUKV, I_LQ1, I_LK1, I_LQ2, I_LK2, I_SUBLN, I_SINK, I_WBR, I_WOUT, I_FNORM };

DI int colmap(int kind, int n) {
    if (kind == 1) {
        if (n < C_KR) return n;
        if (n < C_KR + 32) { const int e = n - C_KR; return C_KR + (e >> 1) + 16 * (e & 1); }
        if (n < C_DQ) return -1;
        if ((n >= C_DQ && n < C_DV) || (n >= C_SQ && n < C_SV)) { const int w = n & 63; return (n - w) - 96 + (w >> 1) + 32 * (w & 1); }
        return n - 96;
    }
    if (kind == 2) { const int h = n / 96, e = n % 96; if (e < 64) return n; const int e2 = e - 64; return h * 96 + 64 + (e2 >> 1) + 16 * (e2 & 1); }
    if (kind == 3) { if (n < 512) return (n >> 6) * 192 + (n & 63); const int n2 = n - 512; return (n2 >> 7) * 192 + 64 + (n2 & 127); }
    return n;
}
DI void transpose_item(const float* W, int ldw, int kind, const float* rowscale, bf16_t* WT, int ldd, int koff, LAS float* scr, int item, int nblk, int lane) {
    const int kb = item / nblk, nb = item % nblk, k0 = 64 * kb, n0 = 32 * nb;
    const int oc = colmap(kind, n0 + (lane & 31));
#pragma unroll 8
    for (int i = 0; i < 32; ++i) { const int kk = 2 * i + (lane >> 5); float v = 0.f; if (oc >= 0) v = W[(size_t)(k0 + kk) * ldw + oc]; if (rowscale) v *= rowscale[k0 + kk]; scr[kk * 33 + (lane & 31)] = v; }
    __builtin_amdgcn_wave_barrier(); asm volatile("s_waitcnt lgkmcnt(0)" ::: "memory");
    const int c = lane & 7;
#pragma unroll
    for (int j = 0; j < 4; ++j) { const int n = (lane >> 3) + 8 * j; const LAS float* s = scr + (8 * c) * 33 + n;
        u32x4 o; o.x = pk2(s[0 * 33], s[1 * 33]); o.y = pk2(s[2 * 33], s[3 * 33]); o.z = pk2(s[4 * 33], s[5 * 33]); o.w = pk2(s[6 * 33], s[7 * 33]);
        *(u32x4*)(WT + (size_t)(n0 + n) * ldd + koff + k0 + 8 * c) = o; }
    __builtin_amdgcn_wave_barrier(); asm volatile("s_waitcnt lgkmcnt(0)" ::: "memory");
}
DI void prologue(ArgsP ap, LAS unsigned char* lds) {
    const int tid = tid_l(), lane = tid & 63, wid = __builtin_amdgcn_readfirstlane(tid >> 6);
    unsigned char* ws = ap->ws;
    LAS float* scr = (LAS float*)(lds + wid * 8448);
    const int gw = bid_l() * 8 + wid, NGW = grd_l() * 8;
    constexpr int I_IN = 16 * (NP / 32), I_UQ = 6 * 24, I_UKV = 4 * 48, I_SQ = 16 * 32, PER_L = I_IN + I_UQ + I_UKV + 6 * I_SQ;
    for (int it = gw; it < 2 * PER_L; it += NGW) {
        const int l = it / PER_L; int r = it % PER_L;
        if (r < I_IN) { transpose_item(ap->in[I_WIN] + (size_t)l * 1024 * D_IN, D_IN, 1, nullptr, (bf16_t*)(ws + WS_WIN) + (size_t)l * NP * 1024, 1024, 0, scr, r, NP / 32, lane); continue; } r -= I_IN;
        if (r < I_UQ) { transpose_item(ap->in[I_WUQ] + (size_t)l * 384 * 768, 768, 2, ap->in[I_QNORM] + l * 384, (bf16_t*)(ws + WS_WUQ) + (size_t)l * 768 * 384, 384, 0, scr, r, 24, lane); continue; } r -= I_UQ;
        if (r < I_UKV) { transpose_item(ap->in[I_WUKV] + (size_t)l * 256 * 1536, 1536, 3, ap->in[I_KVNORM] + l * 256, (bf16_t*)(ws + WS_WUKV) + (size_t)l * 1536 * 256, 256, 0, scr, r, 48, lane); continue; } r -= I_UKV;
        if (r < 3 * I_SQ) { const int br = r / I_SQ; transpose_item(ap->in[I_WBR] + ((size_t)l * 3 + br) * 1024 * 1024, 1024, 0, nullptr, (bf16_t*)(ws + WS_WB) + ((size_t)l * 3 + br) * 1024 * 1024, 1024, 0, scr, r % I_SQ, 32, lane); continue; } r -= 3 * I_SQ;
        { const int rep = r / I_SQ; transpose_item(ap->in[I_WOUT] + (size_t)l * 1024 * 1024, 1024, 0, nullptr, (bf16_t*)(ws + WS_WO3) + (size_t)l * 1024 * 3072, 3072, rep * 1024, scr, r % I_SQ, 32, lane); }
    }
    const int gt = bid_l() * 512 + tid, NGT = grd_l() * 512;
    for (int i = gt; i < SEQ * 48; i += NGT) {
        const int pos = i / 48, p = i % 48; const float frow = (float)(pos >> 6), fcol = (float)(pos & 63);
        float ang; float* cd; float* sd;
        if (p < 32) { const int f = p & 15; const float inv = powf(10000.0f, -(float)f / 16.0f); ang = (p < 16 ? frow : fcol) * inv; cd = (float*)(ws + WS_COSH) + pos * 32 + p; sd = (float*)(ws + WS_SINH) + pos * 32 + p; }
        else { const int pp = p - 32, f = pp & 7; const float inv = powf(10000.0f, -(float)f / 8.0f); ang = (pp < 8 ? frow : fcol) * inv; cd = (float*)(ws + WS_COSM) + pos * 16 + pp; sd = (float*)(ws + WS_SINM) + pos * 16 + pp; }
        *cd = __cosf(ang); *sd = __sinf(ang);
    }
    for (int it = gw; it < 2 * 16 * 48; it += NGW) {
        const int l = it / 768, rem = it % 768, kc = rem / 48, nb = rem % 48; const int k = kc * 64 + lane;
        float sv[9];
#pragma unroll
        for (int v = 0; v < 8; ++v) sv[v] = silu_f(ap->in[I_C][v * 1024 + k]);
        sv[8] = silu_f(ap->in[I_CCTX][k]);
        float acc[9];
#pragma unroll
        for (int v = 0; v < 9; ++v) acc[v] = 0.f;
        const float* w = ap->in[I_WMOD] + ((size_t)l * 1024 + kc * 64) * 3072 + nb * 64 + lane;
#pragma unroll 8
        for (int kk = 0; kk < 64; ++kk) { const float wv = w[(size_t)kk * 3072];
#pragma unroll
            for (int v = 0; v < 9; ++v) acc[v] += __uint_as_float(__builtin_amdgcn_readlane(__float_as_uint(sv[v]), kk)) * wv; }
        float* mp = (float*)(ws + WS_MODP) + ((size_t)(l * 16 + kc) * 9) * 3072 + nb * 64 + lane;
#pragma unroll
        for (int v = 0; v < 9; ++v) mp[(size_t)v * 3072] = acc[v];
    }
}
DI void mod_finalize(ArgsP ap) {
    const int tid = tid_l();
    const int gt = bid_l() * 512 + tid, NGT = grd_l() * 512;
    const float* mp = (const float*)(ap->ws + WS_MODP); float* mod = (float*)(ap->ws + WS_MOD);
    for (int i = gt; i < 2 * 9 * 3072; i += NGT) {
        const int l = i / (9 * 3072), rem = i % (9 * 3072), n = rem % 3072;
        float s = ap->in[I_BMOD][l * 3072 + n];
#pragma unroll
        for (int kc = 0; kc < 16; ++kc) s += mp[(size_t)(l * 16 + kc) * 9 * 3072 + rem];
        mod[i] = s;
    }
}
DI void ph_norm_mod(ArgsP ap, int l, int g) {
    const int tid = tid_l(), lane = tid & 63, wid = __builtin_amdgcn_readfirstlane(tid >> 6);
    const int gw = bid_l() * 8 + wid, NGW = grd_l() * 8;
    const float* ng = ap->in[I_NORMG] + l * 1024; const float* mod = (const float*)(ap->ws + WS_MOD) + (size_t)l * 9 * 3072;
    const float* xs = (l == 0) ? ap->in[I_X] : ap->out; const float* cs = (l == 0) ? ap->in[I_CTX] : (const float*)(ap->ws + WS_CTX);
    bf16_t* H = (bf16_t*)(ap->ws + WS_H);
    for (int r = gw; r < R; r += NGW) {
        const int bl = r / RB, j = r % RB, b = g * GB + bl;
        const float* src; const float* md;
        if (j < CTX) { src = cs + ((size_t)b * CTX + j) * DM; md = mod + 8 * 3072; } else { src = xs + ((size_t)b * SEQ + (j - CTX)) * DM; md = mod + (size_t)b * 3072; }
        f32x4 v[4]; float ss = 0.f;
#pragma unroll
        for (int q = 0; q < 4; ++q) { v[q] = *(const f32x4*)(src + 4 * (lane + 64 * q)); ss += (v[q][0] * v[q][0] + v[q][1] * v[q][1]) + (v[q][2] * v[q][2] + v[q][3] * v[q][3]); }
        const float rstd = 1.0f / sqrtf(wave_sum(ss) * (1.0f / DM) + EPS);
#pragma unroll
        for (int q = 0; q < 4; ++q) { const int idx = 4 * (lane + 64 * q);
            const f32x4 gg = *(const f32x4*)(ng + idx), sh = *(const f32x4*)(md + idx), sc = *(const f32x4*)(md + 1024 + idx);
            const f32x4 y = (v[q] * rstd * gg) * (sc + 1.0f) + sh;
            u32x2 w; w.x = pk2(y[0], y[1]); w.y = pk2(y[2], y[3]); *(u32x2*)(H + (size_t)r * DM + idx) = w; }
    }
}
DI void ph_mla_norm(ArgsP ap) {
    const int tid = tid_l(), lane = tid & 63, wid = __builtin_amdgcn_readfirstlane(tid >> 6);
    const int gw = bid_l() * 8 + wid, NGW = grd_l() * 8;
    const bf16_t* P = (const bf16_t*)(ap->ws + WS_P); bf16_t* AQ = (bf16_t*)(ap->ws + WS_AQ); bf16_t* AKV = (bf16_t*)(ap->ws + WS_AKV); bf16_t* KM = (bf16_t*)(ap->ws + WS_KM);
    for (int r = gw; r < R; r += NGW) {
        const bf16_t* row = P + (size_t)r * NP;
        const u32x4 c0 = *(const u32x4*)(row + 8 * lane);
        u32x4 c1 = {0u, 0u, 0u, 0u}; if (lane < 20) c1 = *(const u32x4*)(row + 8 * (64 + lane));
        float f0[8] = {bflo(c0.x), bfhi(c0.x), bflo(c0.y), bfhi(c0.y), bflo(c0.z), bfhi(c0.z), bflo(c0.w), bfhi(c0.w)};
        float f1[8] = {bflo(c1.x), bfhi(c1.x), bflo(c1.y), bfhi(c1.y), bflo(c1.z), bfhi(c1.z), bflo(c1.w), bfhi(c1.w)};
        float s0 = 0.f, s1 = 0.f;
#pragma unroll
        for (int i = 0; i < 8; ++i) { s0 += f0[i] * f0[i]; s1 += f1[i] * f1[i]; }
        const float sq = wave_sum(lane < 48 ? s0 : 0.f);
        const float skv = wave_sum((lane >= 48 ? s0 : 0.f) + (lane < 16 ? s1 : 0.f));
        const float rq = 1.0f / sqrtf(sq * (1.0f / 384.0f) + EPS), rkv = 1.0f / sqrtf(skv * (1.0f / 256.0f) + EPS);
        { const float rr = lane < 48 ? rq : rkv; u32x4 w; w.x = pk2(f0[0] * rr, f0[1] * rr); w.y = pk2(f0[2] * rr, f0[3] * rr); w.z = pk2(f0[4] * rr, f0[5] * rr); w.w = pk2(f0[6] * rr, f0[7] * rr);
          if (lane < 48) *(u32x4*)(AQ + (size_t)r * 384 + 8 * lane) = w; else *(u32x4*)(AKV + (size_t)r * 256 + 8 * (lane - 48)) = w; }
        if (lane < 16) { u32x4 w; w.x = pk2(f1[0] * rkv, f1[1] * rkv); w.y = pk2(f1[2] * rkv, f1[3] * rkv); w.z = pk2(f1[4] * rkv, f1[5] * rkv); w.w = pk2(f1[6] * rkv, f1[7] * rkv);
            *(u32x4*)(AKV + (size_t)r * 256 + 8 * (16 + lane)) = w; }
        else if (lane < 20) {
#pragma unroll
            for (int h = 0; h < 8; ++h) *(u32x4*)(KM + (size_t)r * 768 + h * 96 + 64 + 8 * (lane - 16)) = c1; }
    }
}
template <bool DRYE>
DI void ph_diff_post(ArgsP ap, int l) {
    const int tid = tid_l(), lane = tid & 63, wid = __builtin_amdgcn_readfirstlane(tid >> 6);
    const int gw = bid_l() * 8 + wid, NGW = grd_l() * 8;
    const float lam_init = (l == 0) ? 0.2f : (0.8f - 0.6f * 0.7408182206817179f);
    const float d1 = wave_sum(ap->in[I_LQ1][l * 64 + lane] * ap->in[I_LK1][l * 64 + lane]), d2 = wave_sum(ap->in[I_LQ2][l * 64 + lane] * ap->in[I_LK2][l * 64 + lane]);
    const float lam = expf(d1) - expf(d2) + lam_init;
    const float sl0 = ap->in[I_SUBLN][l * 128 + 2 * lane] * (1.0f - lam_init), sl1 = ap->in[I_SUBLN][l * 128 + 2 * lane + 1] * (1.0f - lam_init);
    const float* OD = (const float*)(ap->ws + WS_OD); bf16_t* P = (bf16_t*)(ap->ws + WS_P);
    typedef float f32x2 __attribute__((ext_vector_type(2)));
    for (int r = gw; r < R; r += NGW) {
        if (l != 0 && (r % RB) < CTX) continue;
        const float* ob = OD + (size_t)r * 2048 + 2 * lane; unsigned* zb = (unsigned*)(P + (size_t)r * NP + C_Z + 1024 + 2 * lane);
        f32x2 o1[8], o2[8]; unsigned z[8];
#pragma unroll
        for (int h = 0; h < 8; ++h) { o1[h] = *(const f32x2*)(ob + (2 * h) * 128); o2[h] = *(const f32x2*)(ob + (2 * h + 1) * 128); z[h] = zb[h * 64]; }
#pragma unroll
        for (int h = 0; h < 8; ++h) {
            const float a0 = o1[h][0] - lam * o2[h][0], a1 = o1[h][1] - lam * o2[h][1];
            const float rstd = 1.0f / sqrtf(wave_sum(a0 * a0 + a1 * a1) * (1.0f / 128.0f) + EPS);
            if (!DRYE || rstd == 12345.678f) zb[h * 64] = pk2(a0 * rstd * sl0 * silu_f(bflo(z[h])), a1 * rstd * sl1 * silu_f(bfhi(z[h])));
        }
    }
}
template <bool DRYE>
DI void ph_final_norm(ArgsP ap) {
    const int tid = tid_l(), lane = tid & 63, wid = __builtin_amdgcn_readfirstlane(tid >> 6);
    const int gw = bid_l() * 8 + wid, NGW = grd_l() * 8; const float* fg = ap->in[I_FNORM];
    for (int r = gw; r < NBATCH * SEQ; r += NGW) {
        float* row = ap->out + (size_t)r * DM; f32x4 v[4]; float ss = 0.f;
#pragma unroll
        for (int q = 0; q < 4; ++q) { v[q] = *(const f32x4*)(row + 4 * (lane + 64 * q)); ss += (v[q][0] * v[q][0] + v[q][1] * v[q][1]) + (v[q][2] * v[q][2] + v[q][3] * v[q][3]); }
        const float rstd = 1.0f / sqrtf(wave_sum(ss) * (1.0f / DM) + EPS);
#pragma unroll
        for (int q = 0; q < 4; ++q) { const int idx = 4 * (lane + 64 * q); if (!DRYE || rstd == 12345.678f) *(f32x4*)(row + idx) = v[q] * rstd * *(const f32x4*)(fg + idx); }
    }
}
template <bool DRY>
DI void ph_attention(ArgsP ap, int l, LAS unsigned char* lds) {
    constexpr int OM0 = DRY ? 2 : 0;
    const int G = grd_l(), bx = bid_l(), vcu = (G % 8 == 0) ? (bx % 8) * (G / 8) + bx / 8 : bx;
    bf16_t* P = (bf16_t*)(ap->ws + WS_P); const bf16_t* QM = (const bf16_t*)(ap->ws + WS_QM); const bf16_t* KM = (const bf16_t*)(ap->ws + WS_KM); const bf16_t* VM = (const bf16_t*)(ap->ws + WS_VM);
    float* OD = (float*)(ap->ws + WS_OD); const float* sink = ap->in[I_SINK] + l * 16;
#if !defined(ATT_ONLY) || ATT_ONLY == 1
    if (!DRY || (DRY_SEL & 1))
    for (int u = vcu; u < GB * 8 * 32; u += G) { const int bh = u >> 5, qb = u & 31, bl = bh >> 3, h = bh & 7; const size_t rb = (size_t)bl * RB, q0 = rb + CTX + 256 * qb;
        attn_unit<96, 128, OM0, false>(lds, QM + q0 * 768 + h * 96, 768, KM + rb * 768 + h * 96, 768, VM + rb * 1024 + h * 128, 1024, RB / 64, 0, 0, 0, 0, NEGBIG, 0.f, P + q0 * NP + C_Z + h * 128, NP, OD, 0); }
#endif
#if !defined(ATT_ONLY) || ATT_ONLY == 2
    if (!DRY || (DRY_SEL & 2))
    for (int u = vcu; u < GB * 16 * 32; u += G) { const int bh = u >> 5, qb = u & 31, bl = bh >> 4, hm = bh & 15; const size_t rb = (size_t)bl * RB, q0 = rb + CTX + 256 * qb;
        attn_unit<64, 128, 1, false>(lds, P + q0 * NP + C_DQ + hm * 64, NP, P + rb * NP + C_DK + hm * 64, NP, P + rb * NP + C_DV + (hm >> 1) * 128, NP, RB / 64, 0, 0, 0, 0, NEGBIG, 0.f, nullptr, 0, OD + q0 * 2048 + hm * 128, 2048); }
#endif
#if !defined(ATT_ONLY) || ATT_ONLY == 3
    if (!DRY || (DRY_SEL & 4))
    for (int u = vcu; u < GB * 16 * 32; u += G) { const int bh = u >> 5, qb = u & 31, bl = bh >> 4, h = bh & 15; const size_t rb = (size_t)bl * RB, q0 = rb + CTX + 256 * qb;
        const int lo = (256 * qb - 128 < 0) ? 0 : 256 * qb - 128, hi = (256 * qb + 384 > SEQ) ? SEQ : 256 * qb + 384;
        attn_unit<64, 64, OM0, true>(lds, P + q0 * NP + C_SQ + h * 64, NP, P + rb * NP + C_SK + (h >> 2) * 64, NP, P + rb * NP + C_SV + (h >> 2) * 64, NP, CTX / 64, CTX + lo, (hi - lo) / 64, lo, 256 * qb, sink[h] * LOG2E, 1.0f,
                              P + q0 * NP + C_Z + 2048 + h * 64, NP, OD, 0); }
#endif
#if !defined(ATT_ONLY)
    if (l == 0) {
        for (int u = vcu; u < GB * 40; u += G) { const int bl = u / 40, k = u % 40; const size_t rb = (size_t)bl * RB;
            if (k < 8) { const int h = k;
                attn_unit<96, 128, OM0, false>(lds, QM + rb * 768 + h * 96, 768, KM + rb * 768 + h * 96, 768, VM + rb * 1024 + h * 128, 1024, CTX / 64, 0, 0, 0, 0, NEGBIG, 0.f, P + rb * NP + C_Z + h * 128, NP, OD, 0); }
            else if (k < 24) { const int hm = k - 8;
                attn_unit<64, 128, 1, false>(lds, P + rb * NP + C_DQ + hm * 64, NP, P + rb * NP + C_DK + hm * 64, NP, P + rb * NP + C_DV + (hm >> 1) * 128, NP, CTX / 64, 0, 0, 0, 0, NEGBIG, 0.f, nullptr, 0, OD + rb * 2048 + hm * 128, 2048); }
            else { const int h = k - 24;
                attn_unit<64, 64, OM0, false>(lds, P + rb * NP + C_SQ + h * 64, NP, P + rb * NP + C_SK + (h >> 2) * 64, NP, P + rb * NP + C_SV + (h >> 2) * 64, NP, CTX / 64, 0, 0, 0, 0, sink[h] * LOG2E, 1.0f, P + rb * NP + C_Z + 2048 + h * 64, NP, OD, 0); }
        }
    }
#endif
}

#define RLX_AGENT __ATOMIC_RELAXED, __HIP_MEMORY_SCOPE_AGENT
#define XB_TMO      128
#define XB_XCNT(j)  (256  + 64 * (j))
#define XB_XSUB(j)  (1280 + 64 * (j))
#define XB_XGEN(j)  (2304 + 64 * (j))
#define XB_TOP      3328
#define XB_TOPGEN   3392
#define XCD_BAR_WORDS 3456
#define XB_SPIN_CAP (1u << 18)

__device__ __forceinline__ unsigned xb_ld(unsigned* p)              { return __hip_atomic_load(p, __ATOMIC_RELAXED, __HIP_MEMORY_SCOPE_AGENT); }
__device__ __forceinline__ unsigned xb_add(unsigned* p, unsigned v) { return __hip_atomic_fetch_add(p, v, __ATOMIC_RELAXED, __HIP_MEMORY_SCOPE_AGENT); }
__device__ __forceinline__ unsigned xb_xcc_id() { return (unsigned)__builtin_amdgcn_s_getreg((3 << 11) | 20) & 0xFu; }
#define XB_SPIN(cond, bar) do { unsigned _sp = 0; while (cond) { __builtin_amdgcn_s_sleep(1); \
    if ((++_sp & 255u) == 0u) { if (xb_ld(&(bar)[XB_TMO])) break; if (_sp > XB_SPIN_CAP) { atomicAdd(&(bar)[XB_TMO], 1u); break; } } } } while (0)

struct XcdBarrier {
    unsigned* bar; unsigned x;
    volatile LAS unsigned* st;
};

__device__ __forceinline__ XcdBarrier xcd_barrier_post(unsigned* bar, volatile LAS unsigned* st) {
    XcdBarrier b; b.bar = bar; b.x = xb_xcc_id(); b.st = st;
    if (threadIdx.x == 0) (void)xb_add(&bar[XB_XCNT(b.x)], 1u);
    return b;
}
__device__ __forceinline__ void xcd_barrier_complete(unsigned* bar, unsigned x, unsigned& nloc, unsigned& nx) {
    const unsigned G = gridDim.x * gridDim.y * gridDim.z;
    unsigned sum, cnt, mine, sp = 0u;
    for (;;) {
        sum = 0u; cnt = 0u; mine = 0u;
#pragma unroll
        for (unsigned j = 0; j < 16; ++j) { const unsigned c = xb_ld(&bar[XB_XCNT(j)]); sum += c; cnt += (c > 0u) ? 1u : 0u; mine = (j == x) ? c : mine; }
        if (sum == G) break;
        __builtin_amdgcn_s_sleep(1);
        if ((++sp & 255u) == 0u) { if (xb_ld(&bar[XB_TMO])) break; if (sp > XB_SPIN_CAP) { atomicAdd(&bar[XB_TMO], 1u); break; } }
    }
    nloc = mine > 0u ? mine : 1u; nx = cnt > 0u ? cnt : 1u;
}

__device__ __forceinline__ void xcd_barrier(const XcdBarrier& b) {
    asm volatile("s_waitcnt vmcnt(0)" ::: "memory");
    __syncthreads();
    if (threadIdx.x == 0) {
        unsigned* bar = b.bar;
        __builtin_amdgcn_s_waitcnt(0);
        unsigned nloc = b.st[0], nx = b.st[1];
        if (nloc == 0u) { xcd_barrier_complete(bar, b.x, nloc, nx); b.st[0] = nloc; b.st[1] = nx; }
        const unsigned old = xb_add(&bar[XB_XSUB(b.x)], 1u);
        const unsigned gen = old / nloc;
        if (old + 1u == (gen + 1u) * nloc) {
            __builtin_amdgcn_fence(__ATOMIC_RELEASE, "agent");
            asm volatile("s_waitcnt vmcnt(0)" ::: "memory");
            const unsigned og = xb_add(&bar[XB_TOP], 1u);
            const unsigned tg = og / nx;
            if (og + 1u == (tg + 1u) * nx) xb_add(&bar[XB_TOPGEN], 1u);
            else XB_SPIN(xb_ld(&bar[XB_TOPGEN]) == tg, bar);
            __builtin_amdgcn_fence(__ATOMIC_ACQUIRE, "agent");
            xb_add(&bar[XB_XGEN(b.x)], 1u);
            asm volatile("s_waitcnt vmcnt(0)" ::: "memory");
        } else {
            XB_SPIN(xb_ld(&bar[XB_XGEN(b.x)]) == gen, bar);
            __builtin_amdgcn_fence(__ATOMIC_ACQUIRE, "agent");
            asm volatile("s_waitcnt vmcnt(0)" ::: "memory");
        }
    }
    __syncthreads();
}


__global__ void __launch_bounds__(512, 2) hybrid_fwd(Args a_unused) {
    extern __shared__ __attribute__((aligned(16))) unsigned char lds_raw[];
    LAS unsigned char* lds = (LAS unsigned char*)lds_raw;
    cg::grid_group grid = cg::this_grid();
    { volatile LAS unsigned* xst = (volatile LAS unsigned*)(lds + XB_LDS_OFF);
      if (threadIdx.x < 2) xst[threadIdx.x] = 0u;
      __syncthreads();
      (void)xcd_barrier_post((unsigned*)(args_ptr()->ws), xst); }
#define GSYNC() do { XcdBarrier b_; b_.bar = (unsigned*)(args_ptr()->ws); b_.x = xb_xcc_id(); b_.st = (volatile LAS unsigned*)(lds + XB_LDS_OFF); xcd_barrier(b_); } while (0)
#ifndef NO_PRO
    prologue(args_ptr(), lds);
#ifdef PROBE_PRO
    __syncthreads(); prologue(args_ptr(), lds);
#endif
#endif
    grid.sync();
    mod_finalize(args_ptr());
    GSYNC();
    for (int l = 0; l < 2; ++l) {
        for (int g = 0; g < NGRP; ++g) {
            ph_norm_mod(args_ptr(), lnd(l), lnd(g));
#ifdef PROBE_R1
            GSYNC(); ph_norm_mod(args_ptr(), lnd(l), lnd(g));
#endif
            GSYNC();
#ifndef NO_GEMM
            {
                unsigned char* ws = args_ptr()->ws; const int G = grd_l(), bx = bid_l();
                pg8::Gemm gm{1024, 1024, 1024}; pg8::Order S; S.init(R, NP, G, bx, ws + WS_H, 1024, (bf16_t*)(ws + WS_WIN) + (size_t)l * NP * 1024, 1024, 1 << 20, 0);
                EpiIn E{ws};
                pg8::gemm_phase<EpiIn, pg8::Order, true, true>(lds, gm, S, E);
#ifdef PROBE_G1
                __syncthreads(); pg8::gemm_phase<EpiIn, pg8::Order, true, true>(lds, gm, S, E);
#endif
            }
#endif
            GSYNC();
#ifndef NO_GEMM2
            {
                unsigned char* ws = args_ptr()->ws; const int G = grd_l(), bx = bid_l();
                pg8::Gemm gq{384, NP, 384}; pg8::Order Sq; Sq.init(R, 768, G, bx, (bf16_t*)(ws + WS_P) + C_QC, NP, (bf16_t*)(ws + WS_WUQ) + (size_t)l * 768 * 384, 384, 1 << 20, 0);
                EpiQ Eq{ws};
#ifndef NO_GQ
                pg8::gemm_phase<EpiQ, pg8::Order, true, true>(lds, gq, Sq, Eq);
#ifdef PROBE_G2
                __syncthreads(); pg8::gemm_phase<EpiQ, pg8::Order, true, true>(lds, gq, Sq, Eq);
#endif
#endif
            }
            {
                unsigned char* ws = args_ptr()->ws; const int G = grd_l(), bx = bid_l();
                pg8::Gemm gk{256, NP, 256}; pg8::Order Sk; Sk.init(R, 1536, G, bx, (bf16_t*)(ws + WS_P) + C_KVC, NP, (bf16_t*)(ws + WS_WUKV) + (size_t)l * 1536 * 256, 256, 1 << 20, 0);
                EpiKV Ek{ws};
#ifndef NO_GK
                pg8::gemm_phase<EpiKV, pg8::Order, true, true>(lds, gk, Sk, Ek);
#ifdef PROBE_G2
                __syncthreads(); pg8::gemm_phase<EpiKV, pg8::Order, true, true>(lds, gk, Sk, Ek);
#endif
#endif
            }
#endif
            GSYNC();
#ifndef NO_ATT
#ifdef PROBE_ATT
            ph_attention<true>(args_ptr(), lnd(l), lds);
            GSYNC();
#endif
            ph_attention<false>(args_ptr(), lnd(l), lds);
#endif
            GSYNC();
#ifdef PROBE_R2
            ph_diff_post<true>(args_ptr(), lnd(l)); GSYNC();
#endif
            ph_diff_post<false>(args_ptr(), lnd(l));
            GSYNC();
#ifndef NO_BR
            {
                unsigned char* ws = args_ptr()->ws; const int G = grd_l(), bx = bid_l();
                pg8::Gemm gb{1024, NP, 1024}; pg8::Order S; S.init(R, 3072, G, bx, (bf16_t*)(ws + WS_P) + C_Z, NP, (bf16_t*)(ws + WS_WB) + (size_t)l * 3 * 1024 * 1024, 1024, 4, 1024 * 2, l != 0);
#ifdef PROBE_BR
                { EpiBrT<true> Ed{ws}; pg8::gemm_phase<EpiBrT<true>, pg8::Order, true, true>(lds, gb, S, Ed); __syncthreads(); }
#endif
                EpiBrT<false> E{ws};
                pg8::gemm_phase<EpiBrT<false>, pg8::Order, true, true>(lds, gb, S, E);
            }
#endif
            GSYNC();
#ifndef NO_OUT
            {
                ArgsP ap = args_ptr(); unsigned char* ws = ap->ws; const int G = grd_l(), bx = bid_l();
                pg8::Gemm go{3072, NP, 3072}; pg8::Order S; S.init(R, 1024, G, bx, (bf16_t*)(ws + WS_P) + C_GM, NP, (bf16_t*)(ws + WS_WO3) + (size_t)l * 1024 * 3072, 3072, 1 << 20, 0, l != 0);
#ifdef PROBE_OUT
                { EpiOutT<true> Ed{l, g, (l == 0) ? ap->in[I_X] : (const float*)ap->out, ap->out, ap->in[I_CTX], ws}; pg8::gemm_phase<EpiOutT<true>, pg8::Order, true, true>(lds, go, S, Ed); __syncthreads(); }
#endif
                EpiOutT<false> E{l, g, (l == 0) ? ap->in[I_X] : (const float*)ap->out, ap->out, ap->in[I_CTX], ws};
                pg8::gemm_phase<EpiOutT<false>, pg8::Order, true, true>(lds, go, S, E);
            }
#endif
        }
        GSYNC();
    }
#ifdef PROBE_R2
    ph_final_norm<true>(args_ptr()); GSYNC();
#endif
    ph_final_norm<false>(args_ptr());
}

extern "C" void kernel_launch(void* const* d_in, const int* in_sizes, int n_in, void* d_out, int out_size, void* d_ws, size_t ws_size, hipStream_t stream) {
    static int grid = 0;
    if (grid == 0) {
        if (n_in != 21 || ws_size < WS_END) { fprintf(stderr, "kernel_launch: expected 21 inputs and >= %zu bytes of workspace (got %d, %zu)\n", (size_t)WS_END, n_in, ws_size); grid = -1; return; }
        int dev = 0, cus = 0, per_cu = 0;
        (void)hipGetDevice(&dev); (void)hipDeviceGetAttribute(&cus, hipDeviceAttributeMultiprocessorCount, dev);
        if (hipFuncSetAttribute((const void*)hybrid_fwd, hipFuncAttributeMaxDynamicSharedMemorySize, LDS_BYTES) != hipSuccess) fprintf(stderr, "kernel_launch: hipFuncSetAttribute failed\n");
        if (hipOccupancyMaxActiveBlocksPerMultiprocessor(&per_cu, (const void*)hybrid_fwd, 512, LDS_BYTES) != hipSuccess || per_cu < 1) { per_cu = 1; (void)hipGetLastError(); }
        if (cus <= 0) cus = 256;
        grid = cus * per_cu;
    }
    if (grid < 0) return;
    Args a{};
    for (int i = 0; i < 21; ++i) a.in[i] = (const float*)d_in[i];
    a.out = (float*)d_out; a.ws = (unsigned char*)d_ws;
    (void)hipMemsetAsync(d_ws, 0, 16384, stream);
    void* args[] = {&a};
    hipError_t e = hipLaunchCooperativeKernel((const void*)hybrid_fwd, dim3(grid), dim3(512), args, LDS_BYTES, stream);
    if (e != hipSuccess) fprintf(stderr, "kernel_launch: cooperative launch failed: %s (grid %d)\n", hipGetErrorString(e), grid);
}
```
